# Optimizing an MI355X kernel written in HIP

```python
import math
import jax, jax.numpy as jnp
from jax import lax
import numpy as np

D_MODEL = 2048
BATCH = 4
SEQ = 4096
DEPTH = 4

CHUNK = 64
N_MIXERS = 3
EPS = 1e-6
DA_HEAD_DIM = 128
DA_HEADS = D_MODEL // (2 * DA_HEAD_DIM)
DA_VALUE_DIM = 2 * DA_HEAD_DIM
Q_BLOCK = 128
S5_GROUP = 16
S5_GROUPS = D_MODEL // S5_GROUP
S5_STATE = 64
S5_DT_MIN = 0.001
S5_DT_MAX = 0.1
RET_QK_DIM = 256
RET_HEADS = D_MODEL // RET_QK_DIM
RET_V_DIM = 2 * RET_QK_DIM
ROPE_BASE = 10000.0
D_FF = 4 * D_MODEL
N_A = (DEPTH + N_MIXERS - 1) // N_MIXERS
N_B = (DEPTH + N_MIXERS - 2) // N_MIXERS
N_C = DEPTH // N_MIXERS

kernel_name = "hybrid_diffattn_s5_retention_sqrelu"

F32 = jnp.float32


def rmsnorm(x, g):
    xf = x.astype(F32)
    y = xf * lax.rsqrt(jnp.mean(xf * xf, axis=-1, keepdims=True) + EPS)
    return (y * g.astype(F32)).astype(x.dtype)


def rotary(t, pos):
    half = t.shape[-1] // 2
    inv = 1.0 / (ROPE_BASE ** jnp.linspace(0.0, 1.0, half, dtype=F32))
    ang = pos[:, None] * inv[None, :]
    cos = jnp.cos(ang)[None, :, None, :]
    sin = jnp.sin(ang)[None, :, None, :]
    t1, t2 = t[..., :half], t[..., half:]
    return jnp.concatenate([t1 * cos - t2 * sin, t1 * sin + t2 * cos], axis=-1)


def diff_attention(h, w_in, lam_p, subln_g, w_out, lambda_init):
    B, S, D = h.shape
    q, k, v = jnp.split(h @ w_in, 3, axis=-1)
    q = q.reshape(B, S, DA_HEADS, 2, DA_HEAD_DIM).astype(F32) * DA_HEAD_DIM ** -0.5
    k = k.reshape(B, S, DA_HEADS, 2, DA_HEAD_DIM).astype(F32)
    v = v.reshape(B, S, DA_HEADS, DA_VALUE_DIM).astype(F32)
    lp = lam_p.astype(F32)
    lam = jnp.exp(jnp.sum(lp[0] * lp[1])) - jnp.exp(jnp.sum(lp[2] * lp[3])) + lambda_init
    n_blk = S // Q_BLOCK
    k_chunk = jnp.arange(S) // CHUNK
    q_blocks = q.reshape(B, n_blk, Q_BLOCK, DA_HEADS, 2, DA_HEAD_DIM).swapaxes(0, 1)

    def block(args):
        qb, bi = args
        q_chunk = (bi * Q_BLOCK + jnp.arange(Q_BLOCK)) // CHUNK
        mask = k_chunk[None, :] <= q_chunk[:, None]
        s = jnp.einsum('bqhtd,bkhtd->bhtqk', qb, k)
        p = jax.nn.softmax(jnp.where(mask, s, -jnp.inf), axis=-1)
        pd = p[:, :, 0] - lam * p[:, :, 1]
        return jnp.einsum('bhqk,bkhe->bqhe', pd, v)

    o = lax.map(block, (q_blocks, jnp.arange(n_blk)))
    o = o.swapaxes(0, 1).reshape(B, S, DA_HEADS, DA_VALUE_DIM)
    o = o * lax.rsqrt(jnp.mean(o * o, axis=-1, keepdims=True) + EPS)
    o = o * subln_g.astype(F32) * (1.0 - lambda_init)
    return o.reshape(B, S, D).astype(h.dtype) @ w_out


def _scan_combine(first, second):
    a1r, a1i, b1r, b1i = first
    a2r, a2i, b2r, b2i = second
    ar = a2r * a1r - a2i * a1i
    ai = a2r * a1i + a2i * a1r
    br = a2r * b1r - a2i * b1i + b2r
    bi = a2r * b1i + a2i * b1r + b2i
    return (ar, ai, br, bi)


def s5_mixer(h, a_re, a_im, log_dt, b_re, b_im, c_re, c_im, d_skip, w_glu):
    B, S, D = h.shape
    lam_re = a_re.astype(F32)
    lam_im = a_im.astype(F32)
    dt = jnp.exp(log_dt.astype(F32))[:, None]
    mag = jnp.exp(lam_re * dt)
    ab_re = mag * jnp.cos(lam_im * dt)
    ab_im = mag * jnp.sin(lam_im * dt)
    den = lam_re * lam_re + lam_im * lam_im
    nr, ni = ab_re - 1.0, ab_im
    coef_re = (nr * lam_re + ni * lam_im) / den
    coef_im = (ni * lam_re - nr * lam_im) / den
    br, bim = b_re.astype(F32), b_im.astype(F32)
    bb_re = coef_re[..., None] * br - coef_im[..., None] * bim
    bb_im = coef_re[..., None] * bim + coef_im[..., None] * br
    cr, ci = c_re.astype(F32), c_im.astype(F32)
    a_seq_re = jnp.broadcast_to(ab_re, (S, S5_GROUPS, S5_STATE))
    a_seq_im = jnp.broadcast_to(ab_im, (S, S5_GROUPS, S5_STATE))
    u = h.astype(F32).reshape(B, S, S5_GROUPS, S5_GROUP)

    def per_sequence(u_s):
        bu_re = jnp.einsum('sgc,gpc->sgp', u_s, bb_re)
        bu_im = jnp.einsum('sgc,gpc->sgp', u_s, bb_im)
        _, _, x_re, x_im = lax.associative_scan(
            _scan_combine, (a_seq_re, a_seq_im, bu_re, bu_im), axis=0)
        return jnp.einsum('sgp,gcp->sgc', x_re, cr) - jnp.einsum('sgp,gcp->sgc', x_im, ci)

    y = lax.map(per_sequence, u).reshape(B, S, D)
    y = y + d_skip.astype(F32) * h.astype(F32)
    g = jax.nn.gelu(y).astype(h.dtype)
    val, gate = jnp.split(g @ w_glu, 2, axis=-1)
    return val * jax.nn.sigmoid(gate)


def retention_mixer(h, w_in, w_out):
    B, S, D = h.shape
    proj = h @ w_in
    q, k, v, g = jnp.split(proj, [D, 2 * D, 4 * D], axis=-1)
    pos = jnp.arange(S, dtype=F32)
    q = rotary(q.reshape(B, S, RET_HEADS, RET_QK_DIM).astype(F32), pos)
    k = rotary(k.reshape(B, S, RET_HEADS, RET_QK_DIM).astype(F32), pos) * RET_QK_DIM ** -0.5
    v = v.reshape(B, S, RET_HEADS, RET_V_DIM).astype(F32)
    log_gamma = jnp.log(1.0 - jnp.exp2(-5.0 - jnp.arange(RET_HEADS, dtype=F32)))
    idx = jnp.arange(CHUNK, dtype=F32)
    intra_decay = jnp.exp(log_gamma[:, None, None] * jnp.abs(idx[:, None] - idx[None, :]))
    q_decay = jnp.exp(log_gamma[None, :] * (idx[:, None] + 1.0))
    k_decay = jnp.exp(log_gamma[None, :] * (CHUNK - 1.0 - idx[:, None]))
    chunk_decay = jnp.exp(log_gamma * CHUNK)
    n_ch = S // CHUNK

    def to_chunks(t):
        return t.reshape(B, n_ch, CHUNK, *t.shape[2:]).swapaxes(0, 1)

    def step(R, inp):
        qc, kc, vc = inp
        s = jnp.einsum('bnhd,bmhd->bhnm', qc, kc) * intra_decay
        o = jnp.einsum('bhnm,bmhe->bnhe', s, vc)
        o = o + jnp.einsum('bnhd,bhde->bnhe', qc * q_decay[..., None], R)
        R = R * chunk_decay[None, :, None, None] + jnp.einsum(
            'bmhd,bmhe->bhde', kc * k_decay[..., None], vc)
        return R, o

    R0 = jnp.zeros((B, RET_HEADS, RET_QK_DIM, RET_V_DIM), F32)
    _, o = lax.scan(step, R0, (to_chunks(q), to_chunks(k), to_chunks(v)))
    o = o.swapaxes(0, 1).reshape(B, S, RET_HEADS, RET_V_DIM)
    o = o * lax.rsqrt(jnp.mean(o * o, axis=-1, keepdims=True) + EPS)
    o = (jax.nn.silu(g.astype(F32)) * o.reshape(B, S, RET_HEADS * RET_V_DIM)).astype(h.dtype)
    return o @ w_out


def sqrelu_mlp(h, w1, w2):
    a = jax.nn.relu(h @ w1)
    return (a * a) @ w2


def setup_inputs(seed: int = 0) -> dict:
    key = jax.random.key(seed)
    ks = jax.random.split(key, 24)
    D = D_MODEL

    def w(k, shape, fan_in):
        return jax.random.normal(k, shape, F32) * fan_in ** -0.5

    def gain(k, shape):
        return 1.0 + 0.02 * jax.random.normal(k, shape, F32)

    G, P, C = S5_GROUPS, S5_STATE, S5_GROUP
    return {
        "x": jax.random.normal(ks[0], (BATCH, SEQ, D), F32),
        "norm_mix": gain(ks[1], (DEPTH, D)),
        "norm_mlp": gain(ks[2], (DEPTH, D)),
        "norm_final": gain(ks[3], (D,)),
        "a_w_in": w(ks[4], (N_A, D, 3 * D), D),
        "a_lambda": 0.1 * jax.random.normal(ks[5], (N_A, 4, DA_HEAD_DIM), F32),
        "a_subln": gain(ks[6], (N_A, DA_VALUE_DIM)),
        "a_w_out": w(ks[7], (N_A, D, D), D),
        "b_a_re": -0.5 + 0.01 * jax.random.normal(ks[8], (N_B, G, P), F32),
        "b_a_im": jnp.pi * jnp.arange(P, dtype=F32)[None, None, :]
                  + 0.01 * jax.random.normal(ks[9], (N_B, G, P), F32),
        "b_log_dt": jax.random.uniform(ks[10], (N_B, G), F32,
                                       math.log(S5_DT_MIN), math.log(S5_DT_MAX)),
        "b_b_re": w(ks[11], (N_B, G, P, C), 2 * C),
        "b_b_im": w(ks[12], (N_B, G, P, C), 2 * C),
        "b_c_re": w(ks[13], (N_B, G, C, P), 2 * P),
        "b_c_im": w(ks[14], (N_B, G, C, P), 2 * P),
        "b_d": jax.random.normal(ks[15], (N_B, D), F32),
        "b_w_glu": w(ks[16], (N_B, D, 2 * D), D),
        "c_w_in": w(ks[17], (N_C, D, 6 * D), D),
        "c_w_out": w(ks[18], (N_C, 2 * D, D), 2 * D),
        "mlp_w1": w(ks[19], (DEPTH, D, D_FF), D),
        "mlp_w2": w(ks[20], (DEPTH, D_FF, D), D_FF),
    }


def reference(x, norm_mix, norm_mlp, norm_final, a_w_in, a_lambda, a_subln, a_w_out,
              b_a_re, b_a_im, b_log_dt, b_b_re, b_b_im, b_c_re, b_c_im, b_d, b_w_glu,
              c_w_in, c_w_out, mlp_w1, mlp_w2):
    for i in range(DEPTH):
        kind = i % N_MIXERS
        j = i // N_MIXERS
        h = rmsnorm(x, norm_mix[i])
        if kind == 0:
            lambda_init = 0.8 - 0.6 * math.exp(-0.3 * i)
            mix = diff_attention(h, a_w_in[j], a_lambda[j], a_subln[j], a_w_out[j], lambda_init)
        elif kind == 1:
            mix = s5_mixer(h, b_a_re[j], b_a_im[j], b_log_dt[j], b_b_re[j], b_b_im[j],
                           b_c_re[j], b_c_im[j], b_d[j], b_w_glu[j])
        else:
            mix = retention_mixer(h, c_w_in[j], c_w_out[j])
        x = x + mix
        x = x + sqrelu_mlp(rmsnorm(x, norm_mlp[i]), mlp_w1[i], mlp_w2[i])
    return rmsnorm(x, norm_final)
```

```cpp
#include <hip/hip_runtime.h>
#include <hip/hip_cooperative_groups.h>
#include <cstdio>
#include <cstdint>
namespace cg = cooperative_groups;

#define LAS __attribute__((address_space(3)))
typedef unsigned short bf16_t;
typedef short bf16x8 __attribute__((ext_vector_type(8)));
typedef short s16x4 __attribute__((ext_vector_type(4)));
typedef float f32x4 __attribute__((ext_vector_type(4)));
typedef float f32x2 __attribute__((ext_vector_type(2)));
typedef float f32x16 __attribute__((ext_vector_type(16)));
typedef unsigned u32x4 __attribute__((ext_vector_type(4)));
typedef unsigned u32x2 __attribute__((ext_vector_type(2)));

constexpr int T_ = 16384, D_ = 2048, S_ = 4096;
constexpr float EPS_ = 1e-6f;
constexpr int LDS_BYTES = 156672;

constexpr size_t SZ_A_IN = 6144ull * 2048 * 2, SZ_A_OUT = 2048ull * 2048 * 2, SZ_W1 = 8192ull * 2048 * 2;
constexpr size_t OFF_WT_A_IN = 0;
constexpr size_t OFF_WT_A_OUT = OFF_WT_A_IN + 2 * SZ_A_IN;
constexpr size_t OFF_WT_GLU = OFF_WT_A_OUT + 2 * SZ_A_OUT;
constexpr size_t OFF_WT_C_IN = OFF_WT_GLU + 4096ull * 2048 * 2;
constexpr size_t OFF_WT_C_OUT = OFF_WT_C_IN + 12288ull * 2048 * 2;
constexpr size_t OFF_WT_W1 = OFF_WT_C_OUT + 2048ull * 4096 * 2;
constexpr size_t OFF_WT_W2 = OFF_WT_W1 + 4 * SZ_W1;
constexpr size_t OFF_XB = OFF_WT_W2 + 4 * SZ_W1;
constexpr size_t OFF_BIG = OFF_XB + (size_t)T_ * D_ * 2;
constexpr size_t OFF_OA = OFF_BIG + (size_t)T_ * 12288 * 2;
constexpr size_t OFF_SS = OFF_OA + (size_t)T_ * 4096 * 2;
constexpr size_t OFF_RSSQ = OFF_SS + 9ull * T_ * 4;
constexpr size_t OFF_ROT = OFF_RSSQ + (size_t)T_ * 8 * 4;
constexpr size_t OFF_S5B = OFF_ROT + 4096ull * 128 * 8;
constexpr size_t OFF_S5C = OFF_S5B + 128ull * 128 * 16 * 2;
constexpr size_t OFF_S5AB = OFF_S5C + 128ull * 16 * 128 * 2;
constexpr size_t WS_END = OFF_S5AB + 128ull * 64 * 8;
constexpr size_t OFF_SSP = WS_END;
constexpr size_t OFF_RSQP = OFF_SSP + 9ull * 32 * T_ * 4;
constexpr size_t OFF_RSFIN = OFF_RSQP + 8ull * T_ * 8 * 4;
constexpr size_t OFF_BAR = OFF_RSFIN + (size_t)T_ * 4;
constexpr size_t WS_NEED = OFF_BAR + 256;
constexpr size_t OFF_ATT_SCR = OFF_BIG + (size_t)T_ * 6144 * 2;

struct Params {
    const float* x; const float* norm_mix; const float* norm_mlp; const float* norm_final;
    const float* a_w_in; const float* a_lambda; const float* a_subln; const float* a_w_out;
    const float* b_a_re; const float* b_a_im; const float* b_log_dt; const float* b_b_re; const float* b_b_im;
    const float* b_c_re; const float* b_c_im; const float* b_d; const float* b_w_glu;
    const float* c_w_in; const float* c_w_out; const float* mlp_w1; const float* mlp_w2;
    float* out; unsigned char* ws;
};

__device__ __forceinline__ unsigned cvt_pk_bf16(float lo, float hi) { unsigned r; asm volatile("v_cvt_pk_bf16_f32 %0, %1, %2" : "=v"(r) : "v"(lo), "v"(hi)); return r; }
__device__ __forceinline__ float bf2f(unsigned short b) { return __uint_as_float(((unsigned)b) << 16); }
__device__ __forceinline__ float bflo(unsigned w) { return __uint_as_float(w << 16); }
__device__ __forceinline__ float bfhi(unsigned w) { return __uint_as_float(w & 0xffff0000u); }
__device__ __forceinline__ unsigned short f2bf(float f) { return (unsigned short)(cvt_pk_bf16(f, 0.f) & 0xffffu); }

__device__ __forceinline__ int otid() { int t = threadIdx.x; asm volatile("" : "+v"(t)); return t; }
__device__ __forceinline__ int obid() { int t = blockIdx.x; asm volatile("" : "+s"(t)); return t; }

namespace pg8 {
constexpr int BM = 256, BK = 64, HALF = 128, HTB = HALF * BK * 2, STAGE_BYTES = 8 * HTB, NXCD = 8, WGM = 8;
__device__ __forceinline__ int lds_byte(int r, int c) { const int st = (r >> 4) * 2 + (c >> 5), rr = r & 15, cc = c & 31, ob = rr * 64 + cc * 2; return st * 1024 + (ob ^ (((ob >> 9) & 1) << 5)); }
__device__ __forceinline__ void stage_rc(int b, int& R, int& C) { const int st = b / 1024, sb = b % 1024, swz = sb ^ (((sb >> 9) & 1) << 5); R = (st >> 1) * 16 + swz / 64; C = (st & 1) * 32 + (swz % 64) / 2; }
struct Unit { int pm, pn; };
struct Gemm { const bf16_t* A; const bf16_t* Bt; int M, N, K; };
struct StaticOrder {
    int nM, nN, nwg, G, c;
    __device__ void init(int M, int N, int G_, int c_) { nM = M / BM; nN = N / BM; nwg = nM * nN; G = G_; c = c_; }
    __device__ bool next(int i, Unit& u) const {
        const long L = (long)i * G + c; if (L >= nwg) return false;
        int wgid = (int)L; { const int q = nwg / NXCD, r = nwg % NXCD, xcd = wgid % NXCD, off = wgid / NXCD; wgid = (xcd < r ? xcd * (q + 1) : r * (q + 1) + (xcd - r) * q) + off; }
        const int nig = WGM * nN, gid = wgid / nig, fm = gid * WGM, gsz = (nM - fm) < WGM ? (nM - fm) : WGM;
        u.pm = fm + ((wgid % nig) % gsz); u.pn = (wgid % nig) / gsz; return true;
    }
};

struct EpiBf {
    bf16_t* O; int ldc; const float* ss; int mode; const f32x2* rot;
    __device__ __forceinline__ void operator()(const f32x4 (&acc)[2][2][4][2], const Unit& u, int wr, int wc, int fr, int fq) const {
        const int row0 = u.pm * BM + wr * 64 + fr, colt = u.pn * BM + wc * 32 + 4 * fq;
        int sub = 0;
        if (mode == 1) sub = 1;
        else if (mode == 2) { sub = u.pn < 8 ? 2 : (u.pn < 16 ? 3 : (u.pn < 32 ? 0 : 4)); }
#pragma unroll
        for (int ai = 0; ai < 2; ++ai)
#pragma unroll
            for (int m = 0; m < 4; ++m) {
                const int row = row0 + ai * HALF + m * 16;
                float ssum = 0.f;
#pragma unroll
                for (int sl = 0; sl < 8; ++sl) ssum += ss[(size_t)(fq * 8 + sl) * T_ + row];
                ssum += __shfl_xor(ssum, 16); ssum += __shfl_xor(ssum, 32);
                const float rs = rsqrtf(ssum * (1.0f / D_) + EPS_);
                bf16_t* rowp = O + (size_t)row * ldc + colt;
                if (sub == 2 || sub == 3) {
                    const float ksc = (sub == 3) ? 0.0625f * rs : rs;
                    const f32x2* rp = rot + (size_t)(row & (S_ - 1)) * 128 + wc * 32 + 4 * fq;
#pragma unroll
                    for (int n = 0; n < 2; ++n) {
                        const f32x4 t1 = acc[ai][0][m][n] * ksc, t2 = acc[ai][1][m][n] * ksc;
                        f32x4 o1, o2;
#pragma unroll
                        for (int j = 0; j < 4; ++j) { const f32x2 cs = rp[n * 16 + j]; o1[j] = t1[j] * cs.x - t2[j] * cs.y; o2[j] = t1[j] * cs.y + t2[j] * cs.x; }
                        u32x2 w1, w2; w1.x = cvt_pk_bf16(o1[0], o1[1]); w1.y = cvt_pk_bf16(o1[2], o1[3]); w2.x = cvt_pk_bf16(o2[0], o2[1]); w2.y = cvt_pk_bf16(o2[2], o2[3]);
                        *(u32x2*)(rowp + n * 16) = w1; *(u32x2*)(rowp + HALF + n * 16) = w2;
                    }
                } else {
#pragma unroll
                    for (int bj = 0; bj < 2; ++bj)
#pragma unroll
                        for (int n = 0; n < 2; ++n) {
                            f32x4 v = acc[ai][bj][m][n] * rs;
                            if (sub == 1) {
#pragma unroll
                                for (int j = 0; j < 4; ++j) { const float r = fmaxf(v[j], 0.f); v[j] = r * r; }
                            } else if (sub == 4) {
#pragma unroll
                                for (int j = 0; j < 4; ++j) v[j] = v[j] / (1.0f + __expf(-v[j]));
                            }
                            u32x2 w; w.x = cvt_pk_bf16(v[0], v[1]); w.y = cvt_pk_bf16(v[2], v[3]);
                            *(u32x2*)(rowp + bj * HALF + n * 16) = w;
                        }
                }
            }
    }
};
struct EpiRes {
    const float* xin; float* xout; bf16_t* xb; float* ssn; int glu;
    __device__ __forceinline__ void operator()(const f32x4 (&acc)[2][2][4][2], const Unit& u, int wr, int wc, int fr, int fq) const {
        const int row0 = u.pm * BM + wr * 64 + fr;
#pragma unroll
        for (int ai = 0; ai < 2; ++ai)
#pragma unroll
            for (int m = 0; m < 4; ++m) {
                const int row = row0 + ai * HALF + m * 16;
                float sq = 0.f;
                if (glu) {
                    const size_t off = (size_t)row * D_ + u.pn * HALF + wc * 32 + 4 * fq;
#pragma unroll
                    for (int n = 0; n < 2; ++n) {
                        const f32x4 va = acc[ai][0][m][n], ga = acc[ai][1][m][n];
                        f32x4 xv = *(const f32x4*)(xin + off + n * 16);
#pragma unroll
                        for (int j = 0; j < 4; ++j) { xv[j] += va[j] / (1.0f + __expf(-ga[j])); sq += xv[j] * xv[j]; }
                        *(f32x4*)(xout + off + n * 16) = xv;
                        u32x2 w; w.x = cvt_pk_bf16(xv[0], xv[1]); w.y = cvt_pk_bf16(xv[2], xv[3]);
                        *(u32x2*)(xb + off + n * 16) = w;
                    }
                } else {
                    const size_t off = (size_t)row * D_ + u.pn * BM + wc * 32 + 4 * fq;
#pragma unroll
                    for (int bj = 0; bj < 2; ++bj)
#pragma unroll
                        for (int n = 0; n < 2; ++n) {
                            f32x4 xv = *(const f32x4*)(xin + off + bj * HALF + n * 16);
                            xv += acc[ai][bj][m][n];
#pragma unroll
                            for (int j = 0; j < 4; ++j) sq += xv[j] * xv[j];
                            *(f32x4*)(xout + off + bj * HALF + n * 16) = xv;
                            u32x2 w; w.x = cvt_pk_bf16(xv[0], xv[1]); w.y = cvt_pk_bf16(xv[2], xv[3]);
                            *(u32x2*)(xb + off + bj * HALF + n * 16) = w;
                        }
                }
                sq += __shfl_xor(sq, 16); sq += __shfl_xor(sq, 32);
                if (fq == 0) { if (glu) atomicAdd(ssn + (size_t)((u.pn >> 1) * 4 + wc) * T_ + row, sq);
                               else ssn[(size_t)(u.pn * 4 + wc) * T_ + row] = sq; }
            }
    }
};

template <class Epi, class Sched>
__device__ __forceinline__ void gemm_phase(LAS unsigned char* lds, const Gemm g, const Sched& S, const Epi& E) {
    const int tid = otid(), wid = __builtin_amdgcn_readfirstlane(tid >> 6), lane = tid & 63, wr = wid >> 2, wc = wid & 3, fr = lane & 15, fq = lane >> 4;
    const int K = g.K, nt = K / BK;
    unsigned voffA[2], voffB[2];
#pragma unroll
    for (int i = 0; i < 2; ++i) { int R, C; stage_rc(tid * 16 + i * 8192, R, C); voffA[i] = (unsigned)(R * K + C) * 2u; voffB[i] = voffA[i]; }
    const size_t kstep = (size_t)(BK * 2);
    const size_t hstep = (size_t)HALF * K * 2;
    const size_t tstep = 2 * hstep;
    const unsigned ldsw = (unsigned)wid * 1024u;
    const int aoff = lds_byte(wr * 64 + fr, fq * 8), boff = lds_byte(wc * 32 + fr, fq * 8);
#define PG8_SA(b, h) (((b) * 2 + (h)) * HTB)
#define PG8_SB(b, h) ((4 + (b) * 2 + (h)) * HTB)
#define PG8_STAGE(bufoff, gbase, voff) do { _Pragma("unroll") for (int _i = 0; _i < 2; ++_i) \
        __builtin_amdgcn_global_load_lds((const unsigned*)((const char*)(gbase) + (voff)[_i]), (LAS unsigned*)(lds + (bufoff) + ldsw + _i * 8192), 16, 0, 0); } while (0)
#define PG8_LDA(dst, b, h) do { _Pragma("unroll") for (int m = 0; m < 4; ++m) _Pragma("unroll") for (int k = 0; k < 2; ++k) dst[m][k] = *(const LAS bf16x8*)(lds + PG8_SA(b, h) + aoff + m * 2048 + k * 1024); } while (0)
#define PG8_LDB(dst, b, h) do { _Pragma("unroll") for (int n = 0; n < 2; ++n) _Pragma("unroll") for (int k = 0; k < 2; ++k) dst[n][k] = *(const LAS bf16x8*)(lds + PG8_SB(b, h) + boff + n * 2048 + k * 1024); } while (0)
#define PG8_MMA(ai, bj, At, Bt) do { __builtin_amdgcn_s_setprio(1); _Pragma("unroll") for (int m = 0; m < 4; ++m) _Pragma("unroll") for (int n = 0; n < 2; ++n) _Pragma("unroll") for (int k = 0; k < 2; ++k) \
        acc[ai][bj][m][n] = __builtin_amdgcn_mfma_f32_16x16x32_bf16(Bt[n][k], At[m][k], acc[ai][bj][m][n], 0, 0, 0); __builtin_amdgcn_s_setprio(0); } while (0)
#define PG8_WAIT_V(n) asm volatile("s_waitcnt vmcnt(" #n ")" ::: "memory")
#define PG8_WAIT_L(n) asm volatile("s_waitcnt lgkmcnt(" #n ")" ::: "memory")
#define PG8_BAR __builtin_amdgcn_s_barrier()
#define PG8_SCHED __builtin_amdgcn_sched_barrier(0)
    Unit cur, nxt; int ui = 0;
    if (!S.next(0, cur)) return;
    f32x4 acc[2][2][4][2];
#pragma unroll
    for (int a = 0; a < 2; ++a)
#pragma unroll
        for (int b = 0; b < 2; ++b)
#pragma unroll
            for (int m = 0; m < 4; ++m)
#pragma unroll
                for (int n = 0; n < 2; ++n) acc[a][b][m][n] = (f32x4){0.f, 0.f, 0.f, 0.f};
    bf16x8 At[4][2], B0[2][2], B1[2][2];
    const char* cA = (const char*)g.A + (size_t)cur.pm * tstep; const char* cB = (const char*)g.Bt + (size_t)cur.pn * tstep;
    PG8_STAGE(PG8_SB(0, 0), cB, voffB); PG8_STAGE(PG8_SA(0, 0), cA, voffA); PG8_STAGE(PG8_SB(0, 1), cB + hstep, voffB); PG8_STAGE(PG8_SA(0, 1), cA + hstep, voffA);
    if (wr == 1) PG8_BAR;
    PG8_WAIT_V(4); PG8_BAR;
    PG8_STAGE(PG8_SB(1, 0), cB + kstep, voffB); PG8_STAGE(PG8_SA(1, 0), cA + kstep, voffA); PG8_STAGE(PG8_SB(1, 1), cB + hstep + kstep, voffB);
    PG8_WAIT_V(6); PG8_BAR;
    for (;;) {
        const bool has_next = S.next(ui + 1, nxt);
        const char* nA = has_next ? (const char*)g.A + (size_t)nxt.pm * tstep : cA; const char* nB = has_next ? (const char*)g.Bt + (size_t)nxt.pn * tstep : cB;
        for (int t = 0; t < nt; t += 2) {
            const bool last = (t == nt - 2);
            const char* a1 = cA + (size_t)(t + 1) * kstep;
            const char* a2 = last ? nA : cA + (size_t)(t + 2) * kstep; const char* b2 = last ? nB : cB + (size_t)(t + 2) * kstep;
            const char* a3 = a2 + kstep; const char* b3 = b2 + kstep;
            PG8_LDB(B0, 0, 0); PG8_SCHED; PG8_LDA(At, 0, 0); PG8_STAGE(PG8_SA(1, 1), a1 + hstep, voffA);
            PG8_WAIT_L(8); PG8_BAR; PG8_WAIT_L(0); PG8_MMA(0, 0, At, B0); PG8_BAR; PG8_SCHED;
            PG8_LDB(B1, 0, 1); PG8_STAGE(PG8_SB(0, 0), b2, voffB);
            PG8_BAR; PG8_WAIT_L(0); PG8_MMA(0, 1, At, B1); PG8_BAR;
            PG8_LDA(At, 0, 1); PG8_STAGE(PG8_SA(0, 0), a2, voffA);
            PG8_BAR; PG8_WAIT_L(0); PG8_MMA(1, 0, At, B0); PG8_BAR; PG8_SCHED;
            PG8_STAGE(PG8_SB(0, 1), b2 + hstep, voffB);
            PG8_WAIT_V(6); PG8_BAR; PG8_MMA(1, 1, At, B1); PG8_BAR;
            PG8_LDB(B0, 1, 0); PG8_SCHED; PG8_LDA(At, 1, 0); PG8_STAGE(PG8_SA(0, 1), a2 + hstep, voffA);
            PG8_WAIT_L(8); PG8_BAR; PG8_WAIT_L(0); PG8_MMA(0, 0, At, B0); PG8_BAR; PG8_SCHED;
            PG8_LDB(B1, 1, 1); PG8_STAGE(PG8_SB(1, 0), b3, voffB);
            PG8_BAR; PG8_WAIT_L(0); PG8_MMA(0, 1, At, B1); PG8_BAR;
            PG8_LDA(At, 1, 1); PG8_STAGE(PG8_SA(1, 0), a3, voffA);
            PG8_BAR; PG8_WAIT_L(0); PG8_MMA(1, 0, At, B0); PG8_BAR; PG8_SCHED;
            PG8_STAGE(PG8_SB(1, 1), b3 + hstep, voffB);
            PG8_WAIT_V(6); PG8_BAR; PG8_MMA(1, 1, At, B1); PG8_BAR;
        }
        E(acc, cur, wr, wc, fr, fq);
        if (!has_next) break;
#pragma unroll
        for (int a = 0; a < 2; ++a)
#pragma unroll
            for (int b = 0; b < 2; ++b)
#pragma unroll
                for (int m = 0; m < 4; ++m)
#pragma unroll
                    for (int n = 0; n < 2; ++n) acc[a][b][m][n] = (f32x4){0.f, 0.f, 0.f, 0.f};
        cur = nxt; cA = nA; cB = nB; ++ui;
    }
    PG8_WAIT_V(0);
    if (wr == 0) PG8_BAR;
    PG8_BAR;
#undef PG8_SA
#undef PG8_SB
#undef PG8_STAGE
#undef PG8_LDA
#undef PG8_LDB
#undef PG8_MMA
#undef PG8_WAIT_V
#undef PG8_WAIT_L
#undef PG8_BAR
#undef PG8_SCHED
}
}

namespace att {
constexpr int D = 128, KVBLK = 64, LDK = 6144;
constexpr float SCALE = 0.088388347648318440f;
constexpr float THR = 8.f;
constexpr size_t SHM_V = KVBLK * D * 2, SHM_K = KVBLK * D * 2;
#define KSWZ(row, colB) ((row) * 256 + ((colB) ^ (((row) & 7) << 4)))
#define SBAR() __builtin_amdgcn_sched_barrier(0)
__device__ __forceinline__ int crow(int r, int hi) { return (r & 3) + 8 * (r >> 2) + 4 * hi; }
__device__ __forceinline__ void partialSM(f32x16& p0, f32x16& p1, float& m_reg, float& mn, float& alpha, bool msk) {
    constexpr float C = SCALE * 1.4426950408889634f;
    if (msk) {
#pragma unroll
        for (int r = 0; r < 16; ++r) { p0[r] = -1e30f; p1[r] = -1e30f; }
    }
    float pmax = p0[0];
#pragma unroll
    for (int r = 1; r < 16; ++r) pmax = fmaxf(pmax, p0[r]);
#pragma unroll
    for (int r = 0; r < 16; ++r) pmax = fmaxf(pmax, p1[r]);
    { auto rr = __builtin_amdgcn_permlane32_swap(__float_as_uint(pmax), __float_as_uint(pmax), false, false);
      pmax = fmaxf(__uint_as_float(rr[0]), __uint_as_float(rr[1])); }
    if (__builtin_expect(__all(pmax - m_reg <= THR / SCALE), 1)) { mn = m_reg; alpha = 1.f; }
    else { mn = fmaxf(m_reg, pmax); alpha = __builtin_amdgcn_exp2f((m_reg - mn) * C); m_reg = mn; }
    float mnC = -mn * C;
#pragma unroll
    for (int r = 0; r < 16; ++r) p0[r] = fmaf(p0[r], C, mnC);
#pragma unroll
    for (int r = 0; r < 16; ++r) p1[r] = fmaf(p1[r], C, mnC);
#pragma unroll
    for (int r = 0; r < 16; ++r) p0[r] = __builtin_amdgcn_exp2f(p0[r]);
}
__device__ __forceinline__ void finishSM(f32x16& p0, f32x16& p1, float alpha, float& l_reg, bf16x8& pa0, bf16x8& pa1, bf16x8& pa2, bf16x8& pa3) {
#pragma unroll
    for (int r = 0; r < 16; ++r) p1[r] = __builtin_amdgcn_exp2f(p1[r]);
    float ps = 0;
#pragma unroll
    for (int r = 0; r < 16; ++r) ps += p0[r];
#pragma unroll
    for (int r = 0; r < 16; ++r) ps += p1[r];
    { auto rr = __builtin_amdgcn_permlane32_swap(__float_as_uint(ps), __float_as_uint(ps), false, false);
      ps = __uint_as_float(rr[0]) + __uint_as_float(rr[1]); }
    l_reg = l_reg * alpha + ps;
#define PK4(P, BASE, OUT) do { unsigned a0 = cvt_pk_bf16(P[BASE + 0], P[BASE + 1]), a1 = cvt_pk_bf16(P[BASE + 2], P[BASE + 3]);   \
    unsigned b0 = cvt_pk_bf16(P[BASE + 4], P[BASE + 5]), b1 = cvt_pk_bf16(P[BASE + 6], P[BASE + 7]);                              \
    auto r0 = __builtin_amdgcn_permlane32_swap(a0, b0, false, false); auto r1 = __builtin_amdgcn_permlane32_swap(a1, b1, false, false); \
    u32x4 w = {r0[0], r1[0], r0[1], r1[1]}; OUT = *reinterpret_cast<bf16x8*>(&w); } while (0)
    PK4(p0, 0, pa0); PK4(p0, 8, pa1); PK4(p1, 0, pa2); PK4(p1, 8, pa3);
#undef PK4
}
__device__ __forceinline__ void qkt(f32x16& p0, f32x16& p1, const char* Ks, const bf16x8* qr, int r32, int hi) {
    p0 = f32x16{}; p1 = f32x16{};
#pragma unroll
    for (int d0 = 0; d0 < 8; ++d0) { int cb = (d0 * 16 + hi * 8) * 2;
        bf16x8 b0 = *reinterpret_cast<const bf16x8*>(Ks + KSWZ(r32, cb));
        bf16x8 b1 = *reinterpret_cast<const bf16x8*>(Ks + KSWZ(32 + r32, cb));
        p0 = __builtin_amdgcn_mfma_f32_32x32x16_bf16(b0, qr[d0], p0, 0, 0, 0);
        p1 = __builtin_amdgcn_mfma_f32_32x32x16_bf16(b1, qr[d0], p1, 0, 0, 0); }
}
__device__ __forceinline__ int v_st(int k, int c) { const int kk = (k & ~0xC) | ((k & 4) << 1) | ((k & 8) >> 1); return ((kk >> 3) * 4 + (c >> 5)) * 512 + ((kk & 7) * 32 + (c & 31)) * 2; }
__device__ __forceinline__ int v_rd_base(int lane) { return ((lane & 3) << 3) | (((lane >> 2) & 3) << 6) | (((lane >> 4) & 1) << 5) | (((lane >> 5) & 1) << 8); }
constexpr int v_rd_off(int d0, int ks, int half) { return d0 * 512 + ks * 4096 + half * 2048; }
template <int OFF> __device__ __forceinline__ s16x4 tr_read(int vb) {
    s16x4 r; asm volatile("ds_read_b64_tr_b16 %0, %1 offset:%2" : "=&v"(r) : "v"(vb), "i"(OFF) : "memory"); return r;
}
template <int D0> __device__ __forceinline__ void pv_one(f32x16& od, int vb, bf16x8 pa0, bf16x8 pa1, bf16x8 pa2, bf16x8 pa3) {
    const s16x4 l0 = tr_read<v_rd_off(D0, 0, 0)>(vb), h0 = tr_read<v_rd_off(D0, 0, 1)>(vb), l1 = tr_read<v_rd_off(D0, 1, 0)>(vb), h1 = tr_read<v_rd_off(D0, 1, 1)>(vb);
    const s16x4 l2 = tr_read<v_rd_off(D0, 2, 0)>(vb), h2 = tr_read<v_rd_off(D0, 2, 1)>(vb), l3 = tr_read<v_rd_off(D0, 3, 0)>(vb), h3 = tr_read<v_rd_off(D0, 3, 1)>(vb);
    asm volatile("s_waitcnt lgkmcnt(0)" ::: "memory"); SBAR();
#define PK(L, H) (bf16x8){L[0], L[1], L[2], L[3], H[0], H[1], H[2], H[3]}
    od = __builtin_amdgcn_mfma_f32_32x32x16_bf16(pa0, PK(l0, h0), od, 0, 0, 0);
    od = __builtin_amdgcn_mfma_f32_32x32x16_bf16(pa1, PK(l1, h1), od, 0, 0, 0);
    od = __builtin_amdgcn_mfma_f32_32x32x16_bf16(pa2, PK(l2, h2), od, 0, 0, 0);
    od = __builtin_amdgcn_mfma_f32_32x32x16_bf16(pa3, PK(l3, h3), od, 0, 0, 0);
#undef PK
}
__device__ __forceinline__ void pv_d0(f32x16* o, int vb, bf16x8 pa0, bf16x8 pa1, bf16x8 pa2, bf16x8 pa3) {
    pv_one<0>(o[0], vb, pa0, pa1, pa2, pa3); pv_one<1>(o[1], vb, pa0, pa1, pa2, pa3); pv_one<2>(o[2], vb, pa0, pa1, pa2, pa3); pv_one<3>(o[3], vb, pa0, pa1, pa2, pa3);
}
__device__ __forceinline__ void attn_body(const bf16_t* __restrict__ Qb, const bf16_t* __restrict__ Kh, const bf16_t* __restrict__ Vh, int NT, int ntw, char* lds, f32x16 (&o)[4]) {
    const int tid = otid(), wid = tid >> 6, lane = tid & 63, r32 = lane & 31, hi = lane >> 5;
    char* V_lds = lds; char* K_lds = lds + 2 * SHM_V;
    float* wsf = (float*)(lds + 2 * SHM_V + 2 * SHM_K) + wid * 64; float* li_l = wsf; float* al_l = wsf + 32;
    float m_reg = -1e30f, l_reg = 0; bf16x8 qr[8];
#pragma unroll
    for (int d = 0; d < 4; ++d) o[d] = f32x16{};
    const bf16_t* Qw = Qb + (long)(wid * 32 + r32) * LDK + hi * 8;
#pragma unroll
    for (int d0 = 0; d0 < 8; ++d0) qr[d0] = *reinterpret_cast<const bf16x8*>(Qw + d0 * 16);
    const int sr = tid >> 4, sc = (tid & 15) * 8, vst0 = v_st(sr, sc), vst1 = v_st(32 + sr, sc);
    const int vb0 = (int)(uintptr_t)V_lds + v_rd_base(lane);
    struct { bf16x8 vs0, vs1, ks0, ks1; } sr_[1];
#define SLOAD(i, k0) do { sr_[i].vs0 = *reinterpret_cast<const bf16x8*>(&Vh[(long)((k0) + sr) * LDK + sc]); sr_[i].vs1 = *reinterpret_cast<const bf16x8*>(&Vh[(long)((k0) + 32 + sr) * LDK + sc]); \
    sr_[i].ks0 = *reinterpret_cast<const bf16x8*>(&Kh[(long)((k0) + sr) * LDK + sc]); sr_[i].ks1 = *reinterpret_cast<const bf16x8*>(&Kh[(long)((k0) + 32 + sr) * LDK + sc]); } while (0)
#define SWRITE(b, i) do { *(bf16x8*)(V_lds + (b) * SHM_V + vst0) = sr_[i].vs0;          \
    *(bf16x8*)(V_lds + (b) * SHM_V + vst1) = sr_[i].vs1; int kc = sc * 2;               \
    *(bf16x8*)(K_lds + (b) * SHM_K + KSWZ(sr, kc)) = sr_[i].ks0;                       \
    *(bf16x8*)(K_lds + (b) * SHM_K + KSWZ(32 + sr, kc)) = sr_[i].ks1; } while (0)
#define SWAIT() asm volatile("s_waitcnt vmcnt(0)" ::: "memory")
#define RESC(a) do { if (__any((a) < 1.f)) { if (hi == 0) al_l[r32] = (a); asm volatile("s_waitcnt lgkmcnt(0)" ::: "memory"); \
    _Pragma("unroll") for (int d = 0; d < 4; ++d) _Pragma("unroll") for (int r = 0; r < 16; ++r) o[d][r] *= al_l[crow(r, hi)]; } } while (0)
    f32x16 pA0, pA1, pB0, pB1; float mnA, mnB, alA, alB; bf16x8 pa0, pa1, pa2, pa3;
    constexpr int SE = 0, SO = 0;
    __syncthreads();
    SLOAD(SE, 0); asm volatile("s_waitcnt vmcnt(0)" ::: "memory"); SWRITE(0, SE); __syncthreads();
    qkt(pA0, pA1, K_lds, qr, r32, hi); partialSM(pA0, pA1, m_reg, mnA, alA, false);
    SLOAD(SO, KVBLK);
    SWAIT(); SWRITE(1, SO); __syncthreads();
    for (int j = 1; j + 1 < NT; j += 2) {
        SBAR(); qkt(pB0, pB1, K_lds + SHM_K, qr, r32, hi);
        finishSM(pA0, pA1, alA, l_reg, pa0, pa1, pa2, pa3); SBAR();
        SLOAD(SO, (j + 1) * KVBLK); SBAR();
        pv_d0(o, vb0, pa0, pa1, pa2, pa3); partialSM(pB0, pB1, m_reg, mnB, alB, j >= ntw);
        __syncthreads(); SWAIT(); SWRITE(0, SE);
        RESC(alB); __syncthreads();
        SBAR(); qkt(pA0, pA1, K_lds, qr, r32, hi);
        finishSM(pB0, pB1, alB, l_reg, pa0, pa1, pa2, pa3); SBAR();
        SLOAD(SE, (j + 2) * KVBLK); SBAR();
        pv_d0(o, vb0 + (int)SHM_V, pa0, pa1, pa2, pa3); partialSM(pA0, pA1, m_reg, mnA, alA, (j + 1) >= ntw);
        __syncthreads(); SWAIT(); SWRITE(1, SO);
        RESC(alA); __syncthreads();
    }
    SBAR(); qkt(pB0, pB1, K_lds + SHM_K, qr, r32, hi);
    finishSM(pA0, pA1, alA, l_reg, pa0, pa1, pa2, pa3); SBAR();
    pv_d0(o, vb0, pa0, pa1, pa2, pa3); partialSM(pB0, pB1, m_reg, mnB, alB, (NT - 1) >= ntw);
    __syncthreads(); RESC(alB);
    finishSM(pB0, pB1, alB, l_reg, pa0, pa1, pa2, pa3); SBAR();
    pv_d0(o, vb0 + (int)SHM_V, pa0, pa1, pa2, pa3);
    if (hi == 0) li_l[r32] = l_reg; asm volatile("s_waitcnt lgkmcnt(0)" ::: "memory");
#pragma unroll
    for (int r = 0; r < 16; ++r) { const float rl = __builtin_amdgcn_rcpf(li_l[crow(r, hi)]);
#pragma unroll
        for (int d = 0; d < 4; ++d) o[d][r] *= rl; }
#undef SLOAD
#undef SWRITE
#undef SWAIT
#undef RESC
}
}

__device__ __forceinline__ void sincos_red(double ang, float& s, float& c) {
    const double k = rint(ang * 0.15915494309189535);
    const float r = (float)(ang - k * 6.283185307179586);
    s = __sinf(r); c = __cosf(r);
}
__device__ __forceinline__ float gelu_tanh(float y) {
    const float z = 0.7978845608028654f * (y + 0.044715f * y * y * y);
    const float th = 1.0f - 2.0f / (1.0f + __expf(2.0f * z));
    return 0.5f * y * (1.0f + th);
}

__device__ __forceinline__ void conv_tile(const float* __restrict__ W, bf16_t* __restrict__ Wt, int K, int N, const float* __restrict__ gain, int glu, int tile, unsigned* ldsw) {
    const int tid = otid();
    const int ntn = N >> 7; const int tk = tile / ntn, tn = tile - tk * ntn; const int k0 = tk << 7, n0 = tn << 7;
    const int kp = tid >> 5, nl = (tid & 31) << 2;
    f32x4 va[4], vb[4];
#pragma unroll
    for (int i = 0; i < 4; ++i) { const int k = 2 * (kp + 16 * i);
        va[i] = *(const f32x4*)(W + (size_t)(k0 + k) * N + n0 + nl); vb[i] = *(const f32x4*)(W + (size_t)(k0 + k + 1) * N + n0 + nl); }
    __syncthreads();
#pragma unroll
    for (int i = 0; i < 4; ++i) { const int kpair = kp + 16 * i; const int k = 2 * kpair;
        const float ga = gain ? gain[k0 + k] : 1.f, gb = gain ? gain[k0 + k + 1] : 1.f;
#pragma unroll
        for (int j = 0; j < 4; ++j) ldsw[(nl + j) * 65 + kpair] = cvt_pk_bf16(va[i][j] * ga, vb[i][j] * gb); }
    __syncthreads();
    int nbase = n0;
    if (glu) { const int bj = n0 >> 11, pn = (n0 & 2047) >> 7; nbase = 256 * pn + 128 * bj; }
#pragma unroll
    for (int i = 0; i < 4; ++i) { const int n = (tid >> 4) + 32 * i, k8 = tid & 15;
        u32x4 w; w.x = ldsw[n * 65 + k8 * 4 + 0]; w.y = ldsw[n * 65 + k8 * 4 + 1]; w.z = ldsw[n * 65 + k8 * 4 + 2]; w.w = ldsw[n * 65 + k8 * 4 + 3];
        *(u32x4*)(Wt + (size_t)(nbase + n) * K + k0 + k8 * 8) = w; }
}

__device__ __forceinline__ void prep_phase(const Params& p, unsigned char* shm) {
    const int tid = otid(), bid = obid(), G = gridDim.x;
    unsigned char* ws = p.ws;
    for (int t = bid; t < 12800; t += G) {
        const float* W; bf16_t* Wt; int K, N, glu = 0; const float* gain = nullptr; int tile;
        if (t < 1536) { const int j = t / 768; tile = t - j * 768; W = p.a_w_in + (size_t)j * 2048 * 6144; Wt = (bf16_t*)(ws + OFF_WT_A_IN + j * SZ_A_IN); K = 2048; N = 6144; gain = p.norm_mix + (size_t)(3 * j) * D_; }
        else if (t < 2048) { const int u = t - 1536; const int j = u / 256; tile = u - j * 256; W = p.a_w_out + (size_t)j * 2048 * 2048; Wt = (bf16_t*)(ws + OFF_WT_A_OUT + j * SZ_A_OUT); K = 2048; N = 2048; }
        else if (t < 2560) { tile = t - 2048; W = p.b_w_glu; Wt = (bf16_t*)(ws + OFF_WT_GLU); K = 2048; N = 4096; glu = 1; }
        else if (t < 4096) { tile = t - 2560; W = p.c_w_in; Wt = (bf16_t*)(ws + OFF_WT_C_IN); K = 2048; N = 12288; gain = p.norm_mix + 2 * D_; }
        else if (t < 4608) { tile = t - 4096; W = p.c_w_out; Wt = (bf16_t*)(ws + OFF_WT_C_OUT); K = 4096; N = 2048; }
        else if (t < 8704) { const int u = t - 4608; const int i = u / 1024; tile = u - i * 1024; W = p.mlp_w1 + (size_t)i * 2048 * 8192; Wt = (bf16_t*)(ws + OFF_WT_W1 + i * SZ_W1); K = 2048; N = 8192; gain = p.norm_mlp + (size_t)i * D_; }
        else { const int u = t - 8704; const int i = u / 1024; tile = u - i * 1024; W = p.mlp_w2 + (size_t)i * 8192 * 2048; Wt = (bf16_t*)(ws + OFF_WT_W2 + i * SZ_W1); K = 8192; N = 2048; }
        conv_tile(W, Wt, K, N, gain, glu, tile, (unsigned*)shm);
    }
    {
        float* ss = (float*)(ws + OFF_SSP); bf16_t* xb = (bf16_t*)(ws + OFF_XB);
        const int wid = tid >> 6, lane = tid & 63;
        for (int row = bid * 8 + wid; row < T_; row += G * 8) {
            const float* xr = p.x + (size_t)row * D_; float sq = 0.f;
#pragma unroll
            for (int i = 0; i < 8; ++i) { const f32x4 v = *(const f32x4*)(xr + (i * 64 + lane) * 4);
                sq += v[0] * v[0] + v[1] * v[1] + v[2] * v[2] + v[3] * v[3];
                u32x2 w; w.x = cvt_pk_bf16(v[0], v[1]); w.y = cvt_pk_bf16(v[2], v[3]);
                *(u32x2*)(xb + (size_t)row * D_ + (i * 64 + lane) * 4) = w; }
#pragma unroll
            for (int o = 32; o > 0; o >>= 1) sq += __shfl_xor(sq, o);
            if (lane < 32) ss[(size_t)lane * T_ + row] = (lane == 0) ? sq : 0.f;
        }
        for (int i = bid * 512 + tid; i < 32 * T_; i += G * 512) ss[(size_t)3 * 32 * T_ + i] = 0.f;
        float* rssq = (float*)(ws + OFF_RSQP);
        for (int i = bid * 512 + tid; i < 64 * T_; i += G * 512) rssq[i] = 0.f;
    }
    {
        f32x2* rot = (f32x2*)(ws + OFF_ROT);
        for (int i = bid * 512 + tid; i < 4096 * 128; i += G * 512) {
            const int pos = i >> 7, j = i & 127;
            const double inv = exp(-9.210340371976184 * ((double)j / 127.0));
            float s, c; sincos_red((double)pos * inv, s, c);
            f32x2 v; v.x = c; v.y = s; rot[i] = v;
        }
    }
    {
        bf16_t* Bm = (bf16_t*)(ws + OFF_S5B); bf16_t* Cm = (bf16_t*)(ws + OFF_S5C); f32x2* AB = (f32x2*)(ws + OFF_S5AB);
        const float* gmix = p.norm_mix + 1 * D_;
        for (int i = bid * 512 + tid; i < 128 * 64; i += G * 512) {
            const int g = i >> 6, pp = i & 63;
            const float lre = p.b_a_re[i], lim = p.b_a_im[i];
            const float dt = __expf(p.b_log_dt[g]);
            const float mag = __expf(lre * dt);
            float sn, cs; sincos_red((double)lim * (double)dt, sn, cs);
            const float abr = mag * cs, abi = mag * sn;
            const float den = lre * lre + lim * lim;
            const float nr = abr - 1.0f, ni = abi;
            const float cr_ = (nr * lre + ni * lim) / den, ci_ = (ni * lre - nr * lim) / den;
            f32x2 ab; ab.x = abr; ab.y = abi; AB[i] = ab;
#pragma unroll
            for (int c = 0; c < 16; ++c) {
                const float br = p.b_b_re[(size_t)i * 16 + c], bi = p.b_b_im[(size_t)i * 16 + c];
                const float gm = gmix[g * 16 + c];
                Bm[((size_t)g * 128 + pp) * 16 + c] = f2bf((cr_ * br - ci_ * bi) * gm);
                Bm[((size_t)g * 128 + 64 + pp) * 16 + c] = f2bf((cr_ * bi + ci_ * br) * gm);
                Cm[((size_t)g * 16 + c) * 128 + pp] = f2bf(p.b_c_re[((size_t)g * 16 + c) * 64 + pp]);
                Cm[((size_t)g * 16 + c) * 128 + 64 + pp] = f2bf(-p.b_c_im[((size_t)g * 16 + c) * 64 + pp]);
            }
        }
    }
}

__device__ __forceinline__ void attn_phase(const Params& p, int j, float lambda_init, unsigned char* shm) {
    const int tid = otid(), wid = tid >> 6, lane = tid & 63, r32 = lane & 31, hi = lane >> 5;
    const bf16_t* qkv = (const bf16_t*)(p.ws + OFF_BIG);
    bf16_t* oa = (bf16_t*)(p.ws + OFF_OA);
    float* scr = (float*)(p.ws + OFF_ATT_SCR) + (size_t)obid() * 2 * 32768;
    float lam;
    { const float* lp = p.a_lambda + (size_t)j * 512;
      float a = lp[lane] * lp[128 + lane] + lp[64 + lane] * lp[192 + lane];
      float b = lp[256 + lane] * lp[384 + lane] + lp[320 + lane] * lp[448 + lane];
#pragma unroll
      for (int o = 32; o > 0; o >>= 1) { a += __shfl_xor(a, o); b += __shfl_xor(b, o); }
      lam = __expf(a) - __expf(b) + lambda_init; }
    const float* sub = p.a_subln + (size_t)j * 256;
    const int c = obid(); const int xcd = c & 7, jj = c >> 3;
    const int bh = xcd * 4 + (jj >> 3), pi = jj & 7;
    const int b = bh >> 3, h = bh & 7;
#pragma unroll 1
    for (int it = 0; it < 2; ++it) {
        const int qb = it == 0 ? (15 - pi) : pi;
        const int NT = 4 * qb + 4, ntw = 4 * qb + (wid >> 1) + 1;
        const size_t tok0 = (size_t)b * S_ + (size_t)qb * 256;
        f32x16 o[4];
#pragma unroll 1
        for (int ps = 0; ps < 4; ++ps) {
            const int e = ps >> 1, t = ps & 1;
            float* sc = scr + e * 32768;
            att::attn_body(qkv + tok0 * 6144 + h * 256 + t * 128, qkv + (size_t)b * S_ * 6144 + 2048 + h * 256 + t * 128,
                           qkv + (size_t)b * S_ * 6144 + 4096 + h * 256 + e * 128, NT, ntw, (char*)shm, o);
            if (t == 0) {
#pragma unroll
                for (int d = 0; d < 4; ++d)
#pragma unroll
                    for (int r = 0; r < 16; ++r) sc[tid * 64 + d * 16 + r] = o[d][r];
            } else {
#pragma unroll
                for (int d = 0; d < 4; ++d)
#pragma unroll
                    for (int r = 0; r < 16; ++r) { const float cv = sc[tid * 64 + d * 16 + r] - lam * o[d][r]; o[d][r] = cv; if (e == 0) sc[tid * 64 + d * 16 + r] = cv; }
            }
        }
        float ssq[16];
#pragma unroll
        for (int r = 0; r < 16; ++r) { float s = 0.f;
#pragma unroll
            for (int d = 0; d < 4; ++d) { const float c0 = scr[tid * 64 + d * 16 + r]; s += c0 * c0 + o[d][r] * o[d][r]; }
#pragma unroll
            for (int of = 16; of > 0; of >>= 1) s += __shfl_xor(s, of);
            ssq[r] = rsqrtf(s * (1.0f / 256.0f) + EPS_) * (1.0f - lambda_init); }
#pragma unroll
        for (int r = 0; r < 16; ++r) {
            const size_t row = tok0 + wid * 32 + att::crow(r, hi);
            bf16_t* op = oa + row * D_ + h * 256;
#pragma unroll
            for (int d = 0; d < 4; ++d) {
                const int col = d * 32 + r32;
                op[col] = f2bf(scr[tid * 64 + d * 16 + r] * ssq[r] * sub[col]);
                op[128 + col] = f2bf(o[d][r] * ssq[r] * sub[128 + col]);
            }
        }
    }
}

template <bool FINAL>
__device__ __forceinline__ void s5_phase(const Params& p, unsigned char* shm) {
    const int tid = otid(), wid = tid >> 6, lane = tid & 63, r32 = lane & 31, hi = lane >> 5, fr = lane & 15, fq = lane >> 4;
    const bf16_t* xb = (const bf16_t*)(p.ws + OFF_XB);
    const float* ss = (const float*)(p.ws + OFF_SSP) + (size_t)2 * 32 * T_;
    float* rsfin = (float*)(p.ws + OFF_RSFIN);
    const bf16_t* Bm = (const bf16_t*)(p.ws + OFF_S5B); const bf16_t* Cm = (const bf16_t*)(p.ws + OFF_S5C); const f32x2* AB = (const f32x2*)(p.ws + OFF_S5AB);
    f32x2* E = (f32x2*)(p.ws + OFF_BIG);
    bf16_t* gl = (bf16_t*)(p.ws + OFF_OA);
    bf16_t* Xs = (bf16_t*)shm + wid * (32 * 136);
    const float* gmix = p.norm_mix + D_; const float* dsk = p.b_d;
    for (int it = obid(); it < 4096; it += gridDim.x) {
        const int goct = it & 15, chunk = (it >> 4) & 63, b = it >> 10;
        const int g = goct * 8 + wid; const int pp = r32 + 32 * hi;
        const size_t t0 = (size_t)b * S_ + chunk * 64;
        const f32x2 ab = AB[g * 64 + pp];
        bf16x8 bfr[4];
#pragma unroll
        for (int nb = 0; nb < 4; ++nb) bfr[nb] = *(const bf16x8*)(Bm + ((size_t)g * 128 + nb * 32 + r32) * 16 + hi * 8);
        float xr = 0.f, xi = 0.f;
        bf16x8 cfr[4]; float gm4[4], ds4[4];
        if (FINAL) {
            float pr = ab.x, pi_ = ab.y;
#pragma unroll
            for (int s = 0; s < 6; ++s) { const float nr = pr * pr - pi_ * pi_, ni = 2.f * pr * pi_; pr = nr; pi_ = ni; }
            const f32x2* Ep = E + ((size_t)(b * 128 + g) * 64) * 64 + pp;
            for (int c2 = 0; c2 < chunk; ++c2) { const f32x2 e = Ep[(size_t)c2 * 64];
                const float nr = pr * xr - pi_ * xi + e.x, ni = pr * xi + pi_ * xr + e.y; xr = nr; xi = ni; }
#pragma unroll
            for (int ks = 0; ks < 4; ++ks) cfr[ks] = *(const bf16x8*)(Cm + ((size_t)g * 16 + fr) * 128 + ks * 32 + fq * 8);
#pragma unroll
            for (int jx = 0; jx < 4; ++jx) { gm4[jx] = gmix[g * 16 + 4 * fq + jx]; ds4[jx] = dsk[g * 16 + 4 * fq + jx]; }
        }
#pragma unroll
        for (int half = 0; half < 2; ++half) {
            const size_t trow = t0 + half * 32 + r32;
            float rs;
            if (FINAL) rs = rsfin[trow];
            else { float ssum = 0.f;
#pragma unroll 8
                for (int sl = 0; sl < 32; ++sl) ssum += ss[(size_t)sl * T_ + trow];
                rs = rsqrtf(ssum * (1.0f / D_) + EPS_); if (goct == 0 && hi == 0 && wid == 0) rsfin[trow] = rs; }
            const u32x4 raw = *(const u32x4*)(xb + trow * D_ + g * 16 + hi * 8);
            u32x4 sc4;
            sc4.x = cvt_pk_bf16(bflo(raw.x) * rs, bfhi(raw.x) * rs); sc4.y = cvt_pk_bf16(bflo(raw.y) * rs, bfhi(raw.y) * rs);
            sc4.z = cvt_pk_bf16(bflo(raw.z) * rs, bfhi(raw.z) * rs); sc4.w = cvt_pk_bf16(bflo(raw.w) * rs, bfhi(raw.w) * rs);
            const bf16x8 afr = *reinterpret_cast<const bf16x8*>(&sc4);
            f32x16 c0 = __builtin_amdgcn_mfma_f32_32x32x16_bf16(afr, bfr[0], f32x16{}, 0, 0, 0);
            f32x16 c1 = __builtin_amdgcn_mfma_f32_32x32x16_bf16(afr, bfr[1], f32x16{}, 0, 0, 0);
            f32x16 c2 = __builtin_amdgcn_mfma_f32_32x32x16_bf16(afr, bfr[2], f32x16{}, 0, 0, 0);
            f32x16 c3 = __builtin_amdgcn_mfma_f32_32x32x16_bf16(afr, bfr[3], f32x16{}, 0, 0, 0);
#pragma unroll
            for (int i = 0; i < 16; ++i) {
                auto r0 = __builtin_amdgcn_permlane32_swap(__float_as_uint(c0[i]), __float_as_uint(c1[i]), false, false);
                c0[i] = __uint_as_float(r0[0]); c1[i] = __uint_as_float(r0[1]);
                auto r1 = __builtin_amdgcn_permlane32_swap(__float_as_uint(c2[i]), __float_as_uint(c3[i]), false, false);
                c2[i] = __uint_as_float(r1[0]); c3[i] = __uint_as_float(r1[1]);
            }
#pragma unroll
            for (int t = 0; t < 32; ++t) {
                const int q = t >> 3, s = t & 7, idx = 4 * q + (s & 3);
                const float bur = (s < 4) ? c0[idx] : c1[idx], bui = (s < 4) ? c2[idx] : c3[idx];
                const float nr = ab.x * xr - ab.y * xi + bur, ni = ab.x * xi + ab.y * xr + bui;
                xr = nr; xi = ni;
                if (FINAL) { Xs[t * 136 + pp] = f2bf(xr); Xs[t * 136 + 64 + pp] = f2bf(xi); }
            }
            if (FINAL) {
                asm volatile("s_waitcnt lgkmcnt(0)" ::: "memory");
#pragma unroll
                for (int m = 0; m < 2; ++m) {
                    f32x4 acc = {0.f, 0.f, 0.f, 0.f};
#pragma unroll
                    for (int ks = 0; ks < 4; ++ks) {
                        const bf16x8 xf = *(const bf16x8*)(Xs + (m * 16 + fr) * 136 + ks * 32 + fq * 8);
                        acc = __builtin_amdgcn_mfma_f32_16x16x32_bf16(cfr[ks], xf, acc, 0, 0, 0);
                    }
                    const size_t tr2 = t0 + half * 32 + m * 16 + fr;
                    const float rs2 = rsfin[tr2];
                    const u32x2 hx = *(const u32x2*)(xb + tr2 * D_ + g * 16 + 4 * fq);
                    const float h0 = bflo(hx.x) * rs2 * gm4[0], h1 = bfhi(hx.x) * rs2 * gm4[1], h2 = bflo(hx.y) * rs2 * gm4[2], h3 = bfhi(hx.y) * rs2 * gm4[3];
                    const float y0 = gelu_tanh(acc[0] + ds4[0] * h0), y1 = gelu_tanh(acc[1] + ds4[1] * h1), y2 = gelu_tanh(acc[2] + ds4[2] * h2), y3 = gelu_tanh(acc[3] + ds4[3] * h3);
                    u32x2 w; w.x = cvt_pk_bf16(y0, y1); w.y = cvt_pk_bf16(y2, y3);
                    *(u32x2*)(gl + tr2 * D_ + g * 16 + 4 * fq) = w;
                }
                asm volatile("s_waitcnt lgkmcnt(0)" ::: "memory");
            }
        }
        if (!FINAL) { f32x2 e; e.x = xr; e.y = xi; E[((size_t)(b * 128 + g) * 64 + chunk) * 64 + pp] = e; }
    }
}

__device__ __forceinline__ void ret_phase(const Params& p, unsigned char* shm) {
    const int tid = otid(), wid = tid >> 6, lane = tid & 63, fr = lane & 15, fq = lane >> 4;
    const bf16_t* ret = (const bf16_t*)(p.ws + OFF_BIG);
    bf16_t* ao = (bf16_t*)(p.ws + OFF_OA);
    float* rssq = (float*)(p.ws + OFF_RSQP);
    constexpr int QS = 264, TS = 72;
    bf16_t* Qs = (bf16_t*)shm; bf16_t* Ks = Qs + 64 * QS; bf16_t* KTs = Ks + 64 * QS; bf16_t* VTs = KTs + 256 * TS; bf16_t* Ss = VTs + 64 * TS; bf16_t* RTs = Ss + 64 * TS;
    const int c = obid(); const int xcd = c & 7, jj = c >> 3;
    const int bh = xcd * 4 + (jj >> 3), sl = jj & 7;
    const int b = bh >> 3, h = bh & 7;
    const float lg = logf(1.0f - exp2f(-5.0f - (float)h));
    const float cdec = __expf(lg * 64.0f);
    const float kdec = __expf(lg * (float)(63 - lane));
    const int mi = wid >> 1, ni0 = 2 * (wid & 1);
    const float qdec = __expf(lg * (float)(16 * mi + fr + 1));
    float idec[2][4];
#pragma unroll
    for (int t = 0; t < 2; ++t)
#pragma unroll
        for (int j = 0; j < 4; ++j) { const int n = 16 * mi + fr, m = 16 * (ni0 + t) + 4 * fq + j; idec[t][j] = __expf(lg * fabsf((float)(n - m))); }
    f32x4 R[4][2];
#pragma unroll
    for (int a = 0; a < 4; ++a)
#pragma unroll
        for (int d = 0; d < 2; ++d) R[a][d] = (f32x4){0.f, 0.f, 0.f, 0.f};
    const size_t tokb = (size_t)b * S_;
    const bf16_t* qsrc = ret + (tokb + lane) * 12288 + h * 256 + wid * 32;
    const bf16_t* ksrc = qsrc + 2048;
    const bf16_t* vsrc = ret + (tokb + lane) * 12288 + 4096 + h * 512 + sl * 64 + wid * 8;
    u32x4 pq[4], pk[4], pv;
#pragma unroll
    for (int j = 0; j < 4; ++j) { pq[j] = *(const u32x4*)(qsrc + j * 8); pk[j] = *(const u32x4*)(ksrc + j * 8); }
    pv = *(const u32x4*)vsrc;
    for (int ch = 0; ch < 64; ++ch) {
        __syncthreads();
#pragma unroll
        for (int j = 0; j < 4; ++j) {
            *(u32x4*)(Qs + lane * QS + wid * 32 + j * 8) = pq[j];
            *(u32x4*)(Ks + lane * QS + wid * 32 + j * 8) = pk[j];
            const unsigned kw[4] = {pk[j].x, pk[j].y, pk[j].z, pk[j].w};
#pragma unroll
            for (int i = 0; i < 4; ++i) {
                KTs[(wid * 32 + j * 8 + 2 * i) * TS + lane] = f2bf(bflo(kw[i]) * kdec);
                KTs[(wid * 32 + j * 8 + 2 * i + 1) * TS + lane] = f2bf(bfhi(kw[i]) * kdec);
            }
        }
        { const unsigned vw[4] = {pv.x, pv.y, pv.z, pv.w};
#pragma unroll
          for (int i = 0; i < 4; ++i) { VTs[(wid * 8 + 2 * i) * TS + lane] = (bf16_t)(vw[i] & 0xffffu); VTs[(wid * 8 + 2 * i + 1) * TS + lane] = (bf16_t)(vw[i] >> 16); } }
#pragma unroll
        for (int ei = 0; ei < 4; ++ei)
#pragma unroll
            for (int di = 0; di < 2; ++di) { u32x2 w; w.x = cvt_pk_bf16(R[ei][di][0], R[ei][di][1]); w.y = cvt_pk_bf16(R[ei][di][2], R[ei][di][3]);
                *(u32x2*)(RTs + (16 * ei + fr) * QS + wid * 32 + 16 * di + 4 * fq) = w; }
        if (ch + 1 < 64) {
            const size_t adv = (size_t)(ch + 1) * 64 * 12288;
#pragma unroll
            for (int j = 0; j < 4; ++j) { pq[j] = *(const u32x4*)(qsrc + adv + j * 8); pk[j] = *(const u32x4*)(ksrc + adv + j * 8); }
            pv = *(const u32x4*)(vsrc + adv);
        }
        __syncthreads();
        {
            f32x4 sacc[2] = {{0.f, 0.f, 0.f, 0.f}, {0.f, 0.f, 0.f, 0.f}};
#pragma unroll
            for (int ks = 0; ks < 8; ++ks) {
                const bf16x8 af = *(const bf16x8*)(Qs + (16 * mi + fr) * QS + ks * 32 + fq * 8);
#pragma unroll
                for (int t = 0; t < 2; ++t) { const bf16x8 bf = *(const bf16x8*)(Ks + (16 * (ni0 + t) + fr) * QS + ks * 32 + fq * 8);
                    sacc[t] = __builtin_amdgcn_mfma_f32_16x16x32_bf16(bf, af, sacc[t], 0, 0, 0); }
            }
#pragma unroll
            for (int t = 0; t < 2; ++t) { u32x2 w; w.x = cvt_pk_bf16(sacc[t][0] * idec[t][0], sacc[t][1] * idec[t][1]); w.y = cvt_pk_bf16(sacc[t][2] * idec[t][2], sacc[t][3] * idec[t][3]);
                *(u32x2*)(Ss + (16 * mi + fr) * TS + 16 * (ni0 + t) + 4 * fq) = w; }
        }
        __syncthreads();
        {
            f32x4 oi[2] = {{0.f, 0.f, 0.f, 0.f}, {0.f, 0.f, 0.f, 0.f}}, oc[2] = {{0.f, 0.f, 0.f, 0.f}, {0.f, 0.f, 0.f, 0.f}};
#pragma unroll
            for (int ks = 0; ks < 2; ++ks) {
                const bf16x8 af = *(const bf16x8*)(Ss + (16 * mi + fr) * TS + ks * 32 + fq * 8);
#pragma unroll
                for (int t = 0; t < 2; ++t) { const bf16x8 bf = *(const bf16x8*)(VTs + (16 * (ni0 + t) + fr) * TS + ks * 32 + fq * 8);
                    oi[t] = __builtin_amdgcn_mfma_f32_16x16x32_bf16(bf, af, oi[t], 0, 0, 0); }
            }
#pragma unroll
            for (int ks = 0; ks < 8; ++ks) {
                const bf16x8 af = *(const bf16x8*)(Qs + (16 * mi + fr) * QS + ks * 32 + fq * 8);
#pragma unroll
                for (int t = 0; t < 2; ++t) { const bf16x8 bf = *(const bf16x8*)(RTs + (16 * (ni0 + t) + fr) * QS + ks * 32 + fq * 8);
                    oc[t] = __builtin_amdgcn_mfma_f32_16x16x32_bf16(bf, af, oc[t], 0, 0, 0); }
            }
            const size_t tok = tokb + (size_t)ch * 64 + 16 * mi + fr;
            float sq = 0.f;
#pragma unroll
            for (int t = 0; t < 2; ++t) {
                const int e = sl * 64 + 16 * (ni0 + t) + 4 * fq;
                const u32x2 gw = *(const u32x2*)(ret + tok * 12288 + 8192 + h * 512 + e);
                f32x4 ov = oi[t] + oc[t] * qdec;
                sq += ov[0] * ov[0] + ov[1] * ov[1] + ov[2] * ov[2] + ov[3] * ov[3];
                u32x2 w; w.x = cvt_pk_bf16(ov[0] * bflo(gw.x), ov[1] * bfhi(gw.x)); w.y = cvt_pk_bf16(ov[2] * bflo(gw.y), ov[3] * bfhi(gw.y));
                *(u32x2*)(ao + tok * 4096 + h * 512 + e) = w;
            }
            sq += __shfl_xor(sq, 16); sq += __shfl_xor(sq, 32);
            if (fq == 0) atomicAdd(rssq + (size_t)(sl * 4 + mi) * 0 + (size_t)sl * (T_ * 8) + tok * 8 + h, sq);
        }
#pragma unroll
        for (int ei = 0; ei < 4; ++ei)
#pragma unroll
            for (int di = 0; di < 2; ++di) R[ei][di] *= cdec;
#pragma unroll
        for (int ks = 0; ks < 2; ++ks) {
            bf16x8 bfk[2];
#pragma unroll
            for (int di = 0; di < 2; ++di) bfk[di] = *(const bf16x8*)(KTs + (wid * 32 + 16 * di + fr) * TS + ks * 32 + fq * 8);
#pragma unroll
            for (int ei = 0; ei < 4; ++ei) { const bf16x8 af = *(const bf16x8*)(VTs + (16 * ei + fr) * TS + ks * 32 + fq * 8);
#pragma unroll
                for (int di = 0; di < 2; ++di) R[ei][di] = __builtin_amdgcn_mfma_f32_16x16x32_bf16(bfk[di], af, R[ei][di], 0, 0, 0); }
        }
    }
}

__device__ __forceinline__ void ret2_phase(const Params& p) {
    bf16_t* ao = (bf16_t*)(p.ws + OFF_OA); const float* rssq = (const float*)(p.ws + OFF_RSQP);
    const size_t nvec = (size_t)T_ * 4096 / 8;
    for (size_t i = (size_t)obid() * 512 + otid(); i < nvec; i += (size_t)gridDim.x * 512) {
        const size_t t = i >> 9; const int hh = (int)((i & 511) >> 6);
        float rsum = 0.f;
#pragma unroll
        for (int sl = 0; sl < 8; ++sl) rsum += rssq[(size_t)sl * (T_ * 8) + t * 8 + hh];
        const float rs = rsqrtf(rsum * (1.0f / 512.0f) + EPS_);
        u32x4 w = *(u32x4*)(ao + i * 8);
        w.x = cvt_pk_bf16(bflo(w.x) * rs, bfhi(w.x) * rs); w.y = cvt_pk_bf16(bflo(w.y) * rs, bfhi(w.y) * rs);
        w.z = cvt_pk_bf16(bflo(w.z) * rs, bfhi(w.z) * rs); w.w = cvt_pk_bf16(bflo(w.w) * rs, bfhi(w.w) * rs);
        *(u32x4*)(ao + i * 8) = w;
    }
}

__device__ __forceinline__ void final_phase(const Params& p) {
    const float* ss = (const float*)(p.ws + OFF_SSP) + (size_t)8 * 32 * T_;
    const int tid = otid();
    const f32x4 g = *(const f32x4*)(p.norm_final + tid * 4);
    for (int row = obid(); row < T_; row += gridDim.x) {
        float ssum = ss[(size_t)(tid & 31) * T_ + row];
#pragma unroll
        for (int o = 16; o > 0; o >>= 1) ssum += __shfl_xor(ssum, o);
        const float rs = rsqrtf(ssum * (1.0f / D_) + EPS_);
        f32x4 v = *(f32x4*)(p.out + (size_t)row * D_ + tid * 4);
        v = v * rs * g;
        *(f32x4*)(p.out + (size_t)row * D_ + tid * 4) = v;
    }
}

enum { OP_PREP = 0, OP_A_IN, OP_ATTN, OP_A_OUT, OP_S5A, OP_S5C, OP_GLU, OP_C_IN, OP_RET, OP_RET2, OP_C_OUT, OP_W1, OP_W2, OP_FINAL };
#ifndef PHMASK
#define PHMASK 0xffff
#endif
#define PHON(b) ((PHMASK >> (b)) & 1)
constexpr int NPH = 23;
__device__ const unsigned char PROG_OP[NPH] = { OP_PREP,
    OP_A_IN, OP_ATTN, OP_A_OUT, OP_W1, OP_W2,
    OP_S5A, OP_S5C, OP_GLU, OP_W1, OP_W2,
    OP_C_IN, OP_RET, OP_RET2, OP_C_OUT, OP_W1, OP_W2,
    OP_A_IN, OP_ATTN, OP_A_OUT, OP_W1, OP_W2,
    OP_FINAL };
__device__ const unsigned char PROG_LAYER[NPH] = { 0, 0, 0, 0, 0, 0, 1, 1, 1, 1, 1, 2, 2, 2, 2, 2, 2, 3, 3, 3, 3, 3, 3 };

struct GemmDesc { unsigned long long a_off, b_off; int N, K, ss_idx, mode; };
#define GD_NONE {0, 0, 0, 0, 0, 0}
#define GD_A_IN(L)  {OFF_XB, OFF_WT_A_IN + (L / 3) * SZ_A_IN, 6144, 2048, 2 * L, 0}
#define GD_A_OUT(L) {OFF_OA, OFF_WT_A_OUT + (L / 3) * SZ_A_OUT, 2048, 2048, 2 * L + 1, 0}
#define GD_W1(L)    {OFF_XB, OFF_WT_W1 + L * SZ_W1, 8192, 2048, 2 * L + 1, 1}
#define GD_W2(L)    {OFF_BIG, OFF_WT_W2 + L * SZ_W1, 2048, 8192, 2 * L + 2, 0}
#define GD_GLU(L)   {OFF_OA, OFF_WT_GLU, 4096, 2048, 2 * L + 1, 1}
#define GD_C_IN(L)  {OFF_XB, OFF_WT_C_IN, 12288, 2048, 2 * L, 2}
#define GD_C_OUT(L) {OFF_OA, OFF_WT_C_OUT, 2048, 4096, 2 * L + 1, 0}
__device__ const GemmDesc GD[NPH] = { GD_NONE,
    GD_A_IN(0ull), GD_NONE, GD_A_OUT(0ull), GD_W1(0ull), GD_W2(0ull),
    GD_NONE, GD_NONE, GD_GLU(1ull), GD_W1(1ull), GD_W2(1ull),
    GD_C_IN(2ull), GD_NONE, GD_NONE, GD_C_OUT(2ull), GD_W1(2ull), GD_W2(2ull),
    GD_A_IN(3ull), GD_NONE, GD_A_OUT(3ull), GD_W1(3ull), GD_W2(3ull),
    GD_NONE };

__device__ __forceinline__ void gsync(cg::grid_group& grid, unsigned* ctr, unsigned& epoch) {
    __builtin_amdgcn_fence(__ATOMIC_RELEASE, "agent");
    asm volatile("s_waitcnt vmcnt(0) lgkmcnt(0)" ::: "memory");
    grid.sync();
    epoch += gridDim.x;
    if (threadIdx.x == 0) {
        __hip_atomic_fetch_add(ctr, 1u, __ATOMIC_RELAXED, __HIP_MEMORY_SCOPE_AGENT);
        while (__hip_atomic_load(ctr, __ATOMIC_RELAXED, __HIP_MEMORY_SCOPE_AGENT) < epoch) __builtin_amdgcn_s_sleep(2);
    }
    __syncthreads();
    __builtin_amdgcn_fence(__ATOMIC_ACQUIRE, "agent");
    asm volatile("s_waitcnt vmcnt(0) lgkmcnt(0)" ::: "memory");
}

__global__ void __launch_bounds__(512, 2) fwd_megakernel(Params p, int ph_lo, int ph_hi) {
    extern __shared__ __attribute__((aligned(16))) unsigned char shm[];
    cg::grid_group grid = cg::this_grid();
    unsigned* bar = (unsigned*)(p.ws + OFF_BAR); unsigned epoch = 0;
    if (PHON(0) && ph_lo == 0) { prep_phase(p, shm); if (ph_hi > 1) gsync(grid, bar, epoch); }
    for (int ph = (ph_lo < 1 ? 1 : ph_lo); ph < ph_hi; ++ph) {
        const int op = PROG_OP[ph], L = PROG_LAYER[ph];
        unsigned char* ws = p.ws; asm volatile("" : "+s"(ws));
        float* ssb = (float*)(ws + OFF_SSP);
        if (PHON(1) && (op == OP_A_IN || op == OP_C_IN || op == OP_W1)) {
            const GemmDesc gd = GD[ph];
            pg8::Gemm g; g.A = (const bf16_t*)(ws + gd.a_off); g.Bt = (const bf16_t*)(ws + gd.b_off); g.M = T_; g.N = gd.N; g.K = gd.K;
            pg8::EpiBf E; E.rot = (const f32x2*)(ws + OFF_ROT); E.O = (bf16_t*)(ws + OFF_BIG); E.ldc = gd.N; E.mode = gd.mode; E.ss = ssb + (size_t)gd.ss_idx * 32 * T_;
            pg8::StaticOrder S; S.init(g.M, g.N, (int)gridDim.x, obid());
            pg8::gemm_phase<pg8::EpiBf, pg8::StaticOrder>((LAS unsigned char*)shm, g, S, E);
        } else if (PHON(2) && (op == OP_A_OUT || op == OP_GLU || op == OP_C_OUT || op == OP_W2)) {
            const GemmDesc gd = GD[ph];
            pg8::Gemm g; g.A = (const bf16_t*)(ws + gd.a_off); g.Bt = (const bf16_t*)(ws + gd.b_off); g.M = T_; g.N = gd.N; g.K = gd.K;
            pg8::EpiRes E; E.xout = p.out; E.xb = (bf16_t*)(ws + OFF_XB); E.glu = gd.mode; E.xin = (ph == 3) ? p.x : (const float*)p.out; E.ssn = ssb + (size_t)gd.ss_idx * 32 * T_;
            pg8::StaticOrder S; S.init(g.M, g.N, (int)gridDim.x, obid());
            pg8::gemm_phase<pg8::EpiRes, pg8::StaticOrder>((LAS unsigned char*)shm, g, S, E);
        } else if (PHON(3) && op == OP_ATTN) {
            const float li = 0.8f - 0.6f * expf(-0.3f * (float)L);
            attn_phase(p, L / 3, li, shm);
        } else if (PHON(4) && op == OP_S5A) {
            s5_phase<false>(p, shm);
        } else if (PHON(5) && op == OP_S5C) {
            s5_phase<true>(p, shm);
        } else if (PHON(6) && op == OP_RET) {
            ret_phase(p, shm);
        } else if (PHON(7) && op == OP_RET2) {
            ret2_phase(p);
        } else if (PHON(8) && op == OP_FINAL) {
            final_phase(p);
        }
        if (ph + 1 < ph_hi) gsync(grid, bar, epoch);
    }
}

extern "C" void kernel_launch(void* const* d_in, const int* in_sizes, int n_in, void* d_out, int out_size, void* d_ws, size_t ws_size, hipStream_t stream) {
    static int grid_blocks = 0;
    if (grid_blocks == 0) {
        if (n_in != 21 || out_size != T_ * D_ || ws_size < WS_NEED) { fprintf(stderr, "kernel_launch: unexpected shapes n_in %d out %d ws %zu (need %zu)\n", n_in, out_size, ws_size, (size_t)WS_NEED); grid_blocks = -1; return; }
        int dev = 0, cus = 0, per_cu = 0;
        hipGetDevice(&dev);
        hipDeviceGetAttribute(&cus, hipDeviceAttributeMultiprocessorCount, dev);
        if (hipFuncSetAttribute((const void*)fwd_megakernel, hipFuncAttributeMaxDynamicSharedMemorySize, LDS_BYTES) != hipSuccess) { fprintf(stderr, "kernel_launch: hipFuncSetAttribute failed\n"); grid_blocks = -1; return; }
        hipOccupancyMaxActiveBlocksPerMultiprocessor(&per_cu, (const void*)fwd_megakernel, 512, LDS_BYTES);
        (void)hipGetLastError();
        if (per_cu < 1) per_cu = 1;
        grid_blocks = cus * 1;
        if (grid_blocks != 256) fprintf(stderr, "kernel_launch: note: %d CUs (kernel tuned for 256)\n", cus);
    }
    if (grid_blocks < 0) return;
    (void)hipMemsetAsync((unsigned char*)d_ws + OFF_BAR, 0, 256, stream);
    Params p{};
    const float** pp = (const float**)&p;
    for (int i = 0; i < 21; ++i) pp[i] = (const float*)d_in[i];
    p.out = (float*)d_out; p.ws = (unsigned char*)d_ws;
#ifndef DBG_LO
#define DBG_LO 0
#endif
#ifndef DBG_HI
#define DBG_HI NPH
#endif
    int lo = DBG_LO, hi = DBG_HI;
    void* args[] = {&p, &lo, &hi};
    hipError_t e = hipLaunchCooperativeKernel((const void*)fwd_megakernel, dim3(grid_blocks), dim3(512), args, LDS_BYTES, stream);
    if (e != hipSuccess) fprintf(stderr, "cooperative launch failed: %s (grid %d)\n", hipGetErrorString(e), grid_blocks);
}
```

```cpp
#include <hip/hip_runtime.h>
#include <hip/hip_cooperative_groups.h>
#include <cstdio>
#include <cstdint>
namespace cg = cooperative_groups;

#define LAS __attribute__((address_space(3)))
typedef unsigned short bf16_t;
typedef short bf16x8 __attribute__((ext_vector_type(8)));
typedef short s16x4 __attribute__((ext_vector_type(4)));
typedef float f32x4 __attribute__((ext_vector_type(4)));
typedef float f32x2 __attribute__((ext_vector_type(2)));
typedef float f32x16 __attribute__((ext_vector_type(16)));
typedef unsigned u32x4 __attribute__((ext_vector_type(4)));
typedef unsigned u32x2 __attribute__((ext_vector_type(2)));

constexpr int T_ = 16384, D_ = 2048, S_ = 4096;
constexpr float EPS_ = 1e-6f;
constexpr int LDS_BYTES = 156672;

constexpr size_t SZ_A_IN = 6144ull * 2048 * 2, SZ_A_OUT = 2048ull * 2048 * 2, SZ_W1 = 8192ull * 2048 * 2;
constexpr size_t OFF_WT_A_IN = 0;
constexpr size_t OFF_WT_A_OUT = OFF_WT_A_IN + 2 * SZ_A_IN;
constexpr size_t OFF_WT_GLU = OFF_WT_A_OUT + 2 * SZ_A_OUT;
constexpr size_t OFF_WT_C_IN = OFF_WT_GLU + 4096ull * 2048 * 2;
constexpr size_t OFF_WT_C_OUT = OFF_WT_C_IN + 12288ull * 2048 * 2;
constexpr size_t OFF_WT_W1 = OFF_WT_C_OUT + 2048ull * 4096 * 2;
constexpr size_t OFF_WT_W2 = OFF_WT_W1 + 4 * SZ_W1;
constexpr size_t OFF_XB = OFF_WT_W2 + 4 * SZ_W1;
constexpr size_t OFF_BIG = OFF_XB + (size_t)T_ * D_ * 2;
constexpr size_t OFF_OA = OFF_BIG + (size_t)T_ * 12288 * 2;
constexpr size_t OFF_SS = OFF_OA + (size_t)T_ * 4096 * 2;
constexpr size_t OFF_RSSQ = OFF_SS + 9ull * T_ * 4;
constexpr size_t OFF_ROT = OFF_RSSQ + (size_t)T_ * 8 * 4;
constexpr size_t OFF_S5B = OFF_ROT + 4096ull * 128 * 8;
constexpr size_t OFF_S5C = OFF_S5B + 128ull * 128 * 16 * 2;
constexpr size_t OFF_S5AB = OFF_S5C + 128ull * 16 * 128 * 2;
constexpr size_t WS_END = OFF_S5AB + 128ull * 64 * 8;
constexpr size_t OFF_SSP = WS_END;
constexpr size_t OFF_RSQP = OFF_SSP + 9ull * 32 * T_ * 4;
constexpr size_t OFF_RSFIN = OFF_RSQP + 8ull * T_ * 8 * 4;
constexpr size_t OFF_BAR = OFF_RSFIN + (size_t)T_ * 4;
constexpr size_t WS_NEED = OFF_BAR + 256;
constexpr size_t OFF_ATT_SCR = OFF_BIG + (size_t)T_ * 6144 * 2;

struct Params {
    const float* x; const float* norm_mix; const float* norm_mlp; const float* norm_final;
    const float* a_w_in; const float* a_lambda; const float* a_subln; const float* a_w_out;
    const float* b_a_re; const float* b_a_im; const float* b_log_dt; const float* b_b_re; const float* b_b_im;
    const float* b_c_re; const float* b_c_im; const float* b_d; const float* b_w_glu;
    const float* c_w_in; const float* c_w_out; const float* mlp_w1; const float* mlp_w2;
    float* out; unsigned char* ws;
};

__device__ __forceinline__ unsigned cvt_pk_bf16(float lo, float hi) { unsigned r; asm volatile("v_cvt_pk_bf16_f32 %0, %1, %2" : "=v"(r) : "v"(lo), "v"(hi)); return r; }
__device__ __forceinline__ float bf2f(unsigned short b) { return __uint_as_float(((unsigned)b) << 16); }
__device__ __forceinline__ float bflo(unsigned w) { return __uint_as_float(w << 16); }
__device__ __forceinline__ float bfhi(unsigned w) { return __uint_as_float(w & 0xffff0000u); }
__device__ __forceinline__ unsigned short f2bf(float f) { return (unsigned short)(cvt_pk_bf16(f, 0.f) & 0xffffu); }

__device__ __forceinline__ int otid() { int t = threadIdx.x; asm volatile("" : "+v"(t)); return t; }
__device__ __forceinline__ int obid() { int t = blockIdx.x; asm volatile("" : "+s"(t)); return t; }

namespace pg8 {
constexpr int BM = 256, BK = 64, HALF = 128, HTB = HALF * BK * 2, STAGE_BYTES = 8 * HTB, NXCD = 8, WGM = 8;
__device__ __forceinline__ int lds_byte(int r, int c) { const int st = (r >> 4) * 2 + (c >> 5), rr = r & 15, cc = c & 31, ob = rr * 64 + cc * 2; return st * 1024 + (ob ^ (((ob >> 9) & 1) << 5)); }
__device__ __forceinline__ void stage_rc(int b, int& R, int& C) { const int st = b / 1024, sb = b % 1024, swz = sb ^ (((sb >> 9) & 1) << 5); R = (st >> 1) * 16 + swz / 64; C = (st & 1) * 32 + (swz % 64) / 2; }
struct Unit { int pm, pn; };
struct Gemm { const bf16_t* A; const bf16_t* Bt; int M, N, K; };
struct StaticOrder {
    int nM, nN, nwg, G, c;
    __device__ void init(int M, int N, int G_, int c_) { nM = M / BM; nN = N / BM; nwg = nM * nN; G = G_; c = c_; }
    __device__ bool next(int i, Unit& u) const {
        const long L = (long)i * G + c; if (L >= nwg) return false;
        int wgid = (int)L; { const int q = nwg / NXCD, r = nwg % NXCD, xcd = wgid % NXCD, off = wgid / NXCD; wgid = (xcd < r ? xcd * (q + 1) : r * (q + 1) + (xcd - r) * q) + off; }
        const int nig = WGM * nN, gid = wgid / nig, fm = gid * WGM, gsz = (nM - fm) < WGM ? (nM - fm) : WGM;
        u.pm = fm + ((wgid % nig) % gsz); u.pn = (wgid % nig) / gsz; return true;
    }
};

#define GAS __attribute__((address_space(1)))
struct EpiBf {
    bf16_t* O; int ldc; const float* ss; int mode; const f32x2* rot;
    __device__ __forceinline__ void operator()(const f32x4 (&acc)[2][2][4][2], const Unit& u, int wr, int wc, int fr, int fq) const {
        const int row0 = u.pm * BM + wr * 64 + fr, colt = u.pn * BM + wc * 32 + 4 * fq;
        int sub = 0;
        if (mode == 1) sub = 1;
        else if (mode == 2) { sub = u.pn < 8 ? 2 : (u.pn < 16 ? 3 : (u.pn < 32 ? 0 : 4)); }
        const GAS float* ssg = (const GAS float*)ss + (size_t)(fq * 8) * T_ + row0;
        float rs8[8];
#pragma unroll
        for (int r = 0; r < 8; ++r) { float a = 0.f;
#pragma unroll
            for (int sl = 0; sl < 8; ++sl) a += ssg[(size_t)sl * T_ + (r >> 2) * HALF + (r & 3) * 16];
            rs8[r] = a; }
#pragma unroll
        for (int r = 0; r < 8; ++r) { float a = rs8[r]; a += __shfl_xor(a, 16); a += __shfl_xor(a, 32); rs8[r] = rsqrtf(a * (1.0f / D_) + EPS_); }
        GAS bf16_t* Og = (GAS bf16_t*)O;
        if (sub == 2 || sub == 3) {
            const GAS f32x2* rotg = (const GAS f32x2*)rot + wc * 32 + 4 * fq;
#pragma unroll
            for (int ai = 0; ai < 2; ++ai) {
                f32x2 cs[4][2][4];
#pragma unroll
                for (int m = 0; m < 4; ++m) { const int row = row0 + ai * HALF + m * 16; const GAS f32x2* rp = rotg + (size_t)(row & (S_ - 1)) * 128;
#pragma unroll
                    for (int n = 0; n < 2; ++n)
#pragma unroll
                        for (int j = 0; j < 4; ++j) cs[m][n][j] = rp[n * 16 + j]; }
#pragma unroll
                for (int m = 0; m < 4; ++m) { const int row = row0 + ai * HALF + m * 16;
                    const float ksc = (sub == 3) ? 0.0625f * rs8[ai * 4 + m] : rs8[ai * 4 + m];
                    GAS bf16_t* rowp = Og + (size_t)row * ldc + colt;
#pragma unroll
                    for (int n = 0; n < 2; ++n) {
                        const f32x4 t1 = acc[ai][0][m][n] * ksc, t2 = acc[ai][1][m][n] * ksc;
                        f32x4 o1, o2;
#pragma unroll
                        for (int j = 0; j < 4; ++j) { const f32x2 c2 = cs[m][n][j]; o1[j] = t1[j] * c2.x - t2[j] * c2.y; o2[j] = t1[j] * c2.y + t2[j] * c2.x; }
                        u32x2 w1, w2; w1.x = cvt_pk_bf16(o1[0], o1[1]); w1.y = cvt_pk_bf16(o1[2], o1[3]); w2.x = cvt_pk_bf16(o2[0], o2[1]); w2.y = cvt_pk_bf16(o2[2], o2[3]);
                        *(GAS u32x2*)(rowp + n * 16) = w1; *(GAS u32x2*)(rowp + HALF + n * 16) = w2;
                    }
                }
            }
        } else {
#pragma unroll
            for (int ai = 0; ai < 2; ++ai)
#pragma unroll
                for (int m = 0; m < 4; ++m) {
                    const int row = row0 + ai * HALF + m * 16;
                    const float rs = rs8[ai * 4 + m];
                    GAS bf16_t* rowp = Og + (size_t)row * ldc + colt;
#pragma unroll
                    for (int bj = 0; bj < 2; ++bj)
#pragma unroll
                        for (int n = 0; n < 2; ++n) {
                            f32x4 v = acc[ai][bj][m][n] * rs;
                            if (sub == 1) {
#pragma unroll
                                for (int j = 0; j < 4; ++j) { const float r = fmaxf(v[j], 0.f); v[j] = r * r; }
                            } else if (sub == 4) {
#pragma unroll
                                for (int j = 0; j < 4; ++j) v[j] = v[j] / (1.0f + __expf(-v[j]));
                            }
                            u32x2 w; w.x = cvt_pk_bf16(v[0], v[1]); w.y = cvt_pk_bf16(v[2], v[3]);
                            *(GAS u32x2*)(rowp + bj * HALF + n * 16) = w;
                        }
                }
        }
    }
};
struct EpiRes {
    const float* xin; float* xout; bf16_t* xb; float* ssn; int glu;
    __device__ __forceinline__ void operator()(const f32x4 (&acc)[2][2][4][2], const Unit& u, int wr, int wc, int fr, int fq) const {
        const int row0 = u.pm * BM + wr * 64 + fr;
        const GAS float* xi = (const GAS float*)xin; GAS float* xo = (GAS float*)xout; GAS bf16_t* xbg = (GAS bf16_t*)xb; GAS float* ssg = (GAS float*)ssn;
        if (glu) {
            const size_t cb = (size_t)u.pn * HALF + wc * 32 + 4 * fq;
#pragma unroll
            for (int ai = 0; ai < 2; ++ai) {
                f32x4 xv[4][2];
#pragma unroll
                for (int m = 0; m < 4; ++m)
#pragma unroll
                    for (int n = 0; n < 2; ++n) xv[m][n] = *(const GAS f32x4*)(xi + (size_t)(row0 + ai * HALF + m * 16) * D_ + cb + n * 16);
#pragma unroll
                for (int m = 0; m < 4; ++m) {
                    const int row = row0 + ai * HALF + m * 16; const size_t off = (size_t)row * D_ + cb;
                    float sq = 0.f;
#pragma unroll
                    for (int n = 0; n < 2; ++n) {
                        const f32x4 va = acc[ai][0][m][n], ga = acc[ai][1][m][n];
                        f32x4 x4 = xv[m][n];
#pragma unroll
                        for (int j = 0; j < 4; ++j) { x4[j] += va[j] / (1.0f + __expf(-ga[j])); sq += x4[j] * x4[j]; }
                        *(GAS f32x4*)(xo + off + n * 16) = x4;
                        u32x2 w; w.x = cvt_pk_bf16(x4[0], x4[1]); w.y = cvt_pk_bf16(x4[2], x4[3]);
                        *(GAS u32x2*)(xbg + off + n * 16) = w;
                    }
                    sq += __shfl_xor(sq, 16); sq += __shfl_xor(sq, 32);
                    if (fq == 0) atomicAdd((float*)ssn + (size_t)((u.pn >> 1) * 4 + wc) * T_ + row, sq);
                }
            }
        } else {
            const size_t cb = (size_t)u.pn * BM + wc * 32 + 4 * fq;
#pragma unroll
            for (int ai = 0; ai < 2; ++ai) {
                f32x4 xv[4][2][2];
#pragma unroll
                for (int m = 0; m < 4; ++m)
#pragma unroll
                    for (int bj = 0; bj < 2; ++bj)
#pragma unroll
                        for (int n = 0; n < 2; ++n) xv[m][bj][n] = *(const GAS f32x4*)(xi + (size_t)(row0 + ai * HALF + m * 16) * D_ + cb + bj * HALF + n * 16);
#pragma unroll
                for (int m = 0; m < 4; ++m) {
                    const int row = row0 + ai * HALF + m * 16; const size_t off = (size_t)row * D_ + cb;
                    float sq = 0.f;
#pragma unroll
                    for (int bj = 0; bj < 2; ++bj)
#pragma unroll
                        for (int n = 0; n < 2; ++n) {
                            f32x4 x4 = xv[m][bj][n] + acc[ai][bj][m][n];
#pragma unroll
                            for (int j = 0; j < 4; ++j) sq += x4[j] * x4[j];
                            *(GAS f32x4*)(xo + off + bj * HALF + n * 16) = x4;
                            u32x2 w; w.x = cvt_pk_bf16(x4[0], x4[1]); w.y = cvt_pk_bf16(x4[2], x4[3]);
                            *(GAS u32x2*)(xbg + off + bj * HALF + n * 16) = w;
                        }
                    sq += __shfl_xor(sq, 16); sq += __shfl_xor(sq, 32);
                    if (fq == 0) ssg[(size_t)(u.pn * 4 + wc) * T_ + row] = sq;
                }
            }
        }
    }
};

template <class Epi, class Sched>
__device__ __forceinline__ void gemm_phase(LAS unsigned char* lds, const Gemm g, const Sched& S, const Epi& E) {
    const int tid = otid(), wid = __builtin_amdgcn_readfirstlane(tid >> 6), lane = tid & 63, wr = wid >> 2, wc = wid & 3, fr = lane & 15, fq = lane >> 4;
    const int K = g.K, nt = K / BK;
    unsigned voffA[2], voffB[2];
#pragma unroll
    for (int i = 0; i < 2; ++i) { int R, C; stage_rc(tid * 16 + i * 8192, R, C); voffA[i] = (unsigned)(R * K + C) * 2u; voffB[i] = voffA[i]; }
    const size_t kstep = (size_t)(BK * 2);
    const size_t hstep = (size_t)HALF * K * 2;
    const size_t tstep = 2 * hstep;
    const unsigned ldsw = (unsigned)wid * 1024u;
    const int aoff = lds_byte(wr * 64 + fr, fq * 8), boff = lds_byte(wc * 32 + fr, fq * 8);
#define PG8_SA(b, h) (((b) * 2 + (h)) * HTB)
#define PG8_SB(b, h) ((4 + (b) * 2 + (h)) * HTB)
#define PG8_STAGE(bufoff, gbase, voff) do { _Pragma("unroll") for (int _i = 0; _i < 2; ++_i) \
        __builtin_amdgcn_global_load_lds((const unsigned*)((const char*)(gbase) + (voff)[_i]), (LAS unsigned*)(lds + (bufoff) + ldsw + _i * 8192), 16, 0, 0); } while (0)
#define PG8_LDA(dst, b, h) do { _Pragma("unroll") for (int m = 0; m < 4; ++m) _Pragma("unroll") for (int k = 0; k < 2; ++k) dst[m][k] = *(const LAS bf16x8*)(lds + PG8_SA(b, h) + aoff + m * 2048 + k * 1024); } while (0)
#define PG8_LDB(dst, b, h) do { _Pragma("unroll") for (int n = 0; n < 2; ++n) _Pragma("unroll") for (int k = 0; k < 2; ++k) dst[n][k] = *(const LAS bf16x8*)(lds + PG8_SB(b, h) + boff + n * 2048 + k * 1024); } while (0)
#define PG8_MMA(ai, bj, At, Bt) do { __builtin_amdgcn_s_setprio(1); _Pragma("unroll") for (int m = 0; m < 4; ++m) _Pragma("unroll") for (int n = 0; n < 2; ++n) _Pragma("unroll") for (int k = 0; k < 2; ++k) \
        acc[ai][bj][m][n] = __builtin_amdgcn_mfma_f32_16x16x32_bf16(Bt[n][k], At[m][k], acc[ai][bj][m][n], 0, 0, 0); __builtin_amdgcn_s_setprio(0); } while (0)
#define PG8_WAIT_V(n) asm volatile("s_waitcnt vmcnt(" #n ")" ::: "memory")
#define PG8_WAIT_L(n) asm volatile("s_waitcnt lgkmcnt(" #n ")" ::: "memory")
#define PG8_BAR __builtin_amdgcn_s_barrier()
#define PG8_SCHED __builtin_amdgcn_sched_barrier(0)
    Unit cur, nxt; int ui = 0;
    if (!S.next(0, cur)) return;
    f32x4 acc[2][2][4][2];
#pragma unroll
    for (int a = 0; a < 2; ++a)
#pragma unroll
        for (int b = 0; b < 2; ++b)
#pragma unroll
            for (int m = 0; m < 4; ++m)
#pragma unroll
                for (int n = 0; n < 2; ++n) acc[a][b][m][n] = (f32x4){0.f, 0.f, 0.f, 0.f};
    bf16x8 At[4][2], B0[2][2], B1[2][2];
    const char* cA = (const char*)g.A + (size_t)cur.pm * tstep; const char* cB = (const char*)g.Bt + (size_t)cur.pn * tstep;
    PG8_STAGE(PG8_SB(0, 0), cB, voffB); PG8_STAGE(PG8_SA(0, 0), cA, voffA); PG8_STAGE(PG8_SB(0, 1), cB + hstep, voffB); PG8_STAGE(PG8_SA(0, 1), cA + hstep, voffA);
    if (wr == 1) PG8_BAR;
    PG8_WAIT_V(4); PG8_BAR;
    PG8_STAGE(PG8_SB(1, 0), cB + kstep, voffB); PG8_STAGE(PG8_SA(1, 0), cA + kstep, voffA); PG8_STAGE(PG8_SB(1, 1), cB + hstep + kstep, voffB);
    PG8_WAIT_V(6); PG8_BAR;
    for (;;) {
        const bool has_next = S.next(ui + 1, nxt);
        const char* nA = has_next ? (const char*)g.A + (size_t)nxt.pm * tstep : cA; const char* nB = has_next ? (const char*)g.Bt + (size_t)nxt.pn * tstep : cB;
        for (int t = 0; t < nt; t += 2) {
            const bool last = (t == nt - 2);
            const char* a1 = cA + (size_t)(t + 1) * kstep;
            const char* a2 = last ? nA : cA + (size_t)(t + 2) * kstep; const char* b2 = last ? nB : cB + (size_t)(t + 2) * kstep;
            const char* a3 = a2 + kstep; const char* b3 = b2 + kstep;
            PG8_LDB(B0, 0, 0); PG8_SCHED; PG8_LDA(At, 0, 0); PG8_STAGE(PG8_SA(1, 1), a1 + hstep, voffA);
            PG8_WAIT_L(8); PG8_BAR; PG8_WAIT_L(0); PG8_MMA(0, 0, At, B0); PG8_BAR; PG8_SCHED;
            PG8_LDB(B1, 0, 1); PG8_STAGE(PG8_SB(0, 0), b2, voffB);
            PG8_BAR; PG8_WAIT_L(0); PG8_MMA(0, 1, At, B1); PG8_BAR;
            PG8_LDA(At, 0, 1); PG8_STAGE(PG8_SA(0, 0), a2, voffA);
            PG8_BAR; PG8_WAIT_L(0); PG8_MMA(1, 0, At, B0); PG8_BAR; PG8_SCHED;
            PG8_STAGE(PG8_SB(0, 1), b2 + hstep, voffB);
            PG8_WAIT_V(6); PG8_BAR; PG8_MMA(1, 1, At, B1); PG8_BAR;
            PG8_LDB(B0, 1, 0); PG8_SCHED; PG8_LDA(At, 1, 0); PG8_STAGE(PG8_SA(0, 1), a2 + hstep, voffA);
            PG8_WAIT_L(8); PG8_BAR; PG8_WAIT_L(0); PG8_MMA(0, 0, At, B0); PG8_BAR; PG8_SCHED;
            PG8_LDB(B1, 1, 1); PG8_STAGE(PG8_SB(1, 0), b3, voffB);
            PG8_BAR; PG8_WAIT_L(0); PG8_MMA(0, 1, At, B1); PG8_BAR;
            PG8_LDA(At, 1, 1); PG8_STAGE(PG8_SA(1, 0), a3, voffA);
            PG8_BAR; PG8_WAIT_L(0); PG8_MMA(1, 0, At, B0); PG8_BAR; PG8_SCHED;
            PG8_STAGE(PG8_SB(1, 1), b3 + hstep, voffB);
            PG8_WAIT_V(6); PG8_BAR; PG8_MMA(1, 1, At, B1); PG8_BAR;
        }
        E(acc, cur, wr, wc, fr, fq);
        if (!has_next) break;
#pragma unroll
        for (int a = 0; a < 2; ++a)
#pragma unroll
            for (int b = 0; b < 2; ++b)
#pragma unroll
                for (int m = 0; m < 4; ++m)
#pragma unroll
                    for (int n = 0; n < 2; ++n) acc[a][b][m][n] = (f32x4){0.f, 0.f, 0.f, 0.f};
        cur = nxt; cA = nA; cB = nB; ++ui;
    }
    PG8_WAIT_V(0);
    if (wr == 0) PG8_BAR;
    PG8_BAR;
#undef PG8_SA
#undef PG8_SB
#undef PG8_STAGE
#undef PG8_LDA
#undef PG8_LDB
#undef PG8_MMA
#undef PG8_WAIT_V
#undef PG8_WAIT_L
#undef PG8_BAR
#undef PG8_SCHED
}
}

namespace att {
constexpr int D = 128, KVBLK = 64, LDK = 6144;
constexpr float SCALE = 0.088388347648318440f;
constexpr float THR = 8.f;
constexpr size_t SHM_V = KVBLK * D * 2, SHM_K = KVBLK * D * 2;
#define KSWZ(row, colB) ((row) * 256 + ((colB) ^ (((row) & 7) << 4)))
#define SBAR() __builtin_amdgcn_sched_barrier(0)
__device__ __forceinline__ int crow(int r, int hi) { return (r & 3) + 8 * (r >> 2) + 4 * hi; }
__device__ __forceinline__ void partialSM(f32x16& p0, f32x16& p1, float& m_reg, float& mn, float& alpha, bool msk) {
    constexpr float C = SCALE * 1.4426950408889634f;
    if (msk) {
#pragma unroll
        for (int r = 0; r < 16; ++r) { p0[r] = -1e30f; p1[r] = -1e30f; }
    }
    float pmax = p0[0];
#pragma unroll
    for (int r = 1; r < 16; ++r) pmax = fmaxf(pmax, p0[r]);
#pragma unroll
    for (int r = 0; r < 16; ++r) pmax = fmaxf(pmax, p1[r]);
    { auto rr = __builtin_amdgcn_permlane32_swap(__float_as_uint(pmax), __float_as_uint(pmax), false, false);
      pmax = fmaxf(__uint_as_float(rr[0]), __uint_as_float(rr[1])); }
    if (__builtin_expect(__all(pmax - m_reg <= THR / SCALE), 1)) { mn = m_reg; alpha = 1.f; }
    else { mn = fmaxf(m_reg, pmax); alpha = __builtin_amdgcn_exp2f((m_reg - mn) * C); m_reg = mn; }
    float mnC = -mn * C;
#pragma unroll
    for (int r = 0; r < 16; ++r) p0[r] = fmaf(p0[r], C, mnC);
#pragma unroll
    for (int r = 0; r < 16; ++r) p1[r] = fmaf(p1[r], C, mnC);
#pragma unroll
    for (int r = 0; r < 16; ++r) p0[r] = __builtin_amdgcn_exp2f(p0[r]);
}
__device__ __forceinline__ void finishSM(f32x16& p0, f32x16& p1, float alpha, float& l_reg, bf16x8& pa0, bf16x8& pa1, bf16x8& pa2, bf16x8& pa3) {
#pragma unroll
    for (int r = 0; r < 16; ++r) p1[r] = __builtin_amdgcn_exp2f(p1[r]);
    float ps = 0;
#pragma unroll
    for (int r = 0; r < 16; ++r) ps += p0[r];
#pragma unroll
    for (int r = 0; r < 16; ++r) ps += p1[r];
    { auto rr = __builtin_amdgcn_permlane32_swap(__float_as_uint(ps), __float_as_uint(ps), false, false);
      ps = __uint_as_float(rr[0]) + __uint_as_float(rr[1]); }
    l_reg = l_reg * alpha + ps;
#define PK4(P, BASE, OUT) do { unsigned a0 = cvt_pk_bf16(P[BASE + 0], P[BASE + 1]), a1 = cvt_pk_bf16(P[BASE + 2], P[BASE + 3]);   \
    unsigned b0 = cvt_pk_bf16(P[BASE + 4], P[BASE + 5]), b1 = cvt_pk_bf16(P[BASE + 6], P[BASE + 7]);                              \
    auto r0 = __builtin_amdgcn_permlane32_swap(a0, b0, false, false); auto r1 = __builtin_amdgcn_permlane32_swap(a1, b1, false, false); \
    u32x4 w = {r0[0], r1[0], r0[1], r1[1]}; OUT = *reinterpret_cast<bf16x8*>(&w); } while (0)
    PK4(p0, 0, pa0); PK4(p0, 8, pa1); PK4(p1, 0, pa2); PK4(p1, 8, pa3);
#undef PK4
}
__device__ __forceinline__ void qkt(f32x16& p0, f32x16& p1, const char* Ks, const bf16x8* qr, int r32, int hi) {
    p0 = f32x16{}; p1 = f32x16{};
#pragma unroll
    for (int d0 = 0; d0 < 8; ++d0) { int cb = (d0 * 16 + hi * 8) * 2;
        bf16x8 b0 = *reinterpret_cast<const bf16x8*>(Ks + KSWZ(r32, cb));
        bf16x8 b1 = *reinterpret_cast<const bf16x8*>(Ks + KSWZ(32 + r32, cb));
        p0 = __builtin_amdgcn_mfma_f32_32x32x16_bf16(b0, qr[d0], p0, 0, 0, 0);
        p1 = __builtin_amdgcn_mfma_f32_32x32x16_bf16(b1, qr[d0], p1, 0, 0, 0); }
}
__device__ __forceinline__ int v_st(int k, int c) { const int kk = (k & ~0xC) | ((k & 4) << 1) | ((k & 8) >> 1); return ((kk >> 3) * 4 + (c >> 5)) * 512 + ((kk & 7) * 32 + (c & 31)) * 2; }
__device__ __forceinline__ int v_rd_base(int lane) { return ((lane & 3) << 3) | (((lane >> 2) & 3) << 6) | (((lane >> 4) & 1) << 5) | (((lane >> 5) & 1) << 8); }
constexpr int v_rd_off(int d0, int ks, int half) { return d0 * 512 + ks * 4096 + half * 2048; }
template <int OFF> __device__ __forceinline__ s16x4 tr_read(int vb) {
    s16x4 r; asm volatile("ds_read_b64_tr_b16 %0, %1 offset:%2" : "=&v"(r) : "v"(vb), "i"(OFF) : "memory"); return r;
}
template <int D0> __device__ __forceinline__ void pv_one(f32x16& od, int vb, bf16x8 pa0, bf16x8 pa1, bf16x8 pa2, bf16x8 pa3) {
    const s16x4 l0 = tr_read<v_rd_off(D0, 0, 0)>(vb), h0 = tr_read<v_rd_off(D0, 0, 1)>(vb), l1 = tr_read<v_rd_off(D0, 1, 0)>(vb), h1 = tr_read<v_rd_off(D0, 1, 1)>(vb);
    const s16x4 l2 = tr_read<v_rd_off(D0, 2, 0)>(vb), h2 = tr_read<v_rd_off(D0, 2, 1)>(vb), l3 = tr_read<v_rd_off(D0, 3, 0)>(vb), h3 = tr_read<v_rd_off(D0, 3, 1)>(vb);
    asm volatile("s_waitcnt lgkmcnt(0)" ::: "memory"); SBAR();
#define PK(L, H) (bf16x8){L[0], L[1], L[2], L[3], H[0], H[1], H[2], H[3]}
    od = __builtin_amdgcn_mfma_f32_32x32x16_bf16(pa0, PK(l0, h0), od, 0, 0, 0);
    od = __builtin_amdgcn_mfma_f32_32x32x16_bf16(pa1, PK(l1, h1), od, 0, 0, 0);
    od = __builtin_amdgcn_mfma_f32_32x32x16_bf16(pa2, PK(l2, h2), od, 0, 0, 0);
    od = __builtin_amdgcn_mfma_f32_32x32x16_bf16(pa3, PK(l3, h3), od, 0, 0, 0);
#undef PK
}
__device__ __forceinline__ void pv_d0(f32x16* o, int vb, bf16x8 pa0, bf16x8 pa1, bf16x8 pa2, bf16x8 pa3) {
    pv_one<0>(o[0], vb, pa0, pa1, pa2, pa3); pv_one<1>(o[1], vb, pa0, pa1, pa2, pa3); pv_one<2>(o[2], vb, pa0, pa1, pa2, pa3); pv_one<3>(o[3], vb, pa0, pa1, pa2, pa3);
}
__device__ __forceinline__ void attn_body(const bf16_t* __restrict__ Qb, const bf16_t* __restrict__ Kh, const bf16_t* __restrict__ Vh, int NT, int ntw, char* lds, f32x16 (&o)[4]) {
    const int tid = otid(), wid = tid >> 6, lane = tid & 63, r32 = lane & 31, hi = lane >> 5;
    char* V_lds = lds; char* K_lds = lds + 2 * SHM_V;
    float* wsf = (float*)(lds + 2 * SHM_V + 2 * SHM_K) + wid * 64; float* li_l = wsf; float* al_l = wsf + 32;
    float m_reg = -1e30f, l_reg = 0; bf16x8 qr[8];
#pragma unroll
    for (int d = 0; d < 4; ++d) o[d] = f32x16{};
    const bf16_t* Qw = Qb + (long)(wid * 32 + r32) * LDK + hi * 8;
#pragma unroll
    for (int d0 = 0; d0 < 8; ++d0) qr[d0] = *reinterpret_cast<const bf16x8*>(Qw + d0 * 16);
    const int sr = tid >> 4, sc = (tid & 15) * 8, vst0 = v_st(sr, sc), vst1 = v_st(32 + sr, sc);
    const int vb0 = (int)(uintptr_t)V_lds + v_rd_base(lane);
    struct { bf16x8 vs0, vs1, ks0, ks1; } sr_[1];
#define SLOAD(i, k0) do { sr_[i].vs0 = *reinterpret_cast<const bf16x8*>(&Vh[(long)((k0) + sr) * LDK + sc]); sr_[i].vs1 = *reinterpret_cast<const bf16x8*>(&Vh[(long)((k0) + 32 + sr) * LDK + sc]); \
    sr_[i].ks0 = *reinterpret_cast<const bf16x8*>(&Kh[(long)((k0) + sr) * LDK + sc]); sr_[i].ks1 = *reinterpret_cast<const bf16x8*>(&Kh[(long)((k0) + 32 + sr) * LDK + sc]); } while (0)
#define SWRITE(b, i) do { *(bf16x8*)(V_lds + (b) * SHM_V + vst0) = sr_[i].vs0;          \
    *(bf16x8*)(V_lds + (b) * SHM_V + vst1) = sr_[i].vs1; int kc = sc * 2;               \
    *(bf16x8*)(K_lds + (b) * SHM_K + KSWZ(sr, kc)) = sr_[i].ks0;                       \
    *(bf16x8*)(K_lds + (b) * SHM_K + KSWZ(32 + sr, kc)) = sr_[i].ks1; } while (0)
#define SWAIT() asm volatile("s_waitcnt vmcnt(0)" ::: "memory")
#define RESC(a) do { if (__any((a) < 1.f)) { if (hi == 0) al_l[r32] = (a); asm volatile("s_waitcnt lgkmcnt(0)" ::: "memory"); \
    _Pragma("unroll") for (int d = 0; d < 4; ++d) _Pragma("unroll") for (int r = 0; r < 16; ++r) o[d][r] *= al_l[crow(r, hi)]; } } while (0)
    f32x16 pA0, pA1, pB0, pB1; float mnA, mnB, alA, alB; bf16x8 pa0, pa1, pa2, pa3;
    constexpr int SE = 0, SO = 0;
    __syncthreads();
    SLOAD(SE, 0); asm volatile("s_waitcnt vmcnt(0)" ::: "memory"); SWRITE(0, SE); __syncthreads();
    qkt(pA0, pA1, K_lds, qr, r32, hi); partialSM(pA0, pA1, m_reg, mnA, alA, false);
    SLOAD(SO, KVBLK);
    SWAIT(); SWRITE(1, SO); __syncthreads();
    for (int j = 1; j + 1 < NT; j += 2) {
        SBAR(); qkt(pB0, pB1, K_lds + SHM_K, qr, r32, hi);
        finishSM(pA0, pA1, alA, l_reg, pa0, pa1, pa2, pa3); SBAR();
        SLOAD(SO, (j + 1) * KVBLK); SBAR();
        pv_d0(o, vb0, pa0, pa1, pa2, pa3); partialSM(pB0, pB1, m_reg, mnB, alB, j >= ntw);
        __syncthreads(); SWAIT(); SWRITE(0, SE);
        RESC(alB); __syncthreads();
        SBAR(); qkt(pA0, pA1, K_lds, qr, r32, hi);
        finishSM(pB0, pB1, alB, l_reg, pa0, pa1, pa2, pa3); SBAR();
        SLOAD(SE, (j + 2) * KVBLK); SBAR();
        pv_d0(o, vb0 + (int)SHM_V, pa0, pa1, pa2, pa3); partialSM(pA0, pA1, m_reg, mnA, alA, (j + 1) >= ntw);
        __syncthreads(); SWAIT(); SWRITE(1, SO);
        RESC(alA); __syncthreads();
    }
    SBAR(); qkt(pB0, pB1, K_lds + SHM_K, qr, r32, hi);
    finishSM(pA0, pA1, alA, l_reg, pa0, pa1, pa2, pa3); SBAR();
    pv_d0(o, vb0, pa0, pa1, pa2, pa3); partialSM(pB0, pB1, m_reg, mnB, alB, (NT - 1) >= ntw);
    __syncthreads(); RESC(alB);
    finishSM(pB0, pB1, alB, l_reg, pa0, pa1, pa2, pa3); SBAR();
    pv_d0(o, vb0 + (int)SHM_V, pa0, pa1, pa2, pa3);
    if (hi == 0) li_l[r32] = l_reg; asm volatile("s_waitcnt lgkmcnt(0)" ::: "memory");
#pragma unroll
    for (int r = 0; r < 16; ++r) { const float rl = __builtin_amdgcn_rcpf(li_l[crow(r, hi)]);
#pragma unroll
        for (int d = 0; d < 4; ++d) o[d][r] *= rl; }
#undef SLOAD
#undef SWRITE
#undef SWAIT
#undef RESC
}
}

__device__ __forceinline__ void sincos_red(double ang, float& s, float& c) {
    const double k = rint(ang * 0.15915494309189535);
    const float r = (float)(ang - k * 6.283185307179586);
    s = __sinf(r); c = __cosf(r);
}
__device__ __forceinline__ float gelu_tanh(float y) {
    const float z = 0.7978845608028654f * (y + 0.044715f * y * y * y);
    const float th = 1.0f - 2.0f / (1.0f + __expf(2.0f * z));
    return 0.5f * y * (1.0f + th);
}

__device__ __forceinline__ void conv_tile(const float* __restrict__ W, bf16_t* __restrict__ Wt, int K, int N, const float* __restrict__ gain, int glu, int tile, unsigned* ldsw) {
    const int tid = otid();
    const int ntn = N >> 7; const int tk = tile / ntn, tn = tile - tk * ntn; const int k0 = tk << 7, n0 = tn << 7;
    const int kp = tid >> 5, nl = (tid & 31) << 2;
    f32x4 va[4], vb[4];
#pragma unroll
    for (int i = 0; i < 4; ++i) { const int k = 2 * (kp + 16 * i);
        va[i] = *(const f32x4*)(W + (size_t)(k0 + k) * N + n0 + nl); vb[i] = *(const f32x4*)(W + (size_t)(k0 + k + 1) * N + n0 + nl); }
    __syncthreads();
#pragma unroll
    for (int i = 0; i < 4; ++i) { const int kpair = kp + 16 * i; const int k = 2 * kpair;
        const float ga = gain ? gain[k0 + k] : 1.f, gb = gain ? gain[k0 + k + 1] : 1.f;
#pragma unroll
        for (int j = 0; j < 4; ++j) ldsw[(nl + j) * 65 + kpair] = cvt_pk_bf16(va[i][j] * ga, vb[i][j] * gb); }
    __syncthreads();
    int nbase = n0;
    if (glu) { const int bj = n0 >> 11, pn = (n0 & 2047) >> 7; nbase = 256 * pn + 128 * bj; }
#pragma unroll
    for (int i = 0; i < 4; ++i) { const int n = (tid >> 4) + 32 * i, k8 = tid & 15;
        u32x4 w; w.x = ldsw[n * 65 + k8 * 4 + 0]; w.y = ldsw[n * 65 + k8 * 4 + 1]; w.z = ldsw[n * 65 + k8 * 4 + 2]; w.w = ldsw[n * 65 + k8 * 4 + 3];
        *(u32x4*)(Wt + (size_t)(nbase + n) * K + k0 + k8 * 8) = w; }
}

__device__ __forceinline__ void prep_phase(const Params& p, unsigned char* shm) {
    const int tid = otid(), bid = obid(), G = gridDim.x;
    unsigned char* ws = p.ws;
    for (int t = bid; t < 12800; t += G) {
        const float* W; bf16_t* Wt; int K, N, glu = 0; const float* gain = nullptr; int tile;
        if (t < 1536) { const int j = t / 768; tile = t - j * 768; W = p.a_w_in + (size_t)j * 2048 * 6144; Wt = (bf16_t*)(ws + OFF_WT_A_IN + j * SZ_A_IN); K = 2048; N = 6144; gain = p.norm_mix + (size_t)(3 * j) * D_; }
        else if (t < 2048) { const int u = t - 1536; const int j = u / 256; tile = u - j * 256; W = p.a_w_out + (size_t)j * 2048 * 2048; Wt = (bf16_t*)(ws + OFF_WT_A_OUT + j * SZ_A_OUT); K = 2048; N = 2048; }
        else if (t < 2560) { tile = t - 2048; W = p.b_w_glu; Wt = (bf16_t*)(ws + OFF_WT_GLU); K = 2048; N = 4096; glu = 1; }
        else if (t < 4096) { tile = t - 2560; W = p.c_w_in; Wt = (bf16_t*)(ws + OFF_WT_C_IN); K = 2048; N = 12288; gain = p.norm_mix + 2 * D_; }
        else if (t < 4608) { tile = t - 4096; W = p.c_w_out; Wt = (bf16_t*)(ws + OFF_WT_C_OUT); K = 4096; N = 2048; }
        else if (t < 8704) { const int u = t - 4608; const int i = u / 1024; tile = u - i * 1024; W = p.mlp_w1 + (size_t)i * 2048 * 8192; Wt = (bf16_t*)(ws + OFF_WT_W1 + i * SZ_W1); K = 2048; N = 8192; gain = p.norm_mlp + (size_t)i * D_; }
        else { const int u = t - 8704; const int i = u / 1024; tile = u - i * 1024; W = p.mlp_w2 + (size_t)i * 8192 * 2048; Wt = (bf16_t*)(ws + OFF_WT_W2 + i * SZ_W1); K = 8192; N = 2048; }
        conv_tile(W, Wt, K, N, gain, glu, tile, (unsigned*)shm);
    }
    {
        float* ss = (float*)(ws + OFF_SSP); bf16_t* xb = (bf16_t*)(ws + OFF_XB);
        const int wid = tid >> 6, lane = tid & 63;
        for (int row = bid * 8 + wid; row < T_; row += G * 8) {
            const float* xr = p.x + (size_t)row * D_; float sq = 0.f;
#pragma unroll
            for (int i = 0; i < 8; ++i) { const f32x4 v = *(const f32x4*)(xr + (i * 64 + lane) * 4);
                sq += v[0] * v[0] + v[1] * v[1] + v[2] * v[2] + v[3] * v[3];
                u32x2 w; w.x = cvt_pk_bf16(v[0], v[1]); w.y = cvt_pk_bf16(v[2], v[3]);
                *(u32x2*)(xb + (size_t)row * D_ + (i * 64 + lane) * 4) = w; }
#pragma unroll
            for (int o = 32; o > 0; o >>= 1) sq += __shfl_xor(sq, o);
            if (lane < 32) ss[(size_t)lane * T_ + row] = (lane == 0) ? sq : 0.f;
        }
        for (int i = bid * 512 + tid; i < 32 * T_; i += G * 512) ss[(size_t)3 * 32 * T_ + i] = 0.f;
        float* rssq = (float*)(ws + OFF_RSQP);
        for (int i = bid * 512 + tid; i < 64 * T_; i += G * 512) rssq[i] = 0.f;
    }
    {
        f32x2* rot = (f32x2*)(ws + OFF_ROT);
        for (int i = bid * 512 + tid; i < 4096 * 128; i += G * 512) {
            const int pos = i >> 7, j = i & 127;
            const double inv = exp(-9.210340371976184 * ((double)j / 127.0));
            float s, c; sincos_red((double)pos * inv, s, c);
            f32x2 v; v.x = c; v.y = s; rot[i] = v;
        }
    }
    {
        bf16_t* Bm = (bf16_t*)(ws + OFF_S5B); bf16_t* Cm = (bf16_t*)(ws + OFF_S5C); f32x2* AB = (f32x2*)(ws + OFF_S5AB);
        const float* gmix = p.norm_mix + 1 * D_;
        for (int i = bid * 512 + tid; i < 128 * 64; i += G * 512) {
            const int g = i >> 6, pp = i & 63;
            const float lre = p.b_a_re[i], lim = p.b_a_im[i];
            const float dt = __expf(p.b_log_dt[g]);
            const float mag = __expf(lre * dt);
            float sn, cs; sincos_red((double)lim * (double)dt, sn, cs);
            const float abr = mag * cs, abi = mag * sn;
            const float den = lre * lre + lim * lim;
            const float nr = abr - 1.0f, ni = abi;
            const float cr_ = (nr * lre + ni * lim) / den, ci_ = (ni * lre - nr * lim) / den;
            f32x2 ab; ab.x = abr; ab.y = abi; AB[i] = ab;
#pragma unroll
            for (int c = 0; c < 16; ++c) {
                const float br = p.b_b_re[(size_t)i * 16 + c], bi = p.b_b_im[(size_t)i * 16 + c];
                const float gm = gmix[g * 16 + c];
                Bm[((size_t)g * 128 + pp) * 16 + c] = f2bf((cr_ * br - ci_ * bi) * gm);
                Bm[((size_t)g * 128 + 64 + pp) * 16 + c] = f2bf((cr_ * bi + ci_ * br) * gm);
                Cm[((size_t)g * 16 + c) * 128 + pp] = f2bf(p.b_c_re[((size_t)g * 16 + c) * 64 + pp]);
                Cm[((size_t)g * 16 + c) * 128 + 64 + pp] = f2bf(-p.b_c_im[((size_t)g * 16 + c) * 64 + pp]);
            }
        }
    }
}

__device__ __forceinline__ void attn_phase(const Params& p, int j, float lambda_init, unsigned char* shm) {
    const int tid = otid(), wid = tid >> 6, lane = tid & 63, r32 = lane & 31, hi = lane >> 5;
    const bf16_t* qkv = (const bf16_t*)(p.ws + OFF_BIG);
    bf16_t* oa = (bf16_t*)(p.ws + OFF_OA);
    float* scr = (float*)(p.ws + OFF_ATT_SCR) + (size_t)obid() * 2 * 32768;
    float lam;
    { const float* lp = p.a_lambda + (size_t)j * 512;
      float a = lp[lane] * lp[128 + lane] + lp[64 + lane] * lp[192 + lane];
      float b = lp[256 + lane] * lp[384 + lane] + lp[320 + lane] * lp[448 + lane];
#pragma unroll
      for (int o = 32; o > 0; o >>= 1) { a += __shfl_xor(a, o); b += __shfl_xor(b, o); }
      lam = __expf(a) - __expf(b) + lambda_init; }
    const float* sub = p.a_subln + (size_t)j * 256;
    const int c = obid(); const int xcd = c & 7, jj = c >> 3;
    const int bh = xcd * 4 + (jj >> 3), pi = jj & 7;
    const int b = bh >> 3, h = bh & 7;
#pragma unroll 1
    for (int it = 0; it < 2; ++it) {
        const int qb = it == 0 ? (15 - pi) : pi;
        const int NT = 4 * qb + 4, ntw = 4 * qb + (wid >> 1) + 1;
        const size_t tok0 = (size_t)b * S_ + (size_t)qb * 256;
        f32x16 o[4];
#pragma unroll 1
        for (int ps = 0; ps < 4; ++ps) {
            const int e = ps >> 1, t = ps & 1;
            float* sc = scr + e * 32768;
            att::attn_body(qkv + tok0 * 6144 + h * 256 + t * 128, qkv + (size_t)b * S_ * 6144 + 2048 + h * 256 + t * 128,
                           qkv + (size_t)b * S_ * 6144 + 4096 + h * 256 + e * 128, NT, ntw, (char*)shm, o);
            if (t == 0) {
#pragma unroll
                for (int d = 0; d < 4; ++d)
#pragma unroll
                    for (int r = 0; r < 16; ++r) sc[tid * 64 + d * 16 + r] = o[d][r];
            } else {
#pragma unroll
                for (int d = 0; d < 4; ++d)
#pragma unroll
                    for (int r = 0; r < 16; ++r) { const float cv = sc[tid * 64 + d * 16 + r] - lam * o[d][r]; o[d][r] = cv; if (e == 0) sc[tid * 64 + d * 16 + r] = cv; }
            }
        }
        float ssq[16];
#pragma unroll
        for (int r = 0; r < 16; ++r) { float s = 0.f;
#pragma unroll
            for (int d = 0; d < 4; ++d) { const float c0 = scr[tid * 64 + d * 16 + r]; s += c0 * c0 + o[d][r] * o[d][r]; }
#pragma unroll
            for (int of = 16; of > 0; of >>= 1) s += __shfl_xor(s, of);
            ssq[r] = rsqrtf(s * (1.0f / 256.0f) + EPS_) * (1.0f - lambda_init); }
#pragma unroll
        for (int r = 0; r < 16; ++r) {
            const size_t row = tok0 + wid * 32 + att::crow(r, hi);
            bf16_t* op = oa + row * D_ + h * 256;
#pragma unroll
            for (int d = 0; d < 4; ++d) {
                const int col = d * 32 + r32;
                op[col] = f2bf(scr[tid * 64 + d * 16 + r] * ssq[r] * sub[col]);
                op[128 + col] = f2bf(o[d][r] * ssq[r] * sub[128 + col]);
            }
        }
    }
}

template <bool FINAL>
__device__ __forceinline__ void s5_phase(const Params& p, unsigned char* shm) {
    const int tid = otid(), wid = tid >> 6, lane = tid & 63, r32 = lane & 31, hi = lane >> 5, fr = lane & 15, fq = lane >> 4;
    const bf16_t* xb = (const bf16_t*)(p.ws + OFF_XB);
    const float* ss = (const float*)(p.ws + OFF_SSP) + (size_t)2 * 32 * T_;
    float* rsfin = (float*)(p.ws + OFF_RSFIN);
    const bf16_t* Bm = (const bf16_t*)(p.ws + OFF_S5B); const bf16_t* Cm = (const bf16_t*)(p.ws + OFF_S5C); const f32x2* AB = (const f32x2*)(p.ws + OFF_S5AB);
    f32x2* E = (f32x2*)(p.ws + OFF_BIG);
    bf16_t* gl = (bf16_t*)(p.ws + OFF_OA);
    bf16_t* Xs = (bf16_t*)shm + wid * (32 * 136);
    const float* gmix = p.norm_mix + D_; const float* dsk = p.b_d;
    for (int it = obid(); it < 4096; it += gridDim.x) {
        const int goct = it & 15, chunk = (it >> 4) & 63, b = it >> 10;
        const int g = goct * 8 + wid; const int pp = r32 + 32 * hi;
        const size_t t0 = (size_t)b * S_ + chunk * 64;
        const f32x2 ab = AB[g * 64 + pp];
        bf16x8 bfr[4];
#pragma unroll
        for (int nb = 0; nb < 4; ++nb) bfr[nb] = *(const bf16x8*)(Bm + ((size_t)g * 128 + nb * 32 + r32) * 16 + hi * 8);
        float xr = 0.f, xi = 0.f;
        bf16x8 cfr[4]; float gm4[4], ds4[4];
        if (FINAL) {
            float pr = ab.x, pi_ = ab.y;
#pragma unroll
            for (int s = 0; s < 6; ++s) { const float nr = pr * pr - pi_ * pi_, ni = 2.f * pr * pi_; pr = nr; pi_ = ni; }
            const f32x2* Ep = E + ((size_t)(b * 128 + g) * 64) * 64 + pp;
            for (int c2 = 0; c2 < chunk; ++c2) { const f32x2 e = Ep[(size_t)c2 * 64];
                const float nr = pr * xr - pi_ * xi + e.x, ni = pr * xi + pi_ * xr + e.y; xr = nr; xi = ni; }
#pragma unroll
            for (int ks = 0; ks < 4; ++ks) cfr[ks] = *(const bf16x8*)(Cm + ((size_t)g * 16 + fr) * 128 + ks * 32 + fq * 8);
#pragma unroll
            for (int jx = 0; jx < 4; ++jx) { gm4[jx] = gmix[g * 16 + 4 * fq + jx]; ds4[jx] = dsk[g * 16 + 4 * fq + jx]; }
        }
#pragma unroll
        for (int half = 0; half < 2; ++half) {
            const size_t trow = t0 + half * 32 + r32;
            float rs;
            if (FINAL) rs = rsfin[trow];
            else { float ssum = 0.f;
#pragma unroll 8
                for (int sl = 0; sl < 32; ++sl) ssum += ss[(size_t)sl * T_ + trow];
                rs = rsqrtf(ssum * (1.0f / D_) + EPS_); if (goct == 0 && hi == 0 && wid == 0) rsfin[trow] = rs; }
            const u32x4 raw = *(const u32x4*)(xb + trow * D_ + g * 16 + hi * 8);
            u32x4 sc4;
            sc4.x = cvt_pk_bf16(bflo(raw.x) * rs, bfhi(raw.x) * rs); sc4.y = cvt_pk_bf16(bflo(raw.y) * rs, bfhi(raw.y) * rs);
            sc4.z = cvt_pk_bf16(bflo(raw.z) * rs, bfhi(raw.z) * rs); sc4.w = cvt_pk_bf16(bflo(raw.w) * rs, bfhi(raw.w) * rs);
            const bf16x8 afr = *reinterpret_cast<const bf16x8*>(&sc4);
            f32x16 c0 = __builtin_amdgcn_mfma_f32_32x32x16_bf16(afr, bfr[0], f32x16{}, 0, 0, 0);
            f32x16 c1 = __builtin_amdgcn_mfma_f32_32x32x16_bf16(afr, bfr[1], f32x16{}, 0, 0, 0);
            f32x16 c2 = __builtin_amdgcn_mfma_f32_32x32x16_bf16(afr, bfr[2], f32x16{}, 0, 0, 0);
            f32x16 c3 = __builtin_amdgcn_mfma_f32_32x32x16_bf16(afr, bfr[3], f32x16{}, 0, 0, 0);
#pragma unroll
            for (int i = 0; i < 16; ++i) {
                auto r0 = __builtin_amdgcn_permlane32_swap(__float_as_uint(c0[i]), __float_as_uint(c1[i]), false, false);
                c0[i] = __uint_as_float(r0[0]); c1[i] = __uint_as_float(r0[1]);
                auto r1 = __builtin_amdgcn_permlane32_swap(__float_as_uint(c2[i]), __float_as_uint(c3[i]), false, false);
                c2[i] = __uint_as_float(r1[0]); c3[i] = __uint_as_float(r1[1]);
            }
#pragma unroll
            for (int t = 0; t < 32; ++t) {
                const int q = t >> 3, s = t & 7, idx = 4 * q + (s & 3);
                const float bur = (s < 4) ? c0[idx] : c1[idx], bui = (s < 4) ? c2[idx] : c3[idx];
                const float nr = ab.x * xr - ab.y * xi + bur, ni = ab.x * xi + ab.y * xr + bui;
                xr = nr; xi = ni;
                if (FINAL) { Xs[t * 136 + pp] = f2bf(xr); Xs[t * 136 + 64 + pp] = f2bf(xi); }
            }
            if (FINAL) {
                asm volatile("s_waitcnt lgkmcnt(0)" ::: "memory");
#pragma unroll
                for (int m = 0; m < 2; ++m) {
                    f32x4 acc = {0.f, 0.f, 0.f, 0.f};
#pragma unroll
                    for (int ks = 0; ks < 4; ++ks) {
                        const bf16x8 xf = *(const bf16x8*)(Xs + (m * 16 + fr) * 136 + ks * 32 + fq * 8);
                        acc = __builtin_amdgcn_mfma_f32_16x16x32_bf16(cfr[ks], xf, acc, 0, 0, 0);
                    }
                    const size_t tr2 = t0 + half * 32 + m * 16 + fr;
                    const float rs2 = rsfin[tr2];
                    const u32x2 hx = *(const u32x2*)(xb + tr2 * D_ + g * 16 + 4 * fq);
                    const float h0 = bflo(hx.x) * rs2 * gm4[0], h1 = bfhi(hx.x) * rs2 * gm4[1], h2 = bflo(hx.y) * rs2 * gm4[2], h3 = bfhi(hx.y) * rs2 * gm4[3];
                    const float y0 = gelu_tanh(acc[0] + ds4[0] * h0), y1 = gelu_tanh(acc[1] + ds4[1] * h1), y2 = gelu_tanh(acc[2] + ds4[2] * h2), y3 = gelu_tanh(acc[3] + ds4[3] * h3);
                    u32x2 w; w.x = cvt_pk_bf16(y0, y1); w.y = cvt_pk_bf16(y2, y3);
                    *(u32x2*)(gl + tr2 * D_ + g * 16 + 4 * fq) = w;
                }
                asm volatile("s_waitcnt lgkmcnt(0)" ::: "memory");
            }
        }
        if (!FINAL) { f32x2 e; e.x = xr; e.y = xi; E[((size_t)(b * 128 + g) * 64 + chunk) * 64 + pp] = e; }
    }
}

__device__ __forceinline__ void ret_phase(const Params& p, unsigned char* shm, float* rssq) {
    const int tid = otid(), wid = tid >> 6, lane = tid & 63, fr = lane & 15, fq = lane >> 4;
    const bf16_t* ret = (const bf16_t*)(p.ws + OFF_BIG);
    bf16_t* ao = (bf16_t*)(p.ws + OFF_OA);
    constexpr int QS = 264, TS = 72;
    bf16_t* Qs = (bf16_t*)shm; bf16_t* Ks = Qs + 64 * QS; bf16_t* KTs = Ks + 64 * QS; bf16_t* VTs = KTs + 256 * TS; bf16_t* Ss = VTs + 64 * TS; bf16_t* RTs = Ss + 64 * TS;
    const int c = obid(); const int xcd = c & 7, jj = c >> 3;
    const int bh = xcd * 4 + (jj >> 3), sl = jj & 7;
    const int b = bh >> 3, h = bh & 7;
    const float lg = logf(1.0f - exp2f(-5.0f - (float)h));
    const float cdec = __expf(lg * 64.0f);
    const float kdec = __expf(lg * (float)(63 - lane));
    const int mi = wid >> 1, ni0 = 2 * (wid & 1);
    const float qdec = __expf(lg * (float)(16 * mi + fr + 1));
    float idec[2][4];
#pragma unroll
    for (int t = 0; t < 2; ++t)
#pragma unroll
        for (int j = 0; j < 4; ++j) { const int n = 16 * mi + fr, m = 16 * (ni0 + t) + 4 * fq + j; idec[t][j] = __expf(lg * fabsf((float)(n - m))); }
    f32x4 R[4][2];
#pragma unroll
    for (int a = 0; a < 4; ++a)
#pragma unroll
        for (int d = 0; d < 2; ++d) R[a][d] = (f32x4){0.f, 0.f, 0.f, 0.f};
    const size_t tokb = (size_t)b * S_;
    const bf16_t* qsrc = ret + (tokb + lane) * 12288 + h * 256 + wid * 32;
    const bf16_t* ksrc = qsrc + 2048;
    const bf16_t* vsrc = ret + (tokb + lane) * 12288 + 4096 + h * 512 + sl * 64 + wid * 8;
    u32x4 pq[4], pk[4], pv;
#pragma unroll
    for (int j = 0; j < 4; ++j) { pq[j] = *(const u32x4*)(qsrc + j * 8); pk[j] = *(const u32x4*)(ksrc + j * 8); }
    pv = *(const u32x4*)vsrc;
    for (int ch = 0; ch < 64; ++ch) {
        __syncthreads();
#pragma unroll
        for (int j = 0; j < 4; ++j) {
            *(u32x4*)(Qs + lane * QS + wid * 32 + j * 8) = pq[j];
            *(u32x4*)(Ks + lane * QS + wid * 32 + j * 8) = pk[j];
            const unsigned kw[4] = {pk[j].x, pk[j].y, pk[j].z, pk[j].w};
#pragma unroll
            for (int i = 0; i < 4; ++i) {
                KTs[(wid * 32 + j * 8 + 2 * i) * TS + lane] = f2bf(bflo(kw[i]) * kdec);
                KTs[(wid * 32 + j * 8 + 2 * i + 1) * TS + lane] = f2bf(bfhi(kw[i]) * kdec);
            }
        }
        { const unsigned vw[4] = {pv.x, pv.y, pv.z, pv.w};
#pragma unroll
          for (int i = 0; i < 4; ++i) { VTs[(wid * 8 + 2 * i) * TS + lane] = (bf16_t)(vw[i] & 0xffffu); VTs[(wid * 8 + 2 * i + 1) * TS + lane] = (bf16_t)(vw[i] >> 16); } }
#pragma unroll
        for (int ei = 0; ei < 4; ++ei)
#pragma unroll
            for (int di = 0; di < 2; ++di) { u32x2 w; w.x = cvt_pk_bf16(R[ei][di][0], R[ei][di][1]); w.y = cvt_pk_bf16(R[ei][di][2], R[ei][di][3]);
                *(u32x2*)(RTs + (16 * ei + fr) * QS + wid * 32 + 16 * di + 4 * fq) = w; }
        if (ch + 1 < 64) {
            const size_t adv = (size_t)(ch + 1) * 64 * 12288;
#pragma unroll
            for (int j = 0; j < 4; ++j) { pq[j] = *(const u32x4*)(qsrc + adv + j * 8); pk[j] = *(const u32x4*)(ksrc + adv + j * 8); }
            pv = *(const u32x4*)(vsrc + adv);
        }
        __syncthreads();
        {
            f32x4 sacc[2] = {{0.f, 0.f, 0.f, 0.f}, {0.f, 0.f, 0.f, 0.f}};
#pragma unroll
            for (int ks = 0; ks < 8; ++ks) {
                const bf16x8 af = *(const bf16x8*)(Qs + (16 * mi + fr) * QS + ks * 32 + fq * 8);
#pragma unroll
                for (int t = 0; t < 2; ++t) { const bf16x8 bf = *(const bf16x8*)(Ks + (16 * (ni0 + t) + fr) * QS + ks * 32 + fq * 8);
                    sacc[t] = __builtin_amdgcn_mfma_f32_16x16x32_bf16(bf, af, sacc[t], 0, 0, 0); }
            }
#pragma unroll
            for (int t = 0; t < 2; ++t) { u32x2 w; w.x = cvt_pk_bf16(sacc[t][0] * idec[t][0], sacc[t][1] * idec[t][1]); w.y = cvt_pk_bf16(sacc[t][2] * idec[t][2], sacc[t][3] * idec[t][3]);
                *(u32x2*)(Ss + (16 * mi + fr) * TS + 16 * (ni0 + t) + 4 * fq) = w; }
        }
        __syncthreads();
        {
            f32x4 oi[2] = {{0.f, 0.f, 0.f, 0.f}, {0.f, 0.f, 0.f, 0.f}}, oc[2] = {{0.f, 0.f, 0.f, 0.f}, {0.f, 0.f, 0.f, 0.f}};
#pragma unroll
            for (int ks = 0; ks < 2; ++ks) {
                const bf16x8 af = *(const bf16x8*)(Ss + (16 * mi + fr) * TS + ks * 32 + fq * 8);
#pragma unroll
                for (int t = 0; t < 2; ++t) { const bf16x8 bf = *(const bf16x8*)(VTs + (16 * (ni0 + t) + fr) * TS + ks * 32 + fq * 8);
                    oi[t] = __builtin_amdgcn_mfma_f32_16x16x32_bf16(bf, af, oi[t], 0, 0, 0); }
            }
#pragma unroll
            for (int ks = 0; ks < 8; ++ks) {
                const bf16x8 af = *(const bf16x8*)(Qs + (16 * mi + fr) * QS + ks * 32 + fq * 8);
#pragma unroll
                for (int t = 0; t < 2; ++t) { const bf16x8 bf = *(const bf16x8*)(RTs + (16 * (ni0 + t) + fr) * QS + ks * 32 + fq * 8);
                    oc[t] = __builtin_amdgcn_mfma_f32_16x16x32_bf16(bf, af, oc[t], 0, 0, 0); }
            }
            const size_t tok = tokb + (size_t)ch * 64 + 16 * mi + fr;
            float sq = 0.f;
#pragma unroll
            for (int t = 0; t < 2; ++t) {
                const int e = sl * 64 + 16 * (ni0 + t) + 4 * fq;
                const u32x2 gw = *(const u32x2*)(ret + tok * 12288 + 8192 + h * 512 + e);
                f32x4 ov = oi[t] + oc[t] * qdec;
                sq += ov[0] * ov[0] + ov[1] * ov[1] + ov[2] * ov[2] + ov[3] * ov[3];
                u32x2 w; w.x = cvt_pk_bf16(ov[0] * bflo(gw.x), ov[1] * bfhi(gw.x)); w.y = cvt_pk_bf16(ov[2] * bflo(gw.y), ov[3] * bfhi(gw.y));
                *(u32x2*)(ao + tok * 4096 + h * 512 + e) = w;
            }
            sq += __shfl_xor(sq, 16); sq += __shfl_xor(sq, 32);
            if (fq == 0) atomicAdd(rssq + (size_t)(sl * 4 + mi) * 0 + (size_t)sl * (T_ * 8) + tok * 8 + h, sq);
        }
#pragma unroll
        for (int ei = 0; ei < 4; ++ei)
#pragma unroll
            for (int di = 0; di < 2; ++di) R[ei][di] *= cdec;
#pragma unroll
        for (int ks = 0; ks < 2; ++ks) {
            bf16x8 bfk[2];
#pragma unroll
            for (int di = 0; di < 2; ++di) bfk[di] = *(const bf16x8*)(KTs + (wid * 32 + 16 * di + fr) * TS + ks * 32 + fq * 8);
#pragma unroll
            for (int ei = 0; ei < 4; ++ei) { const bf16x8 af = *(const bf16x8*)(VTs + (16 * ei + fr) * TS + ks * 32 + fq * 8);
#pragma unroll
                for (int di = 0; di < 2; ++di) R[ei][di] = __builtin_amdgcn_mfma_f32_16x16x32_bf16(bfk[di], af, R[ei][di], 0, 0, 0); }
        }
    }
}

__device__ __forceinline__ void ret2_phase(const Params& p) {
    bf16_t* ao = (bf16_t*)(p.ws + OFF_OA); const float* rssq = (const float*)(p.ws + OFF_RSQP);
    const size_t nvec = (size_t)T_ * 4096 / 8;
    for (size_t i = (size_t)obid() * 512 + otid(); i < nvec; i += (size_t)gridDim.x * 512) {
        const size_t t = i >> 9; const int hh = (int)((i & 511) >> 6);
        float rsum = 0.f;
#pragma unroll
        for (int sl = 0; sl < 8; ++sl) rsum += rssq[(size_t)sl * (T_ * 8) + t * 8 + hh];
        const float rs = rsqrtf(rsum * (1.0f / 512.0f) + EPS_);
        u32x4 w = *(u32x4*)(ao + i * 8);
        w.x = cvt_pk_bf16(bflo(w.x) * rs, bfhi(w.x) * rs); w.y = cvt_pk_bf16(bflo(w.y) * rs, bfhi(w.y) * rs);
        w.z = cvt_pk_bf16(bflo(w.z) * rs, bfhi(w.z) * rs); w.w = cvt_pk_bf16(bflo(w.w) * rs, bfhi(w.w) * rs);
        *(u32x4*)(ao + i * 8) = w;
    }
}

__device__ __forceinline__ void final_phase(const Params& p) {
    const float* ss = (const float*)(p.ws + OFF_SSP) + (size_t)8 * 32 * T_;
    const int tid = otid();
    const f32x4 g = *(const f32x4*)(p.norm_final + tid * 4);
    for (int row = obid(); row < T_; row += gridDim.x) {
        float ssum = ss[(size_t)(tid & 31) * T_ + row];
#pragma unroll
        for (int o = 16; o > 0; o >>= 1) ssum += __shfl_xor(ssum, o);
        const float rs = rsqrtf(ssum * (1.0f / D_) + EPS_);
        f32x4 v = *(f32x4*)(p.out + (size_t)row * D_ + tid * 4);
        v = v * rs * g;
        *(f32x4*)(p.out + (size_t)row * D_ + tid * 4) = v;
    }
}

enum { OP_PREP = 0, OP_A_IN, OP_ATTN, OP_A_OUT, OP_S5A, OP_S5C, OP_GLU, OP_C_IN, OP_RET, OP_RET2, OP_C_OUT, OP_W1, OP_W2, OP_FINAL };
#ifndef PHMASK
#define PHMASK 0xffff
#endif
#define PHON(b) ((PHMASK >> (b)) & 1)
constexpr int NPH = 23;
__device__ const unsigned char PROG_OP[NPH] = { OP_PREP,
    OP_A_IN, OP_ATTN, OP_A_OUT, OP_W1, OP_W2,
    OP_S5A, OP_S5C, OP_GLU, OP_W1, OP_W2,
    OP_C_IN, OP_RET, OP_RET2, OP_C_OUT, OP_W1, OP_W2,
    OP_A_IN, OP_ATTN, OP_A_OUT, OP_W1, OP_W2,
    OP_FINAL };
__device__ const unsigned char PROG_LAYER[NPH] = { 0, 0, 0, 0, 0, 0, 1, 1, 1, 1, 1, 2, 2, 2, 2, 2, 2, 3, 3, 3, 3, 3, 3 };

struct GemmDesc { unsigned long long a_off, b_off; int N, K, ss_idx, mode; };
#define GD_NONE {0, 0, 0, 0, 0, 0}
#define GD_A_IN(L)  {OFF_XB, OFF_WT_A_IN + (L / 3) * SZ_A_IN, 6144, 2048, 2 * L, 0}
#define GD_A_OUT(L) {OFF_OA, OFF_WT_A_OUT + (L / 3) * SZ_A_OUT, 2048, 2048, 2 * L + 1, 0}
#define GD_W1(L)    {OFF_XB, OFF_WT_W1 + L * SZ_W1, 8192, 2048, 2 * L + 1, 1}
#define GD_W2(L)    {OFF_BIG, OFF_WT_W2 + L * SZ_W1, 2048, 8192, 2 * L + 2, 0}
#define GD_GLU(L)   {OFF_OA, OFF_WT_GLU, 4096, 2048, 2 * L + 1, 1}
#define GD_C_IN(L)  {OFF_XB, OFF_WT_C_IN, 12288, 2048, 2 * L, 2}
#define GD_C_OUT(L) {OFF_OA, OFF_WT_C_OUT, 2048, 4096, 2 * L + 1, 0}
__device__ const GemmDesc GD[NPH] = { GD_NONE,
    GD_A_IN(0ull), GD_NONE, GD_A_OUT(0ull), GD_W1(0ull), GD_W2(0ull),
    GD_NONE, GD_NONE, GD_GLU(1ull), GD_W1(1ull), GD_W2(1ull),
    GD_C_IN(2ull), GD_NONE, GD_NONE, GD_C_OUT(2ull), GD_W1(2ull), GD_W2(2ull),
    GD_A_IN(3ull), GD_NONE, GD_A_OUT(3ull), GD_W1(3ull), GD_W2(3ull),
    GD_NONE };

__device__ __forceinline__ void gsync(cg::grid_group& grid, unsigned* ctr, unsigned& epoch) {
    __builtin_amdgcn_fence(__ATOMIC_RELEASE, "agent");
    asm volatile("s_waitcnt vmcnt(0) lgkmcnt(0)" ::: "memory");
    grid.sync();
    epoch += gridDim.x;
    if (threadIdx.x == 0) {
        __hip_atomic_fetch_add(ctr, 1u, __ATOMIC_RELAXED, __HIP_MEMORY_SCOPE_AGENT);
        while (__hip_atomic_load(ctr, __ATOMIC_RELAXED, __HIP_MEMORY_SCOPE_AGENT) < epoch) __builtin_amdgcn_s_sleep(2);
    }
    __syncthreads();
    __builtin_amdgcn_fence(__ATOMIC_ACQUIRE, "agent");
    asm volatile("s_waitcnt vmcnt(0) lgkmcnt(0)" ::: "memory");
}

__global__ void __launch_bounds__(512, 2) fwd_megakernel(Params p, int ph_lo, int ph_hi) {
    extern __shared__ __attribute__((aligned(16))) unsigned char shm[];
    cg::grid_group grid = cg::this_grid();
    unsigned* bar = (unsigned*)(p.ws + OFF_BAR); unsigned epoch = 0;
#ifndef DUPMASK
#define DUPMASK 0
#endif
    if (PHON(0) && ph_lo == 0) {
#pragma unroll 1
        for (int rp_ = 0; rp_ < ((DUPMASK & 1) ? 2 : 1); ++rp_) { prep_phase(p, shm); if (ph_hi > 1) gsync(grid, bar, epoch); } }
    for (int ph = (ph_lo < 1 ? 1 : ph_lo); ph < ph_hi; ++ph) {
        const int op = PROG_OP[ph], L = PROG_LAYER[ph];
        const int nrep_ = ((DUPMASK >> op) & 1) ? 2 : 1;
#pragma unroll 1
        for (int rp_ = 0; rp_ < nrep_; ++rp_) {
        unsigned char* ws = p.ws; asm volatile("" : "+s"(ws));
        float* ssb = (float*)(ws + OFF_SSP);
        if (PHON(1) && (op == OP_A_IN || op == OP_C_IN || op == OP_W1)) {
            const GemmDesc gd = GD[ph];
            pg8::Gemm g; g.A = (const bf16_t*)(ws + gd.a_off); g.Bt = (const bf16_t*)(ws + gd.b_off); g.M = T_; g.N = gd.N; g.K = gd.K;
            pg8::EpiBf E; E.rot = (const f32x2*)(ws + OFF_ROT); E.O = (bf16_t*)(ws + OFF_BIG); E.ldc = gd.N; E.mode = gd.mode; E.ss = ssb + (size_t)gd.ss_idx * 32 * T_;
            pg8::StaticOrder S; S.init(g.M, g.N, (int)gridDim.x, obid());
            pg8::gemm_phase<pg8::EpiBf, pg8::StaticOrder>((LAS unsigned char*)shm, g, S, E);
        } else if (PHON(2) && (op == OP_A_OUT || op == OP_GLU || op == OP_C_OUT || op == OP_W2)) {
            const GemmDesc gd = GD[ph];
            pg8::Gemm g; g.A = (const bf16_t*)(ws + gd.a_off); g.Bt = (const bf16_t*)(ws + gd.b_off); g.M = T_; g.N = gd.N; g.K = gd.K;
            pg8::EpiRes E; E.xout = p.out; E.xb = (bf16_t*)(ws + OFF_XB); E.glu = gd.mode; E.xin = (ph == 3) ? p.x : (const float*)p.out; E.ssn = ssb + (size_t)gd.ss_idx * 32 * T_;
            pg8::StaticOrder S; S.init(g.M, g.N, (int)gridDim.x, obid());
            pg8::gemm_phase<pg8::EpiRes, pg8::StaticOrder>((LAS unsigned char*)shm, g, S, E);
        } else if (PHON(3) && op == OP_ATTN) {
            const float li = 0.8f - 0.6f * expf(-0.3f * (float)L);
            attn_phase(p, L / 3, li, shm);
        } else if (PHON(4) && op == OP_S5A) {
            s5_phase<false>(p, shm);
        } else if (PHON(5) && op == OP_S5C) {
            s5_phase<true>(p, shm);
        } else if (PHON(6) && op == OP_RET) {
            ret_phase(p, shm, (float*)(ws + (rp_ == 0 ? OFF_RSQP : OFF_XB)));
        } else if (PHON(7) && op == OP_RET2) {
            ret2_phase(p);
        } else if (PHON(8) && op == OP_FINAL) {
            final_phase(p);
        }
        if (ph + 1 < ph_hi || rp_ + 1 < nrep_) gsync(grid, bar, epoch);
        }
    }
}

extern "C" void kernel_launch(void* const* d_in, const int* in_sizes, int n_in, void* d_out, int out_size, void* d_ws, size_t ws_size, hipStream_t stream) {
    static int grid_blocks = 0;
    if (grid_blocks == 0) {
        if (n_in != 21 || out_size != T_ * D_ || ws_size < WS_NEED) { fprintf(stderr, "kernel_launch: unexpected shapes n_in %d out %d ws %zu (need %zu)\n", n_in, out_size, ws_size, (size_t)WS_NEED); grid_blocks = -1; return; }
        int dev = 0, cus = 0, per_cu = 0;
        hipGetDevice(&dev);
        hipDeviceGetAttribute(&cus, hipDeviceAttributeMultiprocessorCount, dev);
        if (hipFuncSetAttribute((const void*)fwd_megakernel, hipFuncAttributeMaxDynamicSharedMemorySize, LDS_BYTES) != hipSuccess) { fprintf(stderr, "kernel_launch: hipFuncSetAttribute failed\n"); grid_blocks = -1; return; }
        hipOccupancyMaxActiveBlocksPerMultiprocessor(&per_cu, (const void*)fwd_megakernel, 512, LDS_BYTES);
        (void)hipGetLastError();
        if (per_cu < 1) per_cu = 1;
        grid_blocks = cus * 1;
        if (grid_blocks != 256) fprintf(stderr, "kernel_launch: note: %d CUs (kernel tuned for 256)\n", cus);
    }
    if (grid_blocks < 0) return;
    (void)hipMemsetAsync((unsigned char*)d_ws + OFF_BAR, 0, 256, stream);
    Params p{};
    const float** pp = (const float**)&p;
    for (int i = 0; i < 21; ++i) pp[i] = (const float*)d_in[i];
    p.out = (float*)d_out; p.ws = (unsigned char*)d_ws;
#ifndef DBG_LO
#define DBG_LO 0
#endif
#ifndef DBG_HI
#define DBG_HI NPH
#endif
    int lo = DBG_LO, hi = DBG_HI;
    void* args[] = {&p, &lo, &hi};
    hipError_t e = hipLaunchCooperativeKernel((const void*)fwd_megakernel, dim3(grid_blocks), dim3(512), args, LDS_BYTES, stream);
    if (e != hipSuccess) fprintf(stderr, "cooperative launch failed: %s (grid %d)\n", hipGetErrorString(e), grid_blocks);
}
```

```cpp
#include <hip/hip_runtime.h>
#include <hip/hip_cooperative_groups.h>
#include <cstdio>
#include <cstdint>
namespace cg = cooperative_groups;

#define LAS __attribute__((address_space(3)))
typedef unsigned short bf16_t;
typedef short bf16x8 __attribute__((ext_vector_type(8)));
typedef short s16x4 __attribute__((ext_vector_type(4)));
typedef float f32x4 __attribute__((ext_vector_type(4)));
typedef float f32x2 __attribute__((ext_vector_type(2)));
typedef float f32x16 __attribute__((ext_vector_type(16)));
typedef unsigned u32x4 __attribute__((ext_vector_type(4)));
typedef unsigned u32x2 __attribute__((ext_vector_type(2)));

constexpr int T_ = 16384, D_ = 2048, S_ = 4096;
constexpr float EPS_ = 1e-6f;
constexpr int LDS_BYTES = 156672;

constexpr size_t SZ_A_IN = 6144ull * 2048 * 2, SZ_A_OUT = 2048ull * 2048 * 2, SZ_W1 = 8192ull * 2048 * 2;
constexpr size_t OFF_WT_A_IN = 0;
constexpr size_t OFF_WT_A_OUT = OFF_WT_A_IN + 2 * SZ_A_IN;
constexpr size_t OFF_WT_GLU = OFF_WT_A_OUT + 2 * SZ_A_OUT;
constexpr size_t OFF_WT_C_IN = OFF_WT_GLU + 4096ull * 2048 * 2;
constexpr size_t OFF_WT_C_OUT = OFF_WT_C_IN + 12288ull * 2048 * 2;
constexpr size_t OFF_WT_W1 = OFF_WT_C_OUT + 2048ull * 4096 * 2;
constexpr size_t OFF_WT_W2 = OFF_WT_W1 + 4 * SZ_W1;
constexpr size_t OFF_XB = OFF_WT_W2 + 4 * SZ_W1;
constexpr size_t OFF_BIG = OFF_XB + (size_t)T_ * D_ * 2;
constexpr size_t OFF_OA = OFF_BIG + (size_t)T_ * 12288 * 2;
constexpr size_t OFF_SS = OFF_OA + (size_t)T_ * 4096 * 2;
constexpr size_t OFF_RSSQ = OFF_SS + 9ull * T_ * 4;
constexpr size_t OFF_ROT = OFF_RSSQ + (size_t)T_ * 8 * 4;
constexpr size_t OFF_S5B = OFF_ROT + 4096ull * 128 * 8;
constexpr size_t OFF_S5C = OFF_S5B + 128ull * 128 * 16 * 2;
constexpr size_t OFF_S5AB = OFF_S5C + 128ull * 16 * 128 * 2;
constexpr size_t WS_END = OFF_S5AB + 128ull * 64 * 8;
constexpr size_t OFF_SSP = WS_END;
constexpr size_t OFF_RSQP = OFF_SSP + 9ull * 32 * T_ * 4;
constexpr size_t OFF_RSFIN = OFF_RSQP + 8ull * T_ * 8 * 4;
constexpr size_t OFF_BAR = OFF_RSFIN + (size_t)T_ * 4;
constexpr size_t WS_NEED = OFF_BAR + 256;
constexpr size_t OFF_ATT_SCR = OFF_BIG + (size_t)T_ * 6144 * 2;

struct Params {
    const float* x; const float* norm_mix; const float* norm_mlp; const float* norm_final;
    const float* a_w_in; const float* a_lambda; const float* a_subln; const float* a_w_out;
    const float* b_a_re; const float* b_a_im; const float* b_log_dt; const float* b_b_re; const float* b_b_im;
    const float* b_c_re; const float* b_c_im; const float* b_d; const float* b_w_glu;
    const float* c_w_in; const float* c_w_out; const float* mlp_w1; const float* mlp_w2;
    float* out; unsigned char* ws;
};

__device__ __forceinline__ unsigned cvt_pk_bf16(float lo, float hi) { unsigned r; asm volatile("v_cvt_pk_bf16_f32 %0, %1, %2" : "=v"(r) : "v"(lo), "v"(hi)); return r; }
__device__ __forceinline__ float bf2f(unsigned short b) { return __uint_as_float(((unsigned)b) << 16); }
__device__ __forceinline__ float bflo(unsigned w) { return __uint_as_float(w << 16); }
__device__ __forceinline__ float bfhi(unsigned w) { return __uint_as_float(w & 0xffff0000u); }
__device__ __forceinline__ unsigned short f2bf(float f) { return (unsigned short)(cvt_pk_bf16(f, 0.f) & 0xffffu); }

__device__ __forceinline__ int otid() { int t = threadIdx.x; asm volatile("" : "+v"(t)); return t; }
__device__ __forceinline__ int obid() { int t = blockIdx.x; asm volatile("" : "+s"(t)); return t; }

namespace pg8 {
constexpr int BM = 256, BK = 64, HALF = 128, HTB = HALF * BK * 2, STAGE_BYTES = 8 * HTB, NXCD = 8, WGM = 8;
__device__ __forceinline__ int lds_byte(int r, int c) { const int st = (r >> 4) * 2 + (c >> 5), rr = r & 15, cc = c & 31, ob = rr * 64 + cc * 2; return st * 1024 + (ob ^ (((ob >> 9) & 1) << 5)); }
__device__ __forceinline__ void stage_rc(int b, int& R, int& C) { const int st = b / 1024, sb = b % 1024, swz = sb ^ (((sb >> 9) & 1) << 5); R = (st >> 1) * 16 + swz / 64; C = (st & 1) * 32 + (swz % 64) / 2; }
struct Unit { int pm, pn; };
struct Gemm { const bf16_t* A; const bf16_t* Bt; int M, N, K; };
struct StaticOrder {
    int nM, nN, nwg, G, c;
    __device__ void init(int M, int N, int G_, int c_) { nM = M / BM; nN = N / BM; nwg = nM * nN; G = G_; c = c_; }
    __device__ bool next(int i, Unit& u) const {
        const long L = (long)i * G + c; if (L >= nwg) return false;
        int wgid = (int)L; { const int q = nwg / NXCD, r = nwg % NXCD, xcd = wgid % NXCD, off = wgid / NXCD; wgid = (xcd < r ? xcd * (q + 1) : r * (q + 1) + (xcd - r) * q) + off; }
        const int nig = WGM * nN, gid = wgid / nig, fm = gid * WGM, gsz = (nM - fm) < WGM ? (nM - fm) : WGM;
        u.pm = fm + ((wgid % nig) % gsz); u.pn = (wgid % nig) / gsz; return true;
    }
};

#define GAS __attribute__((address_space(1)))
struct EpiBf {
    bf16_t* O; int ldc; const float* ss; int mode; const f32x2* rot;
    __device__ __forceinline__ void operator()(const f32x4 (&acc)[2][2][4][2], const Unit& u, int wr, int wc, int fr, int fq) const {
        const int row0 = u.pm * BM + wr * 64 + fr, colt = u.pn * BM + wc * 32 + 4 * fq;
        int sub = 0;
        if (mode == 1) sub = 1;
        else if (mode == 2) { sub = u.pn < 8 ? 2 : (u.pn < 16 ? 3 : (u.pn < 32 ? 0 : 4)); }
        const GAS float* ssg = (const GAS float*)ss + (size_t)(fq * 8) * T_ + row0;
        float rs8[8];
#pragma unroll
        for (int r = 0; r < 8; ++r) { float a = 0.f;
#pragma unroll
            for (int sl = 0; sl < 8; ++sl) a += ssg[(size_t)sl * T_ + (r >> 2) * HALF + (r & 3) * 16];
            rs8[r] = a; }
#pragma unroll
        for (int r = 0; r < 8; ++r) { float a = rs8[r]; a += __shfl_xor(a, 16); a += __shfl_xor(a, 32); rs8[r] = rsqrtf(a * (1.0f / D_) + EPS_); }
        GAS bf16_t* Og = (GAS bf16_t*)O;
        if (sub == 2 || sub == 3) {
            const GAS f32x2* rotg = (const GAS f32x2*)rot + wc * 32 + 4 * fq;
#pragma unroll
            for (int ai = 0; ai < 2; ++ai) {
                f32x2 cs[4][2][4];
#pragma unroll
                for (int m = 0; m < 4; ++m) { const int row = row0 + ai * HALF + m * 16; const GAS f32x2* rp = rotg + (size_t)(row & (S_ - 1)) * 128;
#pragma unroll
                    for (int n = 0; n < 2; ++n)
#pragma unroll
                        for (int j = 0; j < 4; ++j) cs[m][n][j] = rp[n * 16 + j]; }
#pragma unroll
                for (int m = 0; m < 4; ++m) { const int row = row0 + ai * HALF + m * 16;
                    const float ksc = (sub == 3) ? 0.0625f * rs8[ai * 4 + m] : rs8[ai * 4 + m];
                    GAS bf16_t* rowp = Og + (size_t)row * ldc + colt;
#pragma unroll
                    for (int n = 0; n < 2; ++n) {
                        const f32x4 t1 = acc[ai][0][m][n] * ksc, t2 = acc[ai][1][m][n] * ksc;
                        f32x4 o1, o2;
#pragma unroll
                        for (int j = 0; j < 4; ++j) { const f32x2 c2 = cs[m][n][j]; o1[j] = t1[j] * c2.x - t2[j] * c2.y; o2[j] = t1[j] * c2.y + t2[j] * c2.x; }
                        u32x2 w1, w2; w1.x = cvt_pk_bf16(o1[0], o1[1]); w1.y = cvt_pk_bf16(o1[2], o1[3]); w2.x = cvt_pk_bf16(o2[0], o2[1]); w2.y = cvt_pk_bf16(o2[2], o2[3]);
                        *(GAS u32x2*)(rowp + n * 16) = w1; *(GAS u32x2*)(rowp + HALF + n * 16) = w2;
                    }
                }
            }
        } else {
#pragma unroll
            for (int ai = 0; ai < 2; ++ai)
#pragma unroll
                for (int m = 0; m < 4; ++m) {
                    const int row = row0 + ai * HALF + m * 16;
                    const float rs = rs8[ai * 4 + m];
                    GAS bf16_t* rowp = Og + (size_t)row * ldc + colt;
#pragma unroll
                    for (int bj = 0; bj < 2; ++bj)
#pragma unroll
                        for (int n = 0; n < 2; ++n) {
                            f32x4 v = acc[ai][bj][m][n] * rs;
                            if (sub == 1) {
#pragma unroll
                                for (int j = 0; j < 4; ++j) { const float r = fmaxf(v[j], 0.f); v[j] = r * r; }
                            } else if (sub == 4) {
#pragma unroll
                                for (int j = 0; j < 4; ++j) v[j] = v[j] / (1.0f + __expf(-v[j]));
                            }
                            u32x2 w; w.x = cvt_pk_bf16(v[0], v[1]); w.y = cvt_pk_bf16(v[2], v[3]);
                            *(GAS u32x2*)(rowp + bj * HALF + n * 16) = w;
                        }
                }
        }
    }
};
struct EpiRes {
    const float* xin; float* xout; bf16_t* xb; float* ssn; int glu;
    __device__ __forceinline__ void operator()(const f32x4 (&acc)[2][2][4][2], const Unit& u, int wr, int wc, int fr, int fq) const {
        const int row0 = u.pm * BM + wr * 64 + fr;
        const GAS float* xi = (const GAS float*)xin; GAS float* xo = (GAS float*)xout; GAS bf16_t* xbg = (GAS bf16_t*)xb; GAS float* ssg = (GAS float*)ssn;
        if (glu) {
            const size_t cb = (size_t)u.pn * HALF + wc * 32 + 4 * fq;
#pragma unroll
            for (int ai = 0; ai < 2; ++ai) {
                f32x4 xv[4][2];
#pragma unroll
                for (int m = 0; m < 4; ++m)
#pragma unroll
                    for (int n = 0; n < 2; ++n) xv[m][n] = *(const GAS f32x4*)(xi + (size_t)(row0 + ai * HALF + m * 16) * D_ + cb + n * 16);
#pragma unroll
                for (int m = 0; m < 4; ++m) {
                    const int row = row0 + ai * HALF + m * 16; const size_t off = (size_t)row * D_ + cb;
                    float sq = 0.f;
#pragma unroll
                    for (int n = 0; n < 2; ++n) {
                        const f32x4 va = acc[ai][0][m][n], ga = acc[ai][1][m][n];
                        f32x4 x4 = xv[m][n];
#pragma unroll
                        for (int j = 0; j < 4; ++j) { x4[j] += va[j] / (1.0f + __expf(-ga[j])); sq += x4[j] * x4[j]; }
                        *(GAS f32x4*)(xo + off + n * 16) = x4;
                        u32x2 w; w.x = cvt_pk_bf16(x4[0], x4[1]); w.y = cvt_pk_bf16(x4[2], x4[3]);
                        *(GAS u32x2*)(xbg + off + n * 16) = w;
                    }
                    sq += __shfl_xor(sq, 16); sq += __shfl_xor(sq, 32);
                    if (fq == 0) atomicAdd((float*)ssn + (size_t)((u.pn >> 1) * 4 + wc) * T_ + row, sq);
                }
            }
        } else {
            const size_t cb = (size_t)u.pn * BM + wc * 32 + 4 * fq;
#pragma unroll
            for (int ai = 0; ai < 2; ++ai) {
                f32x4 xv[4][2][2];
#pragma unroll
                for (int m = 0; m < 4; ++m)
#pragma unroll
                    for (int bj = 0; bj < 2; ++bj)
#pragma unroll
                        for (int n = 0; n < 2; ++n) xv[m][bj][n] = *(const GAS f32x4*)(xi + (size_t)(row0 + ai * HALF + m * 16) * D_ + cb + bj * HALF + n * 16);
#pragma unroll
                for (int m = 0; m < 4; ++m) {
                    const int row = row0 + ai * HALF + m * 16; const size_t off = (size_t)row * D_ + cb;
                    float sq = 0.f;
#pragma unroll
                    for (int bj = 0; bj < 2; ++bj)
#pragma unroll
                        for (int n = 0; n < 2; ++n) {
                            f32x4 x4 = xv[m][bj][n] + acc[ai][bj][m][n];
#pragma unroll
                            for (int j = 0; j < 4; ++j) sq += x4[j] * x4[j];
                            *(GAS f32x4*)(xo + off + bj * HALF + n * 16) = x4;
                            u32x2 w; w.x = cvt_pk_bf16(x4[0], x4[1]); w.y = cvt_pk_bf16(x4[2], x4[3]);
                            *(GAS u32x2*)(xbg + off + bj * HALF + n * 16) = w;
                        }
                    sq += __shfl_xor(sq, 16); sq += __shfl_xor(sq, 32);
                    if (fq == 0) ssg[(size_t)(u.pn * 4 + wc) * T_ + row] = sq;
                }
            }
        }
    }
};

template <class Epi, class Sched>
__device__ __forceinline__ void gemm_phase(LAS unsigned char* lds, const Gemm g, const Sched& S, const Epi& E) {
    const int tid = otid(), wid = __builtin_amdgcn_readfirstlane(tid >> 6), lane = tid & 63, wr = wid >> 2, wc = wid & 3, fr = lane & 15, fq = lane >> 4;
    const int K = g.K, nt = K / BK;
    unsigned voffA[2], voffB[2];
#pragma unroll
    for (int i = 0; i < 2; ++i) { int R, C; stage_rc(tid * 16 + i * 8192, R, C); voffA[i] = (unsigned)(R * K + C) * 2u; voffB[i] = voffA[i]; }
    const size_t kstep = (size_t)(BK * 2);
    const size_t hstep = (size_t)HALF * K * 2;
    const size_t tstep = 2 * hstep;
    const unsigned ldsw = (unsigned)wid * 1024u;
    const int aoff = lds_byte(wr * 64 + fr, fq * 8), boff = lds_byte(wc * 32 + fr, fq * 8);
#define PG8_SA(b, h) (((b) * 2 + (h)) * HTB)
#define PG8_SB(b, h) ((4 + (b) * 2 + (h)) * HTB)
#define PG8_STAGE(bufoff, gbase, voff) do { _Pragma("unroll") for (int _i = 0; _i < 2; ++_i) \
        __builtin_amdgcn_global_load_lds((const unsigned*)((const char*)(gbase) + (voff)[_i]), (LAS unsigned*)(lds + (bufoff) + ldsw + _i * 8192), 16, 0, 0); } while (0)
#define PG8_LDA(dst, b, h) do { _Pragma("unroll") for (int m = 0; m < 4; ++m) _Pragma("unroll") for (int k = 0; k < 2; ++k) dst[m][k] = *(const LAS bf16x8*)(lds + PG8_SA(b, h) + aoff + m * 2048 + k * 1024); } while (0)
#define PG8_LDB(dst, b, h) do { _Pragma("unroll") for (int n = 0; n < 2; ++n) _Pragma("unroll") for (int k = 0; k < 2; ++k) dst[n][k] = *(const LAS bf16x8*)(lds + PG8_SB(b, h) + boff + n * 2048 + k * 1024); } while (0)
#define PG8_MMA(ai, bj, At, Bt) do { __builtin_amdgcn_s_setprio(1); _Pragma("unroll") for (int m = 0; m < 4; ++m) _Pragma("unroll") for (int n = 0; n < 2; ++n) _Pragma("unroll") for (int k = 0; k < 2; ++k) \
        acc[ai][bj][m][n] = __builtin_amdgcn_mfma_f32_16x16x32_bf16(Bt[n][k], At[m][k], acc[ai][bj][m][n], 0, 0, 0); __builtin_amdgcn_s_setprio(0); } while (0)
#define PG8_WAIT_V(n) asm volatile("s_waitcnt vmcnt(" #n ")" ::: "memory")
#define PG8_WAIT_L(n) asm volatile("s_waitcnt lgkmcnt(" #n ")" ::: "memory")
#define PG8_BAR __builtin_amdgcn_s_barrier()
#define PG8_SCHED __builtin_amdgcn_sched_barrier(0)
    Unit cur, nxt; int ui = 0;
    if (!S.next(0, cur)) return;
    f32x4 acc[2][2][4][2];
#pragma unroll
    for (int a = 0; a < 2; ++a)
#pragma unroll
        for (int b = 0; b < 2; ++b)
#pragma unroll
            for (int m = 0; m < 4; ++m)
#pragma unroll
                for (int n = 0; n < 2; ++n) acc[a][b][m][n] = (f32x4){0.f, 0.f, 0.f, 0.f};
    bf16x8 At[4][2], B0[2][2], B1[2][2];
    const char* cA = (const char*)g.A + (size_t)cur.pm * tstep; const char* cB = (const char*)g.Bt + (size_t)cur.pn * tstep;
    PG8_STAGE(PG8_SB(0, 0), cB, voffB); PG8_STAGE(PG8_SA(0, 0), cA, voffA); PG8_STAGE(PG8_SB(0, 1), cB + hstep, voffB); PG8_STAGE(PG8_SA(0, 1), cA + hstep, voffA);
    if (wr == 1) PG8_BAR;
    PG8_WAIT_V(4); PG8_BAR;
    PG8_STAGE(PG8_SB(1, 0), cB + kstep, voffB); PG8_STAGE(PG8_SA(1, 0), cA + kstep, voffA); PG8_STAGE(PG8_SB(1, 1), cB + hstep + kstep, voffB);
    PG8_WAIT_V(6); PG8_BAR;
    for (;;) {
        const bool has_next = S.next(ui + 1, nxt);
        const char* nA = has_next ? (const char*)g.A + (size_t)nxt.pm * tstep : cA; const char* nB = has_next ? (const char*)g.Bt + (size_t)nxt.pn * tstep : cB;
        for (int t = 0; t < nt; t += 2) {
            const bool last = (t == nt - 2);
            const char* a1 = cA + (size_t)(t + 1) * kstep;
            const char* a2 = last ? nA : cA + (size_t)(t + 2) * kstep; const char* b2 = last ? nB : cB + (size_t)(t + 2) * kstep;
            const char* a3 = a2 + kstep; const char* b3 = b2 + kstep;
            PG8_LDB(B0, 0, 0); PG8_SCHED; PG8_LDA(At, 0, 0); PG8_STAGE(PG8_SA(1, 1), a1 + hstep, voffA);
            PG8_WAIT_L(8); PG8_BAR; PG8_WAIT_L(0); PG8_MMA(0, 0, At, B0); PG8_BAR; PG8_SCHED;
            PG8_LDB(B1, 0, 1); PG8_STAGE(PG8_SB(0, 0), b2, voffB);
            PG8_BAR; PG8_WAIT_L(0); PG8_MMA(0, 1, At, B1); PG8_BAR;
            PG8_LDA(At, 0, 1); PG8_STAGE(PG8_SA(0, 0), a2, voffA);
            PG8_BAR; PG8_WAIT_L(0); PG8_MMA(1, 0, At, B0); PG8_BAR; PG8_SCHED;
            PG8_STAGE(PG8_SB(0, 1), b2 + hstep, voffB);
            PG8_WAIT_V(6); PG8_BAR; PG8_MMA(1, 1, At, B1); PG8_BAR;
            PG8_LDB(B0, 1, 0); PG8_SCHED; PG8_LDA(At, 1, 0); PG8_STAGE(PG8_SA(0, 1), a2 + hstep, voffA);
            PG8_WAIT_L(8); PG8_BAR; PG8_WAIT_L(0); PG8_MMA(0, 0, At, B0); PG8_BAR; PG8_SCHED;
            PG8_LDB(B1, 1, 1); PG8_STAGE(PG8_SB(1, 0), b3, voffB);
            PG8_BAR; PG8_WAIT_L(0); PG8_MMA(0, 1, At, B1); PG8_BAR;
            PG8_LDA(At, 1, 1); PG8_STAGE(PG8_SA(1, 0), a3, voffA);
            PG8_BAR; PG8_WAIT_L(0); PG8_MMA(1, 0, At, B0); PG8_BAR; PG8_SCHED;
            PG8_STAGE(PG8_SB(1, 1), b3 + hstep, voffB);
            PG8_WAIT_V(6); PG8_BAR; PG8_MMA(1, 1, At, B1); PG8_BAR;
        }
        E(acc, cur, wr, wc, fr, fq);
        if (!has_next) break;
#pragma unroll
        for (int a = 0; a < 2; ++a)
#pragma unroll
            for (int b = 0; b < 2; ++b)
#pragma unroll
                for (int m = 0; m < 4; ++m)
#pragma unroll
                    for (int n = 0; n < 2; ++n) acc[a][b][m][n] = (f32x4){0.f, 0.f, 0.f, 0.f};
        cur = nxt; cA = nA; cB = nB; ++ui;
    }
    PG8_WAIT_V(0);
    if (wr == 0) PG8_BAR;
    PG8_BAR;
#undef PG8_SA
#undef PG8_SB
#undef PG8_STAGE
#undef PG8_LDA
#undef PG8_LDB
#undef PG8_MMA
#undef PG8_WAIT_V
#undef PG8_WAIT_L
#undef PG8_BAR
#undef PG8_SCHED
}
}

namespace att {
constexpr int D = 128, KVBLK = 64, LDK = 6144;
constexpr float SCALE = 0.088388347648318440f;
constexpr float THR = 8.f;
constexpr size_t SHM_V = KVBLK * D * 2, SHM_K = KVBLK * D * 2;
#define KSWZ(row, colB) ((row) * 256 + ((colB) ^ (((row) & 7) << 4)))
#define SBAR() __builtin_amdgcn_sched_barrier(0)
__device__ __forceinline__ int crow(int r, int hi) { return (r & 3) + 8 * (r >> 2) + 4 * hi; }
__device__ __forceinline__ void partialSM(f32x16& p0, f32x16& p1, float& m_reg, float& mn, float& alpha, bool msk) {
    constexpr float C = SCALE * 1.4426950408889634f;
    if (msk) {
#pragma unroll
        for (int r = 0; r < 16; ++r) { p0[r] = -1e30f; p1[r] = -1e30f; }
    }
    float pmax = p0[0];
#pragma unroll
    for (int r = 1; r < 16; ++r) pmax = fmaxf(pmax, p0[r]);
#pragma unroll
    for (int r = 0; r < 16; ++r) pmax = fmaxf(pmax, p1[r]);
    { auto rr = __builtin_amdgcn_permlane32_swap(__float_as_uint(pmax), __float_as_uint(pmax), false, false);
      pmax = fmaxf(__uint_as_float(rr[0]), __uint_as_float(rr[1])); }
    if (__builtin_expect(__all(pmax - m_reg <= THR / SCALE), 1)) { mn = m_reg; alpha = 1.f; }
    else { mn = fmaxf(m_reg, pmax); alpha = __builtin_amdgcn_exp2f((m_reg - mn) * C); m_reg = mn; }
    float mnC = -mn * C;
#pragma unroll
    for (int r = 0; r < 16; ++r) p0[r] = fmaf(p0[r], C, mnC);
#pragma unroll
    for (int r = 0; r < 16; ++r) p1[r] = fmaf(p1[r], C, mnC);
#pragma unroll
    for (int r = 0; r < 16; ++r) p0[r] = __builtin_amdgcn_exp2f(p0[r]);
}
__device__ __forceinline__ void finishSM(f32x16& p0, f32x16& p1, float alpha, float& l_reg, bf16x8& pa0, bf16x8& pa1, bf16x8& pa2, bf16x8& pa3) {
#pragma unroll
    for (int r = 0; r < 16; ++r) p1[r] = __builtin_amdgcn_exp2f(p1[r]);
    float ps = 0;
#pragma unroll
    for (int r = 0; r < 16; ++r) ps += p0[r];
#pragma unroll
    for (int r = 0; r < 16; ++r) ps += p1[r];
    { auto rr = __builtin_amdgcn_permlane32_swap(__float_as_uint(ps), __float_as_uint(ps), false, false);
      ps = __uint_as_float(rr[0]) + __uint_as_float(rr[1]); }
    l_reg = l_reg * alpha + ps;
#define PK4(P, BASE, OUT) do { unsigned a0 = cvt_pk_bf16(P[BASE + 0], P[BASE + 1]), a1 = cvt_pk_bf16(P[BASE + 2], P[BASE + 3]);   \
    unsigned b0 = cvt_pk_bf16(P[BASE + 4], P[BASE + 5]), b1 = cvt_pk_bf16(P[BASE + 6], P[BASE + 7]);                              \
    auto r0 = __builtin_amdgcn_permlane32_swap(a0, b0, false, false); auto r1 = __builtin_amdgcn_permlane32_swap(a1, b1, false, false); \
    u32x4 w = {r0[0], r1[0], r0[1], r1[1]}; OUT = *reinterpret_cast<bf16x8*>(&w); } while (0)
    PK4(p0, 0, pa0); PK4(p0, 8, pa1); PK4(p1, 0, pa2); PK4(p1, 8, pa3);
#undef PK4
}
__device__ __forceinline__ void qkt(f32x16& p0, f32x16& p1, const char* Ks, const bf16x8* qr, int r32, int hi) {
    p0 = f32x16{}; p1 = f32x16{};
#pragma unroll
    for (int d0 = 0; d0 < 8; ++d0) { int cb = (d0 * 16 + hi * 8) * 2;
        bf16x8 b0 = *reinterpret_cast<const bf16x8*>(Ks + KSWZ(r32, cb));
        bf16x8 b1 = *reinterpret_cast<const bf16x8*>(Ks + KSWZ(32 + r32, cb));
        p0 = __builtin_amdgcn_mfma_f32_32x32x16_bf16(b0, qr[d0], p0, 0, 0, 0);
        p1 = __builtin_amdgcn_mfma_f32_32x32x16_bf16(b1, qr[d0], p1, 0, 0, 0); }
}
__device__ __forceinline__ int v_st(int k, int c) { const int kk = (k & ~0xC) | ((k & 4) << 1) | ((k & 8) >> 1); return ((kk >> 3) * 4 + (c >> 5)) * 512 + ((kk & 7) * 32 + (c & 31)) * 2; }
__device__ __forceinline__ int v_rd_base(int lane) { return ((lane & 3) << 3) | (((lane >> 2) & 3) << 6) | (((lane >> 4) & 1) << 5) | (((lane >> 5) & 1) << 8); }
constexpr int v_rd_off(int d0, int ks, int half) { return d0 * 512 + ks * 4096 + half * 2048; }
template <int OFF> __device__ __forceinline__ s16x4 tr_read(int vb) {
    s16x4 r; asm volatile("ds_read_b64_tr_b16 %0, %1 offset:%2" : "=&v"(r) : "v"(vb), "i"(OFF) : "memory"); return r;
}
template <int D0> __device__ __forceinline__ void pv_one(f32x16& od, int vb, bf16x8 pa0, bf16x8 pa1, bf16x8 pa2, bf16x8 pa3) {
    const s16x4 l0 = tr_read<v_rd_off(D0, 0, 0)>(vb), h0 = tr_read<v_rd_off(D0, 0, 1)>(vb), l1 = tr_read<v_rd_off(D0, 1, 0)>(vb), h1 = tr_read<v_rd_off(D0, 1, 1)>(vb);
    const s16x4 l2 = tr_read<v_rd_off(D0, 2, 0)>(vb), h2 = tr_read<v_rd_off(D0, 2, 1)>(vb), l3 = tr_read<v_rd_off(D0, 3, 0)>(vb), h3 = tr_read<v_rd_off(D0, 3, 1)>(vb);
    asm volatile("s_waitcnt lgkmcnt(0)" ::: "memory"); SBAR();
#define PK(L, H) (bf16x8){L[0], L[1], L[2], L[3], H[0], H[1], H[2], H[3]}
    od = __builtin_amdgcn_mfma_f32_32x32x16_bf16(pa0, PK(l0, h0), od, 0, 0, 0);
    od = __builtin_amdgcn_mfma_f32_32x32x16_bf16(pa1, PK(l1, h1), od, 0, 0, 0);
    od = __builtin_amdgcn_mfma_f32_32x32x16_bf16(pa2, PK(l2, h2), od, 0, 0, 0);
    od = __builtin_amdgcn_mfma_f32_32x32x16_bf16(pa3, PK(l3, h3), od, 0, 0, 0);
#undef PK
}
__device__ __forceinline__ void pv_d0(f32x16* o, int vb, bf16x8 pa0, bf16x8 pa1, bf16x8 pa2, bf16x8 pa3) {
    pv_one<0>(o[0], vb, pa0, pa1, pa2, pa3); pv_one<1>(o[1], vb, pa0, pa1, pa2, pa3); pv_one<2>(o[2], vb, pa0, pa1, pa2, pa3); pv_one<3>(o[3], vb, pa0, pa1, pa2, pa3);
}
__device__ __forceinline__ void attn_body(const bf16_t* __restrict__ Qb, const bf16_t* __restrict__ Kh, const bf16_t* __restrict__ Vh, int NT, int ntw, char* lds, f32x16 (&o)[4]) {
    const int tid = otid(), wid = __builtin_amdgcn_readfirstlane(tid >> 6), lane = tid & 63, r32 = lane & 31, hi = lane >> 5;
    char* V_lds = lds; char* K_lds = lds + 2 * SHM_V;
    float* wsf = (float*)(lds + 2 * SHM_V + 2 * SHM_K) + wid * 64; float* li_l = wsf; float* al_l = wsf + 32;
    float m_reg = -1e30f, l_reg = 0; bf16x8 qr[8];
#pragma unroll
    for (int d = 0; d < 4; ++d) o[d] = f32x16{};
    const bf16_t* Qw = Qb + (long)(wid * 32 + r32) * LDK + hi * 8;
#pragma unroll
    for (int d0 = 0; d0 < 8; ++d0) qr[d0] = *reinterpret_cast<const bf16x8*>(Qw + d0 * 16);
    const int sr = tid >> 4, sc = (tid & 15) * 8, vst0 = v_st(sr, sc), vst1 = v_st(32 + sr, sc);
    const int vb0 = (int)(uintptr_t)V_lds + v_rd_base(lane);
    struct { bf16x8 vs0, vs1, ks0, ks1; } sr_[2];
#define SLOAD(i, k0) do { sr_[i].vs0 = *reinterpret_cast<const bf16x8*>(&Vh[(long)((k0) + sr) * LDK + sc]); sr_[i].vs1 = *reinterpret_cast<const bf16x8*>(&Vh[(long)((k0) + 32 + sr) * LDK + sc]); \
    sr_[i].ks0 = *reinterpret_cast<const bf16x8*>(&Kh[(long)((k0) + sr) * LDK + sc]); sr_[i].ks1 = *reinterpret_cast<const bf16x8*>(&Kh[(long)((k0) + 32 + sr) * LDK + sc]); } while (0)
#define SWRITE(b, i) do { *(bf16x8*)(V_lds + (b) * SHM_V + vst0) = sr_[i].vs0;          \
    *(bf16x8*)(V_lds + (b) * SHM_V + vst1) = sr_[i].vs1; int kc = sc * 2;               \
    *(bf16x8*)(K_lds + (b) * SHM_K + KSWZ(sr, kc)) = sr_[i].ks0;                       \
    *(bf16x8*)(K_lds + (b) * SHM_K + KSWZ(32 + sr, kc)) = sr_[i].ks1; } while (0)
#define SWAIT() asm volatile("s_waitcnt vmcnt(4)" ::: "memory")
#define RESC(a) do { if (__any((a) < 1.f)) { if (hi == 0) al_l[r32] = (a); asm volatile("s_waitcnt lgkmcnt(0)" ::: "memory"); \
    _Pragma("unroll") for (int d = 0; d < 4; ++d) _Pragma("unroll") for (int r = 0; r < 16; ++r) o[d][r] *= al_l[crow(r, hi)]; } } while (0)
    f32x16 pA0, pA1, pB0, pB1; float mnA, mnB, alA, alB; bf16x8 pa0, pa1, pa2, pa3;
    constexpr int SE = 0, SO = 1;
    __syncthreads();
    SLOAD(SE, 0); asm volatile("s_waitcnt vmcnt(0)" ::: "memory"); SWRITE(0, SE); __syncthreads();
    qkt(pA0, pA1, K_lds, qr, r32, hi); partialSM(pA0, pA1, m_reg, mnA, alA, false);
    SLOAD(SO, KVBLK); if (2 < NT) SLOAD(SE, 2 * KVBLK);
    SWAIT(); SWRITE(1, SO); __syncthreads();
    for (int j = 1; j + 1 < NT; j += 2) {
        SBAR(); qkt(pB0, pB1, K_lds + SHM_K, qr, r32, hi);
        finishSM(pA0, pA1, alA, l_reg, pa0, pa1, pa2, pa3); SBAR();
        SLOAD(SO, (j + 2) * KVBLK); SBAR();
        pv_d0(o, vb0, pa0, pa1, pa2, pa3); partialSM(pB0, pB1, m_reg, mnB, alB, j >= ntw);
        __syncthreads(); SWAIT(); SWRITE(0, SE);
        RESC(alB); __syncthreads();
        SBAR(); qkt(pA0, pA1, K_lds, qr, r32, hi);
        finishSM(pB0, pB1, alB, l_reg, pa0, pa1, pa2, pa3); SBAR();
        if (j + 3 < NT) SLOAD(SE, (j + 3) * KVBLK); SBAR();
        pv_d0(o, vb0 + (int)SHM_V, pa0, pa1, pa2, pa3); partialSM(pA0, pA1, m_reg, mnA, alA, (j + 1) >= ntw);
        __syncthreads(); SWAIT(); SWRITE(1, SO);
        RESC(alA); __syncthreads();
    }
    SBAR(); qkt(pB0, pB1, K_lds + SHM_K, qr, r32, hi);
    finishSM(pA0, pA1, alA, l_reg, pa0, pa1, pa2, pa3); SBAR();
    pv_d0(o, vb0, pa0, pa1, pa2, pa3); partialSM(pB0, pB1, m_reg, mnB, alB, (NT - 1) >= ntw);
    __syncthreads(); RESC(alB);
    finishSM(pB0, pB1, alB, l_reg, pa0, pa1, pa2, pa3); SBAR();
    pv_d0(o, vb0 + (int)SHM_V, pa0, pa1, pa2, pa3);
    if (hi == 0) li_l[r32] = l_reg; asm volatile("s_waitcnt lgkmcnt(0)" ::: "memory");
#pragma unroll
    for (int r = 0; r < 16; ++r) { const float rl = __builtin_amdgcn_rcpf(li_l[crow(r, hi)]);
#pragma unroll
        for (int d = 0; d < 4; ++d) o[d][r] *= rl; }
#undef SLOAD
#undef SWRITE
#undef SWAIT
#undef RESC
}
}

__device__ __forceinline__ void sincos_red(double ang, float& s, float& c) {
    const double k = rint(ang * 0.15915494309189535);
    const float r = (float)(ang - k * 6.283185307179586);
    s = __sinf(r); c = __cosf(r);
}
__device__ __forceinline__ float gelu_tanh(float y) {
    const float z = 0.7978845608028654f * (y + 0.044715f * y * y * y);
    const float th = 1.0f - 2.0f / (1.0f + __expf(2.0f * z));
    return 0.5f * y * (1.0f + th);
}

__device__ __forceinline__ void conv_tile(const float* __restrict__ W, bf16_t* __restrict__ Wt, int K, int N, const float* __restrict__ gain, int glu, int tile, unsigned* ldsw) {
    const int tid = otid();
    const int ntn = N >> 7; const int tk = tile / ntn, tn = tile - tk * ntn; const int k0 = tk << 7, n0 = tn << 7;
    const int kp = tid >> 5, nl = (tid & 31) << 2;
    f32x4 va[4], vb[4];
#pragma unroll
    for (int i = 0; i < 4; ++i) { const int k = 2 * (kp + 16 * i);
        va[i] = *(const f32x4*)(W + (size_t)(k0 + k) * N + n0 + nl); vb[i] = *(const f32x4*)(W + (size_t)(k0 + k + 1) * N + n0 + nl); }
    __syncthreads();
#pragma unroll
    for (int i = 0; i < 4; ++i) { const int kpair = kp + 16 * i; const int k = 2 * kpair;
        const float ga = gain ? gain[k0 + k] : 1.f, gb = gain ? gain[k0 + k + 1] : 1.f;
#pragma unroll
        for (int j = 0; j < 4; ++j) ldsw[(nl + j) * 65 + kpair] = cvt_pk_bf16(va[i][j] * ga, vb[i][j] * gb); }
    __syncthreads();
    int nbase = n0;
    if (glu) { const int bj = n0 >> 11, pn = (n0 & 2047) >> 7; nbase = 256 * pn + 128 * bj; }
#pragma unroll
    for (int i = 0; i < 4; ++i) { const int n = (tid >> 4) + 32 * i, k8 = tid & 15;
        u32x4 w; w.x = ldsw[n * 65 + k8 * 4 + 0]; w.y = ldsw[n * 65 + k8 * 4 + 1]; w.z = ldsw[n * 65 + k8 * 4 + 2]; w.w = ldsw[n * 65 + k8 * 4 + 3];
        *(u32x4*)(Wt + (size_t)(nbase + n) * K + k0 + k8 * 8) = w; }
}

__device__ __forceinline__ void prep_phase(const Params& p, unsigned char* shm) {
    const int tid = otid(), bid = obid(), G = gridDim.x;
    unsigned char* ws = p.ws;
    for (int t = bid; t < 12800; t += G) {
        const float* W; bf16_t* Wt; int K, N, glu = 0; const float* gain = nullptr; int tile;
        if (t < 1536) { const int j = t / 768; tile = t - j * 768; W = p.a_w_in + (size_t)j * 2048 * 6144; Wt = (bf16_t*)(ws + OFF_WT_A_IN + j * SZ_A_IN); K = 2048; N = 6144; gain = p.norm_mix + (size_t)(3 * j) * D_; }
        else if (t < 2048) { const int u = t - 1536; const int j = u / 256; tile = u - j * 256; W = p.a_w_out + (size_t)j * 2048 * 2048; Wt = (bf16_t*)(ws + OFF_WT_A_OUT + j * SZ_A_OUT); K = 2048; N = 2048; }
        else if (t < 2560) { tile = t - 2048; W = p.b_w_glu; Wt = (bf16_t*)(ws + OFF_WT_GLU); K = 2048; N = 4096; glu = 1; }
        else if (t < 4096) { tile = t - 2560; W = p.c_w_in; Wt = (bf16_t*)(ws + OFF_WT_C_IN); K = 2048; N = 12288; gain = p.norm_mix + 2 * D_; }
        else if (t < 4608) { tile = t - 4096; W = p.c_w_out; Wt = (bf16_t*)(ws + OFF_WT_C_OUT); K = 4096; N = 2048; }
        else if (t < 8704) { const int u = t - 4608; const int i = u / 1024; tile = u - i * 1024; W = p.mlp_w1 + (size_t)i * 2048 * 8192; Wt = (bf16_t*)(ws + OFF_WT_W1 + i * SZ_W1); K = 2048; N = 8192; gain = p.norm_mlp + (size_t)i * D_; }
        else { const int u = t - 8704; const int i = u / 1024; tile = u - i * 1024; W = p.mlp_w2 + (size_t)i * 8192 * 2048; Wt = (bf16_t*)(ws + OFF_WT_W2 + i * SZ_W1); K = 8192; N = 2048; }
        conv_tile(W, Wt, K, N, gain, glu, tile, (unsigned*)shm);
    }
    {
        float* ss = (float*)(ws + OFF_SSP); bf16_t* xb = (bf16_t*)(ws + OFF_XB);
        const int wid = tid >> 6, lane = tid & 63;
        for (int row = bid * 8 + wid; row < T_; row += G * 8) {
            const float* xr = p.x + (size_t)row * D_; float sq = 0.f;
#pragma unroll
            for (int i = 0; i < 8; ++i) { const f32x4 v = *(const f32x4*)(xr + (i * 64 + lane) * 4);
                sq += v[0] * v[0] + v[1] * v[1] + v[2] * v[2] + v[3] * v[3];
                u32x2 w; w.x = cvt_pk_bf16(v[0], v[1]); w.y = cvt_pk_bf16(v[2], v[3]);
                *(u32x2*)(xb + (size_t)row * D_ + (i * 64 + lane) * 4) = w; }
#pragma unroll
            for (int o = 32; o > 0; o >>= 1) sq += __shfl_xor(sq, o);
            if (lane < 32) ss[(size_t)lane * T_ + row] = (lane == 0) ? sq : 0.f;
        }
        for (int i = bid * 512 + tid; i < 32 * T_; i += G * 512) ss[(size_t)3 * 32 * T_ + i] = 0.f;
        float* rssq = (float*)(ws + OFF_RSQP);
        for (int i = bid * 512 + tid; i < 64 * T_; i += G * 512) rssq[i] = 0.f;
    }
    {
        f32x2* rot = (f32x2*)(ws + OFF_ROT);
        for (int i = bid * 512 + tid; i < 4096 * 128; i += G * 512) {
            const int pos = i >> 7, j = i & 127;
            const double inv = exp(-9.210340371976184 * ((double)j / 127.0));
            float s, c; sincos_red((double)pos * inv, s, c);
            f32x2 v; v.x = c; v.y = s; rot[i] = v;
        }
    }
    {
        bf16_t* Bm = (bf16_t*)(ws + OFF_S5B); bf16_t* Cm = (bf16_t*)(ws + OFF_S5C); f32x2* AB = (f32x2*)(ws + OFF_S5AB);
        const float* gmix = p.norm_mix + 1 * D_;
        for (int i = bid * 512 + tid; i < 128 * 64; i += G * 512) {
            const int g = i >> 6, pp = i & 63;
            const float lre = p.b_a_re[i], lim = p.b_a_im[i];
            const float dt = __expf(p.b_log_dt[g]);
            const float mag = __expf(lre * dt);
            float sn, cs; sincos_red((double)lim * (double)dt, sn, cs);
            const float abr = mag * cs, abi = mag * sn;
            const float den = lre * lre + lim * lim;
            const float nr = abr - 1.0f, ni = abi;
            const float cr_ = (nr * lre + ni * lim) / den, ci_ = (ni * lre - nr * lim) / den;
            f32x2 ab; ab.x = abr; ab.y = abi; AB[i] = ab;
#pragma unroll
            for (int c = 0; c < 16; ++c) {
                const float br = p.b_b_re[(size_t)i * 16 + c], bi = p.b_b_im[(size_t)i * 16 + c];
                const float gm = gmix[g * 16 + c];
                Bm[((size_t)g * 128 + pp) * 16 + c] = f2bf((cr_ * br - ci_ * bi) * gm);
                Bm[((size_t)g * 128 + 64 + pp) * 16 + c] = f2bf((cr_ * bi + ci_ * br) * gm);
                Cm[((size_t)g * 16 + c) * 128 + pp] = f2bf(p.b_c_re[((size_t)g * 16 + c) * 64 + pp]);
                Cm[((size_t)g * 16 + c) * 128 + 64 + pp] = f2bf(-p.b_c_im[((size_t)g * 16 + c) * 64 + pp]);
            }
        }
    }
}

__device__ __forceinline__ void attn_phase(const Params& p, int j, float lambda_init, unsigned char* shm) {
    const int tid = otid(), wid = __builtin_amdgcn_readfirstlane(tid >> 6), lane = tid & 63, r32 = lane & 31, hi = lane >> 5;
    const bf16_t* qkv = (const bf16_t*)(p.ws + OFF_BIG);
    bf16_t* oa = (bf16_t*)(p.ws + OFF_OA);
    float* scr = (float*)(p.ws + OFF_ATT_SCR) + (size_t)obid() * 2 * 32768;
    float lam;
    { const float* lp = p.a_lambda + (size_t)j * 512;
      float a = lp[lane] * lp[128 + lane] + lp[64 + lane] * lp[192 + lane];
      float b = lp[256 + lane] * lp[384 + lane] + lp[320 + lane] * lp[448 + lane];
#pragma unroll
      for (int o = 32; o > 0; o >>= 1) { a += __shfl_xor(a, o); b += __shfl_xor(b, o); }
      lam = __expf(a) - __expf(b) + lambda_init; lam = __uint_as_float(__builtin_amdgcn_readfirstlane(__float_as_uint(lam))); }
    const float* sub = p.a_subln + (size_t)j * 256;
    const int c = obid(); const int xcd = c & 7, jj = c >> 3;
    const int bh = xcd * 4 + (jj >> 3), pi = jj & 7;
    const int b = bh >> 3, h = bh & 7;
#pragma unroll 1
    for (int it = 0; it < 2; ++it) {
        const int qb = it == 0 ? (15 - pi) : pi;
        const int NT = 4 * qb + 4, ntw = 4 * qb + (wid >> 1) + 1;
        const size_t tok0 = (size_t)b * S_ + (size_t)qb * 256;
        f32x16 o[4];
#pragma unroll 1
        for (int ps = 0; ps < 4; ++ps) {
            const int e = ps >> 1, t = ps & 1;
            float* sc = scr + e * 32768;
            att::attn_body(qkv + tok0 * 6144 + h * 256 + t * 128, qkv + (size_t)b * S_ * 6144 + 2048 + h * 256 + t * 128,
                           qkv + (size_t)b * S_ * 6144 + 4096 + h * 256 + e * 128, NT, ntw, (char*)shm, o);
            if (t == 0) {
#pragma unroll
                for (int d = 0; d < 4; ++d)
#pragma unroll
                    for (int r = 0; r < 16; ++r) sc[tid * 64 + d * 16 + r] = o[d][r];
            } else {
#pragma unroll
                for (int d = 0; d < 4; ++d)
#pragma unroll
                    for (int r = 0; r < 16; ++r) { const float cv = sc[tid * 64 + d * 16 + r] - lam * o[d][r]; o[d][r] = cv; if (e == 0) sc[tid * 64 + d * 16 + r] = cv; }
            }
        }
        float ssq[16];
#pragma unroll
        for (int r = 0; r < 16; ++r) { float s = 0.f;
#pragma unroll
            for (int d = 0; d < 4; ++d) { const float c0 = scr[tid * 64 + d * 16 + r]; s += c0 * c0 + o[d][r] * o[d][r]; }
#pragma unroll
            for (int of = 16; of > 0; of >>= 1) s += __shfl_xor(s, of);
            ssq[r] = rsqrtf(s * (1.0f / 256.0f) + EPS_) * (1.0f - lambda_init); }
#pragma unroll
        for (int r = 0; r < 16; ++r) {
            const size_t row = tok0 + wid * 32 + att::crow(r, hi);
            bf16_t* op = oa + row * D_ + h * 256;
#pragma unroll
            for (int d = 0; d < 4; ++d) {
                const int col = d * 32 + r32;
                op[col] = f2bf(scr[tid * 64 + d * 16 + r] * ssq[r] * sub[col]);
                op[128 + col] = f2bf(o[d][r] * ssq[r] * sub[128 + col]);
            }
        }
    }
}

template <bool FINAL>
__device__ __forceinline__ void s5_phase(const Params& p, unsigned char* shm) {
    const int tid = otid(), wid = tid >> 6, lane = tid & 63, r32 = lane & 31, hi = lane >> 5, fr = lane & 15, fq = lane >> 4;
    const bf16_t* xb = (const bf16_t*)(p.ws + OFF_XB);
    const float* ss = (const float*)(p.ws + OFF_SSP) + (size_t)2 * 32 * T_;
    float* rsfin = (float*)(p.ws + OFF_RSFIN);
    const bf16_t* Bm = (const bf16_t*)(p.ws + OFF_S5B); const bf16_t* Cm = (const bf16_t*)(p.ws + OFF_S5C); const f32x2* AB = (const f32x2*)(p.ws + OFF_S5AB);
    f32x2* E = (f32x2*)(p.ws + OFF_BIG);
    bf16_t* gl = (bf16_t*)(p.ws + OFF_OA);
    bf16_t* Xs = (bf16_t*)shm + wid * (32 * 136);
    const float* gmix = p.norm_mix + D_; const float* dsk = p.b_d;
    for (int it = obid(); it < 4096; it += gridDim.x) {
        const int goct = it & 15, chunk = (it >> 4) & 63, b = it >> 10;
        const int g = goct * 8 + wid; const int pp = r32 + 32 * hi;
        const size_t t0 = (size_t)b * S_ + chunk * 64;
        const f32x2 ab = AB[g * 64 + pp];
        bf16x8 bfr[4];
#pragma unroll
        for (int nb = 0; nb < 4; ++nb) bfr[nb] = *(const bf16x8*)(Bm + ((size_t)g * 128 + nb * 32 + r32) * 16 + hi * 8);
        float xr = 0.f, xi = 0.f;
        bf16x8 cfr[4]; float gm4[4], ds4[4];
        if (FINAL) {
            float pr = ab.x, pi_ = ab.y;
#pragma unroll
            for (int s = 0; s < 6; ++s) { const float nr = pr * pr - pi_ * pi_, ni = 2.f * pr * pi_; pr = nr; pi_ = ni; }
            const f32x2* Ep = E + ((size_t)(b * 128 + g) * 64) * 64 + pp;
            for (int c2 = 0; c2 < chunk; ++c2) { const f32x2 e = Ep[(size_t)c2 * 64];
                const float nr = pr * xr - pi_ * xi + e.x, ni = pr * xi + pi_ * xr + e.y; xr = nr; xi = ni; }
#pragma unroll
            for (int ks = 0; ks < 4; ++ks) cfr[ks] = *(const bf16x8*)(Cm + ((size_t)g * 16 + fr) * 128 + ks * 32 + fq * 8);
#pragma unroll
            for (int jx = 0; jx < 4; ++jx) { gm4[jx] = gmix[g * 16 + 4 * fq + jx]; ds4[jx] = dsk[g * 16 + 4 * fq + jx]; }
        }
#pragma unroll
        for (int half = 0; half < 2; ++half) {
            const size_t trow = t0 + half * 32 + r32;
            float rs;
            if (FINAL) rs = rsfin[trow];
            else { float ssum = 0.f;
#pragma unroll 8
                for (int sl = 0; sl < 32; ++sl) ssum += ss[(size_t)sl * T_ + trow];
                rs = rsqrtf(ssum * (1.0f / D_) + EPS_); if (goct == 0 && hi == 0 && wid == 0) rsfin[trow] = rs; }
            const u32x4 raw = *(const u32x4*)(xb + trow * D_ + g * 16 + hi * 8);
            u32x4 sc4;
            sc4.x = cvt_pk_bf16(bflo(raw.x) * rs, bfhi(raw.x) * rs); sc4.y = cvt_pk_bf16(bflo(raw.y) * rs, bfhi(raw.y) * rs);
            sc4.z = cvt_pk_bf16(bflo(raw.z) * rs, bfhi(raw.z) * rs); sc4.w = cvt_pk_bf16(bflo(raw.w) * rs, bfhi(raw.w) * rs);
            const bf16x8 afr = *reinterpret_cast<const bf16x8*>(&sc4);
            f32x16 c0 = __builtin_amdgcn_mfma_f32_32x32x16_bf16(afr, bfr[0], f32x16{}, 0, 0, 0);
            f32x16 c1 = __builtin_amdgcn_mfma_f32_32x32x16_bf16(afr, bfr[1], f32x16{}, 0, 0, 0);
            f32x16 c2 = __builtin_amdgcn_mfma_f32_32x32x16_bf16(afr, bfr[2], f32x16{}, 0, 0, 0);
            f32x16 c3 = __builtin_amdgcn_mfma_f32_32x32x16_bf16(afr, bfr[3], f32x16{}, 0, 0, 0);
#pragma unroll
            for (int i = 0; i < 16; ++i) {
                auto r0 = __builtin_amdgcn_permlane32_swap(__float_as_uint(c0[i]), __float_as_uint(c1[i]), false, false);
                c0[i] = __uint_as_float(r0[0]); c1[i] = __uint_as_float(r0[1]);
                auto r1 = __builtin_amdgcn_permlane32_swap(__float_as_uint(c2[i]), __float_as_uint(c3[i]), false, false);
                c2[i] = __uint_as_float(r1[0]); c3[i] = __uint_as_float(r1[1]);
            }
#pragma unroll
            for (int t = 0; t < 32; ++t) {
                const int q = t >> 3, s = t & 7, idx = 4 * q + (s & 3);
                const float bur = (s < 4) ? c0[idx] : c1[idx], bui = (s < 4) ? c2[idx] : c3[idx];
                const float nr = ab.x * xr - ab.y * xi + bur, ni = ab.x * xi + ab.y * xr + bui;
                xr = nr; xi = ni;
                if (FINAL) { Xs[t * 136 + pp] = f2bf(xr); Xs[t * 136 + 64 + pp] = f2bf(xi); }
            }
            if (FINAL) {
                asm volatile("s_waitcnt lgkmcnt(0)" ::: "memory");
#pragma unroll
                for (int m = 0; m < 2; ++m) {
                    f32x4 acc = {0.f, 0.f, 0.f, 0.f};
#pragma unroll
                    for (int ks = 0; ks < 4; ++ks) {
                        const bf16x8 xf = *(const bf16x8*)(Xs + (m * 16 + fr) * 136 + ks * 32 + fq * 8);
                        acc = __builtin_amdgcn_mfma_f32_16x16x32_bf16(cfr[ks], xf, acc, 0, 0, 0);
                    }
                    const size_t tr2 = t0 + half * 32 + m * 16 + fr;
                    const float rs2 = rsfin[tr2];
                    const u32x2 hx = *(const u32x2*)(xb + tr2 * D_ + g * 16 + 4 * fq);
                    const float h0 = bflo(hx.x) * rs2 * gm4[0], h1 = bfhi(hx.x) * rs2 * gm4[1], h2 = bflo(hx.y) * rs2 * gm4[2], h3 = bfhi(hx.y) * rs2 * gm4[3];
                    const float y0 = gelu_tanh(acc[0] + ds4[0] * h0), y1 = gelu_tanh(acc[1] + ds4[1] * h1), y2 = gelu_tanh(acc[2] + ds4[2] * h2), y3 = gelu_tanh(acc[3] + ds4[3] * h3);
                    u32x2 w; w.x = cvt_pk_bf16(y0, y1); w.y = cvt_pk_bf16(y2, y3);
                    *(u32x2*)(gl + tr2 * D_ + g * 16 + 4 * fq) = w;
                }
                asm volatile("s_waitcnt lgkmcnt(0)" ::: "memory");
            }
        }
        if (!FINAL) { f32x2 e; e.x = xr; e.y = xi; E[((size_t)(b * 128 + g) * 64 + chunk) * 64 + pp] = e; }
    }
}

__device__ __forceinline__ void ret_phase(const Params& p, unsigned char* shm, float* rssq) {
    const int tid = otid(), wid = tid >> 6, lane = tid & 63, fr = lane & 15, fq = lane >> 4;
    const bf16_t* ret = (const bf16_t*)(p.ws + OFF_BIG);
    bf16_t* ao = (bf16_t*)(p.ws + OFF_OA);
    constexpr int QS = 264, TS = 72;
    bf16_t* Qs = (bf16_t*)shm; bf16_t* Ks = Qs + 64 * QS; bf16_t* KTs = Ks + 64 * QS; bf16_t* VTs = KTs + 256 * TS; bf16_t* Ss = VTs + 64 * TS; bf16_t* RTs = Ss + 64 * TS;
    const int c = obid(); const int xcd = c & 7, jj = c >> 3;
    const int bh = xcd * 4 + (jj >> 3), sl = jj & 7;
    const int b = bh >> 3, h = bh & 7;
    const float lg = logf(1.0f - exp2f(-5.0f - (float)h));
    const float cdec = __expf(lg * 64.0f);
    const float kdec = __expf(lg * (float)(63 - lane));
    const int mi = wid >> 1, ni0 = 2 * (wid & 1);
    const float qdec = __expf(lg * (float)(16 * mi + fr + 1));
    float idec[2][4];
#pragma unroll
    for (int t = 0; t < 2; ++t)
#pragma unroll
        for (int j = 0; j < 4; ++j) { const int n = 16 * mi + fr, m = 16 * (ni0 + t) + 4 * fq + j; idec[t][j] = __expf(lg * fabsf((float)(n - m))); }
    f32x4 R[4][2];
#pragma unroll
    for (int a = 0; a < 4; ++a)
#pragma unroll
        for (int d = 0; d < 2; ++d) R[a][d] = (f32x4){0.f, 0.f, 0.f, 0.f};
    const size_t tokb = (size_t)b * S_;
    const bf16_t* qsrc = ret + (tokb + lane) * 12288 + h * 256 + wid * 32;
    const bf16_t* ksrc = qsrc + 2048;
    const bf16_t* vsrc = ret + (tokb + lane) * 12288 + 4096 + h * 512 + sl * 64 + wid * 8;
    u32x4 pq[4], pk[4], pv;
#pragma unroll
    for (int j = 0; j < 4; ++j) { pq[j] = *(const u32x4*)(qsrc + j * 8); pk[j] = *(const u32x4*)(ksrc + j * 8); }
    pv = *(const u32x4*)vsrc;
    for (int ch = 0; ch < 64; ++ch) {
        __syncthreads();
#pragma unroll
        for (int j = 0; j < 4; ++j) {
            *(u32x4*)(Qs + lane * QS + wid * 32 + j * 8) = pq[j];
            *(u32x4*)(Ks + lane * QS + wid * 32 + j * 8) = pk[j];
            const unsigned kw[4] = {pk[j].x, pk[j].y, pk[j].z, pk[j].w};
#pragma unroll
            for (int i = 0; i < 4; ++i) {
                KTs[(wid * 32 + j * 8 + 2 * i) * TS + lane] = f2bf(bflo(kw[i]) * kdec);
                KTs[(wid * 32 + j * 8 + 2 * i + 1) * TS + lane] = f2bf(bfhi(kw[i]) * kdec);
            }
        }
        { const unsigned vw[4] = {pv.x, pv.y, pv.z, pv.w};
#pragma unroll
          for (int i = 0; i < 4; ++i) { VTs[(wid * 8 + 2 * i) * TS + lane] = (bf16_t)(vw[i] & 0xffffu); VTs[(wid * 8 + 2 * i + 1) * TS + lane] = (bf16_t)(vw[i] >> 16); } }
#pragma unroll
        for (int ei = 0; ei < 4; ++ei)
#pragma unroll
            for (int di = 0; di < 2; ++di) { u32x2 w; w.x = cvt_pk_bf16(R[ei][di][0], R[ei][di][1]); w.y = cvt_pk_bf16(R[ei][di][2], R[ei][di][3]);
                *(u32x2*)(RTs + (16 * ei + fr) * QS + wid * 32 + 16 * di + 4 * fq) = w; }
        if (ch + 1 < 64) {
            const size_t adv = (size_t)(ch + 1) * 64 * 12288;
#pragma unroll
            for (int j = 0; j < 4; ++j) { pq[j] = *(const u32x4*)(qsrc + adv + j * 8); pk[j] = *(const u32x4*)(ksrc + adv + j * 8); }
            pv = *(const u32x4*)(vsrc + adv);
        }
        __syncthreads();
        {
            f32x4 sacc[2] = {{0.f, 0.f, 0.f, 0.f}, {0.f, 0.f, 0.f, 0.f}};
#pragma unroll
            for (int ks = 0; ks < 8; ++ks) {
                const bf16x8 af = *(const bf16x8*)(Qs + (16 * mi + fr) * QS + ks * 32 + fq * 8);
#pragma unroll
                for (int t = 0; t < 2; ++t) { const bf16x8 bf = *(const bf16x8*)(Ks + (16 * (ni0 + t) + fr) * QS + ks * 32 + fq * 8);
                    sacc[t] = __builtin_amdgcn_mfma_f32_16x16x32_bf16(bf, af, sacc[t], 0, 0, 0); }
            }
#pragma unroll
            for (int t = 0; t < 2; ++t) { u32x2 w; w.x = cvt_pk_bf16(sacc[t][0] * idec[t][0], sacc[t][1] * idec[t][1]); w.y = cvt_pk_bf16(sacc[t][2] * idec[t][2], sacc[t][3] * idec[t][3]);
                *(u32x2*)(Ss + (16 * mi + fr) * TS + 16 * (ni0 + t) + 4 * fq) = w; }
        }
        __syncthreads();
        {
            f32x4 oi[2] = {{0.f, 0.f, 0.f, 0.f}, {0.f, 0.f, 0.f, 0.f}}, oc[2] = {{0.f, 0.f, 0.f, 0.f}, {0.f, 0.f, 0.f, 0.f}};
#pragma unroll
            for (int ks = 0; ks < 2; ++ks) {
                const bf16x8 af = *(const bf16x8*)(Ss + (16 * mi + fr) * TS + ks * 32 + fq * 8);
#pragma unroll
                for (int t = 0; t < 2; ++t) { const bf16x8 bf = *(const bf16x8*)(VTs + (16 * (ni0 + t) + fr) * TS + ks * 32 + fq * 8);
                    oi[t] = __builtin_amdgcn_mfma_f32_16x16x32_bf16(bf, af, oi[t], 0, 0, 0); }
            }
#pragma unroll
            for (int ks = 0; ks < 8; ++ks) {
                const bf16x8 af = *(const bf16x8*)(Qs + (16 * mi + fr) * QS + ks * 32 + fq * 8);
#pragma unroll
                for (int t = 0; t < 2; ++t) { const bf16x8 bf = *(const bf16x8*)(RTs + (16 * (ni0 + t) + fr) * QS + ks * 32 + fq * 8);
                    oc[t] = __builtin_amdgcn_mfma_f32_16x16x32_bf16(bf, af, oc[t], 0, 0, 0); }
            }
            const size_t tok = tokb + (size_t)ch * 64 + 16 * mi + fr;
            float sq = 0.f;
#pragma unroll
            for (int t = 0; t < 2; ++t) {
                const int e = sl * 64 + 16 * (ni0 + t) + 4 * fq;
                const u32x2 gw = *(const u32x2*)(ret + tok * 12288 + 8192 + h * 512 + e);
                f32x4 ov = oi[t] + oc[t] * qdec;
                sq += ov[0] * ov[0] + ov[1] * ov[1] + ov[2] * ov[2] + ov[3] * ov[3];
                u32x2 w; w.x = cvt_pk_bf16(ov[0] * bflo(gw.x), ov[1] * bfhi(gw.x)); w.y = cvt_pk_bf16(ov[2] * bflo(gw.y), ov[3] * bfhi(gw.y));
                *(u32x2*)(ao + tok * 4096 + h * 512 + e) = w;
            }
            sq += __shfl_xor(sq, 16); sq += __shfl_xor(sq, 32);
            if (fq == 0) atomicAdd(rssq + (size_t)(sl * 4 + mi) * 0 + (size_t)sl * (T_ * 8) + tok * 8 + h, sq);
        }
#pragma unroll
        for (int ei = 0; ei < 4; ++ei)
#pragma unroll
            for (int di = 0; di < 2; ++di) R[ei][di] *= cdec;
#pragma unroll
        for (int ks = 0; ks < 2; ++ks) {
            bf16x8 bfk[2];
#pragma unroll
            for (int di = 0; di < 2; ++di) bfk[di] = *(const bf16x8*)(KTs + (wid * 32 + 16 * di + fr) * TS + ks * 32 + fq * 8);
#pragma unroll
            for (int ei = 0; ei < 4; ++ei) { const bf16x8 af = *(const bf16x8*)(VTs + (16 * ei + fr) * TS + ks * 32 + fq * 8);
#pragma unroll
                for (int di = 0; di < 2; ++di) R[ei][di] = __builtin_amdgcn_mfma_f32_16x16x32_bf16(bfk[di], af, R[ei][di], 0, 0, 0); }
        }
    }
}

__device__ __forceinline__ void ret2_phase(const Params& p) {
    bf16_t* ao = (bf16_t*)(p.ws + OFF_OA); const float* rssq = (const float*)(p.ws + OFF_RSQP);
    const size_t nvec = (size_t)T_ * 4096 / 8;
    for (size_t i = (size_t)obid() * 512 + otid(); i < nvec; i += (size_t)gridDim.x * 512) {
        const size_t t = i >> 9; const int hh = (int)((i & 511) >> 6);
        float rsum = 0.f;
#pragma unroll
        for (int sl = 0; sl < 8; ++sl) rsum += rssq[(size_t)sl * (T_ * 8) + t * 8 + hh];
        const float rs = rsqrtf(rsum * (1.0f / 512.0f) + EPS_);
        u32x4 w = *(u32x4*)(ao + i * 8);
        w.x = cvt_pk_bf16(bflo(w.x) * rs, bfhi(w.x) * rs); w.y = cvt_pk_bf16(bflo(w.y) * rs, bfhi(w.y) * rs);
        w.z = cvt_pk_bf16(bflo(w.z) * rs, bfhi(w.z) * rs); w.w = cvt_pk_bf16(bflo(w.w) * rs, bfhi(w.w) * rs);
        *(u32x4*)(ao + i * 8) = w;
    }
}

__device__ __forceinline__ void final_phase(const Params& p) {
    const float* ss = (const float*)(p.ws + OFF_SSP) + (size_t)8 * 32 * T_;
    const int tid = otid();
    const f32x4 g = *(const f32x4*)(p.norm_final + tid * 4);
    for (int row = obid(); row < T_; row += gridDim.x) {
        float ssum = ss[(size_t)(tid & 31) * T_ + row];
#pragma unroll
        for (int o = 16; o > 0; o >>= 1) ssum += __shfl_xor(ssum, o);
        const float rs = rsqrtf(ssum * (1.0f / D_) + EPS_);
        f32x4 v = *(f32x4*)(p.out + (size_t)row * D_ + tid * 4);
        v = v * rs * g;
        *(f32x4*)(p.out + (size_t)row * D_ + tid * 4) = v;
    }
}

enum { OP_PREP = 0, OP_A_IN, OP_ATTN, OP_A_OUT, OP_S5A, OP_S5C, OP_GLU, OP_C_IN, OP_RET, OP_RET2, OP_C_OUT, OP_W1, OP_W2, OP_FINAL };
#ifndef PHMASK
#define PHMASK 0xffff
#endif
#define PHON(b) ((PHMASK >> (b)) & 1)
constexpr int NPH = 23;
__device__ const unsigned char PROG_OP[NPH] = { OP_PREP,
    OP_A_IN, OP_ATTN, OP_A_OUT, OP_W1, OP_W2,
    OP_S5A, OP_S5C, OP_GLU, OP_W1, OP_W2,
    OP_C_IN, OP_RET, OP_RET2, OP_C_OUT, OP_W1, OP_W2,
    OP_A_IN, OP_ATTN, OP_A_OUT, OP_W1, OP_W2,
    OP_FINAL };
__device__ const unsigned char PROG_LAYER[NPH] = { 0, 0, 0, 0, 0, 0, 1, 1, 1, 1, 1, 2, 2, 2, 2, 2, 2, 3, 3, 3, 3, 3, 3 };

struct GemmDesc { unsigned long long a_off, b_off; int N, K, ss_idx, mode; };
#define GD_NONE {0, 0, 0, 0, 0, 0}
#define GD_A_IN(L)  {OFF_XB, OFF_WT_A_IN + (L / 3) * SZ_A_IN, 6144, 2048, 2 * L, 0}
#define GD_A_OUT(L) {OFF_OA, OFF_WT_A_OUT + (L / 3) * SZ_A_OUT, 2048, 2048, 2 * L + 1, 0}
#define GD_W1(L)    {OFF_XB, OFF_WT_W1 + L * SZ_W1, 8192, 2048, 2 * L + 1, 1}
#define GD_W2(L)    {OFF_BIG, OFF_WT_W2 + L * SZ_W1, 2048, 8192, 2 * L + 2, 0}
#define GD_GLU(L)   {OFF_OA, OFF_WT_GLU, 4096, 2048, 2 * L + 1, 1}
#define GD_C_IN(L)  {OFF_XB, OFF_WT_C_IN, 12288, 2048, 2 * L, 2}
#define GD_C_OUT(L) {OFF_OA, OFF_WT_C_OUT, 2048, 4096, 2 * L + 1, 0}
__device__ const GemmDesc GD[NPH] = { GD_NONE,
    GD_A_IN(0ull), GD_NONE, GD_A_OUT(0ull), GD_W1(0ull), GD_W2(0ull),
    GD_NONE, GD_NONE, GD_GLU(1ull), GD_W1(1ull), GD_W2(1ull),
    GD_C_IN(2ull), GD_NONE, GD_NONE, GD_C_OUT(2ull), GD_W1(2ull), GD_W2(2ull),
    GD_A_IN(3ull), GD_NONE, GD_A_OUT(3ull), GD_W1(3ull), GD_W2(3ull),
    GD_NONE };

__device__ __forceinline__ void gsync(cg::grid_group& grid) {
    asm volatile("s_waitcnt vmcnt(0) lgkmcnt(0)" ::: "memory");
    grid.sync();
    __builtin_amdgcn_fence(__ATOMIC_ACQUIRE, "agent");
    asm volatile("s_waitcnt vmcnt(0) lgkmcnt(0)" ::: "memory");
}

__global__ void __launch_bounds__(512, 2) fwd_megakernel(Params p, int ph_lo, int ph_hi) {
    extern __shared__ __attribute__((aligned(16))) unsigned char shm[];
    cg::grid_group grid = cg::this_grid();
#ifndef DUPMASK
#define DUPMASK 0
#endif
    if (PHON(0) && ph_lo == 0) {
#pragma unroll 1
        for (int rp_ = 0; rp_ < ((DUPMASK & 1) ? 2 : 1); ++rp_) { prep_phase(p, shm); if (ph_hi > 1) gsync(grid); } }
    for (int ph = (ph_lo < 1 ? 1 : ph_lo); ph < ph_hi; ++ph) {
        const int op = PROG_OP[ph], L = PROG_LAYER[ph];
        const int nrep_ = ((DUPMASK >> op) & 1) ? 2 : 1;
#pragma unroll 1
        for (int rp_ = 0; rp_ < nrep_; ++rp_) {
        unsigned char* ws = p.ws; asm volatile("" : "+s"(ws));
        float* ssb = (float*)(ws + OFF_SSP);
        if (PHON(1) && (op == OP_A_IN || op == OP_C_IN || op == OP_W1)) {
            const GemmDesc gd = GD[ph];
            pg8::Gemm g; g.A = (const bf16_t*)(ws + gd.a_off); g.Bt = (const bf16_t*)(ws + gd.b_off); g.M = T_; g.N = gd.N; g.K = gd.K;
            pg8::EpiBf E; E.rot = (const f32x2*)(ws + OFF_ROT); E.O = (bf16_t*)(ws + OFF_BIG); E.ldc = gd.N; E.mode = gd.mode; E.ss = ssb + (size_t)gd.ss_idx * 32 * T_;
            pg8::StaticOrder S; S.init(g.M, g.N, (int)gridDim.x, obid());
            pg8::gemm_phase<pg8::EpiBf, pg8::StaticOrder>((LAS unsigned char*)shm, g, S, E);
        } else if (PHON(2) && (op == OP_A_OUT || op == OP_GLU || op == OP_C_OUT || op == OP_W2)) {
            const GemmDesc gd = GD[ph];
            pg8::Gemm g; g.A = (const bf16_t*)(ws + gd.a_off); g.Bt = (const bf16_t*)(ws + gd.b_off); g.M = T_; g.N = gd.N; g.K = gd.K;
            pg8::EpiRes E; E.xout = p.out; E.xb = (bf16_t*)(ws + OFF_XB); E.glu = gd.mode; E.xin = (ph == 3) ? p.x : (const float*)p.out; E.ssn = ssb + (size_t)gd.ss_idx * 32 * T_;
            pg8::StaticOrder S; S.init(g.M, g.N, (int)gridDim.x, obid());
            pg8::gemm_phase<pg8::EpiRes, pg8::StaticOrder>((LAS unsigned char*)shm, g, S, E);
        } else if (PHON(3) && op == OP_ATTN) {
            const float li = 0.8f - 0.6f * expf(-0.3f * (float)L);
            attn_phase(p, L / 3, li, shm);
        } else if (PHON(4) && op == OP_S5A) {
            s5_phase<false>(p, shm);
        } else if (PHON(5) && op == OP_S5C) {
            s5_phase<true>(p, shm);
        } else if (PHON(6) && op == OP_RET) {
            ret_phase(p, shm, (float*)(ws + (rp_ == 0 ? OFF_RSQP : OFF_XB)));
        } else if (PHON(7) && op == OP_RET2) {
            ret2_phase(p);
        } else if (PHON(8) && op == OP_FINAL) {
            final_phase(p);
        }
        if (ph + 1 < ph_hi || rp_ + 1 < nrep_) gsync(grid);
        }
    }
}

extern "C" void kernel_launch(void* const* d_in, const int* in_sizes, int n_in, void* d_out, int out_size, void* d_ws, size_t ws_size, hipStream_t stream) {
    static int grid_blocks = 0;
    if (grid_blocks == 0) {
        if (n_in != 21 || out_size != T_ * D_ || ws_size < WS_NEED) { fprintf(stderr, "kernel_launch: unexpected shapes n_in %d out %d ws %zu (need %zu)\n", n_in, out_size, ws_size, (size_t)WS_NEED); grid_blocks = -1; return; }
        int dev = 0, cus = 0, per_cu = 0;
        hipGetDevice(&dev);
        hipDeviceGetAttribute(&cus, hipDeviceAttributeMultiprocessorCount, dev);
        if (hipFuncSetAttribute((const void*)fwd_megakernel, hipFuncAttributeMaxDynamicSharedMemorySize, LDS_BYTES) != hipSuccess) { fprintf(stderr, "kernel_launch: hipFuncSetAttribute failed\n"); grid_blocks = -1; return; }
        hipOccupancyMaxActiveBlocksPerMultiprocessor(&per_cu, (const void*)fwd_megakernel, 512, LDS_BYTES);
        (void)hipGetLastError();
        if (per_cu < 1) per_cu = 1;
        grid_blocks = cus * 1;
        if (grid_blocks != 256) fprintf(stderr, "kernel_launch: note: %d CUs (kernel tuned for 256)\n", cus);
    }
    if (grid_blocks < 0) return;
    Params p{};
    const float** pp = (const float**)&p;
    for (int i = 0; i < 21; ++i) pp[i] = (const float*)d_in[i];
    p.out = (float*)d_out; p.ws = (unsigned char*)d_ws;
#ifndef DBG_LO
#define DBG_LO 0
#endif
#ifndef DBG_HI
#define DBG_HI NPH
#endif
    int lo = DBG_LO, hi = DBG_HI;
    void* args[] = {&p, &lo, &hi};
    hipError_t e = hipLaunchCooperativeKernel((const void*)fwd_megakernel, dim3(grid_blocks), dim3(512), args, LDS_BYTES, stream);
    if (e != hipSuccess) fprintf(stderr, "cooperative launch failed: %s (grid %d)\n", hipGetErrorString(e), grid_blocks);
}
```

```cpp
#include <hip/hip_runtime.h>
#include <hip/hip_cooperative_groups.h>
#include <cstdio>
#include <cstdint>
namespace cg = cooperative_groups;

#define LAS __attribute__((address_space(3)))
typedef unsigned short bf16_t;
typedef short bf16x8 __attribute__((ext_vector_type(8)));
typedef short s16x4 __attribute__((ext_vector_type(4)));
typedef float f32x4 __attribute__((ext_vector_type(4)));
typedef float f32x2 __attribute__((ext_vector_type(2)));
typedef float f32x16 __attribute__((ext_vector_type(16)));
typedef unsigned u32x4 __attribute__((ext_vector_type(4)));
typedef unsigned u32x2 __attribute__((ext_vector_type(2)));

constexpr int T_ = 16384, D_ = 2048, S_ = 4096;
constexpr float EPS_ = 1e-6f;
constexpr int LDS_BYTES = 156672;

constexpr size_t SZ_A_IN = 6144ull * 2048 * 2, SZ_A_OUT = 2048ull * 2048 * 2, SZ_W1 = 8192ull * 2048 * 2;
constexpr size_t OFF_WT_A_IN = 0;
constexpr size_t OFF_WT_A_OUT = OFF_WT_A_IN + 2 * SZ_A_IN;
constexpr size_t OFF_WT_GLU = OFF_WT_A_OUT + 2 * SZ_A_OUT;
constexpr size_t OFF_WT_C_IN = OFF_WT_GLU + 4096ull * 2048 * 2;
constexpr size_t OFF_WT_C_OUT = OFF_WT_C_IN + 12288ull * 2048 * 2;
constexpr size_t OFF_WT_W1 = OFF_WT_C_OUT + 2048ull * 4096 * 2;
constexpr size_t OFF_WT_W2 = OFF_WT_W1 + 4 * SZ_W1;
constexpr size_t OFF_XB = OFF_WT_W2 + 4 * SZ_W1;
constexpr size_t OFF_BIG = OFF_XB + (size_t)T_ * D_ * 2;
constexpr size_t OFF_OA = OFF_BIG + (size_t)T_ * 12288 * 2;
constexpr size_t OFF_SS = OFF_OA + (size_t)T_ * 4096 * 2;
constexpr size_t OFF_RSSQ = OFF_SS + 9ull * T_ * 4;
constexpr size_t OFF_ROT = OFF_RSSQ + (size_t)T_ * 8 * 4;
constexpr size_t OFF_S5B = OFF_ROT + 4096ull * 128 * 8;
constexpr size_t OFF_S5C = OFF_S5B + 128ull * 128 * 16 * 2;
constexpr size_t OFF_S5AB = OFF_S5C + 128ull * 16 * 128 * 2;
constexpr size_t WS_END = OFF_S5AB + 128ull * 64 * 8;
constexpr size_t OFF_SSP = WS_END;
constexpr size_t OFF_RSQP = OFF_SSP + 9ull * 32 * T_ * 4;
constexpr size_t OFF_RSFIN = OFF_RSQP + 8ull * T_ * 8 * 4;
constexpr size_t OFF_BAR = OFF_RSFIN + (size_t)T_ * 4;
constexpr size_t WS_NEED = OFF_BAR + 256;
constexpr size_t OFF_ATT_SCR = OFF_BIG + (size_t)T_ * 6144 * 2;

struct Params {
    const float* x; const float* norm_mix; const float* norm_mlp; const float* norm_final;
    const float* a_w_in; const float* a_lambda; const float* a_subln; const float* a_w_out;
    const float* b_a_re; const float* b_a_im; const float* b_log_dt; const float* b_b_re; const float* b_b_im;
    const float* b_c_re; const float* b_c_im; const float* b_d; const float* b_w_glu;
    const float* c_w_in; const float* c_w_out; const float* mlp_w1; const float* mlp_w2;
    float* out; unsigned char* ws;
};

__device__ __forceinline__ unsigned cvt_pk_bf16(float lo, float hi) { unsigned r; asm volatile("v_cvt_pk_bf16_f32 %0, %1, %2" : "=v"(r) : "v"(lo), "v"(hi)); return r; }
__device__ __forceinline__ float bf2f(unsigned short b) { return __uint_as_float(((unsigned)b) << 16); }
__device__ __forceinline__ float bflo(unsigned w) { return __uint_as_float(w << 16); }
__device__ __forceinline__ float bfhi(unsigned w) { return __uint_as_float(w & 0xffff0000u); }
__device__ __forceinline__ unsigned short f2bf(float f) { return (unsigned short)(cvt_pk_bf16(f, 0.f) & 0xffffu); }

__device__ __forceinline__ int otid() { int t = threadIdx.x; asm volatile("" : "+v"(t)); return t; }
__device__ __forceinline__ int obid() { int t = blockIdx.x; asm volatile("" : "+s"(t)); return t; }

namespace pg8 {
constexpr int BM = 256, BK = 64, HALF = 128, HTB = HALF * BK * 2, STAGE_BYTES = 8 * HTB, NXCD = 8, WGM = 8;
__device__ __forceinline__ int lds_byte(int r, int c) { const int st = (r >> 4) * 2 + (c >> 5), rr = r & 15, cc = c & 31, ob = rr * 64 + cc * 2; return st * 1024 + (ob ^ (((ob >> 9) & 1) << 5)); }
__device__ __forceinline__ void stage_rc(int b, int& R, int& C) { const int st = b / 1024, sb = b % 1024, swz = sb ^ (((sb >> 9) & 1) << 5); R = (st >> 1) * 16 + swz / 64; C = (st & 1) * 32 + (swz % 64) / 2; }
struct Unit { int pm, pn; };
struct Gemm { const bf16_t* A; const bf16_t* Bt; int M, N, K; };
struct StaticOrder {
    int nM, nN, nwg, G, c;
    __device__ void init(int M, int N, int G_, int c_) { nM = M / BM; nN = N / BM; nwg = nM * nN; G = G_; c = c_; }
    __device__ bool next(int i, Unit& u) const {
        const long L = (long)i * G + c; if (L >= nwg) return false;
        int wgid = (int)L; { const int q = nwg / NXCD, r = nwg % NXCD, xcd = wgid % NXCD, off = wgid / NXCD; wgid = (xcd < r ? xcd * (q + 1) : r * (q + 1) + (xcd - r) * q) + off; }
        const int nig = WGM * nN, gid = wgid / nig, fm = gid * WGM, gsz = (nM - fm) < WGM ? (nM - fm) : WGM;
        u.pm = fm + ((wgid % nig) % gsz); u.pn = (wgid % nig) / gsz; return true;
    }
};

#define GAS __attribute__((address_space(1)))
struct EpiBf {
    bf16_t* O; int ldc; const float* ss; int mode; const f32x2* rot;
    __device__ __forceinline__ void operator()(const f32x4 (&acc)[2][2][4][2], const Unit& u, int wr, int wc, int fr, int fq) const {
        const int row0 = u.pm * BM + wr * 64 + fr, colt = u.pn * BM + wc * 32 + 8 * fq;
        int sub = 0;
        if (mode == 1) sub = 1;
        else if (mode == 2) { sub = u.pn < 8 ? 2 : (u.pn < 16 ? 3 : (u.pn < 32 ? 0 : 4)); }
        const GAS float* ssg = (const GAS float*)ss + (size_t)(fq * 8) * T_ + row0;
        float rs8[8];
#pragma unroll
        for (int r = 0; r < 8; ++r) { float a = 0.f;
#pragma unroll
            for (int sl = 0; sl < 8; ++sl) a += ssg[(size_t)sl * T_ + (r >> 2) * HALF + (r & 3) * 16];
            rs8[r] = a; }
#pragma unroll
        for (int r = 0; r < 8; ++r) { float a = rs8[r]; a += __shfl_xor(a, 16); a += __shfl_xor(a, 32); rs8[r] = rsqrtf(a * (1.0f / D_) + EPS_); }
        GAS bf16_t* Og = (GAS bf16_t*)O;
        if (sub == 2 || sub == 3) {
            const GAS f32x2* rotg = (const GAS f32x2*)rot + wc * 32 + 8 * fq;
#pragma unroll
            for (int ai = 0; ai < 2; ++ai) {
                f32x2 cs[4][2][4];
#pragma unroll
                for (int m = 0; m < 4; ++m) { const int row = row0 + ai * HALF + m * 16; const GAS f32x2* rp = rotg + (size_t)(row & (S_ - 1)) * 128;
#pragma unroll
                    for (int n = 0; n < 2; ++n)
#pragma unroll
                        for (int j = 0; j < 4; ++j) cs[m][n][j] = rp[n * 4 + j]; }
#pragma unroll
                for (int m = 0; m < 4; ++m) { const int row = row0 + ai * HALF + m * 16;
                    const float ksc = (sub == 3) ? 0.0625f * rs8[ai * 4 + m] : rs8[ai * 4 + m];
                    GAS bf16_t* rowp = Og + (size_t)row * ldc + colt;
                    u32x4 w1, w2;
#pragma unroll
                    for (int n = 0; n < 2; ++n) {
                        const f32x4 t1 = acc[ai][0][m][n] * ksc, t2 = acc[ai][1][m][n] * ksc;
                        f32x4 o1, o2;
#pragma unroll
                        for (int j = 0; j < 4; ++j) { const f32x2 c2 = cs[m][n][j]; o1[j] = t1[j] * c2.x - t2[j] * c2.y; o2[j] = t1[j] * c2.y + t2[j] * c2.x; }
                        w1[2 * n] = cvt_pk_bf16(o1[0], o1[1]); w1[2 * n + 1] = cvt_pk_bf16(o1[2], o1[3]); w2[2 * n] = cvt_pk_bf16(o2[0], o2[1]); w2[2 * n + 1] = cvt_pk_bf16(o2[2], o2[3]);
                    }
                    *(GAS u32x4*)(rowp) = w1; *(GAS u32x4*)(rowp + HALF) = w2;
                }
            }
        } else {
#pragma unroll
            for (int ai = 0; ai < 2; ++ai)
#pragma unroll
                for (int m = 0; m < 4; ++m) {
                    const int row = row0 + ai * HALF + m * 16;
                    const float rs = rs8[ai * 4 + m];
                    GAS bf16_t* rowp = Og + (size_t)row * ldc + colt;
#pragma unroll
                    for (int bj = 0; bj < 2; ++bj) {
                        u32x4 w;
#pragma unroll
                        for (int n = 0; n < 2; ++n) {
                            f32x4 v = acc[ai][bj][m][n] * rs;
                            if (sub == 1) {
#pragma unroll
                                for (int j = 0; j < 4; ++j) { const float r = fmaxf(v[j], 0.f); v[j] = r * r; }
                            } else if (sub == 4) {
#pragma unroll
                                for (int j = 0; j < 4; ++j) v[j] = v[j] / (1.0f + __expf(-v[j]));
                            }
                            w[2 * n] = cvt_pk_bf16(v[0], v[1]); w[2 * n + 1] = cvt_pk_bf16(v[2], v[3]);
                        }
                        *(GAS u32x4*)(rowp + bj * HALF) = w;
                    }
                }
        }
    }
};
struct EpiRes {
    const float* xin; float* xout; bf16_t* xb; float* ssn; int glu;
    __device__ __forceinline__ void operator()(const f32x4 (&acc)[2][2][4][2], const Unit& u, int wr, int wc, int fr, int fq) const {
        const int row0 = u.pm * BM + wr * 64 + fr;
        const GAS float* xi = (const GAS float*)xin; GAS float* xo = (GAS float*)xout; GAS bf16_t* xbg = (GAS bf16_t*)xb; GAS float* ssg = (GAS float*)ssn;
        if (glu) {
            const size_t cb = (size_t)u.pn * HALF + wc * 32 + 8 * fq;
#pragma unroll
            for (int ai = 0; ai < 2; ++ai) {
                f32x4 xv[4][2];
#pragma unroll
                for (int m = 0; m < 4; ++m)
#pragma unroll
                    for (int n = 0; n < 2; ++n) xv[m][n] = *(const GAS f32x4*)(xi + (size_t)(row0 + ai * HALF + m * 16) * D_ + cb + n * 4);
#pragma unroll
                for (int m = 0; m < 4; ++m) {
                    const int row = row0 + ai * HALF + m * 16; const size_t off = (size_t)row * D_ + cb;
                    float sq = 0.f; u32x4 w;
#pragma unroll
                    for (int n = 0; n < 2; ++n) {
                        const f32x4 va = acc[ai][0][m][n], ga = acc[ai][1][m][n];
                        f32x4 x4 = xv[m][n];
#pragma unroll
                        for (int j = 0; j < 4; ++j) { x4[j] += va[j] / (1.0f + __expf(-ga[j])); sq += x4[j] * x4[j]; }
                        *(GAS f32x4*)(xo + off + n * 4) = x4;
                        w[2 * n] = cvt_pk_bf16(x4[0], x4[1]); w[2 * n + 1] = cvt_pk_bf16(x4[2], x4[3]);
                    }
                    *(GAS u32x4*)(xbg + off) = w;
                    sq += __shfl_xor(sq, 16); sq += __shfl_xor(sq, 32);
                    if (fq == 0) atomicAdd((float*)ssn + (size_t)((u.pn >> 1) * 4 + wc) * T_ + row, sq);
                }
            }
        } else {
            const size_t cb = (size_t)u.pn * BM + wc * 32 + 8 * fq;
#pragma unroll
            for (int ai = 0; ai < 2; ++ai) {
                f32x4 xv[4][2][2];
#pragma unroll
                for (int m = 0; m < 4; ++m)
#pragma unroll
                    for (int bj = 0; bj < 2; ++bj)
#pragma unroll
                        for (int n = 0; n < 2; ++n) xv[m][bj][n] = *(const GAS f32x4*)(xi + (size_t)(row0 + ai * HALF + m * 16) * D_ + cb + bj * HALF + n * 4);
#pragma unroll
                for (int m = 0; m < 4; ++m) {
                    const int row = row0 + ai * HALF + m * 16; const size_t off = (size_t)row * D_ + cb;
                    float sq = 0.f;
#pragma unroll
                    for (int bj = 0; bj < 2; ++bj) {
                        u32x4 w;
#pragma unroll
                        for (int n = 0; n < 2; ++n) {
                            f32x4 x4 = xv[m][bj][n] + acc[ai][bj][m][n];
#pragma unroll
                            for (int j = 0; j < 4; ++j) sq += x4[j] * x4[j];
                            *(GAS f32x4*)(xo + off + bj * HALF + n * 4) = x4;
                            w[2 * n] = cvt_pk_bf16(x4[0], x4[1]); w[2 * n + 1] = cvt_pk_bf16(x4[2], x4[3]);
                        }
                        *(GAS u32x4*)(xbg + off + bj * HALF) = w;
                    }
                    sq += __shfl_xor(sq, 16); sq += __shfl_xor(sq, 32);
                    if (fq == 0) ssg[(size_t)(u.pn * 4 + wc) * T_ + row] = sq;
                }
            }
        }
    }
};

template <class Epi, class Sched>
__device__ __forceinline__ void gemm_phase(LAS unsigned char* lds, const Gemm g, const Sched& S, const Epi& E) {
    const int tid = otid(), wid = __builtin_amdgcn_readfirstlane(tid >> 6), lane = tid & 63, wr = wid >> 2, wc = wid & 3, fr = lane & 15, fq = lane >> 4;
    const int K = g.K, nt = K / BK;
    unsigned voffA[2], voffB[2];
#pragma unroll
    for (int i = 0; i < 2; ++i) { int R, C; stage_rc(tid * 16 + i * 8192, R, C); voffA[i] = (unsigned)(R * K + C) * 2u; voffB[i] = voffA[i]; }
    const size_t kstep = (size_t)(BK * 2);
    const size_t hstep = (size_t)HALF * K * 2;
    const size_t tstep = 2 * hstep;
    const unsigned ldsw = (unsigned)wid * 1024u;
    const int aoff = lds_byte(wr * 64 + fr, fq * 8), boff = lds_byte(wc * 32 + fr, fq * 8);
#define PG8_SA(b, h) (((b) * 2 + (h)) * HTB)
#define PG8_SB(b, h) ((4 + (b) * 2 + (h)) * HTB)
#define PG8_STAGE(bufoff, gbase, voff) do { _Pragma("unroll") for (int _i = 0; _i < 2; ++_i) \
        __builtin_amdgcn_global_load_lds((const unsigned*)((const char*)(gbase) + (voff)[_i]), (LAS unsigned*)(lds + (bufoff) + ldsw + _i * 8192), 16, 0, 0); } while (0)
#define PG8_LDA(dst, b, h) do { _Pragma("unroll") for (int m = 0; m < 4; ++m) _Pragma("unroll") for (int k = 0; k < 2; ++k) dst[m][k] = *(const LAS bf16x8*)(lds + PG8_SA(b, h) + aoff + m * 2048 + k * 1024); } while (0)
#define PG8_LDB(dst, b, h) do { _Pragma("unroll") for (int n = 0; n < 2; ++n) _Pragma("unroll") for (int k = 0; k < 2; ++k) dst[n][k] = *(const LAS bf16x8*)(lds + PG8_SB(b, h) + boff + n * 2048 + k * 1024); } while (0)
#define PG8_MMA(ai, bj, At, Bt) do { __builtin_amdgcn_s_setprio(1); _Pragma("unroll") for (int m = 0; m < 4; ++m) _Pragma("unroll") for (int n = 0; n < 2; ++n) _Pragma("unroll") for (int k = 0; k < 2; ++k) \
        acc[ai][bj][m][n] = __builtin_amdgcn_mfma_f32_16x16x32_bf16(Bt[n][k], At[m][k], acc[ai][bj][m][n], 0, 0, 0); __builtin_amdgcn_s_setprio(0); } while (0)
#define PG8_WAIT_V(n) asm volatile("s_waitcnt vmcnt(" #n ")" ::: "memory")
#define PG8_WAIT_L(n) asm volatile("s_waitcnt lgkmcnt(" #n ")" ::: "memory")
#define PG8_BAR __builtin_amdgcn_s_barrier()
#define PG8_SCHED __builtin_amdgcn_sched_barrier(0)
    Unit cur, nxt; int ui = 0;
    if (!S.next(0, cur)) return;
    f32x4 acc[2][2][4][2];
#pragma unroll
    for (int a = 0; a < 2; ++a)
#pragma unroll
        for (int b = 0; b < 2; ++b)
#pragma unroll
            for (int m = 0; m < 4; ++m)
#pragma unroll
                for (int n = 0; n < 2; ++n) acc[a][b][m][n] = (f32x4){0.f, 0.f, 0.f, 0.f};
    bf16x8 At[4][2], B0[2][2], B1[2][2];
    const char* cA = (const char*)g.A + (size_t)cur.pm * tstep; const char* cB = (const char*)g.Bt + (size_t)cur.pn * tstep;
    PG8_STAGE(PG8_SB(0, 0), cB, voffB); PG8_STAGE(PG8_SA(0, 0), cA, voffA); PG8_STAGE(PG8_SB(0, 1), cB + hstep, voffB); PG8_STAGE(PG8_SA(0, 1), cA + hstep, voffA);
    if (wr == 1) PG8_BAR;
    PG8_WAIT_V(4); PG8_BAR;
    PG8_STAGE(PG8_SB(1, 0), cB + kstep, voffB); PG8_STAGE(PG8_SA(1, 0), cA + kstep, voffA); PG8_STAGE(PG8_SB(1, 1), cB + hstep + kstep, voffB);
    PG8_WAIT_V(6); PG8_BAR;
    for (;;) {
        const bool has_next = S.next(ui + 1, nxt);
        const char* nA = has_next ? (const char*)g.A + (size_t)nxt.pm * tstep : cA; const char* nB = has_next ? (const char*)g.Bt + (size_t)nxt.pn * tstep : cB;
        for (int t = 0; t < nt; t += 2) {
            const bool last = (t == nt - 2);
            const char* a1 = cA + (size_t)(t + 1) * kstep;
            const char* a2 = last ? nA : cA + (size_t)(t + 2) * kstep; const char* b2 = last ? nB : cB + (size_t)(t + 2) * kstep;
            const char* a3 = a2 + kstep; const char* b3 = b2 + kstep;
            PG8_LDB(B0, 0, 0); PG8_SCHED; PG8_LDA(At, 0, 0); PG8_STAGE(PG8_SA(1, 1), a1 + hstep, voffA);
            PG8_WAIT_L(8); PG8_BAR; PG8_WAIT_L(0); PG8_MMA(0, 0, At, B0); PG8_BAR; PG8_SCHED;
            PG8_LDB(B1, 0, 1); PG8_STAGE(PG8_SB(0, 0), b2, voffB);
            PG8_BAR; PG8_WAIT_L(0); PG8_MMA(0, 1, At, B1); PG8_BAR;
            PG8_LDA(At, 0, 1); PG8_STAGE(PG8_SA(0, 0), a2, voffA);
            PG8_BAR; PG8_WAIT_L(0); PG8_MMA(1, 0, At, B0); PG8_BAR; PG8_SCHED;
            PG8_STAGE(PG8_SB(0, 1), b2 + hstep, voffB);
            PG8_WAIT_V(6); PG8_BAR; PG8_MMA(1, 1, At, B1); PG8_BAR;
            PG8_LDB(B0, 1, 0); PG8_SCHED; PG8_LDA(At, 1, 0); PG8_STAGE(PG8_SA(0, 1), a2 + hstep, voffA);
            PG8_WAIT_L(8); PG8_BAR; PG8_WAIT_L(0); PG8_MMA(0, 0, At, B0); PG8_BAR; PG8_SCHED;
            PG8_LDB(B1, 1, 1); PG8_STAGE(PG8_SB(1, 0), b3, voffB);
            PG8_BAR; PG8_WAIT_L(0); PG8_MMA(0, 1, At, B1); PG8_BAR;
            PG8_LDA(At, 1, 1); PG8_STAGE(PG8_SA(1, 0), a3, voffA);
            PG8_BAR; PG8_WAIT_L(0); PG8_MMA(1, 0, At, B0); PG8_BAR; PG8_SCHED;
            PG8_STAGE(PG8_SB(1, 1), b3 + hstep, voffB);
            PG8_WAIT_V(6); PG8_BAR; PG8_MMA(1, 1, At, B1); PG8_BAR;
        }
        E(acc, cur, wr, wc, fr, fq);
        if (!has_next) break;
#pragma unroll
        for (int a = 0; a < 2; ++a)
#pragma unroll
            for (int b = 0; b < 2; ++b)
#pragma unroll
                for (int m = 0; m < 4; ++m)
#pragma unroll
                    for (int n = 0; n < 2; ++n) acc[a][b][m][n] = (f32x4){0.f, 0.f, 0.f, 0.f};
        cur = nxt; cA = nA; cB = nB; ++ui;
    }
    PG8_WAIT_V(0);
    if (wr == 0) PG8_BAR;
    PG8_BAR;
#undef PG8_SA
#undef PG8_SB
#undef PG8_STAGE
#undef PG8_LDA
#undef PG8_LDB
#undef PG8_MMA
#undef PG8_WAIT_V
#undef PG8_WAIT_L
#undef PG8_BAR
#undef PG8_SCHED
}
}

namespace att {
constexpr int D = 128, KVBLK = 64, LDK = 6144;
constexpr float SCALE = 0.088388347648318440f;
constexpr float THR = 8.f;
constexpr size_t SHM_V = KVBLK * D * 2, SHM_K = KVBLK * D * 2;
#define KSWZ(row, colB) ((row) * 256 + ((colB) ^ (((row) & 7) << 4)))
#define SBAR() __builtin_amdgcn_sched_barrier(0)
__device__ __forceinline__ int crow(int r, int hi) { return (r & 3) + 8 * (r >> 2) + 4 * hi; }
__device__ __forceinline__ void partialSM(f32x16& p0, f32x16& p1, float& m_reg, float& mn, float& alpha, bool msk) {
    constexpr float C = SCALE * 1.4426950408889634f;
    if (msk) {
#pragma unroll
        for (int r = 0; r < 16; ++r) { p0[r] = -1e30f; p1[r] = -1e30f; }
    }
    float pmax = p0[0];
#pragma unroll
    for (int r = 1; r < 16; ++r) pmax = fmaxf(pmax, p0[r]);
#pragma unroll
    for (int r = 0; r < 16; ++r) pmax = fmaxf(pmax, p1[r]);
    { auto rr = __builtin_amdgcn_permlane32_swap(__float_as_uint(pmax), __float_as_uint(pmax), false, false);
      pmax = fmaxf(__uint_as_float(rr[0]), __uint_as_float(rr[1])); }
    if (__builtin_expect(__all(pmax - m_reg <= THR / SCALE), 1)) { mn = m_reg; alpha = 1.f; }
    else { mn = fmaxf(m_reg, pmax); alpha = __builtin_amdgcn_exp2f((m_reg - mn) * C); m_reg = mn; }
    float mnC = -mn * C;
#pragma unroll
    for (int r = 0; r < 16; ++r) p0[r] = fmaf(p0[r], C, mnC);
#pragma unroll
    for (int r = 0; r < 16; ++r) p1[r] = fmaf(p1[r], C, mnC);
#pragma unroll
    for (int r = 0; r < 16; ++r) p0[r] = __builtin_amdgcn_exp2f(p0[r]);
}
__device__ __forceinline__ void finishSM(f32x16& p0, f32x16& p1, float alpha, float& l_reg, bf16x8& pa0, bf16x8& pa1, bf16x8& pa2, bf16x8& pa3) {
#pragma unroll
    for (int r = 0; r < 16; ++r) p1[r] = __builtin_amdgcn_exp2f(p1[r]);
    float ps = 0;
#pragma unroll
    for (int r = 0; r < 16; ++r) ps += p0[r];
#pragma unroll
    for (int r = 0; r < 16; ++r) ps += p1[r];
    { auto rr = __builtin_amdgcn_permlane32_swap(__float_as_uint(ps), __float_as_uint(ps), false, false);
      ps = __uint_as_float(rr[0]) + __uint_as_float(rr[1]); }
    l_reg = l_reg * alpha + ps;
#define PK4(P, BASE, OUT) do { unsigned a0 = cvt_pk_bf16(P[BASE + 0], P[BASE + 1]), a1 = cvt_pk_bf16(P[BASE + 2], P[BASE + 3]);   \
    unsigned b0 = cvt_pk_bf16(P[BASE + 4], P[BASE + 5]), b1 = cvt_pk_bf16(P[BASE + 6], P[BASE + 7]);                              \
    auto r0 = __builtin_amdgcn_permlane32_swap(a0, b0, false, false); auto r1 = __builtin_amdgcn_permlane32_swap(a1, b1, false, false); \
    u32x4 w = {r0[0], r1[0], r0[1], r1[1]}; OUT = *reinterpret_cast<bf16x8*>(&w); } while (0)
    PK4(p0, 0, pa0); PK4(p0, 8, pa1); PK4(p1, 0, pa2); PK4(p1, 8, pa3);
#undef PK4
}
__device__ __forceinline__ void qkt(f32x16& p0, f32x16& p1, const char* Ks, const bf16x8* qr, int r32, int hi) {
    p0 = f32x16{}; p1 = f32x16{};
#pragma unroll
    for (int d0 = 0; d0 < 8; ++d0) { int cb = (d0 * 16 + hi * 8) * 2;
        bf16x8 b0 = *reinterpret_cast<const bf16x8*>(Ks + KSWZ(r32, cb));
        bf16x8 b1 = *reinterpret_cast<const bf16x8*>(Ks + KSWZ(32 + r32, cb));
        p0 = __builtin_amdgcn_mfma_f32_32x32x16_bf16(b0, qr[d0], p0, 0, 0, 0);
        p1 = __builtin_amdgcn_mfma_f32_32x32x16_bf16(b1, qr[d0], p1, 0, 0, 0); }
}
__device__ __forceinline__ int v_st(int k, int c) { const int kk = (k & ~0xC) | ((k & 4) << 1) | ((k & 8) >> 1); return ((kk >> 3) * 4 + (c >> 5)) * 512 + ((kk & 7) * 32 + (c & 31)) * 2; }
__device__ __forceinline__ int v_rd_base(int lane) { return ((lane & 3) << 3) | (((lane >> 2) & 3) << 6) | (((lane >> 4) & 1) << 5) | (((lane >> 5) & 1) << 8); }
constexpr int v_rd_off(int d0, int ks, int half) { return d0 * 512 + ks * 4096 + half * 2048; }
template <int OFF> __device__ __forceinline__ s16x4 tr_read(int vb) {
    s16x4 r; asm volatile("ds_read_b64_tr_b16 %0, %1 offset:%2" : "=&v"(r) : "v"(vb), "i"(OFF) : "memory"); return r;
}
template <int D0> __device__ __forceinline__ void pv_one(f32x16& od, int vb, bf16x8 pa0, bf16x8 pa1, bf16x8 pa2, bf16x8 pa3) {
    const s16x4 l0 = tr_read<v_rd_off(D0, 0, 0)>(vb), h0 = tr_read<v_rd_off(D0, 0, 1)>(vb), l1 = tr_read<v_rd_off(D0, 1, 0)>(vb), h1 = tr_read<v_rd_off(D0, 1, 1)>(vb);
    const s16x4 l2 = tr_read<v_rd_off(D0, 2, 0)>(vb), h2 = tr_read<v_rd_off(D0, 2, 1)>(vb), l3 = tr_read<v_rd_off(D0, 3, 0)>(vb), h3 = tr_read<v_rd_off(D0, 3, 1)>(vb);
    asm volatile("s_waitcnt lgkmcnt(0)" ::: "memory"); SBAR();
#define PK(L, H) (bf16x8){L[0], L[1], L[2], L[3], H[0], H[1], H[2], H[3]}
    od = __builtin_amdgcn_mfma_f32_32x32x16_bf16(pa0, PK(l0, h0), od, 0, 0, 0);
    od = __builtin_amdgcn_mfma_f32_32x32x16_bf16(pa1, PK(l1, h1), od, 0, 0, 0);
    od = __builtin_amdgcn_mfma_f32_32x32x16_bf16(pa2, PK(l2, h2), od, 0, 0, 0);
    od = __builtin_amdgcn_mfma_f32_32x32x16_bf16(pa3, PK(l3, h3), od, 0, 0, 0);
#undef PK
}
__device__ __forceinline__ void pv_d0(f32x16* o, int vb, bf16x8 pa0, bf16x8 pa1, bf16x8 pa2, bf16x8 pa3) {
    pv_one<0>(o[0], vb, pa0, pa1, pa2, pa3); pv_one<1>(o[1], vb, pa0, pa1, pa2, pa3); pv_one<2>(o[2], vb, pa0, pa1, pa2, pa3); pv_one<3>(o[3], vb, pa0, pa1, pa2, pa3);
}
__device__ __forceinline__ void attn_body(const bf16_t* __restrict__ Qb, const bf16_t* __restrict__ Kh, const bf16_t* __restrict__ Vh, int NT, int ntw, char* lds, f32x16 (&o)[4]) {
    const int tid = otid(), wid = __builtin_amdgcn_readfirstlane(tid >> 6), lane = tid & 63, r32 = lane & 31, hi = lane >> 5;
    char* V_lds = lds; char* K_lds = lds + 2 * SHM_V;
    float* wsf = (float*)(lds + 2 * SHM_V + 2 * SHM_K) + wid * 64; float* li_l = wsf; float* al_l = wsf + 32;
    float m_reg = -1e30f, l_reg = 0; bf16x8 qr[8];
#pragma unroll
    for (int d = 0; d < 4; ++d) o[d] = f32x16{};
    const bf16_t* Qw = Qb + (long)(wid * 32 + r32) * LDK + hi * 8;
#pragma unroll
    for (int d0 = 0; d0 < 8; ++d0) qr[d0] = *reinterpret_cast<const bf16x8*>(Qw + d0 * 16);
    const int sr = tid >> 4, sc = (tid & 15) * 8, vst0 = v_st(sr, sc), vst1 = v_st(32 + sr, sc);
    const int vb0 = (int)(uintptr_t)V_lds + v_rd_base(lane);
    struct { bf16x8 vs0, vs1, ks0, ks1; } sr_[2];
#define SLOAD(i, k0) do { sr_[i].vs0 = *reinterpret_cast<const bf16x8*>(&Vh[(long)((k0) + sr) * LDK + sc]); sr_[i].vs1 = *reinterpret_cast<const bf16x8*>(&Vh[(long)((k0) + 32 + sr) * LDK + sc]); \
    sr_[i].ks0 = *reinterpret_cast<const bf16x8*>(&Kh[(long)((k0) + sr) * LDK + sc]); sr_[i].ks1 = *reinterpret_cast<const bf16x8*>(&Kh[(long)((k0) + 32 + sr) * LDK + sc]); } while (0)
#define SWRITE(b, i) do { *(bf16x8*)(V_lds + (b) * SHM_V + vst0) = sr_[i].vs0;          \
    *(bf16x8*)(V_lds + (b) * SHM_V + vst1) = sr_[i].vs1; int kc = sc * 2;               \
    *(bf16x8*)(K_lds + (b) * SHM_K + KSWZ(sr, kc)) = sr_[i].ks0;                       \
    *(bf16x8*)(K_lds + (b) * SHM_K + KSWZ(32 + sr, kc)) = sr_[i].ks1; } while (0)
#define SWAIT() asm volatile("s_waitcnt vmcnt(4)" ::: "memory")
#define RESC(a) do { if (__any((a) < 1.f)) { if (hi == 0) al_l[r32] = (a); asm volatile("s_waitcnt lgkmcnt(0)" ::: "memory"); \
    _Pragma("unroll") for (int d = 0; d < 4; ++d) _Pragma("unroll") for (int r = 0; r < 16; ++r) o[d][r] *= al_l[crow(r, hi)]; } } while (0)
    f32x16 pA0, pA1, pB0, pB1; float mnA, mnB, alA, alB; bf16x8 pa0, pa1, pa2, pa3;
    constexpr int SE = 0, SO = 1;
    __syncthreads();
    SLOAD(SE, 0); asm volatile("s_waitcnt vmcnt(0)" ::: "memory"); SWRITE(0, SE); __syncthreads();
    qkt(pA0, pA1, K_lds, qr, r32, hi); partialSM(pA0, pA1, m_reg, mnA, alA, false);
    SLOAD(SO, KVBLK); if (2 < NT) SLOAD(SE, 2 * KVBLK);
    SWAIT(); SWRITE(1, SO); __syncthreads();
    for (int j = 1; j + 1 < NT; j += 2) {
        SBAR(); qkt(pB0, pB1, K_lds + SHM_K, qr, r32, hi);
        finishSM(pA0, pA1, alA, l_reg, pa0, pa1, pa2, pa3); SBAR();
        SLOAD(SO, (j + 2) * KVBLK); SBAR();
        pv_d0(o, vb0, pa0, pa1, pa2, pa3); partialSM(pB0, pB1, m_reg, mnB, alB, j >= ntw);
        __syncthreads(); SWAIT(); SWRITE(0, SE);
        RESC(alB); __syncthreads();
        SBAR(); qkt(pA0, pA1, K_lds, qr, r32, hi);
        finishSM(pB0, pB1, alB, l_reg, pa0, pa1, pa2, pa3); SBAR();
        if (j + 3 < NT) SLOAD(SE, (j + 3) * KVBLK); SBAR();
        pv_d0(o, vb0 + (int)SHM_V, pa0, pa1, pa2, pa3); partialSM(pA0, pA1, m_reg, mnA, alA, (j + 1) >= ntw);
        __syncthreads(); SWAIT(); SWRITE(1, SO);
        RESC(alA); __syncthreads();
    }
    SBAR(); qkt(pB0, pB1, K_lds + SHM_K, qr, r32, hi);
    finishSM(pA0, pA1, alA, l_reg, pa0, pa1, pa2, pa3); SBAR();
    pv_d0(o, vb0, pa0, pa1, pa2, pa3); partialSM(pB0, pB1, m_reg, mnB, alB, (NT - 1) >= ntw);
    __syncthreads(); RESC(alB);
    finishSM(pB0, pB1, alB, l_reg, pa0, pa1, pa2, pa3); SBAR();
    pv_d0(o, vb0 + (int)SHM_V, pa0, pa1, pa2, pa3);
    if (hi == 0) li_l[r32] = l_reg; asm volatile("s_waitcnt lgkmcnt(0)" ::: "memory");
#pragma unroll
    for (int r = 0; r < 16; ++r) { const float rl = __builtin_amdgcn_rcpf(li_l[crow(r, hi)]);
#pragma unroll
        for (int d = 0; d < 4; ++d) o[d][r] *= rl; }
#undef SLOAD
#undef SWRITE
#undef SWAIT
#undef RESC
}
}

__device__ __forceinline__ void sincos_red(double ang, float& s, float& c) {
    const double k = rint(ang * 0.15915494309189535);
    const float r = (float)(ang - k * 6.283185307179586);
    s = __sinf(r); c = __cosf(r);
}
__device__ __forceinline__ float gelu_tanh(float y) {
    const float z = 0.7978845608028654f * (y + 0.044715f * y * y * y);
    const float th = 1.0f - 2.0f / (1.0f + __expf(2.0f * z));
    return 0.5f * y * (1.0f + th);
}

struct ConvJob { const float* W; bf16_t* Wt; const float* gain; int K, N, glu, tile; };
struct ConvRegs { f32x4 va[4], vb[4]; float ga[4], gb[4]; };
__device__ __forceinline__ ConvJob conv_decode(const Params& p, unsigned char* ws, int t) {
    ConvJob j; j.glu = 0; j.gain = nullptr;
    if (t < 1536) { const int q = t / 768; j.tile = t - q * 768; j.W = p.a_w_in + (size_t)q * 2048 * 6144; j.Wt = (bf16_t*)(ws + OFF_WT_A_IN + q * SZ_A_IN); j.K = 2048; j.N = 6144; j.gain = p.norm_mix + (size_t)(3 * q) * D_; }
    else if (t < 2048) { const int u = t - 1536; const int q = u / 256; j.tile = u - q * 256; j.W = p.a_w_out + (size_t)q * 2048 * 2048; j.Wt = (bf16_t*)(ws + OFF_WT_A_OUT + q * SZ_A_OUT); j.K = 2048; j.N = 2048; }
    else if (t < 2560) { j.tile = t - 2048; j.W = p.b_w_glu; j.Wt = (bf16_t*)(ws + OFF_WT_GLU); j.K = 2048; j.N = 4096; j.glu = 1; }
    else if (t < 4096) { j.tile = t - 2560; j.W = p.c_w_in; j.Wt = (bf16_t*)(ws + OFF_WT_C_IN); j.K = 2048; j.N = 12288; j.gain = p.norm_mix + 2 * D_; }
    else if (t < 4608) { j.tile = t - 4096; j.W = p.c_w_out; j.Wt = (bf16_t*)(ws + OFF_WT_C_OUT); j.K = 4096; j.N = 2048; }
    else if (t < 8704) { const int u = t - 4608; const int i = u / 1024; j.tile = u - i * 1024; j.W = p.mlp_w1 + (size_t)i * 2048 * 8192; j.Wt = (bf16_t*)(ws + OFF_WT_W1 + i * SZ_W1); j.K = 2048; j.N = 8192; j.gain = p.norm_mlp + (size_t)i * D_; }
    else { const int u = t - 8704; const int i = u / 1024; j.tile = u - i * 1024; j.W = p.mlp_w2 + (size_t)i * 8192 * 2048; j.Wt = (bf16_t*)(ws + OFF_WT_W2 + i * SZ_W1); j.K = 8192; j.N = 2048; }
    return j;
}
__device__ __forceinline__ void conv_load(const ConvJob& j, ConvRegs& r, int tid) {
    const int ntn = j.N >> 7; const int tk = j.tile / ntn, tn = j.tile - tk * ntn; const int k0 = tk << 7, n0 = tn << 7;
    const int kp = tid >> 5, nl = (tid & 31) << 2;
#pragma unroll
    for (int i = 0; i < 4; ++i) { const int k = 2 * (kp + 16 * i);
        r.va[i] = *(const f32x4*)(j.W + (size_t)(k0 + k) * j.N + n0 + nl); r.vb[i] = *(const f32x4*)(j.W + (size_t)(k0 + k + 1) * j.N + n0 + nl);
        r.ga[i] = j.gain ? j.gain[k0 + k] : 1.f; r.gb[i] = j.gain ? j.gain[k0 + k + 1] : 1.f; }
}
__device__ __forceinline__ void conv_store(const ConvJob& j, const ConvRegs& r, int tid, unsigned* ldsw) {
    const int ntn = j.N >> 7; const int tk = j.tile / ntn, tn = j.tile - tk * ntn; const int k0 = tk << 7, n0 = tn << 7;
    const int kp = tid >> 5, nl = (tid & 31) << 2;
    __syncthreads();
#pragma unroll
    for (int i = 0; i < 4; ++i) { const int kpair = kp + 16 * i;
#pragma unroll
        for (int jj = 0; jj < 4; ++jj) ldsw[(nl + jj) * 65 + kpair] = cvt_pk_bf16(r.va[i][jj] * r.ga[i], r.vb[i][jj] * r.gb[i]); }
    __syncthreads();
    int nbase = n0;
    if (j.glu) { const int bj = n0 >> 11, pn = (n0 & 2047) >> 7; nbase = 256 * pn + 128 * bj; }
#pragma unroll
    for (int i = 0; i < 4; ++i) { const int n = (tid >> 4) + 32 * i, k8 = tid & 15;
        u32x4 w; w.x = ldsw[n * 65 + k8 * 4 + 0]; w.y = ldsw[n * 65 + k8 * 4 + 1]; w.z = ldsw[n * 65 + k8 * 4 + 2]; w.w = ldsw[n * 65 + k8 * 4 + 3];
        const int c5 = n & 31, np = (n & ~31) | (16 * ((c5 >> 2) & 1) + 4 * (c5 >> 3) + (c5 & 3));
        *(u32x4*)(j.Wt + (size_t)(nbase + np) * j.K + k0 + k8 * 8) = w; }
}

__device__ __forceinline__ void prep_phase(const Params& p, unsigned char* shm) {
    const int tid = otid(), bid = obid(), G = gridDim.x;
    unsigned char* ws = p.ws;
    {
        ConvJob jc = conv_decode(p, ws, bid); ConvRegs rc; conv_load(jc, rc, tid);
#pragma unroll 1
        for (int t = bid; t < 12800; t += G) {
            ConvJob jn = jc; ConvRegs rn = rc;
            if (t + G < 12800) { jn = conv_decode(p, ws, t + G); conv_load(jn, rn, tid); }
            conv_store(jc, rc, tid, (unsigned*)shm);
            jc = jn; rc = rn;
        }
    }
    {
        float* ss = (float*)(ws + OFF_SSP); bf16_t* xb = (bf16_t*)(ws + OFF_XB);
        const int wid = tid >> 6, lane = tid & 63;
        for (int row = bid * 8 + wid; row < T_; row += G * 8) {
            const float* xr = p.x + (size_t)row * D_; float sq = 0.f;
#pragma unroll
            for (int i = 0; i < 8; ++i) { const f32x4 v = *(const f32x4*)(xr + (i * 64 + lane) * 4);
                sq += v[0] * v[0] + v[1] * v[1] + v[2] * v[2] + v[3] * v[3];
                u32x2 w; w.x = cvt_pk_bf16(v[0], v[1]); w.y = cvt_pk_bf16(v[2], v[3]);
                *(u32x2*)(xb + (size_t)row * D_ + (i * 64 + lane) * 4) = w; }
#pragma unroll
            for (int o = 32; o > 0; o >>= 1) sq += __shfl_xor(sq, o);
            if (lane < 32) ss[(size_t)lane * T_ + row] = (lane == 0) ? sq : 0.f;
        }
        for (int i = bid * 512 + tid; i < 32 * T_; i += G * 512) ss[(size_t)3 * 32 * T_ + i] = 0.f;
        float* rssq = (float*)(ws + OFF_RSQP);
        for (int i = bid * 512 + tid; i < 64 * T_; i += G * 512) rssq[i] = 0.f;
    }
    {
        f32x2* rot = (f32x2*)(ws + OFF_ROT);
        for (int i = bid * 512 + tid; i < 4096 * 128; i += G * 512) {
            const int pos = i >> 7, j = i & 127;
            const double inv = exp(-9.210340371976184 * ((double)j / 127.0));
            float s, c; sincos_red((double)pos * inv, s, c);
            f32x2 v; v.x = c; v.y = s; rot[i] = v;
        }
    }
    {
        bf16_t* Bm = (bf16_t*)(ws + OFF_S5B); bf16_t* Cm = (bf16_t*)(ws + OFF_S5C); f32x2* AB = (f32x2*)(ws + OFF_S5AB);
        const float* gmix = p.norm_mix + 1 * D_;
        for (int i = bid * 512 + tid; i < 128 * 64; i += G * 512) {
            const int g = i >> 6, pp = i & 63;
            const float lre = p.b_a_re[i], lim = p.b_a_im[i];
            const float dt = __expf(p.b_log_dt[g]);
            const float mag = __expf(lre * dt);
            float sn, cs; sincos_red((double)lim * (double)dt, sn, cs);
            const float abr = mag * cs, abi = mag * sn;
            const float den = lre * lre + lim * lim;
            const float nr = abr - 1.0f, ni = abi;
            const float cr_ = (nr * lre + ni * lim) / den, ci_ = (ni * lre - nr * lim) / den;
            f32x2 ab; ab.x = abr; ab.y = abi; AB[i] = ab;
#pragma unroll
            for (int c = 0; c < 16; ++c) {
                const float br = p.b_b_re[(size_t)i * 16 + c], bi = p.b_b_im[(size_t)i * 16 + c];
                const float gm = gmix[g * 16 + c];
                Bm[((size_t)g * 128 + pp) * 16 + c] = f2bf((cr_ * br - ci_ * bi) * gm);
                Bm[((size_t)g * 128 + 64 + pp) * 16 + c] = f2bf((cr_ * bi + ci_ * br) * gm);
                Cm[((size_t)g * 16 + c) * 128 + pp] = f2bf(p.b_c_re[((size_t)g * 16 + c) * 64 + pp]);
                Cm[((size_t)g * 16 + c) * 128 + 64 + pp] = f2bf(-p.b_c_im[((size_t)g * 16 + c) * 64 + pp]);
            }
        }
    }
}

__device__ __forceinline__ void attn_phase(const Params& p, int j, float lambda_init, unsigned char* shm) {
    const int tid = otid(), wid = __builtin_amdgcn_readfirstlane(tid >> 6), lane = tid & 63, r32 = lane & 31, hi = lane >> 5;
    const bf16_t* qkv = (const bf16_t*)(p.ws + OFF_BIG);
    bf16_t* oa = (bf16_t*)(p.ws + OFF_OA);
    float* scr = (float*)(p.ws + OFF_ATT_SCR) + (size_t)obid() * 2 * 32768;
    float lam;
    { const float* lp = p.a_lambda + (size_t)j * 512;
      float a = lp[lane] * lp[128 + lane] + lp[64 + lane] * lp[192 + lane];
      float b = lp[256 + lane] * lp[384 + lane] + lp[320 + lane] * lp[448 + lane];
#pragma unroll
      for (int o = 32; o > 0; o >>= 1) { a += __shfl_xor(a, o); b += __shfl_xor(b, o); }
      lam = __expf(a) - __expf(b) + lambda_init; lam = __uint_as_float(__builtin_amdgcn_readfirstlane(__float_as_uint(lam))); }
    const float* sub = p.a_subln + (size_t)j * 256;
    const int c = obid(); const int xcd = c & 7, jj = c >> 3;
    const int bh = xcd * 4 + (jj >> 3), pi = jj & 7;
    const int b = bh >> 3, h = bh & 7;
#pragma unroll 1
    for (int it = 0; it < 2; ++it) {
        const int qb = it == 0 ? (15 - pi) : pi;
        const int NT = 4 * qb + 4, ntw = 4 * qb + (wid >> 1) + 1;
        const size_t tok0 = (size_t)b * S_ + (size_t)qb * 256;
        f32x16 o[4];
#pragma unroll 1
        for (int ps = 0; ps < 4; ++ps) {
            const int e = ps >> 1, t = ps & 1;
            float* sc = scr + e * 32768;
            att::attn_body(qkv + tok0 * 6144 + h * 256 + t * 128, qkv + (size_t)b * S_ * 6144 + 2048 + h * 256 + t * 128,
                           qkv + (size_t)b * S_ * 6144 + 4096 + h * 256 + e * 128, NT, ntw, (char*)shm, o);
            if (t == 0) {
#pragma unroll
                for (int d = 0; d < 4; ++d)
#pragma unroll
                    for (int r = 0; r < 16; ++r) sc[tid * 64 + d * 16 + r] = o[d][r];
            } else {
#pragma unroll
                for (int d = 0; d < 4; ++d)
#pragma unroll
                    for (int r = 0; r < 16; ++r) { const float cv = sc[tid * 64 + d * 16 + r] - lam * o[d][r]; o[d][r] = cv; if (e == 0) sc[tid * 64 + d * 16 + r] = cv; }
            }
        }
        float ssq[16];
#pragma unroll
        for (int r = 0; r < 16; ++r) { float s = 0.f;
#pragma unroll
            for (int d = 0; d < 4; ++d) { const float c0 = scr[tid * 64 + d * 16 + r]; s += c0 * c0 + o[d][r] * o[d][r]; }
#pragma unroll
            for (int of = 16; of > 0; of >>= 1) s += __shfl_xor(s, of);
            ssq[r] = rsqrtf(s * (1.0f / 256.0f) + EPS_) * (1.0f - lambda_init); }
#pragma unroll
        for (int r = 0; r < 16; ++r) {
            const size_t row = tok0 + wid * 32 + att::crow(r, hi);
            bf16_t* op = oa + row * D_ + h * 256;
#pragma unroll
            for (int d = 0; d < 4; ++d) {
                const int col = d * 32 + r32;
                op[col] = f2bf(scr[tid * 64 + d * 16 + r] * ssq[r] * sub[col]);
                op[128 + col] = f2bf(o[d][r] * ssq[r] * sub[128 + col]);
            }
        }
    }
}

template <bool FINAL>
__device__ __forceinline__ void s5_phase(const Params& p, unsigned char* shm) {
    const int tid = otid(), wid = tid >> 6, lane = tid & 63, r32 = lane & 31, hi = lane >> 5, fr = lane & 15, fq = lane >> 4;
    const bf16_t* xb = (const bf16_t*)(p.ws + OFF_XB);
    const float* ss = (const float*)(p.ws + OFF_SSP) + (size_t)2 * 32 * T_;
    float* rsfin = (float*)(p.ws + OFF_RSFIN);
    const bf16_t* Bm = (const bf16_t*)(p.ws + OFF_S5B); const bf16_t* Cm = (const bf16_t*)(p.ws + OFF_S5C); const f32x2* AB = (const f32x2*)(p.ws + OFF_S5AB);
    f32x2* E = (f32x2*)(p.ws + OFF_BIG);
    bf16_t* gl = (bf16_t*)(p.ws + OFF_OA);
    bf16_t* Xs = (bf16_t*)shm + wid * (32 * 136);
    const float* gmix = p.norm_mix + D_; const float* dsk = p.b_d;
    for (int it = obid(); it < 4096; it += gridDim.x) {
        const int goct = it & 15, chunk = (it >> 4) & 63, b = it >> 10;
        const int g = goct * 8 + wid; const int pp = r32 + 32 * hi;
        const size_t t0 = (size_t)b * S_ + chunk * 64;
        const f32x2 ab = AB[g * 64 + pp];
        bf16x8 bfr[4];
#pragma unroll
        for (int nb = 0; nb < 4; ++nb) bfr[nb] = *(const bf16x8*)(Bm + ((size_t)g * 128 + nb * 32 + r32) * 16 + hi * 8);
        float xr = 0.f, xi = 0.f;
        bf16x8 cfr[4]; float gm4[4], ds4[4];
        if (FINAL) {
            float pr = ab.x, pi_ = ab.y;
#pragma unroll
            for (int s = 0; s < 6; ++s) { const float nr = pr * pr - pi_ * pi_, ni = 2.f * pr * pi_; pr = nr; pi_ = ni; }
            const f32x2* Ep = E + ((size_t)(b * 128 + g) * 64) * 64 + pp;
            for (int c2 = 0; c2 < chunk; ++c2) { const f32x2 e = Ep[(size_t)c2 * 64];
                const float nr = pr * xr - pi_ * xi + e.x, ni = pr * xi + pi_ * xr + e.y; xr = nr; xi = ni; }
#pragma unroll
            for (int ks = 0; ks < 4; ++ks) cfr[ks] = *(const bf16x8*)(Cm + ((size_t)g * 16 + fr) * 128 + ks * 32 + fq * 8);
#pragma unroll
            for (int jx = 0; jx < 4; ++jx) { gm4[jx] = gmix[g * 16 + 4 * fq + jx]; ds4[jx] = dsk[g * 16 + 4 * fq + jx]; }
        }
#pragma unroll
        for (int half = 0; half < 2; ++half) {
            const size_t trow = t0 + half * 32 + r32;
            float rs;
            if (FINAL) rs = rsfin[trow];
            else { float ssum = 0.f;
#pragma unroll 8
                for (int sl = 0; sl < 32; ++sl) ssum += ss[(size_t)sl * T_ + trow];
                rs = rsqrtf(ssum * (1.0f / D_) + EPS_); if (goct == 0 && hi == 0 && wid == 0) rsfin[trow] = rs; }
            const u32x4 raw = *(const u32x4*)(xb + trow * D_ + g * 16 + hi * 8);
            u32x4 sc4;
            sc4.x = cvt_pk_bf16(bflo(raw.x) * rs, bfhi(raw.x) * rs); sc4.y = cvt_pk_bf16(bflo(raw.y) * rs, bfhi(raw.y) * rs);
            sc4.z = cvt_pk_bf16(bflo(raw.z) * rs, bfhi(raw.z) * rs); sc4.w = cvt_pk_bf16(bflo(raw.w) * rs, bfhi(raw.w) * rs);
            const bf16x8 afr = *reinterpret_cast<const bf16x8*>(&sc4);
            f32x16 c0 = __builtin_amdgcn_mfma_f32_32x32x16_bf16(afr, bfr[0], f32x16{}, 0, 0, 0);
            f32x16 c1 = __builtin_amdgcn_mfma_f32_32x32x16_bf16(afr, bfr[1], f32x16{}, 0, 0, 0);
            f32x16 c2 = __builtin_amdgcn_mfma_f32_32x32x16_bf16(afr, bfr[2], f32x16{}, 0, 0, 0);
            f32x16 c3 = __builtin_amdgcn_mfma_f32_32x32x16_bf16(afr, bfr[3], f32x16{}, 0, 0, 0);
#pragma unroll
            for (int i = 0; i < 16; ++i) {
                auto r0 = __builtin_amdgcn_permlane32_swap(__float_as_uint(c0[i]), __float_as_uint(c1[i]), false, false);
                c0[i] = __uint_as_float(r0[0]); c1[i] = __uint_as_float(r0[1]);
                auto r1 = __builtin_amdgcn_permlane32_swap(__float_as_uint(c2[i]), __float_as_uint(c3[i]), false, false);
                c2[i] = __uint_as_float(r1[0]); c3[i] = __uint_as_float(r1[1]);
            }
#pragma unroll
            for (int t = 0; t < 32; ++t) {
                const int q = t >> 3, s = t & 7, idx = 4 * q + (s & 3);
                const float bur = (s < 4) ? c0[idx] : c1[idx], bui = (s < 4) ? c2[idx] : c3[idx];
                const float nr = ab.x * xr - ab.y * xi + bur, ni = ab.x * xi + ab.y * xr + bui;
                xr = nr; xi = ni;
                if (FINAL) { Xs[t * 136 + pp] = f2bf(xr); Xs[t * 136 + 64 + pp] = f2bf(xi); }
            }
            if (FINAL) {
                asm volatile("s_waitcnt lgkmcnt(0)" ::: "memory");
#pragma unroll
                for (int m = 0; m < 2; ++m) {
                    f32x4 acc = {0.f, 0.f, 0.f, 0.f};
#pragma unroll
                    for (int ks = 0; ks < 4; ++ks) {
                        const bf16x8 xf = *(const bf16x8*)(Xs + (m * 16 + fr) * 136 + ks * 32 + fq * 8);
                        acc = __builtin_amdgcn_mfma_f32_16x16x32_bf16(cfr[ks], xf, acc, 0, 0, 0);
                    }
                    const size_t tr2 = t0 + half * 32 + m * 16 + fr;
                    const float rs2 = rsfin[tr2];
                    const u32x2 hx = *(const u32x2*)(xb + tr2 * D_ + g * 16 + 4 * fq);
                    const float h0 = bflo(hx.x) * rs2 * gm4[0], h1 = bfhi(hx.x) * rs2 * gm4[1], h2 = bflo(hx.y) * rs2 * gm4[2], h3 = bfhi(hx.y) * rs2 * gm4[3];
                    const float y0 = gelu_tanh(acc[0] + ds4[0] * h0), y1 = gelu_tanh(acc[1] + ds4[1] * h1), y2 = gelu_tanh(acc[2] + ds4[2] * h2), y3 = gelu_tanh(acc[3] + ds4[3] * h3);
                    u32x2 w; w.x = cvt_pk_bf16(y0, y1); w.y = cvt_pk_bf16(y2, y3);
                    *(u32x2*)(gl + tr2 * D_ + g * 16 + 4 * fq) = w;
                }
                asm volatile("s_waitcnt lgkmcnt(0)" ::: "memory");
            }
        }
        if (!FINAL) { f32x2 e; e.x = xr; e.y = xi; E[((size_t)(b * 128 + g) * 64 + chunk) * 64 + pp] = e; }
    }
}

__device__ __forceinline__ void ret_phase(const Params& p, unsigned char* shm, float* rssq) {
    const int tid = otid(), wid = tid >> 6, lane = tid & 63, fr = lane & 15, fq = lane >> 4;
    const bf16_t* ret = (const bf16_t*)(p.ws + OFF_BIG);
    bf16_t* ao = (bf16_t*)(p.ws + OFF_OA);
    constexpr int QS = 264, TS = 72;
    bf16_t* Qs = (bf16_t*)shm; bf16_t* Ks = Qs + 64 * QS; bf16_t* KTs = Ks + 64 * QS; bf16_t* VTs = KTs + 256 * TS; bf16_t* Ss = VTs + 64 * TS; bf16_t* RTs = Ss + 64 * TS;
    const int c = obid(); const int xcd = c & 7, jj = c >> 3;
    const int bh = xcd * 4 + (jj >> 3), sl = jj & 7;
    const int b = bh >> 3, h = bh & 7;
    const float lg = logf(1.0f - exp2f(-5.0f - (float)h));
    const float cdec = __expf(lg * 64.0f);
    const float kdec = __expf(lg * (float)(63 - lane));
    const int mi = wid >> 1, ni0 = 2 * (wid & 1);
    const float qdec = __expf(lg * (float)(16 * mi + fr + 1));
    float idec[2][4];
#pragma unroll
    for (int t = 0; t < 2; ++t)
#pragma unroll
        for (int j = 0; j < 4; ++j) { const int n = 16 * mi + fr, m = 16 * (ni0 + t) + 4 * fq + j; idec[t][j] = __expf(lg * fabsf((float)(n - m))); }
    f32x4 R[4][2];
#pragma unroll
    for (int a = 0; a < 4; ++a)
#pragma unroll
        for (int d = 0; d < 2; ++d) R[a][d] = (f32x4){0.f, 0.f, 0.f, 0.f};
    const size_t tokb = (size_t)b * S_;
    const bf16_t* qsrc = ret + (tokb + lane) * 12288 + h * 256 + wid * 32;
    const bf16_t* ksrc = qsrc + 2048;
    const bf16_t* vsrc = ret + (tokb + lane) * 12288 + 4096 + h * 512 + sl * 64 + wid * 8;
    u32x4 pq[4], pk[4], pv;
#pragma unroll
    for (int j = 0; j < 4; ++j) { pq[j] = *(const u32x4*)(qsrc + j * 8); pk[j] = *(const u32x4*)(ksrc + j * 8); }
    pv = *(const u32x4*)vsrc;
    for (int ch = 0; ch < 64; ++ch) {
        __syncthreads();
#pragma unroll
        for (int j = 0; j < 4; ++j) {
            *(u32x4*)(Qs + lane * QS + wid * 32 + j * 8) = pq[j];
            *(u32x4*)(Ks + lane * QS + wid * 32 + j * 8) = pk[j];
            const unsigned kw[4] = {pk[j].x, pk[j].y, pk[j].z, pk[j].w};
#pragma unroll
            for (int i = 0; i < 4; ++i) {
                KTs[(wid * 32 + j * 8 + 2 * i) * TS + lane] = f2bf(bflo(kw[i]) * kdec);
                KTs[(wid * 32 + j * 8 + 2 * i + 1) * TS + lane] = f2bf(bfhi(kw[i]) * kdec);
            }
        }
        { const unsigned vw[4] = {pv.x, pv.y, pv.z, pv.w};
#pragma unroll
          for (int i = 0; i < 4; ++i) { VTs[(wid * 8 + 2 * i) * TS + lane] = (bf16_t)(vw[i] & 0xffffu); VTs[(wid * 8 + 2 * i + 1) * TS + lane] = (bf16_t)(vw[i] >> 16); } }
#pragma unroll
        for (int ei = 0; ei < 4; ++ei)
#pragma unroll
            for (int di = 0; di < 2; ++di) { u32x2 w; w.x = cvt_pk_bf16(R[ei][di][0], R[ei][di][1]); w.y = cvt_pk_bf16(R[ei][di][2], R[ei][di][3]);
                *(u32x2*)(RTs + (16 * ei + fr) * QS + wid * 32 + 16 * di + 4 * fq) = w; }
        if (ch + 1 < 64) {
            const size_t adv = (size_t)(ch + 1) * 64 * 12288;
#pragma unroll
            for (int j = 0; j < 4; ++j) { pq[j] = *(const u32x4*)(qsrc + adv + j * 8); pk[j] = *(const u32x4*)(ksrc + adv + j * 8); }
            pv = *(const u32x4*)(vsrc + adv);
        }
        __syncthreads();
        {
            f32x4 sacc[2] = {{0.f, 0.f, 0.f, 0.f}, {0.f, 0.f, 0.f, 0.f}};
#pragma unroll
            for (int ks = 0; ks < 8; ++ks) {
                const bf16x8 af = *(const bf16x8*)(Qs + (16 * mi + fr) * QS + ks * 32 + fq * 8);
#pragma unroll
                for (int t = 0; t < 2; ++t) { const bf16x8 bf = *(const bf16x8*)(Ks + (16 * (ni0 + t) + fr) * QS + ks * 32 + fq * 8);
                    sacc[t] = __builtin_amdgcn_mfma_f32_16x16x32_bf16(bf, af, sacc[t], 0, 0, 0); }
            }
#pragma unroll
            for (int t = 0; t < 2; ++t) { u32x2 w; w.x = cvt_pk_bf16(sacc[t][0] * idec[t][0], sacc[t][1] * idec[t][1]); w.y = cvt_pk_bf16(sacc[t][2] * idec[t][2], sacc[t][3] * idec[t][3]);
                *(u32x2*)(Ss + (16 * mi + fr) * TS + 16 * (ni0 + t) + 4 * fq) = w; }
        }
        __syncthreads();
        {
            f32x4 oi[2] = {{0.f, 0.f, 0.f, 0.f}, {0.f, 0.f, 0.f, 0.f}}, oc[2] = {{0.f, 0.f, 0.f, 0.f}, {0.f, 0.f, 0.f, 0.f}};
#pragma unroll
            for (int ks = 0; ks < 2; ++ks) {
                const bf16x8 af = *(const bf16x8*)(Ss + (16 * mi + fr) * TS + ks * 32 + fq * 8);
#pragma unroll
                for (int t = 0; t < 2; ++t) { const bf16x8 bf = *(const bf16x8*)(VTs + (16 * (ni0 + t) + fr) * TS + ks * 32 + fq * 8);
                    oi[t] = __builtin_amdgcn_mfma_f32_16x16x32_bf16(bf, af, oi[t], 0, 0, 0); }
            }
#pragma unroll
            for (int ks = 0; ks < 8; ++ks) {
                const bf16x8 af = *(const bf16x8*)(Qs + (16 * mi + fr) * QS + ks * 32 + fq * 8);
#pragma unroll
                for (int t = 0; t < 2; ++t) { const bf16x8 bf = *(const bf16x8*)(RTs + (16 * (ni0 + t) + fr) * QS + ks * 32 + fq * 8);
                    oc[t] = __builtin_amdgcn_mfma_f32_16x16x32_bf16(bf, af, oc[t], 0, 0, 0); }
            }
            const size_t tok = tokb + (size_t)ch * 64 + 16 * mi + fr;
            float sq = 0.f;
#pragma unroll
            for (int t = 0; t < 2; ++t) {
                const int e = sl * 64 + 16 * (ni0 + t) + 4 * fq;
                const u32x2 gw = *(const u32x2*)(ret + tok * 12288 + 8192 + h * 512 + e);
                f32x4 ov = oi[t] + oc[t] * qdec;
                sq += ov[0] * ov[0] + ov[1] * ov[1] + ov[2] * ov[2] + ov[3] * ov[3];
                u32x2 w; w.x = cvt_pk_bf16(ov[0] * bflo(gw.x), ov[1] * bfhi(gw.x)); w.y = cvt_pk_bf16(ov[2] * bflo(gw.y), ov[3] * bfhi(gw.y));
                *(u32x2*)(ao + tok * 4096 + h * 512 + e) = w;
            }
            sq += __shfl_xor(sq, 16); sq += __shfl_xor(sq, 32);
            if (fq == 0) atomicAdd(rssq + (size_t)(sl * 4 + mi) * 0 + (size_t)sl * (T_ * 8) + tok * 8 + h, sq);
        }
#pragma unroll
        for (int ei = 0; ei < 4; ++ei)
#pragma unroll
            for (int di = 0; di < 2; ++di) R[ei][di] *= cdec;
#pragma unroll
        for (int ks = 0; ks < 2; ++ks) {
            bf16x8 bfk[2];
#pragma unroll
            for (int di = 0; di < 2; ++di) bfk[di] = *(const bf16x8*)(KTs + (wid * 32 + 16 * di + fr) * TS + ks * 32 + fq * 8);
#pragma unroll
            for (int ei = 0; ei < 4; ++ei) { const bf16x8 af = *(const bf16x8*)(VTs + (16 * ei + fr) * TS + ks * 32 + fq * 8);
#pragma unroll
                for (int di = 0; di < 2; ++di) R[ei][di] = __builtin_amdgcn_mfma_f32_16x16x32_bf16(bfk[di], af, R[ei][di], 0, 0, 0); }
        }
    }
}

__device__ __forceinline__ void ret2_phase(const Params& p) {
    bf16_t* ao = (bf16_t*)(p.ws + OFF_OA); const float* rssq = (const float*)(p.ws + OFF_RSQP);
    const size_t nvec = (size_t)T_ * 4096 / 8;
    for (size_t i = (size_t)obid() * 512 + otid(); i < nvec; i += (size_t)gridDim.x * 512) {
        const size_t t = i >> 9; const int hh = (int)((i & 511) >> 6);
        float rsum = 0.f;
#pragma unroll
        for (int sl = 0; sl < 8; ++sl) rsum += rssq[(size_t)sl * (T_ * 8) + t * 8 + hh];
        const float rs = rsqrtf(rsum * (1.0f / 512.0f) + EPS_);
        u32x4 w = *(u32x4*)(ao + i * 8);
        w.x = cvt_pk_bf16(bflo(w.x) * rs, bfhi(w.x) * rs); w.y = cvt_pk_bf16(bflo(w.y) * rs, bfhi(w.y) * rs);
        w.z = cvt_pk_bf16(bflo(w.z) * rs, bfhi(w.z) * rs); w.w = cvt_pk_bf16(bflo(w.w) * rs, bfhi(w.w) * rs);
        *(u32x4*)(ao + i * 8) = w;
    }
}

__device__ __forceinline__ void final_phase(const Params& p) {
    const float* ss = (const float*)(p.ws + OFF_SSP) + (size_t)8 * 32 * T_;
    const int tid = otid();
    const f32x4 g = *(const f32x4*)(p.norm_final + tid * 4);
    for (int row = obid(); row < T_; row += gridDim.x) {
        float ssum = ss[(size_t)(tid & 31) * T_ + row];
#pragma unroll
        for (int o = 16; o > 0; o >>= 1) ssum += __shfl_xor(ssum, o);
        const float rs = rsqrtf(ssum * (1.0f / D_) + EPS_);
        f32x4 v = *(f32x4*)(p.out + (size_t)row * D_ + tid * 4);
        v = v * rs * g;
        *(f32x4*)(p.out + (size_t)row * D_ + tid * 4) = v;
    }
}

enum { OP_PREP = 0, OP_A_IN, OP_ATTN, OP_A_OUT, OP_S5A, OP_S5C, OP_GLU, OP_C_IN, OP_RET, OP_RET2, OP_C_OUT, OP_W1, OP_W2, OP_FINAL };
#ifndef PHMASK
#define PHMASK 0xffff
#endif
#define PHON(b) ((PHMASK >> (b)) & 1)
constexpr int NPH = 23;
__device__ const unsigned char PROG_OP[NPH] = { OP_PREP,
    OP_A_IN, OP_ATTN, OP_A_OUT, OP_W1, OP_W2,
    OP_S5A, OP_S5C, OP_GLU, OP_W1, OP_W2,
    OP_C_IN, OP_RET, OP_RET2, OP_C_OUT, OP_W1, OP_W2,
    OP_A_IN, OP_ATTN, OP_A_OUT, OP_W1, OP_W2,
    OP_FINAL };
__device__ const unsigned char PROG_LAYER[NPH] = { 0, 0, 0, 0, 0, 0, 1, 1, 1, 1, 1, 2, 2, 2, 2, 2, 2, 3, 3, 3, 3, 3, 3 };

struct GemmDesc { unsigned long long a_off, b_off; int N, K, ss_idx, mode; };
#define GD_NONE {0, 0, 0, 0, 0, 0}
#define GD_A_IN(L)  {OFF_XB, OFF_WT_A_IN + (L / 3) * SZ_A_IN, 6144, 2048, 2 * L, 0}
#define GD_A_OUT(L) {OFF_OA, OFF_WT_A_OUT + (L / 3) * SZ_A_OUT, 2048, 2048, 2 * L + 1, 0}
#define GD_W1(L)    {OFF_XB, OFF_WT_W1 + L * SZ_W1, 8192, 2048, 2 * L + 1, 1}
#define GD_W2(L)    {OFF_BIG, OFF_WT_W2 + L * SZ_W1, 2048, 8192, 2 * L + 2, 0}
#define GD_GLU(L)   {OFF_OA, OFF_WT_GLU, 4096, 2048, 2 * L + 1, 1}
#define GD_C_IN(L)  {OFF_XB, OFF_WT_C_IN, 12288, 2048, 2 * L, 2}
#define GD_C_OUT(L) {OFF_OA, OFF_WT_C_OUT, 2048, 4096, 2 * L + 1, 0}
__device__ const GemmDesc GD[NPH] = { GD_NONE,
    GD_A_IN(0ull), GD_NONE, GD_A_OUT(0ull), GD_W1(0ull), GD_W2(0ull),
    GD_NONE, GD_NONE, GD_GLU(1ull), GD_W1(1ull), GD_W2(1ull),
    GD_C_IN(2ull), GD_NONE, GD_NONE, GD_C_OUT(2ull), GD_W1(2ull), GD_W2(2ull),
    GD_A_IN(3ull), GD_NONE, GD_A_OUT(3ull), GD_W1(3ull), GD_W2(3ull),
    GD_NONE };

__device__ __forceinline__ void gsync(cg::grid_group& grid) {
    asm volatile("s_waitcnt vmcnt(0) lgkmcnt(0)" ::: "memory");
    grid.sync();
    __builtin_amdgcn_fence(__ATOMIC_ACQUIRE, "agent");
    asm volatile("s_waitcnt vmcnt(0) lgkmcnt(0)" ::: "memory");
}

__global__ void __launch_bounds__(512, 2) fwd_megakernel(Params p, int ph_lo, int ph_hi) {
    extern __shared__ __attribute__((aligned(16))) unsigned char shm[];
    cg::grid_group grid = cg::this_grid();
#ifndef DUPMASK
#define DUPMASK 0
#endif
    if (PHON(0) && ph_lo == 0) {
#pragma unroll 1
        for (int rp_ = 0; rp_ < ((DUPMASK & 1) ? 2 : 1); ++rp_) { prep_phase(p, shm); if (ph_hi > 1) gsync(grid); } }
    for (int ph = (ph_lo < 1 ? 1 : ph_lo); ph < ph_hi; ++ph) {
        const int op = PROG_OP[ph], L = PROG_LAYER[ph];
        const int nrep_ = ((DUPMASK >> op) & 1) ? 2 : 1;
#pragma unroll 1
        for (int rp_ = 0; rp_ < nrep_; ++rp_) {
        unsigned char* ws = p.ws; asm volatile("" : "+s"(ws));
        float* ssb = (float*)(ws + OFF_SSP);
        if (PHON(1) && (op == OP_A_IN || op == OP_C_IN || op == OP_W1)) {
            const GemmDesc gd = GD[ph];
            pg8::Gemm g; g.A = (const bf16_t*)(ws + gd.a_off); g.Bt = (const bf16_t*)(ws + gd.b_off); g.M = T_; g.N = gd.N; g.K = gd.K;
            pg8::EpiBf E; E.rot = (const f32x2*)(ws + OFF_ROT); E.O = (bf16_t*)(ws + OFF_BIG); E.ldc = gd.N; E.mode = gd.mode; E.ss = ssb + (size_t)gd.ss_idx * 32 * T_;
            pg8::StaticOrder S; S.init(g.M, g.N, (int)gridDim.x, obid());
            pg8::gemm_phase<pg8::EpiBf, pg8::StaticOrder>((LAS unsigned char*)shm, g, S, E);
        } else if (PHON(2) && (op == OP_A_OUT || op == OP_GLU || op == OP_C_OUT || op == OP_W2)) {
            const GemmDesc gd = GD[ph];
            pg8::Gemm g; g.A = (const bf16_t*)(ws + gd.a_off); g.Bt = (const bf16_t*)(ws + gd.b_off); g.M = T_; g.N = gd.N; g.K = gd.K;
            pg8::EpiRes E; E.xout = p.out; E.xb = (bf16_t*)(ws + OFF_XB); E.glu = gd.mode; E.xin = (ph == 3) ? p.x : (const float*)p.out; E.ssn = ssb + (size_t)gd.ss_idx * 32 * T_;
            pg8::StaticOrder S; S.init(g.M, g.N, (int)gridDim.x, obid());
            pg8::gemm_phase<pg8::EpiRes, pg8::StaticOrder>((LAS unsigned char*)shm, g, S, E);
        } else if (PHON(3) && op == OP_ATTN) {
            const float li = 0.8f - 0.6f * expf(-0.3f * (float)L);
            attn_phase(p, L / 3, li, shm);
        } else if (PHON(4) && op == OP_S5A) {
            s5_phase<false>(p, shm);
        } else if (PHON(5) && op == OP_S5C) {
            s5_phase<true>(p, shm);
        } else if (PHON(6) && op == OP_RET) {
            ret_phase(p, shm, (float*)(ws + (rp_ == 0 ? OFF_RSQP : OFF_XB)));
        } else if (PHON(7) && op == OP_RET2) {
            ret2_phase(p);
        } else if (PHON(8) && op == OP_FINAL) {
            final_phase(p);
        }
        if (ph + 1 < ph_hi || rp_ + 1 < nrep_) gsync(grid);
        }
    }
}

extern "C" void kernel_launch(void* const* d_in, const int* in_sizes, int n_in, void* d_out, int out_size, void* d_ws, size_t ws_size, hipStream_t stream) {
    static int grid_blocks = 0;
    if (grid_blocks == 0) {
        if (n_in != 21 || out_size != T_ * D_ || ws_size < WS_NEED) { fprintf(stderr, "kernel_launch: unexpected shapes n_in %d out %d ws %zu (need %zu)\n", n_in, out_size, ws_size, (size_t)WS_NEED); grid_blocks = -1; return; }
        int dev = 0, cus = 0, per_cu = 0;
        hipGetDevice(&dev);
        hipDeviceGetAttribute(&cus, hipDeviceAttributeMultiprocessorCount, dev);
        if (hipFuncSetAttribute((const void*)fwd_megakernel, hipFuncAttributeMaxDynamicSharedMemorySize, LDS_BYTES) != hipSuccess) { fprintf(stderr, "kernel_launch: hipFuncSetAttribute failed\n"); grid_blocks = -1; return; }
        hipOccupancyMaxActiveBlocksPerMultiprocessor(&per_cu, (const void*)fwd_megakernel, 512, LDS_BYTES);
        (void)hipGetLastError();
        if (per_cu < 1) per_cu = 1;
        grid_blocks = cus * 1;
        if (grid_blocks != 256) fprintf(stderr, "kernel_launch: note: %d CUs (kernel tuned for 256)\n", cus);
    }
    if (grid_blocks < 0) return;
    Params p{};
    const float** pp = (const float**)&p;
    for (int i = 0; i < 21; ++i) pp[i] = (const float*)d_in[i];
    p.out = (float*)d_out; p.ws = (unsigned char*)d_ws;
#ifndef DBG_LO
#define DBG_LO 0
#endif
#ifndef DBG_HI
#define DBG_HI NPH
#endif
    int lo = DBG_LO, hi = DBG_HI;
    void* args[] = {&p, &lo, &hi};
    hipError_t e = hipLaunchCooperativeKernel((const void*)fwd_megakernel, dim3(grid_blocks), dim3(512), args, LDS_BYTES, stream);
    if (e != hipSuccess) fprintf(stderr, "cooperative launch failed: %s (grid %d)\n", hipGetErrorString(e), grid_blocks);
}
```

```cpp
#include <hip/hip_runtime.h>
#include <hip/hip_cooperative_groups.h>
#include <cstdio>
#include <cstdint>
namespace cg = cooperative_groups;

#define LAS __attribute__((address_space(3)))
typedef unsigned short bf16_t;
typedef short bf16x8 __attribute__((ext_vector_type(8)));
typedef short s16x4 __attribute__((ext_vector_type(4)));
typedef float f32x4 __attribute__((ext_vector_type(4)));
typedef float f32x2 __attribute__((ext_vector_type(2)));
typedef float f32x16 __attribute__((ext_vector_type(16)));
typedef unsigned u32x4 __attribute__((ext_vector_type(4)));
typedef unsigned u32x2 __attribute__((ext_vector_type(2)));

constexpr int T_ = 16384, D_ = 2048, S_ = 4096;
constexpr float EPS_ = 1e-6f;
constexpr int LDS_BYTES = 156672;

constexpr size_t SZ_A_IN = 6144ull * 2048 * 2, SZ_A_OUT = 2048ull * 2048 * 2, SZ_W1 = 8192ull * 2048 * 2;
constexpr size_t OFF_WT_A_IN = 0;
constexpr size_t OFF_WT_A_OUT = OFF_WT_A_IN + 2 * SZ_A_IN;
constexpr size_t OFF_WT_GLU = OFF_WT_A_OUT + 2 * SZ_A_OUT;
constexpr size_t OFF_WT_C_IN = OFF_WT_GLU + 4096ull * 2048 * 2;
constexpr size_t OFF_WT_C_OUT = OFF_WT_C_IN + 12288ull * 2048 * 2;
constexpr size_t OFF_WT_W1 = OFF_WT_C_OUT + 2048ull * 4096 * 2;
constexpr size_t OFF_WT_W2 = OFF_WT_W1 + 4 * SZ_W1;
constexpr size_t OFF_XB = OFF_WT_W2 + 4 * SZ_W1;
constexpr size_t OFF_BIG = OFF_XB + (size_t)T_ * D_ * 2;
constexpr size_t OFF_OA = OFF_BIG + (size_t)T_ * 12288 * 2;
constexpr size_t OFF_SS = OFF_OA + (size_t)T_ * 4096 * 2;
constexpr size_t OFF_RSSQ = OFF_SS + 9ull * T_ * 4;
constexpr size_t OFF_ROT = OFF_RSSQ + (size_t)T_ * 8 * 4;
constexpr size_t OFF_S5B = OFF_ROT + 4096ull * 128 * 8;
constexpr size_t OFF_S5C = OFF_S5B + 128ull * 128 * 16 * 2;
constexpr size_t OFF_S5AB = OFF_S5C + 128ull * 16 * 128 * 2;
constexpr size_t WS_END = OFF_S5AB + 128ull * 64 * 8;
constexpr size_t OFF_SSP = WS_END;
constexpr size_t OFF_RSQP = OFF_SSP + 9ull * 32 * T_ * 4;
constexpr size_t OFF_RSFIN = OFF_RSQP + 8ull * T_ * 8 * 4;
constexpr size_t OFF_BAR = OFF_RSFIN + (size_t)T_ * 4;
constexpr size_t OFF_PAR = OFF_BAR + 256;
constexpr int PAR_GMIX = 0, PAR_NFINAL = 2048, PAR_LAM = 4096, PAR_SUBLN = 5120, PAR_BD = 5632, PAR_N = 7680;
constexpr size_t WS_NEED = OFF_PAR + PAR_N * 4;
constexpr size_t OFF_ATT_SCR = OFF_BIG + (size_t)T_ * 6144 * 2;

struct Params {
    const float* x; const float* norm_mix; const float* norm_mlp; const float* norm_final;
    const float* a_w_in; const float* a_lambda; const float* a_subln; const float* a_w_out;
    const float* b_a_re; const float* b_a_im; const float* b_log_dt; const float* b_b_re; const float* b_b_im;
    const float* b_c_re; const float* b_c_im; const float* b_d; const float* b_w_glu;
    const float* c_w_in; const float* c_w_out; const float* mlp_w1; const float* mlp_w2;
    float* out; unsigned char* ws;
};

__device__ __forceinline__ unsigned cvt_pk_bf16(float lo, float hi) { unsigned r; asm volatile("v_cvt_pk_bf16_f32 %0, %1, %2" : "=v"(r) : "v"(lo), "v"(hi)); return r; }
__device__ __forceinline__ float bf2f(unsigned short b) { return __uint_as_float(((unsigned)b) << 16); }
__device__ __forceinline__ float bflo(unsigned w) { return __uint_as_float(w << 16); }
__device__ __forceinline__ float bfhi(unsigned w) { return __uint_as_float(w & 0xffff0000u); }
__device__ __forceinline__ unsigned short f2bf(float f) { return (unsigned short)(cvt_pk_bf16(f, 0.f) & 0xffffu); }

__device__ __forceinline__ int otid() { int t = threadIdx.x; asm volatile("" : "+v"(t)); return t; }
__device__ __forceinline__ int obid() { int t = blockIdx.x; asm volatile("" : "+s"(t)); return t; }

namespace pg8 {
constexpr int BM = 256, BK = 64, HALF = 128, HTB = HALF * BK * 2, STAGE_BYTES = 8 * HTB, NXCD = 8, WGM = 8;
__device__ __forceinline__ int lds_byte(int r, int c) { const int st = (r >> 4) * 2 + (c >> 5), rr = r & 15, cc = c & 31, ob = rr * 64 + cc * 2; return st * 1024 + (ob ^ (((ob >> 9) & 1) << 5)); }
__device__ __forceinline__ void stage_rc(int b, int& R, int& C) { const int st = b / 1024, sb = b % 1024, swz = sb ^ (((sb >> 9) & 1) << 5); R = (st >> 1) * 16 + swz / 64; C = (st & 1) * 32 + (swz % 64) / 2; }
struct Unit { int pm, pn; };
struct Gemm { const bf16_t* A; const bf16_t* Bt; int M, N, K; };
struct StaticOrder {
    int nM, nN, nwg, G, c;
    __device__ void init(int M, int N, int G_, int c_) { nM = M / BM; nN = N / BM; nwg = nM * nN; G = G_; c = c_; }
    __device__ bool next(int i, Unit& u) const {
        const long L = (long)i * G + c; if (L >= nwg) return false;
        int wgid = (int)L; { const int q = nwg / NXCD, r = nwg % NXCD, xcd = wgid % NXCD, off = wgid / NXCD; wgid = (xcd < r ? xcd * (q + 1) : r * (q + 1) + (xcd - r) * q) + off; }
        const int nig = WGM * nN, gid = wgid / nig, fm = gid * WGM, gsz = (nM - fm) < WGM ? (nM - fm) : WGM;
        u.pm = fm + ((wgid % nig) % gsz); u.pn = (wgid % nig) / gsz; return true;
    }
};

#define GAS __attribute__((address_space(1)))
struct EpiBf {
    bf16_t* O; int ldc; const float* ss; int mode; const f32x2* rot;
    __device__ __forceinline__ void operator()(const f32x4 (&acc)[2][2][4][2], const Unit& u, int wr, int wc, int fr, int fq) const {
        const int row0 = u.pm * BM + wr * 64 + fr, colt = u.pn * BM + wc * 32 + 8 * fq;
        int sub = 0;
        if (mode == 1) sub = 1;
        else if (mode == 2) { sub = u.pn < 8 ? 2 : (u.pn < 16 ? 3 : (u.pn < 32 ? 0 : 4)); }
        const GAS float* ssg = (const GAS float*)ss + (size_t)(fq * 8) * T_ + row0;
        float rs8[8];
#pragma unroll
        for (int r = 0; r < 8; ++r) { float a = 0.f;
#pragma unroll
            for (int sl = 0; sl < 8; ++sl) a += ssg[(size_t)sl * T_ + (r >> 2) * HALF + (r & 3) * 16];
            rs8[r] = a; }
#pragma unroll
        for (int r = 0; r < 8; ++r) { float a = rs8[r]; a += __shfl_xor(a, 16); a += __shfl_xor(a, 32); rs8[r] = rsqrtf(a * (1.0f / D_) + EPS_); }
        GAS bf16_t* Og = (GAS bf16_t*)O;
        if (sub == 2 || sub == 3) {
            const GAS f32x2* rotg = (const GAS f32x2*)rot + wc * 32 + 8 * fq;
#pragma unroll
            for (int ai = 0; ai < 2; ++ai) {
                f32x2 cs[4][2][4];
#pragma unroll
                for (int m = 0; m < 4; ++m) { const int row = row0 + ai * HALF + m * 16; const GAS f32x2* rp = rotg + (size_t)(row & (S_ - 1)) * 128;
#pragma unroll
                    for (int n = 0; n < 2; ++n)
#pragma unroll
                        for (int j = 0; j < 4; ++j) cs[m][n][j] = rp[n * 4 + j]; }
#pragma unroll
                for (int m = 0; m < 4; ++m) { const int row = row0 + ai * HALF + m * 16;
                    float ksc = rs8[ai * 4 + m];
                    if (sub == 3) { const float lgam = logf(1.0f - exp2f(-5.0f - (float)(u.pn - 8))); ksc *= 0.0625f * __expf(lgam * (float)(63 - (row & 63))); }
                    GAS bf16_t* rowp = Og + (size_t)row * ldc + colt;
                    u32x4 w1, w2;
#pragma unroll
                    for (int n = 0; n < 2; ++n) {
                        const f32x4 t1 = acc[ai][0][m][n] * ksc, t2 = acc[ai][1][m][n] * ksc;
                        f32x4 o1, o2;
#pragma unroll
                        for (int j = 0; j < 4; ++j) { const f32x2 c2 = cs[m][n][j]; o1[j] = t1[j] * c2.x - t2[j] * c2.y; o2[j] = t1[j] * c2.y + t2[j] * c2.x; }
                        w1[2 * n] = cvt_pk_bf16(o1[0], o1[1]); w1[2 * n + 1] = cvt_pk_bf16(o1[2], o1[3]); w2[2 * n] = cvt_pk_bf16(o2[0], o2[1]); w2[2 * n + 1] = cvt_pk_bf16(o2[2], o2[3]);
                    }
                    *(GAS u32x4*)(rowp) = w1; *(GAS u32x4*)(rowp + HALF) = w2;
                }
            }
        } else {
#pragma unroll
            for (int ai = 0; ai < 2; ++ai)
#pragma unroll
                for (int m = 0; m < 4; ++m) {
                    const int row = row0 + ai * HALF + m * 16;
                    const float rs = rs8[ai * 4 + m];
                    GAS bf16_t* rowp = Og + (size_t)row * ldc + colt;
#pragma unroll
                    for (int bj = 0; bj < 2; ++bj) {
                        u32x4 w;
#pragma unroll
                        for (int n = 0; n < 2; ++n) {
                            f32x4 v = acc[ai][bj][m][n] * rs;
                            if (sub == 1) {
#pragma unroll
                                for (int j = 0; j < 4; ++j) { const float r = fmaxf(v[j], 0.f); v[j] = r * r; }
                            } else if (sub == 4) {
#pragma unroll
                                for (int j = 0; j < 4; ++j) v[j] = v[j] / (1.0f + __expf(-v[j]));
                            }
                            w[2 * n] = cvt_pk_bf16(v[0], v[1]); w[2 * n + 1] = cvt_pk_bf16(v[2], v[3]);
                        }
                        *(GAS u32x4*)(rowp + bj * HALF) = w;
                    }
                }
        }
    }
};
struct EpiRes {
    const float* xin; float* xout; bf16_t* xb; float* ssn; int glu;
    __device__ __forceinline__ void operator()(const f32x4 (&acc)[2][2][4][2], const Unit& u, int wr, int wc, int fr, int fq) const {
        const int row0 = u.pm * BM + wr * 64 + fr;
        const GAS float* xi = (const GAS float*)xin; GAS float* xo = (GAS float*)xout; GAS bf16_t* xbg = (GAS bf16_t*)xb; GAS float* ssg = (GAS float*)ssn;
        if (glu) {
            const size_t cb = (size_t)u.pn * HALF + wc * 32 + 8 * fq;
#pragma unroll
            for (int ai = 0; ai < 2; ++ai) {
                f32x4 xv[4][2];
#pragma unroll
                for (int m = 0; m < 4; ++m)
#pragma unroll
                    for (int n = 0; n < 2; ++n) xv[m][n] = *(const GAS f32x4*)(xi + (size_t)(row0 + ai * HALF + m * 16) * D_ + cb + n * 4);
#pragma unroll
                for (int m = 0; m < 4; ++m) {
                    const int row = row0 + ai * HALF + m * 16; const size_t off = (size_t)row * D_ + cb;
                    float sq = 0.f; u32x4 w;
#pragma unroll
                    for (int n = 0; n < 2; ++n) {
                        const f32x4 va = acc[ai][0][m][n], ga = acc[ai][1][m][n];
                        f32x4 x4 = xv[m][n];
#pragma unroll
                        for (int j = 0; j < 4; ++j) { x4[j] += va[j] / (1.0f + __expf(-ga[j])); sq += x4[j] * x4[j]; }
                        *(GAS f32x4*)(xo + off + n * 4) = x4;
                        w[2 * n] = cvt_pk_bf16(x4[0], x4[1]); w[2 * n + 1] = cvt_pk_bf16(x4[2], x4[3]);
                    }
                    *(GAS u32x4*)(xbg + off) = w;
                    sq += __shfl_xor(sq, 16); sq += __shfl_xor(sq, 32);
                    if (fq == 0) atomicAdd((float*)ssn + (size_t)((u.pn >> 1) * 4 + wc) * T_ + row, sq);
                }
            }
        } else {
            const size_t cb = (size_t)u.pn * BM + wc * 32 + 8 * fq;
#pragma unroll
            for (int ai = 0; ai < 2; ++ai) {
                f32x4 xv[4][2][2];
#pragma unroll
                for (int m = 0; m < 4; ++m)
#pragma unroll
                    for (int bj = 0; bj < 2; ++bj)
#pragma unroll
                        for (int n = 0; n < 2; ++n) xv[m][bj][n] = *(const GAS f32x4*)(xi + (size_t)(row0 + ai * HALF + m * 16) * D_ + cb + bj * HALF + n * 4);
#pragma unroll
                for (int m = 0; m < 4; ++m) {
                    const int row = row0 + ai * HALF + m * 16; const size_t off = (size_t)row * D_ + cb;
                    float sq = 0.f;
#pragma unroll
                    for (int bj = 0; bj < 2; ++bj) {
                        u32x4 w;
#pragma unroll
                        for (int n = 0; n < 2; ++n) {
                            f32x4 x4 = xv[m][bj][n] + acc[ai][bj][m][n];
#pragma unroll
                            for (int j = 0; j < 4; ++j) sq += x4[j] * x4[j];
                            *(GAS f32x4*)(xo + off + bj * HALF + n * 4) = x4;
                            w[2 * n] = cvt_pk_bf16(x4[0], x4[1]); w[2 * n + 1] = cvt_pk_bf16(x4[2], x4[3]);
                        }
                        *(GAS u32x4*)(xbg + off + bj * HALF) = w;
                    }
                    sq += __shfl_xor(sq, 16); sq += __shfl_xor(sq, 32);
                    if (fq == 0) ssg[(size_t)(u.pn * 4 + wc) * T_ + row] = sq;
                }
            }
        }
    }
};

template <class Epi, class Sched>
__device__ __forceinline__ void gemm_phase(LAS unsigned char* lds, const Gemm g, const Sched& S, const Epi& E) {
    const int tid = otid(), wid = __builtin_amdgcn_readfirstlane(tid >> 6), lane = tid & 63, wr = wid >> 2, wc = wid & 3, fr = lane & 15, fq = lane >> 4;
    const int K = g.K, nt = K / BK;
    unsigned voffA[2], voffB[2];
#pragma unroll
    for (int i = 0; i < 2; ++i) { int R, C; stage_rc(tid * 16 + i * 8192, R, C); voffA[i] = (unsigned)(R * K + C) * 2u; voffB[i] = voffA[i]; }
    const size_t kstep = (size_t)(BK * 2);
    const size_t hstep = (size_t)HALF * K * 2;
    const size_t tstep = 2 * hstep;
    const unsigned ldsw = (unsigned)wid * 1024u;
    const int aoff = lds_byte(wr * 64 + fr, fq * 8), boff = lds_byte(wc * 32 + fr, fq * 8);
#define PG8_SA(b, h) (((b) * 2 + (h)) * HTB)
#define PG8_SB(b, h) ((4 + (b) * 2 + (h)) * HTB)
#define PG8_STAGE(bufoff, gbase, voff) do { _Pragma("unroll") for (int _i = 0; _i < 2; ++_i) \
        __builtin_amdgcn_global_load_lds((const unsigned*)((const char*)(gbase) + (voff)[_i]), (LAS unsigned*)(lds + (bufoff) + ldsw + _i * 8192), 16, 0, 0); } while (0)
#define PG8_LDA(dst, b, h) do { _Pragma("unroll") for (int m = 0; m < 4; ++m) _Pragma("unroll") for (int k = 0; k < 2; ++k) dst[m][k] = *(const LAS bf16x8*)(lds + PG8_SA(b, h) + aoff + m * 2048 + k * 1024); } while (0)
#define PG8_LDB(dst, b, h) do { _Pragma("unroll") for (int n = 0; n < 2; ++n) _Pragma("unroll") for (int k = 0; k < 2; ++k) dst[n][k] = *(const LAS bf16x8*)(lds + PG8_SB(b, h) + boff + n * 2048 + k * 1024); } while (0)
#define PG8_MMA(ai, bj, At, Bt) do { __builtin_amdgcn_s_setprio(1); _Pragma("unroll") for (int m = 0; m < 4; ++m) _Pragma("unroll") for (int n = 0; n < 2; ++n) _Pragma("unroll") for (int k = 0; k < 2; ++k) \
        acc[ai][bj][m][n] = __builtin_amdgcn_mfma_f32_16x16x32_bf16(Bt[n][k], At[m][k], acc[ai][bj][m][n], 0, 0, 0); __builtin_amdgcn_s_setprio(0); } while (0)
#define PG8_WAIT_V(n) asm volatile("s_waitcnt vmcnt(" #n ")" ::: "memory")
#define PG8_WAIT_L(n) asm volatile("s_waitcnt lgkmcnt(" #n ")" ::: "memory")
#define PG8_BAR __builtin_amdgcn_s_barrier()
#define PG8_SCHED __builtin_amdgcn_sched_barrier(0)
    Unit cur, nxt; int ui = 0;
    if (!S.next(0, cur)) return;
    f32x4 acc[2][2][4][2];
#pragma unroll
    for (int a = 0; a < 2; ++a)
#pragma unroll
        for (int b = 0; b < 2; ++b)
#pragma unroll
            for (int m = 0; m < 4; ++m)
#pragma unroll
                for (int n = 0; n < 2; ++n) acc[a][b][m][n] = (f32x4){0.f, 0.f, 0.f, 0.f};
    bf16x8 At[4][2], B0[2][2], B1[2][2];
    const char* cA = (const char*)g.A + (size_t)cur.pm * tstep; const char* cB = (const char*)g.Bt + (size_t)cur.pn * tstep;
    PG8_STAGE(PG8_SB(0, 0), cB, voffB); PG8_STAGE(PG8_SA(0, 0), cA, voffA); PG8_STAGE(PG8_SB(0, 1), cB + hstep, voffB); PG8_STAGE(PG8_SA(0, 1), cA + hstep, voffA);
    if (wr == 1) PG8_BAR;
    PG8_WAIT_V(4); PG8_BAR;
    PG8_STAGE(PG8_SB(1, 0), cB + kstep, voffB); PG8_STAGE(PG8_SA(1, 0), cA + kstep, voffA); PG8_STAGE(PG8_SB(1, 1), cB + hstep + kstep, voffB);
    PG8_WAIT_V(6); PG8_BAR;
    for (;;) {
        const bool has_next = S.next(ui + 1, nxt);
        const char* nA = has_next ? (const char*)g.A + (size_t)nxt.pm * tstep : cA; const char* nB = has_next ? (const char*)g.Bt + (size_t)nxt.pn * tstep : cB;
        for (int t = 0; t < nt; t += 2) {
            const bool last = (t == nt - 2);
            const char* a1 = cA + (size_t)(t + 1) * kstep;
            const char* a2 = last ? nA : cA + (size_t)(t + 2) * kstep; const char* b2 = last ? nB : cB + (size_t)(t + 2) * kstep;
            const char* a3 = a2 + kstep; const char* b3 = b2 + kstep;
            PG8_LDB(B0, 0, 0); PG8_SCHED; PG8_LDA(At, 0, 0); PG8_STAGE(PG8_SA(1, 1), a1 + hstep, voffA);
            PG8_WAIT_L(8); PG8_BAR; PG8_WAIT_L(0); PG8_MMA(0, 0, At, B0); PG8_BAR; PG8_SCHED;
            PG8_LDB(B1, 0, 1); PG8_STAGE(PG8_SB(0, 0), b2, voffB);
            PG8_BAR; PG8_WAIT_L(0); PG8_MMA(0, 1, At, B1); PG8_BAR;
            PG8_LDA(At, 0, 1); PG8_STAGE(PG8_SA(0, 0), a2, voffA);
            PG8_BAR; PG8_WAIT_L(0); PG8_MMA(1, 0, At, B0); PG8_BAR; PG8_SCHED;
            PG8_STAGE(PG8_SB(0, 1), b2 + hstep, voffB);
            PG8_WAIT_V(6); PG8_BAR; PG8_MMA(1, 1, At, B1); PG8_BAR;
            PG8_LDB(B0, 1, 0); PG8_SCHED; PG8_LDA(At, 1, 0); PG8_STAGE(PG8_SA(0, 1), a2 + hstep, voffA);
            PG8_WAIT_L(8); PG8_BAR; PG8_WAIT_L(0); PG8_MMA(0, 0, At, B0); PG8_BAR; PG8_SCHED;
            PG8_LDB(B1, 1, 1); PG8_STAGE(PG8_SB(1, 0), b3, voffB);
            PG8_BAR; PG8_WAIT_L(0); PG8_MMA(0, 1, At, B1); PG8_BAR;
            PG8_LDA(At, 1, 1); PG8_STAGE(PG8_SA(1, 0), a3, voffA);
            PG8_BAR; PG8_WAIT_L(0); PG8_MMA(1, 0, At, B0); PG8_BAR; PG8_SCHED;
            PG8_STAGE(PG8_SB(1, 1), b3 + hstep, voffB);
            PG8_WAIT_V(6); PG8_BAR; PG8_MMA(1, 1, At, B1); PG8_BAR;
        }
        E(acc, cur, wr, wc, fr, fq);
        if (!has_next) break;
#pragma unroll
        for (int a = 0; a < 2; ++a)
#pragma unroll
            for (int b = 0; b < 2; ++b)
#pragma unroll
                for (int m = 0; m < 4; ++m)
#pragma unroll
                    for (int n = 0; n < 2; ++n) acc[a][b][m][n] = (f32x4){0.f, 0.f, 0.f, 0.f};
        cur = nxt; cA = nA; cB = nB; ++ui;
    }
    PG8_WAIT_V(0);
    if (wr == 0) PG8_BAR;
    PG8_BAR;
#undef PG8_SA
#undef PG8_SB
#undef PG8_STAGE
#undef PG8_LDA
#undef PG8_LDB
#undef PG8_MMA
#undef PG8_WAIT_V
#undef PG8_WAIT_L
#undef PG8_BAR
#undef PG8_SCHED
}
}

namespace att {
constexpr int D = 128, KVBLK = 64, LDK = 6144;
constexpr float SCALE = 0.088388347648318440f;
constexpr float THR = 8.f;
constexpr size_t SHM_V = KVBLK * D * 2, SHM_K = KVBLK * D * 2;
#define KSWZ(row, colB) ((row) * 256 + ((colB) ^ (((row) & 7) << 4)))
#define SBAR() __builtin_amdgcn_sched_barrier(0)
__device__ __forceinline__ int crow(int r, int hi) { return (r & 3) + 8 * (r >> 2) + 4 * hi; }
__device__ __forceinline__ void partialSM(f32x16& p0, f32x16& p1, float& m_reg, float& mn, float& alpha, bool msk) {
    constexpr float C = SCALE * 1.4426950408889634f;
    if (msk) {
#pragma unroll
        for (int r = 0; r < 16; ++r) { p0[r] = -1e30f; p1[r] = -1e30f; }
    }
    float pmax = p0[0];
#pragma unroll
    for (int r = 1; r < 16; ++r) pmax = fmaxf(pmax, p0[r]);
#pragma unroll
    for (int r = 0; r < 16; ++r) pmax = fmaxf(pmax, p1[r]);
    { auto rr = __builtin_amdgcn_permlane32_swap(__float_as_uint(pmax), __float_as_uint(pmax), false, false);
      pmax = fmaxf(__uint_as_float(rr[0]), __uint_as_float(rr[1])); }
    if (__builtin_expect(__all(pmax - m_reg <= THR / SCALE), 1)) { mn = m_reg; alpha = 1.f; }
    else { mn = fmaxf(m_reg, pmax); alpha = __builtin_amdgcn_exp2f((m_reg - mn) * C); m_reg = mn; }
    float mnC = -mn * C;
#pragma unroll
    for (int r = 0; r < 16; ++r) p0[r] = fmaf(p0[r], C, mnC);
#pragma unroll
    for (int r = 0; r < 16; ++r) p1[r] = fmaf(p1[r], C, mnC);
#pragma unroll
    for (int r = 0; r < 16; ++r) p0[r] = __builtin_amdgcn_exp2f(p0[r]);
}
__device__ __forceinline__ void finishSM(f32x16& p0, f32x16& p1, float alpha, float& l_reg, bf16x8& pa0, bf16x8& pa1, bf16x8& pa2, bf16x8& pa3) {
#pragma unroll
    for (int r = 0; r < 16; ++r) p1[r] = __builtin_amdgcn_exp2f(p1[r]);
    float ps = 0;
#pragma unroll
    for (int r = 0; r < 16; ++r) ps += p0[r];
#pragma unroll
    for (int r = 0; r < 16; ++r) ps += p1[r];
    { auto rr = __builtin_amdgcn_permlane32_swap(__float_as_uint(ps), __float_as_uint(ps), false, false);
      ps = __uint_as_float(rr[0]) + __uint_as_float(rr[1]); }
    l_reg = l_reg * alpha + ps;
#define PK4(P, BASE, OUT) do { unsigned a0 = cvt_pk_bf16(P[BASE + 0], P[BASE + 1]), a1 = cvt_pk_bf16(P[BASE + 2], P[BASE + 3]);   \
    unsigned b0 = cvt_pk_bf16(P[BASE + 4], P[BASE + 5]), b1 = cvt_pk_bf16(P[BASE + 6], P[BASE + 7]);                              \
    auto r0 = __builtin_amdgcn_permlane32_swap(a0, b0, false, false); auto r1 = __builtin_amdgcn_permlane32_swap(a1, b1, false, false); \
    u32x4 w = {r0[0], r1[0], r0[1], r1[1]}; OUT = *reinterpret_cast<bf16x8*>(&w); } while (0)
    PK4(p0, 0, pa0); PK4(p0, 8, pa1); PK4(p1, 0, pa2); PK4(p1, 8, pa3);
#undef PK4
}
__device__ __forceinline__ void qkt(f32x16& p0, f32x16& p1, const char* Ks, const bf16x8* qr, int r32, int hi) {
    p0 = f32x16{}; p1 = f32x16{};
#pragma unroll
    for (int d0 = 0; d0 < 8; ++d0) { int cb = (d0 * 16 + hi * 8) * 2;
        bf16x8 b0 = *reinterpret_cast<const bf16x8*>(Ks + KSWZ(r32, cb));
        bf16x8 b1 = *reinterpret_cast<const bf16x8*>(Ks + KSWZ(32 + r32, cb));
        p0 = __builtin_amdgcn_mfma_f32_32x32x16_bf16(b0, qr[d0], p0, 0, 0, 0);
        p1 = __builtin_amdgcn_mfma_f32_32x32x16_bf16(b1, qr[d0], p1, 0, 0, 0); }
}
__device__ __forceinline__ int v_st(int k, int c) { const int kk = (k & ~0xC) | ((k & 4) << 1) | ((k & 8) >> 1); return ((kk >> 3) * 4 + (c >> 5)) * 512 + ((kk & 7) * 32 + (c & 31)) * 2; }
__device__ __forceinline__ int v_rd_base(int lane) { return ((lane & 3) << 3) | (((lane >> 2) & 3) << 6) | (((lane >> 4) & 1) << 5) | (((lane >> 5) & 1) << 8); }
constexpr int v_rd_off(int d0, int ks, int half) { return d0 * 512 + ks * 4096 + half * 2048; }
template <int OFF> __device__ __forceinline__ s16x4 tr_read(int vb) {
    s16x4 r; asm volatile("ds_read_b64_tr_b16 %0, %1 offset:%2" : "=&v"(r) : "v"(vb), "i"(OFF) : "memory"); return r;
}
template <int D0> __device__ __forceinline__ void pv_one(f32x16& od, int vb, bf16x8 pa0, bf16x8 pa1, bf16x8 pa2, bf16x8 pa3) {
    const s16x4 l0 = tr_read<v_rd_off(D0, 0, 0)>(vb), h0 = tr_read<v_rd_off(D0, 0, 1)>(vb), l1 = tr_read<v_rd_off(D0, 1, 0)>(vb), h1 = tr_read<v_rd_off(D0, 1, 1)>(vb);
    const s16x4 l2 = tr_read<v_rd_off(D0, 2, 0)>(vb), h2 = tr_read<v_rd_off(D0, 2, 1)>(vb), l3 = tr_read<v_rd_off(D0, 3, 0)>(vb), h3 = tr_read<v_rd_off(D0, 3, 1)>(vb);
    asm volatile("s_waitcnt lgkmcnt(0)" ::: "memory"); SBAR();
#define PK(L, H) (bf16x8){L[0], L[1], L[2], L[3], H[0], H[1], H[2], H[3]}
    od = __builtin_amdgcn_mfma_f32_32x32x16_bf16(pa0, PK(l0, h0), od, 0, 0, 0);
    od = __builtin_amdgcn_mfma_f32_32x32x16_bf16(pa1, PK(l1, h1), od, 0, 0, 0);
    od = __builtin_amdgcn_mfma_f32_32x32x16_bf16(pa2, PK(l2, h2), od, 0, 0, 0);
    od = __builtin_amdgcn_mfma_f32_32x32x16_bf16(pa3, PK(l3, h3), od, 0, 0, 0);
#undef PK
}
__device__ __forceinline__ void pv_d0(f32x16* o, int vb, bf16x8 pa0, bf16x8 pa1, bf16x8 pa2, bf16x8 pa3) {
    pv_one<0>(o[0], vb, pa0, pa1, pa2, pa3); pv_one<1>(o[1], vb, pa0, pa1, pa2, pa3); pv_one<2>(o[2], vb, pa0, pa1, pa2, pa3); pv_one<3>(o[3], vb, pa0, pa1, pa2, pa3);
}
__device__ __forceinline__ void attn_body(const bf16_t* __restrict__ Qb, const bf16_t* __restrict__ Kh, const bf16_t* __restrict__ Vh, int NT, int ntw, char* lds, f32x16 (&o)[4]) {
    const int tid = otid(), wid = __builtin_amdgcn_readfirstlane(tid >> 6), lane = tid & 63, r32 = lane & 31, hi = lane >> 5;
    char* V_lds = lds; char* K_lds = lds + 2 * SHM_V;
    float* wsf = (float*)(lds + 2 * SHM_V + 2 * SHM_K) + wid * 64; float* li_l = wsf; float* al_l = wsf + 32;
    float m_reg = -1e30f, l_reg = 0; bf16x8 qr[8];
#pragma unroll
    for (int d = 0; d < 4; ++d) o[d] = f32x16{};
    const bf16_t* Qw = Qb + (long)(wid * 32 + r32) * LDK + hi * 8;
#pragma unroll
    for (int d0 = 0; d0 < 8; ++d0) qr[d0] = *reinterpret_cast<const bf16x8*>(Qw + d0 * 16);
    const int sr = tid >> 4, sc = (tid & 15) * 8, vst0 = v_st(sr, sc), vst1 = v_st(32 + sr, sc);
    const int vb0 = (int)(uintptr_t)V_lds + v_rd_base(lane);
    struct { bf16x8 vs0, vs1, ks0, ks1; } sr_[2];
#define SLOAD(i, k0) do { sr_[i].vs0 = *reinterpret_cast<const bf16x8*>(&Vh[(long)((k0) + sr) * LDK + sc]); sr_[i].vs1 = *reinterpret_cast<const bf16x8*>(&Vh[(long)((k0) + 32 + sr) * LDK + sc]); \
    sr_[i].ks0 = *reinterpret_cast<const bf16x8*>(&Kh[(long)((k0) + sr) * LDK + sc]); sr_[i].ks1 = *reinterpret_cast<const bf16x8*>(&Kh[(long)((k0) + 32 + sr) * LDK + sc]); } while (0)
#define SWRITE(b, i) do { *(bf16x8*)(V_lds + (b) * SHM_V + vst0) = sr_[i].vs0;          \
    *(bf16x8*)(V_lds + (b) * SHM_V + vst1) = sr_[i].vs1; int kc = sc * 2;               \
    *(bf16x8*)(K_lds + (b) * SHM_K + KSWZ(sr, kc)) = sr_[i].ks0;                       \
    *(bf16x8*)(K_lds + (b) * SHM_K + KSWZ(32 + sr, kc)) = sr_[i].ks1; } while (0)
#define SWAIT() asm volatile("s_waitcnt vmcnt(4)" ::: "memory")
#define RESC(a) do { if (__any((a) < 1.f)) { if (hi == 0) al_l[r32] = (a); asm volatile("s_waitcnt lgkmcnt(0)" ::: "memory"); \
    _Pragma("unroll") for (int d = 0; d < 4; ++d) _Pragma("unroll") for (int r = 0; r < 16; ++r) o[d][r] *= al_l[crow(r, hi)]; } } while (0)
    f32x16 pA0, pA1, pB0, pB1; float mnA, mnB, alA, alB; bf16x8 pa0, pa1, pa2, pa3;
    constexpr int SE = 0, SO = 1;
    __syncthreads();
    SLOAD(SE, 0); asm volatile("s_waitcnt vmcnt(0)" ::: "memory"); SWRITE(0, SE); __syncthreads();
    qkt(pA0, pA1, K_lds, qr, r32, hi); partialSM(pA0, pA1, m_reg, mnA, alA, false);
    SLOAD(SO, KVBLK); if (2 < NT) SLOAD(SE, 2 * KVBLK);
    SWAIT(); SWRITE(1, SO); __syncthreads();
    for (int j = 1; j + 1 < NT; j += 2) {
        SBAR(); qkt(pB0, pB1, K_lds + SHM_K, qr, r32, hi);
        finishSM(pA0, pA1, alA, l_reg, pa0, pa1, pa2, pa3); SBAR();
        SLOAD(SO, (j + 2) * KVBLK); SBAR();
        pv_d0(o, vb0, pa0, pa1, pa2, pa3); partialSM(pB0, pB1, m_reg, mnB, alB, j >= ntw);
        __syncthreads(); SWAIT(); SWRITE(0, SE);
        RESC(alB); __syncthreads();
        SBAR(); qkt(pA0, pA1, K_lds, qr, r32, hi);
        finishSM(pB0, pB1, alB, l_reg, pa0, pa1, pa2, pa3); SBAR();
        if (j + 3 < NT) SLOAD(SE, (j + 3) * KVBLK); SBAR();
        pv_d0(o, vb0 + (int)SHM_V, pa0, pa1, pa2, pa3); partialSM(pA0, pA1, m_reg, mnA, alA, (j + 1) >= ntw);
        __syncthreads(); SWAIT(); SWRITE(1, SO);
        RESC(alA); __syncthreads();
    }
    SBAR(); qkt(pB0, pB1, K_lds + SHM_K, qr, r32, hi);
    finishSM(pA0, pA1, alA, l_reg, pa0, pa1, pa2, pa3); SBAR();
    pv_d0(o, vb0, pa0, pa1, pa2, pa3); partialSM(pB0, pB1, m_reg, mnB, alB, (NT - 1) >= ntw);
    __syncthreads(); RESC(alB);
    finishSM(pB0, pB1, alB, l_reg, pa0, pa1, pa2, pa3); SBAR();
    pv_d0(o, vb0 + (int)SHM_V, pa0, pa1, pa2, pa3);
    if (hi == 0) li_l[r32] = l_reg; asm volatile("s_waitcnt lgkmcnt(0)" ::: "memory");
#pragma unroll
    for (int r = 0; r < 16; ++r) { const float rl = __builtin_amdgcn_rcpf(li_l[crow(r, hi)]);
#pragma unroll
        for (int d = 0; d < 4; ++d) o[d][r] *= rl; }
#undef SLOAD
#undef SWRITE
#undef SWAIT
#undef RESC
}
}

__device__ __forceinline__ void sincos_red(double ang, float& s, float& c) {
    const double k = rint(ang * 0.15915494309189535);
    const float r = (float)(ang - k * 6.283185307179586);
    s = __sinf(r); c = __cosf(r);
}
__device__ __forceinline__ float gelu_tanh(float y) {
    const float z = 0.7978845608028654f * (y + 0.044715f * y * y * y);
    const float th = 1.0f - 2.0f / (1.0f + __expf(2.0f * z));
    return 0.5f * y * (1.0f + th);
}

struct ConvJob { const float* W; bf16_t* Wt; const float* gain; int K, N, glu, tile; };
struct ConvRegs { f32x4 va[4], vb[4]; float ga[4], gb[4]; };
__device__ __forceinline__ ConvJob conv_decode(const Params& p, unsigned char* ws, int t) {
    ConvJob j; j.glu = 0; j.gain = nullptr;
    if (t < 1536) { const int q = t / 768; j.tile = t - q * 768; j.W = p.a_w_in + (size_t)q * 2048 * 6144; j.Wt = (bf16_t*)(ws + OFF_WT_A_IN + q * SZ_A_IN); j.K = 2048; j.N = 6144; j.gain = p.norm_mix + (size_t)(3 * q) * D_; }
    else if (t < 2048) { const int u = t - 1536; const int q = u / 256; j.tile = u - q * 256; j.W = p.a_w_out + (size_t)q * 2048 * 2048; j.Wt = (bf16_t*)(ws + OFF_WT_A_OUT + q * SZ_A_OUT); j.K = 2048; j.N = 2048; }
    else if (t < 2560) { j.tile = t - 2048; j.W = p.b_w_glu; j.Wt = (bf16_t*)(ws + OFF_WT_GLU); j.K = 2048; j.N = 4096; j.glu = 1; }
    else if (t < 4096) { j.tile = t - 2560; j.W = p.c_w_in; j.Wt = (bf16_t*)(ws + OFF_WT_C_IN); j.K = 2048; j.N = 12288; j.gain = p.norm_mix + 2 * D_; }
    else if (t < 4608) { j.tile = t - 4096; j.W = p.c_w_out; j.Wt = (bf16_t*)(ws + OFF_WT_C_OUT); j.K = 4096; j.N = 2048; }
    else if (t < 8704) { const int u = t - 4608; const int i = u / 1024; j.tile = u - i * 1024; j.W = p.mlp_w1 + (size_t)i * 2048 * 8192; j.Wt = (bf16_t*)(ws + OFF_WT_W1 + i * SZ_W1); j.K = 2048; j.N = 8192; j.gain = p.norm_mlp + (size_t)i * D_; }
    else { const int u = t - 8704; const int i = u / 1024; j.tile = u - i * 1024; j.W = p.mlp_w2 + (size_t)i * 8192 * 2048; j.Wt = (bf16_t*)(ws + OFF_WT_W2 + i * SZ_W1); j.K = 8192; j.N = 2048; }
    return j;
}
__device__ __forceinline__ void conv_load(const ConvJob& j, ConvRegs& r, int tid) {
    const int ntn = j.N >> 7; const int tk = j.tile / ntn, tn = j.tile - tk * ntn; const int k0 = tk << 7, n0 = tn << 7;
    const int kp = tid >> 5, nl = (tid & 31) << 2;
#pragma unroll
    for (int i = 0; i < 4; ++i) { const int k = 2 * (kp + 16 * i);
        r.va[i] = *(const f32x4*)(j.W + (size_t)(k0 + k) * j.N + n0 + nl); r.vb[i] = *(const f32x4*)(j.W + (size_t)(k0 + k + 1) * j.N + n0 + nl);
        r.ga[i] = j.gain ? j.gain[k0 + k] : 1.f; r.gb[i] = j.gain ? j.gain[k0 + k + 1] : 1.f; }
}
__device__ __forceinline__ void conv_store(const ConvJob& j, const ConvRegs& r, int tid, unsigned* ldsw) {
    const int ntn = j.N >> 7; const int tk = j.tile / ntn, tn = j.tile - tk * ntn; const int k0 = tk << 7, n0 = tn << 7;
    const int kp = tid >> 5, nl = (tid & 31) << 2;
    __syncthreads();
#pragma unroll
    for (int i = 0; i < 4; ++i) { const int kpair = kp + 16 * i;
#pragma unroll
        for (int jj = 0; jj < 4; ++jj) ldsw[(nl + jj) * 65 + kpair] = cvt_pk_bf16(r.va[i][jj] * r.ga[i], r.vb[i][jj] * r.gb[i]); }
    __syncthreads();
    int nbase = n0;
    if (j.glu) { const int bj = n0 >> 11, pn = (n0 & 2047) >> 7; nbase = 256 * pn + 128 * bj; }
#pragma unroll
    for (int i = 0; i < 4; ++i) { const int n = (tid >> 4) + 32 * i, k8 = tid & 15;
        u32x4 w; w.x = ldsw[n * 65 + k8 * 4 + 0]; w.y = ldsw[n * 65 + k8 * 4 + 1]; w.z = ldsw[n * 65 + k8 * 4 + 2]; w.w = ldsw[n * 65 + k8 * 4 + 3];
        const int c5 = n & 31, np = (n & ~31) | (16 * ((c5 >> 2) & 1) + 4 * (c5 >> 3) + (c5 & 3));
        *(u32x4*)(j.Wt + (size_t)(nbase + np) * j.K + k0 + k8 * 8) = w; }
}

__device__ __forceinline__ void prep_phase(const Params& p, unsigned char* shm) {
    const int tid = otid(), bid = obid(), G = gridDim.x;
    unsigned char* ws = p.ws;
    {
        ConvJob jc = conv_decode(p, ws, bid); ConvRegs rc; conv_load(jc, rc, tid);
#pragma unroll 1
        for (int t = bid; t < 12800; t += G) {
            ConvJob jn = jc; ConvRegs rn = rc;
            if (t + G < 12800) { jn = conv_decode(p, ws, t + G); conv_load(jn, rn, tid); }
            conv_store(jc, rc, tid, (unsigned*)shm);
            jc = jn; rc = rn;
        }
    }
    {
        float* ss = (float*)(ws + OFF_SSP); bf16_t* xb = (bf16_t*)(ws + OFF_XB);
        const int wid = tid >> 6, lane = tid & 63;
        for (int row = bid * 8 + wid; row < T_; row += G * 8) {
            const float* xr = p.x + (size_t)row * D_; float sq = 0.f;
#pragma unroll
            for (int i = 0; i < 8; ++i) { const f32x4 v = *(const f32x4*)(xr + (i * 64 + lane) * 4);
                sq += v[0] * v[0] + v[1] * v[1] + v[2] * v[2] + v[3] * v[3];
                *(f32x4*)(p.out + (size_t)row * D_ + (i * 64 + lane) * 4) = v;
                u32x2 w; w.x = cvt_pk_bf16(v[0], v[1]); w.y = cvt_pk_bf16(v[2], v[3]);
                *(u32x2*)(xb + (size_t)row * D_ + (i * 64 + lane) * 4) = w; }
#pragma unroll
            for (int o = 32; o > 0; o >>= 1) sq += __shfl_xor(sq, o);
            if (lane < 32) ss[(size_t)lane * T_ + row] = (lane == 0) ? sq : 0.f;
        }
        for (int i = bid * 512 + tid; i < 32 * T_; i += G * 512) ss[(size_t)3 * 32 * T_ + i] = 0.f;
        float* rssq = (float*)(ws + OFF_RSQP);
        for (int i = bid * 512 + tid; i < 64 * T_; i += G * 512) rssq[i] = 0.f;
    }
    {
        float* par = (float*)(ws + OFF_PAR);
        for (int i = bid * 512 + tid; i < PAR_N; i += G * 512) {
            float v;
            if (i < PAR_NFINAL) v = p.norm_mix[D_ + i];
            else if (i < PAR_LAM) v = p.norm_final[i - PAR_NFINAL];
            else if (i < PAR_SUBLN) v = p.a_lambda[i - PAR_LAM];
            else if (i < PAR_BD) v = p.a_subln[i - PAR_SUBLN];
            else v = p.b_d[i - PAR_BD];
            par[i] = v;
        }
    }
    {
        f32x2* rot = (f32x2*)(ws + OFF_ROT);
        for (int i = bid * 512 + tid; i < 4096 * 128; i += G * 512) {
            const int pos = i >> 7, j = i & 127;
            const double inv = exp(-9.210340371976184 * ((double)j / 127.0));
            float s, c; sincos_red((double)pos * inv, s, c);
            f32x2 v; v.x = c; v.y = s; rot[i] = v;
        }
    }
    {
        bf16_t* Bm = (bf16_t*)(ws + OFF_S5B); bf16_t* Cm = (bf16_t*)(ws + OFF_S5C); f32x2* AB = (f32x2*)(ws + OFF_S5AB);
        const float* gmix = p.norm_mix + 1 * D_;
        for (int i = bid * 512 + tid; i < 128 * 64; i += G * 512) {
            const int g = i >> 6, pp = i & 63;
            const float lre = p.b_a_re[i], lim = p.b_a_im[i];
            const float dt = __expf(p.b_log_dt[g]);
            const float mag = __expf(lre * dt);
            float sn, cs; sincos_red((double)lim * (double)dt, sn, cs);
            const float abr = mag * cs, abi = mag * sn;
            const float den = lre * lre + lim * lim;
            const float nr = abr - 1.0f, ni = abi;
            const float cr_ = (nr * lre + ni * lim) / den, ci_ = (ni * lre - nr * lim) / den;
            f32x2 ab; ab.x = abr; ab.y = abi; AB[i] = ab;
#pragma unroll
            for (int c = 0; c < 16; ++c) {
                const float br = p.b_b_re[(size_t)i * 16 + c], bi = p.b_b_im[(size_t)i * 16 + c];
                const float gm = gmix[g * 16 + c];
                Bm[((size_t)g * 128 + pp) * 16 + c] = f2bf((cr_ * br - ci_ * bi) * gm);
                Bm[((size_t)g * 128 + 64 + pp) * 16 + c] = f2bf((cr_ * bi + ci_ * br) * gm);
                Cm[((size_t)g * 16 + c) * 128 + pp] = f2bf(p.b_c_re[((size_t)g * 16 + c) * 64 + pp]);
                Cm[((size_t)g * 16 + c) * 128 + 64 + pp] = f2bf(-p.b_c_im[((size_t)g * 16 + c) * 64 + pp]);
            }
        }
    }
}

__device__ __forceinline__ void attn_phase(const Params& p, int j, float lambda_init, unsigned char* shm) {
    const int tid = otid(), wid = __builtin_amdgcn_readfirstlane(tid >> 6), lane = tid & 63, r32 = lane & 31, hi = lane >> 5;
    const bf16_t* qkv = (const bf16_t*)(p.ws + OFF_BIG);
    bf16_t* oa = (bf16_t*)(p.ws + OFF_OA);
    float* scr = (float*)(p.ws + OFF_ATT_SCR) + (size_t)obid() * 2 * 32768;
    float lam;
    { const float* lp = (const float*)(p.ws + OFF_PAR) + PAR_LAM + (size_t)j * 512;
      float a = lp[lane] * lp[128 + lane] + lp[64 + lane] * lp[192 + lane];
      float b = lp[256 + lane] * lp[384 + lane] + lp[320 + lane] * lp[448 + lane];
#pragma unroll
      for (int o = 32; o > 0; o >>= 1) { a += __shfl_xor(a, o); b += __shfl_xor(b, o); }
      lam = __expf(a) - __expf(b) + lambda_init; lam = __uint_as_float(__builtin_amdgcn_readfirstlane(__float_as_uint(lam))); }
    const float* sub = (const float*)(p.ws + OFF_PAR) + PAR_SUBLN + (size_t)j * 256;
    const int c = obid(); const int xcd = c & 7, jj = c >> 3;
    const int bh = xcd * 4 + (jj >> 3), pi = jj & 7;
    const int b = bh >> 3, h = bh & 7;
#pragma unroll 1
    for (int it = 0; it < 2; ++it) {
        const int qb = it == 0 ? (15 - pi) : pi;
        const int NT = 4 * qb + 4, ntw = 4 * qb + (wid >> 1) + 1;
        const size_t tok0 = (size_t)b * S_ + (size_t)qb * 256;
        f32x16 o[4];
#pragma unroll 1
        for (int ps = 0; ps < 4; ++ps) {
            const int e = ps >> 1, t = ps & 1;
            float* sc = scr + e * 32768;
            att::attn_body(qkv + tok0 * 6144 + h * 256 + t * 128, qkv + (size_t)b * S_ * 6144 + 2048 + h * 256 + t * 128,
                           qkv + (size_t)b * S_ * 6144 + 4096 + h * 256 + e * 128, NT, ntw, (char*)shm, o);
            if (t == 0) {
#pragma unroll
                for (int d = 0; d < 4; ++d)
#pragma unroll
                    for (int r = 0; r < 16; ++r) sc[tid * 64 + d * 16 + r] = o[d][r];
            } else {
#pragma unroll
                for (int d = 0; d < 4; ++d)
#pragma unroll
                    for (int r = 0; r < 16; ++r) { const float cv = sc[tid * 64 + d * 16 + r] - lam * o[d][r]; o[d][r] = cv; if (e == 0) sc[tid * 64 + d * 16 + r] = cv; }
            }
        }
        float ssq[16];
#pragma unroll
        for (int r = 0; r < 16; ++r) { float s = 0.f;
#pragma unroll
            for (int d = 0; d < 4; ++d) { const float c0 = scr[tid * 64 + d * 16 + r]; s += c0 * c0 + o[d][r] * o[d][r]; }
#pragma unroll
            for (int of = 16; of > 0; of >>= 1) s += __shfl_xor(s, of);
            ssq[r] = rsqrtf(s * (1.0f / 256.0f) + EPS_) * (1.0f - lambda_init); }
#pragma unroll
        for (int r = 0; r < 16; ++r) {
            const size_t row = tok0 + wid * 32 + att::crow(r, hi);
            bf16_t* op = oa + row * D_ + h * 256;
#pragma unroll
            for (int d = 0; d < 4; ++d) {
                const int col = d * 32 + r32;
                op[col] = f2bf(scr[tid * 64 + d * 16 + r] * ssq[r] * sub[col]);
                op[128 + col] = f2bf(o[d][r] * ssq[r] * sub[128 + col]);
            }
        }
    }
}

template <bool FINAL>
__device__ __forceinline__ void s5_phase(const Params& p, unsigned char* shm) {
    const int tid = otid(), wid = tid >> 6, lane = tid & 63, r32 = lane & 31, hi = lane >> 5, fr = lane & 15, fq = lane >> 4;
    const bf16_t* xb = (const bf16_t*)(p.ws + OFF_XB);
    const float* ss = (const float*)(p.ws + OFF_SSP) + (size_t)2 * 32 * T_;
    float* rsfin = (float*)(p.ws + OFF_RSFIN);
    const bf16_t* Bm = (const bf16_t*)(p.ws + OFF_S5B); const bf16_t* Cm = (const bf16_t*)(p.ws + OFF_S5C); const f32x2* AB = (const f32x2*)(p.ws + OFF_S5AB);
    f32x2* E = (f32x2*)(p.ws + OFF_BIG);
    bf16_t* gl = (bf16_t*)(p.ws + OFF_OA);
    bf16_t* Xs = (bf16_t*)shm + wid * (32 * 136);
    const float* gmix = (const float*)(p.ws + OFF_PAR) + PAR_GMIX; const float* dsk = (const float*)(p.ws + OFF_PAR) + PAR_BD;
    float* partL = (float*)(shm + 8 * 8704); float* rsL = partL + 512;
#pragma unroll 1
    for (int bc = obid(); bc < 256; bc += gridDim.x) {
      const int chunk = bc & 63, b = bc >> 6;
      const size_t t0 = (size_t)b * S_ + chunk * 64;
      __syncthreads();
      if (FINAL) { if (tid < 64) rsL[tid] = rsfin[t0 + tid]; }
      else {
          { const int row = tid & 63, part = tid >> 6; float a = 0.f;
#pragma unroll
            for (int k = 0; k < 4; ++k) a += ss[(size_t)(part * 4 + k) * T_ + t0 + row];
            partL[part * 64 + row] = a; }
          __syncthreads();
          if (tid < 64) { float tot = 0.f;
#pragma unroll
              for (int k = 0; k < 8; ++k) tot += partL[k * 64 + tid];
              const float r = rsqrtf(tot * (1.0f / D_) + EPS_); rsL[tid] = r; rsfin[t0 + tid] = r; }
      }
      __syncthreads();
#pragma unroll 1
      for (int goct = 0; goct < 16; ++goct) {
        const int g = goct * 8 + wid; const int pp = r32 + 32 * hi;
        const f32x2 ab = AB[g * 64 + pp];
        bf16x8 bfr[4];
#pragma unroll
        for (int nb = 0; nb < 4; ++nb) bfr[nb] = *(const bf16x8*)(Bm + ((size_t)g * 128 + nb * 32 + r32) * 16 + hi * 8);
        float xr = 0.f, xi = 0.f;
        bf16x8 cfr[4]; float gm4[4], ds4[4];
        if (FINAL) {
            float pr = ab.x, pi_ = ab.y;
#pragma unroll
            for (int s = 0; s < 6; ++s) { const float nr = pr * pr - pi_ * pi_, ni = 2.f * pr * pi_; pr = nr; pi_ = ni; }
            const f32x2* Ep = E + ((size_t)(b * 128 + g) * 64) * 64 + pp;
            for (int c2 = 0; c2 < chunk; c2 += 8) { f32x2 e8[8];
#pragma unroll
                for (int k = 0; k < 8; ++k) { const int ci = (c2 + k) < 63 ? (c2 + k) : 63; e8[k] = Ep[(size_t)ci * 64]; }
#pragma unroll
                for (int k = 0; k < 8; ++k) if (c2 + k < chunk) { const float nr = pr * xr - pi_ * xi + e8[k].x, ni = pr * xi + pi_ * xr + e8[k].y; xr = nr; xi = ni; } }
#pragma unroll
            for (int ks = 0; ks < 4; ++ks) cfr[ks] = *(const bf16x8*)(Cm + ((size_t)g * 16 + fr) * 128 + ks * 32 + fq * 8);
#pragma unroll
            for (int jx = 0; jx < 4; ++jx) { gm4[jx] = gmix[g * 16 + 4 * fq + jx]; ds4[jx] = dsk[g * 16 + 4 * fq + jx]; }
        }
#pragma unroll
        for (int half = 0; half < 2; ++half) {
            const size_t trow = t0 + half * 32 + r32;
            const float rs = rsL[half * 32 + r32];
            const u32x4 raw = *(const u32x4*)(xb + trow * D_ + g * 16 + hi * 8);
            u32x4 sc4;
            sc4.x = cvt_pk_bf16(bflo(raw.x) * rs, bfhi(raw.x) * rs); sc4.y = cvt_pk_bf16(bflo(raw.y) * rs, bfhi(raw.y) * rs);
            sc4.z = cvt_pk_bf16(bflo(raw.z) * rs, bfhi(raw.z) * rs); sc4.w = cvt_pk_bf16(bflo(raw.w) * rs, bfhi(raw.w) * rs);
            const bf16x8 afr = *reinterpret_cast<const bf16x8*>(&sc4);
            f32x16 c0 = __builtin_amdgcn_mfma_f32_32x32x16_bf16(afr, bfr[0], f32x16{}, 0, 0, 0);
            f32x16 c1 = __builtin_amdgcn_mfma_f32_32x32x16_bf16(afr, bfr[1], f32x16{}, 0, 0, 0);
            f32x16 c2 = __builtin_amdgcn_mfma_f32_32x32x16_bf16(afr, bfr[2], f32x16{}, 0, 0, 0);
            f32x16 c3 = __builtin_amdgcn_mfma_f32_32x32x16_bf16(afr, bfr[3], f32x16{}, 0, 0, 0);
#pragma unroll
            for (int i = 0; i < 16; ++i) {
                auto r0 = __builtin_amdgcn_permlane32_swap(__float_as_uint(c0[i]), __float_as_uint(c1[i]), false, false);
                c0[i] = __uint_as_float(r0[0]); c1[i] = __uint_as_float(r0[1]);
                auto r1 = __builtin_amdgcn_permlane32_swap(__float_as_uint(c2[i]), __float_as_uint(c3[i]), false, false);
                c2[i] = __uint_as_float(r1[0]); c3[i] = __uint_as_float(r1[1]);
            }
#pragma unroll
            for (int t = 0; t < 32; ++t) {
                const int q = t >> 3, s = t & 7, idx = 4 * q + (s & 3);
                const float bur = (s < 4) ? c0[idx] : c1[idx], bui = (s < 4) ? c2[idx] : c3[idx];
                const float nr = ab.x * xr - ab.y * xi + bur, ni = ab.x * xi + ab.y * xr + bui;
                xr = nr; xi = ni;
                if (FINAL) { Xs[t * 136 + pp] = f2bf(xr); Xs[t * 136 + 64 + pp] = f2bf(xi); }
            }
            if (FINAL) {
                asm volatile("s_waitcnt lgkmcnt(0)" ::: "memory");
#pragma unroll
                for (int m = 0; m < 2; ++m) {
                    f32x4 acc = {0.f, 0.f, 0.f, 0.f};
#pragma unroll
                    for (int ks = 0; ks < 4; ++ks) {
                        const bf16x8 xf = *(const bf16x8*)(Xs + (m * 16 + fr) * 136 + ks * 32 + fq * 8);
                        acc = __builtin_amdgcn_mfma_f32_16x16x32_bf16(cfr[ks], xf, acc, 0, 0, 0);
                    }
                    const size_t tr2 = t0 + half * 32 + m * 16 + fr;
                    const float rs2 = rsL[half * 32 + m * 16 + fr];
                    const u32x2 hx = *(const u32x2*)(xb + tr2 * D_ + g * 16 + 4 * fq);
                    const float h0 = bflo(hx.x) * rs2 * gm4[0], h1 = bfhi(hx.x) * rs2 * gm4[1], h2 = bflo(hx.y) * rs2 * gm4[2], h3 = bfhi(hx.y) * rs2 * gm4[3];
                    const float y0 = gelu_tanh(acc[0] + ds4[0] * h0), y1 = gelu_tanh(acc[1] + ds4[1] * h1), y2 = gelu_tanh(acc[2] + ds4[2] * h2), y3 = gelu_tanh(acc[3] + ds4[3] * h3);
                    u32x2 w; w.x = cvt_pk_bf16(y0, y1); w.y = cvt_pk_bf16(y2, y3);
                    *(u32x2*)(gl + tr2 * D_ + g * 16 + 4 * fq) = w;
                }
                asm volatile("s_waitcnt lgkmcnt(0)" ::: "memory");
            }
        }
        if (!FINAL) { f32x2 e; e.x = xr; e.y = xi; E[((size_t)(b * 128 + g) * 64 + chunk) * 64 + pp] = e; }
      }
    }
}

__device__ __forceinline__ void ret_phase(const Params& p, unsigned char* shm, float* rssq) {
    const int tid = otid(), wid = tid >> 6, lane = tid & 63, fr = lane & 15, fq = lane >> 4;
    const bf16_t* ret = (const bf16_t*)(p.ws + OFF_BIG);
    bf16_t* ao = (bf16_t*)(p.ws + OFF_OA);
    constexpr int QS = 264, TS = 72;
    bf16_t* Qs = (bf16_t*)shm; bf16_t* Ks = Qs + 64 * QS; bf16_t* KTs = Ks + 64 * QS; bf16_t* VTs = KTs + 256 * TS; bf16_t* Ss = VTs + 64 * TS; bf16_t* RTs = Ss + 64 * TS;
    const int c = obid(); const int xcd = c & 7, jj = c >> 3;
    const int bh = xcd * 4 + (jj >> 3), sl = jj & 7;
    const int b = bh >> 3, h = bh & 7;
    const float lg = logf(1.0f - exp2f(-5.0f - (float)h));
    const float cdec = __expf(lg * 64.0f);
    const int mi = wid >> 1, ni0 = 2 * (wid & 1);
    const float qdec = __expf(lg * (float)(16 * mi + fr + 1));
    float idec[2][4];
#pragma unroll
    for (int t = 0; t < 2; ++t)
#pragma unroll
        for (int j = 0; j < 4; ++j) { const int n = 16 * mi + fr, m = 16 * (ni0 + t) + 4 * fq + j; idec[t][j] = __expf(lg * (fabsf((float)(n - m)) - (float)(63 - m))); }
    f32x4 R[4][2];
#pragma unroll
    for (int a = 0; a < 4; ++a)
#pragma unroll
        for (int d = 0; d < 2; ++d) R[a][d] = (f32x4){0.f, 0.f, 0.f, 0.f};
    const size_t tokb = (size_t)b * S_;
    const bf16_t* qsrc = ret + (tokb + lane) * 12288 + h * 256 + wid * 32;
    const bf16_t* ksrc = qsrc + 2048;
    const bf16_t* vsrc = ret + (tokb + lane) * 12288 + 4096 + h * 512 + sl * 64 + wid * 8;
    u32x4 pq[4], pk[4], pv; u32x2 pg[2], cg2[2];
    const bf16_t* gsrc = ret + (tokb + 16 * mi + fr) * 12288 + 8192 + h * 512 + sl * 64 + 16 * ni0 + 4 * fq;
#pragma unroll
    for (int j = 0; j < 4; ++j) { pq[j] = *(const u32x4*)(qsrc + j * 8); pk[j] = *(const u32x4*)(ksrc + j * 8); }
    pv = *(const u32x4*)vsrc;
    pg[0] = *(const u32x2*)gsrc; pg[1] = *(const u32x2*)(gsrc + 16);
    for (int ch = 0; ch < 64; ++ch) {
        __syncthreads();
        cg2[0] = pg[0]; cg2[1] = pg[1];
#pragma unroll
        for (int j = 0; j < 4; ++j) {
            *(u32x4*)(Qs + lane * QS + wid * 32 + j * 8) = pq[j];
            *(u32x4*)(Ks + lane * QS + wid * 32 + j * 8) = pk[j];
            const unsigned kw[4] = {pk[j].x, pk[j].y, pk[j].z, pk[j].w};
#pragma unroll
            for (int i = 0; i < 4; ++i) {
                KTs[(wid * 32 + j * 8 + 2 * i) * TS + lane] = (bf16_t)(kw[i] & 0xffffu);
                KTs[(wid * 32 + j * 8 + 2 * i + 1) * TS + lane] = (bf16_t)(kw[i] >> 16);
            }
        }
        { const unsigned vw[4] = {pv.x, pv.y, pv.z, pv.w};
#pragma unroll
          for (int i = 0; i < 4; ++i) { VTs[(wid * 8 + 2 * i) * TS + lane] = (bf16_t)(vw[i] & 0xffffu); VTs[(wid * 8 + 2 * i + 1) * TS + lane] = (bf16_t)(vw[i] >> 16); } }
#pragma unroll
        for (int ei = 0; ei < 4; ++ei)
#pragma unroll
            for (int di = 0; di < 2; ++di) { u32x2 w; w.x = cvt_pk_bf16(R[ei][di][0], R[ei][di][1]); w.y = cvt_pk_bf16(R[ei][di][2], R[ei][di][3]);
                *(u32x2*)(RTs + (16 * ei + fr) * QS + wid * 32 + 16 * di + 4 * fq) = w; }
        if (ch + 1 < 64) {
            const size_t adv = (size_t)(ch + 1) * 64 * 12288;
#pragma unroll
            for (int j = 0; j < 4; ++j) { pq[j] = *(const u32x4*)(qsrc + adv + j * 8); pk[j] = *(const u32x4*)(ksrc + adv + j * 8); }
            pv = *(const u32x4*)(vsrc + adv);
            pg[0] = *(const u32x2*)(gsrc + adv); pg[1] = *(const u32x2*)(gsrc + adv + 16);
        }
        __syncthreads();
        {
            f32x4 sacc[2] = {{0.f, 0.f, 0.f, 0.f}, {0.f, 0.f, 0.f, 0.f}};
#pragma unroll
            for (int ks = 0; ks < 8; ++ks) {
                const bf16x8 af = *(const bf16x8*)(Qs + (16 * mi + fr) * QS + ks * 32 + fq * 8);
#pragma unroll
                for (int t = 0; t < 2; ++t) { const bf16x8 bf = *(const bf16x8*)(Ks + (16 * (ni0 + t) + fr) * QS + ks * 32 + fq * 8);
                    sacc[t] = __builtin_amdgcn_mfma_f32_16x16x32_bf16(bf, af, sacc[t], 0, 0, 0); }
            }
#pragma unroll
            for (int t = 0; t < 2; ++t) { u32x2 w; w.x = cvt_pk_bf16(sacc[t][0] * idec[t][0], sacc[t][1] * idec[t][1]); w.y = cvt_pk_bf16(sacc[t][2] * idec[t][2], sacc[t][3] * idec[t][3]);
                *(u32x2*)(Ss + (16 * mi + fr) * TS + 16 * (ni0 + t) + 4 * fq) = w; }
        }
        __syncthreads();
        {
            f32x4 oi[2] = {{0.f, 0.f, 0.f, 0.f}, {0.f, 0.f, 0.f, 0.f}}, oc[2] = {{0.f, 0.f, 0.f, 0.f}, {0.f, 0.f, 0.f, 0.f}};
#pragma unroll
            for (int ks = 0; ks < 2; ++ks) {
                const bf16x8 af = *(const bf16x8*)(Ss + (16 * mi + fr) * TS + ks * 32 + fq * 8);
#pragma unroll
                for (int t = 0; t < 2; ++t) { const bf16x8 bf = *(const bf16x8*)(VTs + (16 * (ni0 + t) + fr) * TS + ks * 32 + fq * 8);
                    oi[t] = __builtin_amdgcn_mfma_f32_16x16x32_bf16(bf, af, oi[t], 0, 0, 0); }
            }
#pragma unroll
            for (int ks = 0; ks < 8; ++ks) {
                const bf16x8 af = *(const bf16x8*)(Qs + (16 * mi + fr) * QS + ks * 32 + fq * 8);
#pragma unroll
                for (int t = 0; t < 2; ++t) { const bf16x8 bf = *(const bf16x8*)(RTs + (16 * (ni0 + t) + fr) * QS + ks * 32 + fq * 8);
                    oc[t] = __builtin_amdgcn_mfma_f32_16x16x32_bf16(bf, af, oc[t], 0, 0, 0); }
            }
            const size_t tok = tokb + (size_t)ch * 64 + 16 * mi + fr;
            float sq = 0.f;
#pragma unroll
            for (int t = 0; t < 2; ++t) {
                const int e = sl * 64 + 16 * (ni0 + t) + 4 * fq;
                const u32x2 gw = cg2[t];
                f32x4 ov = oi[t] + oc[t] * qdec;
                sq += ov[0] * ov[0] + ov[1] * ov[1] + ov[2] * ov[2] + ov[3] * ov[3];
                u32x2 w; w.x = cvt_pk_bf16(ov[0] * bflo(gw.x), ov[1] * bfhi(gw.x)); w.y = cvt_pk_bf16(ov[2] * bflo(gw.y), ov[3] * bfhi(gw.y));
                *(u32x2*)(ao + tok * 4096 + h * 512 + e) = w;
            }
            sq += __shfl_xor(sq, 16); sq += __shfl_xor(sq, 32);
            if (fq == 0) atomicAdd(rssq + (size_t)(sl * 4 + mi) * 0 + (size_t)sl * (T_ * 8) + tok * 8 + h, sq);
        }
#pragma unroll
        for (int ei = 0; ei < 4; ++ei)
#pragma unroll
            for (int di = 0; di < 2; ++di) R[ei][di] *= cdec;
#pragma unroll
        for (int ks = 0; ks < 2; ++ks) {
            bf16x8 bfk[2];
#pragma unroll
            for (int di = 0; di < 2; ++di) bfk[di] = *(const bf16x8*)(KTs + (wid * 32 + 16 * di + fr) * TS + ks * 32 + fq * 8);
#pragma unroll
            for (int ei = 0; ei < 4; ++ei) { const bf16x8 af = *(const bf16x8*)(VTs + (16 * ei + fr) * TS + ks * 32 + fq * 8);
#pragma unroll
                for (int di = 0; di < 2; ++di) R[ei][di] = __builtin_amdgcn_mfma_f32_16x16x32_bf16(bfk[di], af, R[ei][di], 0, 0, 0); }
        }
    }
}

__device__ __forceinline__ void ret2_phase(const Params& p) {
    bf16_t* ao = (bf16_t*)(p.ws + OFF_OA); const float* rssq = (const float*)(p.ws + OFF_RSQP);
    const size_t nvec = (size_t)T_ * 4096 / 8;
    for (size_t i = (size_t)obid() * 512 + otid(); i < nvec; i += (size_t)gridDim.x * 512) {
        const size_t t = i >> 9; const int hh = (int)((i & 511) >> 6);
        float rsum = 0.f;
#pragma unroll
        for (int sl = 0; sl < 8; ++sl) rsum += rssq[(size_t)sl * (T_ * 8) + t * 8 + hh];
        const float rs = rsqrtf(rsum * (1.0f / 512.0f) + EPS_);
        u32x4 w = *(u32x4*)(ao + i * 8);
        w.x = cvt_pk_bf16(bflo(w.x) * rs, bfhi(w.x) * rs); w.y = cvt_pk_bf16(bflo(w.y) * rs, bfhi(w.y) * rs);
        w.z = cvt_pk_bf16(bflo(w.z) * rs, bfhi(w.z) * rs); w.w = cvt_pk_bf16(bflo(w.w) * rs, bfhi(w.w) * rs);
        *(u32x4*)(ao + i * 8) = w;
    }
}

__device__ __forceinline__ void final_phase(const Params& p) {
    const float* ss = (const float*)(p.ws + OFF_SSP) + (size_t)8 * 32 * T_;
    const int tid = otid();
    const f32x4 g = *(const f32x4*)((const float*)(p.ws + OFF_PAR) + PAR_NFINAL + tid * 4);
    for (int row = obid(); row < T_; row += gridDim.x) {
        float ssum = ss[(size_t)(tid & 31) * T_ + row];
#pragma unroll
        for (int o = 16; o > 0; o >>= 1) ssum += __shfl_xor(ssum, o);
        const float rs = rsqrtf(ssum * (1.0f / D_) + EPS_);
        f32x4 v = *(f32x4*)(p.out + (size_t)row * D_ + tid * 4);
        v = v * rs * g;
        *(f32x4*)(p.out + (size_t)row * D_ + tid * 4) = v;
    }
}

enum { OP_PREP = 0, OP_A_IN, OP_ATTN, OP_A_OUT, OP_S5A, OP_S5C, OP_GLU, OP_C_IN, OP_RET, OP_RET2, OP_C_OUT, OP_W1, OP_W2, OP_FINAL };
#ifndef PHMASK
#define PHMASK 0xffff
#endif
#define PHON(b) ((PHMASK >> (b)) & 1)
constexpr int NPH = 23;
__device__ const unsigned char PROG_OP[NPH] = { OP_PREP,
    OP_A_IN, OP_ATTN, OP_A_OUT, OP_W1, OP_W2,
    OP_S5A, OP_S5C, OP_GLU, OP_W1, OP_W2,
    OP_C_IN, OP_RET, OP_RET2, OP_C_OUT, OP_W1, OP_W2,
    OP_A_IN, OP_ATTN, OP_A_OUT, OP_W1, OP_W2,
    OP_FINAL };
__device__ const unsigned char PROG_LAYER[NPH] = { 0, 0, 0, 0, 0, 0, 1, 1, 1, 1, 1, 2, 2, 2, 2, 2, 2, 3, 3, 3, 3, 3, 3 };

struct GemmDesc { unsigned long long a_off, b_off; int N, K, ss_idx, mode; };
#define GD_NONE {0, 0, 0, 0, 0, 0}
#define GD_A_IN(L)  {OFF_XB, OFF_WT_A_IN + (L / 3) * SZ_A_IN, 6144, 2048, 2 * L, 0}
#define GD_A_OUT(L) {OFF_OA, OFF_WT_A_OUT + (L / 3) * SZ_A_OUT, 2048, 2048, 2 * L + 1, 0}
#define GD_W1(L)    {OFF_XB, OFF_WT_W1 + L * SZ_W1, 8192, 2048, 2 * L + 1, 1}
#define GD_W2(L)    {OFF_BIG, OFF_WT_W2 + L * SZ_W1, 2048, 8192, 2 * L + 2, 0}
#define GD_GLU(L)   {OFF_OA, OFF_WT_GLU, 4096, 2048, 2 * L + 1, 1}
#define GD_C_IN(L)  {OFF_XB, OFF_WT_C_IN, 12288, 2048, 2 * L, 2}
#define GD_C_OUT(L) {OFF_OA, OFF_WT_C_OUT, 2048, 4096, 2 * L + 1, 0}
__device__ const GemmDesc GD[NPH] = { GD_NONE,
    GD_A_IN(0ull), GD_NONE, GD_A_OUT(0ull), GD_W1(0ull), GD_W2(0ull),
    GD_NONE, GD_NONE, GD_GLU(1ull), GD_W1(1ull), GD_W2(1ull),
    GD_C_IN(2ull), GD_NONE, GD_NONE, GD_C_OUT(2ull), GD_W1(2ull), GD_W2(2ull),
    GD_A_IN(3ull), GD_NONE, GD_A_OUT(3ull), GD_W1(3ull), GD_W2(3ull),
    GD_NONE };

__device__ __forceinline__ void gsync(cg::grid_group& grid) {
    asm volatile("s_waitcnt vmcnt(0) lgkmcnt(0)" ::: "memory");
    grid.sync();
    __builtin_amdgcn_fence(__ATOMIC_ACQUIRE, "agent");
    asm volatile("s_waitcnt vmcnt(0) lgkmcnt(0)" ::: "memory");
}

__global__ void __launch_bounds__(512, 2) fwd_megakernel(Params p, int ph_lo, int ph_hi) {
    extern __shared__ __attribute__((aligned(16))) unsigned char shm[];
    cg::grid_group grid = cg::this_grid();
#ifndef DUPMASK
#define DUPMASK 0
#endif
    if (PHON(0) && ph_lo == 0) {
#pragma unroll 1
        for (int rp_ = 0; rp_ < ((DUPMASK & 1) ? 2 : 1); ++rp_) { prep_phase(p, shm); if (ph_hi > 1) gsync(grid); } }
    for (int ph = (ph_lo < 1 ? 1 : ph_lo); ph < ph_hi; ++ph) {
        const int op = PROG_OP[ph], L = PROG_LAYER[ph];
        const int nrep_ = ((DUPMASK >> op) & 1) ? 2 : 1;
#pragma unroll 1
        for (int rp_ = 0; rp_ < nrep_; ++rp_) {
        unsigned char* ws = p.ws; asm volatile("" : "+s"(ws));
        float* ssb = (float*)(ws + OFF_SSP);
        if (PHON(1) && (op == OP_A_IN || op == OP_C_IN || op == OP_W1)) {
            const GemmDesc gd = GD[ph];
            pg8::Gemm g; g.A = (const bf16_t*)(ws + gd.a_off); g.Bt = (const bf16_t*)(ws + gd.b_off); g.M = T_; g.N = gd.N; g.K = gd.K;
            pg8::EpiBf E; E.rot = (const f32x2*)(ws + OFF_ROT); E.O = (bf16_t*)(ws + OFF_BIG); E.ldc = gd.N; E.mode = gd.mode; E.ss = ssb + (size_t)gd.ss_idx * 32 * T_;
            pg8::StaticOrder S; S.init(g.M, g.N, (int)gridDim.x, obid());
            pg8::gemm_phase<pg8::EpiBf, pg8::StaticOrder>((LAS unsigned char*)shm, g, S, E);
        } else if (PHON(2) && (op == OP_A_OUT || op == OP_GLU || op == OP_C_OUT || op == OP_W2)) {
            const GemmDesc gd = GD[ph];
            pg8::Gemm g; g.A = (const bf16_t*)(ws + gd.a_off); g.Bt = (const bf16_t*)(ws + gd.b_off); g.M = T_; g.N = gd.N; g.K = gd.K;
            pg8::EpiRes E; E.xout = p.out; E.xb = (bf16_t*)(ws + OFF_XB); E.glu = gd.mode; E.xin = p.out; E.ssn = ssb + (size_t)gd.ss_idx * 32 * T_;
            pg8::StaticOrder S; S.init(g.M, g.N, (int)gridDim.x, obid());
            pg8::gemm_phase<pg8::EpiRes, pg8::StaticOrder>((LAS unsigned char*)shm, g, S, E);
        } else if (PHON(3) && op == OP_ATTN) {
            const float li = 0.8f - 0.6f * expf(-0.3f * (float)L);
            attn_phase(p, L / 3, li, shm);
        } else if (PHON(4) && op == OP_S5A) {
            s5_phase<false>(p, shm);
        } else if (PHON(5) && op == OP_S5C) {
            s5_phase<true>(p, shm);
        } else if (PHON(6) && op == OP_RET) {
            ret_phase(p, shm, (float*)(ws + (rp_ == 0 ? OFF_RSQP : OFF_XB)));
        } else if (PHON(7) && op == OP_RET2) {
            ret2_phase(p);
        } else if (PHON(8) && op == OP_FINAL) {
            final_phase(p);
        }
        if (ph + 1 < ph_hi || rp_ + 1 < nrep_) gsync(grid);
        }
    }
}

extern "C" void kernel_launch(void* const* d_in, const int* in_sizes, int n_in, void* d_out, int out_size, void* d_ws, size_t ws_size, hipStream_t stream) {
    static int grid_blocks = 0;
    if (grid_blocks == 0) {
        if (n_in != 21 || out_size != T_ * D_ || ws_size < WS_NEED) { fprintf(stderr, "kernel_launch: unexpected shapes n_in %d out %d ws %zu (need %zu)\n", n_in, out_size, ws_size, (size_t)WS_NEED); grid_blocks = -1; return; }
        int dev = 0, cus = 0, per_cu = 0;
        hipGetDevice(&dev);
        hipDeviceGetAttribute(&cus, hipDeviceAttributeMultiprocessorCount, dev);
        if (hipFuncSetAttribute((const void*)fwd_megakernel, hipFuncAttributeMaxDynamicSharedMemorySize, LDS_BYTES) != hipSuccess) { fprintf(stderr, "kernel_launch: hipFuncSetAttribute failed\n"); grid_blocks = -1; return; }
        hipOccupancyMaxActiveBlocksPerMultiprocessor(&per_cu, (const void*)fwd_megakernel, 512, LDS_BYTES);
        (void)hipGetLastError();
        if (per_cu < 1) per_cu = 1;
        grid_blocks = cus * 1;
        if (grid_blocks != 256) fprintf(stderr, "kernel_launch: note: %d CUs (kernel tuned for 256)\n", cus);
    }
    if (grid_blocks < 0) return;
    Params p{};
    const float** pp = (const float**)&p;
    for (int i = 0; i < 21; ++i) pp[i] = (const float*)d_in[i];
    p.out = (float*)d_out; p.ws = (unsigned char*)d_ws;
#ifndef DBG_LO
#define DBG_LO 0
#endif
#ifndef DBG_HI
#define DBG_HI NPH
#endif
    int lo = DBG_LO, hi = DBG_HI;
    void* args[] = {&p, &lo, &hi};
    hipError_t e = hipLaunchCooperativeKernel((const void*)fwd_megakernel, dim3(grid_blocks), dim3(512), args, LDS_BYTES, stream);
    if (e != hipSuccess) fprintf(stderr, "cooperative launch failed: %s (grid %d)\n", hipGetErrorString(e), grid_blocks);
}
```

```cpp
#include <hip/hip_runtime.h>
#include <hip/hip_cooperative_groups.h>
#include <cstdio>
#include <cstdint>
namespace cg = cooperative_groups;

#define LAS __attribute__((address_space(3)))
typedef unsigned short bf16_t;
typedef short bf16x8 __attribute__((ext_vector_type(8)));
typedef short s16x4 __attribute__((ext_vector_type(4)));
typedef float f32x4 __attribute__((ext_vector_type(4)));
typedef float f32x2 __attribute__((ext_vector_type(2)));
typedef float f32x16 __attribute__((ext_vector_type(16)));
typedef unsigned u32x4 __attribute__((ext_vector_type(4)));
typedef unsigned u32x2 __attribute__((ext_vector_type(2)));

constexpr int T_ = 16384, D_ = 2048, S_ = 4096;
constexpr float EPS_ = 1e-6f;
constexpr int LDS_PHASE_BYTES = 156672;
constexpr int LDS_BYTES = LDS_PHASE_BYTES + 16;

constexpr size_t SZ_A_IN = 6144ull * 2048 * 2, SZ_A_OUT = 2048ull * 2048 * 2, SZ_W1 = 8192ull * 2048 * 2;
constexpr size_t OFF_WT_A_IN = 0;
constexpr size_t OFF_WT_A_OUT = OFF_WT_A_IN + 2 * SZ_A_IN;
constexpr size_t OFF_WT_GLU = OFF_WT_A_OUT + 2 * SZ_A_OUT;
constexpr size_t OFF_WT_C_IN = OFF_WT_GLU + 4096ull * 2048 * 2;
constexpr size_t OFF_WT_C_OUT = OFF_WT_C_IN + 12288ull * 2048 * 2;
constexpr size_t OFF_WT_W1 = OFF_WT_C_OUT + 2048ull * 4096 * 2;
constexpr size_t OFF_WT_W2 = OFF_WT_W1 + 4 * SZ_W1;
constexpr size_t OFF_XB = OFF_WT_W2 + 4 * SZ_W1;
constexpr size_t OFF_BIG = OFF_XB + (size_t)T_ * D_ * 2;
constexpr size_t OFF_OA = OFF_BIG + (size_t)T_ * 12288 * 2;
constexpr size_t OFF_SS = OFF_OA + (size_t)T_ * 4096 * 2;
constexpr size_t OFF_RSSQ = OFF_SS + 9ull * T_ * 4;
constexpr size_t OFF_ROT = OFF_RSSQ + (size_t)T_ * 8 * 4;
constexpr size_t OFF_S5B = OFF_ROT + 4096ull * 128 * 8;
constexpr size_t OFF_S5C = OFF_S5B + 128ull * 128 * 16 * 2;
constexpr size_t OFF_S5AB = OFF_S5C + 128ull * 16 * 128 * 2;
constexpr size_t WS_END = OFF_S5AB + 128ull * 64 * 8;
constexpr size_t OFF_SSP = WS_END;
constexpr size_t OFF_RSQP = OFF_SSP + 9ull * 32 * T_ * 4;
constexpr size_t OFF_RSFIN = OFF_RSQP + 8ull * T_ * 8 * 4;
constexpr size_t OFF_BAR = OFF_RSFIN + (size_t)T_ * 4;
constexpr size_t OFF_PAR = OFF_BAR + 16384;
constexpr int PAR_GMIX = 0, PAR_NFINAL = 2048, PAR_LAM = 4096, PAR_SUBLN = 5120, PAR_BD = 5632, PAR_N = 7680;
constexpr size_t WS_NEED = OFF_PAR + PAR_N * 4;
constexpr size_t OFF_ATT_SCR = OFF_BIG + (size_t)T_ * 6144 * 2;

struct Params {
    const float* x; const float* norm_mix; const float* norm_mlp; const float* norm_final;
    const float* a_w_in; const float* a_lambda; const float* a_subln; const float* a_w_out;
    const float* b_a_re; const float* b_a_im; const float* b_log_dt; const float* b_b_re; const float* b_b_im;
    const float* b_c_re; const float* b_c_im; const float* b_d; const float* b_w_glu;
    const float* c_w_in; const float* c_w_out; const float* mlp_w1; const float* mlp_w2;
    float* out; unsigned char* ws;
};

__device__ __forceinline__ unsigned cvt_pk_bf16(float lo, float hi) { unsigned r; asm volatile("v_cvt_pk_bf16_f32 %0, %1, %2" : "=v"(r) : "v"(lo), "v"(hi)); return r; }
__device__ __forceinline__ float bf2f(unsigned short b) { return __uint_as_float(((unsigned)b) << 16); }
__device__ __forceinline__ float bflo(unsigned w) { return __uint_as_float(w << 16); }
__device__ __forceinline__ float bfhi(unsigned w) { return __uint_as_float(w & 0xffff0000u); }
__device__ __forceinline__ unsigned short f2bf(float f) { return (unsigned short)(cvt_pk_bf16(f, 0.f) & 0xffffu); }

__device__ __forceinline__ int otid() { int t = threadIdx.x; asm volatile("" : "+v"(t)); return t; }
__device__ __forceinline__ int obid() { int t = blockIdx.x; asm volatile("" : "+s"(t)); return t; }

namespace pg8 {
constexpr int BM = 256, BK = 64, HALF = 128, HTB = HALF * BK * 2, STAGE_BYTES = 8 * HTB, NXCD = 8, WGM = 8;
__device__ __forceinline__ int lds_byte(int r, int c) { const int st = (r >> 4) * 2 + (c >> 5), rr = r & 15, cc = c & 31, ob = rr * 64 + cc * 2; return st * 1024 + (ob ^ (((ob >> 9) & 1) << 5)); }
__device__ __forceinline__ void stage_rc(int b, int& R, int& C) { const int st = b / 1024, sb = b % 1024, swz = sb ^ (((sb >> 9) & 1) << 5); R = (st >> 1) * 16 + swz / 64; C = (st & 1) * 32 + (swz % 64) / 2; }
struct Unit { int pm, pn; };
struct Gemm { const bf16_t* A; const bf16_t* Bt; int M, N, K; };
struct StaticOrder {
    int nM, nN, nwg, G, c;
    __device__ void init(int M, int N, int G_, int c_) { nM = M / BM; nN = N / BM; nwg = nM * nN; G = G_; c = c_; }
    __device__ bool next(int i, Unit& u) const {
        const long L = (long)i * G + c; if (L >= nwg) return false;
        int wgid = (int)L; { const int q = nwg / NXCD, r = nwg % NXCD, xcd = wgid % NXCD, off = wgid / NXCD; wgid = (xcd < r ? xcd * (q + 1) : r * (q + 1) + (xcd - r) * q) + off; }
        const int nig = WGM * nN, gid = wgid / nig, fm = gid * WGM, gsz = (nM - fm) < WGM ? (nM - fm) : WGM;
        u.pm = fm + ((wgid % nig) % gsz); u.pn = (wgid % nig) / gsz; return true;
    }
};

#define GAS __attribute__((address_space(1)))
struct EpiBf {
    bf16_t* O; int ldc; const float* ss; int mode; const f32x2* rot;
    __device__ __forceinline__ void operator()(const f32x4 (&acc)[2][2][4][2], const Unit& u, int wr, int wc, int fr, int fq) const {
        const int row0 = u.pm * BM + wr * 64 + fr, colt = u.pn * BM + wc * 32 + 8 * fq;
        int sub = 0;
        if (mode == 1) sub = 1;
        else if (mode == 2) { sub = u.pn < 8 ? 2 : (u.pn < 16 ? 3 : (u.pn < 32 ? 0 : 4)); }
        const GAS float* ssg = (const GAS float*)ss + (size_t)(fq * 8) * T_ + row0;
        float rs8[8];
#pragma unroll
        for (int r = 0; r < 8; ++r) { float a = 0.f;
#pragma unroll
            for (int sl = 0; sl < 8; ++sl) a += ssg[(size_t)sl * T_ + (r >> 2) * HALF + (r & 3) * 16];
            rs8[r] = a; }
#pragma unroll
        for (int r = 0; r < 8; ++r) { float a = rs8[r]; a += __shfl_xor(a, 16); a += __shfl_xor(a, 32); rs8[r] = rsqrtf(a * (1.0f / D_) + EPS_); }
        GAS bf16_t* Og = (GAS bf16_t*)O;
        if (sub == 2 || sub == 3) {
            const GAS f32x2* rotg = (const GAS f32x2*)rot + wc * 32 + 8 * fq;
#pragma unroll
            for (int ai = 0; ai < 2; ++ai) {
                f32x2 cs[4][2][4];
#pragma unroll
                for (int m = 0; m < 4; ++m) { const int row = row0 + ai * HALF + m * 16; const GAS f32x2* rp = rotg + (size_t)(row & (S_ - 1)) * 128;
#pragma unroll
                    for (int n = 0; n < 2; ++n)
#pragma unroll
                        for (int j = 0; j < 4; ++j) cs[m][n][j] = rp[n * 4 + j]; }
#pragma unroll
                for (int m = 0; m < 4; ++m) { const int row = row0 + ai * HALF + m * 16;
                    float ksc = rs8[ai * 4 + m];
                    if (sub == 3) { const float lgam = logf(1.0f - exp2f(-5.0f - (float)(u.pn - 8))); ksc *= 0.0625f * __expf(lgam * (float)(63 - (row & 63))); }
                    GAS bf16_t* rowp = Og + (size_t)row * ldc + colt;
                    u32x4 w1, w2;
#pragma unroll
                    for (int n = 0; n < 2; ++n) {
                        const f32x4 t1 = acc[ai][0][m][n] * ksc, t2 = acc[ai][1][m][n] * ksc;
                        f32x4 o1, o2;
#pragma unroll
                        for (int j = 0; j < 4; ++j) { const f32x2 c2 = cs[m][n][j]; o1[j] = t1[j] * c2.x - t2[j] * c2.y; o2[j] = t1[j] * c2.y + t2[j] * c2.x; }
                        w1[2 * n] = cvt_pk_bf16(o1[0], o1[1]); w1[2 * n + 1] = cvt_pk_bf16(o1[2], o1[3]); w2[2 * n] = cvt_pk_bf16(o2[0], o2[1]); w2[2 * n + 1] = cvt_pk_bf16(o2[2], o2[3]);
                    }
                    *(GAS u32x4*)(rowp) = w1; *(GAS u32x4*)(rowp + HALF) = w2;
                }
            }
        } else {
#pragma unroll
            for (int ai = 0; ai < 2; ++ai)
#pragma unroll
                for (int m = 0; m < 4; ++m) {
                    const int row = row0 + ai * HALF + m * 16;
                    const float rs = rs8[ai * 4 + m];
                    GAS bf16_t* rowp = Og + (size_t)row * ldc + colt;
#pragma unroll
                    for (int bj = 0; bj < 2; ++bj) {
                        u32x4 w;
#pragma unroll
                        for (int n = 0; n < 2; ++n) {
                            f32x4 v = acc[ai][bj][m][n] * rs;
                            if (sub == 1) {
#pragma unroll
                                for (int j = 0; j < 4; ++j) { const float r = fmaxf(v[j], 0.f); v[j] = r * r; }
                            } else if (sub == 4) {
#pragma unroll
                                for (int j = 0; j < 4; ++j) v[j] = v[j] / (1.0f + __expf(-v[j]));
                            }
                            w[2 * n] = cvt_pk_bf16(v[0], v[1]); w[2 * n + 1] = cvt_pk_bf16(v[2], v[3]);
                        }
                        *(GAS u32x4*)(rowp + bj * HALF) = w;
                    }
                }
        }
    }
};
struct EpiRes {
    const float* xin; float* xout; bf16_t* xb; float* ssn; int glu;
    __device__ __forceinline__ void operator()(const f32x4 (&acc)[2][2][4][2], const Unit& u, int wr, int wc, int fr, int fq) const {
        const int row0 = u.pm * BM + wr * 64 + fr;
        const GAS float* xi = (const GAS float*)xin; GAS float* xo = (GAS float*)xout; GAS bf16_t* xbg = (GAS bf16_t*)xb; GAS float* ssg = (GAS float*)ssn;
        if (glu) {
            const size_t cb = (size_t)u.pn * HALF + wc * 32 + 8 * fq;
#pragma unroll
            for (int ai = 0; ai < 2; ++ai) {
                f32x4 xv[4][2];
#pragma unroll
                for (int m = 0; m < 4; ++m)
#pragma unroll
                    for (int n = 0; n < 2; ++n) xv[m][n] = *(const GAS f32x4*)(xi + (size_t)(row0 + ai * HALF + m * 16) * D_ + cb + n * 4);
#pragma unroll
                for (int m = 0; m < 4; ++m) {
                    const int row = row0 + ai * HALF + m * 16; const size_t off = (size_t)row * D_ + cb;
                    float sq = 0.f; u32x4 w;
#pragma unroll
                    for (int n = 0; n < 2; ++n) {
                        const f32x4 va = acc[ai][0][m][n], ga = acc[ai][1][m][n];
                        f32x4 x4 = xv[m][n];
#pragma unroll
                        for (int j = 0; j < 4; ++j) { x4[j] += va[j] / (1.0f + __expf(-ga[j])); sq += x4[j] * x4[j]; }
                        *(GAS f32x4*)(xo + off + n * 4) = x4;
                        w[2 * n] = cvt_pk_bf16(x4[0], x4[1]); w[2 * n + 1] = cvt_pk_bf16(x4[2], x4[3]);
                    }
                    *(GAS u32x4*)(xbg + off) = w;
                    sq += __shfl_xor(sq, 16); sq += __shfl_xor(sq, 32);
                    if (fq == 0) atomicAdd((float*)ssn + (size_t)((u.pn >> 1) * 4 + wc) * T_ + row, sq);
                }
            }
        } else {
            const size_t cb = (size_t)u.pn * BM + wc * 32 + 8 * fq;
#pragma unroll
            for (int ai = 0; ai < 2; ++ai) {
                f32x4 xv[4][2][2];
#pragma unroll
                for (int m = 0; m < 4; ++m)
#pragma unroll
                    for (int bj = 0; bj < 2; ++bj)
#pragma unroll
                        for (int n = 0; n < 2; ++n) xv[m][bj][n] = *(const GAS f32x4*)(xi + (size_t)(row0 + ai * HALF + m * 16) * D_ + cb + bj * HALF + n * 4);
#pragma unroll
                for (int m = 0; m < 4; ++m) {
                    const int row = row0 + ai * HALF + m * 16; const size_t off = (size_t)row * D_ + cb;
                    float sq = 0.f;
#pragma unroll
                    for (int bj = 0; bj < 2; ++bj) {
                        u32x4 w;
#pragma unroll
                        for (int n = 0; n < 2; ++n) {
                            f32x4 x4 = xv[m][bj][n] + acc[ai][bj][m][n];
#pragma unroll
                            for (int j = 0; j < 4; ++j) sq += x4[j] * x4[j];
                            *(GAS f32x4*)(xo + off + bj * HALF + n * 4) = x4;
                            w[2 * n] = cvt_pk_bf16(x4[0], x4[1]); w[2 * n + 1] = cvt_pk_bf16(x4[2], x4[3]);
                        }
                        *(GAS u32x4*)(xbg + off + bj * HALF) = w;
                    }
                    sq += __shfl_xor(sq, 16); sq += __shfl_xor(sq, 32);
                    if (fq == 0) ssg[(size_t)(u.pn * 4 + wc) * T_ + row] = sq;
                }
            }
        }
    }
};

template <class Epi, class Sched>
__device__ __forceinline__ void gemm_phase(LAS unsigned char* lds, const Gemm g, const Sched& S, const Epi& E) {
    const int tid = otid(), wid = __builtin_amdgcn_readfirstlane(tid >> 6), lane = tid & 63, wr = wid >> 2, wc = wid & 3, fr = lane & 15, fq = lane >> 4;
    const int K = g.K, nt = K / BK;
    unsigned voffA[2], voffB[2];
#pragma unroll
    for (int i = 0; i < 2; ++i) { int R, C; stage_rc(tid * 16 + i * 8192, R, C); voffA[i] = (unsigned)(R * K + C) * 2u; voffB[i] = voffA[i]; }
    const size_t kstep = (size_t)(BK * 2);
    const size_t hstep = (size_t)HALF * K * 2;
    const size_t tstep = 2 * hstep;
    const unsigned ldsw = (unsigned)wid * 1024u;
    const int aoff = lds_byte(wr * 64 + fr, fq * 8), boff = lds_byte(wc * 32 + fr, fq * 8);
#define PG8_SA(b, h) (((b) * 2 + (h)) * HTB)
#define PG8_SB(b, h) ((4 + (b) * 2 + (h)) * HTB)
#define PG8_STAGE(bufoff, gbase, voff) do { _Pragma("unroll") for (int _i = 0; _i < 2; ++_i) \
        __builtin_amdgcn_global_load_lds((const unsigned*)((const char*)(gbase) + (voff)[_i]), (LAS unsigned*)(lds + (bufoff) + ldsw + _i * 8192), 16, 0, 0); } while (0)
#define PG8_LDA(dst, b, h) do { _Pragma("unroll") for (int m = 0; m < 4; ++m) _Pragma("unroll") for (int k = 0; k < 2; ++k) dst[m][k] = *(const LAS bf16x8*)(lds + PG8_SA(b, h) + aoff + m * 2048 + k * 1024); } while (0)
#define PG8_LDB(dst, b, h) do { _Pragma("unroll") for (int n = 0; n < 2; ++n) _Pragma("unroll") for (int k = 0; k < 2; ++k) dst[n][k] = *(const LAS bf16x8*)(lds + PG8_SB(b, h) + boff + n * 2048 + k * 1024); } while (0)
#define PG8_MMA(ai, bj, At, Bt) do { __builtin_amdgcn_s_setprio(1); _Pragma("unroll") for (int m = 0; m < 4; ++m) _Pragma("unroll") for (int n = 0; n < 2; ++n) _Pragma("unroll") for (int k = 0; k < 2; ++k) \
        acc[ai][bj][m][n] = __builtin_amdgcn_mfma_f32_16x16x32_bf16(Bt[n][k], At[m][k], acc[ai][bj][m][n], 0, 0, 0); __builtin_amdgcn_s_setprio(0); } while (0)
#define PG8_WAIT_V(n) asm volatile("s_waitcnt vmcnt(" #n ")" ::: "memory")
#define PG8_WAIT_L(n) asm volatile("s_waitcnt lgkmcnt(" #n ")" ::: "memory")
#define PG8_BAR __builtin_amdgcn_s_barrier()
#define PG8_SCHED __builtin_amdgcn_sched_barrier(0)
    Unit cur, nxt; int ui = 0;
    if (!S.next(0, cur)) return;
    f32x4 acc[2][2][4][2];
#pragma unroll
    for (int a = 0; a < 2; ++a)
#pragma unroll
        for (int b = 0; b < 2; ++b)
#pragma unroll
            for (int m = 0; m < 4; ++m)
#pragma unroll
                for (int n = 0; n < 2; ++n) acc[a][b][m][n] = (f32x4){0.f, 0.f, 0.f, 0.f};
    bf16x8 At[4][2], B0[2][2], B1[2][2];
    const char* cA = (const char*)g.A + (size_t)cur.pm * tstep; const char* cB = (const char*)g.Bt + (size_t)cur.pn * tstep;
    PG8_STAGE(PG8_SB(0, 0), cB, voffB); PG8_STAGE(PG8_SA(0, 0), cA, voffA); PG8_STAGE(PG8_SB(0, 1), cB + hstep, voffB); PG8_STAGE(PG8_SA(0, 1), cA + hstep, voffA);
    if (wr == 1) PG8_BAR;
    PG8_WAIT_V(4); PG8_BAR;
    PG8_STAGE(PG8_SB(1, 0), cB + kstep, voffB); PG8_STAGE(PG8_SA(1, 0), cA + kstep, voffA); PG8_STAGE(PG8_SB(1, 1), cB + hstep + kstep, voffB);
    PG8_WAIT_V(6); PG8_BAR;
    for (;;) {
        const bool has_next = S.next(ui + 1, nxt);
        const char* nA = has_next ? (const char*)g.A + (size_t)nxt.pm * tstep : cA; const char* nB = has_next ? (const char*)g.Bt + (size_t)nxt.pn * tstep : cB;
        for (int t = 0; t < nt; t += 2) {
            const bool last = (t == nt - 2);
            const char* a1 = cA + (size_t)(t + 1) * kstep;
            const char* a2 = last ? nA : cA + (size_t)(t + 2) * kstep; const char* b2 = last ? nB : cB + (size_t)(t + 2) * kstep;
            const char* a3 = a2 + kstep; const char* b3 = b2 + kstep;
            PG8_LDB(B0, 0, 0); PG8_SCHED; PG8_LDA(At, 0, 0); PG8_STAGE(PG8_SA(1, 1), a1 + hstep, voffA);
            PG8_WAIT_L(8); PG8_BAR; PG8_WAIT_L(0); PG8_MMA(0, 0, At, B0); PG8_BAR; PG8_SCHED;
            PG8_LDB(B1, 0, 1); PG8_STAGE(PG8_SB(0, 0), b2, voffB);
            PG8_BAR; PG8_WAIT_L(0); PG8_MMA(0, 1, At, B1); PG8_BAR;
            PG8_LDA(At, 0, 1); PG8_STAGE(PG8_SA(0, 0), a2, voffA);
            PG8_BAR; PG8_WAIT_L(0); PG8_MMA(1, 0, At, B0); PG8_BAR; PG8_SCHED;
            PG8_STAGE(PG8_SB(0, 1), b2 + hstep, voffB);
            PG8_WAIT_V(6); PG8_BAR; PG8_MMA(1, 1, At, B1); PG8_BAR;
            PG8_LDB(B0, 1, 0); PG8_SCHED; PG8_LDA(At, 1, 0); PG8_STAGE(PG8_SA(0, 1), a2 + hstep, voffA);
            PG8_WAIT_L(8); PG8_BAR; PG8_WAIT_L(0); PG8_MMA(0, 0, At, B0); PG8_BAR; PG8_SCHED;
            PG8_LDB(B1, 1, 1); PG8_STAGE(PG8_SB(1, 0), b3, voffB);
            PG8_BAR; PG8_WAIT_L(0); PG8_MMA(0, 1, At, B1); PG8_BAR;
            PG8_LDA(At, 1, 1); PG8_STAGE(PG8_SA(1, 0), a3, voffA);
            PG8_BAR; PG8_WAIT_L(0); PG8_MMA(1, 0, At, B0); PG8_BAR; PG8_SCHED;
            PG8_STAGE(PG8_SB(1, 1), b3 + hstep, voffB);
            PG8_WAIT_V(6); PG8_BAR; PG8_MMA(1, 1, At, B1); PG8_BAR;
        }
        E(acc, cur, wr, wc, fr, fq);
        if (!has_next) break;
#pragma unroll
        for (int a = 0; a < 2; ++a)
#pragma unroll
            for (int b = 0; b < 2; ++b)
#pragma unroll
                for (int m = 0; m < 4; ++m)
#pragma unroll
                    for (int n = 0; n < 2; ++n) acc[a][b][m][n] = (f32x4){0.f, 0.f, 0.f, 0.f};
        cur = nxt; cA = nA; cB = nB; ++ui;
    }
    PG8_WAIT_V(0);
    if (wr == 0) PG8_BAR;
    PG8_BAR;
#undef PG8_SA
#undef PG8_SB
#undef PG8_STAGE
#undef PG8_LDA
#undef PG8_LDB
#undef PG8_MMA
#undef PG8_WAIT_V
#undef PG8_WAIT_L
#undef PG8_BAR
#undef PG8_SCHED
}
}

namespace att {
constexpr int D = 128, KVBLK = 64, LDK = 6144;
constexpr float SCALE = 0.088388347648318440f;
constexpr float THR = 8.f;
constexpr size_t SHM_V = KVBLK * D * 2, SHM_K = KVBLK * D * 2;
#define KSWZ(row, colB) ((row) * 256 + ((colB) ^ (((row) & 7) << 4)))
#define SBAR() __builtin_amdgcn_sched_barrier(0)
__device__ __forceinline__ int crow(int r, int hi) { return (r & 3) + 8 * (r >> 2) + 4 * hi; }
__device__ __forceinline__ void partialSM(f32x16& p0, f32x16& p1, float& m_reg, float& mn, float& alpha, bool msk) {
    constexpr float C = SCALE * 1.4426950408889634f;
    if (msk) {
#pragma unroll
        for (int r = 0; r < 16; ++r) { p0[r] = -1e30f; p1[r] = -1e30f; }
    }
    float pmax = p0[0];
#pragma unroll
    for (int r = 1; r < 16; ++r) pmax = fmaxf(pmax, p0[r]);
#pragma unroll
    for (int r = 0; r < 16; ++r) pmax = fmaxf(pmax, p1[r]);
    { auto rr = __builtin_amdgcn_permlane32_swap(__float_as_uint(pmax), __float_as_uint(pmax), false, false);
      pmax = fmaxf(__uint_as_float(rr[0]), __uint_as_float(rr[1])); }
    if (__builtin_expect(__all(pmax - m_reg <= THR / SCALE), 1)) { mn = m_reg; alpha = 1.f; }
    else { mn = fmaxf(m_reg, pmax); alpha = __builtin_amdgcn_exp2f((m_reg - mn) * C); m_reg = mn; }
    float mnC = -mn * C;
#pragma unroll
    for (int r = 0; r < 16; ++r) p0[r] = fmaf(p0[r], C, mnC);
#pragma unroll
    for (int r = 0; r < 16; ++r) p1[r] = fmaf(p1[r], C, mnC);
#pragma unroll
    for (int r = 0; r < 16; ++r) p0[r] = __builtin_amdgcn_exp2f(p0[r]);
}
__device__ __forceinline__ void finishSM(f32x16& p0, f32x16& p1, float alpha, float& l_reg, bf16x8& pa0, bf16x8& pa1, bf16x8& pa2, bf16x8& pa3) {
#pragma unroll
    for (int r = 0; r < 16; ++r) p1[r] = __builtin_amdgcn_exp2f(p1[r]);
    float ps = 0;
#pragma unroll
    for (int r = 0; r < 16; ++r) ps += p0[r];
#pragma unroll
    for (int r = 0; r < 16; ++r) ps += p1[r];
    { auto rr = __builtin_amdgcn_permlane32_swap(__float_as_uint(ps), __float_as_uint(ps), false, false);
      ps = __uint_as_float(rr[0]) + __uint_as_float(rr[1]); }
    l_reg = l_reg * alpha + ps;
#define PK4(P, BASE, OUT) do { unsigned a0 = cvt_pk_bf16(P[BASE + 0], P[BASE + 1]), a1 = cvt_pk_bf16(P[BASE + 2], P[BASE + 3]);   \
    unsigned b0 = cvt_pk_bf16(P[BASE + 4], P[BASE + 5]), b1 = cvt_pk_bf16(P[BASE + 6], P[BASE + 7]);                              \
    auto r0 = __builtin_amdgcn_permlane32_swap(a0, b0, false, false); auto r1 = __builtin_amdgcn_permlane32_swap(a1, b1, false, false); \
    u32x4 w = {r0[0], r1[0], r0[1], r1[1]}; OUT = *reinterpret_cast<bf16x8*>(&w); } while (0)
    PK4(p0, 0, pa0); PK4(p0, 8, pa1); PK4(p1, 0, pa2); PK4(p1, 8, pa3);
#undef PK4
}
__device__ __forceinline__ void qkt(f32x16& p0, f32x16& p1, const char* Ks, const bf16x8* qr, int r32, int hi) {
    p0 = f32x16{}; p1 = f32x16{};
#pragma unroll
    for (int d0 = 0; d0 < 8; ++d0) { int cb = (d0 * 16 + hi * 8) * 2;
        bf16x8 b0 = *reinterpret_cast<const bf16x8*>(Ks + KSWZ(r32, cb));
        bf16x8 b1 = *reinterpret_cast<const bf16x8*>(Ks + KSWZ(32 + r32, cb));
        p0 = __builtin_amdgcn_mfma_f32_32x32x16_bf16(b0, qr[d0], p0, 0, 0, 0);
        p1 = __builtin_amdgcn_mfma_f32_32x32x16_bf16(b1, qr[d0], p1, 0, 0, 0); }
}
__device__ __forceinline__ int v_st(int k, int c) { const int kk = (k & ~0xC) | ((k & 4) << 1) | ((k & 8) >> 1); return ((kk >> 3) * 4 + (c >> 5)) * 512 + ((kk & 7) * 32 + (c & 31)) * 2; }
__device__ __forceinline__ int v_rd_base(int lane) { return ((lane & 3) << 3) | (((lane >> 2) & 3) << 6) | (((lane >> 4) & 1) << 5) | (((lane >> 5) & 1) << 8); }
constexpr int v_rd_off(int d0, int ks, int half) { return d0 * 512 + ks * 4096 + half * 2048; }
template <int OFF> __device__ __forceinline__ s16x4 tr_read(int vb) {
    s16x4 r; asm volatile("ds_read_b64_tr_b16 %0, %1 offset:%2" : "=&v"(r) : "v"(vb), "i"(OFF) : "memory"); return r;
}
template <int D0> __device__ __forceinline__ void pv_one(f32x16& od, int vb, bf16x8 pa0, bf16x8 pa1, bf16x8 pa2, bf16x8 pa3) {
    const s16x4 l0 = tr_read<v_rd_off(D0, 0, 0)>(vb), h0 = tr_read<v_rd_off(D0, 0, 1)>(vb), l1 = tr_read<v_rd_off(D0, 1, 0)>(vb), h1 = tr_read<v_rd_off(D0, 1, 1)>(vb);
    const s16x4 l2 = tr_read<v_rd_off(D0, 2, 0)>(vb), h2 = tr_read<v_rd_off(D0, 2, 1)>(vb), l3 = tr_read<v_rd_off(D0, 3, 0)>(vb), h3 = tr_read<v_rd_off(D0, 3, 1)>(vb);
    asm volatile("s_waitcnt lgkmcnt(0)" ::: "memory"); SBAR();
#define PK(L, H) (bf16x8){L[0], L[1], L[2], L[3], H[0], H[1], H[2], H[3]}
    od = __builtin_amdgcn_mfma_f32_32x32x16_bf16(pa0, PK(l0, h0), od, 0, 0, 0);
    od = __builtin_amdgcn_mfma_f32_32x32x16_bf16(pa1, PK(l1, h1), od, 0, 0, 0);
    od = __builtin_amdgcn_mfma_f32_32x32x16_bf16(pa2, PK(l2, h2), od, 0, 0, 0);
    od = __builtin_amdgcn_mfma_f32_32x32x16_bf16(pa3, PK(l3, h3), od, 0, 0, 0);
#undef PK
}
__device__ __forceinline__ void pv_d0(f32x16* o, int vb, bf16x8 pa0, bf16x8 pa1, bf16x8 pa2, bf16x8 pa3) {
    pv_one<0>(o[0], vb, pa0, pa1, pa2, pa3); pv_one<1>(o[1], vb, pa0, pa1, pa2, pa3); pv_one<2>(o[2], vb, pa0, pa1, pa2, pa3); pv_one<3>(o[3], vb, pa0, pa1, pa2, pa3);
}
__device__ __forceinline__ void attn_body(const bf16_t* __restrict__ Qb, const bf16_t* __restrict__ Kh, const bf16_t* __restrict__ Vh, int NT, int ntw, char* lds, f32x16 (&o)[4]) {
    const int tid = otid(), wid = __builtin_amdgcn_readfirstlane(tid >> 6), lane = tid & 63, r32 = lane & 31, hi = lane >> 5;
    char* V_lds = lds; char* K_lds = lds + 2 * SHM_V;
    float* wsf = (float*)(lds + 2 * SHM_V + 2 * SHM_K) + wid * 64; float* li_l = wsf; float* al_l = wsf + 32;
    float m_reg = -1e30f, l_reg = 0; bf16x8 qr[8];
#pragma unroll
    for (int d = 0; d < 4; ++d) o[d] = f32x16{};
    const bf16_t* Qw = Qb + (long)(wid * 32 + r32) * LDK + hi * 8;
#pragma unroll
    for (int d0 = 0; d0 < 8; ++d0) qr[d0] = *reinterpret_cast<const bf16x8*>(Qw + d0 * 16);
    const int sr = tid >> 4, sc = (tid & 15) * 8, vst0 = v_st(sr, sc), vst1 = v_st(32 + sr, sc);
    const int vb0 = (int)(uintptr_t)V_lds + v_rd_base(lane);
    struct { bf16x8 vs0, vs1, ks0, ks1; } sr_[2];
#define SLOAD(i, k0) do { sr_[i].vs0 = *reinterpret_cast<const bf16x8*>(&Vh[(long)((k0) + sr) * LDK + sc]); sr_[i].vs1 = *reinterpret_cast<const bf16x8*>(&Vh[(long)((k0) + 32 + sr) * LDK + sc]); \
    sr_[i].ks0 = *reinterpret_cast<const bf16x8*>(&Kh[(long)((k0) + sr) * LDK + sc]); sr_[i].ks1 = *reinterpret_cast<const bf16x8*>(&Kh[(long)((k0) + 32 + sr) * LDK + sc]); } while (0)
#define SWRITE(b, i) do { *(bf16x8*)(V_lds + (b) * SHM_V + vst0) = sr_[i].vs0;          \
    *(bf16x8*)(V_lds + (b) * SHM_V + vst1) = sr_[i].vs1; int kc = sc * 2;               \
    *(bf16x8*)(K_lds + (b) * SHM_K + KSWZ(sr, kc)) = sr_[i].ks0;                       \
    *(bf16x8*)(K_lds + (b) * SHM_K + KSWZ(32 + sr, kc)) = sr_[i].ks1; } while (0)
#define SWAIT() asm volatile("s_waitcnt vmcnt(4)" ::: "memory")
#define RESC(a) do { if (__any((a) < 1.f)) { if (hi == 0) al_l[r32] = (a); asm volatile("s_waitcnt lgkmcnt(0)" ::: "memory"); \
    _Pragma("unroll") for (int d = 0; d < 4; ++d) _Pragma("unroll") for (int r = 0; r < 16; ++r) o[d][r] *= al_l[crow(r, hi)]; } } while (0)
    f32x16 pA0, pA1, pB0, pB1; float mnA, mnB, alA, alB; bf16x8 pa0, pa1, pa2, pa3;
    constexpr int SE = 0, SO = 1;
    __syncthreads();
    SLOAD(SE, 0); asm volatile("s_waitcnt vmcnt(0)" ::: "memory"); SWRITE(0, SE); __syncthreads();
    qkt(pA0, pA1, K_lds, qr, r32, hi); partialSM(pA0, pA1, m_reg, mnA, alA, false);
    SLOAD(SO, KVBLK); if (2 < NT) SLOAD(SE, 2 * KVBLK);
    SWAIT(); SWRITE(1, SO); __syncthreads();
    for (int j = 1; j + 1 < NT; j += 2) {
        SBAR(); qkt(pB0, pB1, K_lds + SHM_K, qr, r32, hi);
        finishSM(pA0, pA1, alA, l_reg, pa0, pa1, pa2, pa3); SBAR();
        SLOAD(SO, (j + 2) * KVBLK); SBAR();
        pv_d0(o, vb0, pa0, pa1, pa2, pa3); partialSM(pB0, pB1, m_reg, mnB, alB, j >= ntw);
        __syncthreads(); SWAIT(); SWRITE(0, SE);
        RESC(alB); __syncthreads();
        SBAR(); qkt(pA0, pA1, K_lds, qr, r32, hi);
        finishSM(pB0, pB1, alB, l_reg, pa0, pa1, pa2, pa3); SBAR();
        if (j + 3 < NT) SLOAD(SE, (j + 3) * KVBLK); SBAR();
        pv_d0(o, vb0 + (int)SHM_V, pa0, pa1, pa2, pa3); partialSM(pA0, pA1, m_reg, mnA, alA, (j + 1) >= ntw);
        __syncthreads(); SWAIT(); SWRITE(1, SO);
        RESC(alA); __syncthreads();
    }
    SBAR(); qkt(pB0, pB1, K_lds + SHM_K, qr, r32, hi);
    finishSM(pA0, pA1, alA, l_reg, pa0, pa1, pa2, pa3); SBAR();
    pv_d0(o, vb0, pa0, pa1, pa2, pa3); partialSM(pB0, pB1, m_reg, mnB, alB, (NT - 1) >= ntw);
    __syncthreads(); RESC(alB);
    finishSM(pB0, pB1, alB, l_reg, pa0, pa1, pa2, pa3); SBAR();
    pv_d0(o, vb0 + (int)SHM_V, pa0, pa1, pa2, pa3);
    if (hi == 0) li_l[r32] = l_reg; asm volatile("s_waitcnt lgkmcnt(0)" ::: "memory");
#pragma unroll
    for (int r = 0; r < 16; ++r) { const float rl = __builtin_amdgcn_rcpf(li_l[crow(r, hi)]);
#pragma unroll
        for (int d = 0; d < 4; ++d) o[d][r] *= rl; }
#undef SLOAD
#undef SWRITE
#undef SWAIT
#undef RESC
}
}

__device__ __forceinline__ void sincos_red(double ang, float& s, float& c) {
    const double k = rint(ang * 0.15915494309189535);
    const float r = (float)(ang - k * 6.283185307179586);
    s = __sinf(r); c = __cosf(r);
}
__device__ __forceinline__ float gelu_tanh(float y) {
    const float z = 0.7978845608028654f * (y + 0.044715f * y * y * y);
    const float th = 1.0f - 2.0f / (1.0f + __expf(2.0f * z));
    return 0.5f * y * (1.0f + th);
}

struct ConvJob { const float* W; bf16_t* Wt; const float* gain; int K, N, glu, tile; };
struct ConvRegs { f32x4 va[4], vb[4]; float ga[4], gb[4]; };
__device__ __forceinline__ ConvJob conv_decode(const Params& p, unsigned char* ws, int t) {
    ConvJob j; j.glu = 0; j.gain = nullptr;
    if (t < 1536) { const int q = t / 768; j.tile = t - q * 768; j.W = p.a_w_in + (size_t)q * 2048 * 6144; j.Wt = (bf16_t*)(ws + OFF_WT_A_IN + q * SZ_A_IN); j.K = 2048; j.N = 6144; j.gain = p.norm_mix + (size_t)(3 * q) * D_; }
    else if (t < 2048) { const int u = t - 1536; const int q = u / 256; j.tile = u - q * 256; j.W = p.a_w_out + (size_t)q * 2048 * 2048; j.Wt = (bf16_t*)(ws + OFF_WT_A_OUT + q * SZ_A_OUT); j.K = 2048; j.N = 2048; }
    else if (t < 2560) { j.tile = t - 2048; j.W = p.b_w_glu; j.Wt = (bf16_t*)(ws + OFF_WT_GLU); j.K = 2048; j.N = 4096; j.glu = 1; }
    else if (t < 4096) { j.tile = t - 2560; j.W = p.c_w_in; j.Wt = (bf16_t*)(ws + OFF_WT_C_IN); j.K = 2048; j.N = 12288; j.gain = p.norm_mix + 2 * D_; }
    else if (t < 4608) { j.tile = t - 4096; j.W = p.c_w_out; j.Wt = (bf16_t*)(ws + OFF_WT_C_OUT); j.K = 4096; j.N = 2048; }
    else if (t < 8704) { const int u = t - 4608; const int i = u / 1024; j.tile = u - i * 1024; j.W = p.mlp_w1 + (size_t)i * 2048 * 8192; j.Wt = (bf16_t*)(ws + OFF_WT_W1 + i * SZ_W1); j.K = 2048; j.N = 8192; j.gain = p.norm_mlp + (size_t)i * D_; }
    else { const int u = t - 8704; const int i = u / 1024; j.tile = u - i * 1024; j.W = p.mlp_w2 + (size_t)i * 8192 * 2048; j.Wt = (bf16_t*)(ws + OFF_WT_W2 + i * SZ_W1); j.K = 8192; j.N = 2048; }
    return j;
}
__device__ __forceinline__ void conv_load(const ConvJob& j, ConvRegs& r, int tid) {
    const int ntn = j.N >> 7; const int tk = j.tile / ntn, tn = j.tile - tk * ntn; const int k0 = tk << 7, n0 = tn << 7;
    const int kp = tid >> 5, nl = (tid & 31) << 2;
#pragma unroll
    for (int i = 0; i < 4; ++i) { const int k = 2 * (kp + 16 * i);
        r.va[i] = *(const f32x4*)(j.W + (size_t)(k0 + k) * j.N + n0 + nl); r.vb[i] = *(const f32x4*)(j.W + (size_t)(k0 + k + 1) * j.N + n0 + nl);
        r.ga[i] = j.gain ? j.gain[k0 + k] : 1.f; r.gb[i] = j.gain ? j.gain[k0 + k + 1] : 1.f; }
}
__device__ __forceinline__ void conv_store(const ConvJob& j, const ConvRegs& r, int tid, unsigned* ldsw) {
    const int ntn = j.N >> 7; const int tk = j.tile / ntn, tn = j.tile - tk * ntn; const int k0 = tk << 7, n0 = tn << 7;
    const int kp = tid >> 5, nl = (tid & 31) << 2;
    __syncthreads();
#pragma unroll
    for (int i = 0; i < 4; ++i) { const int kpair = kp + 16 * i;
#pragma unroll
        for (int jj = 0; jj < 4; ++jj) ldsw[(nl + jj) * 65 + kpair] = cvt_pk_bf16(r.va[i][jj] * r.ga[i], r.vb[i][jj] * r.gb[i]); }
    __syncthreads();
    int nbase = n0;
    if (j.glu) { const int bj = n0 >> 11, pn = (n0 & 2047) >> 7; nbase = 256 * pn + 128 * bj; }
#pragma unroll
    for (int i = 0; i < 4; ++i) { const int n = (tid >> 4) + 32 * i, k8 = tid & 15;
        u32x4 w; w.x = ldsw[n * 65 + k8 * 4 + 0]; w.y = ldsw[n * 65 + k8 * 4 + 1]; w.z = ldsw[n * 65 + k8 * 4 + 2]; w.w = ldsw[n * 65 + k8 * 4 + 3];
        const int c5 = n & 31, np = (n & ~31) | (16 * ((c5 >> 2) & 1) + 4 * (c5 >> 3) + (c5 & 3));
        *(u32x4*)(j.Wt + (size_t)(nbase + np) * j.K + k0 + k8 * 8) = w; }
}

__device__ __forceinline__ void prep_phase(const Params& p, unsigned char* shm) {
    const int tid = otid(), bid = obid(), G = gridDim.x;
    unsigned char* ws = p.ws;
    {
        ConvJob jc = conv_decode(p, ws, bid); ConvRegs rc; conv_load(jc, rc, tid);
#pragma unroll 1
        for (int t = bid; t < 12800; t += G) {
            ConvJob jn = jc; ConvRegs rn = rc;
            if (t + G < 12800) { jn = conv_decode(p, ws, t + G); conv_load(jn, rn, tid); }
            conv_store(jc, rc, tid, (unsigned*)shm);
            jc = jn; rc = rn;
        }
    }
    {
        float* ss = (float*)(ws + OFF_SSP); bf16_t* xb = (bf16_t*)(ws + OFF_XB);
        const int wid = tid >> 6, lane = tid & 63;
        for (int row = bid * 8 + wid; row < T_; row += G * 8) {
            const float* xr = p.x + (size_t)row * D_; float sq = 0.f;
#pragma unroll
            for (int i = 0; i < 8; ++i) { const f32x4 v = *(const f32x4*)(xr + (i * 64 + lane) * 4);
                sq += v[0] * v[0] + v[1] * v[1] + v[2] * v[2] + v[3] * v[3];
                *(f32x4*)(p.out + (size_t)row * D_ + (i * 64 + lane) * 4) = v;
                u32x2 w; w.x = cvt_pk_bf16(v[0], v[1]); w.y = cvt_pk_bf16(v[2], v[3]);
                *(u32x2*)(xb + (size_t)row * D_ + (i * 64 + lane) * 4) = w; }
#pragma unroll
            for (int o = 32; o > 0; o >>= 1) sq += __shfl_xor(sq, o);
            if (lane < 32) ss[(size_t)lane * T_ + row] = (lane == 0) ? sq : 0.f;
        }
        for (int i = bid * 512 + tid; i < 32 * T_; i += G * 512) ss[(size_t)3 * 32 * T_ + i] = 0.f;
        float* rssq = (float*)(ws + OFF_RSQP);
        for (int i = bid * 512 + tid; i < 64 * T_; i += G * 512) rssq[i] = 0.f;
    }
    {
        float* par = (float*)(ws + OFF_PAR);
        for (int i = bid * 512 + tid; i < PAR_N; i += G * 512) {
            float v;
            if (i < PAR_NFINAL) v = p.norm_mix[D_ + i];
            else if (i < PAR_LAM) v = p.norm_final[i - PAR_NFINAL];
            else if (i < PAR_SUBLN) v = p.a_lambda[i - PAR_LAM];
            else if (i < PAR_BD) v = p.a_subln[i - PAR_SUBLN];
            else v = p.b_d[i - PAR_BD];
            par[i] = v;
        }
    }
    {
        f32x2* rot = (f32x2*)(ws + OFF_ROT);
        for (int i = bid * 512 + tid; i < 4096 * 128; i += G * 512) {
            const int pos = i >> 7, j = i & 127;
            const double inv = exp(-9.210340371976184 * ((double)j / 127.0));
            float s, c; sincos_red((double)pos * inv, s, c);
            f32x2 v; v.x = c; v.y = s; rot[i] = v;
        }
    }
    {
        bf16_t* Bm = (bf16_t*)(ws + OFF_S5B); bf16_t* Cm = (bf16_t*)(ws + OFF_S5C); f32x2* AB = (f32x2*)(ws + OFF_S5AB);
        const float* gmix = p.norm_mix + 1 * D_;
        for (int i = bid * 512 + tid; i < 128 * 64; i += G * 512) {
            const int g = i >> 6, pp = i & 63;
            const float lre = p.b_a_re[i], lim = p.b_a_im[i];
            const float dt = __expf(p.b_log_dt[g]);
            const float mag = __expf(lre * dt);
            float sn, cs; sincos_red((double)lim * (double)dt, sn, cs);
            const float abr = mag * cs, abi = mag * sn;
            const float den = lre * lre + lim * lim;
            const float nr = abr - 1.0f, ni = abi;
            const float cr_ = (nr * lre + ni * lim) / den, ci_ = (ni * lre - nr * lim) / den;
            f32x2 ab; ab.x = abr; ab.y = abi; AB[i] = ab;
#pragma unroll
            for (int c = 0; c < 16; ++c) {
                const float br = p.b_b_re[(size_t)i * 16 + c], bi = p.b_b_im[(size_t)i * 16 + c];
                const float gm = gmix[g * 16 + c];
                Bm[((size_t)g * 128 + pp) * 16 + c] = f2bf((cr_ * br - ci_ * bi) * gm);
                Bm[((size_t)g * 128 + 64 + pp) * 16 + c] = f2bf((cr_ * bi + ci_ * br) * gm);
                Cm[((size_t)g * 16 + c) * 128 + pp] = f2bf(p.b_c_re[((size_t)g * 16 + c) * 64 + pp]);
                Cm[((size_t)g * 16 + c) * 128 + 64 + pp] = f2bf(-p.b_c_im[((size_t)g * 16 + c) * 64 + pp]);
            }
        }
    }
}

__device__ __forceinline__ void attn_phase(const Params& p, int j, float lambda_init, unsigned char* shm) {
    const int tid = otid(), wid = __builtin_amdgcn_readfirstlane(tid >> 6), lane = tid & 63, r32 = lane & 31, hi = lane >> 5;
    const bf16_t* qkv = (const bf16_t*)(p.ws + OFF_BIG);
    bf16_t* oa = (bf16_t*)(p.ws + OFF_OA);
    float* scr = (float*)(p.ws + OFF_ATT_SCR) + (size_t)obid() * 2 * 32768;
    float lam;
    { const float* lp = (const float*)(p.ws + OFF_PAR) + PAR_LAM + (size_t)j * 512;
      float a = lp[lane] * lp[128 + lane] + lp[64 + lane] * lp[192 + lane];
      float b = lp[256 + lane] * lp[384 + lane] + lp[320 + lane] * lp[448 + lane];
#pragma unroll
      for (int o = 32; o > 0; o >>= 1) { a += __shfl_xor(a, o); b += __shfl_xor(b, o); }
      lam = __expf(a) - __expf(b) + lambda_init; lam = __uint_as_float(__builtin_amdgcn_readfirstlane(__float_as_uint(lam))); }
    const float* sub = (const float*)(p.ws + OFF_PAR) + PAR_SUBLN + (size_t)j * 256;
    const int c = obid(); const int xcd = c & 7, jj = c >> 3;
    const int bh = xcd * 4 + (jj >> 3), pi = jj & 7;
    const int b = bh >> 3, h = bh & 7;
#pragma unroll 1
    for (int it = 0; it < 2; ++it) {
        const int qb = it == 0 ? (15 - pi) : pi;
        const int NT = 4 * qb + 4, ntw = 4 * qb + (wid >> 1) + 1;
        const size_t tok0 = (size_t)b * S_ + (size_t)qb * 256;
        f32x16 o[4];
#pragma unroll 1
        for (int ps = 0; ps < 4; ++ps) {
            const int e = ps >> 1, t = ps & 1;
            float* sc = scr + e * 32768;
            att::attn_body(qkv + tok0 * 6144 + h * 256 + t * 128, qkv + (size_t)b * S_ * 6144 + 2048 + h * 256 + t * 128,
                           qkv + (size_t)b * S_ * 6144 + 4096 + h * 256 + e * 128, NT, ntw, (char*)shm, o);
            if (t == 0) {
#pragma unroll
                for (int d = 0; d < 4; ++d)
#pragma unroll
                    for (int r = 0; r < 16; ++r) sc[tid * 64 + d * 16 + r] = o[d][r];
            } else {
#pragma unroll
                for (int d = 0; d < 4; ++d)
#pragma unroll
                    for (int r = 0; r < 16; ++r) { const float cv = sc[tid * 64 + d * 16 + r] - lam * o[d][r]; o[d][r] = cv; if (e == 0) sc[tid * 64 + d * 16 + r] = cv; }
            }
        }
        float ssq[16];
#pragma unroll
        for (int r = 0; r < 16; ++r) { float s = 0.f;
#pragma unroll
            for (int d = 0; d < 4; ++d) { const float c0 = scr[tid * 64 + d * 16 + r]; s += c0 * c0 + o[d][r] * o[d][r]; }
#pragma unroll
            for (int of = 16; of > 0; of >>= 1) s += __shfl_xor(s, of);
            ssq[r] = rsqrtf(s * (1.0f / 256.0f) + EPS_) * (1.0f - lambda_init); }
#pragma unroll
        for (int r = 0; r < 16; ++r) {
            const size_t row = tok0 + wid * 32 + att::crow(r, hi);
            bf16_t* op = oa + row * D_ + h * 256;
#pragma unroll
            for (int d = 0; d < 4; ++d) {
                const int col = d * 32 + r32;
                op[col] = f2bf(scr[tid * 64 + d * 16 + r] * ssq[r] * sub[col]);
                op[128 + col] = f2bf(o[d][r] * ssq[r] * sub[128 + col]);
            }
        }
    }
}

template <bool FINAL>
__device__ __forceinline__ void s5_phase(const Params& p, unsigned char* shm) {
    const int tid = otid(), wid = tid >> 6, lane = tid & 63, r32 = lane & 31, hi = lane >> 5, fr = lane & 15, fq = lane >> 4;
    const bf16_t* xb = (const bf16_t*)(p.ws + OFF_XB);
    const float* ss = (const float*)(p.ws + OFF_SSP) + (size_t)2 * 32 * T_;
    float* rsfin = (float*)(p.ws + OFF_RSFIN);
    const bf16_t* Bm = (const bf16_t*)(p.ws + OFF_S5B); const bf16_t* Cm = (const bf16_t*)(p.ws + OFF_S5C); const f32x2* AB = (const f32x2*)(p.ws + OFF_S5AB);
    f32x2* E = (f32x2*)(p.ws + OFF_BIG);
    bf16_t* gl = (bf16_t*)(p.ws + OFF_OA);
    bf16_t* Xs = (bf16_t*)shm + wid * (32 * 136);
    const float* gmix = (const float*)(p.ws + OFF_PAR) + PAR_GMIX; const float* dsk = (const float*)(p.ws + OFF_PAR) + PAR_BD;
    float* partL = (float*)(shm + 8 * 8704); float* rsL = partL + 512;
#pragma unroll 1
    for (int bc = obid(); bc < 256; bc += gridDim.x) {
      const int chunk = bc & 63, b = bc >> 6;
      const size_t t0 = (size_t)b * S_ + chunk * 64;
      __syncthreads();
      if (FINAL) { if (tid < 64) rsL[tid] = rsfin[t0 + tid]; }
      else {
          { const int row = tid & 63, part = tid >> 6; float a = 0.f;
#pragma unroll
            for (int k = 0; k < 4; ++k) a += ss[(size_t)(part * 4 + k) * T_ + t0 + row];
            partL[part * 64 + row] = a; }
          __syncthreads();
          if (tid < 64) { float tot = 0.f;
#pragma unroll
              for (int k = 0; k < 8; ++k) tot += partL[k * 64 + tid];
              const float r = rsqrtf(tot * (1.0f / D_) + EPS_); rsL[tid] = r; rsfin[t0 + tid] = r; }
      }
      __syncthreads();
#pragma unroll 1
      for (int goct = 0; goct < 16; ++goct) {
        const int g = goct * 8 + wid; const int pp = r32 + 32 * hi;
        const f32x2 ab = AB[g * 64 + pp];
        bf16x8 bfr[4];
#pragma unroll
        for (int nb = 0; nb < 4; ++nb) bfr[nb] = *(const bf16x8*)(Bm + ((size_t)g * 128 + nb * 32 + r32) * 16 + hi * 8);
        float xr = 0.f, xi = 0.f;
        bf16x8 cfr[4]; float gm4[4], ds4[4];
        if (FINAL) {
            float pr = ab.x, pi_ = ab.y;
#pragma unroll
            for (int s = 0; s < 6; ++s) { const float nr = pr * pr - pi_ * pi_, ni = 2.f * pr * pi_; pr = nr; pi_ = ni; }
            const f32x2* Ep = E + ((size_t)(b * 128 + g) * 64) * 64 + pp;
            for (int c2 = 0; c2 < chunk; c2 += 8) { f32x2 e8[8];
#pragma unroll
                for (int k = 0; k < 8; ++k) { const int ci = (c2 + k) < 63 ? (c2 + k) : 63; e8[k] = Ep[(size_t)ci * 64]; }
#pragma unroll
                for (int k = 0; k < 8; ++k) if (c2 + k < chunk) { const float nr = pr * xr - pi_ * xi + e8[k].x, ni = pr * xi + pi_ * xr + e8[k].y; xr = nr; xi = ni; } }
#pragma unroll
            for (int ks = 0; ks < 4; ++ks) cfr[ks] = *(const bf16x8*)(Cm + ((size_t)g * 16 + fr) * 128 + ks * 32 + fq * 8);
#pragma unroll
            for (int jx = 0; jx < 4; ++jx) { gm4[jx] = gmix[g * 16 + 4 * fq + jx]; ds4[jx] = dsk[g * 16 + 4 * fq + jx]; }
        }
#pragma unroll
        for (int half = 0; half < 2; ++half) {
            const size_t trow = t0 + half * 32 + r32;
            const float rs = rsL[half * 32 + r32];
            const u32x4 raw = *(const u32x4*)(xb + trow * D_ + g * 16 + hi * 8);
            u32x4 sc4;
            sc4.x = cvt_pk_bf16(bflo(raw.x) * rs, bfhi(raw.x) * rs); sc4.y = cvt_pk_bf16(bflo(raw.y) * rs, bfhi(raw.y) * rs);
            sc4.z = cvt_pk_bf16(bflo(raw.z) * rs, bfhi(raw.z) * rs); sc4.w = cvt_pk_bf16(bflo(raw.w) * rs, bfhi(raw.w) * rs);
            const bf16x8 afr = *reinterpret_cast<const bf16x8*>(&sc4);
            f32x16 c0 = __builtin_amdgcn_mfma_f32_32x32x16_bf16(afr, bfr[0], f32x16{}, 0, 0, 0);
            f32x16 c1 = __builtin_amdgcn_mfma_f32_32x32x16_bf16(afr, bfr[1], f32x16{}, 0, 0, 0);
            f32x16 c2 = __builtin_amdgcn_mfma_f32_32x32x16_bf16(afr, bfr[2], f32x16{}, 0, 0, 0);
            f32x16 c3 = __builtin_amdgcn_mfma_f32_32x32x16_bf16(afr, bfr[3], f32x16{}, 0, 0, 0);
#pragma unroll
            for (int i = 0; i < 16; ++i) {
                auto r0 = __builtin_amdgcn_permlane32_swap(__float_as_uint(c0[i]), __float_as_uint(c1[i]), false, false);
                c0[i] = __uint_as_float(r0[0]); c1[i] = __uint_as_float(r0[1]);
                auto r1 = __builtin_amdgcn_permlane32_swap(__float_as_uint(c2[i]), __float_as_uint(c3[i]), false, false);
                c2[i] = __uint_as_float(r1[0]); c3[i] = __uint_as_float(r1[1]);
            }
#pragma unroll
            for (int t = 0; t < 32; ++t) {
                const int q = t >> 3, s = t & 7, idx = 4 * q + (s & 3);
                const float bur = (s < 4) ? c0[idx] : c1[idx], bui = (s < 4) ? c2[idx] : c3[idx];
                const float nr = ab.x * xr - ab.y * xi + bur, ni = ab.x * xi + ab.y * xr + bui;
                xr = nr; xi = ni;
                if (FINAL) { Xs[t * 136 + pp] = f2bf(xr); Xs[t * 136 + 64 + pp] = f2bf(xi); }
            }
            if (FINAL) {
                asm volatile("s_waitcnt lgkmcnt(0)" ::: "memory");
#pragma unroll
                for (int m = 0; m < 2; ++m) {
                    f32x4 acc = {0.f, 0.f, 0.f, 0.f};
#pragma unroll
                    for (int ks = 0; ks < 4; ++ks) {
                        const bf16x8 xf = *(const bf16x8*)(Xs + (m * 16 + fr) * 136 + ks * 32 + fq * 8);
                        acc = __builtin_amdgcn_mfma_f32_16x16x32_bf16(cfr[ks], xf, acc, 0, 0, 0);
                    }
                    const size_t tr2 = t0 + half * 32 + m * 16 + fr;
                    const float rs2 = rsL[half * 32 + m * 16 + fr];
                    const u32x2 hx = *(const u32x2*)(xb + tr2 * D_ + g * 16 + 4 * fq);
                    const float h0 = bflo(hx.x) * rs2 * gm4[0], h1 = bfhi(hx.x) * rs2 * gm4[1], h2 = bflo(hx.y) * rs2 * gm4[2], h3 = bfhi(hx.y) * rs2 * gm4[3];
                    const float y0 = gelu_tanh(acc[0] + ds4[0] * h0), y1 = gelu_tanh(acc[1] + ds4[1] * h1), y2 = gelu_tanh(acc[2] + ds4[2] * h2), y3 = gelu_tanh(acc[3] + ds4[3] * h3);
                    u32x2 w; w.x = cvt_pk_bf16(y0, y1); w.y = cvt_pk_bf16(y2, y3);
                    *(u32x2*)(gl + tr2 * D_ + g * 16 + 4 * fq) = w;
                }
                asm volatile("s_waitcnt lgkmcnt(0)" ::: "memory");
            }
        }
        if (!FINAL) { f32x2 e; e.x = xr; e.y = xi; E[((size_t)(b * 128 + g) * 64 + chunk) * 64 + pp] = e; }
      }
    }
}

__device__ __forceinline__ void ret_phase(const Params& p, unsigned char* shm, float* rssq) {
    const int tid = otid(), wid = tid >> 6, lane = tid & 63, fr = lane & 15, fq = lane >> 4;
    const bf16_t* ret = (const bf16_t*)(p.ws + OFF_BIG);
    bf16_t* ao = (bf16_t*)(p.ws + OFF_OA);
    constexpr int QS = 264, TS = 72;
    bf16_t* Qs = (bf16_t*)shm; bf16_t* Ks = Qs + 64 * QS; bf16_t* KTs = Ks + 64 * QS; bf16_t* VTs = KTs + 256 * TS; bf16_t* Ss = VTs + 64 * TS; bf16_t* RTs = Ss + 64 * TS;
    const int c = obid(); const int xcd = c & 7, jj = c >> 3;
    const int bh = xcd * 4 + (jj >> 3), sl = jj & 7;
    const int b = bh >> 3, h = bh & 7;
    const float lg = logf(1.0f - exp2f(-5.0f - (float)h));
    const float cdec = __expf(lg * 64.0f);
    const int mi = wid >> 1, ni0 = 2 * (wid & 1);
    const float qdec = __expf(lg * (float)(16 * mi + fr + 1));
    float idec[2][4];
#pragma unroll
    for (int t = 0; t < 2; ++t)
#pragma unroll
        for (int j = 0; j < 4; ++j) { const int n = 16 * mi + fr, m = 16 * (ni0 + t) + 4 * fq + j; idec[t][j] = __expf(lg * (fabsf((float)(n - m)) - (float)(63 - m))); }
    f32x4 R[4][2];
#pragma unroll
    for (int a = 0; a < 4; ++a)
#pragma unroll
        for (int d = 0; d < 2; ++d) R[a][d] = (f32x4){0.f, 0.f, 0.f, 0.f};
    const size_t tokb = (size_t)b * S_;
    const bf16_t* qsrc = ret + (tokb + lane) * 12288 + h * 256 + wid * 32;
    const bf16_t* ksrc = qsrc + 2048;
    const bf16_t* vsrc = ret + (tokb + lane) * 12288 + 4096 + h * 512 + sl * 64 + wid * 8;
    u32x4 pq[4], pk[4], pv; u32x2 pg[2], cg2[2];
    const bf16_t* gsrc = ret + (tokb + 16 * mi + fr) * 12288 + 8192 + h * 512 + sl * 64 + 16 * ni0 + 4 * fq;
#pragma unroll
    for (int j = 0; j < 4; ++j) { pq[j] = *(const u32x4*)(qsrc + j * 8); pk[j] = *(const u32x4*)(ksrc + j * 8); }
    pv = *(const u32x4*)vsrc;
    pg[0] = *(const u32x2*)gsrc; pg[1] = *(const u32x2*)(gsrc + 16);
    for (int ch = 0; ch < 64; ++ch) {
        __syncthreads();
        cg2[0] = pg[0]; cg2[1] = pg[1];
#pragma unroll
        for (int j = 0; j < 4; ++j) {
            *(u32x4*)(Qs + lane * QS + wid * 32 + j * 8) = pq[j];
            *(u32x4*)(Ks + lane * QS + wid * 32 + j * 8) = pk[j];
            const unsigned kw[4] = {pk[j].x, pk[j].y, pk[j].z, pk[j].w};
#pragma unroll
            for (int i = 0; i < 4; ++i) {
                KTs[(wid * 32 + j * 8 + 2 * i) * TS + lane] = (bf16_t)(kw[i] & 0xffffu);
                KTs[(wid * 32 + j * 8 + 2 * i + 1) * TS + lane] = (bf16_t)(kw[i] >> 16);
            }
        }
        { const unsigned vw[4] = {pv.x, pv.y, pv.z, pv.w};
#pragma unroll
          for (int i = 0; i < 4; ++i) { VTs[(wid * 8 + 2 * i) * TS + lane] = (bf16_t)(vw[i] & 0xffffu); VTs[(wid * 8 + 2 * i + 1) * TS + lane] = (bf16_t)(vw[i] >> 16); } }
#pragma unroll
        for (int ei = 0; ei < 4; ++ei)
#pragma unroll
            for (int di = 0; di < 2; ++di) { u32x2 w; w.x = cvt_pk_bf16(R[ei][di][0], R[ei][di][1]); w.y = cvt_pk_bf16(R[ei][di][2], R[ei][di][3]);
                *(u32x2*)(RTs + (16 * ei + fr) * QS + wid * 32 + 16 * di + 4 * fq) = w; }
        if (ch + 1 < 64) {
            const size_t adv = (size_t)(ch + 1) * 64 * 12288;
#pragma unroll
            for (int j = 0; j < 4; ++j) { pq[j] = *(const u32x4*)(qsrc + adv + j * 8); pk[j] = *(const u32x4*)(ksrc + adv + j * 8); }
            pv = *(const u32x4*)(vsrc + adv);
            pg[0] = *(const u32x2*)(gsrc + adv); pg[1] = *(const u32x2*)(gsrc + adv + 16);
        }
        __syncthreads();
        {
            f32x4 sacc[2] = {{0.f, 0.f, 0.f, 0.f}, {0.f, 0.f, 0.f, 0.f}};
#pragma unroll
            for (int ks = 0; ks < 8; ++ks) {
                const bf16x8 af = *(const bf16x8*)(Qs + (16 * mi + fr) * QS + ks * 32 + fq * 8);
#pragma unroll
                for (int t = 0; t < 2; ++t) { const bf16x8 bf = *(const bf16x8*)(Ks + (16 * (ni0 + t) + fr) * QS + ks * 32 + fq * 8);
                    sacc[t] = __builtin_amdgcn_mfma_f32_16x16x32_bf16(bf, af, sacc[t], 0, 0, 0); }
            }
#pragma unroll
            for (int t = 0; t < 2; ++t) { u32x2 w; w.x = cvt_pk_bf16(sacc[t][0] * idec[t][0], sacc[t][1] * idec[t][1]); w.y = cvt_pk_bf16(sacc[t][2] * idec[t][2], sacc[t][3] * idec[t][3]);
                *(u32x2*)(Ss + (16 * mi + fr) * TS + 16 * (ni0 + t) + 4 * fq) = w; }
        }
        __syncthreads();
        {
            f32x4 oi[2] = {{0.f, 0.f, 0.f, 0.f}, {0.f, 0.f, 0.f, 0.f}}, oc[2] = {{0.f, 0.f, 0.f, 0.f}, {0.f, 0.f, 0.f, 0.f}};
#pragma unroll
            for (int ks = 0; ks < 2; ++ks) {
                const bf16x8 af = *(const bf16x8*)(Ss + (16 * mi + fr) * TS + ks * 32 + fq * 8);
#pragma unroll
                for (int t = 0; t < 2; ++t) { const bf16x8 bf = *(const bf16x8*)(VTs + (16 * (ni0 + t) + fr) * TS + ks * 32 + fq * 8);
                    oi[t] = __builtin_amdgcn_mfma_f32_16x16x32_bf16(bf, af, oi[t], 0, 0, 0); }
            }
#pragma unroll
            for (int ks = 0; ks < 8; ++ks) {
                const bf16x8 af = *(const bf16x8*)(Qs + (16 * mi + fr) * QS + ks * 32 + fq * 8);
#pragma unroll
                for (int t = 0; t < 2; ++t) { const bf16x8 bf = *(const bf16x8*)(RTs + (16 * (ni0 + t) + fr) * QS + ks * 32 + fq * 8);
                    oc[t] = __builtin_amdgcn_mfma_f32_16x16x32_bf16(bf, af, oc[t], 0, 0, 0); }
            }
            const size_t tok = tokb + (size_t)ch * 64 + 16 * mi + fr;
            float sq = 0.f;
#pragma unroll
            for (int t = 0; t < 2; ++t) {
                const int e = sl * 64 + 16 * (ni0 + t) + 4 * fq;
                const u32x2 gw = cg2[t];
                f32x4 ov = oi[t] + oc[t] * qdec;
                sq += ov[0] * ov[0] + ov[1] * ov[1] + ov[2] * ov[2] + ov[3] * ov[3];
                u32x2 w; w.x = cvt_pk_bf16(ov[0] * bflo(gw.x), ov[1] * bfhi(gw.x)); w.y = cvt_pk_bf16(ov[2] * bflo(gw.y), ov[3] * bfhi(gw.y));
                *(u32x2*)(ao + tok * 4096 + h * 512 + e) = w;
            }
            sq += __shfl_xor(sq, 16); sq += __shfl_xor(sq, 32);
            if (fq == 0) atomicAdd(rssq + (size_t)(sl * 4 + mi) * 0 + (size_t)sl * (T_ * 8) + tok * 8 + h, sq);
        }
#pragma unroll
        for (int ei = 0; ei < 4; ++ei)
#pragma unroll
            for (int di = 0; di < 2; ++di) R[ei][di] *= cdec;
#pragma unroll
        for (int ks = 0; ks < 2; ++ks) {
            bf16x8 bfk[2];
#pragma unroll
            for (int di = 0; di < 2; ++di) bfk[di] = *(const bf16x8*)(KTs + (wid * 32 + 16 * di + fr) * TS + ks * 32 + fq * 8);
#pragma unroll
            for (int ei = 0; ei < 4; ++ei) { const bf16x8 af = *(const bf16x8*)(VTs + (16 * ei + fr) * TS + ks * 32 + fq * 8);
#pragma unroll
                for (int di = 0; di < 2; ++di) R[ei][di] = __builtin_amdgcn_mfma_f32_16x16x32_bf16(bfk[di], af, R[ei][di], 0, 0, 0); }
        }
    }
}

__device__ __forceinline__ void ret2_phase(const Params& p) {
    bf16_t* ao = (bf16_t*)(p.ws + OFF_OA); const float* rssq = (const float*)(p.ws + OFF_RSQP);
    const size_t nvec = (size_t)T_ * 4096 / 8;
    for (size_t i = (size_t)obid() * 512 + otid(); i < nvec; i += (size_t)gridDim.x * 512) {
        const size_t t = i >> 9; const int hh = (int)((i & 511) >> 6);
        float rsum = 0.f;
#pragma unroll
        for (int sl = 0; sl < 8; ++sl) rsum += rssq[(size_t)sl * (T_ * 8) + t * 8 + hh];
        const float rs = rsqrtf(rsum * (1.0f / 512.0f) + EPS_);
        u32x4 w = *(u32x4*)(ao + i * 8);
        w.x = cvt_pk_bf16(bflo(w.x) * rs, bfhi(w.x) * rs); w.y = cvt_pk_bf16(bflo(w.y) * rs, bfhi(w.y) * rs);
        w.z = cvt_pk_bf16(bflo(w.z) * rs, bfhi(w.z) * rs); w.w = cvt_pk_bf16(bflo(w.w) * rs, bfhi(w.w) * rs);
        *(u32x4*)(ao + i * 8) = w;
    }
}

__device__ __forceinline__ void final_phase(const Params& p) {
    const float* ss = (const float*)(p.ws + OFF_SSP) + (size_t)8 * 32 * T_;
    const int tid = otid();
    const f32x4 g = *(const f32x4*)((const float*)(p.ws + OFF_PAR) + PAR_NFINAL + tid * 4);
    for (int row = obid(); row < T_; row += gridDim.x) {
        float ssum = ss[(size_t)(tid & 31) * T_ + row];
#pragma unroll
        for (int o = 16; o > 0; o >>= 1) ssum += __shfl_xor(ssum, o);
        const float rs = rsqrtf(ssum * (1.0f / D_) + EPS_);
        f32x4 v = *(f32x4*)(p.out + (size_t)row * D_ + tid * 4);
        v = v * rs * g;
        *(f32x4*)(p.out + (size_t)row * D_ + tid * 4) = v;
    }
}

enum { OP_PREP = 0, OP_A_IN, OP_ATTN, OP_A_OUT, OP_S5A, OP_S5C, OP_GLU, OP_C_IN, OP_RET, OP_RET2, OP_C_OUT, OP_W1, OP_W2, OP_FINAL };
#ifndef PHMASK
#define PHMASK 0xffff
#endif
#define PHON(b) ((PHMASK >> (b)) & 1)
constexpr int NPH = 23;
__device__ const unsigned char PROG_OP[NPH] = { OP_PREP,
    OP_A_IN, OP_ATTN, OP_A_OUT, OP_W1, OP_W2,
    OP_S5A, OP_S5C, OP_GLU, OP_W1, OP_W2,
    OP_C_IN, OP_RET, OP_RET2, OP_C_OUT, OP_W1, OP_W2,
    OP_A_IN, OP_ATTN, OP_A_OUT, OP_W1, OP_W2,
    OP_FINAL };
__device__ const unsigned char PROG_LAYER[NPH] = { 0, 0, 0, 0, 0, 0, 1, 1, 1, 1, 1, 2, 2, 2, 2, 2, 2, 3, 3, 3, 3, 3, 3 };

struct GemmDesc { unsigned long long a_off, b_off; int N, K, ss_idx, mode; };
#define GD_NONE {0, 0, 0, 0, 0, 0}
#define GD_A_IN(L)  {OFF_XB, OFF_WT_A_IN + (L / 3) * SZ_A_IN, 6144, 2048, 2 * L, 0}
#define GD_A_OUT(L) {OFF_OA, OFF_WT_A_OUT + (L / 3) * SZ_A_OUT, 2048, 2048, 2 * L + 1, 0}
#define GD_W1(L)    {OFF_XB, OFF_WT_W1 + L * SZ_W1, 8192, 2048, 2 * L + 1, 1}
#define GD_W2(L)    {OFF_BIG, OFF_WT_W2 + L * SZ_W1, 2048, 8192, 2 * L + 2, 0}
#define GD_GLU(L)   {OFF_OA, OFF_WT_GLU, 4096, 2048, 2 * L + 1, 1}
#define GD_C_IN(L)  {OFF_XB, OFF_WT_C_IN, 12288, 2048, 2 * L, 2}
#define GD_C_OUT(L) {OFF_OA, OFF_WT_C_OUT, 2048, 4096, 2 * L + 1, 0}
__device__ const GemmDesc GD[NPH] = { GD_NONE,
    GD_A_IN(0ull), GD_NONE, GD_A_OUT(0ull), GD_W1(0ull), GD_W2(0ull),
    GD_NONE, GD_NONE, GD_GLU(1ull), GD_W1(1ull), GD_W2(1ull),
    GD_C_IN(2ull), GD_NONE, GD_NONE, GD_C_OUT(2ull), GD_W1(2ull), GD_W2(2ull),
    GD_A_IN(3ull), GD_NONE, GD_A_OUT(3ull), GD_W1(3ull), GD_W2(3ull),
    GD_NONE };

#define XB_TMO      128
#define XB_XCNT(j)  (256  + 64 * (j))
#define XB_XSUB(j)  (1280 + 64 * (j))
#define XB_XGEN(j)  (2304 + 64 * (j))
#define XB_TOP      3328
#define XB_TOPGEN   3392
#define XCD_BAR_WORDS 3456
#define XB_SPIN_CAP (1u << 22)
__device__ __forceinline__ unsigned xb_ld(unsigned* p)              { return __hip_atomic_load(p, __ATOMIC_RELAXED, __HIP_MEMORY_SCOPE_AGENT); }
__device__ __forceinline__ unsigned xb_add(unsigned* p, unsigned v) { return __hip_atomic_fetch_add(p, v, __ATOMIC_RELAXED, __HIP_MEMORY_SCOPE_AGENT); }
__device__ __forceinline__ unsigned xb_xcc_id() { return (unsigned)__builtin_amdgcn_s_getreg((3 << 11) | 20) & 0xFu; }
#define XB_SPIN(cond, bar) do { unsigned _sp = 0; while (cond) { __builtin_amdgcn_s_sleep(1); \
    if ((++_sp & 255u) == 0u) { if (xb_ld(&(bar)[XB_TMO])) break; if (_sp > XB_SPIN_CAP) { atomicAdd(&(bar)[XB_TMO], 1u); break; } } } } while (0)
struct XcdBarrier { unsigned* bar; unsigned x; volatile LAS unsigned* st; };
__device__ __forceinline__ XcdBarrier xcd_barrier_post(unsigned* bar, volatile LAS unsigned* st) {
    XcdBarrier b; b.bar = bar; b.x = xb_xcc_id(); b.st = st;
    if (threadIdx.x == 0) (void)xb_add(&bar[XB_XCNT(b.x)], 1u);
    return b;
}
__device__ __forceinline__ void xcd_barrier_complete(unsigned* bar, unsigned x, unsigned& nloc, unsigned& nx) {
    const unsigned G = gridDim.x * gridDim.y * gridDim.z;
    unsigned sum, cnt, mine, sp = 0u;
    for (;;) {
        sum = 0u; cnt = 0u; mine = 0u;
#pragma unroll
        for (unsigned j = 0; j < 16; ++j) { const unsigned c = xb_ld(&bar[XB_XCNT(j)]); sum += c; cnt += (c > 0u) ? 1u : 0u; mine = (j == x) ? c : mine; }
        if (sum == G) break;
        __builtin_amdgcn_s_sleep(1);
        if ((++sp & 255u) == 0u) { if (xb_ld(&bar[XB_TMO])) break; if (sp > XB_SPIN_CAP) { atomicAdd(&bar[XB_TMO], 1u); break; } }
    }
    nloc = mine > 0u ? mine : 1u; nx = cnt > 0u ? cnt : 1u;
}
__device__ __forceinline__ void xcd_barrier(unsigned char* ws, unsigned char* shm) {
    XcdBarrier b; b.bar = (unsigned*)(ws + OFF_BAR); b.x = xb_xcc_id(); b.st = (volatile LAS unsigned*)((LAS unsigned char*)shm + LDS_PHASE_BYTES);
    asm volatile("s_waitcnt vmcnt(0) lgkmcnt(0)" ::: "memory");
    __syncthreads();
    if (threadIdx.x == 0) {
        unsigned* bar = b.bar;
        __builtin_amdgcn_s_waitcnt(0);
        unsigned nloc = b.st[0], nx = b.st[1];
        if (nloc == 0u) { xcd_barrier_complete(bar, b.x, nloc, nx); b.st[0] = nloc; b.st[1] = nx; }
        const unsigned old = xb_add(&bar[XB_XSUB(b.x)], 1u);
        const unsigned gen = old / nloc;
        if (old + 1u == (gen + 1u) * nloc) {
            __builtin_amdgcn_fence(__ATOMIC_RELEASE, "agent");
            asm volatile("s_waitcnt vmcnt(0)" ::: "memory");
            const unsigned og = xb_add(&bar[XB_TOP], 1u);
            const unsigned tg = og / nx;
            if (og + 1u == (tg + 1u) * nx) xb_add(&bar[XB_TOPGEN], 1u);
            else XB_SPIN(xb_ld(&bar[XB_TOPGEN]) == tg, bar);
            __builtin_amdgcn_fence(__ATOMIC_ACQUIRE, "agent");
            xb_add(&bar[XB_XGEN(b.x)], 1u);
            asm volatile("s_waitcnt vmcnt(0)" ::: "memory");
        } else {
            XB_SPIN(xb_ld(&bar[XB_XGEN(b.x)]) == gen, bar);
            __builtin_amdgcn_fence(__ATOMIC_ACQUIRE, "agent");
            asm volatile("s_waitcnt vmcnt(0)" ::: "memory");
        }
    }
    __syncthreads();
}
__device__ __forceinline__ void gsync_cg(cg::grid_group& grid) {
    asm volatile("s_waitcnt vmcnt(0) lgkmcnt(0)" ::: "memory");
    grid.sync();
    __builtin_amdgcn_fence(__ATOMIC_ACQUIRE, "agent");
    asm volatile("s_waitcnt vmcnt(0) lgkmcnt(0)" ::: "memory");
}

__global__ void __launch_bounds__(512, 2) fwd_megakernel(Params p, int ph_lo, int ph_hi) {
    extern __shared__ __attribute__((aligned(16))) unsigned char shm[];
    cg::grid_group grid = cg::this_grid();
    volatile LAS unsigned* xst = (volatile LAS unsigned*)((LAS unsigned char*)shm + LDS_PHASE_BYTES);
    if (threadIdx.x == 0) { xst[0] = 0u; xst[1] = 0u; }
    __syncthreads();
    (void)xcd_barrier_post((unsigned*)(p.ws + OFF_BAR), xst);
#ifndef DUPMASK
#define DUPMASK 0
#endif
    if (PHON(0) && ph_lo == 0) {
#pragma unroll 1
        for (int rp_ = 0; rp_ < ((DUPMASK & 1) ? 2 : 1); ++rp_) { prep_phase(p, shm); if (ph_hi > 1) gsync_cg(grid); } }
    for (int ph = (ph_lo < 1 ? 1 : ph_lo); ph < ph_hi; ++ph) {
        const int op = PROG_OP[ph], L = PROG_LAYER[ph];
        const int nrep_ = ((DUPMASK >> op) & 1) ? 2 : 1;
#pragma unroll 1
        for (int rp_ = 0; rp_ < nrep_; ++rp_) {
        unsigned char* ws = p.ws; asm volatile("" : "+s"(ws));
        float* ssb = (float*)(ws + OFF_SSP);
        if (PHON(1) && (op == OP_A_IN || op == OP_C_IN || op == OP_W1)) {
            const GemmDesc gd = GD[ph];
            pg8::Gemm g; g.A = (const bf16_t*)(ws + gd.a_off); g.Bt = (const bf16_t*)(ws + gd.b_off); g.M = T_; g.N = gd.N; g.K = gd.K;
            pg8::EpiBf E; E.rot = (const f32x2*)(ws + OFF_ROT); E.O = (bf16_t*)(ws + OFF_BIG); E.ldc = gd.N; E.mode = gd.mode; E.ss = ssb + (size_t)gd.ss_idx * 32 * T_;
            pg8::StaticOrder S; S.init(g.M, g.N, (int)gridDim.x, obid());
            pg8::gemm_phase<pg8::EpiBf, pg8::StaticOrder>((LAS unsigned char*)shm, g, S, E);
        } else if (PHON(2) && (op == OP_A_OUT || op == OP_GLU || op == OP_C_OUT || op == OP_W2)) {
            const GemmDesc gd = GD[ph];
            pg8::Gemm g; g.A = (const bf16_t*)(ws + gd.a_off); g.Bt = (const bf16_t*)(ws + gd.b_off); g.M = T_; g.N = gd.N; g.K = gd.K;
            pg8::EpiRes E; E.xout = p.out; E.xb = (bf16_t*)(ws + OFF_XB); E.glu = gd.mode; E.xin = p.out; E.ssn = ssb + (size_t)gd.ss_idx * 32 * T_;
            pg8::StaticOrder S; S.init(g.M, g.N, (int)gridDim.x, obid());
            pg8::gemm_phase<pg8::EpiRes, pg8::StaticOrder>((LAS unsigned char*)shm, g, S, E);
        } else if (PHON(3) && op == OP_ATTN) {
            const float li = 0.8f - 0.6f * expf(-0.3f * (float)L);
            attn_phase(p, L / 3, li, shm);
        } else if (PHON(4) && op == OP_S5A) {
            s5_phase<false>(p, shm);
        } else if (PHON(5) && op == OP_S5C) {
            s5_phase<true>(p, shm);
        } else if (PHON(6) && op == OP_RET) {
            ret_phase(p, shm, (float*)(ws + (rp_ == 0 ? OFF_RSQP : OFF_XB)));
        } else if (PHON(7) && op == OP_RET2) {
            ret2_phase(p);
        } else if (PHON(8) && op == OP_FINAL) {
            final_phase(p);
        }
        if (ph + 1 < ph_hi || rp_ + 1 < nrep_) xcd_barrier(ws, shm);
        }
    }
}

extern "C" void kernel_launch(void* const* d_in, const int* in_sizes, int n_in, void* d_out, int out_size, void* d_ws, size_t ws_size, hipStream_t stream) {
    static int grid_blocks = 0;
    if (grid_blocks == 0) {
        if (n_in != 21 || out_size != T_ * D_ || ws_size < WS_NEED) { fprintf(stderr, "kernel_launch: unexpected shapes n_in %d out %d ws %zu (need %zu)\n", n_in, out_size, ws_size, (size_t)WS_NEED); grid_blocks = -1; return; }
        int dev = 0, cus = 0, per_cu = 0;
        hipGetDevice(&dev);
        hipDeviceGetAttribute(&cus, hipDeviceAttributeMultiprocessorCount, dev);
        if (hipFuncSetAttribute((const void*)fwd_megakernel, hipFuncAttributeMaxDynamicSharedMemorySize, LDS_BYTES) != hipSuccess) { fprintf(stderr, "kernel_launch: hipFuncSetAttribute failed\n"); grid_blocks = -1; return; }
        hipOccupancyMaxActiveBlocksPerMultiprocessor(&per_cu, (const void*)fwd_megakernel, 512, LDS_BYTES);
        (void)hipGetLastError();
        if (per_cu < 1) per_cu = 1;
        grid_blocks = cus * 1;
        if (grid_blocks != 256) fprintf(stderr, "kernel_launch: note: %d CUs (kernel tuned for 256)\n", cus);
    }
    if (grid_blocks < 0) return;
    (void)hipMemsetAsync((unsigned char*)d_ws + OFF_BAR, 0, XCD_BAR_WORDS * 4, stream);
    Params p{};
    const float** pp = (const float**)&p;
    for (int i = 0; i < 21; ++i) pp[i] = (const float*)d_in[i];
    p.out = (float*)d_out; p.ws = (unsigned char*)d_ws;
#ifndef DBG_LO
#define DBG_LO 0
#endif
#ifndef DBG_HI
#define DBG_HI NPH
#endif
    int lo = DBG_LO, hi = DBG_HI;
    void* args[] = {&p, &lo, &hi};
    hipError_t e = hipLaunchCooperativeKernel((const void*)fwd_megakernel, dim3(grid_blocks), dim3(512), args, LDS_BYTES, stream);
    if (e != hipSuccess) fprintf(stderr, "cooperative launch failed: %s (grid %d)\n", hipGetErrorString(e), grid_blocks);
}
```

```cpp
#include <hip/hip_runtime.h>
#include <hip/hip_cooperative_groups.h>
#include <cstdio>
#include <cstdint>
namespace cg = cooperative_groups;

#define LAS __attribute__((address_space(3)))
typedef unsigned short bf16_t;
typedef short bf16x8 __attribute__((ext_vector_type(8)));
typedef short s16x4 __attribute__((ext_vector_type(4)));
typedef float f32x4 __attribute__((ext_vector_type(4)));
typedef float f32x2 __attribute__((ext_vector_type(2)));
typedef float f32x16 __attribute__((ext_vector_type(16)));
typedef unsigned u32x4 __attribute__((ext_vector_type(4)));
typedef unsigned u32x2 __attribute__((ext_vector_type(2)));

constexpr int T_ = 16384, D_ = 2048, S_ = 4096;
constexpr float EPS_ = 1e-6f;
constexpr int LDS_PHASE_BYTES = 156672;
constexpr int LDS_BYTES = LDS_PHASE_BYTES + 16;

constexpr size_t SZ_A_IN = 6144ull * 2048 * 2, SZ_A_OUT = 2048ull * 2048 * 2, SZ_W1 = 8192ull * 2048 * 2;
constexpr size_t OFF_WT_A_IN = 0;
constexpr size_t OFF_WT_A_OUT = OFF_WT_A_IN + 2 * SZ_A_IN;
constexpr size_t OFF_WT_GLU = OFF_WT_A_OUT + 2 * SZ_A_OUT;
constexpr size_t OFF_WT_C_IN = OFF_WT_GLU + 4096ull * 2048 * 2;
constexpr size_t OFF_WT_C_OUT = OFF_WT_C_IN + 12288ull * 2048 * 2;
constexpr size_t OFF_WT_W1 = OFF_WT_C_OUT + 2048ull * 4096 * 2;
constexpr size_t OFF_WT_W2 = OFF_WT_W1 + 4 * SZ_W1;
constexpr size_t OFF_XB = OFF_WT_W2 + 4 * SZ_W1;
constexpr size_t OFF_BIG = OFF_XB + (size_t)T_ * D_ * 2;
constexpr size_t OFF_OA = OFF_BIG + (size_t)T_ * 12288 * 2;
constexpr size_t OFF_SS = OFF_OA + (size_t)T_ * 4096 * 2;
constexpr size_t OFF_RSSQ = OFF_SS + 9ull * T_ * 4;
constexpr size_t OFF_ROT = OFF_RSSQ + (size_t)T_ * 8 * 4;
constexpr size_t OFF_S5B = OFF_ROT + 4096ull * 128 * 8;
constexpr size_t OFF_S5C = OFF_S5B + 128ull * 128 * 16 * 2;
constexpr size_t OFF_S5AB = OFF_S5C + 128ull * 16 * 128 * 2;
constexpr size_t WS_END = OFF_S5AB + 128ull * 64 * 8;
constexpr size_t OFF_SSP = WS_END;
constexpr size_t OFF_RSQP = OFF_SSP + 9ull * 32 * T_ * 4;
constexpr size_t OFF_RSFIN = OFF_RSQP + 8ull * T_ * 8 * 4;
constexpr size_t OFF_BAR = OFF_RSFIN + (size_t)T_ * 4;
constexpr size_t OFF_PAR = OFF_BAR + 16384;
constexpr int PAR_GMIX = 0, PAR_NFINAL = 2048, PAR_LAM = 4096, PAR_SUBLN = 5120, PAR_BD = 5632, PAR_N = 7680;
constexpr size_t WS_NEED = OFF_PAR + PAR_N * 4;
constexpr size_t OFF_ATT_SCR = OFF_BIG + (size_t)T_ * 6144 * 2;

struct Params {
    const float* x; const float* norm_mix; const float* norm_mlp; const float* norm_final;
    const float* a_w_in; const float* a_lambda; const float* a_subln; const float* a_w_out;
    const float* b_a_re; const float* b_a_im; const float* b_log_dt; const float* b_b_re; const float* b_b_im;
    const float* b_c_re; const float* b_c_im; const float* b_d; const float* b_w_glu;
    const float* c_w_in; const float* c_w_out; const float* mlp_w1; const float* mlp_w2;
    float* out; unsigned char* ws;
};

__device__ __forceinline__ unsigned cvt_pk_bf16(float lo, float hi) { unsigned r; asm volatile("v_cvt_pk_bf16_f32 %0, %1, %2" : "=v"(r) : "v"(lo), "v"(hi)); return r; }
__device__ __forceinline__ float bf2f(unsigned short b) { return __uint_as_float(((unsigned)b) << 16); }
__device__ __forceinline__ float bflo(unsigned w) { return __uint_as_float(w << 16); }
__device__ __forceinline__ float bfhi(unsigned w) { return __uint_as_float(w & 0xffff0000u); }
__device__ __forceinline__ unsigned short f2bf(float f) { return (unsigned short)(cvt_pk_bf16(f, 0.f) & 0xffffu); }

__device__ __forceinline__ int otid() { int t = threadIdx.x; asm volatile("" : "+v"(t)); return t; }
__device__ __forceinline__ int obid() { int t = blockIdx.x; asm volatile("" : "+s"(t)); return t; }

namespace pg8 {
constexpr int BM = 256, BK = 64, HALF = 128, HTB = HALF * BK * 2, STAGE_BYTES = 8 * HTB, NXCD = 8, WGM = 8;
__device__ __forceinline__ int lds_byte(int r, int c) { const int st = (r >> 4) * 2 + (c >> 5), rr = r & 15, cc = c & 31, ob = rr * 64 + cc * 2; return st * 1024 + (ob ^ (((ob >> 9) & 1) << 5)); }
__device__ __forceinline__ void stage_rc(int b, int& R, int& C) { const int st = b / 1024, sb = b % 1024, swz = sb ^ (((sb >> 9) & 1) << 5); R = (st >> 1) * 16 + swz / 64; C = (st & 1) * 32 + (swz % 64) / 2; }
struct Unit { int pm, pn; };
struct Gemm { const bf16_t* A; const bf16_t* Bt; int M, N, K; };
struct StaticOrder {
    int nM, nN, nwg, G, c;
    __device__ void init(int M, int N, int G_, int c_) { nM = M / BM; nN = N / BM; nwg = nM * nN; G = G_; c = c_; }
    __device__ bool next(int i, Unit& u) const {
        const long L = (long)i * G + c; if (L >= nwg) return false;
        int wgid = (int)L; { const int q = nwg / NXCD, r = nwg % NXCD, xcd = wgid % NXCD, off = wgid / NXCD; wgid = (xcd < r ? xcd * (q + 1) : r * (q + 1) + (xcd - r) * q) + off; }
        const int nig = WGM * nN, gid = wgid / nig, fm = gid * WGM, gsz = (nM - fm) < WGM ? (nM - fm) : WGM;
        u.pm = fm + ((wgid % nig) % gsz); u.pn = (wgid % nig) / gsz; return true;
    }
};

#define GAS __attribute__((address_space(1)))
struct EpiBf {
    bf16_t* O; int ldc; const float* ss; int mode; const f32x2* rot;
    __device__ __forceinline__ void operator()(const f32x4 (&acc)[2][2][4][2], const Unit& u, int wr, int wc, int fr, int fq, LAS unsigned char* lds, int ui) const {
        const int row0 = u.pm * BM + wr * 64 + fr, colt = u.pn * BM + wc * 32 + 8 * fq;
        int sub = 0;
        if (mode == 1) sub = 1;
        else if (mode == 2) { sub = u.pn < 8 ? 2 : (u.pn < 16 ? 3 : (u.pn < 32 ? 0 : 4)); }
        const LAS float* lrs = (const LAS float*)(lds + STAGE_BYTES) + ui * 256 + wr * 64 + fr;
        float rs8[8];
#pragma unroll
        for (int r = 0; r < 8; ++r) rs8[r] = lrs[(r >> 2) * HALF + (r & 3) * 16];
        GAS bf16_t* Og = (GAS bf16_t*)O;
        if (sub == 2 || sub == 3) {
            const GAS f32x2* rotg = (const GAS f32x2*)rot + wc * 32 + 8 * fq;
#pragma unroll
            for (int ai = 0; ai < 2; ++ai) {
                f32x2 cs[4][2][4];
#pragma unroll
                for (int m = 0; m < 4; ++m) { const int row = row0 + ai * HALF + m * 16; const GAS f32x2* rp = rotg + (size_t)(row & (S_ - 1)) * 128;
#pragma unroll
                    for (int n = 0; n < 2; ++n)
#pragma unroll
                        for (int j = 0; j < 4; ++j) cs[m][n][j] = rp[n * 4 + j]; }
#pragma unroll
                for (int m = 0; m < 4; ++m) { const int row = row0 + ai * HALF + m * 16;
                    float ksc = rs8[ai * 4 + m];
                    if (sub == 3) { const float lgam = logf(1.0f - exp2f(-5.0f - (float)(u.pn - 8))); ksc *= 0.0625f * __expf(lgam * (float)(63 - (row & 63))); }
                    GAS bf16_t* rowp = Og + (size_t)row * ldc + colt;
                    u32x4 w1, w2;
#pragma unroll
                    for (int n = 0; n < 2; ++n) {
                        const f32x4 t1 = acc[ai][0][m][n] * ksc, t2 = acc[ai][1][m][n] * ksc;
                        f32x4 o1, o2;
#pragma unroll
                        for (int j = 0; j < 4; ++j) { const f32x2 c2 = cs[m][n][j]; o1[j] = t1[j] * c2.x - t2[j] * c2.y; o2[j] = t1[j] * c2.y + t2[j] * c2.x; }
                        w1[2 * n] = cvt_pk_bf16(o1[0], o1[1]); w1[2 * n + 1] = cvt_pk_bf16(o1[2], o1[3]); w2[2 * n] = cvt_pk_bf16(o2[0], o2[1]); w2[2 * n + 1] = cvt_pk_bf16(o2[2], o2[3]);
                    }
                    *(GAS u32x4*)(rowp) = w1; *(GAS u32x4*)(rowp + HALF) = w2;
                }
            }
        } else {
#pragma unroll
            for (int ai = 0; ai < 2; ++ai)
#pragma unroll
                for (int m = 0; m < 4; ++m) {
                    const int row = row0 + ai * HALF + m * 16;
                    const float rs = rs8[ai * 4 + m];
                    GAS bf16_t* rowp = Og + (size_t)row * ldc + colt;
#pragma unroll
                    for (int bj = 0; bj < 2; ++bj) {
                        u32x4 w;
#pragma unroll
                        for (int n = 0; n < 2; ++n) {
                            f32x4 v = acc[ai][bj][m][n] * rs;
                            if (sub == 1) {
#pragma unroll
                                for (int j = 0; j < 4; ++j) { const float r = fmaxf(v[j], 0.f); v[j] = r * r; }
                            } else if (sub == 4) {
#pragma unroll
                                for (int j = 0; j < 4; ++j) v[j] = v[j] / (1.0f + __expf(-v[j]));
                            }
                            w[2 * n] = cvt_pk_bf16(v[0], v[1]); w[2 * n + 1] = cvt_pk_bf16(v[2], v[3]);
                        }
                        *(GAS u32x4*)(rowp + bj * HALF) = w;
                    }
                }
        }
    }
};
struct EpiRes {
    const float* xin; float* xout; bf16_t* xb; float* ssn; int glu;
    __device__ __forceinline__ void operator()(const f32x4 (&acc)[2][2][4][2], const Unit& u, int wr, int wc, int fr, int fq, LAS unsigned char*, int) const {
        const int row0 = u.pm * BM + wr * 64 + fr;
        const GAS float* xi = (const GAS float*)xin; GAS float* xo = (GAS float*)xout; GAS bf16_t* xbg = (GAS bf16_t*)xb; GAS float* ssg = (GAS float*)ssn;
        if (glu) {
            const size_t cb = (size_t)u.pn * HALF + wc * 32 + 8 * fq;
#pragma unroll
            for (int ai = 0; ai < 2; ++ai) {
                f32x4 xv[4][2];
#pragma unroll
                for (int m = 0; m < 4; ++m)
#pragma unroll
                    for (int n = 0; n < 2; ++n) xv[m][n] = *(const GAS f32x4*)(xi + (size_t)(row0 + ai * HALF + m * 16) * D_ + cb + n * 4);
#pragma unroll
                for (int m = 0; m < 4; ++m) {
                    const int row = row0 + ai * HALF + m * 16; const size_t off = (size_t)row * D_ + cb;
                    float sq = 0.f; u32x4 w;
#pragma unroll
                    for (int n = 0; n < 2; ++n) {
                        const f32x4 va = acc[ai][0][m][n], ga = acc[ai][1][m][n];
                        f32x4 x4 = xv[m][n];
#pragma unroll
                        for (int j = 0; j < 4; ++j) { x4[j] += va[j] / (1.0f + __expf(-ga[j])); sq += x4[j] * x4[j]; }
                        *(GAS f32x4*)(xo + off + n * 4) = x4;
                        w[2 * n] = cvt_pk_bf16(x4[0], x4[1]); w[2 * n + 1] = cvt_pk_bf16(x4[2], x4[3]);
                    }
                    *(GAS u32x4*)(xbg + off) = w;
                    sq += __shfl_xor(sq, 16); sq += __shfl_xor(sq, 32);
                    if (fq == 0) atomicAdd((float*)ssn + (size_t)((u.pn >> 1) * 4 + wc) * T_ + row, sq);
                }
            }
        } else {
            const size_t cb = (size_t)u.pn * BM + wc * 32 + 8 * fq;
#pragma unroll
            for (int ai = 0; ai < 2; ++ai) {
                f32x4 xv[4][2][2];
#pragma unroll
                for (int m = 0; m < 4; ++m)
#pragma unroll
                    for (int bj = 0; bj < 2; ++bj)
#pragma unroll
                        for (int n = 0; n < 2; ++n) xv[m][bj][n] = *(const GAS f32x4*)(xi + (size_t)(row0 + ai * HALF + m * 16) * D_ + cb + bj * HALF + n * 4);
#pragma unroll
                for (int m = 0; m < 4; ++m) {
                    const int row = row0 + ai * HALF + m * 16; const size_t off = (size_t)row * D_ + cb;
                    float sq = 0.f;
#pragma unroll
                    for (int bj = 0; bj < 2; ++bj) {
                        u32x4 w;
#pragma unroll
                        for (int n = 0; n < 2; ++n) {
                            f32x4 x4 = xv[m][bj][n] + acc[ai][bj][m][n];
#pragma unroll
                            for (int j = 0; j < 4; ++j) sq += x4[j] * x4[j];
                            *(GAS f32x4*)(xo + off + bj * HALF + n * 4) = x4;
                            w[2 * n] = cvt_pk_bf16(x4[0], x4[1]); w[2 * n + 1] = cvt_pk_bf16(x4[2], x4[3]);
                        }
                        *(GAS u32x4*)(xbg + off + bj * HALF) = w;
                    }
                    sq += __shfl_xor(sq, 16); sq += __shfl_xor(sq, 32);
                    if (fq == 0) ssg[(size_t)(u.pn * 4 + wc) * T_ + row] = sq;
                }
            }
        }
    }
};

template <class Epi, class Sched>
__device__ __forceinline__ void gemm_phase(LAS unsigned char* lds, const Gemm g, const Sched& S, const Epi& E) {
    const int tid = otid(), wid = __builtin_amdgcn_readfirstlane(tid >> 6), lane = tid & 63, wr = wid >> 2, wc = wid & 3, fr = lane & 15, fq = lane >> 4;
    const int K = g.K, nt = K / BK;
    unsigned voffA[2], voffB[2];
#pragma unroll
    for (int i = 0; i < 2; ++i) { int R, C; stage_rc(tid * 16 + i * 8192, R, C); voffA[i] = (unsigned)(R * K + C) * 2u; voffB[i] = voffA[i]; }
    const size_t kstep = (size_t)(BK * 2);
    const size_t hstep = (size_t)HALF * K * 2;
    const size_t tstep = 2 * hstep;
    const unsigned ldsw = (unsigned)wid * 1024u;
    const int aoff = lds_byte(wr * 64 + fr, fq * 8), boff = lds_byte(wc * 32 + fr, fq * 8);
#define PG8_SA(b, h) (((b) * 2 + (h)) * HTB)
#define PG8_SB(b, h) ((4 + (b) * 2 + (h)) * HTB)
#define PG8_STAGE(bufoff, gbase, voff) do { _Pragma("unroll") for (int _i = 0; _i < 2; ++_i) \
        __builtin_amdgcn_global_load_lds((const unsigned*)((const char*)(gbase) + (voff)[_i]), (LAS unsigned*)(lds + (bufoff) + ldsw + _i * 8192), 16, 0, 0); } while (0)
#define PG8_LDA(dst, b, h) do { _Pragma("unroll") for (int m = 0; m < 4; ++m) _Pragma("unroll") for (int k = 0; k < 2; ++k) dst[m][k] = *(const LAS bf16x8*)(lds + PG8_SA(b, h) + aoff + m * 2048 + k * 1024); } while (0)
#define PG8_LDB(dst, b, h) do { _Pragma("unroll") for (int n = 0; n < 2; ++n) _Pragma("unroll") for (int k = 0; k < 2; ++k) dst[n][k] = *(const LAS bf16x8*)(lds + PG8_SB(b, h) + boff + n * 2048 + k * 1024); } while (0)
#define PG8_MMA(ai, bj, At, Bt) do { __builtin_amdgcn_s_setprio(1); _Pragma("unroll") for (int m = 0; m < 4; ++m) _Pragma("unroll") for (int n = 0; n < 2; ++n) _Pragma("unroll") for (int k = 0; k < 2; ++k) \
        acc[ai][bj][m][n] = __builtin_amdgcn_mfma_f32_16x16x32_bf16(Bt[n][k], At[m][k], acc[ai][bj][m][n], 0, 0, 0); __builtin_amdgcn_s_setprio(0); } while (0)
#define PG8_WAIT_V(n) asm volatile("s_waitcnt vmcnt(" #n ")" ::: "memory")
#define PG8_WAIT_L(n) asm volatile("s_waitcnt lgkmcnt(" #n ")" ::: "memory")
#define PG8_BAR __builtin_amdgcn_s_barrier()
#define PG8_SCHED __builtin_amdgcn_sched_barrier(0)
    Unit cur, nxt; int ui = 0;
    if (!S.next(0, cur)) return;
    f32x4 acc[2][2][4][2];
#pragma unroll
    for (int a = 0; a < 2; ++a)
#pragma unroll
        for (int b = 0; b < 2; ++b)
#pragma unroll
            for (int m = 0; m < 4; ++m)
#pragma unroll
                for (int n = 0; n < 2; ++n) acc[a][b][m][n] = (f32x4){0.f, 0.f, 0.f, 0.f};
    bf16x8 At[4][2], B0[2][2], B1[2][2];
    const char* cA = (const char*)g.A + (size_t)cur.pm * tstep; const char* cB = (const char*)g.Bt + (size_t)cur.pn * tstep;
    PG8_STAGE(PG8_SB(0, 0), cB, voffB); PG8_STAGE(PG8_SA(0, 0), cA, voffA); PG8_STAGE(PG8_SB(0, 1), cB + hstep, voffB); PG8_STAGE(PG8_SA(0, 1), cA + hstep, voffA);
    if (wr == 1) PG8_BAR;
    PG8_WAIT_V(4); PG8_BAR;
    PG8_STAGE(PG8_SB(1, 0), cB + kstep, voffB); PG8_STAGE(PG8_SA(1, 0), cA + kstep, voffA); PG8_STAGE(PG8_SB(1, 1), cB + hstep + kstep, voffB);
    PG8_WAIT_V(6); PG8_BAR;
    for (;;) {
        const bool has_next = S.next(ui + 1, nxt);
        const char* nA = has_next ? (const char*)g.A + (size_t)nxt.pm * tstep : cA; const char* nB = has_next ? (const char*)g.Bt + (size_t)nxt.pn * tstep : cB;
        for (int t = 0; t < nt; t += 2) {
            const bool last = (t == nt - 2);
            const char* a1 = cA + (size_t)(t + 1) * kstep;
            const char* a2 = last ? nA : cA + (size_t)(t + 2) * kstep; const char* b2 = last ? nB : cB + (size_t)(t + 2) * kstep;
            const char* a3 = a2 + kstep; const char* b3 = b2 + kstep;
            PG8_LDB(B0, 0, 0); PG8_SCHED; PG8_LDA(At, 0, 0); PG8_STAGE(PG8_SA(1, 1), a1 + hstep, voffA);
            PG8_WAIT_L(8); PG8_BAR; PG8_WAIT_L(0); PG8_MMA(0, 0, At, B0); PG8_BAR; PG8_SCHED;
            PG8_LDB(B1, 0, 1); PG8_STAGE(PG8_SB(0, 0), b2, voffB);
            PG8_BAR; PG8_WAIT_L(0); PG8_MMA(0, 1, At, B1); PG8_BAR;
            PG8_LDA(At, 0, 1); PG8_STAGE(PG8_SA(0, 0), a2, voffA);
            PG8_BAR; PG8_WAIT_L(0); PG8_MMA(1, 0, At, B0); PG8_BAR; PG8_SCHED;
            PG8_STAGE(PG8_SB(0, 1), b2 + hstep, voffB);
            PG8_WAIT_V(6); PG8_BAR; PG8_MMA(1, 1, At, B1); PG8_BAR;
            PG8_LDB(B0, 1, 0); PG8_SCHED; PG8_LDA(At, 1, 0); PG8_STAGE(PG8_SA(0, 1), a2 + hstep, voffA);
            PG8_WAIT_L(8); PG8_BAR; PG8_WAIT_L(0); PG8_MMA(0, 0, At, B0); PG8_BAR; PG8_SCHED;
            PG8_LDB(B1, 1, 1); PG8_STAGE(PG8_SB(1, 0), b3, voffB);
            PG8_BAR; PG8_WAIT_L(0); PG8_MMA(0, 1, At, B1); PG8_BAR;
            PG8_LDA(At, 1, 1); PG8_STAGE(PG8_SA(1, 0), a3, voffA);
            PG8_BAR; PG8_WAIT_L(0); PG8_MMA(1, 0, At, B0); PG8_BAR; PG8_SCHED;
            PG8_STAGE(PG8_SB(1, 1), b3 + hstep, voffB);
            PG8_WAIT_V(6); PG8_BAR; PG8_MMA(1, 1, At, B1); PG8_BAR;
        }
        E(acc, cur, wr, wc, fr, fq, lds, ui);
        if (!has_next) break;
#pragma unroll
        for (int a = 0; a < 2; ++a)
#pragma unroll
            for (int b = 0; b < 2; ++b)
#pragma unroll
                for (int m = 0; m < 4; ++m)
#pragma unroll
                    for (int n = 0; n < 2; ++n) acc[a][b][m][n] = (f32x4){0.f, 0.f, 0.f, 0.f};
        cur = nxt; cA = nA; cB = nB; ++ui;
    }
    PG8_WAIT_V(0);
    if (wr == 0) PG8_BAR;
    PG8_BAR;
#undef PG8_SA
#undef PG8_SB
#undef PG8_STAGE
#undef PG8_LDA
#undef PG8_LDB
#undef PG8_MMA
#undef PG8_WAIT_V
#undef PG8_WAIT_L
#undef PG8_BAR
#undef PG8_SCHED
}
}

namespace att {
constexpr int D = 128, KVBLK = 64, LDK = 6144;
constexpr float SCALE = 0.088388347648318440f;
constexpr float THR = 8.f;
constexpr size_t SHM_V = KVBLK * D * 2, SHM_K = KVBLK * D * 2;
#define KSWZ(row, colB) ((row) * 256 + ((colB) ^ (((row) & 7) << 4)))
#define SBAR() __builtin_amdgcn_sched_barrier(0)
__device__ __forceinline__ int crow(int r, int hi) { return (r & 3) + 8 * (r >> 2) + 4 * hi; }
__device__ __forceinline__ void partialSM(f32x16& p0, f32x16& p1, float& m_reg, float& mn, float& alpha, bool msk) {
    constexpr float C = SCALE * 1.4426950408889634f;
    if (msk) {
#pragma unroll
        for (int r = 0; r < 16; ++r) { p0[r] = -1e30f; p1[r] = -1e30f; }
    }
    float pmax = p0[0];
#pragma unroll
    for (int r = 1; r < 16; ++r) pmax = fmaxf(pmax, p0[r]);
#pragma unroll
    for (int r = 0; r < 16; ++r) pmax = fmaxf(pmax, p1[r]);
    { auto rr = __builtin_amdgcn_permlane32_swap(__float_as_uint(pmax), __float_as_uint(pmax), false, false);
      pmax = fmaxf(__uint_as_float(rr[0]), __uint_as_float(rr[1])); }
    if (__builtin_expect(__all(pmax - m_reg <= THR / SCALE), 1)) { mn = m_reg; alpha = 1.f; }
    else { mn = fmaxf(m_reg, pmax); alpha = __builtin_amdgcn_exp2f((m_reg - mn) * C); m_reg = mn; }
    float mnC = -mn * C;
#pragma unroll
    for (int r = 0; r < 16; ++r) p0[r] = fmaf(p0[r], C, mnC);
#pragma unroll
    for (int r = 0; r < 16; ++r) p1[r] = fmaf(p1[r], C, mnC);
#pragma unroll
    for (int r = 0; r < 16; ++r) p0[r] = __builtin_amdgcn_exp2f(p0[r]);
}
__device__ __forceinline__ void finishSM(f32x16& p0, f32x16& p1, float alpha, float& l_reg, bf16x8& pa0, bf16x8& pa1, bf16x8& pa2, bf16x8& pa3) {
#pragma unroll
    for (int r = 0; r < 16; ++r) p1[r] = __builtin_amdgcn_exp2f(p1[r]);
    float ps = 0;
#pragma unroll
    for (int r = 0; r < 16; ++r) ps += p0[r];
#pragma unroll
    for (int r = 0; r < 16; ++r) ps += p1[r];
    { auto rr = __builtin_amdgcn_permlane32_swap(__float_as_uint(ps), __float_as_uint(ps), false, false);
      ps = __uint_as_float(rr[0]) + __uint_as_float(rr[1]); }
    l_reg = l_reg * alpha + ps;
#define PK4(P, BASE, OUT) do { unsigned a0 = cvt_pk_bf16(P[BASE + 0], P[BASE + 1]), a1 = cvt_pk_bf16(P[BASE + 2], P[BASE + 3]);   \
    unsigned b0 = cvt_pk_bf16(P[BASE + 4], P[BASE + 5]), b1 = cvt_pk_bf16(P[BASE + 6], P[BASE + 7]);                              \
    auto r0 = __builtin_amdgcn_permlane32_swap(a0, b0, false, false); auto r1 = __builtin_amdgcn_permlane32_swap(a1, b1, false, false); \
    u32x4 w = {r0[0], r1[0], r0[1], r1[1]}; OUT = *reinterpret_cast<bf16x8*>(&w); } while (0)
    PK4(p0, 0, pa0); PK4(p0, 8, pa1); PK4(p1, 0, pa2); PK4(p1, 8, pa3);
#undef PK4
}
__device__ __forceinline__ void qkt(f32x16& p0, f32x16& p1, const char* Ks, const bf16x8* qr, int r32, int hi) {
    p0 = f32x16{}; p1 = f32x16{};
#pragma unroll
    for (int d0 = 0; d0 < 8; ++d0) { int cb = (d0 * 16 + hi * 8) * 2;
        bf16x8 b0 = *reinterpret_cast<const bf16x8*>(Ks + KSWZ(r32, cb));
        bf16x8 b1 = *reinterpret_cast<const bf16x8*>(Ks + KSWZ(32 + r32, cb));
        p0 = __builtin_amdgcn_mfma_f32_32x32x16_bf16(b0, qr[d0], p0, 0, 0, 0);
        p1 = __builtin_amdgcn_mfma_f32_32x32x16_bf16(b1, qr[d0], p1, 0, 0, 0); }
}
__device__ __forceinline__ int v_st(int k, int c) { const int kk = (k & ~0xC) | ((k & 4) << 1) | ((k & 8) >> 1); return ((kk >> 3) * 4 + (c >> 5)) * 512 + ((kk & 7) * 32 + (c & 31)) * 2; }
__device__ __forceinline__ int v_rd_base(int lane) { return ((lane & 3) << 3) | (((lane >> 2) & 3) << 6) | (((lane >> 4) & 1) << 5) | (((lane >> 5) & 1) << 8); }
constexpr int v_rd_off(int d0, int ks, int half) { return d0 * 512 + ks * 4096 + half * 2048; }
template <int OFF> __device__ __forceinline__ s16x4 tr_read(int vb) {
    s16x4 r; asm volatile("ds_read_b64_tr_b16 %0, %1 offset:%2" : "=&v"(r) : "v"(vb), "i"(OFF) : "memory"); return r;
}
template <int D0> __device__ __forceinline__ void pv_one(f32x16& od, int vb, bf16x8 pa0, bf16x8 pa1, bf16x8 pa2, bf16x8 pa3) {
    const s16x4 l0 = tr_read<v_rd_off(D0, 0, 0)>(vb), h0 = tr_read<v_rd_off(D0, 0, 1)>(vb), l1 = tr_read<v_rd_off(D0, 1, 0)>(vb), h1 = tr_read<v_rd_off(D0, 1, 1)>(vb);
    const s16x4 l2 = tr_read<v_rd_off(D0, 2, 0)>(vb), h2 = tr_read<v_rd_off(D0, 2, 1)>(vb), l3 = tr_read<v_rd_off(D0, 3, 0)>(vb), h3 = tr_read<v_rd_off(D0, 3, 1)>(vb);
    asm volatile("s_waitcnt lgkmcnt(0)" ::: "memory"); SBAR();
#define PK(L, H) (bf16x8){L[0], L[1], L[2], L[3], H[0], H[1], H[2], H[3]}
    od = __builtin_amdgcn_mfma_f32_32x32x16_bf16(pa0, PK(l0, h0), od, 0, 0, 0);
    od = __builtin_amdgcn_mfma_f32_32x32x16_bf16(pa1, PK(l1, h1), od, 0, 0, 0);
    od = __builtin_amdgcn_mfma_f32_32x32x16_bf16(pa2, PK(l2, h2), od, 0, 0, 0);
    od = __builtin_amdgcn_mfma_f32_32x32x16_bf16(pa3, PK(l3, h3), od, 0, 0, 0);
#undef PK
}
__device__ __forceinline__ void pv_d0(f32x16* o, int vb, bf16x8 pa0, bf16x8 pa1, bf16x8 pa2, bf16x8 pa3) {
    pv_one<0>(o[0], vb, pa0, pa1, pa2, pa3); pv_one<1>(o[1], vb, pa0, pa1, pa2, pa3); pv_one<2>(o[2], vb, pa0, pa1, pa2, pa3); pv_one<3>(o[3], vb, pa0, pa1, pa2, pa3);
}
__device__ __forceinline__ void attn_body(const bf16_t* __restrict__ Qb, const bf16_t* __restrict__ Kh, const bf16_t* __restrict__ Vh, int NT, int ntw, char* lds, f32x16 (&o)[4]) {
    const int tid = otid(), wid = __builtin_amdgcn_readfirstlane(tid >> 6), lane = tid & 63, r32 = lane & 31, hi = lane >> 5;
    char* V_lds = lds; char* K_lds = lds + 2 * SHM_V;
    float* wsf = (float*)(lds + 2 * SHM_V + 2 * SHM_K) + wid * 64; float* li_l = wsf; float* al_l = wsf + 32;
    float m_reg = -1e30f, l_reg = 0; bf16x8 qr[8];
#pragma unroll
    for (int d = 0; d < 4; ++d) o[d] = f32x16{};
    const bf16_t* Qw = Qb + (long)(wid * 32 + r32) * LDK + hi * 8;
#pragma unroll
    for (int d0 = 0; d0 < 8; ++d0) qr[d0] = *reinterpret_cast<const bf16x8*>(Qw + d0 * 16);
    const int sr = tid >> 4, sc = (tid & 15) * 8, vst0 = v_st(sr, sc), vst1 = v_st(32 + sr, sc);
    const int vb0 = (int)(uintptr_t)V_lds + v_rd_base(lane);
    struct { bf16x8 vs0, vs1, ks0, ks1; } sr_[2];
#define SLOAD(i, k0) do { sr_[i].vs0 = *reinterpret_cast<const bf16x8*>(&Vh[(long)((k0) + sr) * LDK + sc]); sr_[i].vs1 = *reinterpret_cast<const bf16x8*>(&Vh[(long)((k0) + 32 + sr) * LDK + sc]); \
    sr_[i].ks0 = *reinterpret_cast<const bf16x8*>(&Kh[(long)((k0) + sr) * LDK + sc]); sr_[i].ks1 = *reinterpret_cast<const bf16x8*>(&Kh[(long)((k0) + 32 + sr) * LDK + sc]); } while (0)
#define SWRITE(b, i) do { *(bf16x8*)(V_lds + (b) * SHM_V + vst0) = sr_[i].vs0;          \
    *(bf16x8*)(V_lds + (b) * SHM_V + vst1) = sr_[i].vs1; int kc = sc * 2;               \
    *(bf16x8*)(K_lds + (b) * SHM_K + KSWZ(sr, kc)) = sr_[i].ks0;                       \
    *(bf16x8*)(K_lds + (b) * SHM_K + KSWZ(32 + sr, kc)) = sr_[i].ks1; } while (0)
#define SWAIT() asm volatile("s_waitcnt vmcnt(4)" ::: "memory")
#define RESC(a) do { if (__any((a) < 1.f)) { if (hi == 0) al_l[r32] = (a); asm volatile("s_waitcnt lgkmcnt(0)" ::: "memory"); \
    _Pragma("unroll") for (int d = 0; d < 4; ++d) _Pragma("unroll") for (int r = 0; r < 16; ++r) o[d][r] *= al_l[crow(r, hi)]; } } while (0)
    f32x16 pA0, pA1, pB0, pB1; float mnA, mnB, alA, alB; bf16x8 pa0, pa1, pa2, pa3;
    constexpr int SE = 0, SO = 1;
    __syncthreads();
    SLOAD(SE, 0); asm volatile("s_waitcnt vmcnt(0)" ::: "memory"); SWRITE(0, SE); __syncthreads();
    qkt(pA0, pA1, K_lds, qr, r32, hi); partialSM(pA0, pA1, m_reg, mnA, alA, false);
    SLOAD(SO, KVBLK); if (2 < NT) SLOAD(SE, 2 * KVBLK);
    SWAIT(); SWRITE(1, SO); __syncthreads();
    for (int j = 1; j + 1 < NT; j += 2) {
        SBAR(); qkt(pB0, pB1, K_lds + SHM_K, qr, r32, hi);
        finishSM(pA0, pA1, alA, l_reg, pa0, pa1, pa2, pa3); SBAR();
        SLOAD(SO, (j + 2) * KVBLK); SBAR();
        pv_d0(o, vb0, pa0, pa1, pa2, pa3); partialSM(pB0, pB1, m_reg, mnB, alB, j >= ntw);
        __syncthreads(); SWAIT(); SWRITE(0, SE);
        RESC(alB); __syncthreads();
        SBAR(); qkt(pA0, pA1, K_lds, qr, r32, hi);
        finishSM(pB0, pB1, alB, l_reg, pa0, pa1, pa2, pa3); SBAR();
        if (j + 3 < NT) SLOAD(SE, (j + 3) * KVBLK); SBAR();
        pv_d0(o, vb0 + (int)SHM_V, pa0, pa1, pa2, pa3); partialSM(pA0, pA1, m_reg, mnA, alA, (j + 1) >= ntw);
        __syncthreads(); SWAIT(); SWRITE(1, SO);
        RESC(alA); __syncthreads();
    }
    SBAR(); qkt(pB0, pB1, K_lds + SHM_K, qr, r32, hi);
    finishSM(pA0, pA1, alA, l_reg, pa0, pa1, pa2, pa3); SBAR();
    pv_d0(o, vb0, pa0, pa1, pa2, pa3); partialSM(pB0, pB1, m_reg, mnB, alB, (NT - 1) >= ntw);
    __syncthreads(); RESC(alB);
    finishSM(pB0, pB1, alB, l_reg, pa0, pa1, pa2, pa3); SBAR();
    pv_d0(o, vb0 + (int)SHM_V, pa0, pa1, pa2, pa3);
    if (hi == 0) li_l[r32] = l_reg; asm volatile("s_waitcnt lgkmcnt(0)" ::: "memory");
#pragma unroll
    for (int r = 0; r < 16; ++r) { const float rl = __builtin_amdgcn_rcpf(li_l[crow(r, hi)]);
#pragma unroll
        for (int d = 0; d < 4; ++d) o[d][r] *= rl; }
#undef SLOAD
#undef SWRITE
#undef SWAIT
#undef RESC
}
}

__device__ __forceinline__ void sincos_red(double ang, float& s, float& c) {
    const double k = rint(ang * 0.15915494309189535);
    const float r = (float)(ang - k * 6.283185307179586);
    s = __sinf(r); c = __cosf(r);
}
__device__ __forceinline__ float gelu_tanh(float y) {
    const float z = 0.7978845608028654f * (y + 0.044715f * y * y * y);
    const float th = 1.0f - 2.0f / (1.0f + __expf(2.0f * z));
    return 0.5f * y * (1.0f + th);
}

struct ConvJob { const float* W; bf16_t* Wt; const float* gain; int K, N, glu, tile; };
struct ConvRegs { f32x4 va[4], vb[4]; float ga[4], gb[4]; };
__device__ __forceinline__ ConvJob conv_decode(const Params& p, unsigned char* ws, int t) {
    ConvJob j; j.glu = 0; j.gain = nullptr;
    if (t < 1536) { const int q = t / 768; j.tile = t - q * 768; j.W = p.a_w_in + (size_t)q * 2048 * 6144; j.Wt = (bf16_t*)(ws + OFF_WT_A_IN + q * SZ_A_IN); j.K = 2048; j.N = 6144; j.gain = p.norm_mix + (size_t)(3 * q) * D_; }
    else if (t < 2048) { const int u = t - 1536; const int q = u / 256; j.tile = u - q * 256; j.W = p.a_w_out + (size_t)q * 2048 * 2048; j.Wt = (bf16_t*)(ws + OFF_WT_A_OUT + q * SZ_A_OUT); j.K = 2048; j.N = 2048; }
    else if (t < 2560) { j.tile = t - 2048; j.W = p.b_w_glu; j.Wt = (bf16_t*)(ws + OFF_WT_GLU); j.K = 2048; j.N = 4096; j.glu = 1; }
    else if (t < 4096) { j.tile = t - 2560; j.W = p.c_w_in; j.Wt = (bf16_t*)(ws + OFF_WT_C_IN); j.K = 2048; j.N = 12288; j.gain = p.norm_mix + 2 * D_; }
    else if (t < 4608) { j.tile = t - 4096; j.W = p.c_w_out; j.Wt = (bf16_t*)(ws + OFF_WT_C_OUT); j.K = 4096; j.N = 2048; }
    else if (t < 8704) { const int u = t - 4608; const int i = u / 1024; j.tile = u - i * 1024; j.W = p.mlp_w1 + (size_t)i * 2048 * 8192; j.Wt = (bf16_t*)(ws + OFF_WT_W1 + i * SZ_W1); j.K = 2048; j.N = 8192; j.gain = p.norm_mlp + (size_t)i * D_; }
    else { const int u = t - 8704; const int i = u / 1024; j.tile = u - i * 1024; j.W = p.mlp_w2 + (size_t)i * 8192 * 2048; j.Wt = (bf16_t*)(ws + OFF_WT_W2 + i * SZ_W1); j.K = 8192; j.N = 2048; }
    return j;
}
__device__ __forceinline__ void conv_load(const ConvJob& j, ConvRegs& r, int tid) {
    const int ntn = j.N >> 7; const int tk = j.tile / ntn, tn = j.tile - tk * ntn; const int k0 = tk << 7, n0 = tn << 7;
    const int kp = tid >> 5, nl = (tid & 31) << 2;
#pragma unroll
    for (int i = 0; i < 4; ++i) { const int k = 2 * (kp + 16 * i);
        r.va[i] = *(const f32x4*)(j.W + (size_t)(k0 + k) * j.N + n0 + nl); r.vb[i] = *(const f32x4*)(j.W + (size_t)(k0 + k + 1) * j.N + n0 + nl);
        r.ga[i] = j.gain ? j.gain[k0 + k] : 1.f; r.gb[i] = j.gain ? j.gain[k0 + k + 1] : 1.f; }
}
__device__ __forceinline__ void conv_store(const ConvJob& j, const ConvRegs& r, int tid, unsigned* ldsw) {
    const int ntn = j.N >> 7; const int tk = j.tile / ntn, tn = j.tile - tk * ntn; const int k0 = tk << 7, n0 = tn << 7;
    const int kp = tid >> 5, nl = (tid & 31) << 2;
    __syncthreads();
#pragma unroll
    for (int i = 0; i < 4; ++i) { const int kpair = kp + 16 * i;
#pragma unroll
        for (int jj = 0; jj < 4; ++jj) ldsw[(nl + jj) * 65 + kpair] = cvt_pk_bf16(r.va[i][jj] * r.ga[i], r.vb[i][jj] * r.gb[i]); }
    __syncthreads();
    int nbase = n0;
    if (j.glu) { const int bj = n0 >> 11, pn = (n0 & 2047) >> 7; nbase = 256 * pn + 128 * bj; }
#pragma unroll
    for (int i = 0; i < 4; ++i) { const int n = (tid >> 4) + 32 * i, k8 = tid & 15;
        u32x4 w; w.x = ldsw[n * 65 + k8 * 4 + 0]; w.y = ldsw[n * 65 + k8 * 4 + 1]; w.z = ldsw[n * 65 + k8 * 4 + 2]; w.w = ldsw[n * 65 + k8 * 4 + 3];
        const int c5 = n & 31, np = (n & ~31) | (16 * ((c5 >> 2) & 1) + 4 * (c5 >> 3) + (c5 & 3));
        *(u32x4*)(j.Wt + (size_t)(nbase + np) * j.K + k0 + k8 * 8) = w; }
}

__device__ __forceinline__ void prep_phase(const Params& p, unsigned char* shm) {
    const int tid = otid(), bid = obid(), G = gridDim.x;
    unsigned char* ws = p.ws;
    {
        ConvJob jc = conv_decode(p, ws, bid); ConvRegs rc; conv_load(jc, rc, tid);
#pragma unroll 1
        for (int t = bid; t < 12800; t += G) {
            ConvJob jn = jc; ConvRegs rn = rc;
            if (t + G < 12800) { jn = conv_decode(p, ws, t + G); conv_load(jn, rn, tid); }
            conv_store(jc, rc, tid, (unsigned*)shm);
            jc = jn; rc = rn;
        }
    }
    {
        float* ss = (float*)(ws + OFF_SSP); bf16_t* xb = (bf16_t*)(ws + OFF_XB);
        const int wid = tid >> 6, lane = tid & 63;
        for (int row = bid * 8 + wid; row < T_; row += G * 8) {
            const float* xr = p.x + (size_t)row * D_; float sq = 0.f;
#pragma unroll
            for (int i = 0; i < 8; ++i) { const f32x4 v = *(const f32x4*)(xr + (i * 64 + lane) * 4);
                sq += v[0] * v[0] + v[1] * v[1] + v[2] * v[2] + v[3] * v[3];
                *(f32x4*)(p.out + (size_t)row * D_ + (i * 64 + lane) * 4) = v;
                u32x2 w; w.x = cvt_pk_bf16(v[0], v[1]); w.y = cvt_pk_bf16(v[2], v[3]);
                *(u32x2*)(xb + (size_t)row * D_ + (i * 64 + lane) * 4) = w; }
#pragma unroll
            for (int o = 32; o > 0; o >>= 1) sq += __shfl_xor(sq, o);
            if (lane < 32) ss[(size_t)lane * T_ + row] = (lane == 0) ? sq : 0.f;
        }
        for (int i = bid * 512 + tid; i < 32 * T_; i += G * 512) ss[(size_t)3 * 32 * T_ + i] = 0.f;
        float* rssq = (float*)(ws + OFF_RSQP);
        for (int i = bid * 512 + tid; i < 64 * T_; i += G * 512) rssq[i] = 0.f;
    }
    {
        float* par = (float*)(ws + OFF_PAR);
        for (int i = bid * 512 + tid; i < PAR_N; i += G * 512) {
            float v;
            if (i < PAR_NFINAL) v = p.norm_mix[D_ + i];
            else if (i < PAR_LAM) v = p.norm_final[i - PAR_NFINAL];
            else if (i < PAR_SUBLN) v = p.a_lambda[i - PAR_LAM];
            else if (i < PAR_BD) v = p.a_subln[i - PAR_SUBLN];
            else v = p.b_d[i - PAR_BD];
            par[i] = v;
        }
    }
    {
        f32x2* rot = (f32x2*)(ws + OFF_ROT);
        for (int i = bid * 512 + tid; i < 4096 * 128; i += G * 512) {
            const int pos = i >> 7, j = i & 127;
            const double inv = exp(-9.210340371976184 * ((double)j / 127.0));
            float s, c; sincos_red((double)pos * inv, s, c);
            f32x2 v; v.x = c; v.y = s; rot[i] = v;
        }
    }
    {
        bf16_t* Bm = (bf16_t*)(ws + OFF_S5B); bf16_t* Cm = (bf16_t*)(ws + OFF_S5C); f32x2* AB = (f32x2*)(ws + OFF_S5AB);
        const float* gmix = p.norm_mix + 1 * D_;
        for (int i = bid * 512 + tid; i < 128 * 64; i += G * 512) {
            const int g = i >> 6, pp = i & 63;
            const float lre = p.b_a_re[i], lim = p.b_a_im[i];
            const float dt = __expf(p.b_log_dt[g]);
            const float mag = __expf(lre * dt);
            float sn, cs; sincos_red((double)lim * (double)dt, sn, cs);
            const float abr = mag * cs, abi = mag * sn;
            const float den = lre * lre + lim * lim;
            const float nr = abr - 1.0f, ni = abi;
            const float cr_ = (nr * lre + ni * lim) / den, ci_ = (ni * lre - nr * lim) / den;
            f32x2 ab; ab.x = abr; ab.y = abi; AB[i] = ab;
#pragma unroll
            for (int c = 0; c < 16; ++c) {
                const float br = p.b_b_re[(size_t)i * 16 + c], bi = p.b_b_im[(size_t)i * 16 + c];
                const float gm = gmix[g * 16 + c];
                Bm[((size_t)g * 128 + pp) * 16 + c] = f2bf((cr_ * br - ci_ * bi) * gm);
                Bm[((size_t)g * 128 + 64 + pp) * 16 + c] = f2bf((cr_ * bi + ci_ * br) * gm);
                Cm[((size_t)g * 16 + c) * 128 + pp] = f2bf(p.b_c_re[((size_t)g * 16 + c) * 64 + pp]);
                Cm[((size_t)g * 16 + c) * 128 + 64 + pp] = f2bf(-p.b_c_im[((size_t)g * 16 + c) * 64 + pp]);
            }
        }
    }
}

__device__ __forceinline__ void attn_phase(const Params& p, int j, float lambda_init, unsigned char* shm) {
    const int tid = otid(), wid = __builtin_amdgcn_readfirstlane(tid >> 6), lane = tid & 63, r32 = lane & 31, hi = lane >> 5;
    const bf16_t* qkv = (const bf16_t*)(p.ws + OFF_BIG);
    bf16_t* oa = (bf16_t*)(p.ws + OFF_OA);
    float* scr = (float*)(p.ws + OFF_ATT_SCR) + (size_t)obid() * 2 * 32768;
    float lam;
    { const float* lp = (const float*)(p.ws + OFF_PAR) + PAR_LAM + (size_t)j * 512;
      float a = lp[lane] * lp[128 + lane] + lp[64 + lane] * lp[192 + lane];
      float b = lp[256 + lane] * lp[384 + lane] + lp[320 + lane] * lp[448 + lane];
#pragma unroll
      for (int o = 32; o > 0; o >>= 1) { a += __shfl_xor(a, o); b += __shfl_xor(b, o); }
      lam = __expf(a) - __expf(b) + lambda_init; lam = __uint_as_float(__builtin_amdgcn_readfirstlane(__float_as_uint(lam))); }
    const float* sub = (const float*)(p.ws + OFF_PAR) + PAR_SUBLN + (size_t)j * 256;
    const int c = obid(); const int xcd = c & 7, jj = c >> 3;
    const int bh = xcd * 4 + (jj >> 3), pi = jj & 7;
    const int b = bh >> 3, h = bh & 7;
#pragma unroll 1
    for (int it = 0; it < 2; ++it) {
        const int qb = it == 0 ? (15 - pi) : pi;
        const int NT = 4 * qb + 4, ntw = 4 * qb + (wid >> 1) + 1;
        const size_t tok0 = (size_t)b * S_ + (size_t)qb * 256;
        f32x16 o[4];
#pragma unroll 1
        for (int ps = 0; ps < 4; ++ps) {
            const int e = ps >> 1, t = ps & 1;
            float* sc = scr + e * 32768;
            att::attn_body(qkv + tok0 * 6144 + h * 256 + t * 128, qkv + (size_t)b * S_ * 6144 + 2048 + h * 256 + t * 128,
                           qkv + (size_t)b * S_ * 6144 + 4096 + h * 256 + e * 128, NT, ntw, (char*)shm, o);
            if (t == 0) {
#pragma unroll
                for (int d = 0; d < 4; ++d)
#pragma unroll
                    for (int r = 0; r < 16; ++r) sc[tid * 64 + d * 16 + r] = o[d][r];
            } else {
#pragma unroll
                for (int d = 0; d < 4; ++d)
#pragma unroll
                    for (int r = 0; r < 16; ++r) { const float cv = sc[tid * 64 + d * 16 + r] - lam * o[d][r]; o[d][r] = cv; if (e == 0) sc[tid * 64 + d * 16 + r] = cv; }
            }
        }
        float ssq[16];
#pragma unroll
        for (int r = 0; r < 16; ++r) { float s = 0.f;
#pragma unroll
            for (int d = 0; d < 4; ++d) { const float c0 = scr[tid * 64 + d * 16 + r]; s += c0 * c0 + o[d][r] * o[d][r]; }
#pragma unroll
            for (int of = 16; of > 0; of >>= 1) s += __shfl_xor(s, of);
            ssq[r] = rsqrtf(s * (1.0f / 256.0f) + EPS_) * (1.0f - lambda_init); }
#pragma unroll
        for (int r = 0; r < 16; ++r) {
            const size_t row = tok0 + wid * 32 + att::crow(r, hi);
            bf16_t* op = oa + row * D_ + h * 256;
#pragma unroll
            for (int d = 0; d < 4; ++d) {
                const int col = d * 32 + r32;
                op[col] = f2bf(scr[tid * 64 + d * 16 + r] * ssq[r] * sub[col]);
                op[128 + col] = f2bf(o[d][r] * ssq[r] * sub[128 + col]);
            }
        }
    }
}

template <bool FINAL>
__device__ __forceinline__ void s5_phase(const Params& p, unsigned char* shm) {
    const int tid = otid(), wid = tid >> 6, lane = tid & 63, r32 = lane & 31, hi = lane >> 5, fr = lane & 15, fq = lane >> 4;
    const bf16_t* xb = (const bf16_t*)(p.ws + OFF_XB);
    const float* ss = (const float*)(p.ws + OFF_SSP) + (size_t)2 * 32 * T_;
    float* rsfin = (float*)(p.ws + OFF_RSFIN);
    const bf16_t* Bm = (const bf16_t*)(p.ws + OFF_S5B); const bf16_t* Cm = (const bf16_t*)(p.ws + OFF_S5C); const f32x2* AB = (const f32x2*)(p.ws + OFF_S5AB);
    f32x2* E = (f32x2*)(p.ws + OFF_BIG);
    bf16_t* gl = (bf16_t*)(p.ws + OFF_OA);
    bf16_t* Xs = (bf16_t*)shm + wid * (32 * 136);
    const float* gmix = (const float*)(p.ws + OFF_PAR) + PAR_GMIX; const float* dsk = (const float*)(p.ws + OFF_PAR) + PAR_BD;
    float* partL = (float*)(shm + 8 * 8704); float* rsL = partL + 512;
#pragma unroll 1
    for (int bc = obid(); bc < 256; bc += gridDim.x) {
      const int chunk = bc & 63, b = bc >> 6;
      const size_t t0 = (size_t)b * S_ + chunk * 64;
      __syncthreads();
      if (FINAL) { if (tid < 64) rsL[tid] = rsfin[t0 + tid]; }
      else {
          { const int row = tid & 63, part = tid >> 6; float a = 0.f;
#pragma unroll
            for (int k = 0; k < 4; ++k) a += ss[(size_t)(part * 4 + k) * T_ + t0 + row];
            partL[part * 64 + row] = a; }
          __syncthreads();
          if (tid < 64) { float tot = 0.f;
#pragma unroll
              for (int k = 0; k < 8; ++k) tot += partL[k * 64 + tid];
              const float r = rsqrtf(tot * (1.0f / D_) + EPS_); rsL[tid] = r; rsfin[t0 + tid] = r; }
      }
      __syncthreads();
#pragma unroll 1
      for (int goct = 0; goct < 16; ++goct) {
        const int g = goct * 8 + wid; const int pp = r32 + 32 * hi;
        const f32x2 ab = AB[g * 64 + pp];
        bf16x8 bfr[4];
#pragma unroll
        for (int nb = 0; nb < 4; ++nb) bfr[nb] = *(const bf16x8*)(Bm + ((size_t)g * 128 + nb * 32 + r32) * 16 + hi * 8);
        float xr = 0.f, xi = 0.f;
        bf16x8 cfr[4]; float gm4[4], ds4[4];
        if (FINAL) {
            float pr = ab.x, pi_ = ab.y;
#pragma unroll
            for (int s = 0; s < 6; ++s) { const float nr = pr * pr - pi_ * pi_, ni = 2.f * pr * pi_; pr = nr; pi_ = ni; }
            const f32x2* Ep = E + ((size_t)(b * 128 + g) * 64) * 64 + pp;
            for (int c2 = 0; c2 < chunk; c2 += 8) { f32x2 e8[8];
#pragma unroll
                for (int k = 0; k < 8; ++k) { const int ci = (c2 + k) < 63 ? (c2 + k) : 63; e8[k] = Ep[(size_t)ci * 64]; }
#pragma unroll
                for (int k = 0; k < 8; ++k) if (c2 + k < chunk) { const float nr = pr * xr - pi_ * xi + e8[k].x, ni = pr * xi + pi_ * xr + e8[k].y; xr = nr; xi = ni; } }
#pragma unroll
            for (int ks = 0; ks < 4; ++ks) cfr[ks] = *(const bf16x8*)(Cm + ((size_t)g * 16 + fr) * 128 + ks * 32 + fq * 8);
#pragma unroll
            for (int jx = 0; jx < 4; ++jx) { gm4[jx] = gmix[g * 16 + 4 * fq + jx]; ds4[jx] = dsk[g * 16 + 4 * fq + jx]; }
        }
#pragma unroll
        for (int half = 0; half < 2; ++half) {
            const size_t trow = t0 + half * 32 + r32;
            const float rs = rsL[half * 32 + r32];
            const u32x4 raw = *(const u32x4*)(xb + trow * D_ + g * 16 + hi * 8);
            u32x4 sc4;
            sc4.x = cvt_pk_bf16(bflo(raw.x) * rs, bfhi(raw.x) * rs); sc4.y = cvt_pk_bf16(bflo(raw.y) * rs, bfhi(raw.y) * rs);
            sc4.z = cvt_pk_bf16(bflo(raw.z) * rs, bfhi(raw.z) * rs); sc4.w = cvt_pk_bf16(bflo(raw.w) * rs, bfhi(raw.w) * rs);
            const bf16x8 afr = *reinterpret_cast<const bf16x8*>(&sc4);
            f32x16 c0 = __builtin_amdgcn_mfma_f32_32x32x16_bf16(afr, bfr[0], f32x16{}, 0, 0, 0);
            f32x16 c1 = __builtin_amdgcn_mfma_f32_32x32x16_bf16(afr, bfr[1], f32x16{}, 0, 0, 0);
            f32x16 c2 = __builtin_amdgcn_mfma_f32_32x32x16_bf16(afr, bfr[2], f32x16{}, 0, 0, 0);
            f32x16 c3 = __builtin_amdgcn_mfma_f32_32x32x16_bf16(afr, bfr[3], f32x16{}, 0, 0, 0);
#pragma unroll
            for (int i = 0; i < 16; ++i) {
                auto r0 = __builtin_amdgcn_permlane32_swap(__float_as_uint(c0[i]), __float_as_uint(c1[i]), false, false);
                c0[i] = __uint_as_float(r0[0]); c1[i] = __uint_as_float(r0[1]);
                auto r1 = __builtin_amdgcn_permlane32_swap(__float_as_uint(c2[i]), __float_as_uint(c3[i]), false, false);
                c2[i] = __uint_as_float(r1[0]); c3[i] = __uint_as_float(r1[1]);
            }
#pragma unroll
            for (int t = 0; t < 32; ++t) {
                const int q = t >> 3, s = t & 7, idx = 4 * q + (s & 3);
                const float bur = (s < 4) ? c0[idx] : c1[idx], bui = (s < 4) ? c2[idx] : c3[idx];
                const float nr = ab.x * xr - ab.y * xi + bur, ni = ab.x * xi + ab.y * xr + bui;
                xr = nr; xi = ni;
                if (FINAL) { Xs[t * 136 + pp] = f2bf(xr); Xs[t * 136 + 64 + pp] = f2bf(xi); }
            }
            if (FINAL) {
                asm volatile("s_waitcnt lgkmcnt(0)" ::: "memory");
#pragma unroll
                for (int m = 0; m < 2; ++m) {
                    f32x4 acc = {0.f, 0.f, 0.f, 0.f};
#pragma unroll
                    for (int ks = 0; ks < 4; ++ks) {
                        const bf16x8 xf = *(const bf16x8*)(Xs + (m * 16 + fr) * 136 + ks * 32 + fq * 8);
                        acc = __builtin_amdgcn_mfma_f32_16x16x32_bf16(cfr[ks], xf, acc, 0, 0, 0);
                    }
                    const size_t tr2 = t0 + half * 32 + m * 16 + fr;
                    const float rs2 = rsL[half * 32 + m * 16 + fr];
                    const u32x2 hx = *(const u32x2*)(xb + tr2 * D_ + g * 16 + 4 * fq);
                    const float h0 = bflo(hx.x) * rs2 * gm4[0], h1 = bfhi(hx.x) * rs2 * gm4[1], h2 = bflo(hx.y) * rs2 * gm4[2], h3 = bfhi(hx.y) * rs2 * gm4[3];
                    const float y0 = gelu_tanh(acc[0] + ds4[0] * h0), y1 = gelu_tanh(acc[1] + ds4[1] * h1), y2 = gelu_tanh(acc[2] + ds4[2] * h2), y3 = gelu_tanh(acc[3] + ds4[3] * h3);
                    u32x2 w; w.x = cvt_pk_bf16(y0, y1); w.y = cvt_pk_bf16(y2, y3);
                    *(u32x2*)(gl + tr2 * D_ + g * 16 + 4 * fq) = w;
                }
                asm volatile("s_waitcnt lgkmcnt(0)" ::: "memory");
            }
        }
        if (!FINAL) { f32x2 e; e.x = xr; e.y = xi; E[((size_t)(b * 128 + g) * 64 + chunk) * 64 + pp] = e; }
      }
    }
}

__device__ __forceinline__ void ret_phase(const Params& p, unsigned char* shm, float* rssq) {
    const int tid = otid(), wid = tid >> 6, lane = tid & 63, fr = lane & 15, fq = lane >> 4;
    const bf16_t* ret = (const bf16_t*)(p.ws + OFF_BIG);
    bf16_t* ao = (bf16_t*)(p.ws + OFF_OA);
    constexpr int QS = 264, TS = 72;
    bf16_t* Qs = (bf16_t*)shm; bf16_t* Ks = Qs + 64 * QS; bf16_t* KTs = Ks + 64 * QS; bf16_t* VTs = KTs + 256 * TS; bf16_t* Ss = VTs + 64 * TS; bf16_t* RTs = Ss + 64 * TS;
    const int c = obid(); const int xcd = c & 7, jj = c >> 3;
    const int bh = xcd * 4 + (jj >> 3), sl = jj & 7;
    const int b = bh >> 3, h = bh & 7;
    const float lg = logf(1.0f - exp2f(-5.0f - (float)h));
    const float cdec = __expf(lg * 64.0f);
    const int mi = wid >> 1, ni0 = 2 * (wid & 1);
    const float qdec = __expf(lg * (float)(16 * mi + fr + 1));
    float idec[2][4];
#pragma unroll
    for (int t = 0; t < 2; ++t)
#pragma unroll
        for (int j = 0; j < 4; ++j) { const int n = 16 * mi + fr, m = 16 * (ni0 + t) + 4 * fq + j; idec[t][j] = __expf(lg * (fabsf((float)(n - m)) - (float)(63 - m))); }
    f32x4 R[4][2];
#pragma unroll
    for (int a = 0; a < 4; ++a)
#pragma unroll
        for (int d = 0; d < 2; ++d) R[a][d] = (f32x4){0.f, 0.f, 0.f, 0.f};
    const size_t tokb = (size_t)b * S_;
    const bf16_t* qsrc = ret + (tokb + lane) * 12288 + h * 256 + wid * 32;
    const bf16_t* ksrc = qsrc + 2048;
    const bf16_t* vsrc = ret + (tokb + lane) * 12288 + 4096 + h * 512 + sl * 64 + wid * 8;
    u32x4 pq[4], pk[4], pv; u32x2 pg[2], cg2[2];
    const bf16_t* gsrc = ret + (tokb + 16 * mi + fr) * 12288 + 8192 + h * 512 + sl * 64 + 16 * ni0 + 4 * fq;
#pragma unroll
    for (int j = 0; j < 4; ++j) { pq[j] = *(const u32x4*)(qsrc + j * 8); pk[j] = *(const u32x4*)(ksrc + j * 8); }
    pv = *(const u32x4*)vsrc;
    pg[0] = *(const u32x2*)gsrc; pg[1] = *(const u32x2*)(gsrc + 16);
    for (int ch = 0; ch < 64; ++ch) {
        __syncthreads();
        cg2[0] = pg[0]; cg2[1] = pg[1];
#pragma unroll
        for (int j = 0; j < 4; ++j) {
            *(u32x4*)(Qs + lane * QS + wid * 32 + j * 8) = pq[j];
            *(u32x4*)(Ks + lane * QS + wid * 32 + j * 8) = pk[j];
            const unsigned kw[4] = {pk[j].x, pk[j].y, pk[j].z, pk[j].w};
#pragma unroll
            for (int i = 0; i < 4; ++i) {
                KTs[(wid * 32 + j * 8 + 2 * i) * TS + lane] = (bf16_t)(kw[i] & 0xffffu);
                KTs[(wid * 32 + j * 8 + 2 * i + 1) * TS + lane] = (bf16_t)(kw[i] >> 16);
            }
        }
        { const unsigned vw[4] = {pv.x, pv.y, pv.z, pv.w};
#pragma unroll
          for (int i = 0; i < 4; ++i) { VTs[(wid * 8 + 2 * i) * TS + lane] = (bf16_t)(vw[i] & 0xffffu); VTs[(wid * 8 + 2 * i + 1) * TS + lane] = (bf16_t)(vw[i] >> 16); } }
#pragma unroll
        for (int ei = 0; ei < 4; ++ei)
#pragma unroll
            for (int di = 0; di < 2; ++di) { u32x2 w; w.x = cvt_pk_bf16(R[ei][di][0], R[ei][di][1]); w.y = cvt_pk_bf16(R[ei][di][2], R[ei][di][3]);
                *(u32x2*)(RTs + (16 * ei + fr) * QS + wid * 32 + 16 * di + 4 * fq) = w; }
        if (ch + 1 < 64) {
            const size_t adv = (size_t)(ch + 1) * 64 * 12288;
#pragma unroll
            for (int j = 0; j < 4; ++j) { pq[j] = *(const u32x4*)(qsrc + adv + j * 8); pk[j] = *(const u32x4*)(ksrc + adv + j * 8); }
            pv = *(const u32x4*)(vsrc + adv);
            pg[0] = *(const u32x2*)(gsrc + adv); pg[1] = *(const u32x2*)(gsrc + adv + 16);
        }
        __syncthreads();
        {
            f32x4 sacc[2] = {{0.f, 0.f, 0.f, 0.f}, {0.f, 0.f, 0.f, 0.f}};
#pragma unroll
            for (int ks = 0; ks < 8; ++ks) {
                const bf16x8 af = *(const bf16x8*)(Qs + (16 * mi + fr) * QS + ks * 32 + fq * 8);
#pragma unroll
                for (int t = 0; t < 2; ++t) { const bf16x8 bf = *(const bf16x8*)(Ks + (16 * (ni0 + t) + fr) * QS + ks * 32 + fq * 8);
                    sacc[t] = __builtin_amdgcn_mfma_f32_16x16x32_bf16(bf, af, sacc[t], 0, 0, 0); }
            }
#pragma unroll
            for (int t = 0; t < 2; ++t) { u32x2 w; w.x = cvt_pk_bf16(sacc[t][0] * idec[t][0], sacc[t][1] * idec[t][1]); w.y = cvt_pk_bf16(sacc[t][2] * idec[t][2], sacc[t][3] * idec[t][3]);
                *(u32x2*)(Ss + (16 * mi + fr) * TS + 16 * (ni0 + t) + 4 * fq) = w; }
        }
        __syncthreads();
        {
            f32x4 oi[2] = {{0.f, 0.f, 0.f, 0.f}, {0.f, 0.f, 0.f, 0.f}}, oc[2] = {{0.f, 0.f, 0.f, 0.f}, {0.f, 0.f, 0.f, 0.f}};
#pragma unroll
            for (int ks = 0; ks < 2; ++ks) {
                const bf16x8 af = *(const bf16x8*)(Ss + (16 * mi + fr) * TS + ks * 32 + fq * 8);
#pragma unroll
                for (int t = 0; t < 2; ++t) { const bf16x8 bf = *(const bf16x8*)(VTs + (16 * (ni0 + t) + fr) * TS + ks * 32 + fq * 8);
                    oi[t] = __builtin_amdgcn_mfma_f32_16x16x32_bf16(bf, af, oi[t], 0, 0, 0); }
            }
#pragma unroll
            for (int ks = 0; ks < 8; ++ks) {
                const bf16x8 af = *(const bf16x8*)(Qs + (16 * mi + fr) * QS + ks * 32 + fq * 8);
#pragma unroll
                for (int t = 0; t < 2; ++t) { const bf16x8 bf = *(const bf16x8*)(RTs + (16 * (ni0 + t) + fr) * QS + ks * 32 + fq * 8);
                    oc[t] = __builtin_amdgcn_mfma_f32_16x16x32_bf16(bf, af, oc[t], 0, 0, 0); }
            }
            const size_t tok = tokb + (size_t)ch * 64 + 16 * mi + fr;
            float sq = 0.f;
#pragma unroll
            for (int t = 0; t < 2; ++t) {
                const int e = sl * 64 + 16 * (ni0 + t) + 4 * fq;
                const u32x2 gw = cg2[t];
                f32x4 ov = oi[t] + oc[t] * qdec;
                sq += ov[0] * ov[0] + ov[1] * ov[1] + ov[2] * ov[2] + ov[3] * ov[3];
                u32x2 w; w.x = cvt_pk_bf16(ov[0] * bflo(gw.x), ov[1] * bfhi(gw.x)); w.y = cvt_pk_bf16(ov[2] * bflo(gw.y), ov[3] * bfhi(gw.y));
                *(u32x2*)(ao + tok * 4096 + h * 512 + e) = w;
            }
            sq += __shfl_xor(sq, 16); sq += __shfl_xor(sq, 32);
            if (fq == 0) atomicAdd(rssq + (size_t)(sl * 4 + mi) * 0 + (size_t)sl * (T_ * 8) + tok * 8 + h, sq);
        }
#pragma unroll
        for (int ei = 0; ei < 4; ++ei)
#pragma unroll
            for (int di = 0; di < 2; ++di) R[ei][di] *= cdec;
#pragma unroll
        for (int ks = 0; ks < 2; ++ks) {
            bf16x8 bfk[2];
#pragma unroll
            for (int di = 0; di < 2; ++di) bfk[di] = *(const bf16x8*)(KTs + (wid * 32 + 16 * di + fr) * TS + ks * 32 + fq * 8);
#pragma unroll
            for (int ei = 0; ei < 4; ++ei) { const bf16x8 af = *(const bf16x8*)(VTs + (16 * ei + fr) * TS + ks * 32 + fq * 8);
#pragma unroll
                for (int di = 0; di < 2; ++di) R[ei][di] = __builtin_amdgcn_mfma_f32_16x16x32_bf16(bfk[di], af, R[ei][di], 0, 0, 0); }
        }
    }
}

__device__ __forceinline__ void ret2_phase(const Params& p) {
    bf16_t* ao = (bf16_t*)(p.ws + OFF_OA); const float* rssq = (const float*)(p.ws + OFF_RSQP);
    const size_t nvec = (size_t)T_ * 4096 / 8;
    for (size_t i = (size_t)obid() * 512 + otid(); i < nvec; i += (size_t)gridDim.x * 512) {
        const size_t t = i >> 9; const int hh = (int)((i & 511) >> 6);
        float rsum = 0.f;
#pragma unroll
        for (int sl = 0; sl < 8; ++sl) rsum += rssq[(size_t)sl * (T_ * 8) + t * 8 + hh];
        const float rs = rsqrtf(rsum * (1.0f / 512.0f) + EPS_);
        u32x4 w = *(u32x4*)(ao + i * 8);
        w.x = cvt_pk_bf16(bflo(w.x) * rs, bfhi(w.x) * rs); w.y = cvt_pk_bf16(bflo(w.y) * rs, bfhi(w.y) * rs);
        w.z = cvt_pk_bf16(bflo(w.z) * rs, bfhi(w.z) * rs); w.w = cvt_pk_bf16(bflo(w.w) * rs, bfhi(w.w) * rs);
        *(u32x4*)(ao + i * 8) = w;
    }
}

__device__ __forceinline__ void final_phase(const Params& p) {
    const float* ss = (const float*)(p.ws + OFF_SSP) + (size_t)8 * 32 * T_;
    const int tid = otid();
    const f32x4 g = *(const f32x4*)((const float*)(p.ws + OFF_PAR) + PAR_NFINAL + tid * 4);
    for (int row = obid(); row < T_; row += gridDim.x) {
        float ssum = ss[(size_t)(tid & 31) * T_ + row];
#pragma unroll
        for (int o = 16; o > 0; o >>= 1) ssum += __shfl_xor(ssum, o);
        const float rs = rsqrtf(ssum * (1.0f / D_) + EPS_);
        f32x4 v = *(f32x4*)(p.out + (size_t)row * D_ + tid * 4);
        v = v * rs * g;
        *(f32x4*)(p.out + (size_t)row * D_ + tid * 4) = v;
    }
}

enum { OP_PREP = 0, OP_A_IN, OP_ATTN, OP_A_OUT, OP_S5A, OP_S5C, OP_GLU, OP_C_IN, OP_RET, OP_RET2, OP_C_OUT, OP_W1, OP_W2, OP_FINAL };
#ifndef PHMASK
#define PHMASK 0xffff
#endif
#define PHON(b) ((PHMASK >> (b)) & 1)
constexpr int NPH = 23;
__device__ const unsigned char PROG_OP[NPH] = { OP_PREP,
    OP_A_IN, OP_ATTN, OP_A_OUT, OP_W1, OP_W2,
    OP_S5A, OP_S5C, OP_GLU, OP_W1, OP_W2,
    OP_C_IN, OP_RET, OP_RET2, OP_C_OUT, OP_W1, OP_W2,
    OP_A_IN, OP_ATTN, OP_A_OUT, OP_W1, OP_W2,
    OP_FINAL };
__device__ const unsigned char PROG_LAYER[NPH] = { 0, 0, 0, 0, 0, 0, 1, 1, 1, 1, 1, 2, 2, 2, 2, 2, 2, 3, 3, 3, 3, 3, 3 };

struct GemmDesc { unsigned long long a_off, b_off; int N, K, ss_idx, mode; };
#define GD_NONE {0, 0, 0, 0, 0, 0}
#define GD_A_IN(L)  {OFF_XB, OFF_WT_A_IN + (L / 3) * SZ_A_IN, 6144, 2048, 2 * L, 0}
#define GD_A_OUT(L) {OFF_OA, OFF_WT_A_OUT + (L / 3) * SZ_A_OUT, 2048, 2048, 2 * L + 1, 0}
#define GD_W1(L)    {OFF_XB, OFF_WT_W1 + L * SZ_W1, 8192, 2048, 2 * L + 1, 1}
#define GD_W2(L)    {OFF_BIG, OFF_WT_W2 + L * SZ_W1, 2048, 8192, 2 * L + 2, 0}
#define GD_GLU(L)   {OFF_OA, OFF_WT_GLU, 4096, 2048, 2 * L + 1, 1}
#define GD_C_IN(L)  {OFF_XB, OFF_WT_C_IN, 12288, 2048, 2 * L, 2}
#define GD_C_OUT(L) {OFF_OA, OFF_WT_C_OUT, 2048, 4096, 2 * L + 1, 0}
__device__ const GemmDesc GD[NPH] = { GD_NONE,
    GD_A_IN(0ull), GD_NONE, GD_A_OUT(0ull), GD_W1(0ull), GD_W2(0ull),
    GD_NONE, GD_NONE, GD_GLU(1ull), GD_W1(1ull), GD_W2(1ull),
    GD_C_IN(2ull), GD_NONE, GD_NONE, GD_C_OUT(2ull), GD_W1(2ull), GD_W2(2ull),
    GD_A_IN(3ull), GD_NONE, GD_A_OUT(3ull), GD_W1(3ull), GD_W2(3ull),
    GD_NONE };

#define XB_TMO      128
#define XB_XCNT(j)  (256  + 64 * (j))
#define XB_XSUB(j)  (1280 + 64 * (j))
#define XB_XGEN(j)  (2304 + 64 * (j))
#define XB_TOP      3328
#define XB_TOPGEN   3392
#define XCD_BAR_WORDS 3456
#define XB_SPIN_CAP (1u << 22)
__device__ __forceinline__ unsigned xb_ld(unsigned* p)              { return __hip_atomic_load(p, __ATOMIC_RELAXED, __HIP_MEMORY_SCOPE_AGENT); }
__device__ __forceinline__ unsigned xb_add(unsigned* p, unsigned v) { return __hip_atomic_fetch_add(p, v, __ATOMIC_RELAXED, __HIP_MEMORY_SCOPE_AGENT); }
__device__ __forceinline__ unsigned xb_xcc_id() { return (unsigned)__builtin_amdgcn_s_getreg((3 << 11) | 20) & 0xFu; }
#define XB_SPIN(cond, bar) do { unsigned _sp = 0; while (cond) { __builtin_amdgcn_s_sleep(1); \
    if ((++_sp & 255u) == 0u) { if (xb_ld(&(bar)[XB_TMO])) break; if (_sp > XB_SPIN_CAP) { atomicAdd(&(bar)[XB_TMO], 1u); break; } } } } while (0)
struct XcdBarrier { unsigned* bar; unsigned x; volatile LAS unsigned* st; };
__device__ __forceinline__ XcdBarrier xcd_barrier_post(unsigned* bar, volatile LAS unsigned* st) {
    XcdBarrier b; b.bar = bar; b.x = xb_xcc_id(); b.st = st;
    if (threadIdx.x == 0) (void)xb_add(&bar[XB_XCNT(b.x)], 1u);
    return b;
}
__device__ __forceinline__ void xcd_barrier_complete(unsigned* bar, unsigned x, unsigned& nloc, unsigned& nx) {
    const unsigned G = gridDim.x * gridDim.y * gridDim.z;
    unsigned sum, cnt, mine, sp = 0u;
    for (;;) {
        sum = 0u; cnt = 0u; mine = 0u;
#pragma unroll
        for (unsigned j = 0; j < 16; ++j) { const unsigned c = xb_ld(&bar[XB_XCNT(j)]); sum += c; cnt += (c > 0u) ? 1u : 0u; mine = (j == x) ? c : mine; }
        if (sum == G) break;
        __builtin_amdgcn_s_sleep(1);
        if ((++sp & 255u) == 0u) { if (xb_ld(&bar[XB_TMO])) break; if (sp > XB_SPIN_CAP) { atomicAdd(&bar[XB_TMO], 1u); break; } }
    }
    nloc = mine > 0u ? mine : 1u; nx = cnt > 0u ? cnt : 1u;
}
__device__ __forceinline__ void xcd_barrier(unsigned char* ws, unsigned char* shm) {
    XcdBarrier b; b.bar = (unsigned*)(ws + OFF_BAR); b.x = xb_xcc_id(); b.st = (volatile LAS unsigned*)((LAS unsigned char*)shm + LDS_PHASE_BYTES);
    asm volatile("s_waitcnt vmcnt(0) lgkmcnt(0)" ::: "memory");
    __syncthreads();
    if (threadIdx.x == 0) {
        unsigned* bar = b.bar;
        __builtin_amdgcn_s_waitcnt(0);
        unsigned nloc = b.st[0], nx = b.st[1];
        if (nloc == 0u) { xcd_barrier_complete(bar, b.x, nloc, nx); b.st[0] = nloc; b.st[1] = nx; }
        const unsigned old = xb_add(&bar[XB_XSUB(b.x)], 1u);
        const unsigned gen = old / nloc;
        if (old + 1u == (gen + 1u) * nloc) {
            __builtin_amdgcn_fence(__ATOMIC_RELEASE, "agent");
            asm volatile("s_waitcnt vmcnt(0)" ::: "memory");
            const unsigned og = xb_add(&bar[XB_TOP], 1u);
            const unsigned tg = og / nx;
            if (og + 1u == (tg + 1u) * nx) xb_add(&bar[XB_TOPGEN], 1u);
            else XB_SPIN(xb_ld(&bar[XB_TOPGEN]) == tg, bar);
            __builtin_amdgcn_fence(__ATOMIC_ACQUIRE, "agent");
            xb_add(&bar[XB_XGEN(b.x)], 1u);
            asm volatile("s_waitcnt vmcnt(0)" ::: "memory");
        } else {
            XB_SPIN(xb_ld(&bar[XB_XGEN(b.x)]) == gen, bar);
            __builtin_amdgcn_fence(__ATOMIC_ACQUIRE, "agent");
            asm volatile("s_waitcnt vmcnt(0)" ::: "memory");
        }
    }
    __syncthreads();
}
__device__ __forceinline__ void gsync_cg(cg::grid_group& grid) {
    asm volatile("s_waitcnt vmcnt(0) lgkmcnt(0)" ::: "memory");
    grid.sync();
    __builtin_amdgcn_fence(__ATOMIC_ACQUIRE, "agent");
    asm volatile("s_waitcnt vmcnt(0) lgkmcnt(0)" ::: "memory");
}

__global__ void __launch_bounds__(512, 2) fwd_megakernel(Params p, int ph_lo, int ph_hi) {
    extern __shared__ __attribute__((aligned(16))) unsigned char shm[];
    cg::grid_group grid = cg::this_grid();
    volatile LAS unsigned* xst = (volatile LAS unsigned*)((LAS unsigned char*)shm + LDS_PHASE_BYTES);
    if (threadIdx.x == 0) { xst[0] = 0u; xst[1] = 0u; }
    __syncthreads();
    (void)xcd_barrier_post((unsigned*)(p.ws + OFF_BAR), xst);
#ifndef DUPMASK
#define DUPMASK 0
#endif
    if (PHON(0) && ph_lo == 0) {
#pragma unroll 1
        for (int rp_ = 0; rp_ < ((DUPMASK & 1) ? 2 : 1); ++rp_) { prep_phase(p, shm); if (ph_hi > 1) gsync_cg(grid); } }
    for (int ph = (ph_lo < 1 ? 1 : ph_lo); ph < ph_hi; ++ph) {
        const int op = PROG_OP[ph], L = PROG_LAYER[ph];
        const int nrep_ = ((DUPMASK >> op) & 1) ? 2 : 1;
#pragma unroll 1
        for (int rp_ = 0; rp_ < nrep_; ++rp_) {
        unsigned char* ws = p.ws; asm volatile("" : "+s"(ws));
        float* ssb = (float*)(ws + OFF_SSP);
        if (PHON(1) && (op == OP_A_IN || op == OP_C_IN || op == OP_W1)) {
            const GemmDesc gd = GD[ph];
            pg8::Gemm g; g.A = (const bf16_t*)(ws + gd.a_off); g.Bt = (const bf16_t*)(ws + gd.b_off); g.M = T_; g.N = gd.N; g.K = gd.K;
            pg8::EpiBf E; E.rot = (const f32x2*)(ws + OFF_ROT); E.O = (bf16_t*)(ws + OFF_BIG); E.ldc = gd.N; E.mode = gd.mode; E.ss = ssb + (size_t)gd.ss_idx * 32 * T_;
            pg8::StaticOrder S; S.init(g.M, g.N, (int)gridDim.x, obid());
            {
                float* lrs = (float*)(shm + pg8::STAGE_BYTES); const int tid2 = otid();
                int nun = 0; { pg8::Unit uu; while (nun < 24 && S.next(nun, uu)) ++nun; }
                for (int j = tid2; j < nun * 256; j += 512) { pg8::Unit uu; S.next(j >> 8, uu);
                    const float* sp = E.ss + (size_t)uu.pm * 256 + (j & 255); float a = 0.f;
#pragma unroll 8
                    for (int sl = 0; sl < 32; ++sl) a += sp[(size_t)sl * T_];
                    lrs[j] = rsqrtf(a * (1.0f / D_) + EPS_); }
                __syncthreads();
            }
            pg8::gemm_phase<pg8::EpiBf, pg8::StaticOrder>((LAS unsigned char*)shm, g, S, E);
        } else if (PHON(2) && (op == OP_A_OUT || op == OP_GLU || op == OP_C_OUT || op == OP_W2)) {
            const GemmDesc gd = GD[ph];
            pg8::Gemm g; g.A = (const bf16_t*)(ws + gd.a_off); g.Bt = (const bf16_t*)(ws + gd.b_off); g.M = T_; g.N = gd.N; g.K = gd.K;
            pg8::EpiRes E; E.xout = p.out; E.xb = (bf16_t*)(ws + OFF_XB); E.glu = gd.mode; E.xin = p.out; E.ssn = ssb + (size_t)gd.ss_idx * 32 * T_;
            pg8::StaticOrder S; S.init(g.M, g.N, (int)gridDim.x, obid());
            pg8::gemm_phase<pg8::EpiRes, pg8::StaticOrder>((LAS unsigned char*)shm, g, S, E);
        } else if (PHON(3) && op == OP_ATTN) {
            const float li = 0.8f - 0.6f * expf(-0.3f * (float)L);
            attn_phase(p, L / 3, li, shm);
        } else if (PHON(4) && op == OP_S5A) {
            s5_phase<false>(p, shm);
        } else if (PHON(5) && op == OP_S5C) {
            s5_phase<true>(p, shm);
        } else if (PHON(6) && op == OP_RET) {
            ret_phase(p, shm, (float*)(ws + (rp_ == 0 ? OFF_RSQP : OFF_XB)));
        } else if (PHON(7) && op == OP_RET2) {
            ret2_phase(p);
        } else if (PHON(8) && op == OP_FINAL) {
            final_phase(p);
        }
        if (ph + 1 < ph_hi || rp_ + 1 < nrep_) xcd_barrier(ws, shm);
        }
    }
}

extern "C" void kernel_launch(void* const* d_in, const int* in_sizes, int n_in, void* d_out, int out_size, void* d_ws, size_t ws_size, hipStream_t stream) {
    static int grid_blocks = 0;
    if (grid_blocks == 0) {
        if (n_in != 21 || out_size != T_ * D_ || ws_size < WS_NEED) { fprintf(stderr, "kernel_launch: unexpected shapes n_in %d out %d ws %zu (need %zu)\n", n_in, out_size, ws_size, (size_t)WS_NEED); grid_blocks = -1; return; }
        int dev = 0, cus = 0, per_cu = 0;
        hipGetDevice(&dev);
        hipDeviceGetAttribute(&cus, hipDeviceAttributeMultiprocessorCount, dev);
        if (hipFuncSetAttribute((const void*)fwd_megakernel, hipFuncAttributeMaxDynamicSharedMemorySize, LDS_BYTES) != hipSuccess) { fprintf(stderr, "kernel_launch: hipFuncSetAttribute failed\n"); grid_blocks = -1; return; }
        hipOccupancyMaxActiveBlocksPerMultiprocessor(&per_cu, (const void*)fwd_megakernel, 512, LDS_BYTES);
        (void)hipGetLastError();
        if (per_cu < 1) per_cu = 1;
        grid_blocks = cus * 1;
        if (grid_blocks != 256) fprintf(stderr, "kernel_launch: note: %d CUs (kernel tuned for 256)\n", cus);
    }
    if (grid_blocks < 0) return;
    (void)hipMemsetAsync((unsigned char*)d_ws + OFF_BAR, 0, XCD_BAR_WORDS * 4, stream);
    Params p{};
    const float** pp = (const float**)&p;
    for (int i = 0; i < 21; ++i) pp[i] = (const float*)d_in[i];
    p.out = (float*)d_out; p.ws = (unsigned char*)d_ws;
#ifndef DBG_LO
#define DBG_LO 0
#endif
#ifndef DBG_HI
#define DBG_HI NPH
#endif
    int lo = DBG_LO, hi = DBG_HI;
    void* args[] = {&p, &lo, &hi};
    hipError_t e = hipLaunchCooperativeKernel((const void*)fwd_megakernel, dim3(grid_blocks), dim3(512), args, LDS_BYTES, stream);
    if (e != hipSuccess) fprintf(stderr, "cooperative launch failed: %s (grid %d)\n", hipGetErrorString(e), grid_blocks);
}
```

```cpp
#include <hip/hip_runtime.h>
#include <hip/hip_cooperative_groups.h>
#include <cstdio>
#include <cstdint>
namespace cg = cooperative_groups;

#define LAS __attribute__((address_space(3)))
typedef unsigned short bf16_t;
typedef short bf16x8 __attribute__((ext_vector_type(8)));
typedef short s16x4 __attribute__((ext_vector_type(4)));
typedef float f32x4 __attribute__((ext_vector_type(4)));
typedef float f32x2 __attribute__((ext_vector_type(2)));
typedef float f32x16 __attribute__((ext_vector_type(16)));
typedef unsigned u32x4 __attribute__((ext_vector_type(4)));
typedef unsigned u32x2 __attribute__((ext_vector_type(2)));

constexpr int T_ = 16384, D_ = 2048, S_ = 4096;
constexpr float EPS_ = 1e-6f;
constexpr int LDS_PHASE_BYTES = 156672;
constexpr int LDS_BYTES = LDS_PHASE_BYTES + 16;

constexpr size_t SZ_A_IN = 6144ull * 2048 * 2, SZ_A_OUT = 2048ull * 2048 * 2, SZ_W1 = 8192ull * 2048 * 2;
constexpr size_t OFF_WT_A_IN = 0;
constexpr size_t OFF_WT_A_OUT = OFF_WT_A_IN + 2 * SZ_A_IN;
constexpr size_t OFF_WT_GLU = OFF_WT_A_OUT + 2 * SZ_A_OUT;
constexpr size_t OFF_WT_C_IN = OFF_WT_GLU + 4096ull * 2048 * 2;
constexpr size_t OFF_WT_C_OUT = OFF_WT_C_IN + 12288ull * 2048 * 2;
constexpr size_t OFF_WT_W1 = OFF_WT_C_OUT + 2048ull * 4096 * 2;
constexpr size_t OFF_WT_W2 = OFF_WT_W1 + 4 * SZ_W1;
constexpr size_t OFF_XB = OFF_WT_W2 + 4 * SZ_W1;
constexpr size_t OFF_BIG = OFF_XB + (size_t)T_ * D_ * 2;
constexpr size_t OFF_OA = OFF_BIG + (size_t)T_ * 12288 * 2;
constexpr size_t OFF_SS = OFF_OA + (size_t)T_ * 4096 * 2;
constexpr size_t OFF_RSSQ = OFF_SS + 9ull * T_ * 4;
constexpr size_t OFF_ROT = OFF_RSSQ + (size_t)T_ * 8 * 4;
constexpr size_t OFF_S5B = OFF_ROT + 4096ull * 128 * 8;
constexpr size_t OFF_S5C = OFF_S5B + 128ull * 128 * 16 * 2;
constexpr size_t OFF_S5AB = OFF_S5C + 128ull * 16 * 128 * 2;
constexpr size_t WS_END = OFF_S5AB + 128ull * 64 * 8;
constexpr size_t OFF_SSP = WS_END;
constexpr size_t OFF_RSQP = OFF_SSP + 9ull * 32 * T_ * 4;
constexpr size_t OFF_RSFIN = OFF_RSQP + 8ull * T_ * 8 * 4;
constexpr size_t OFF_BAR = OFF_RSFIN + (size_t)T_ * 4;
constexpr size_t OFF_PAR = OFF_BAR + 16384;
constexpr int PAR_GMIX = 0, PAR_NFINAL = 2048, PAR_LAM = 4096, PAR_SUBLN = 5120, PAR_BD = 5632, PAR_N = 7680;
constexpr size_t WS_NEED = OFF_PAR + PAR_N * 4;
constexpr size_t OFF_ATT_SCR = OFF_BIG + (size_t)T_ * 6144 * 2;

struct Params {
    const float* x; const float* norm_mix; const float* norm_mlp; const float* norm_final;
    const float* a_w_in; const float* a_lambda; const float* a_subln; const float* a_w_out;
    const float* b_a_re; const float* b_a_im; const float* b_log_dt; const float* b_b_re; const float* b_b_im;
    const float* b_c_re; const float* b_c_im; const float* b_d; const float* b_w_glu;
    const float* c_w_in; const float* c_w_out; const float* mlp_w1; const float* mlp_w2;
    float* out; unsigned char* ws;
};

__device__ __forceinline__ unsigned cvt_pk_bf16(float lo, float hi) { unsigned r; asm volatile("v_cvt_pk_bf16_f32 %0, %1, %2" : "=v"(r) : "v"(lo), "v"(hi)); return r; }
__device__ __forceinline__ float bf2f(unsigned short b) { return __uint_as_float(((unsigned)b) << 16); }
__device__ __forceinline__ float bflo(unsigned w) { return __uint_as_float(w << 16); }
__device__ __forceinline__ float bfhi(unsigned w) { return __uint_as_float(w & 0xffff0000u); }
__device__ __forceinline__ unsigned short f2bf(float f) { return (unsigned short)(cvt_pk_bf16(f, 0.f) & 0xffffu); }

__device__ __forceinline__ int otid() { int t = threadIdx.x; asm volatile("" : "+v"(t)); return t; }
__device__ __forceinline__ int obid() { int t = blockIdx.x; asm volatile("" : "+s"(t)); return t; }

namespace pg8 {
constexpr int BM = 256, BK = 64, HALF = 128, HTB = HALF * BK * 2, STAGE_BYTES = 8 * HTB, NXCD = 8, WGM = 8;
__device__ __forceinline__ int lds_byte(int r, int c) { const int st = (r >> 4) * 2 + (c >> 5), rr = r & 15, cc = c & 31, ob = rr * 64 + cc * 2; return st * 1024 + (ob ^ (((ob >> 9) & 1) << 5)); }
__device__ __forceinline__ void stage_rc(int b, int& R, int& C) { const int st = b / 1024, sb = b % 1024, swz = sb ^ (((sb >> 9) & 1) << 5); R = (st >> 1) * 16 + swz / 64; C = (st & 1) * 32 + (swz % 64) / 2; }
struct Unit { int pm, pn; };
struct Gemm { const bf16_t* A; const bf16_t* Bt; int M, N, K; };
struct StaticOrder {
    int nM, nN, nwg, G, c;
    __device__ void init(int M, int N, int G_, int c_) { nM = M / BM; nN = N / BM; nwg = nM * nN; G = G_; c = c_; }
    __device__ bool next(int i, Unit& u) const {
        const long L = (long)i * G + c; if (L >= nwg) return false;
        int wgid = (int)L; { const int q = nwg / NXCD, r = nwg % NXCD, xcd = wgid % NXCD, off = wgid / NXCD; wgid = (xcd < r ? xcd * (q + 1) : r * (q + 1) + (xcd - r) * q) + off; }
        const int nig = WGM * nN, gid = wgid / nig, fm = gid * WGM, gsz = (nM - fm) < WGM ? (nM - fm) : WGM;
        u.pm = fm + ((wgid % nig) % gsz); u.pn = (wgid % nig) / gsz; return true;
    }
};

#define GAS __attribute__((address_space(1)))
struct EpiBf {
    bf16_t* O; int ldc; const float* ss; int mode; const f32x2* rot;
    __device__ __forceinline__ void operator()(const f32x4 (&acc)[2][2][4][2], const Unit& u, int wr, int wc, int fr, int fq, LAS unsigned char* lds, int ui) const {
        const int row0 = u.pm * BM + wr * 64 + fr, colt = u.pn * BM + wc * 32 + 8 * fq;
        int sub = 0;
        if (mode == 1) sub = 1;
        else if (mode == 2) { sub = u.pn < 8 ? 2 : (u.pn < 16 ? 3 : (u.pn < 32 ? 0 : 4)); }
        const LAS float* lrs = (const LAS float*)(lds + STAGE_BYTES) + ui * 256 + wr * 64 + fr;
        float rs8[8];
#pragma unroll
        for (int r = 0; r < 8; ++r) rs8[r] = lrs[(r >> 2) * HALF + (r & 3) * 16];
        GAS bf16_t* Og = (GAS bf16_t*)O;
        if (sub == 2 || sub == 3) {
            const GAS f32x2* rotg = (const GAS f32x2*)rot + wc * 32 + 8 * fq;
#pragma unroll
            for (int ai = 0; ai < 2; ++ai) {
                f32x2 cs[4][2][4];
#pragma unroll
                for (int m = 0; m < 4; ++m) { const int row = row0 + ai * HALF + m * 16; const GAS f32x2* rp = rotg + (size_t)(row & (S_ - 1)) * 128;
#pragma unroll
                    for (int n = 0; n < 2; ++n)
#pragma unroll
                        for (int j = 0; j < 4; ++j) cs[m][n][j] = rp[n * 4 + j]; }
#pragma unroll
                for (int m = 0; m < 4; ++m) { const int row = row0 + ai * HALF + m * 16;
                    float ksc = rs8[ai * 4 + m];
                    if (sub == 3) { const float lgam = logf(1.0f - exp2f(-5.0f - (float)(u.pn - 8))); ksc *= 0.0625f * __expf(lgam * (float)(63 - (row & 63))); }
                    GAS bf16_t* rowp = Og + (size_t)row * ldc + colt;
                    u32x4 w1, w2;
#pragma unroll
                    for (int n = 0; n < 2; ++n) {
                        const f32x4 t1 = acc[ai][0][m][n] * ksc, t2 = acc[ai][1][m][n] * ksc;
                        f32x4 o1, o2;
#pragma unroll
                        for (int j = 0; j < 4; ++j) { const f32x2 c2 = cs[m][n][j]; o1[j] = t1[j] * c2.x - t2[j] * c2.y; o2[j] = t1[j] * c2.y + t2[j] * c2.x; }
                        w1[2 * n] = cvt_pk_bf16(o1[0], o1[1]); w1[2 * n + 1] = cvt_pk_bf16(o1[2], o1[3]); w2[2 * n] = cvt_pk_bf16(o2[0], o2[1]); w2[2 * n + 1] = cvt_pk_bf16(o2[2], o2[3]);
                    }
                    *(GAS u32x4*)(rowp) = w1; *(GAS u32x4*)(rowp + HALF) = w2;
                }
            }
        } else {
#pragma unroll
            for (int ai = 0; ai < 2; ++ai)
#pragma unroll
                for (int m = 0; m < 4; ++m) {
                    const int row = row0 + ai * HALF + m * 16;
                    const float rs = rs8[ai * 4 + m];
                    GAS bf16_t* rowp = Og + (size_t)row * ldc + colt;
#pragma unroll
                    for (int bj = 0; bj < 2; ++bj) {
                        u32x4 w;
#pragma unroll
                        for (int n = 0; n < 2; ++n) {
                            f32x4 v = acc[ai][bj][m][n] * rs;
                            if (sub == 1) {
#pragma unroll
                                for (int j = 0; j < 4; ++j) { const float r = fmaxf(v[j], 0.f); v[j] = r * r; }
                            } else if (sub == 4) {
#pragma unroll
                                for (int j = 0; j < 4; ++j) v[j] = v[j] / (1.0f + __expf(-v[j]));
                            }
                            w[2 * n] = cvt_pk_bf16(v[0], v[1]); w[2 * n + 1] = cvt_pk_bf16(v[2], v[3]);
                        }
                        *(GAS u32x4*)(rowp + bj * HALF) = w;
                    }
                }
        }
    }
};
struct EpiRes {
    const float* xin; float* xout; bf16_t* xb; float* ssn; int glu;
    __device__ __forceinline__ void operator()(const f32x4 (&acc)[2][2][4][2], const Unit& u, int wr, int wc, int fr, int fq, LAS unsigned char*, int) const {
        const int row0 = u.pm * BM + wr * 64 + fr;
        const GAS float* xi = (const GAS float*)xin; GAS float* xo = (GAS float*)xout; GAS bf16_t* xbg = (GAS bf16_t*)xb; GAS float* ssg = (GAS float*)ssn;
        if (glu) {
            const size_t cb = (size_t)u.pn * HALF + wc * 32 + 8 * fq;
#pragma unroll
            for (int ai = 0; ai < 2; ++ai) {
                f32x4 xv[4][2];
#pragma unroll
                for (int m = 0; m < 4; ++m)
#pragma unroll
                    for (int n = 0; n < 2; ++n) xv[m][n] = *(const GAS f32x4*)(xi + (size_t)(row0 + ai * HALF + m * 16) * D_ + cb + n * 4);
#pragma unroll
                for (int m = 0; m < 4; ++m) {
                    const int row = row0 + ai * HALF + m * 16; const size_t off = (size_t)row * D_ + cb;
                    float sq = 0.f; u32x4 w;
#pragma unroll
                    for (int n = 0; n < 2; ++n) {
                        const f32x4 va = acc[ai][0][m][n], ga = acc[ai][1][m][n];
                        f32x4 x4 = xv[m][n];
#pragma unroll
                        for (int j = 0; j < 4; ++j) { x4[j] += va[j] / (1.0f + __expf(-ga[j])); sq += x4[j] * x4[j]; }
                        *(GAS f32x4*)(xo + off + n * 4) = x4;
                        w[2 * n] = cvt_pk_bf16(x4[0], x4[1]); w[2 * n + 1] = cvt_pk_bf16(x4[2], x4[3]);
                    }
                    *(GAS u32x4*)(xbg + off) = w;
                    sq += __shfl_xor(sq, 16); sq += __shfl_xor(sq, 32);
                    if (fq == 0) atomicAdd((float*)ssn + (size_t)((u.pn >> 1) * 4 + wc) * T_ + row, sq);
                }
            }
        } else {
            const size_t cb = (size_t)u.pn * BM + wc * 32 + 8 * fq;
#pragma unroll
            for (int ai = 0; ai < 2; ++ai) {
                f32x4 xv[4][2][2];
#pragma unroll
                for (int m = 0; m < 4; ++m)
#pragma unroll
                    for (int bj = 0; bj < 2; ++bj)
#pragma unroll
                        for (int n = 0; n < 2; ++n) xv[m][bj][n] = *(const GAS f32x4*)(xi + (size_t)(row0 + ai * HALF + m * 16) * D_ + cb + bj * HALF + n * 4);
#pragma unroll
                for (int m = 0; m < 4; ++m) {
                    const int row = row0 + ai * HALF + m * 16; const size_t off = (size_t)row * D_ + cb;
                    float sq = 0.f;
#pragma unroll
                    for (int bj = 0; bj < 2; ++bj) {
                        u32x4 w;
#pragma unroll
                        for (int n = 0; n < 2; ++n) {
                            f32x4 x4 = xv[m][bj][n] + acc[ai][bj][m][n];
#pragma unroll
                            for (int j = 0; j < 4; ++j) sq += x4[j] * x4[j];
                            *(GAS f32x4*)(xo + off + bj * HALF + n * 4) = x4;
                            w[2 * n] = cvt_pk_bf16(x4[0], x4[1]); w[2 * n + 1] = cvt_pk_bf16(x4[2], x4[3]);
                        }
                        *(GAS u32x4*)(xbg + off + bj * HALF) = w;
                    }
                    sq += __shfl_xor(sq, 16); sq += __shfl_xor(sq, 32);
                    if (fq == 0) ssg[(size_t)(u.pn * 4 + wc) * T_ + row] = sq;
                }
            }
        }
    }
};

template <class Epi, class Sched>
__device__ __forceinline__ void gemm_phase(LAS unsigned char* lds, const Gemm g, const Sched& S, const Epi& E) {
    const int tid = otid(), wid = __builtin_amdgcn_readfirstlane(tid >> 6), lane = tid & 63, wr = wid >> 2, wc = wid & 3, fr = lane & 15, fq = lane >> 4;
    const int K = g.K, nt = K / BK;
    unsigned voffA[2], voffB[2];
#pragma unroll
    for (int i = 0; i < 2; ++i) { int R, C; stage_rc(tid * 16 + i * 8192, R, C); voffA[i] = (unsigned)(R * K + C) * 2u; voffB[i] = voffA[i]; }
    const size_t kstep = (size_t)(BK * 2);
    const size_t hstep = (size_t)HALF * K * 2;
    const size_t tstep = 2 * hstep;
    const unsigned ldsw = (unsigned)wid * 1024u;
    const int aoff = lds_byte(wr * 64 + fr, fq * 8), boff = lds_byte(wc * 32 + fr, fq * 8);
#define PG8_SA(b, h) (((b) * 2 + (h)) * HTB)
#define PG8_SB(b, h) ((4 + (b) * 2 + (h)) * HTB)
#define PG8_STAGE(bufoff, gbase, voff) do { _Pragma("unroll") for (int _i = 0; _i < 2; ++_i) \
        __builtin_amdgcn_global_load_lds((const unsigned*)((const char*)(gbase) + (voff)[_i]), (LAS unsigned*)(lds + (bufoff) + ldsw + _i * 8192), 16, 0, 0); } while (0)
#define PG8_LDA(dst, b, h) do { _Pragma("unroll") for (int m = 0; m < 4; ++m) _Pragma("unroll") for (int k = 0; k < 2; ++k) dst[m][k] = *(const LAS bf16x8*)(lds + PG8_SA(b, h) + aoff + m * 2048 + k * 1024); } while (0)
#define PG8_LDB(dst, b, h) do { _Pragma("unroll") for (int n = 0; n < 2; ++n) _Pragma("unroll") for (int k = 0; k < 2; ++k) dst[n][k] = *(const LAS bf16x8*)(lds + PG8_SB(b, h) + boff + n * 2048 + k * 1024); } while (0)
#define PG8_MMA(ai, bj, At, Bt) do { __builtin_amdgcn_s_setprio(1); _Pragma("unroll") for (int m = 0; m < 4; ++m) _Pragma("unroll") for (int n = 0; n < 2; ++n) _Pragma("unroll") for (int k = 0; k < 2; ++k) \
        acc[ai][bj][m][n] = __builtin_amdgcn_mfma_f32_16x16x32_bf16(Bt[n][k], At[m][k], acc[ai][bj][m][n], 0, 0, 0); __builtin_amdgcn_s_setprio(0); } while (0)
#define PG8_WAIT_V(n) asm volatile("s_waitcnt vmcnt(" #n ")" ::: "memory")
#define PG8_WAIT_L(n) asm volatile("s_waitcnt lgkmcnt(" #n ")" ::: "memory")
#define PG8_BAR __builtin_amdgcn_s_barrier()
#define PG8_SCHED __builtin_amdgcn_sched_barrier(0)
    Unit cur, nxt; int ui = 0;
    if (!S.next(0, cur)) return;
    f32x4 acc[2][2][4][2];
#pragma unroll
    for (int a = 0; a < 2; ++a)
#pragma unroll
        for (int b = 0; b < 2; ++b)
#pragma unroll
            for (int m = 0; m < 4; ++m)
#pragma unroll
                for (int n = 0; n < 2; ++n) acc[a][b][m][n] = (f32x4){0.f, 0.f, 0.f, 0.f};
    bf16x8 At[4][2], B0[2][2], B1[2][2];
    const char* cA = (const char*)g.A + (size_t)cur.pm * tstep; const char* cB = (const char*)g.Bt + (size_t)cur.pn * tstep;
    PG8_STAGE(PG8_SB(0, 0), cB, voffB); PG8_STAGE(PG8_SA(0, 0), cA, voffA); PG8_STAGE(PG8_SB(0, 1), cB + hstep, voffB); PG8_STAGE(PG8_SA(0, 1), cA + hstep, voffA);
    if (wr == 1) PG8_BAR;
    PG8_WAIT_V(4); PG8_BAR;
    PG8_STAGE(PG8_SB(1, 0), cB + kstep, voffB); PG8_STAGE(PG8_SA(1, 0), cA + kstep, voffA); PG8_STAGE(PG8_SB(1, 1), cB + hstep + kstep, voffB);
    PG8_WAIT_V(6); PG8_BAR;
    for (;;) {
        const bool has_next = S.next(ui + 1, nxt);
        const char* nA = has_next ? (const char*)g.A + (size_t)nxt.pm * tstep : cA; const char* nB = has_next ? (const char*)g.Bt + (size_t)nxt.pn * tstep : cB;
        for (int t = 0; t < nt; t += 2) {
            const bool last = (t == nt - 2);
            const char* a1 = cA + (size_t)(t + 1) * kstep;
            const char* a2 = last ? nA : cA + (size_t)(t + 2) * kstep; const char* b2 = last ? nB : cB + (size_t)(t + 2) * kstep;
            const char* a3 = a2 + kstep; const char* b3 = b2 + kstep;
            PG8_LDB(B0, 0, 0); PG8_SCHED; PG8_LDA(At, 0, 0); PG8_STAGE(PG8_SA(1, 1), a1 + hstep, voffA);
            PG8_WAIT_L(8); PG8_BAR; PG8_WAIT_L(0); PG8_MMA(0, 0, At, B0); PG8_BAR; PG8_SCHED;
            PG8_LDB(B1, 0, 1); PG8_STAGE(PG8_SB(0, 0), b2, voffB);
            PG8_BAR; PG8_WAIT_L(0); PG8_MMA(0, 1, At, B1); PG8_BAR;
            PG8_LDA(At, 0, 1); PG8_STAGE(PG8_SA(0, 0), a2, voffA);
            PG8_BAR; PG8_WAIT_L(0); PG8_MMA(1, 0, At, B0); PG8_BAR; PG8_SCHED;
            PG8_STAGE(PG8_SB(0, 1), b2 + hstep, voffB);
            PG8_WAIT_V(6); PG8_BAR; PG8_MMA(1, 1, At, B1); PG8_BAR;
            PG8_LDB(B0, 1, 0); PG8_SCHED; PG8_LDA(At, 1, 0); PG8_STAGE(PG8_SA(0, 1), a2 + hstep, voffA);
            PG8_WAIT_L(8); PG8_BAR; PG8_WAIT_L(0); PG8_MMA(0, 0, At, B0); PG8_BAR; PG8_SCHED;
            PG8_LDB(B1, 1, 1); PG8_STAGE(PG8_SB(1, 0), b3, voffB);
            PG8_BAR; PG8_WAIT_L(0); PG8_MMA(0, 1, At, B1); PG8_BAR;
            PG8_LDA(At, 1, 1); PG8_STAGE(PG8_SA(1, 0), a3, voffA);
            PG8_BAR; PG8_WAIT_L(0); PG8_MMA(1, 0, At, B0); PG8_BAR; PG8_SCHED;
            PG8_STAGE(PG8_SB(1, 1), b3 + hstep, voffB);
            PG8_WAIT_V(6); PG8_BAR; PG8_MMA(1, 1, At, B1); PG8_BAR;
        }
        E(acc, cur, wr, wc, fr, fq, lds, ui);
        if (!has_next) break;
#pragma unroll
        for (int a = 0; a < 2; ++a)
#pragma unroll
            for (int b = 0; b < 2; ++b)
#pragma unroll
                for (int m = 0; m < 4; ++m)
#pragma unroll
                    for (int n = 0; n < 2; ++n) acc[a][b][m][n] = (f32x4){0.f, 0.f, 0.f, 0.f};
        cur = nxt; cA = nA; cB = nB; ++ui;
    }
    PG8_WAIT_V(0);
    if (wr == 0) PG8_BAR;
    PG8_BAR;
#undef PG8_SA
#undef PG8_SB
#undef PG8_STAGE
#undef PG8_LDA
#undef PG8_LDB
#undef PG8_MMA
#undef PG8_WAIT_V
#undef PG8_WAIT_L
#undef PG8_BAR
#undef PG8_SCHED
}
}

namespace att {
constexpr int D = 128, KVBLK = 64, LDK = 6144;
constexpr float SCALE = 0.088388347648318440f;
constexpr float THR = 8.f;
constexpr size_t SHM_V = KVBLK * D * 2, SHM_K = KVBLK * D * 2;
#define KSWZ(row, colB) ((row) * 256 + ((colB) ^ (((row) & 7) << 4)))
#define SBAR() __builtin_amdgcn_sched_barrier(0)
__device__ __forceinline__ int crow(int r, int hi) { return (r & 3) + 8 * (r >> 2) + 4 * hi; }
__device__ __forceinline__ void partialSM(f32x16& p0, f32x16& p1, float& m_reg, float& mn, float& alpha, bool msk) {
    constexpr float C = SCALE * 1.4426950408889634f;
    if (msk) {
#pragma unroll
        for (int r = 0; r < 16; ++r) { p0[r] = -1e30f; p1[r] = -1e30f; }
    }
    float pmax = p0[0];
#pragma unroll
    for (int r = 1; r < 16; ++r) pmax = fmaxf(pmax, p0[r]);
#pragma unroll
    for (int r = 0; r < 16; ++r) pmax = fmaxf(pmax, p1[r]);
    { auto rr = __builtin_amdgcn_permlane32_swap(__float_as_uint(pmax), __float_as_uint(pmax), false, false);
      pmax = fmaxf(__uint_as_float(rr[0]), __uint_as_float(rr[1])); }
    if (__builtin_expect(__all(pmax - m_reg <= THR / SCALE), 1)) { mn = m_reg; alpha = 1.f; }
    else { mn = fmaxf(m_reg, pmax); alpha = __builtin_amdgcn_exp2f((m_reg - mn) * C); m_reg = mn; }
    float mnC = -mn * C;
#pragma unroll
    for (int r = 0; r < 16; ++r) p0[r] = fmaf(p0[r], C, mnC);
#pragma unroll
    for (int r = 0; r < 16; ++r) p1[r] = fmaf(p1[r], C, mnC);
#pragma unroll
    for (int r = 0; r < 16; ++r) p0[r] = __builtin_amdgcn_exp2f(p0[r]);
}
__device__ __forceinline__ void finishSM(f32x16& p0, f32x16& p1, float alpha, float& l_reg, bf16x8& pa0, bf16x8& pa1, bf16x8& pa2, bf16x8& pa3) {
#pragma unroll
    for (int r = 0; r < 16; ++r) p1[r] = __builtin_amdgcn_exp2f(p1[r]);
    float ps = 0;
#pragma unroll
    for (int r = 0; r < 16; ++r) ps += p0[r];
#pragma unroll
    for (int r = 0; r < 16; ++r) ps += p1[r];
    { auto rr = __builtin_amdgcn_permlane32_swap(__float_as_uint(ps), __float_as_uint(ps), false, false);
      ps = __uint_as_float(rr[0]) + __uint_as_float(rr[1]); }
    l_reg = l_reg * alpha + ps;
#define PK4(P, BASE, OUT) do { unsigned a0 = cvt_pk_bf16(P[BASE + 0], P[BASE + 1]), a1 = cvt_pk_bf16(P[BASE + 2], P[BASE + 3]);   \
    unsigned b0 = cvt_pk_bf16(P[BASE + 4], P[BASE + 5]), b1 = cvt_pk_bf16(P[BASE + 6], P[BASE + 7]);                              \
    auto r0 = __builtin_amdgcn_permlane32_swap(a0, b0, false, false); auto r1 = __builtin_amdgcn_permlane32_swap(a1, b1, false, false); \
    u32x4 w = {r0[0], r1[0], r0[1], r1[1]}; OUT = *reinterpret_cast<bf16x8*>(&w); } while (0)
    PK4(p0, 0, pa0); PK4(p0, 8, pa1); PK4(p1, 0, pa2); PK4(p1, 8, pa3);
#undef PK4
}
__device__ __forceinline__ void qkt(f32x16& p0, f32x16& p1, const char* Ks, const bf16x8* qr, int r32, int hi) {
    p0 = f32x16{}; p1 = f32x16{};
#pragma unroll
    for (int d0 = 0; d0 < 8; ++d0) { int cb = (d0 * 16 + hi * 8) * 2;
        bf16x8 b0 = *reinterpret_cast<const bf16x8*>(Ks + KSWZ(r32, cb));
        bf16x8 b1 = *reinterpret_cast<const bf16x8*>(Ks + KSWZ(32 + r32, cb));
        p0 = __builtin_amdgcn_mfma_f32_32x32x16_bf16(b0, qr[d0], p0, 0, 0, 0);
        p1 = __builtin_amdgcn_mfma_f32_32x32x16_bf16(b1, qr[d0], p1, 0, 0, 0); }
}
__device__ __forceinline__ int v_st(int k, int c) { const int kk = (k & ~0xC) | ((k & 4) << 1) | ((k & 8) >> 1); return ((kk >> 3) * 4 + (c >> 5)) * 512 + ((kk & 7) * 32 + (c & 31)) * 2; }
__device__ __forceinline__ int v_rd_base(int lane) { return ((lane & 3) << 3) | (((lane >> 2) & 3) << 6) | (((lane >> 4) & 1) << 5) | (((lane >> 5) & 1) << 8); }
constexpr int v_rd_off(int d0, int ks, int half) { return d0 * 512 + ks * 4096 + half * 2048; }
template <int OFF> __device__ __forceinline__ s16x4 tr_read(int vb) {
    s16x4 r; asm volatile("ds_read_b64_tr_b16 %0, %1 offset:%2" : "=&v"(r) : "v"(vb), "i"(OFF) : "memory"); return r;
}
template <int D0> __device__ __forceinline__ void pv_one(f32x16& od, int vb, bf16x8 pa0, bf16x8 pa1, bf16x8 pa2, bf16x8 pa3) {
    const s16x4 l0 = tr_read<v_rd_off(D0, 0, 0)>(vb), h0 = tr_read<v_rd_off(D0, 0, 1)>(vb), l1 = tr_read<v_rd_off(D0, 1, 0)>(vb), h1 = tr_read<v_rd_off(D0, 1, 1)>(vb);
    const s16x4 l2 = tr_read<v_rd_off(D0, 2, 0)>(vb), h2 = tr_read<v_rd_off(D0, 2, 1)>(vb), l3 = tr_read<v_rd_off(D0, 3, 0)>(vb), h3 = tr_read<v_rd_off(D0, 3, 1)>(vb);
    asm volatile("s_waitcnt lgkmcnt(0)" ::: "memory"); SBAR();
#define PK(L, H) (bf16x8){L[0], L[1], L[2], L[3], H[0], H[1], H[2], H[3]}
    od = __builtin_amdgcn_mfma_f32_32x32x16_bf16(pa0, PK(l0, h0), od, 0, 0, 0);
    od = __builtin_amdgcn_mfma_f32_32x32x16_bf16(pa1, PK(l1, h1), od, 0, 0, 0);
    od = __builtin_amdgcn_mfma_f32_32x32x16_bf16(pa2, PK(l2, h2), od, 0, 0, 0);
    od = __builtin_amdgcn_mfma_f32_32x32x16_bf16(pa3, PK(l3, h3), od, 0, 0, 0);
#undef PK
}
__device__ __forceinline__ void pv_d0(f32x16* o, int vb, bf16x8 pa0, bf16x8 pa1, bf16x8 pa2, bf16x8 pa3) {
    pv_one<0>(o[0], vb, pa0, pa1, pa2, pa3); pv_one<1>(o[1], vb, pa0, pa1, pa2, pa3); pv_one<2>(o[2], vb, pa0, pa1, pa2, pa3); pv_one<3>(o[3], vb, pa0, pa1, pa2, pa3);
}
__device__ __forceinline__ void attn_body(const bf16_t* __restrict__ Qb, const bf16_t* __restrict__ Kh, const bf16_t* __restrict__ Vh, int NT, int ntw, char* lds, f32x16 (&o)[4]) {
    const int tid = otid(), wid = __builtin_amdgcn_readfirstlane(tid >> 6), lane = tid & 63, r32 = lane & 31, hi = lane >> 5;
    char* V_lds = lds; char* K_lds = lds + 2 * SHM_V;
    float* wsf = (float*)(lds + 2 * SHM_V + 2 * SHM_K) + wid * 64; float* li_l = wsf; float* al_l = wsf + 32;
    float m_reg = -1e30f, l_reg = 0; bf16x8 qr[8];
#pragma unroll
    for (int d = 0; d < 4; ++d) o[d] = f32x16{};
    const bf16_t* Qw = Qb + (long)(wid * 32 + r32) * LDK + hi * 8;
#pragma unroll
    for (int d0 = 0; d0 < 8; ++d0) qr[d0] = *reinterpret_cast<const bf16x8*>(Qw + d0 * 16);
    const int sr = tid >> 4, sc = (tid & 15) * 8, vst0 = v_st(sr, sc), vst1 = v_st(32 + sr, sc);
    const int vb0 = (int)(uintptr_t)V_lds + v_rd_base(lane);
    struct { bf16x8 vs0, vs1, ks0, ks1; } sr_[2];
#define SLOAD(i, k0) do { sr_[i].vs0 = *reinterpret_cast<const bf16x8*>(&Vh[(long)((k0) + sr) * LDK + sc]); sr_[i].vs1 = *reinterpret_cast<const bf16x8*>(&Vh[(long)((k0) + 32 + sr) * LDK + sc]); \
    sr_[i].ks0 = *reinterpret_cast<const bf16x8*>(&Kh[(long)((k0) + sr) * LDK + sc]); sr_[i].ks1 = *reinterpret_cast<const bf16x8*>(&Kh[(long)((k0) + 32 + sr) * LDK + sc]); } while (0)
#define SWRITE(b, i) do { *(bf16x8*)(V_lds + (b) * SHM_V + vst0) = sr_[i].vs0;          \
    *(bf16x8*)(V_lds + (b) * SHM_V + vst1) = sr_[i].vs1; int kc = sc * 2;               \
    *(bf16x8*)(K_lds + (b) * SHM_K + KSWZ(sr, kc)) = sr_[i].ks0;                       \
    *(bf16x8*)(K_lds + (b) * SHM_K + KSWZ(32 + sr, kc)) = sr_[i].ks1; } while (0)
#define SWAIT() asm volatile("s_waitcnt vmcnt(4)" ::: "memory")
#define RESC(a) do { if (__any((a) < 1.f)) { if (hi == 0) al_l[r32] = (a); asm volatile("s_waitcnt lgkmcnt(0)" ::: "memory"); \
    _Pragma("unroll") for (int d = 0; d < 4; ++d) _Pragma("unroll") for (int r = 0; r < 16; ++r) o[d][r] *= al_l[crow(r, hi)]; } } while (0)
    f32x16 pA0, pA1, pB0, pB1; float mnA, mnB, alA, alB; bf16x8 pa0, pa1, pa2, pa3;
    constexpr int SE = 0, SO = 1;
    __syncthreads();
    SLOAD(SE, 0); asm volatile("s_waitcnt vmcnt(0)" ::: "memory"); SWRITE(0, SE); __syncthreads();
    qkt(pA0, pA1, K_lds, qr, r32, hi); partialSM(pA0, pA1, m_reg, mnA, alA, false);
    SLOAD(SO, KVBLK); if (2 < NT) SLOAD(SE, 2 * KVBLK);
    SWAIT(); SWRITE(1, SO); __syncthreads();
    for (int j = 1; j + 1 < NT; j += 2) {
        SBAR(); qkt(pB0, pB1, K_lds + SHM_K, qr, r32, hi);
        finishSM(pA0, pA1, alA, l_reg, pa0, pa1, pa2, pa3); SBAR();
        SLOAD(SO, (j + 2) * KVBLK); SBAR();
        pv_d0(o, vb0, pa0, pa1, pa2, pa3); partialSM(pB0, pB1, m_reg, mnB, alB, j >= ntw);
        __syncthreads(); SWAIT(); SWRITE(0, SE);
        RESC(alB); __syncthreads();
        SBAR(); qkt(pA0, pA1, K_lds, qr, r32, hi);
        finishSM(pB0, pB1, alB, l_reg, pa0, pa1, pa2, pa3); SBAR();
        if (j + 3 < NT) SLOAD(SE, (j + 3) * KVBLK); SBAR();
        pv_d0(o, vb0 + (int)SHM_V, pa0, pa1, pa2, pa3); partialSM(pA0, pA1, m_reg, mnA, alA, (j + 1) >= ntw);
        __syncthreads(); SWAIT(); SWRITE(1, SO);
        RESC(alA); __syncthreads();
    }
    SBAR(); qkt(pB0, pB1, K_lds + SHM_K, qr, r32, hi);
    finishSM(pA0, pA1, alA, l_reg, pa0, pa1, pa2, pa3); SBAR();
    pv_d0(o, vb0, pa0, pa1, pa2, pa3); partialSM(pB0, pB1, m_reg, mnB, alB, (NT - 1) >= ntw);
    __syncthreads(); RESC(alB);
    finishSM(pB0, pB1, alB, l_reg, pa0, pa1, pa2, pa3); SBAR();
    pv_d0(o, vb0 + (int)SHM_V, pa0, pa1, pa2, pa3);
    if (hi == 0) li_l[r32] = l_reg; asm volatile("s_waitcnt lgkmcnt(0)" ::: "memory");
#pragma unroll
    for (int r = 0; r < 16; ++r) { const float rl = __builtin_amdgcn_rcpf(li_l[crow(r, hi)]);
#pragma unroll
        for (int d = 0; d < 4; ++d) o[d][r] *= rl; }
#undef SLOAD
#undef SWRITE
#undef SWAIT
#undef RESC
}
}

__device__ __forceinline__ void sincos_red(double ang, float& s, float& c) {
    const double k = rint(ang * 0.15915494309189535);
    const float r = (float)(ang - k * 6.283185307179586);
    s = __sinf(r); c = __cosf(r);
}
__device__ __forceinline__ float gelu_tanh(float y) {
    const float z = 0.7978845608028654f * (y + 0.044715f * y * y * y);
    const float th = 1.0f - 2.0f / (1.0f + __expf(2.0f * z));
    return 0.5f * y * (1.0f + th);
}

struct ConvJob { const float* W; bf16_t* Wt; const float* gain; int K, N, glu, tile; };
struct ConvRegs { f32x4 va[4], vb[4]; float ga[4], gb[4]; };
__device__ __forceinline__ ConvJob conv_decode(const Params& p, unsigned char* ws, int t) {
    ConvJob j; j.glu = 0; j.gain = nullptr;
    if (t < 1536) { const int q = t / 768; j.tile = t - q * 768; j.W = p.a_w_in + (size_t)q * 2048 * 6144; j.Wt = (bf16_t*)(ws + OFF_WT_A_IN + q * SZ_A_IN); j.K = 2048; j.N = 6144; j.gain = p.norm_mix + (size_t)(3 * q) * D_; }
    else if (t < 2048) { const int u = t - 1536; const int q = u / 256; j.tile = u - q * 256; j.W = p.a_w_out + (size_t)q * 2048 * 2048; j.Wt = (bf16_t*)(ws + OFF_WT_A_OUT + q * SZ_A_OUT); j.K = 2048; j.N = 2048; }
    else if (t < 2560) { j.tile = t - 2048; j.W = p.b_w_glu; j.Wt = (bf16_t*)(ws + OFF_WT_GLU); j.K = 2048; j.N = 4096; j.glu = 1; }
    else if (t < 4096) { j.tile = t - 2560; j.W = p.c_w_in; j.Wt = (bf16_t*)(ws + OFF_WT_C_IN); j.K = 2048; j.N = 12288; j.gain = p.norm_mix + 2 * D_; }
    else if (t < 4608) { j.tile = t - 4096; j.W = p.c_w_out; j.Wt = (bf16_t*)(ws + OFF_WT_C_OUT); j.K = 4096; j.N = 2048; }
    else if (t < 8704) { const int u = t - 4608; const int i = u / 1024; j.tile = u - i * 1024; j.W = p.mlp_w1 + (size_t)i * 2048 * 8192; j.Wt = (bf16_t*)(ws + OFF_WT_W1 + i * SZ_W1); j.K = 2048; j.N = 8192; j.gain = p.norm_mlp + (size_t)i * D_; }
    else { const int u = t - 8704; const int i = u / 1024; j.tile = u - i * 1024; j.W = p.mlp_w2 + (size_t)i * 8192 * 2048; j.Wt = (bf16_t*)(ws + OFF_WT_W2 + i * SZ_W1); j.K = 8192; j.N = 2048; }
    return j;
}
__device__ __forceinline__ void conv_load(const ConvJob& j, ConvRegs& r, int tid) {
    const int ntn = j.N >> 7; const int tk = j.tile / ntn, tn = j.tile - tk * ntn; const int k0 = tk << 7, n0 = tn << 7;
    const int kp = tid >> 5, nl = (tid & 31) << 2;
#pragma unroll
    for (int i = 0; i < 4; ++i) { const int k = 2 * (kp + 16 * i);
        r.va[i] = *(const f32x4*)(j.W + (size_t)(k0 + k) * j.N + n0 + nl); r.vb[i] = *(const f32x4*)(j.W + (size_t)(k0 + k + 1) * j.N + n0 + nl);
        r.ga[i] = j.gain ? j.gain[k0 + k] : 1.f; r.gb[i] = j.gain ? j.gain[k0 + k + 1] : 1.f; }
}
__device__ __forceinline__ void conv_store(const ConvJob& j, const ConvRegs& r, int tid, unsigned* ldsw) {
    const int ntn = j.N >> 7; const int tk = j.tile / ntn, tn = j.tile - tk * ntn; const int k0 = tk << 7, n0 = tn << 7;
    const int kp = tid >> 5, nl = (tid & 31) << 2;
    __syncthreads();
#pragma unroll
    for (int i = 0; i < 4; ++i) { const int kpair = kp + 16 * i;
#pragma unroll
        for (int jj = 0; jj < 4; ++jj) ldsw[(nl + jj) * 65 + kpair] = cvt_pk_bf16(r.va[i][jj] * r.ga[i], r.vb[i][jj] * r.gb[i]); }
    __syncthreads();
    int nbase = n0;
    if (j.glu) { const int bj = n0 >> 11, pn = (n0 & 2047) >> 7; nbase = 256 * pn + 128 * bj; }
#pragma unroll
    for (int i = 0; i < 4; ++i) { const int n = (tid >> 4) + 32 * i, k8 = tid & 15;
        u32x4 w; w.x = ldsw[n * 65 + k8 * 4 + 0]; w.y = ldsw[n * 65 + k8 * 4 + 1]; w.z = ldsw[n * 65 + k8 * 4 + 2]; w.w = ldsw[n * 65 + k8 * 4 + 3];
        const int c5 = n & 31, np = (n & ~31) | (16 * ((c5 >> 2) & 1) + 4 * (c5 >> 3) + (c5 & 3));
        *(u32x4*)(j.Wt + (size_t)(nbase + np) * j.K + k0 + k8 * 8) = w; }
}

__device__ __forceinline__ void prep_phase(const Params& p, unsigned char* shm) {
    const int tid = otid(), bid = obid(), G = gridDim.x;
    unsigned char* ws = p.ws;
    {
        ConvJob jc = conv_decode(p, ws, bid); ConvRegs rc; conv_load(jc, rc, tid);
#pragma unroll 1
        for (int t = bid; t < 12800; t += G) {
            ConvJob jn = jc; ConvRegs rn = rc;
            if (t + G < 12800) { jn = conv_decode(p, ws, t + G); conv_load(jn, rn, tid); }
            conv_store(jc, rc, tid, (unsigned*)shm);
            jc = jn; rc = rn;
        }
    }
    {
        float* ss = (float*)(ws + OFF_SSP); bf16_t* xb = (bf16_t*)(ws + OFF_XB);
        const int wid = tid >> 6, lane = tid & 63;
        for (int row = bid * 8 + wid; row < T_; row += G * 8) {
            const float* xr = p.x + (size_t)row * D_; float sq = 0.f;
#pragma unroll
            for (int i = 0; i < 8; ++i) { const f32x4 v = *(const f32x4*)(xr + (i * 64 + lane) * 4);
                sq += v[0] * v[0] + v[1] * v[1] + v[2] * v[2] + v[3] * v[3];
                *(f32x4*)(p.out + (size_t)row * D_ + (i * 64 + lane) * 4) = v;
                u32x2 w; w.x = cvt_pk_bf16(v[0], v[1]); w.y = cvt_pk_bf16(v[2], v[3]);
                *(u32x2*)(xb + (size_t)row * D_ + (i * 64 + lane) * 4) = w; }
#pragma unroll
            for (int o = 32; o > 0; o >>= 1) sq += __shfl_xor(sq, o);
            if (lane < 32) ss[(size_t)lane * T_ + row] = (lane == 0) ? sq : 0.f;
        }
        for (int i = bid * 512 + tid; i < 32 * T_; i += G * 512) ss[(size_t)3 * 32 * T_ + i] = 0.f;
        float* rssq = (float*)(ws + OFF_RSQP);
        for (int i = bid * 512 + tid; i < 64 * T_; i += G * 512) rssq[i] = 0.f;
    }
    {
        float* par = (float*)(ws + OFF_PAR);
        for (int i = bid * 512 + tid; i < PAR_N; i += G * 512) {
            float v;
            if (i < PAR_NFINAL) v = p.norm_mix[D_ + i];
            else if (i < PAR_LAM) v = p.norm_final[i - PAR_NFINAL];
            else if (i < PAR_SUBLN) v = p.a_lambda[i - PAR_LAM];
            else if (i < PAR_BD) v = p.a_subln[i - PAR_SUBLN];
            else v = p.b_d[i - PAR_BD];
            par[i] = v;
        }
    }
    {
        f32x2* rot = (f32x2*)(ws + OFF_ROT);
        for (int i = bid * 512 + tid; i < 4096 * 128; i += G * 512) {
            const int pos = i >> 7, j = i & 127;
            const double inv = exp(-9.210340371976184 * ((double)j / 127.0));
            float s, c; sincos_red((double)pos * inv, s, c);
            f32x2 v; v.x = c; v.y = s; rot[i] = v;
        }
    }
    {
        bf16_t* Bm = (bf16_t*)(ws + OFF_S5B); bf16_t* Cm = (bf16_t*)(ws + OFF_S5C); f32x2* AB = (f32x2*)(ws + OFF_S5AB);
        const float* gmix = p.norm_mix + 1 * D_;
        for (int i = bid * 512 + tid; i < 128 * 64; i += G * 512) {
            const int g = i >> 6, pp = i & 63;
            const float lre = p.b_a_re[i], lim = p.b_a_im[i];
            const float dt = __expf(p.b_log_dt[g]);
            const float mag = __expf(lre * dt);
            float sn, cs; sincos_red((double)lim * (double)dt, sn, cs);
            const float abr = mag * cs, abi = mag * sn;
            const float den = lre * lre + lim * lim;
            const float nr = abr - 1.0f, ni = abi;
            const float cr_ = (nr * lre + ni * lim) / den, ci_ = (ni * lre - nr * lim) / den;
            f32x2 ab; ab.x = abr; ab.y = abi; AB[i] = ab;
#pragma unroll
            for (int c = 0; c < 16; ++c) {
                const float br = p.b_b_re[(size_t)i * 16 + c], bi = p.b_b_im[(size_t)i * 16 + c];
                const float gm = gmix[g * 16 + c];
                Bm[((size_t)g * 128 + pp) * 16 + c] = f2bf((cr_ * br - ci_ * bi) * gm);
                Bm[((size_t)g * 128 + 64 + pp) * 16 + c] = f2bf((cr_ * bi + ci_ * br) * gm);
                Cm[((size_t)g * 16 + c) * 128 + pp] = f2bf(p.b_c_re[((size_t)g * 16 + c) * 64 + pp]);
                Cm[((size_t)g * 16 + c) * 128 + 64 + pp] = f2bf(-p.b_c_im[((size_t)g * 16 + c) * 64 + pp]);
            }
        }
    }
}

__device__ __forceinline__ void attn_phase(const Params& p, int j, float lambda_init, unsigned char* shm) {
    const int tid = otid(), wid = __builtin_amdgcn_readfirstlane(tid >> 6), lane = tid & 63, r32 = lane & 31, hi = lane >> 5;
    const bf16_t* qkv = (const bf16_t*)(p.ws + OFF_BIG);
    bf16_t* oa = (bf16_t*)(p.ws + OFF_OA);
    float* scr = (float*)(p.ws + OFF_ATT_SCR) + (size_t)obid() * 2 * 32768;
    float lam;
    { const float* lp = (const float*)(p.ws + OFF_PAR) + PAR_LAM + (size_t)j * 512;
      float a = lp[lane] * lp[128 + lane] + lp[64 + lane] * lp[192 + lane];
      float b = lp[256 + lane] * lp[384 + lane] + lp[320 + lane] * lp[448 + lane];
#pragma unroll
      for (int o = 32; o > 0; o >>= 1) { a += __shfl_xor(a, o); b += __shfl_xor(b, o); }
      lam = __expf(a) - __expf(b) + lambda_init; lam = __uint_as_float(__builtin_amdgcn_readfirstlane(__float_as_uint(lam))); }
    const float* sub = (const float*)(p.ws + OFF_PAR) + PAR_SUBLN + (size_t)j * 256;
    const int c = obid(); const int xcd = c & 7, jj = c >> 3;
    const int bh = xcd * 4 + (jj >> 3), pi = jj & 7;
    const int b = bh >> 3, h = bh & 7;
#pragma unroll 1
    for (int it = 0; it < 2; ++it) {
        const int qb = it == 0 ? (15 - pi) : pi;
        const int NT = 4 * qb + 4, ntw = 4 * qb + (wid >> 1) + 1;
        const size_t tok0 = (size_t)b * S_ + (size_t)qb * 256;
        f32x16 o[4];
#pragma unroll 1
        for (int ps = 0; ps < 4; ++ps) {
            const int e = ps >> 1, t = ps & 1;
            float* sc = scr + e * 32768;
            att::attn_body(qkv + tok0 * 6144 + h * 256 + t * 128, qkv + (size_t)b * S_ * 6144 + 2048 + h * 256 + t * 128,
                           qkv + (size_t)b * S_ * 6144 + 4096 + h * 256 + e * 128, NT, ntw, (char*)shm, o);
            if (t == 0) {
#pragma unroll
                for (int d = 0; d < 4; ++d)
#pragma unroll
                    for (int r = 0; r < 16; ++r) sc[tid * 64 + d * 16 + r] = o[d][r];
            } else {
#pragma unroll
                for (int d = 0; d < 4; ++d)
#pragma unroll
                    for (int r = 0; r < 16; ++r) { const float cv = sc[tid * 64 + d * 16 + r] - lam * o[d][r]; o[d][r] = cv; if (e == 0) sc[tid * 64 + d * 16 + r] = cv; }
            }
        }
        float ssq[16];
#pragma unroll
        for (int r = 0; r < 16; ++r) { float s = 0.f;
#pragma unroll
            for (int d = 0; d < 4; ++d) { const float c0 = scr[tid * 64 + d * 16 + r]; s += c0 * c0 + o[d][r] * o[d][r]; }
#pragma unroll
            for (int of = 16; of > 0; of >>= 1) s += __shfl_xor(s, of);
            ssq[r] = rsqrtf(s * (1.0f / 256.0f) + EPS_) * (1.0f - lambda_init); }
#pragma unroll
        for (int r = 0; r < 16; ++r) {
            const size_t row = tok0 + wid * 32 + att::crow(r, hi);
            bf16_t* op = oa + row * D_ + h * 256;
#pragma unroll
            for (int d = 0; d < 4; ++d) {
                const int col = d * 32 + r32;
                op[col] = f2bf(scr[tid * 64 + d * 16 + r] * ssq[r] * sub[col]);
                op[128 + col] = f2bf(o[d][r] * ssq[r] * sub[128 + col]);
            }
        }
    }
}

template <bool FINAL>
__device__ __forceinline__ void s5_phase(const Params& p, unsigned char* shm) {
    const int tid = otid(), wid = tid >> 6, lane = tid & 63, r32 = lane & 31, hi = lane >> 5, fr = lane & 15, fq = lane >> 4;
    const bf16_t* xb = (const bf16_t*)(p.ws + OFF_XB);
    const float* ss = (const float*)(p.ws + OFF_SSP) + (size_t)2 * 32 * T_;
    float* rsfin = (float*)(p.ws + OFF_RSFIN);
    const bf16_t* Bm = (const bf16_t*)(p.ws + OFF_S5B); const bf16_t* Cm = (const bf16_t*)(p.ws + OFF_S5C); const f32x2* AB = (const f32x2*)(p.ws + OFF_S5AB);
    f32x2* E = (f32x2*)(p.ws + OFF_BIG);
    bf16_t* gl = (bf16_t*)(p.ws + OFF_OA);
    bf16_t* Xs = (bf16_t*)shm + wid * (32 * 136);
    const float* gmix = (const float*)(p.ws + OFF_PAR) + PAR_GMIX; const float* dsk = (const float*)(p.ws + OFF_PAR) + PAR_BD;
    float* partL = (float*)(shm + 8 * 8704); float* rsL = partL + 512;
#pragma unroll 1
    for (int bc = obid(); bc < 256; bc += gridDim.x) {
      const int chunk = bc & 63, b = bc >> 6;
      const size_t t0 = (size_t)b * S_ + chunk * 64;
      __syncthreads();
      if (FINAL) { if (tid < 64) rsL[tid] = rsfin[t0 + tid]; }
      else {
          { const int row = tid & 63, part = tid >> 6; float a = 0.f;
#pragma unroll
            for (int k = 0; k < 4; ++k) a += ss[(size_t)(part * 4 + k) * T_ + t0 + row];
            partL[part * 64 + row] = a; }
          __syncthreads();
          if (tid < 64) { float tot = 0.f;
#pragma unroll
              for (int k = 0; k < 8; ++k) tot += partL[k * 64 + tid];
              const float r = rsqrtf(tot * (1.0f / D_) + EPS_); rsL[tid] = r; rsfin[t0 + tid] = r; }
      }
      __syncthreads();
#pragma unroll 1
      for (int goct = 0; goct < 16; ++goct) {
        const int g = goct * 8 + wid; const int pp = r32 + 32 * hi;
        const f32x2 ab = AB[g * 64 + pp];
        bf16x8 bfr[4];
#pragma unroll
        for (int nb = 0; nb < 4; ++nb) bfr[nb] = *(const bf16x8*)(Bm + ((size_t)g * 128 + nb * 32 + r32) * 16 + hi * 8);
        float xr = 0.f, xi = 0.f;
        bf16x8 cfr[4]; float gm4[4], ds4[4];
        if (FINAL) {
            float pr = ab.x, pi_ = ab.y;
#pragma unroll
            for (int s = 0; s < 6; ++s) { const float nr = pr * pr - pi_ * pi_, ni = 2.f * pr * pi_; pr = nr; pi_ = ni; }
            const f32x2* Ep = E + ((size_t)(b * 128 + g) * 64) * 64 + pp;
            for (int c2 = 0; c2 < chunk; c2 += 8) { f32x2 e8[8];
#pragma unroll
                for (int k = 0; k < 8; ++k) { const int ci = (c2 + k) < 63 ? (c2 + k) : 63; e8[k] = Ep[(size_t)ci * 64]; }
#pragma unroll
                for (int k = 0; k < 8; ++k) if (c2 + k < chunk) { const float nr = pr * xr - pi_ * xi + e8[k].x, ni = pr * xi + pi_ * xr + e8[k].y; xr = nr; xi = ni; } }
#pragma unroll
            for (int ks = 0; ks < 4; ++ks) cfr[ks] = *(const bf16x8*)(Cm + ((size_t)g * 16 + fr) * 128 + ks * 32 + fq * 8);
#pragma unroll
            for (int jx = 0; jx < 4; ++jx) { gm4[jx] = gmix[g * 16 + 4 * fq + jx]; ds4[jx] = dsk[g * 16 + 4 * fq + jx]; }
        }
#pragma unroll
        for (int half = 0; half < 2; ++half) {
            const size_t trow = t0 + half * 32 + r32;
            const float rs = rsL[half * 32 + r32];
            const u32x4 raw = *(const u32x4*)(xb + trow * D_ + g * 16 + hi * 8);
            u32x4 sc4;
            sc4.x = cvt_pk_bf16(bflo(raw.x) * rs, bfhi(raw.x) * rs); sc4.y = cvt_pk_bf16(bflo(raw.y) * rs, bfhi(raw.y) * rs);
            sc4.z = cvt_pk_bf16(bflo(raw.z) * rs, bfhi(raw.z) * rs); sc4.w = cvt_pk_bf16(bflo(raw.w) * rs, bfhi(raw.w) * rs);
            const bf16x8 afr = *reinterpret_cast<const bf16x8*>(&sc4);
            f32x16 c0 = __builtin_amdgcn_mfma_f32_32x32x16_bf16(afr, bfr[0], f32x16{}, 0, 0, 0);
            f32x16 c1 = __builtin_amdgcn_mfma_f32_32x32x16_bf16(afr, bfr[1], f32x16{}, 0, 0, 0);
            f32x16 c2 = __builtin_amdgcn_mfma_f32_32x32x16_bf16(afr, bfr[2], f32x16{}, 0, 0, 0);
            f32x16 c3 = __builtin_amdgcn_mfma_f32_32x32x16_bf16(afr, bfr[3], f32x16{}, 0, 0, 0);
#pragma unroll
            for (int i = 0; i < 16; ++i) {
                auto r0 = __builtin_amdgcn_permlane32_swap(__float_as_uint(c0[i]), __float_as_uint(c1[i]), false, false);
                c0[i] = __uint_as_float(r0[0]); c1[i] = __uint_as_float(r0[1]);
                auto r1 = __builtin_amdgcn_permlane32_swap(__float_as_uint(c2[i]), __float_as_uint(c3[i]), false, false);
                c2[i] = __uint_as_float(r1[0]); c3[i] = __uint_as_float(r1[1]);
            }
#pragma unroll
            for (int t = 0; t < 32; ++t) {
                const int q = t >> 3, s = t & 7, idx = 4 * q + (s & 3);
                const float bur = (s < 4) ? c0[idx] : c1[idx], bui = (s < 4) ? c2[idx] : c3[idx];
                const float nr = ab.x * xr - ab.y * xi + bur, ni = ab.x * xi + ab.y * xr + bui;
                xr = nr; xi = ni;
                if (FINAL) { Xs[t * 136 + pp] = f2bf(xr); Xs[t * 136 + 64 + pp] = f2bf(xi); }
            }
            if (FINAL) {
                asm volatile("s_waitcnt lgkmcnt(0)" ::: "memory");
#pragma unroll
                for (int m = 0; m < 2; ++m) {
                    f32x4 acc = {0.f, 0.f, 0.f, 0.f};
#pragma unroll
                    for (int ks = 0; ks < 4; ++ks) {
                        const bf16x8 xf = *(const bf16x8*)(Xs + (m * 16 + fr) * 136 + ks * 32 + fq * 8);
                        acc = __builtin_amdgcn_mfma_f32_16x16x32_bf16(cfr[ks], xf, acc, 0, 0, 0);
                    }
                    const size_t tr2 = t0 + half * 32 + m * 16 + fr;
                    const float rs2 = rsL[half * 32 + m * 16 + fr];
                    const u32x2 hx = *(const u32x2*)(xb + tr2 * D_ + g * 16 + 4 * fq);
                    const float h0 = bflo(hx.x) * rs2 * gm4[0], h1 = bfhi(hx.x) * rs2 * gm4[1], h2 = bflo(hx.y) * rs2 * gm4[2], h3 = bfhi(hx.y) * rs2 * gm4[3];
                    const float y0 = gelu_tanh(acc[0] + ds4[0] * h0), y1 = gelu_tanh(acc[1] + ds4[1] * h1), y2 = gelu_tanh(acc[2] + ds4[2] * h2), y3 = gelu_tanh(acc[3] + ds4[3] * h3);
                    u32x2 w; w.x = cvt_pk_bf16(y0, y1); w.y = cvt_pk_bf16(y2, y3);
                    *(u32x2*)(gl + tr2 * D_ + g * 16 + 4 * fq) = w;
                }
                asm volatile("s_waitcnt lgkmcnt(0)" ::: "memory");
            }
        }
        if (!FINAL) { f32x2 e; e.x = xr; e.y = xi; E[((size_t)(b * 128 + g) * 64 + chunk) * 64 + pp] = e; }
      }
    }
}

__device__ __forceinline__ void ret_phase(const Params& p, unsigned char* shm, float* rssq) {
    const int tid = otid(), wid = tid >> 6, lane = tid & 63, fr = lane & 15, fq = lane >> 4;
    const bf16_t* ret = (const bf16_t*)(p.ws + OFF_BIG);
    bf16_t* ao = (bf16_t*)(p.ws + OFF_OA);
    constexpr int QS = 264, TS = 72;
    bf16_t* Qs = (bf16_t*)shm; bf16_t* Ks = Qs + 64 * QS; bf16_t* KTs = Ks + 64 * QS; bf16_t* VTs = KTs + 256 * TS; bf16_t* Ss = VTs + 64 * TS; bf16_t* RTs = Ss + 64 * TS;
    const int c = obid(); const int xcd = c & 7, jj = c >> 3;
    const int bh = xcd * 4 + (jj >> 3), sl = jj & 7;
    const int b = bh >> 3, h = bh & 7;
    const float lg = logf(1.0f - exp2f(-5.0f - (float)h));
    const float cdec = __expf(lg * 64.0f);
    const int mi = wid >> 1, ni0 = 2 * (wid & 1);
    const float qdec = __expf(lg * (float)(16 * mi + fr + 1));
    float idec[2][4];
#pragma unroll
    for (int t = 0; t < 2; ++t)
#pragma unroll
        for (int j = 0; j < 4; ++j) { const int n = 16 * mi + fr, m = 16 * (ni0 + t) + 4 * fq + j; idec[t][j] = __expf(lg * (fabsf((float)(n - m)) - (float)(63 - m))); }
    f32x4 R[4][2];
#pragma unroll
    for (int a = 0; a < 4; ++a)
#pragma unroll
        for (int d = 0; d < 2; ++d) R[a][d] = (f32x4){0.f, 0.f, 0.f, 0.f};
    const size_t tokb = (size_t)b * S_;
    const bf16_t* qsrc = ret + (tokb + lane) * 12288 + h * 256 + wid * 32;
    const bf16_t* ksrc = qsrc + 2048;
    const bf16_t* vsrc = ret + (tokb + lane) * 12288 + 4096 + h * 512 + sl * 64 + wid * 8;
    u32x4 pq[4], pk[4], pv; u32x2 pg[2], cg2[2];
    const bf16_t* gsrc = ret + (tokb + 16 * mi + fr) * 12288 + 8192 + h * 512 + sl * 64 + 16 * ni0 + 4 * fq;
#pragma unroll
    for (int j = 0; j < 4; ++j) { pq[j] = *(const u32x4*)(qsrc + j * 8); pk[j] = *(const u32x4*)(ksrc + j * 8); }
    pv = *(const u32x4*)vsrc;
    pg[0] = *(const u32x2*)gsrc; pg[1] = *(const u32x2*)(gsrc + 16);
    for (int ch = 0; ch < 64; ++ch) {
        __syncthreads();
        cg2[0] = pg[0]; cg2[1] = pg[1];
#pragma unroll
        for (int j = 0; j < 4; ++j) {
            *(u32x4*)(Qs + lane * QS + wid * 32 + j * 8) = pq[j];
            *(u32x4*)(Ks + lane * QS + wid * 32 + j * 8) = pk[j];
            const unsigned kw[4] = {pk[j].x, pk[j].y, pk[j].z, pk[j].w};
#pragma unroll
            for (int i = 0; i < 4; ++i) {
                KTs[(wid * 32 + j * 8 + 2 * i) * TS + lane] = (bf16_t)(kw[i] & 0xffffu);
                KTs[(wid * 32 + j * 8 + 2 * i + 1) * TS + lane] = (bf16_t)(kw[i] >> 16);
            }
        }
        { const unsigned vw[4] = {pv.x, pv.y, pv.z, pv.w};
#pragma unroll
          for (int i = 0; i < 4; ++i) { VTs[(wid * 8 + 2 * i) * TS + lane] = (bf16_t)(vw[i] & 0xffffu); VTs[(wid * 8 + 2 * i + 1) * TS + lane] = (bf16_t)(vw[i] >> 16); } }
#pragma unroll
        for (int ei = 0; ei < 4; ++ei)
#pragma unroll
            for (int di = 0; di < 2; ++di) { u32x2 w; w.x = cvt_pk_bf16(R[ei][di][0], R[ei][di][1]); w.y = cvt_pk_bf16(R[ei][di][2], R[ei][di][3]);
                *(u32x2*)(RTs + (16 * ei + fr) * QS + wid * 32 + 16 * di + 4 * fq) = w; }
        if (ch + 1 < 64) {
            const size_t adv = (size_t)(ch + 1) * 64 * 12288;
#pragma unroll
            for (int j = 0; j < 4; ++j) { pq[j] = *(const u32x4*)(qsrc + adv + j * 8); pk[j] = *(const u32x4*)(ksrc + adv + j * 8); }
            pv = *(const u32x4*)(vsrc + adv);
            pg[0] = *(const u32x2*)(gsrc + adv); pg[1] = *(const u32x2*)(gsrc + adv + 16);
        }
        __syncthreads();
        bf16x8 qa[8];
        {
            f32x4 sacc[2] = {{0.f, 0.f, 0.f, 0.f}, {0.f, 0.f, 0.f, 0.f}};
#pragma unroll
            for (int ks = 0; ks < 8; ++ks) qa[ks] = *(const bf16x8*)(Qs + (16 * mi + fr) * QS + ks * 32 + fq * 8);
#pragma unroll
            for (int ks = 0; ks < 8; ++ks) {
#pragma unroll
                for (int t = 0; t < 2; ++t) { const bf16x8 bf = *(const bf16x8*)(Ks + (16 * (ni0 + t) + fr) * QS + ks * 32 + fq * 8);
                    sacc[t] = __builtin_amdgcn_mfma_f32_16x16x32_bf16(bf, qa[ks], sacc[t], 0, 0, 0); }
            }
#pragma unroll
            for (int t = 0; t < 2; ++t) { u32x2 w; w.x = cvt_pk_bf16(sacc[t][0] * idec[t][0], sacc[t][1] * idec[t][1]); w.y = cvt_pk_bf16(sacc[t][2] * idec[t][2], sacc[t][3] * idec[t][3]);
                *(u32x2*)(Ss + (16 * mi + fr) * TS + 16 * (ni0 + t) + 4 * fq) = w; }
        }
        __syncthreads();
        {
            f32x4 oi[2] = {{0.f, 0.f, 0.f, 0.f}, {0.f, 0.f, 0.f, 0.f}}, oc[2] = {{0.f, 0.f, 0.f, 0.f}, {0.f, 0.f, 0.f, 0.f}};
#pragma unroll
            for (int ks = 0; ks < 2; ++ks) {
                const bf16x8 af = *(const bf16x8*)(Ss + (16 * mi + fr) * TS + ks * 32 + fq * 8);
#pragma unroll
                for (int t = 0; t < 2; ++t) { const bf16x8 bf = *(const bf16x8*)(VTs + (16 * (ni0 + t) + fr) * TS + ks * 32 + fq * 8);
                    oi[t] = __builtin_amdgcn_mfma_f32_16x16x32_bf16(bf, af, oi[t], 0, 0, 0); }
            }
#pragma unroll
            for (int ks = 0; ks < 8; ++ks) {
#pragma unroll
                for (int t = 0; t < 2; ++t) { const bf16x8 bf = *(const bf16x8*)(RTs + (16 * (ni0 + t) + fr) * QS + ks * 32 + fq * 8);
                    oc[t] = __builtin_amdgcn_mfma_f32_16x16x32_bf16(bf, qa[ks], oc[t], 0, 0, 0); }
            }
            const size_t tok = tokb + (size_t)ch * 64 + 16 * mi + fr;
            float sq = 0.f;
#pragma unroll
            for (int t = 0; t < 2; ++t) {
                const int e = sl * 64 + 16 * (ni0 + t) + 4 * fq;
                const u32x2 gw = cg2[t];
                f32x4 ov = oi[t] + oc[t] * qdec;
                sq += ov[0] * ov[0] + ov[1] * ov[1] + ov[2] * ov[2] + ov[3] * ov[3];
                u32x2 w; w.x = cvt_pk_bf16(ov[0] * bflo(gw.x), ov[1] * bfhi(gw.x)); w.y = cvt_pk_bf16(ov[2] * bflo(gw.y), ov[3] * bfhi(gw.y));
                *(u32x2*)(ao + tok * 4096 + h * 512 + e) = w;
            }
            sq += __shfl_xor(sq, 16); sq += __shfl_xor(sq, 32);
            if (fq == 0) atomicAdd(rssq + (size_t)(sl * 4 + mi) * 0 + (size_t)sl * (T_ * 8) + tok * 8 + h, sq);
        }
#pragma unroll
        for (int ei = 0; ei < 4; ++ei)
#pragma unroll
            for (int di = 0; di < 2; ++di) R[ei][di] *= cdec;
#pragma unroll
        for (int ks = 0; ks < 2; ++ks) {
            bf16x8 bfk[2];
#pragma unroll
            for (int di = 0; di < 2; ++di) bfk[di] = *(const bf16x8*)(KTs + (wid * 32 + 16 * di + fr) * TS + ks * 32 + fq * 8);
#pragma unroll
            for (int ei = 0; ei < 4; ++ei) { const bf16x8 af = *(const bf16x8*)(VTs + (16 * ei + fr) * TS + ks * 32 + fq * 8);
#pragma unroll
                for (int di = 0; di < 2; ++di) R[ei][di] = __builtin_amdgcn_mfma_f32_16x16x32_bf16(bfk[di], af, R[ei][di], 0, 0, 0); }
        }
    }
}

__device__ __forceinline__ void ret2_phase(const Params& p) {
    bf16_t* ao = (bf16_t*)(p.ws + OFF_OA); const float* rssq = (const float*)(p.ws + OFF_RSQP);
    const size_t nvec = (size_t)T_ * 4096 / 8;
    for (size_t i = (size_t)obid() * 512 + otid(); i < nvec; i += (size_t)gridDim.x * 512) {
        const size_t t = i >> 9; const int hh = (int)((i & 511) >> 6);
        float rsum = 0.f;
#pragma unroll
        for (int sl = 0; sl < 8; ++sl) rsum += rssq[(size_t)sl * (T_ * 8) + t * 8 + hh];
        const float rs = rsqrtf(rsum * (1.0f / 512.0f) + EPS_);
        u32x4 w = *(u32x4*)(ao + i * 8);
        w.x = cvt_pk_bf16(bflo(w.x) * rs, bfhi(w.x) * rs); w.y = cvt_pk_bf16(bflo(w.y) * rs, bfhi(w.y) * rs);
        w.z = cvt_pk_bf16(bflo(w.z) * rs, bfhi(w.z) * rs); w.w = cvt_pk_bf16(bflo(w.w) * rs, bfhi(w.w) * rs);
        *(u32x4*)(ao + i * 8) = w;
    }
}

__device__ __forceinline__ void final_phase(const Params& p) {
    const float* ss = (const float*)(p.ws + OFF_SSP) + (size_t)8 * 32 * T_;
    const int tid = otid();
    const f32x4 g = *(const f32x4*)((const float*)(p.ws + OFF_PAR) + PAR_NFINAL + tid * 4);
    for (int row = obid(); row < T_; row += gridDim.x) {
        float ssum = ss[(size_t)(tid & 31) * T_ + row];
#pragma unroll
        for (int o = 16; o > 0; o >>= 1) ssum += __shfl_xor(ssum, o);
        const float rs = rsqrtf(ssum * (1.0f / D_) + EPS_);
        f32x4 v = *(f32x4*)(p.out + (size_t)row * D_ + tid * 4);
        v = v * rs * g;
        *(f32x4*)(p.out + (size_t)row * D_ + tid * 4) = v;
    }
}

enum { OP_PREP = 0, OP_A_IN, OP_ATTN, OP_A_OUT, OP_S5A, OP_S5C, OP_GLU, OP_C_IN, OP_RET, OP_RET2, OP_C_OUT, OP_W1, OP_W2, OP_FINAL };
#ifndef PHMASK
#define PHMASK 0xffff
#endif
#define PHON(b) ((PHMASK >> (b)) & 1)
constexpr int NPH = 23;
__device__ const unsigned char PROG_OP[NPH] = { OP_PREP,
    OP_A_IN, OP_ATTN, OP_A_OUT, OP_W1, OP_W2,
    OP_S5A, OP_S5C, OP_GLU, OP_W1, OP_W2,
    OP_C_IN, OP_RET, OP_RET2, OP_C_OUT, OP_W1, OP_W2,
    OP_A_IN, OP_ATTN, OP_A_OUT, OP_W1, OP_W2,
    OP_FINAL };
__device__ const unsigned char PROG_LAYER[NPH] = { 0, 0, 0, 0, 0, 0, 1, 1, 1, 1, 1, 2, 2, 2, 2, 2, 2, 3, 3, 3, 3, 3, 3 };

struct GemmDesc { unsigned long long a_off, b_off; int N, K, ss_idx, mode; };
#define GD_NONE {0, 0, 0, 0, 0, 0}
#define GD_A_IN(L)  {OFF_XB, OFF_WT_A_IN + (L / 3) * SZ_A_IN, 6144, 2048, 2 * L, 0}
#define GD_A_OUT(L) {OFF_OA, OFF_WT_A_OUT + (L / 3) * SZ_A_OUT, 2048, 2048, 2 * L + 1, 0}
#define GD_W1(L)    {OFF_XB, OFF_WT_W1 + L * SZ_W1, 8192, 2048, 2 * L + 1, 1}
#define GD_W2(L)    {OFF_BIG, OFF_WT_W2 + L * SZ_W1, 2048, 8192, 2 * L + 2, 0}
#define GD_GLU(L)   {OFF_OA, OFF_WT_GLU, 4096, 2048, 2 * L + 1, 1}
#define GD_C_IN(L)  {OFF_XB, OFF_WT_C_IN, 12288, 2048, 2 * L, 2}
#define GD_C_OUT(L) {OFF_OA, OFF_WT_C_OUT, 2048, 4096, 2 * L + 1, 0}
__device__ const GemmDesc GD[NPH] = { GD_NONE,
    GD_A_IN(0ull), GD_NONE, GD_A_OUT(0ull), GD_W1(0ull), GD_W2(0ull),
    GD_NONE, GD_NONE, GD_GLU(1ull), GD_W1(1ull), GD_W2(1ull),
    GD_C_IN(2ull), GD_NONE, GD_NONE, GD_C_OUT(2ull), GD_W1(2ull), GD_W2(2ull),
    GD_A_IN(3ull), GD_NONE, GD_A_OUT(3ull), GD_W1(3ull), GD_W2(3ull),
    GD_NONE };

#define XB_TMO      128
#define XB_XCNT(j)  (256  + 64 * (j))
#define XB_XSUB(j)  (1280 + 64 * (j))
#define XB_XGEN(j)  (2304 + 64 * (j))
#define XB_TOP      3328
#define XB_TOPGEN   3392
#define XCD_BAR_WORDS 3456
#define XB_SPIN_CAP (1u << 22)
__device__ __forceinline__ unsigned xb_ld(unsigned* p)              { return __hip_atomic_load(p, __ATOMIC_RELAXED, __HIP_MEMORY_SCOPE_AGENT); }
__device__ __forceinline__ unsigned xb_add(unsigned* p, unsigned v) { return __hip_atomic_fetch_add(p, v, __ATOMIC_RELAXED, __HIP_MEMORY_SCOPE_AGENT); }
__device__ __forceinline__ unsigned xb_xcc_id() { return (unsigned)__builtin_amdgcn_s_getreg((3 << 11) | 20) & 0xFu; }
#define XB_SPIN(cond, bar) do { unsigned _sp = 0; while (cond) { __builtin_amdgcn_s_sleep(1); \
    if ((++_sp & 255u) == 0u) { if (xb_ld(&(bar)[XB_TMO])) break; if (_sp > XB_SPIN_CAP) { atomicAdd(&(bar)[XB_TMO], 1u); break; } } } } while (0)
struct XcdBarrier { unsigned* bar; unsigned x; volatile LAS unsigned* st; };
__device__ __forceinline__ XcdBarrier xcd_barrier_post(unsigned* bar, volatile LAS unsigned* st) {
    XcdBarrier b; b.bar = bar; b.x = xb_xcc_id(); b.st = st;
    if (threadIdx.x == 0) (void)xb_add(&bar[XB_XCNT(b.x)], 1u);
    return b;
}
__device__ __forceinline__ void xcd_barrier_complete(unsigned* bar, unsigned x, unsigned& nloc, unsigned& nx) {
    const unsigned G = gridDim.x * gridDim.y * gridDim.z;
    unsigned sum, cnt, mine, sp = 0u;
    for (;;) {
        sum = 0u; cnt = 0u; mine = 0u;
#pragma unroll
        for (unsigned j = 0; j < 16; ++j) { const unsigned c = xb_ld(&bar[XB_XCNT(j)]); sum += c; cnt += (c > 0u) ? 1u : 0u; mine = (j == x) ? c : mine; }
        if (sum == G) break;
        __builtin_amdgcn_s_sleep(1);
        if ((++sp & 255u) == 0u) { if (xb_ld(&bar[XB_TMO])) break; if (sp > XB_SPIN_CAP) { atomicAdd(&bar[XB_TMO], 1u); break; } }
    }
    nloc = mine > 0u ? mine : 1u; nx = cnt > 0u ? cnt : 1u;
}
__device__ __forceinline__ void xcd_barrier(unsigned char* ws, unsigned char* shm) {
    XcdBarrier b; b.bar = (unsigned*)(ws + OFF_BAR); b.x = xb_xcc_id(); b.st = (volatile LAS unsigned*)((LAS unsigned char*)shm + LDS_PHASE_BYTES);
    asm volatile("s_waitcnt vmcnt(0) lgkmcnt(0)" ::: "memory");
    __syncthreads();
    if (threadIdx.x == 0) {
        unsigned* bar = b.bar;
        __builtin_amdgcn_s_waitcnt(0);
        unsigned nloc = b.st[0], nx = b.st[1];
        if (nloc == 0u) { xcd_barrier_complete(bar, b.x, nloc, nx); b.st[0] = nloc; b.st[1] = nx; }
        const unsigned old = xb_add(&bar[XB_XSUB(b.x)], 1u);
        const unsigned gen = old / nloc;
        if (old + 1u == (gen + 1u) * nloc) {
            __builtin_amdgcn_fence(__ATOMIC_RELEASE, "agent");
            asm volatile("s_waitcnt vmcnt(0)" ::: "memory");
            const unsigned og = xb_add(&bar[XB_TOP], 1u);
            const unsigned tg = og / nx;
            if (og + 1u == (tg + 1u) * nx) xb_add(&bar[XB_TOPGEN], 1u);
            else XB_SPIN(xb_ld(&bar[XB_TOPGEN]) == tg, bar);
            __builtin_amdgcn_fence(__ATOMIC_ACQUIRE, "agent");
            xb_add(&bar[XB_XGEN(b.x)], 1u);
            asm volatile("s_waitcnt vmcnt(0)" ::: "memory");
        } else {
            XB_SPIN(xb_ld(&bar[XB_XGEN(b.x)]) == gen, bar);
            __builtin_amdgcn_fence(__ATOMIC_ACQUIRE, "agent");
            asm volatile("s_waitcnt vmcnt(0)" ::: "memory");
        }
    }
    __syncthreads();
}
__device__ __forceinline__ void gsync_cg(cg::grid_group& grid) {
    asm volatile("s_waitcnt vmcnt(0) lgkmcnt(0)" ::: "memory");
    grid.sync();
    __builtin_amdgcn_fence(__ATOMIC_ACQUIRE, "agent");
    asm volatile("s_waitcnt vmcnt(0) lgkmcnt(0)" ::: "memory");
}

__global__ void __launch_bounds__(512, 2) fwd_megakernel(Params p, int ph_lo, int ph_hi) {
    extern __shared__ __attribute__((aligned(16))) unsigned char shm[];
    cg::grid_group grid = cg::this_grid();
    volatile LAS unsigned* xst = (volatile LAS unsigned*)((LAS unsigned char*)shm + LDS_PHASE_BYTES);
    if (threadIdx.x == 0) { xst[0] = 0u; xst[1] = 0u; }
    __syncthreads();
    (void)xcd_barrier_post((unsigned*)(p.ws + OFF_BAR), xst);
#ifndef DUPMASK
#define DUPMASK 0
#endif
    if (PHON(0) && ph_lo == 0) {
#pragma unroll 1
        for (int rp_ = 0; rp_ < ((DUPMASK & 1) ? 2 : 1); ++rp_) { prep_phase(p, shm); if (ph_hi > 1) gsync_cg(grid); } }
    for (int ph = (ph_lo < 1 ? 1 : ph_lo); ph < ph_hi; ++ph) {
        const int op = PROG_OP[ph], L = PROG_LAYER[ph];
        const int nrep_ = ((DUPMASK >> op) & 1) ? 2 : 1;
#pragma unroll 1
        for (int rp_ = 0; rp_ < nrep_; ++rp_) {
        unsigned char* ws = p.ws; asm volatile("" : "+s"(ws));
        float* ssb = (float*)(ws + OFF_SSP);
        if (PHON(1) && (op == OP_A_IN || op == OP_C_IN || op == OP_W1)) {
            const GemmDesc gd = GD[ph];
            pg8::Gemm g; g.A = (const bf16_t*)(ws + gd.a_off); g.Bt = (const bf16_t*)(ws + gd.b_off); g.M = T_; g.N = gd.N; g.K = gd.K;
            pg8::EpiBf E; E.rot = (const f32x2*)(ws + OFF_ROT); E.O = (bf16_t*)(ws + OFF_BIG); E.ldc = gd.N; E.mode = gd.mode; E.ss = ssb + (size_t)gd.ss_idx * 32 * T_;
            pg8::StaticOrder S; S.init(g.M, g.N, (int)gridDim.x, obid());
            {
                float* lrs = (float*)(shm + pg8::STAGE_BYTES); const int tid2 = otid();
                int nun = 0; { pg8::Unit uu; while (nun < 24 && S.next(nun, uu)) ++nun; }
                for (int j = tid2; j < nun * 256; j += 512) { pg8::Unit uu; S.next(j >> 8, uu);
                    const float* sp = E.ss + (size_t)uu.pm * 256 + (j & 255); float a = 0.f;
#pragma unroll 8
                    for (int sl = 0; sl < 32; ++sl) a += sp[(size_t)sl * T_];
                    lrs[j] = rsqrtf(a * (1.0f / D_) + EPS_); }
                __syncthreads();
            }
            pg8::gemm_phase<pg8::EpiBf, pg8::StaticOrder>((LAS unsigned char*)shm, g, S, E);
        } else if (PHON(2) && (op == OP_A_OUT || op == OP_GLU || op == OP_C_OUT || op == OP_W2)) {
            const GemmDesc gd = GD[ph];
            pg8::Gemm g; g.A = (const bf16_t*)(ws + gd.a_off); g.Bt = (const bf16_t*)(ws + gd.b_off); g.M = T_; g.N = gd.N; g.K = gd.K;
            pg8::EpiRes E; E.xout = p.out; E.xb = (bf16_t*)(ws + OFF_XB); E.glu = gd.mode; E.xin = p.out; E.ssn = ssb + (size_t)gd.ss_idx * 32 * T_;
            pg8::StaticOrder S; S.init(g.M, g.N, (int)gridDim.x, obid());
            pg8::gemm_phase<pg8::EpiRes, pg8::StaticOrder>((LAS unsigned char*)shm, g, S, E);
        } else if (PHON(3) && op == OP_ATTN) {
            const float li = 0.8f - 0.6f * expf(-0.3f * (float)L);
            attn_phase(p, L / 3, li, shm);
        } else if (PHON(4) && op == OP_S5A) {
            s5_phase<false>(p, shm);
        } else if (PHON(5) && op == OP_S5C) {
            s5_phase<true>(p, shm);
        } else if (PHON(6) && op == OP_RET) {
            ret_phase(p, shm, (float*)(ws + (rp_ == 0 ? OFF_RSQP : OFF_XB)));
        } else if (PHON(7) && op == OP_RET2) {
            ret2_phase(p);
        } else if (PHON(8) && op == OP_FINAL) {
            final_phase(p);
        }
        if (ph + 1 < ph_hi || rp_ + 1 < nrep_) xcd_barrier(ws, shm);
        }
    }
}

extern "C" void kernel_launch(void* const* d_in, const int* in_sizes, int n_in, void* d_out, int out_size, void* d_ws, size_t ws_size, hipStream_t stream) {
    static int grid_blocks = 0;
    if (grid_blocks == 0) {
        if (n_in != 21 || out_size != T_ * D_ || ws_size < WS_NEED) { fprintf(stderr, "kernel_launch: unexpected shapes n_in %d out %d ws %zu (need %zu)\n", n_in, out_size, ws_size, (size_t)WS_NEED); grid_blocks = -1; return; }
        int dev = 0, cus = 0, per_cu = 0;
        hipGetDevice(&dev);
        hipDeviceGetAttribute(&cus, hipDeviceAttributeMultiprocessorCount, dev);
        if (hipFuncSetAttribute((const void*)fwd_megakernel, hipFuncAttributeMaxDynamicSharedMemorySize, LDS_BYTES) != hipSuccess) { fprintf(stderr, "kernel_launch: hipFuncSetAttribute failed\n"); grid_blocks = -1; return; }
        hipOccupancyMaxActiveBlocksPerMultiprocessor(&per_cu, (const void*)fwd_megakernel, 512, LDS_BYTES);
        (void)hipGetLastError();
        if (per_cu < 1) per_cu = 1;
        grid_blocks = cus * 1;
        if (grid_blocks != 256) fprintf(stderr, "kernel_launch: note: %d CUs (kernel tuned for 256)\n", cus);
    }
    if (grid_blocks < 0) return;
    (void)hipMemsetAsync((unsigned char*)d_ws + OFF_BAR, 0, XCD_BAR_WORDS * 4, stream);
    Params p{};
    const float** pp = (const float**)&p;
    for (int i = 0; i < 21; ++i) pp[i] = (const float*)d_in[i];
    p.out = (float*)d_out; p.ws = (unsigned char*)d_ws;
#ifndef DBG_LO
#define DBG_LO 0
#endif
#ifndef DBG_HI
#define DBG_HI NPH
#endif
    int lo = DBG_LO, hi = DBG_HI;
    void* args[] = {&p, &lo, &hi};
    hipError_t e = hipLaunchCooperativeKernel((const void*)fwd_megakernel, dim3(grid_blocks), dim3(512), args, LDS_BYTES, stream);
    if (e != hipSuccess) fprintf(stderr, "cooperative launch failed: %s (grid %d)\n", hipGetErrorString(e), grid_blocks);
}
```

```cpp
#include <hip/hip_runtime.h>
#include <hip/hip_cooperative_groups.h>
#include <cstdio>
#include <cstdint>
namespace cg = cooperative_groups;

#define LAS __attribute__((address_space(3)))
typedef unsigned short bf16_t;
typedef short bf16x8 __attribute__((ext_vector_type(8)));
typedef short s16x4 __attribute__((ext_vector_type(4)));
typedef float f32x4 __attribute__((ext_vector_type(4)));
typedef float f32x2 __attribute__((ext_vector_type(2)));
typedef float f32x16 __attribute__((ext_vector_type(16)));
typedef unsigned u32x4 __attribute__((ext_vector_type(4)));
typedef unsigned u32x2 __attribute__((ext_vector_type(2)));

constexpr int T_ = 16384, D_ = 2048, S_ = 4096;
constexpr float EPS_ = 1e-6f;
constexpr int LDS_PHASE_BYTES = 156672;
constexpr int LDS_BYTES = LDS_PHASE_BYTES + 16;

constexpr size_t SZ_A_IN = 6144ull * 2048 * 2, SZ_A_OUT = 2048ull * 2048 * 2, SZ_W1 = 8192ull * 2048 * 2;
constexpr size_t OFF_WT_A_IN = 0;
constexpr size_t OFF_WT_A_OUT = OFF_WT_A_IN + 2 * SZ_A_IN;
constexpr size_t OFF_WT_GLU = OFF_WT_A_OUT + 2 * SZ_A_OUT;
constexpr size_t OFF_WT_C_IN = OFF_WT_GLU + 4096ull * 2048 * 2;
constexpr size_t OFF_WT_C_OUT = OFF_WT_C_IN + 12288ull * 2048 * 2;
constexpr size_t OFF_WT_W1 = OFF_WT_C_OUT + 2048ull * 4096 * 2;
constexpr size_t OFF_WT_W2 = OFF_WT_W1 + 4 * SZ_W1;
constexpr size_t OFF_XB = OFF_WT_W2 + 4 * SZ_W1;
constexpr size_t OFF_BIG = OFF_XB + (size_t)T_ * D_ * 2;
constexpr size_t OFF_OA = OFF_BIG + (size_t)T_ * 12288 * 2;
constexpr size_t OFF_SS = OFF_OA + (size_t)T_ * 4096 * 2;
constexpr size_t OFF_RSSQ = OFF_SS + 9ull * T_ * 4;
constexpr size_t OFF_ROT = OFF_RSSQ + (size_t)T_ * 8 * 4;
constexpr size_t OFF_S5B = OFF_ROT + 4096ull * 128 * 8;
constexpr size_t OFF_S5C = OFF_S5B + 128ull * 128 * 16 * 2;
constexpr size_t OFF_S5AB = OFF_S5C + 128ull * 16 * 128 * 2;
constexpr size_t WS_END = OFF_S5AB + 128ull * 64 * 8;
constexpr size_t OFF_SSP = WS_END;
constexpr size_t OFF_RSQP = OFF_SSP + 9ull * 32 * T_ * 4;
constexpr size_t OFF_RSFIN = OFF_RSQP + 8ull * T_ * 8 * 4;
constexpr size_t OFF_BAR = OFF_RSFIN + (size_t)T_ * 4;
constexpr size_t OFF_PAR = OFF_BAR + 16384;
constexpr int PAR_GMIX = 0, PAR_NFINAL = 2048, PAR_LAM = 4096, PAR_SUBLN = 5120, PAR_BD = 5632, PAR_N = 7680;
constexpr size_t WS_NEED = OFF_PAR + PAR_N * 4;
constexpr size_t OFF_ATT_SCR = OFF_BIG + (size_t)T_ * 6144 * 2;

struct Params {
    const float* x; const float* norm_mix; const float* norm_mlp; const float* norm_final;
    const float* a_w_in; const float* a_lambda; const float* a_subln; const float* a_w_out;
    const float* b_a_re; const float* b_a_im; const float* b_log_dt; const float* b_b_re; const float* b_b_im;
    const float* b_c_re; const float* b_c_im; const float* b_d; const float* b_w_glu;
    const float* c_w_in; const float* c_w_out; const float* mlp_w1; const float* mlp_w2;
    float* out; unsigned char* ws;
};

__device__ __forceinline__ unsigned cvt_pk_bf16(float lo, float hi) { unsigned r; asm volatile("v_cvt_pk_bf16_f32 %0, %1, %2" : "=v"(r) : "v"(lo), "v"(hi)); return r; }
__device__ __forceinline__ float bf2f(unsigned short b) { return __uint_as_float(((unsigned)b) << 16); }
__device__ __forceinline__ float bflo(unsigned w) { return __uint_as_float(w << 16); }
__device__ __forceinline__ float bfhi(unsigned w) { return __uint_as_float(w & 0xffff0000u); }
__device__ __forceinline__ unsigned short f2bf(float f) { return (unsigned short)(cvt_pk_bf16(f, 0.f) & 0xffffu); }

__device__ __forceinline__ int otid() { int t = threadIdx.x; asm volatile("" : "+v"(t)); return t; }
__device__ __forceinline__ int obid() { int t = blockIdx.x; asm volatile("" : "+s"(t)); return t; }

namespace pg8 {
constexpr int BM = 256, BK = 64, HALF = 128, HTB = HALF * BK * 2, STAGE_BYTES = 8 * HTB, NXCD = 8, WGM = 8;
__device__ __forceinline__ int lds_byte(int r, int c) { const int st = (r >> 4) * 2 + (c >> 5), rr = r & 15, cc = c & 31, ob = rr * 64 + cc * 2; return st * 1024 + (ob ^ (((ob >> 9) & 1) << 5)); }
__device__ __forceinline__ void stage_rc(int b, int& R, int& C) { const int st = b / 1024, sb = b % 1024, swz = sb ^ (((sb >> 9) & 1) << 5); R = (st >> 1) * 16 + swz / 64; C = (st & 1) * 32 + (swz % 64) / 2; }
struct Unit { int pm, pn; };
struct Gemm { const bf16_t* A; const bf16_t* Bt; int M, N, K; };
struct StaticOrder {
    int nM, nN, nwg, G, c;
    __device__ void init(int M, int N, int G_, int c_) { nM = M / BM; nN = N / BM; nwg = nM * nN; G = G_; c = c_; }
    __device__ bool next(int i, Unit& u) const {
        const long L = (long)i * G + c; if (L >= nwg) return false;
        int wgid = (int)L; { const int q = nwg / NXCD, r = nwg % NXCD, xcd = wgid % NXCD, off = wgid / NXCD; wgid = (xcd < r ? xcd * (q + 1) : r * (q + 1) + (xcd - r) * q) + off; }
        const int nig = WGM * nN, gid = wgid / nig, fm = gid * WGM, gsz = (nM - fm) < WGM ? (nM - fm) : WGM;
        u.pm = fm + ((wgid % nig) % gsz); u.pn = (wgid % nig) / gsz; return true;
    }
};

#define GAS __attribute__((address_space(1)))
struct EpiBf {
    bf16_t* O; int ldc; const float* ss; int mode; const f32x2* rot;
    __device__ __forceinline__ void operator()(const f32x4 (&acc)[2][2][4][2], const Unit& u, int wr, int wc, int fr, int fq, LAS unsigned char* lds, int ui) const {
        const int row0 = u.pm * BM + wr * 64 + fr, colt = u.pn * BM + wc * 32 + 8 * fq;
        int sub = 0;
        if (mode == 1) sub = 1;
        else if (mode == 2) { sub = u.pn < 8 ? 2 : (u.pn < 16 ? 3 : (u.pn < 32 ? 0 : 4)); }
        const LAS float* lrs = (const LAS float*)(lds + STAGE_BYTES) + ui * 256 + wr * 64 + fr;
        float rs8[8];
#pragma unroll
        for (int r = 0; r < 8; ++r) rs8[r] = lrs[(r >> 2) * HALF + (r & 3) * 16];
        GAS bf16_t* Og = (GAS bf16_t*)O;
        if (sub == 2 || sub == 3) {
            const GAS f32x2* rotg = (const GAS f32x2*)rot + wc * 32 + 8 * fq;
#pragma unroll
            for (int ai = 0; ai < 2; ++ai) {
                f32x2 cs[4][2][4];
#pragma unroll
                for (int m = 0; m < 4; ++m) { const int row = row0 + ai * HALF + m * 16; const GAS f32x2* rp = rotg + (size_t)(row & (S_ - 1)) * 128;
#pragma unroll
                    for (int n = 0; n < 2; ++n)
#pragma unroll
                        for (int j = 0; j < 4; ++j) cs[m][n][j] = rp[n * 4 + j]; }
#pragma unroll
                for (int m = 0; m < 4; ++m) { const int row = row0 + ai * HALF + m * 16;
                    float ksc = rs8[ai * 4 + m];
                    if (sub == 3) { const float lgam = logf(1.0f - exp2f(-5.0f - (float)(u.pn - 8))); ksc *= 0.0625f * __expf(lgam * (float)(63 - (row & 63))); }
                    GAS bf16_t* rowp = Og + (size_t)row * ldc + colt;
                    u32x4 w1, w2;
#pragma unroll
                    for (int n = 0; n < 2; ++n) {
                        const f32x4 t1 = acc[ai][0][m][n] * ksc, t2 = acc[ai][1][m][n] * ksc;
                        f32x4 o1, o2;
#pragma unroll
                        for (int j = 0; j < 4; ++j) { const f32x2 c2 = cs[m][n][j]; o1[j] = t1[j] * c2.x - t2[j] * c2.y; o2[j] = t1[j] * c2.y + t2[j] * c2.x; }
                        w1[2 * n] = cvt_pk_bf16(o1[0], o1[1]); w1[2 * n + 1] = cvt_pk_bf16(o1[2], o1[3]); w2[2 * n] = cvt_pk_bf16(o2[0], o2[1]); w2[2 * n + 1] = cvt_pk_bf16(o2[2], o2[3]);
                    }
                    *(GAS u32x4*)(rowp) = w1; *(GAS u32x4*)(rowp + HALF) = w2;
                }
            }
        } else {
#pragma unroll
            for (int ai = 0; ai < 2; ++ai)
#pragma unroll
                for (int m = 0; m < 4; ++m) {
                    const int row = row0 + ai * HALF + m * 16;
                    const float rs = rs8[ai * 4 + m];
                    GAS bf16_t* rowp = Og + (size_t)row * ldc + colt;
#pragma unroll
                    for (int bj = 0; bj < 2; ++bj) {
                        u32x4 w;
#pragma unroll
                        for (int n = 0; n < 2; ++n) {
                            f32x4 v = acc[ai][bj][m][n] * rs;
                            if (sub == 1) {
#pragma unroll
                                for (int j = 0; j < 4; ++j) { const float r = fmaxf(v[j], 0.f); v[j] = r * r; }
                            } else if (sub == 4) {
#pragma unroll
                                for (int j = 0; j < 4; ++j) v[j] = v[j] / (1.0f + __expf(-v[j]));
                            }
                            w[2 * n] = cvt_pk_bf16(v[0], v[1]); w[2 * n + 1] = cvt_pk_bf16(v[2], v[3]);
                        }
                        *(GAS u32x4*)(rowp + bj * HALF) = w;
                    }
                }
        }
    }
};
struct EpiRes {
    const float* xin; float* xout; bf16_t* xb; float* ssn; int glu;
    __device__ __forceinline__ void operator()(const f32x4 (&acc)[2][2][4][2], const Unit& u, int wr, int wc, int fr, int fq, LAS unsigned char*, int) const {
        const int row0 = u.pm * BM + wr * 64 + fr;
        const GAS float* xi = (const GAS float*)xin; GAS float* xo = (GAS float*)xout; GAS bf16_t* xbg = (GAS bf16_t*)xb; GAS float* ssg = (GAS float*)ssn;
        if (glu) {
            const size_t cb = (size_t)u.pn * HALF + wc * 32 + 8 * fq;
#pragma unroll
            for (int ai = 0; ai < 2; ++ai) {
                f32x4 xv[4][2];
#pragma unroll
                for (int m = 0; m < 4; ++m)
#pragma unroll
                    for (int n = 0; n < 2; ++n) xv[m][n] = *(const GAS f32x4*)(xi + (size_t)(row0 + ai * HALF + m * 16) * D_ + cb + n * 4);
#pragma unroll
                for (int m = 0; m < 4; ++m) {
                    const int row = row0 + ai * HALF + m * 16; const size_t off = (size_t)row * D_ + cb;
                    float sq = 0.f; u32x4 w;
#pragma unroll
                    for (int n = 0; n < 2; ++n) {
                        const f32x4 va = acc[ai][0][m][n], ga = acc[ai][1][m][n];
                        f32x4 x4 = xv[m][n];
#pragma unroll
                        for (int j = 0; j < 4; ++j) { x4[j] += va[j] / (1.0f + __expf(-ga[j])); sq += x4[j] * x4[j]; }
                        *(GAS f32x4*)(xo + off + n * 4) = x4;
                        w[2 * n] = cvt_pk_bf16(x4[0], x4[1]); w[2 * n + 1] = cvt_pk_bf16(x4[2], x4[3]);
                    }
                    *(GAS u32x4*)(xbg + off) = w;
                    sq += __shfl_xor(sq, 16); sq += __shfl_xor(sq, 32);
                    if (fq == 0) atomicAdd((float*)ssn + (size_t)((u.pn >> 1) * 4 + wc) * T_ + row, sq);
                }
            }
        } else {
            const size_t cb = (size_t)u.pn * BM + wc * 32 + 8 * fq;
#pragma unroll
            for (int ai = 0; ai < 2; ++ai) {
                f32x4 xv[4][2][2];
#pragma unroll
                for (int m = 0; m < 4; ++m)
#pragma unroll
                    for (int bj = 0; bj < 2; ++bj)
#pragma unroll
                        for (int n = 0; n < 2; ++n) xv[m][bj][n] = *(const GAS f32x4*)(xi + (size_t)(row0 + ai * HALF + m * 16) * D_ + cb + bj * HALF + n * 4);
#pragma unroll
                for (int m = 0; m < 4; ++m) {
                    const int row = row0 + ai * HALF + m * 16; const size_t off = (size_t)row * D_ + cb;
                    float sq = 0.f;
#pragma unroll
                    for (int bj = 0; bj < 2; ++bj) {
                        u32x4 w;
#pragma unroll
                        for (int n = 0; n < 2; ++n) {
                            f32x4 x4 = xv[m][bj][n] + acc[ai][bj][m][n];
#pragma unroll
                            for (int j = 0; j < 4; ++j) sq += x4[j] * x4[j];
                            *(GAS f32x4*)(xo + off + bj * HALF + n * 4) = x4;
                            w[2 * n] = cvt_pk_bf16(x4[0], x4[1]); w[2 * n + 1] = cvt_pk_bf16(x4[2], x4[3]);
                        }
                        *(GAS u32x4*)(xbg + off + bj * HALF) = w;
                    }
                    sq += __shfl_xor(sq, 16); sq += __shfl_xor(sq, 32);
                    if (fq == 0) ssg[(size_t)(u.pn * 4 + wc) * T_ + row] = sq;
                }
            }
        }
    }
};

template <class Epi, class Sched>
__device__ __forceinline__ void gemm_phase(LAS unsigned char* lds, const Gemm g, const Sched& S, const Epi& E) {
    const int tid = otid(), wid = __builtin_amdgcn_readfirstlane(tid >> 6), lane = tid & 63, wr = wid >> 2, wc = wid & 3, fr = lane & 15, fq = lane >> 4;
    const int K = g.K, nt = K / BK;
    unsigned voffA[2], voffB[2];
#pragma unroll
    for (int i = 0; i < 2; ++i) { int R, C; stage_rc(tid * 16 + i * 8192, R, C); voffA[i] = (unsigned)(R * K + C) * 2u; voffB[i] = voffA[i]; }
    const size_t kstep = (size_t)(BK * 2);
    const size_t hstep = (size_t)HALF * K * 2;
    const size_t tstep = 2 * hstep;
    const unsigned ldsw = (unsigned)wid * 1024u;
    const int aoff = lds_byte(wr * 64 + fr, fq * 8), boff = lds_byte(wc * 32 + fr, fq * 8);
#define PG8_SA(b, h) (((b) * 2 + (h)) * HTB)
#define PG8_SB(b, h) ((4 + (b) * 2 + (h)) * HTB)
#define PG8_STAGE(bufoff, gbase, voff) do { _Pragma("unroll") for (int _i = 0; _i < 2; ++_i) \
        __builtin_amdgcn_global_load_lds((const unsigned*)((const char*)(gbase) + (voff)[_i]), (LAS unsigned*)(lds + (bufoff) + ldsw + _i * 8192), 16, 0, 0); } while (0)
#define PG8_LDA(dst, b, h) do { _Pragma("unroll") for (int m = 0; m < 4; ++m) _Pragma("unroll") for (int k = 0; k < 2; ++k) dst[m][k] = *(const LAS bf16x8*)(lds + PG8_SA(b, h) + aoff + m * 2048 + k * 1024); } while (0)
#define PG8_LDB(dst, b, h) do { _Pragma("unroll") for (int n = 0; n < 2; ++n) _Pragma("unroll") for (int k = 0; k < 2; ++k) dst[n][k] = *(const LAS bf16x8*)(lds + PG8_SB(b, h) + boff + n * 2048 + k * 1024); } while (0)
#define PG8_MMA(ai, bj, At, Bt) do { __builtin_amdgcn_s_setprio(1); _Pragma("unroll") for (int m = 0; m < 4; ++m) _Pragma("unroll") for (int n = 0; n < 2; ++n) _Pragma("unroll") for (int k = 0; k < 2; ++k) \
        acc[ai][bj][m][n] = __builtin_amdgcn_mfma_f32_16x16x32_bf16(Bt[n][k], At[m][k], acc[ai][bj][m][n], 0, 0, 0); __builtin_amdgcn_s_setprio(0); } while (0)
#define PG8_WAIT_V(n) asm volatile("s_waitcnt vmcnt(" #n ")" ::: "memory")
#define PG8_WAIT_L(n) asm volatile("s_waitcnt lgkmcnt(" #n ")" ::: "memory")
#define PG8_BAR __builtin_amdgcn_s_barrier()
#define PG8_SCHED __builtin_amdgcn_sched_barrier(0)
    Unit cur, nxt; int ui = 0;
    if (!S.next(0, cur)) return;
    f32x4 acc[2][2][4][2];
#pragma unroll
    for (int a = 0; a < 2; ++a)
#pragma unroll
        for (int b = 0; b < 2; ++b)
#pragma unroll
            for (int m = 0; m < 4; ++m)
#pragma unroll
                for (int n = 0; n < 2; ++n) acc[a][b][m][n] = (f32x4){0.f, 0.f, 0.f, 0.f};
    bf16x8 At[4][2], B0[2][2], B1[2][2];
    const char* cA = (const char*)g.A + (size_t)cur.pm * tstep; const char* cB = (const char*)g.Bt + (size_t)cur.pn * tstep;
    PG8_STAGE(PG8_SB(0, 0), cB, voffB); PG8_STAGE(PG8_SA(0, 0), cA, voffA); PG8_STAGE(PG8_SB(0, 1), cB + hstep, voffB); PG8_STAGE(PG8_SA(0, 1), cA + hstep, voffA);
    if (wr == 1) PG8_BAR;
    PG8_WAIT_V(4); PG8_BAR;
    PG8_STAGE(PG8_SB(1, 0), cB + kstep, voffB); PG8_STAGE(PG8_SA(1, 0), cA + kstep, voffA); PG8_STAGE(PG8_SB(1, 1), cB + hstep + kstep, voffB);
    PG8_WAIT_V(6); PG8_BAR;
    for (;;) {
        const bool has_next = S.next(ui + 1, nxt);
        const char* nA = has_next ? (const char*)g.A + (size_t)nxt.pm * tstep : cA; const char* nB = has_next ? (const char*)g.Bt + (size_t)nxt.pn * tstep : cB;
        for (int t = 0; t < nt; t += 2) {
            const bool last = (t == nt - 2);
            const char* a1 = cA + (size_t)(t + 1) * kstep;
            const char* a2 = last ? nA : cA + (size_t)(t + 2) * kstep; const char* b2 = last ? nB : cB + (size_t)(t + 2) * kstep;
            const char* a3 = a2 + kstep; const char* b3 = b2 + kstep;
            PG8_LDB(B0, 0, 0); PG8_SCHED; PG8_LDA(At, 0, 0); PG8_STAGE(PG8_SA(1, 1), a1 + hstep, voffA);
            PG8_WAIT_L(8); PG8_BAR; PG8_WAIT_L(0); PG8_MMA(0, 0, At, B0); PG8_BAR; PG8_SCHED;
            PG8_LDB(B1, 0, 1); PG8_STAGE(PG8_SB(0, 0), b2, voffB);
            PG8_BAR; PG8_WAIT_L(0); PG8_MMA(0, 1, At, B1); PG8_BAR;
            PG8_LDA(At, 0, 1); PG8_STAGE(PG8_SA(0, 0), a2, voffA);
            PG8_BAR; PG8_WAIT_L(0); PG8_MMA(1, 0, At, B0); PG8_BAR; PG8_SCHED;
            PG8_STAGE(PG8_SB(0, 1), b2 + hstep, voffB);
            PG8_WAIT_V(6); PG8_BAR; PG8_MMA(1, 1, At, B1); PG8_BAR;
            PG8_LDB(B0, 1, 0); PG8_SCHED; PG8_LDA(At, 1, 0); PG8_STAGE(PG8_SA(0, 1), a2 + hstep, voffA);
            PG8_WAIT_L(8); PG8_BAR; PG8_WAIT_L(0); PG8_MMA(0, 0, At, B0); PG8_BAR; PG8_SCHED;
            PG8_LDB(B1, 1, 1); PG8_STAGE(PG8_SB(1, 0), b3, voffB);
            PG8_BAR; PG8_WAIT_L(0); PG8_MMA(0, 1, At, B1); PG8_BAR;
            PG8_LDA(At, 1, 1); PG8_STAGE(PG8_SA(1, 0), a3, voffA);
            PG8_BAR; PG8_WAIT_L(0); PG8_MMA(1, 0, At, B0); PG8_BAR; PG8_SCHED;
            PG8_STAGE(PG8_SB(1, 1), b3 + hstep, voffB);
            PG8_WAIT_V(6); PG8_BAR; PG8_MMA(1, 1, At, B1); PG8_BAR;
        }
        E(acc, cur, wr, wc, fr, fq, lds, ui);
        if (!has_next) break;
#pragma unroll
        for (int a = 0; a < 2; ++a)
#pragma unroll
            for (int b = 0; b < 2; ++b)
#pragma unroll
                for (int m = 0; m < 4; ++m)
#pragma unroll
                    for (int n = 0; n < 2; ++n) acc[a][b][m][n] = (f32x4){0.f, 0.f, 0.f, 0.f};
        cur = nxt; cA = nA; cB = nB; ++ui;
    }
    PG8_WAIT_V(0);
    if (wr == 0) PG8_BAR;
    PG8_BAR;
#undef PG8_SA
#undef PG8_SB
#undef PG8_STAGE
#undef PG8_LDA
#undef PG8_LDB
#undef PG8_MMA
#undef PG8_WAIT_V
#undef PG8_WAIT_L
#undef PG8_BAR
#undef PG8_SCHED
}
}

namespace att {
constexpr int D = 128, KVBLK = 64, LDK = 6144;
constexpr float SCALE = 0.088388347648318440f;
constexpr float THR = 8.f;
constexpr size_t SHM_V = KVBLK * D * 2, SHM_K = KVBLK * D * 2;
#define KSWZ(row, colB) ((row) * 256 + ((colB) ^ (((row) & 7) << 4)))
#define SBAR() __builtin_amdgcn_sched_barrier(0)
__device__ __forceinline__ int crow(int r, int hi) { return (r & 3) + 8 * (r >> 2) + 4 * hi; }
__device__ __forceinline__ void partialSM(f32x16& p0, f32x16& p1, float& m_reg, float& mn, float& alpha, bool msk) {
    constexpr float C = SCALE * 1.4426950408889634f;
    if (msk) {
#pragma unroll
        for (int r = 0; r < 16; ++r) { p0[r] = -1e30f; p1[r] = -1e30f; }
    }
    float pmax = p0[0];
#pragma unroll
    for (int r = 1; r < 16; ++r) pmax = fmaxf(pmax, p0[r]);
#pragma unroll
    for (int r = 0; r < 16; ++r) pmax = fmaxf(pmax, p1[r]);
    { auto rr = __builtin_amdgcn_permlane32_swap(__float_as_uint(pmax), __float_as_uint(pmax), false, false);
      pmax = fmaxf(__uint_as_float(rr[0]), __uint_as_float(rr[1])); }
    if (__builtin_expect(__all(pmax - m_reg <= THR / SCALE), 1)) { mn = m_reg; alpha = 1.f; }
    else { mn = fmaxf(m_reg, pmax); alpha = __builtin_amdgcn_exp2f((m_reg - mn) * C); m_reg = mn; }
    float mnC = -mn * C;
#pragma unroll
    for (int r = 0; r < 16; ++r) p0[r] = fmaf(p0[r], C, mnC);
#pragma unroll
    for (int r = 0; r < 16; ++r) p1[r] = fmaf(p1[r], C, mnC);
#pragma unroll
    for (int r = 0; r < 16; ++r) p0[r] = __builtin_amdgcn_exp2f(p0[r]);
}
__device__ __forceinline__ void finishSM(f32x16& p0, f32x16& p1, float alpha, float& l_reg, bf16x8& pa0, bf16x8& pa1, bf16x8& pa2, bf16x8& pa3) {
#pragma unroll
    for (int r = 0; r < 16; ++r) p1[r] = __builtin_amdgcn_exp2f(p1[r]);
    float ps = 0;
#pragma unroll
    for (int r = 0; r < 16; ++r) ps += p0[r];
#pragma unroll
    for (int r = 0; r < 16; ++r) ps += p1[r];
    { auto rr = __builtin_amdgcn_permlane32_swap(__float_as_uint(ps), __float_as_uint(ps), false, false);
      ps = __uint_as_float(rr[0]) + __uint_as_float(rr[1]); }
    l_reg = l_reg * alpha + ps;
#define PK4(P, BASE, OUT) do { unsigned a0 = cvt_pk_bf16(P[BASE + 0], P[BASE + 1]), a1 = cvt_pk_bf16(P[BASE + 2], P[BASE + 3]);   \
    unsigned b0 = cvt_pk_bf16(P[BASE + 4], P[BASE + 5]), b1 = cvt_pk_bf16(P[BASE + 6], P[BASE + 7]);                              \
    auto r0 = __builtin_amdgcn_permlane32_swap(a0, b0, false, false); auto r1 = __builtin_amdgcn_permlane32_swap(a1, b1, false, false); \
    u32x4 w = {r0[0], r1[0], r0[1], r1[1]}; OUT = *reinterpret_cast<bf16x8*>(&w); } while (0)
    PK4(p0, 0, pa0); PK4(p0, 8, pa1); PK4(p1, 0, pa2); PK4(p1, 8, pa3);
#undef PK4
}
__device__ __forceinline__ void qkt(f32x16& p0, f32x16& p1, const char* Ks, const bf16x8* qr, int r32, int hi) {
    p0 = f32x16{}; p1 = f32x16{};
#pragma unroll
    for (int d0 = 0; d0 < 8; ++d0) { int cb = (d0 * 16 + hi * 8) * 2;
        bf16x8 b0 = *reinterpret_cast<const bf16x8*>(Ks + KSWZ(r32, cb));
        bf16x8 b1 = *reinterpret_cast<const bf16x8*>(Ks + KSWZ(32 + r32, cb));
        p0 = __builtin_amdgcn_mfma_f32_32x32x16_bf16(b0, qr[d0], p0, 0, 0, 0);
        p1 = __builtin_amdgcn_mfma_f32_32x32x16_bf16(b1, qr[d0], p1, 0, 0, 0); }
}
__device__ __forceinline__ int v_st(int k, int c) { const int kk = (k & ~0xC) | ((k & 4) << 1) | ((k & 8) >> 1); return ((kk >> 3) * 4 + (c >> 5)) * 512 + ((kk & 7) * 32 + (c & 31)) * 2; }
__device__ __forceinline__ int v_rd_base(int lane) { return ((lane & 3) << 3) | (((lane >> 2) & 3) << 6) | (((lane >> 4) & 1) << 5) | (((lane >> 5) & 1) << 8); }
constexpr int v_rd_off(int d0, int ks, int half) { return d0 * 512 + ks * 4096 + half * 2048; }
template <int OFF> __device__ __forceinline__ s16x4 tr_read(int vb) {
    s16x4 r; asm volatile("ds_read_b64_tr_b16 %0, %1 offset:%2" : "=&v"(r) : "v"(vb), "i"(OFF) : "memory"); return r;
}
template <int D0> __device__ __forceinline__ void pv_one(f32x16& od, int vb, bf16x8 pa0, bf16x8 pa1, bf16x8 pa2, bf16x8 pa3) {
    const s16x4 l0 = tr_read<v_rd_off(D0, 0, 0)>(vb), h0 = tr_read<v_rd_off(D0, 0, 1)>(vb), l1 = tr_read<v_rd_off(D0, 1, 0)>(vb), h1 = tr_read<v_rd_off(D0, 1, 1)>(vb);
    const s16x4 l2 = tr_read<v_rd_off(D0, 2, 0)>(vb), h2 = tr_read<v_rd_off(D0, 2, 1)>(vb), l3 = tr_read<v_rd_off(D0, 3, 0)>(vb), h3 = tr_read<v_rd_off(D0, 3, 1)>(vb);
    asm volatile("s_waitcnt lgkmcnt(0)" ::: "memory"); SBAR();
#define PK(L, H) (bf16x8){L[0], L[1], L[2], L[3], H[0], H[1], H[2], H[3]}
    od = __builtin_amdgcn_mfma_f32_32x32x16_bf16(pa0, PK(l0, h0), od, 0, 0, 0);
    od = __builtin_amdgcn_mfma_f32_32x32x16_bf16(pa1, PK(l1, h1), od, 0, 0, 0);
    od = __builtin_amdgcn_mfma_f32_32x32x16_bf16(pa2, PK(l2, h2), od, 0, 0, 0);
    od = __builtin_amdgcn_mfma_f32_32x32x16_bf16(pa3, PK(l3, h3), od, 0, 0, 0);
#undef PK
}
__device__ __forceinline__ void pv_d0(f32x16* o, int vb, bf16x8 pa0, bf16x8 pa1, bf16x8 pa2, bf16x8 pa3) {
    pv_one<0>(o[0], vb, pa0, pa1, pa2, pa3); pv_one<1>(o[1], vb, pa0, pa1, pa2, pa3); pv_one<2>(o[2], vb, pa0, pa1, pa2, pa3); pv_one<3>(o[3], vb, pa0, pa1, pa2, pa3);
}
__device__ __forceinline__ void attn_body(const bf16_t* __restrict__ Qb, const bf16_t* __restrict__ Kh, const bf16_t* __restrict__ Vh, int NT, int ntw, char* lds, f32x16 (&o)[4]) {
    const int tid = otid(), wid = __builtin_amdgcn_readfirstlane(tid >> 6), lane = tid & 63, r32 = lane & 31, hi = lane >> 5;
    char* V_lds = lds; char* K_lds = lds + 2 * SHM_V;
    float* wsf = (float*)(lds + 2 * SHM_V + 2 * SHM_K) + wid * 64; float* li_l = wsf; float* al_l = wsf + 32;
    float m_reg = -1e30f, l_reg = 0; bf16x8 qr[8];
#pragma unroll
    for (int d = 0; d < 4; ++d) o[d] = f32x16{};
    const bf16_t* Qw = Qb + (long)(wid * 32 + r32) * LDK + hi * 8;
#pragma unroll
    for (int d0 = 0; d0 < 8; ++d0) qr[d0] = *reinterpret_cast<const bf16x8*>(Qw + d0 * 16);
    const int sr = tid >> 4, sc = (tid & 15) * 8, vst0 = v_st(sr, sc), vst1 = v_st(32 + sr, sc);
    const int vb0 = (int)(uintptr_t)V_lds + v_rd_base(lane);
    struct { bf16x8 vs0, vs1, ks0, ks1; } sr_[2];
#define SLOAD(i, k0) do { sr_[i].vs0 = *reinterpret_cast<const bf16x8*>(&Vh[(long)((k0) + sr) * LDK + sc]); sr_[i].vs1 = *reinterpret_cast<const bf16x8*>(&Vh[(long)((k0) + 32 + sr) * LDK + sc]); \
    sr_[i].ks0 = *reinterpret_cast<const bf16x8*>(&Kh[(long)((k0) + sr) * LDK + sc]); sr_[i].ks1 = *reinterpret_cast<const bf16x8*>(&Kh[(long)((k0) + 32 + sr) * LDK + sc]); } while (0)
#define SWRITE(b, i) do { *(bf16x8*)(V_lds + (b) * SHM_V + vst0) = sr_[i].vs0;          \
    *(bf16x8*)(V_lds + (b) * SHM_V + vst1) = sr_[i].vs1; int kc = sc * 2;               \
    *(bf16x8*)(K_lds + (b) * SHM_K + KSWZ(sr, kc)) = sr_[i].ks0;                       \
    *(bf16x8*)(K_lds + (b) * SHM_K + KSWZ(32 + sr, kc)) = sr_[i].ks1; } while (0)
#define SWAIT() asm volatile("s_waitcnt vmcnt(4)" ::: "memory")
#define RESC(a) do { if (__any((a) < 1.f)) { if (hi == 0) al_l[r32] = (a); asm volatile("s_waitcnt lgkmcnt(0)" ::: "memory"); \
    _Pragma("unroll") for (int d = 0; d < 4; ++d) _Pragma("unroll") for (int r = 0; r < 16; ++r) o[d][r] *= al_l[crow(r, hi)]; } } while (0)
    f32x16 pA0, pA1, pB0, pB1; float mnA, mnB, alA, alB; bf16x8 pa0, pa1, pa2, pa3;
    constexpr int SE = 0, SO = 1;
    __syncthreads();
    SLOAD(SE, 0); asm volatile("s_waitcnt vmcnt(0)" ::: "memory"); SWRITE(0, SE); __syncthreads();
    qkt(pA0, pA1, K_lds, qr, r32, hi); partialSM(pA0, pA1, m_reg, mnA, alA, false);
    SLOAD(SO, KVBLK); if (2 < NT) SLOAD(SE, 2 * KVBLK);
    SWAIT(); SWRITE(1, SO); __syncthreads();
    for (int j = 1; j + 1 < NT; j += 2) {
        SBAR(); qkt(pB0, pB1, K_lds + SHM_K, qr, r32, hi);
        finishSM(pA0, pA1, alA, l_reg, pa0, pa1, pa2, pa3); SBAR();
        SLOAD(SO, (j + 2) * KVBLK); SBAR();
        pv_d0(o, vb0, pa0, pa1, pa2, pa3); partialSM(pB0, pB1, m_reg, mnB, alB, j >= ntw);
        __syncthreads(); SWAIT(); SWRITE(0, SE);
        RESC(alB); __syncthreads();
        SBAR(); qkt(pA0, pA1, K_lds, qr, r32, hi);
        finishSM(pB0, pB1, alB, l_reg, pa0, pa1, pa2, pa3); SBAR();
        if (j + 3 < NT) SLOAD(SE, (j + 3) * KVBLK); SBAR();
        pv_d0(o, vb0 + (int)SHM_V, pa0, pa1, pa2, pa3); partialSM(pA0, pA1, m_reg, mnA, alA, (j + 1) >= ntw);
        __syncthreads(); SWAIT(); SWRITE(1, SO);
        RESC(alA); __syncthreads();
    }
    SBAR(); qkt(pB0, pB1, K_lds + SHM_K, qr, r32, hi);
    finishSM(pA0, pA1, alA, l_reg, pa0, pa1, pa2, pa3); SBAR();
    pv_d0(o, vb0, pa0, pa1, pa2, pa3); partialSM(pB0, pB1, m_reg, mnB, alB, (NT - 1) >= ntw);
    __syncthreads(); RESC(alB);
    finishSM(pB0, pB1, alB, l_reg, pa0, pa1, pa2, pa3); SBAR();
    pv_d0(o, vb0 + (int)SHM_V, pa0, pa1, pa2, pa3);
    if (hi == 0) li_l[r32] = l_reg; asm volatile("s_waitcnt lgkmcnt(0)" ::: "memory");
#pragma unroll
    for (int r = 0; r < 16; ++r) { const float rl = __builtin_amdgcn_rcpf(li_l[crow(r, hi)]);
#pragma unroll
        for (int d = 0; d < 4; ++d) o[d][r] *= rl; }
#undef SLOAD
#undef SWRITE
#undef SWAIT
#undef RESC
}
}

__device__ __forceinline__ void sincos_red(double ang, float& s, float& c) {
    const double k = rint(ang * 0.15915494309189535);
    const float r = (float)(ang - k * 6.283185307179586);
    s = __sinf(r); c = __cosf(r);
}
__device__ __forceinline__ float gelu_tanh(float y) {
    const float z = 0.7978845608028654f * (y + 0.044715f * y * y * y);
    const float th = 1.0f - 2.0f / (1.0f + __expf(2.0f * z));
    return 0.5f * y * (1.0f + th);
}

struct ConvJob { const float* W; bf16_t* Wt; const float* gain; int K, N, glu, tile; };
struct ConvRegs { f32x4 va[4], vb[4]; float ga[4], gb[4]; };
__device__ __forceinline__ ConvJob conv_decode(const Params& p, unsigned char* ws, int t) {
    ConvJob j; j.glu = 0; j.gain = nullptr;
    if (t < 1536) { const int q = t / 768; j.tile = t - q * 768; j.W = p.a_w_in + (size_t)q * 2048 * 6144; j.Wt = (bf16_t*)(ws + OFF_WT_A_IN + q * SZ_A_IN); j.K = 2048; j.N = 6144; j.gain = p.norm_mix + (size_t)(3 * q) * D_; }
    else if (t < 2048) { const int u = t - 1536; const int q = u / 256; j.tile = u - q * 256; j.W = p.a_w_out + (size_t)q * 2048 * 2048; j.Wt = (bf16_t*)(ws + OFF_WT_A_OUT + q * SZ_A_OUT); j.K = 2048; j.N = 2048; }
    else if (t < 2560) { j.tile = t - 2048; j.W = p.b_w_glu; j.Wt = (bf16_t*)(ws + OFF_WT_GLU); j.K = 2048; j.N = 4096; j.glu = 1; }
    else if (t < 4096) { j.tile = t - 2560; j.W = p.c_w_in; j.Wt = (bf16_t*)(ws + OFF_WT_C_IN); j.K = 2048; j.N = 12288; j.gain = p.norm_mix + 2 * D_; }
    else if (t < 4608) { j.tile = t - 4096; j.W = p.c_w_out; j.Wt = (bf16_t*)(ws + OFF_WT_C_OUT); j.K = 4096; j.N = 2048; }
    else if (t < 8704) { const int u = t - 4608; const int i = u / 1024; j.tile = u - i * 1024; j.W = p.mlp_w1 + (size_t)i * 2048 * 8192; j.Wt = (bf16_t*)(ws + OFF_WT_W1 + i * SZ_W1); j.K = 2048; j.N = 8192; j.gain = p.norm_mlp + (size_t)i * D_; }
    else { const int u = t - 8704; const int i = u / 1024; j.tile = u - i * 1024; j.W = p.mlp_w2 + (size_t)i * 8192 * 2048; j.Wt = (bf16_t*)(ws + OFF_WT_W2 + i * SZ_W1); j.K = 8192; j.N = 2048; }
    return j;
}
__device__ __forceinline__ void conv_load(const ConvJob& j, ConvRegs& r, int tid) {
    const int ntn = j.N >> 7; const int tk = j.tile / ntn, tn = j.tile - tk * ntn; const int k0 = tk << 7, n0 = tn << 7;
    const int kp = tid >> 5, nl = (tid & 31) << 2;
#pragma unroll
    for (int i = 0; i < 4; ++i) { const int k = 2 * (kp + 16 * i);
        r.va[i] = *(const f32x4*)(j.W + (size_t)(k0 + k) * j.N + n0 + nl); r.vb[i] = *(const f32x4*)(j.W + (size_t)(k0 + k + 1) * j.N + n0 + nl);
        r.ga[i] = j.gain ? j.gain[k0 + k] : 1.f; r.gb[i] = j.gain ? j.gain[k0 + k + 1] : 1.f; }
}
__device__ __forceinline__ void conv_store(const ConvJob& j, const ConvRegs& r, int tid, unsigned* ldsw) {
    const int ntn = j.N >> 7; const int tk = j.tile / ntn, tn = j.tile - tk * ntn; const int k0 = tk << 7, n0 = tn << 7;
    const int kp = tid >> 5, nl = (tid & 31) << 2;
    __syncthreads();
#pragma unroll
    for (int i = 0; i < 4; ++i) { const int kpair = kp + 16 * i;
#pragma unroll
        for (int jj = 0; jj < 4; ++jj) ldsw[(nl + jj) * 65 + kpair] = cvt_pk_bf16(r.va[i][jj] * r.ga[i], r.vb[i][jj] * r.gb[i]); }
    __syncthreads();
    int nbase = n0;
    if (j.glu) { const int bj = n0 >> 11, pn = (n0 & 2047) >> 7; nbase = 256 * pn + 128 * bj; }
#pragma unroll
    for (int i = 0; i < 4; ++i) { const int n = (tid >> 4) + 32 * i, k8 = tid & 15;
        u32x4 w; w.x = ldsw[n * 65 + k8 * 4 + 0]; w.y = ldsw[n * 65 + k8 * 4 + 1]; w.z = ldsw[n * 65 + k8 * 4 + 2]; w.w = ldsw[n * 65 + k8 * 4 + 3];
        const int c5 = n & 31, np = (n & ~31) | (16 * ((c5 >> 2) & 1) + 4 * (c5 >> 3) + (c5 & 3));
        *(u32x4*)(j.Wt + (size_t)(nbase + np) * j.K + k0 + k8 * 8) = w; }
}

__device__ __forceinline__ void prep_phase(const Params& p, unsigned char* shm) {
    const int tid = otid(), bid = obid(), G = gridDim.x;
    unsigned char* ws = p.ws;
    {
        ConvJob jc = conv_decode(p, ws, bid); ConvRegs rc; conv_load(jc, rc, tid);
#pragma unroll 1
        for (int t = bid; t < 12800; t += G) {
            ConvJob jn = jc; ConvRegs rn = rc;
            if (t + G < 12800) { jn = conv_decode(p, ws, t + G); conv_load(jn, rn, tid); }
            conv_store(jc, rc, tid, (unsigned*)shm);
            jc = jn; rc = rn;
        }
    }
    {
        float* ss = (float*)(ws + OFF_SSP); bf16_t* xb = (bf16_t*)(ws + OFF_XB);
        const int wid = tid >> 6, lane = tid & 63;
        for (int row = bid * 8 + wid; row < T_; row += G * 8) {
            const float* xr = p.x + (size_t)row * D_; float sq = 0.f;
#pragma unroll
            for (int i = 0; i < 8; ++i) { const f32x4 v = *(const f32x4*)(xr + (i * 64 + lane) * 4);
                sq += v[0] * v[0] + v[1] * v[1] + v[2] * v[2] + v[3] * v[3];
                *(f32x4*)(p.out + (size_t)row * D_ + (i * 64 + lane) * 4) = v;
                u32x2 w; w.x = cvt_pk_bf16(v[0], v[1]); w.y = cvt_pk_bf16(v[2], v[3]);
                *(u32x2*)(xb + (size_t)row * D_ + (i * 64 + lane) * 4) = w; }
#pragma unroll
            for (int o = 32; o > 0; o >>= 1) sq += __shfl_xor(sq, o);
            if (lane < 32) ss[(size_t)lane * T_ + row] = (lane == 0) ? sq : 0.f;
        }
        for (int i = bid * 512 + tid; i < 32 * T_; i += G * 512) ss[(size_t)3 * 32 * T_ + i] = 0.f;
        float* rssq = (float*)(ws + OFF_RSQP);
        for (int i = bid * 512 + tid; i < 64 * T_; i += G * 512) rssq[i] = 0.f;
    }
    {
        float* par = (float*)(ws + OFF_PAR);
        for (int i = bid * 512 + tid; i < PAR_N; i += G * 512) {
            float v;
            if (i < PAR_NFINAL) v = p.norm_mix[D_ + i];
            else if (i < PAR_LAM) v = p.norm_final[i - PAR_NFINAL];
            else if (i < PAR_SUBLN) v = p.a_lambda[i - PAR_LAM];
            else if (i < PAR_BD) v = p.a_subln[i - PAR_SUBLN];
            else v = p.b_d[i - PAR_BD];
            par[i] = v;
        }
    }
    {
        f32x2* rot = (f32x2*)(ws + OFF_ROT);
        for (int i = bid * 512 + tid; i < 4096 * 128; i += G * 512) {
            const int pos = i >> 7, j = i & 127;
            const double inv = exp(-9.210340371976184 * ((double)j / 127.0));
            float s, c; sincos_red((double)pos * inv, s, c);
            f32x2 v; v.x = c; v.y = s; rot[i] = v;
        }
    }
    {
        bf16_t* Bm = (bf16_t*)(ws + OFF_S5B); bf16_t* Cm = (bf16_t*)(ws + OFF_S5C); f32x2* AB = (f32x2*)(ws + OFF_S5AB);
        const float* gmix = p.norm_mix + 1 * D_;
        for (int i = bid * 512 + tid; i < 128 * 64; i += G * 512) {
            const int g = i >> 6, pp = i & 63;
            const float lre = p.b_a_re[i], lim = p.b_a_im[i];
            const float dt = __expf(p.b_log_dt[g]);
            const float mag = __expf(lre * dt);
            float sn, cs; sincos_red((double)lim * (double)dt, sn, cs);
            const float abr = mag * cs, abi = mag * sn;
            const float den = lre * lre + lim * lim;
            const float nr = abr - 1.0f, ni = abi;
            const float cr_ = (nr * lre + ni * lim) / den, ci_ = (ni * lre - nr * lim) / den;
            f32x2 ab; ab.x = abr; ab.y = abi; AB[i] = ab;
#pragma unroll
            for (int c = 0; c < 16; ++c) {
                const float br = p.b_b_re[(size_t)i * 16 + c], bi = p.b_b_im[(size_t)i * 16 + c];
                const float gm = gmix[g * 16 + c];
                Bm[((size_t)g * 128 + pp) * 16 + c] = f2bf((cr_ * br - ci_ * bi) * gm);
                Bm[((size_t)g * 128 + 64 + pp) * 16 + c] = f2bf((cr_ * bi + ci_ * br) * gm);
                Cm[((size_t)g * 16 + c) * 128 + pp] = f2bf(p.b_c_re[((size_t)g * 16 + c) * 64 + pp]);
                Cm[((size_t)g * 16 + c) * 128 + 64 + pp] = f2bf(-p.b_c_im[((size_t)g * 16 + c) * 64 + pp]);
            }
        }
    }
}

__device__ __forceinline__ void attn_phase(const Params& p, int j, float lambda_init, unsigned char* shm) {
    const int tid = otid(), wid = __builtin_amdgcn_readfirstlane(tid >> 6), lane = tid & 63, r32 = lane & 31, hi = lane >> 5;
    const bf16_t* qkv = (const bf16_t*)(p.ws + OFF_BIG);
    bf16_t* oa = (bf16_t*)(p.ws + OFF_OA);
    float* scr = (float*)(p.ws + OFF_ATT_SCR) + (size_t)obid() * 2 * 32768;
    float lam;
    { const float* lp = (const float*)(p.ws + OFF_PAR) + PAR_LAM + (size_t)j * 512;
      float a = lp[lane] * lp[128 + lane] + lp[64 + lane] * lp[192 + lane];
      float b = lp[256 + lane] * lp[384 + lane] + lp[320 + lane] * lp[448 + lane];
#pragma unroll
      for (int o = 32; o > 0; o >>= 1) { a += __shfl_xor(a, o); b += __shfl_xor(b, o); }
      lam = __expf(a) - __expf(b) + lambda_init; lam = __uint_as_float(__builtin_amdgcn_readfirstlane(__float_as_uint(lam))); }
    const float* sub = (const float*)(p.ws + OFF_PAR) + PAR_SUBLN + (size_t)j * 256;
    const int c = obid(); const int xcd = c & 7, jj = c >> 3;
    const int bh = xcd * 4 + (jj >> 3), pi = jj & 7;
    const int b = bh >> 3, h = bh & 7;
#pragma unroll 1
    for (int it = 0; it < 2; ++it) {
        const int qb = it == 0 ? (15 - pi) : pi;
        const int NT = 4 * qb + 4, ntw = 4 * qb + (wid >> 1) + 1;
        const size_t tok0 = (size_t)b * S_ + (size_t)qb * 256;
        f32x16 o[4];
#pragma unroll 1
        for (int ps = 0; ps < 4; ++ps) {
            const int e = ps >> 1, t = ps & 1;
            float* sc = scr + e * 32768;
            att::attn_body(qkv + tok0 * 6144 + h * 256 + t * 128, qkv + (size_t)b * S_ * 6144 + 2048 + h * 256 + t * 128,
                           qkv + (size_t)b * S_ * 6144 + 4096 + h * 256 + e * 128, NT, ntw, (char*)shm, o);
            if (t == 0) {
#pragma unroll
                for (int d = 0; d < 4; ++d)
#pragma unroll
                    for (int r = 0; r < 16; ++r) sc[tid * 64 + d * 16 + r] = o[d][r];
            } else {
#pragma unroll
                for (int d = 0; d < 4; ++d)
#pragma unroll
                    for (int r = 0; r < 16; ++r) { const float cv = sc[tid * 64 + d * 16 + r] - lam * o[d][r]; o[d][r] = cv; if (e == 0) sc[tid * 64 + d * 16 + r] = cv; }
            }
        }
        float ssq[16];
#pragma unroll
        for (int r = 0; r < 16; ++r) { float s = 0.f;
#pragma unroll
            for (int d = 0; d < 4; ++d) { const float c0 = scr[tid * 64 + d * 16 + r]; s += c0 * c0 + o[d][r] * o[d][r]; }
#pragma unroll
            for (int of = 16; of > 0; of >>= 1) s += __shfl_xor(s, of);
            ssq[r] = rsqrtf(s * (1.0f / 256.0f) + EPS_) * (1.0f - lambda_init); }
#pragma unroll
        for (int r = 0; r < 16; ++r) {
            const size_t row = tok0 + wid * 32 + att::crow(r, hi);
            bf16_t* op = oa + row * D_ + h * 256;
#pragma unroll
            for (int d = 0; d < 4; ++d) {
                const int col = d * 32 + r32;
                op[col] = f2bf(scr[tid * 64 + d * 16 + r] * ssq[r] * sub[col]);
                op[128 + col] = f2bf(o[d][r] * ssq[r] * sub[128 + col]);
            }
        }
    }
}

template <bool FINAL>
__device__ __forceinline__ void s5_phase(const Params& p, unsigned char* shm) {
    const int tid = otid(), wid = tid >> 6, lane = tid & 63, r32 = lane & 31, hi = lane >> 5, fr = lane & 15, fq = lane >> 4;
    const bf16_t* xb = (const bf16_t*)(p.ws + OFF_XB);
    const float* ss = (const float*)(p.ws + OFF_SSP) + (size_t)2 * 32 * T_;
    float* rsfin = (float*)(p.ws + OFF_RSFIN);
    const bf16_t* Bm = (const bf16_t*)(p.ws + OFF_S5B); const bf16_t* Cm = (const bf16_t*)(p.ws + OFF_S5C); const f32x2* AB = (const f32x2*)(p.ws + OFF_S5AB);
    f32x2* E = (f32x2*)(p.ws + OFF_BIG);
    bf16_t* gl = (bf16_t*)(p.ws + OFF_OA);
    bf16_t* Xs = (bf16_t*)shm + wid * (32 * 136);
    const float* gmix = (const float*)(p.ws + OFF_PAR) + PAR_GMIX; const float* dsk = (const float*)(p.ws + OFF_PAR) + PAR_BD;
    float* partL = (float*)(shm + 8 * 8704); float* rsL = partL + 512;
#pragma unroll 1
    for (int bc = obid(); bc < 256; bc += gridDim.x) {
      const int chunk = bc & 63, b = bc >> 6;
      const size_t t0 = (size_t)b * S_ + chunk * 64;
      __syncthreads();
      if (FINAL) { if (tid < 64) rsL[tid] = rsfin[t0 + tid]; }
      else {
          { const int row = tid & 63, part = tid >> 6; float a = 0.f;
#pragma unroll
            for (int k = 0; k < 4; ++k) a += ss[(size_t)(part * 4 + k) * T_ + t0 + row];
            partL[part * 64 + row] = a; }
          __syncthreads();
          if (tid < 64) { float tot = 0.f;
#pragma unroll
              for (int k = 0; k < 8; ++k) tot += partL[k * 64 + tid];
              const float r = rsqrtf(tot * (1.0f / D_) + EPS_); rsL[tid] = r; rsfin[t0 + tid] = r; }
      }
      __syncthreads();
#pragma unroll 1
      for (int goct = 0; goct < 16; ++goct) {
        const int g = goct * 8 + wid; const int pp = r32 + 32 * hi;
        const f32x2 ab = AB[g * 64 + pp];
        bf16x8 bfr[4];
#pragma unroll
        for (int nb = 0; nb < 4; ++nb) bfr[nb] = *(const bf16x8*)(Bm + ((size_t)g * 128 + nb * 32 + r32) * 16 + hi * 8);
        float xr = 0.f, xi = 0.f;
        bf16x8 cfr[4]; float gm4[4], ds4[4];
        if (FINAL) {
            { const f32x2 cin = E[((size_t)(b * 128 + g) * 64 + chunk) * 64 + pp]; xr = cin.x; xi = cin.y; }
#pragma unroll
            for (int ks = 0; ks < 4; ++ks) cfr[ks] = *(const bf16x8*)(Cm + ((size_t)g * 16 + fr) * 128 + ks * 32 + fq * 8);
#pragma unroll
            for (int jx = 0; jx < 4; ++jx) { gm4[jx] = gmix[g * 16 + 4 * fq + jx]; ds4[jx] = dsk[g * 16 + 4 * fq + jx]; }
        }
#pragma unroll
        for (int half = 0; half < 2; ++half) {
            const size_t trow = t0 + half * 32 + r32;
            const float rs = rsL[half * 32 + r32];
            const u32x4 raw = *(const u32x4*)(xb + trow * D_ + g * 16 + hi * 8);
            u32x4 sc4;
            sc4.x = cvt_pk_bf16(bflo(raw.x) * rs, bfhi(raw.x) * rs); sc4.y = cvt_pk_bf16(bflo(raw.y) * rs, bfhi(raw.y) * rs);
            sc4.z = cvt_pk_bf16(bflo(raw.z) * rs, bfhi(raw.z) * rs); sc4.w = cvt_pk_bf16(bflo(raw.w) * rs, bfhi(raw.w) * rs);
            const bf16x8 afr = *reinterpret_cast<const bf16x8*>(&sc4);
            f32x16 c0 = __builtin_amdgcn_mfma_f32_32x32x16_bf16(afr, bfr[0], f32x16{}, 0, 0, 0);
            f32x16 c1 = __builtin_amdgcn_mfma_f32_32x32x16_bf16(afr, bfr[1], f32x16{}, 0, 0, 0);
            f32x16 c2 = __builtin_amdgcn_mfma_f32_32x32x16_bf16(afr, bfr[2], f32x16{}, 0, 0, 0);
            f32x16 c3 = __builtin_amdgcn_mfma_f32_32x32x16_bf16(afr, bfr[3], f32x16{}, 0, 0, 0);
#pragma unroll
            for (int i = 0; i < 16; ++i) {
                auto r0 = __builtin_amdgcn_permlane32_swap(__float_as_uint(c0[i]), __float_as_uint(c1[i]), false, false);
                c0[i] = __uint_as_float(r0[0]); c1[i] = __uint_as_float(r0[1]);
                auto r1 = __builtin_amdgcn_permlane32_swap(__float_as_uint(c2[i]), __float_as_uint(c3[i]), false, false);
                c2[i] = __uint_as_float(r1[0]); c3[i] = __uint_as_float(r1[1]);
            }
#pragma unroll
            for (int t = 0; t < 32; ++t) {
                const int q = t >> 3, s = t & 7, idx = 4 * q + (s & 3);
                const float bur = (s < 4) ? c0[idx] : c1[idx], bui = (s < 4) ? c2[idx] : c3[idx];
                const float nr = ab.x * xr - ab.y * xi + bur, ni = ab.x * xi + ab.y * xr + bui;
                xr = nr; xi = ni;
                if (FINAL) { Xs[t * 136 + pp] = f2bf(xr); Xs[t * 136 + 64 + pp] = f2bf(xi); }
            }
            if (FINAL) {
                asm volatile("s_waitcnt lgkmcnt(0)" ::: "memory");
#pragma unroll
                for (int m = 0; m < 2; ++m) {
                    f32x4 acc = {0.f, 0.f, 0.f, 0.f};
#pragma unroll
                    for (int ks = 0; ks < 4; ++ks) {
                        const bf16x8 xf = *(const bf16x8*)(Xs + (m * 16 + fr) * 136 + ks * 32 + fq * 8);
                        acc = __builtin_amdgcn_mfma_f32_16x16x32_bf16(cfr[ks], xf, acc, 0, 0, 0);
                    }
                    const size_t tr2 = t0 + half * 32 + m * 16 + fr;
                    const float rs2 = rsL[half * 32 + m * 16 + fr];
                    const u32x2 hx = *(const u32x2*)(xb + tr2 * D_ + g * 16 + 4 * fq);
                    const float h0 = bflo(hx.x) * rs2 * gm4[0], h1 = bfhi(hx.x) * rs2 * gm4[1], h2 = bflo(hx.y) * rs2 * gm4[2], h3 = bfhi(hx.y) * rs2 * gm4[3];
                    const float y0 = gelu_tanh(acc[0] + ds4[0] * h0), y1 = gelu_tanh(acc[1] + ds4[1] * h1), y2 = gelu_tanh(acc[2] + ds4[2] * h2), y3 = gelu_tanh(acc[3] + ds4[3] * h3);
                    u32x2 w; w.x = cvt_pk_bf16(y0, y1); w.y = cvt_pk_bf16(y2, y3);
                    *(u32x2*)(gl + tr2 * D_ + g * 16 + 4 * fq) = w;
                }
                asm volatile("s_waitcnt lgkmcnt(0)" ::: "memory");
            }
        }
        if (!FINAL) { f32x2 e; e.x = xr; e.y = xi; E[((size_t)(b * 128 + g) * 64 + chunk) * 64 + pp] = e; }
      }
    }
}

__device__ __forceinline__ void s5_scan_phase(const Params& p) {
    const int tid = otid(), bid = obid();
    if (tid >= 128) return;
    f32x2* E = (f32x2*)(p.ws + OFF_BIG); const f32x2* AB = (const f32x2*)(p.ws + OFF_S5AB);
    for (int seq = bid * 128 + tid; seq < 4 * 128 * 64; seq += gridDim.x * 128) {
        const int pp = seq & 63, bg = seq >> 6, g = bg & 127;
        const f32x2 ab = AB[g * 64 + pp];
        float pr = ab.x, pi_ = ab.y;
#pragma unroll
        for (int k = 0; k < 6; ++k) { const float nr = pr * pr - pi_ * pi_, ni = 2.f * pr * pi_; pr = nr; pi_ = ni; }
        f32x2* Ep = E + (size_t)bg * 64 * 64 + pp;
        float xr = 0.f, xi = 0.f;
#pragma unroll 1
        for (int c0 = 0; c0 < 64; c0 += 16) {
            f32x2 e[16];
#pragma unroll
            for (int k = 0; k < 16; ++k) e[k] = Ep[(size_t)(c0 + k) * 64];
#pragma unroll
            for (int k = 0; k < 16; ++k) { f32x2 x; x.x = xr; x.y = xi; Ep[(size_t)(c0 + k) * 64] = x;
                const float nr = pr * xr - pi_ * xi + e[k].x, ni = pr * xi + pi_ * xr + e[k].y; xr = nr; xi = ni; }
        }
    }
}

__device__ __forceinline__ void ret_phase(const Params& p, unsigned char* shm, float* rssq) {
    const int tid = otid(), wid = tid >> 6, lane = tid & 63, fr = lane & 15, fq = lane >> 4;
    const bf16_t* ret = (const bf16_t*)(p.ws + OFF_BIG);
    bf16_t* ao = (bf16_t*)(p.ws + OFF_OA);
    constexpr int QS = 264, TS = 72;
    bf16_t* Qs = (bf16_t*)shm; bf16_t* Ks = Qs + 64 * QS; bf16_t* KTs = Ks + 64 * QS; bf16_t* VTs = KTs + 256 * TS; bf16_t* Ss = VTs + 64 * TS; bf16_t* RTs = Ss + 64 * TS;
    const int c = obid(); const int xcd = c & 7, jj = c >> 3;
    const int bh = xcd * 4 + (jj >> 3), sl = jj & 7;
    const int b = bh >> 3, h = bh & 7;
    const float lg = logf(1.0f - exp2f(-5.0f - (float)h));
    const float cdec = __expf(lg * 64.0f);
    const int mi = wid >> 1, ni0 = 2 * (wid & 1);
    const float qdec = __expf(lg * (float)(16 * mi + fr + 1));
    float idec[2][4];
#pragma unroll
    for (int t = 0; t < 2; ++t)
#pragma unroll
        for (int j = 0; j < 4; ++j) { const int n = 16 * mi + fr, m = 16 * (ni0 + t) + 4 * fq + j; idec[t][j] = __expf(lg * (fabsf((float)(n - m)) - (float)(63 - m))); }
    f32x4 R[4][2];
#pragma unroll
    for (int a = 0; a < 4; ++a)
#pragma unroll
        for (int d = 0; d < 2; ++d) R[a][d] = (f32x4){0.f, 0.f, 0.f, 0.f};
    const size_t tokb = (size_t)b * S_;
    const bf16_t* qsrc = ret + (tokb + lane) * 12288 + h * 256 + wid * 32;
    const bf16_t* ksrc = qsrc + 2048;
    const bf16_t* vsrc = ret + (tokb + lane) * 12288 + 4096 + h * 512 + sl * 64 + wid * 8;
    u32x4 pq[4], pk[4], pv; u32x2 pg[2], cg2[2];
    const bf16_t* gsrc = ret + (tokb + 16 * mi + fr) * 12288 + 8192 + h * 512 + sl * 64 + 16 * ni0 + 4 * fq;
#pragma unroll
    for (int j = 0; j < 4; ++j) { pq[j] = *(const u32x4*)(qsrc + j * 8); pk[j] = *(const u32x4*)(ksrc + j * 8); }
    pv = *(const u32x4*)vsrc;
    pg[0] = *(const u32x2*)gsrc; pg[1] = *(const u32x2*)(gsrc + 16);
    for (int ch = 0; ch < 64; ++ch) {
        __syncthreads();
        cg2[0] = pg[0]; cg2[1] = pg[1];
#pragma unroll
        for (int j = 0; j < 4; ++j) {
            *(u32x4*)(Qs + lane * QS + wid * 32 + j * 8) = pq[j];
            *(u32x4*)(Ks + lane * QS + wid * 32 + j * 8) = pk[j];
            const unsigned kw[4] = {pk[j].x, pk[j].y, pk[j].z, pk[j].w};
#pragma unroll
            for (int i = 0; i < 4; ++i) {
                KTs[(wid * 32 + j * 8 + 2 * i) * TS + lane] = (bf16_t)(kw[i] & 0xffffu);
                KTs[(wid * 32 + j * 8 + 2 * i + 1) * TS + lane] = (bf16_t)(kw[i] >> 16);
            }
        }
        { const unsigned vw[4] = {pv.x, pv.y, pv.z, pv.w};
#pragma unroll
          for (int i = 0; i < 4; ++i) { VTs[(wid * 8 + 2 * i) * TS + lane] = (bf16_t)(vw[i] & 0xffffu); VTs[(wid * 8 + 2 * i + 1) * TS + lane] = (bf16_t)(vw[i] >> 16); } }
#pragma unroll
        for (int ei = 0; ei < 4; ++ei)
#pragma unroll
            for (int di = 0; di < 2; ++di) { u32x2 w; w.x = cvt_pk_bf16(R[ei][di][0], R[ei][di][1]); w.y = cvt_pk_bf16(R[ei][di][2], R[ei][di][3]);
                *(u32x2*)(RTs + (16 * ei + fr) * QS + wid * 32 + 16 * di + 4 * fq) = w; }
        if (ch + 1 < 64) {
            const size_t adv = (size_t)(ch + 1) * 64 * 12288;
#pragma unroll
            for (int j = 0; j < 4; ++j) { pq[j] = *(const u32x4*)(qsrc + adv + j * 8); pk[j] = *(const u32x4*)(ksrc + adv + j * 8); }
            pv = *(const u32x4*)(vsrc + adv);
            pg[0] = *(const u32x2*)(gsrc + adv); pg[1] = *(const u32x2*)(gsrc + adv + 16);
        }
        __syncthreads();
        bf16x8 qa[8];
        {
            f32x4 sacc[2] = {{0.f, 0.f, 0.f, 0.f}, {0.f, 0.f, 0.f, 0.f}};
#pragma unroll
            for (int ks = 0; ks < 8; ++ks) qa[ks] = *(const bf16x8*)(Qs + (16 * mi + fr) * QS + ks * 32 + fq * 8);
#pragma unroll
            for (int ks = 0; ks < 8; ++ks) {
#pragma unroll
                for (int t = 0; t < 2; ++t) { const bf16x8 bf = *(const bf16x8*)(Ks + (16 * (ni0 + t) + fr) * QS + ks * 32 + fq * 8);
                    sacc[t] = __builtin_amdgcn_mfma_f32_16x16x32_bf16(bf, qa[ks], sacc[t], 0, 0, 0); }
            }
#pragma unroll
            for (int t = 0; t < 2; ++t) { u32x2 w; w.x = cvt_pk_bf16(sacc[t][0] * idec[t][0], sacc[t][1] * idec[t][1]); w.y = cvt_pk_bf16(sacc[t][2] * idec[t][2], sacc[t][3] * idec[t][3]);
                *(u32x2*)(Ss + (16 * mi + fr) * TS + 16 * (ni0 + t) + 4 * fq) = w; }
        }
        __syncthreads();
        {
            f32x4 oi[2] = {{0.f, 0.f, 0.f, 0.f}, {0.f, 0.f, 0.f, 0.f}}, oc[2] = {{0.f, 0.f, 0.f, 0.f}, {0.f, 0.f, 0.f, 0.f}};
#pragma unroll
            for (int ks = 0; ks < 2; ++ks) {
                const bf16x8 af = *(const bf16x8*)(Ss + (16 * mi + fr) * TS + ks * 32 + fq * 8);
#pragma unroll
                for (int t = 0; t < 2; ++t) { const bf16x8 bf = *(const bf16x8*)(VTs + (16 * (ni0 + t) + fr) * TS + ks * 32 + fq * 8);
                    oi[t] = __builtin_amdgcn_mfma_f32_16x16x32_bf16(bf, af, oi[t], 0, 0, 0); }
            }
#pragma unroll
            for (int ks = 0; ks < 8; ++ks) {
#pragma unroll
                for (int t = 0; t < 2; ++t) { const bf16x8 bf = *(const bf16x8*)(RTs + (16 * (ni0 + t) + fr) * QS + ks * 32 + fq * 8);
                    oc[t] = __builtin_amdgcn_mfma_f32_16x16x32_bf16(bf, qa[ks], oc[t], 0, 0, 0); }
            }
            const size_t tok = tokb + (size_t)ch * 64 + 16 * mi + fr;
            float sq = 0.f;
#pragma unroll
            for (int t = 0; t < 2; ++t) {
                const int e = sl * 64 + 16 * (ni0 + t) + 4 * fq;
                const u32x2 gw = cg2[t];
                f32x4 ov = oi[t] + oc[t] * qdec;
                sq += ov[0] * ov[0] + ov[1] * ov[1] + ov[2] * ov[2] + ov[3] * ov[3];
                u32x2 w; w.x = cvt_pk_bf16(ov[0] * bflo(gw.x), ov[1] * bfhi(gw.x)); w.y = cvt_pk_bf16(ov[2] * bflo(gw.y), ov[3] * bfhi(gw.y));
                *(u32x2*)(ao + tok * 4096 + h * 512 + e) = w;
            }
            sq += __shfl_xor(sq, 16); sq += __shfl_xor(sq, 32);
            if (fq == 0) atomicAdd(rssq + (size_t)(sl * 4 + mi) * 0 + (size_t)sl * (T_ * 8) + tok * 8 + h, sq);
        }
#pragma unroll
        for (int ei = 0; ei < 4; ++ei)
#pragma unroll
            for (int di = 0; di < 2; ++di) R[ei][di] *= cdec;
#pragma unroll
        for (int ks = 0; ks < 2; ++ks) {
            bf16x8 bfk[2];
#pragma unroll
            for (int di = 0; di < 2; ++di) bfk[di] = *(const bf16x8*)(KTs + (wid * 32 + 16 * di + fr) * TS + ks * 32 + fq * 8);
#pragma unroll
            for (int ei = 0; ei < 4; ++ei) { const bf16x8 af = *(const bf16x8*)(VTs + (16 * ei + fr) * TS + ks * 32 + fq * 8);
#pragma unroll
                for (int di = 0; di < 2; ++di) R[ei][di] = __builtin_amdgcn_mfma_f32_16x16x32_bf16(bfk[di], af, R[ei][di], 0, 0, 0); }
        }
    }
}

__device__ __forceinline__ void ret2_phase(const Params& p) {
    bf16_t* ao = (bf16_t*)(p.ws + OFF_OA); const float* rssq = (const float*)(p.ws + OFF_RSQP);
    const size_t nvec = (size_t)T_ * 4096 / 8;
    for (size_t i = (size_t)obid() * 512 + otid(); i < nvec; i += (size_t)gridDim.x * 512) {
        const size_t t = i >> 9; const int hh = (int)((i & 511) >> 6);
        float rsum = 0.f;
#pragma unroll
        for (int sl = 0; sl < 8; ++sl) rsum += rssq[(size_t)sl * (T_ * 8) + t * 8 + hh];
        const float rs = rsqrtf(rsum * (1.0f / 512.0f) + EPS_);
        u32x4 w = *(u32x4*)(ao + i * 8);
        w.x = cvt_pk_bf16(bflo(w.x) * rs, bfhi(w.x) * rs); w.y = cvt_pk_bf16(bflo(w.y) * rs, bfhi(w.y) * rs);
        w.z = cvt_pk_bf16(bflo(w.z) * rs, bfhi(w.z) * rs); w.w = cvt_pk_bf16(bflo(w.w) * rs, bfhi(w.w) * rs);
        *(u32x4*)(ao + i * 8) = w;
    }
}

__device__ __forceinline__ void final_phase(const Params& p) {
    const float* ss = (const float*)(p.ws + OFF_SSP) + (size_t)8 * 32 * T_;
    const int tid = otid();
    const f32x4 g = *(const f32x4*)((const float*)(p.ws + OFF_PAR) + PAR_NFINAL + tid * 4);
    for (int row = obid(); row < T_; row += gridDim.x) {
        float ssum = ss[(size_t)(tid & 31) * T_ + row];
#pragma unroll
        for (int o = 16; o > 0; o >>= 1) ssum += __shfl_xor(ssum, o);
        const float rs = rsqrtf(ssum * (1.0f / D_) + EPS_);
        f32x4 v = *(f32x4*)(p.out + (size_t)row * D_ + tid * 4);
        v = v * rs * g;
        *(f32x4*)(p.out + (size_t)row * D_ + tid * 4) = v;
    }
}

enum { OP_PREP = 0, OP_A_IN, OP_ATTN, OP_A_OUT, OP_S5A, OP_S5C, OP_GLU, OP_C_IN, OP_RET, OP_RET2, OP_C_OUT, OP_W1, OP_W2, OP_FINAL, OP_S5B };
#ifndef PHMASK
#define PHMASK 0xffff
#endif
#define PHON(b) ((PHMASK >> (b)) & 1)
constexpr int NPH = 24;
__device__ const unsigned char PROG_OP[NPH] = { OP_PREP,
    OP_A_IN, OP_ATTN, OP_A_OUT, OP_W1, OP_W2,
    OP_S5A, OP_S5B, OP_S5C, OP_GLU, OP_W1, OP_W2,
    OP_C_IN, OP_RET, OP_RET2, OP_C_OUT, OP_W1, OP_W2,
    OP_A_IN, OP_ATTN, OP_A_OUT, OP_W1, OP_W2,
    OP_FINAL };
__device__ const unsigned char PROG_LAYER[NPH] = { 0, 0, 0, 0, 0, 0, 1, 1, 1, 1, 1, 1, 2, 2, 2, 2, 2, 2, 3, 3, 3, 3, 3, 3 };

struct GemmDesc { unsigned long long a_off, b_off; int N, K, ss_idx, mode; };
#define GD_NONE {0, 0, 0, 0, 0, 0}
#define GD_A_IN(L)  {OFF_XB, OFF_WT_A_IN + (L / 3) * SZ_A_IN, 6144, 2048, 2 * L, 0}
#define GD_A_OUT(L) {OFF_OA, OFF_WT_A_OUT + (L / 3) * SZ_A_OUT, 2048, 2048, 2 * L + 1, 0}
#define GD_W1(L)    {OFF_XB, OFF_WT_W1 + L * SZ_W1, 8192, 2048, 2 * L + 1, 1}
#define GD_W2(L)    {OFF_BIG, OFF_WT_W2 + L * SZ_W1, 2048, 8192, 2 * L + 2, 0}
#define GD_GLU(L)   {OFF_OA, OFF_WT_GLU, 4096, 2048, 2 * L + 1, 1}
#define GD_C_IN(L)  {OFF_XB, OFF_WT_C_IN, 12288, 2048, 2 * L, 2}
#define GD_C_OUT(L) {OFF_OA, OFF_WT_C_OUT, 2048, 4096, 2 * L + 1, 0}
__device__ const GemmDesc GD[NPH] = { GD_NONE,
    GD_A_IN(0ull), GD_NONE, GD_A_OUT(0ull), GD_W1(0ull), GD_W2(0ull),
    GD_NONE, GD_NONE, GD_NONE, GD_GLU(1ull), GD_W1(1ull), GD_W2(1ull),
    GD_C_IN(2ull), GD_NONE, GD_NONE, GD_C_OUT(2ull), GD_W1(2ull), GD_W2(2ull),
    GD_A_IN(3ull), GD_NONE, GD_A_OUT(3ull), GD_W1(3ull), GD_W2(3ull),
    GD_NONE };

#define XB_TMO      128
#define XB_XCNT(j)  (256  + 64 * (j))
#define XB_XSUB(j)  (1280 + 64 * (j))
#define XB_XGEN(j)  (2304 + 64 * (j))
#define XB_TOP      3328
#define XB_TOPGEN   3392
#define XCD_BAR_WORDS 3456
#define XB_SPIN_CAP (1u << 22)
__device__ __forceinline__ unsigned xb_ld(unsigned* p)              { return __hip_atomic_load(p, __ATOMIC_RELAXED, __HIP_MEMORY_SCOPE_AGENT); }
__device__ __forceinline__ unsigned xb_add(unsigned* p, unsigned v) { return __hip_atomic_fetch_add(p, v, __ATOMIC_RELAXED, __HIP_MEMORY_SCOPE_AGENT); }
__device__ __forceinline__ unsigned xb_xcc_id() { return (unsigned)__builtin_amdgcn_s_getreg((3 << 11) | 20) & 0xFu; }
#define XB_SPIN(cond, bar) do { unsigned _sp = 0; while (cond) { __builtin_amdgcn_s_sleep(1); \
    if ((++_sp & 255u) == 0u) { if (xb_ld(&(bar)[XB_TMO])) break; if (_sp > XB_SPIN_CAP) { atomicAdd(&(bar)[XB_TMO], 1u); break; } } } } while (0)
struct XcdBarrier { unsigned* bar; unsigned x; volatile LAS unsigned* st; };
__device__ __forceinline__ XcdBarrier xcd_barrier_post(unsigned* bar, volatile LAS unsigned* st) {
    XcdBarrier b; b.bar = bar; b.x = xb_xcc_id(); b.st = st;
    if (threadIdx.x == 0) (void)xb_add(&bar[XB_XCNT(b.x)], 1u);
    return b;
}
__device__ __forceinline__ void xcd_barrier_complete(unsigned* bar, unsigned x, unsigned& nloc, unsigned& nx) {
    const unsigned G = gridDim.x * gridDim.y * gridDim.z;
    unsigned sum, cnt, mine, sp = 0u;
    for (;;) {
        sum = 0u; cnt = 0u; mine = 0u;
#pragma unroll
        for (unsigned j = 0; j < 16; ++j) { const unsigned c = xb_ld(&bar[XB_XCNT(j)]); sum += c; cnt += (c > 0u) ? 1u : 0u; mine = (j == x) ? c : mine; }
        if (sum == G) break;
        __builtin_amdgcn_s_sleep(1);
        if ((++sp & 255u) == 0u) { if (xb_ld(&bar[XB_TMO])) break; if (sp > XB_SPIN_CAP) { atomicAdd(&bar[XB_TMO], 1u); break; } }
    }
    nloc = mine > 0u ? mine : 1u; nx = cnt > 0u ? cnt : 1u;
}
__device__ __forceinline__ void xcd_barrier(unsigned char* ws, unsigned char* shm) {
    XcdBarrier b; b.bar = (unsigned*)(ws + OFF_BAR); b.x = xb_xcc_id(); b.st = (volatile LAS unsigned*)((LAS unsigned char*)shm + LDS_PHASE_BYTES);
    asm volatile("s_waitcnt vmcnt(0) lgkmcnt(0)" ::: "memory");
    __syncthreads();
    if (threadIdx.x == 0) {
        unsigned* bar = b.bar;
        __builtin_amdgcn_s_waitcnt(0);
        unsigned nloc = b.st[0], nx = b.st[1];
        if (nloc == 0u) { xcd_barrier_complete(bar, b.x, nloc, nx); b.st[0] = nloc; b.st[1] = nx; }
        const unsigned old = xb_add(&bar[XB_XSUB(b.x)], 1u);
        const unsigned gen = old / nloc;
        if (old + 1u == (gen + 1u) * nloc) {
            __builtin_amdgcn_fence(__ATOMIC_RELEASE, "agent");
            asm volatile("s_waitcnt vmcnt(0)" ::: "memory");
            const unsigned og = xb_add(&bar[XB_TOP], 1u);
            const unsigned tg = og / nx;
            if (og + 1u == (tg + 1u) * nx) xb_add(&bar[XB_TOPGEN], 1u);
            else XB_SPIN(xb_ld(&bar[XB_TOPGEN]) == tg, bar);
            __builtin_amdgcn_fence(__ATOMIC_ACQUIRE, "agent");
            xb_add(&bar[XB_XGEN(b.x)], 1u);
            asm volatile("s_waitcnt vmcnt(0)" ::: "memory");
        } else {
            XB_SPIN(xb_ld(&bar[XB_XGEN(b.x)]) == gen, bar);
            __builtin_amdgcn_fence(__ATOMIC_ACQUIRE, "agent");
            asm volatile("s_waitcnt vmcnt(0)" ::: "memory");
        }
    }
    __syncthreads();
}
__device__ __forceinline__ void gsync_cg(cg::grid_group& grid) {
    asm volatile("s_waitcnt vmcnt(0) lgkmcnt(0)" ::: "memory");
    grid.sync();
    __builtin_amdgcn_fence(__ATOMIC_ACQUIRE, "agent");
    asm volatile("s_waitcnt vmcnt(0) lgkmcnt(0)" ::: "memory");
}

__global__ void __launch_bounds__(512, 2) fwd_megakernel(Params p, int ph_lo, int ph_hi) {
    extern __shared__ __attribute__((aligned(16))) unsigned char shm[];
    cg::grid_group grid = cg::this_grid();
    volatile LAS unsigned* xst = (volatile LAS unsigned*)((LAS unsigned char*)shm + LDS_PHASE_BYTES);
    if (threadIdx.x == 0) { xst[0] = 0u; xst[1] = 0u; }
    __syncthreads();
    (void)xcd_barrier_post((unsigned*)(p.ws + OFF_BAR), xst);
#ifndef DUPMASK
#define DUPMASK 0
#endif
    if (PHON(0) && ph_lo == 0) {
#pragma unroll 1
        for (int rp_ = 0; rp_ < ((DUPMASK & 1) ? 2 : 1); ++rp_) { prep_phase(p, shm); if (ph_hi > 1) gsync_cg(grid); } }
    for (int ph = (ph_lo < 1 ? 1 : ph_lo); ph < ph_hi; ++ph) {
        const int op = PROG_OP[ph], L = PROG_LAYER[ph];
        const int nrep_ = ((DUPMASK >> op) & 1) ? 2 : 1;
#pragma unroll 1
        for (int rp_ = 0; rp_ < nrep_; ++rp_) {
        unsigned char* ws = p.ws; asm volatile("" : "+s"(ws));
        float* ssb = (float*)(ws + OFF_SSP);
        if (PHON(1) && (op == OP_A_IN || op == OP_C_IN || op == OP_W1)) {
            const GemmDesc gd = GD[ph];
            pg8::Gemm g; g.A = (const bf16_t*)(ws + gd.a_off); g.Bt = (const bf16_t*)(ws + gd.b_off); g.M = T_; g.N = gd.N; g.K = gd.K;
            pg8::EpiBf E; E.rot = (const f32x2*)(ws + OFF_ROT); E.O = (bf16_t*)(ws + OFF_BIG); E.ldc = gd.N; E.mode = gd.mode; E.ss = ssb + (size_t)gd.ss_idx * 32 * T_;
            pg8::StaticOrder S; S.init(g.M, g.N, (int)gridDim.x, obid());
            {
                float* lrs = (float*)(shm + pg8::STAGE_BYTES); const int tid2 = otid();
                int nun = 0; { pg8::Unit uu; while (nun < 24 && S.next(nun, uu)) ++nun; }
                for (int j = tid2; j < nun * 256; j += 512) { pg8::Unit uu; S.next(j >> 8, uu);
                    const float* sp = E.ss + (size_t)uu.pm * 256 + (j & 255); float a = 0.f;
#pragma unroll 8
                    for (int sl = 0; sl < 32; ++sl) a += sp[(size_t)sl * T_];
                    lrs[j] = rsqrtf(a * (1.0f / D_) + EPS_); }
                __syncthreads();
            }
            pg8::gemm_phase<pg8::EpiBf, pg8::StaticOrder>((LAS unsigned char*)shm, g, S, E);
        } else if (PHON(2) && (op == OP_A_OUT || op == OP_GLU || op == OP_C_OUT || op == OP_W2)) {
            const GemmDesc gd = GD[ph];
            pg8::Gemm g; g.A = (const bf16_t*)(ws + gd.a_off); g.Bt = (const bf16_t*)(ws + gd.b_off); g.M = T_; g.N = gd.N; g.K = gd.K;
            pg8::EpiRes E; E.xout = p.out; E.xb = (bf16_t*)(ws + OFF_XB); E.glu = gd.mode; E.xin = p.out; E.ssn = ssb + (size_t)gd.ss_idx * 32 * T_;
            pg8::StaticOrder S; S.init(g.M, g.N, (int)gridDim.x, obid());
            pg8::gemm_phase<pg8::EpiRes, pg8::StaticOrder>((LAS unsigned char*)shm, g, S, E);
        } else if (PHON(3) && op == OP_ATTN) {
            const float li = 0.8f - 0.6f * expf(-0.3f * (float)L);
            attn_phase(p, L / 3, li, shm);
        } else if (PHON(4) && op == OP_S5A) {
            s5_phase<false>(p, shm);
        } else if (PHON(4) && op == OP_S5B) {
            s5_scan_phase(p);
        } else if (PHON(5) && op == OP_S5C) {
            s5_phase<true>(p, shm);
        } else if (PHON(6) && op == OP_RET) {
            ret_phase(p, shm, (float*)(ws + (rp_ == 0 ? OFF_RSQP : OFF_XB)));
        } else if (PHON(7) && op == OP_RET2) {
            ret2_phase(p);
        } else if (PHON(8) && op == OP_FINAL) {
            final_phase(p);
        }
        if (ph + 1 < ph_hi || rp_ + 1 < nrep_) xcd_barrier(ws, shm);
        }
    }
}

extern "C" void kernel_launch(void* const* d_in, const int* in_sizes, int n_in, void* d_out, int out_size, void* d_ws, size_t ws_size, hipStream_t stream) {
    static int grid_blocks = 0;
    if (grid_blocks == 0) {
        if (n_in != 21 || out_size != T_ * D_ || ws_size < WS_NEED) { fprintf(stderr, "kernel_launch: unexpected shapes n_in %d out %d ws %zu (need %zu)\n", n_in, out_size, ws_size, (size_t)WS_NEED); grid_blocks = -1; return; }
        int dev = 0, cus = 0, per_cu = 0;
        hipGetDevice(&dev);
        hipDeviceGetAttribute(&cus, hipDeviceAttributeMultiprocessorCount, dev);
        if (hipFuncSetAttribute((const void*)fwd_megakernel, hipFuncAttributeMaxDynamicSharedMemorySize, LDS_BYTES) != hipSuccess) { fprintf(stderr, "kernel_launch: hipFuncSetAttribute failed\n"); grid_blocks = -1; return; }
        hipOccupancyMaxActiveBlocksPerMultiprocessor(&per_cu, (const void*)fwd_megakernel, 512, LDS_BYTES);
        (void)hipGetLastError();
        if (per_cu < 1) per_cu = 1;
        grid_blocks = cus * 1;
        if (grid_blocks != 256) fprintf(stderr, "kernel_launch: note: %d CUs (kernel tuned for 256)\n", cus);
    }
    if (grid_blocks < 0) return;
    (void)hipMemsetAsync((unsigned char*)d_ws + OFF_BAR, 0, XCD_BAR_WORDS * 4, stream);
    Params p{};
    const float** pp = (const float**)&p;
    for (int i = 0; i < 21; ++i) pp[i] = (const float*)d_in[i];
    p.out = (float*)d_out; p.ws = (unsigned char*)d_ws;
#ifndef DBG_LO
#define DBG_LO 0
#endif
#ifndef DBG_HI
#define DBG_HI NPH
#endif
    int lo = DBG_LO, hi = DBG_HI;
    void* args[] = {&p, &lo, &hi};
    hipError_t e = hipLaunchCooperativeKernel((const void*)fwd_megakernel, dim3(grid_blocks), dim3(512), args, LDS_BYTES, stream);
    if (e != hipSuccess) fprintf(stderr, "cooperative launch failed: %s (grid %d)\n", hipGetErrorString(e), grid_blocks);
}
```

```cpp
#include <hip/hip_runtime.h>
#include <hip/hip_cooperative_groups.h>
#include <cstdio>
#include <cstdint>
namespace cg = cooperative_groups;

#define LAS __attribute__((address_space(3)))
typedef unsigned short bf16_t;
typedef short bf16x8 __attribute__((ext_vector_type(8)));
typedef short s16x4 __attribute__((ext_vector_type(4)));
typedef float f32x4 __attribute__((ext_vector_type(4)));
typedef float f32x2 __attribute__((ext_vector_type(2)));
typedef float f32x16 __attribute__((ext_vector_type(16)));
typedef unsigned u32x4 __attribute__((ext_vector_type(4)));
typedef unsigned u32x2 __attribute__((ext_vector_type(2)));

constexpr int T_ = 16384, D_ = 2048, S_ = 4096;
constexpr float EPS_ = 1e-6f;
constexpr int LDS_PHASE_BYTES = 156672;
constexpr int LDS_BYTES = LDS_PHASE_BYTES + 16;

constexpr size_t SZ_A_IN = 6144ull * 2048 * 2, SZ_A_OUT = 2048ull * 2048 * 2, SZ_W1 = 8192ull * 2048 * 2;
constexpr size_t OFF_WT_A_IN = 0;
constexpr size_t OFF_WT_A_OUT = OFF_WT_A_IN + 2 * SZ_A_IN;
constexpr size_t OFF_WT_GLU = OFF_WT_A_OUT + 2 * SZ_A_OUT;
constexpr size_t OFF_WT_C_IN = OFF_WT_GLU + 4096ull * 2048 * 2;
constexpr size_t OFF_WT_C_OUT = OFF_WT_C_IN + 12288ull * 2048 * 2;
constexpr size_t OFF_WT_W1 = OFF_WT_C_OUT + 2048ull * 4096 * 2;
constexpr size_t OFF_WT_W2 = OFF_WT_W1 + 4 * SZ_W1;
constexpr size_t OFF_XB = OFF_WT_W2 + 4 * SZ_W1;
constexpr size_t OFF_BIG = OFF_XB + (size_t)T_ * D_ * 2;
constexpr size_t OFF_OA = OFF_BIG + (size_t)T_ * 12288 * 2;
constexpr size_t OFF_SS = OFF_OA + (size_t)T_ * 4096 * 2;
constexpr size_t OFF_RSSQ = OFF_SS + 9ull * T_ * 4;
constexpr size_t OFF_ROT = OFF_RSSQ + (size_t)T_ * 8 * 4;
constexpr size_t OFF_S5B = OFF_ROT + 4096ull * 128 * 8;
constexpr size_t OFF_S5C = OFF_S5B + 128ull * 128 * 16 * 2;
constexpr size_t OFF_S5AB = OFF_S5C + 128ull * 16 * 128 * 2;
constexpr size_t WS_END = OFF_S5AB + 128ull * 64 * 8;
constexpr size_t OFF_SSP = WS_END;
constexpr size_t OFF_RSQP = OFF_SSP + 9ull * 32 * T_ * 4;
constexpr size_t OFF_RSFIN = OFF_RSQP + 8ull * T_ * 8 * 4;
constexpr size_t OFF_BAR = OFF_RSFIN + (size_t)T_ * 4;
constexpr size_t OFF_PAR = OFF_BAR + 16384;
constexpr int PAR_GMIX = 0, PAR_NFINAL = 2048, PAR_LAM = 4096, PAR_SUBLN = 5120, PAR_BD = 5632, PAR_N = 7680;
constexpr size_t WS_NEED = OFF_PAR + PAR_N * 4;
constexpr size_t OFF_ATT_SCR = OFF_BIG + (size_t)T_ * 6144 * 2;

struct Params {
    const float* x; const float* norm_mix; const float* norm_mlp; const float* norm_final;
    const float* a_w_in; const float* a_lambda; const float* a_subln; const float* a_w_out;
    const float* b_a_re; const float* b_a_im; const float* b_log_dt; const float* b_b_re; const float* b_b_im;
    const float* b_c_re; const float* b_c_im; const float* b_d; const float* b_w_glu;
    const float* c_w_in; const float* c_w_out; const float* mlp_w1; const float* mlp_w2;
    float* out; unsigned char* ws;
};

__device__ __forceinline__ unsigned cvt_pk_bf16(float lo, float hi) { unsigned r; asm volatile("v_cvt_pk_bf16_f32 %0, %1, %2" : "=v"(r) : "v"(lo), "v"(hi)); return r; }
__device__ __forceinline__ float bf2f(unsigned short b) { return __uint_as_float(((unsigned)b) << 16); }
__device__ __forceinline__ float bflo(unsigned w) { return __uint_as_float(w << 16); }
__device__ __forceinline__ float bfhi(unsigned w) { return __uint_as_float(w & 0xffff0000u); }
__device__ __forceinline__ unsigned short f2bf(float f) { return (unsigned short)(cvt_pk_bf16(f, 0.f) & 0xffffu); }

__device__ __forceinline__ int otid() { int t = threadIdx.x; asm volatile("" : "+v"(t)); return t; }
__device__ __forceinline__ int obid() { int t = blockIdx.x; asm volatile("" : "+s"(t)); return t; }

namespace pg8 {
constexpr int BM = 256, BK = 64, HALF = 128, HTB = HALF * BK * 2, STAGE_BYTES = 8 * HTB, NXCD = 8, WGM = 8;
__device__ __forceinline__ int lds_byte(int r, int c) { const int st = (r >> 4) * 2 + (c >> 5), rr = r & 15, cc = c & 31, ob = rr * 64 + cc * 2; return st * 1024 + (ob ^ (((ob >> 9) & 1) << 5)); }
__device__ __forceinline__ void stage_rc(int b, int& R, int& C) { const int st = b / 1024, sb = b % 1024, swz = sb ^ (((sb >> 9) & 1) << 5); R = (st >> 1) * 16 + swz / 64; C = (st & 1) * 32 + (swz % 64) / 2; }
struct Unit { int pm, pn; };
struct Gemm { const bf16_t* A; const bf16_t* Bt; int M, N, K; };
struct StaticOrder {
    int nM, nN, nwg, G, c;
    __device__ void init(int M, int N, int G_, int c_) { nM = M / BM; nN = N / BM; nwg = nM * nN; G = G_; c = c_; }
    __device__ bool next(int i, Unit& u) const {
        const long L = (long)i * G + c; if (L >= nwg) return false;
        int wgid = (int)L; { const int q = nwg / NXCD, r = nwg % NXCD, xcd = wgid % NXCD, off = wgid / NXCD; wgid = (xcd < r ? xcd * (q + 1) : r * (q + 1) + (xcd - r) * q) + off; }
        const int nig = WGM * nN, gid = wgid / nig, fm = gid * WGM, gsz = (nM - fm) < WGM ? (nM - fm) : WGM;
        u.pm = fm + ((wgid % nig) % gsz); u.pn = (wgid % nig) / gsz; return true;
    }
};

#define GAS __attribute__((address_space(1)))
struct EpiBf {
    bf16_t* O; int ldc; const float* ss; int mode; const f32x2* rot;
    __device__ __forceinline__ void operator()(const f32x4 (&acc)[2][2][4][2], const Unit& u, int wr, int wc, int fr, int fq, LAS unsigned char* lds, int ui) const {
        const int row0 = u.pm * BM + wr * 64 + fr, colt = u.pn * BM + wc * 32 + 8 * fq;
        int sub = 0;
        if (mode == 1) sub = 1;
        else if (mode == 2) { sub = u.pn < 8 ? 2 : (u.pn < 16 ? 3 : (u.pn < 32 ? 0 : 4)); }
        const LAS float* lrs = (const LAS float*)(lds + STAGE_BYTES) + ui * 256 + wr * 64 + fr;
        float rs8[8];
#pragma unroll
        for (int r = 0; r < 8; ++r) rs8[r] = lrs[(r >> 2) * HALF + (r & 3) * 16];
        GAS bf16_t* Og = (GAS bf16_t*)O;
        if (sub == 2 || sub == 3) {
            const GAS f32x2* rotg = (const GAS f32x2*)rot + wc * 32 + 8 * fq;
#pragma unroll
            for (int ai = 0; ai < 2; ++ai) {
                f32x2 cs[4][2][4];
#pragma unroll
                for (int m = 0; m < 4; ++m) { const int row = row0 + ai * HALF + m * 16; const GAS f32x2* rp = rotg + (size_t)(row & (S_ - 1)) * 128;
#pragma unroll
                    for (int n = 0; n < 2; ++n)
#pragma unroll
                        for (int j = 0; j < 4; ++j) cs[m][n][j] = rp[n * 4 + j]; }
#pragma unroll
                for (int m = 0; m < 4; ++m) { const int row = row0 + ai * HALF + m * 16;
                    float ksc = rs8[ai * 4 + m];
                    if (sub == 3) { const float lgam = logf(1.0f - exp2f(-5.0f - (float)(u.pn - 8))); ksc *= 0.0625f * __expf(lgam * (float)(63 - (row & 63))); }
                    GAS bf16_t* rowp = Og + (size_t)row * ldc + colt;
                    u32x4 w1, w2;
#pragma unroll
                    for (int n = 0; n < 2; ++n) {
                        const f32x4 t1 = acc[ai][0][m][n] * ksc, t2 = acc[ai][1][m][n] * ksc;
                        f32x4 o1, o2;
#pragma unroll
                        for (int j = 0; j < 4; ++j) { const f32x2 c2 = cs[m][n][j]; o1[j] = t1[j] * c2.x - t2[j] * c2.y; o2[j] = t1[j] * c2.y + t2[j] * c2.x; }
                        w1[2 * n] = cvt_pk_bf16(o1[0], o1[1]); w1[2 * n + 1] = cvt_pk_bf16(o1[2], o1[3]); w2[2 * n] = cvt_pk_bf16(o2[0], o2[1]); w2[2 * n + 1] = cvt_pk_bf16(o2[2], o2[3]);
                    }
                    *(GAS u32x4*)(rowp) = w1; *(GAS u32x4*)(rowp + HALF) = w2;
                }
            }
        } else {
#pragma unroll
            for (int ai = 0; ai < 2; ++ai)
#pragma unroll
                for (int m = 0; m < 4; ++m) {
                    const int row = row0 + ai * HALF + m * 16;
                    const float rs = rs8[ai * 4 + m];
                    GAS bf16_t* rowp = Og + (size_t)row * ldc + colt;
#pragma unroll
                    for (int bj = 0; bj < 2; ++bj) {
                        u32x4 w;
#pragma unroll
                        for (int n = 0; n < 2; ++n) {
                            f32x4 v = acc[ai][bj][m][n] * rs;
                            if (sub == 1) {
#pragma unroll
                                for (int j = 0; j < 4; ++j) { const float r = fmaxf(v[j], 0.f); v[j] = r * r; }
                            } else if (sub == 4) {
#pragma unroll
                                for (int j = 0; j < 4; ++j) v[j] = v[j] / (1.0f + __expf(-v[j]));
                            }
                            w[2 * n] = cvt_pk_bf16(v[0], v[1]); w[2 * n + 1] = cvt_pk_bf16(v[2], v[3]);
                        }
                        *(GAS u32x4*)(rowp + bj * HALF) = w;
                    }
                }
        }
    }
};
struct EpiRes {
    const float* xin; float* xout; bf16_t* xb; float* ssn; int glu;
    __device__ __forceinline__ void operator()(const f32x4 (&acc)[2][2][4][2], const Unit& u, int wr, int wc, int fr, int fq, LAS unsigned char*, int) const {
        const int row0 = u.pm * BM + wr * 64 + fr;
        const GAS float* xi = (const GAS float*)xin; GAS float* xo = (GAS float*)xout; GAS bf16_t* xbg = (GAS bf16_t*)xb; GAS float* ssg = (GAS float*)ssn;
        if (glu) {
            const size_t cb = (size_t)u.pn * HALF + wc * 32 + 8 * fq;
#pragma unroll
            for (int ai = 0; ai < 2; ++ai) {
                f32x4 xv[4][2];
#pragma unroll
                for (int m = 0; m < 4; ++m)
#pragma unroll
                    for (int n = 0; n < 2; ++n) xv[m][n] = *(const GAS f32x4*)(xi + (size_t)(row0 + ai * HALF + m * 16) * D_ + cb + n * 4);
#pragma unroll
                for (int m = 0; m < 4; ++m) {
                    const int row = row0 + ai * HALF + m * 16; const size_t off = (size_t)row * D_ + cb;
                    float sq = 0.f; u32x4 w;
#pragma unroll
                    for (int n = 0; n < 2; ++n) {
                        const f32x4 va = acc[ai][0][m][n], ga = acc[ai][1][m][n];
                        f32x4 x4 = xv[m][n];
#pragma unroll
                        for (int j = 0; j < 4; ++j) { x4[j] += va[j] / (1.0f + __expf(-ga[j])); sq += x4[j] * x4[j]; }
                        *(GAS f32x4*)(xo + off + n * 4) = x4;
                        w[2 * n] = cvt_pk_bf16(x4[0], x4[1]); w[2 * n + 1] = cvt_pk_bf16(x4[2], x4[3]);
                    }
                    *(GAS u32x4*)(xbg + off) = w;
                    sq += __shfl_xor(sq, 16); sq += __shfl_xor(sq, 32);
                    if (fq == 0) atomicAdd((float*)ssn + (size_t)((u.pn >> 1) * 4 + wc) * T_ + row, sq);
                }
            }
        } else {
            const size_t cb = (size_t)u.pn * BM + wc * 32 + 8 * fq;
#pragma unroll
            for (int ai = 0; ai < 2; ++ai) {
                f32x4 xv[4][2][2];
#pragma unroll
                for (int m = 0; m < 4; ++m)
#pragma unroll
                    for (int bj = 0; bj < 2; ++bj)
#pragma unroll
                        for (int n = 0; n < 2; ++n) xv[m][bj][n] = *(const GAS f32x4*)(xi + (size_t)(row0 + ai * HALF + m * 16) * D_ + cb + bj * HALF + n * 4);
#pragma unroll
                for (int m = 0; m < 4; ++m) {
                    const int row = row0 + ai * HALF + m * 16; const size_t off = (size_t)row * D_ + cb;
                    float sq = 0.f;
#pragma unroll
                    for (int bj = 0; bj < 2; ++bj) {
                        u32x4 w;
#pragma unroll
                        for (int n = 0; n < 2; ++n) {
                            f32x4 x4 = xv[m][bj][n] + acc[ai][bj][m][n];
#pragma unroll
                            for (int j = 0; j < 4; ++j) sq += x4[j] * x4[j];
                            *(GAS f32x4*)(xo + off + bj * HALF + n * 4) = x4;
                            w[2 * n] = cvt_pk_bf16(x4[0], x4[1]); w[2 * n + 1] = cvt_pk_bf16(x4[2], x4[3]);
                        }
                        *(GAS u32x4*)(xbg + off + bj * HALF) = w;
                    }
                    sq += __shfl_xor(sq, 16); sq += __shfl_xor(sq, 32);
                    if (fq == 0) ssg[(size_t)(u.pn * 4 + wc) * T_ + row] = sq;
                }
            }
        }
    }
};

template <class Epi, class Sched>
__device__ __forceinline__ void gemm_phase(LAS unsigned char* lds, const Gemm g, const Sched& S, const Epi& E) {
    const int tid = otid(), wid = __builtin_amdgcn_readfirstlane(tid >> 6), lane = tid & 63, wr = wid >> 2, wc = wid & 3, fr = lane & 15, fq = lane >> 4;
    const int K = g.K, nt = K / BK;
    unsigned voffA[2], voffB[2];
#pragma unroll
    for (int i = 0; i < 2; ++i) { int R, C; stage_rc(tid * 16 + i * 8192, R, C); voffA[i] = (unsigned)(R * K + C) * 2u; voffB[i] = voffA[i]; }
    const size_t kstep = (size_t)(BK * 2);
    const size_t hstep = (size_t)HALF * K * 2;
    const size_t tstep = 2 * hstep;
    const unsigned ldsw = (unsigned)wid * 1024u;
    const int aoff = lds_byte(wr * 64 + fr, fq * 8), boff = lds_byte(wc * 32 + fr, fq * 8);
#define PG8_SA(b, h) (((b) * 2 + (h)) * HTB)
#define PG8_SB(b, h) ((4 + (b) * 2 + (h)) * HTB)
#define PG8_STAGE(bufoff, gbase, voff) do { _Pragma("unroll") for (int _i = 0; _i < 2; ++_i) \
        __builtin_amdgcn_global_load_lds((const unsigned*)((const char*)(gbase) + (voff)[_i]), (LAS unsigned*)(lds + (bufoff) + ldsw + _i * 8192), 16, 0, 0); } while (0)
#define PG8_LDA(dst, b, h) do { _Pragma("unroll") for (int m = 0; m < 4; ++m) _Pragma("unroll") for (int k = 0; k < 2; ++k) dst[m][k] = *(const LAS bf16x8*)(lds + PG8_SA(b, h) + aoff + m * 2048 + k * 1024); } while (0)
#define PG8_LDB(dst, b, h) do { _Pragma("unroll") for (int n = 0; n < 2; ++n) _Pragma("unroll") for (int k = 0; k < 2; ++k) dst[n][k] = *(const LAS bf16x8*)(lds + PG8_SB(b, h) + boff + n * 2048 + k * 1024); } while (0)
#define PG8_MMA(ai, bj, At, Bt) do { __builtin_amdgcn_s_setprio(1); _Pragma("unroll") for (int m = 0; m < 4; ++m) _Pragma("unroll") for (int n = 0; n < 2; ++n) _Pragma("unroll") for (int k = 0; k < 2; ++k) \
        acc[ai][bj][m][n] = __builtin_amdgcn_mfma_f32_16x16x32_bf16(Bt[n][k], At[m][k], acc[ai][bj][m][n], 0, 0, 0); __builtin_amdgcn_s_setprio(0); } while (0)
#define PG8_WAIT_V(n) asm volatile("s_waitcnt vmcnt(" #n ")" ::: "memory")
#define PG8_WAIT_L(n) asm volatile("s_waitcnt lgkmcnt(" #n ")" ::: "memory")
#define PG8_BAR __builtin_amdgcn_s_barrier()
#define PG8_SCHED __builtin_amdgcn_sched_barrier(0)
    Unit cur, nxt; int ui = 0;
    if (!S.next(0, cur)) return;
    f32x4 acc[2][2][4][2];
#pragma unroll
    for (int a = 0; a < 2; ++a)
#pragma unroll
        for (int b = 0; b < 2; ++b)
#pragma unroll
            for (int m = 0; m < 4; ++m)
#pragma unroll
                for (int n = 0; n < 2; ++n) acc[a][b][m][n] = (f32x4){0.f, 0.f, 0.f, 0.f};
    bf16x8 At[4][2], B0[2][2], B1[2][2];
    const char* cA = (const char*)g.A + (size_t)cur.pm * tstep; const char* cB = (const char*)g.Bt + (size_t)cur.pn * tstep;
    PG8_STAGE(PG8_SB(0, 0), cB, voffB); PG8_STAGE(PG8_SA(0, 0), cA, voffA); PG8_STAGE(PG8_SB(0, 1), cB + hstep, voffB); PG8_STAGE(PG8_SA(0, 1), cA + hstep, voffA);
    if (wr == 1) PG8_BAR;
    PG8_WAIT_V(4); PG8_BAR;
    PG8_STAGE(PG8_SB(1, 0), cB + kstep, voffB); PG8_STAGE(PG8_SA(1, 0), cA + kstep, voffA); PG8_STAGE(PG8_SB(1, 1), cB + hstep + kstep, voffB);
    PG8_WAIT_V(6); PG8_BAR;
    for (;;) {
        const bool has_next = S.next(ui + 1, nxt);
        const char* nA = has_next ? (const char*)g.A + (size_t)nxt.pm * tstep : cA; const char* nB = has_next ? (const char*)g.Bt + (size_t)nxt.pn * tstep : cB;
        for (int t = 0; t < nt; t += 2) {
            const bool last = (t == nt - 2);
            const char* a1 = cA + (size_t)(t + 1) * kstep;
            const char* a2 = last ? nA : cA + (size_t)(t + 2) * kstep; const char* b2 = last ? nB : cB + (size_t)(t + 2) * kstep;
            const char* a3 = a2 + kstep; const char* b3 = b2 + kstep;
            PG8_LDB(B0, 0, 0); PG8_SCHED; PG8_LDA(At, 0, 0); PG8_STAGE(PG8_SA(1, 1), a1 + hstep, voffA);
            PG8_WAIT_L(8); PG8_BAR; PG8_WAIT_L(0); PG8_MMA(0, 0, At, B0); PG8_BAR; PG8_SCHED;
            PG8_LDB(B1, 0, 1); PG8_STAGE(PG8_SB(0, 0), b2, voffB);
            PG8_BAR; PG8_WAIT_L(0); PG8_MMA(0, 1, At, B1); PG8_BAR;
            PG8_LDA(At, 0, 1); PG8_STAGE(PG8_SA(0, 0), a2, voffA);
            PG8_BAR; PG8_WAIT_L(0); PG8_MMA(1, 0, At, B0); PG8_BAR; PG8_SCHED;
            PG8_STAGE(PG8_SB(0, 1), b2 + hstep, voffB);
            PG8_WAIT_V(6); PG8_BAR; PG8_MMA(1, 1, At, B1); PG8_BAR;
            PG8_LDB(B0, 1, 0); PG8_SCHED; PG8_LDA(At, 1, 0); PG8_STAGE(PG8_SA(0, 1), a2 + hstep, voffA);
            PG8_WAIT_L(8); PG8_BAR; PG8_WAIT_L(0); PG8_MMA(0, 0, At, B0); PG8_BAR; PG8_SCHED;
            PG8_LDB(B1, 1, 1); PG8_STAGE(PG8_SB(1, 0), b3, voffB);
            PG8_BAR; PG8_WAIT_L(0); PG8_MMA(0, 1, At, B1); PG8_BAR;
            PG8_LDA(At, 1, 1); PG8_STAGE(PG8_SA(1, 0), a3, voffA);
            PG8_BAR; PG8_WAIT_L(0); PG8_MMA(1, 0, At, B0); PG8_BAR; PG8_SCHED;
            PG8_STAGE(PG8_SB(1, 1), b3 + hstep, voffB);
            PG8_WAIT_V(6); PG8_BAR; PG8_MMA(1, 1, At, B1); PG8_BAR;
        }
        E(acc, cur, wr, wc, fr, fq, lds, ui);
        if (!has_next) break;
#pragma unroll
        for (int a = 0; a < 2; ++a)
#pragma unroll
            for (int b = 0; b < 2; ++b)
#pragma unroll
                for (int m = 0; m < 4; ++m)
#pragma unroll
                    for (int n = 0; n < 2; ++n) acc[a][b][m][n] = (f32x4){0.f, 0.f, 0.f, 0.f};
        cur = nxt; cA = nA; cB = nB; ++ui;
    }
    PG8_WAIT_V(0);
    if (wr == 0) PG8_BAR;
    PG8_BAR;
#undef PG8_SA
#undef PG8_SB
#undef PG8_STAGE
#undef PG8_LDA
#undef PG8_LDB
#undef PG8_MMA
#undef PG8_WAIT_V
#undef PG8_WAIT_L
#undef PG8_BAR
#undef PG8_SCHED
}
}

namespace att {
constexpr int D = 128, KVBLK = 64, LDK = 6144;
constexpr float SCALE = 0.088388347648318440f;
constexpr float THR = 8.f;
constexpr size_t SHM_V = KVBLK * D * 2, SHM_K = KVBLK * D * 2;
#define KSWZ(row, colB) ((row) * 256 + ((colB) ^ (((row) & 7) << 4)))
#define SBAR() __builtin_amdgcn_sched_barrier(0)
__device__ __forceinline__ int crow(int r, int hi) { return (r & 3) + 8 * (r >> 2) + 4 * hi; }
__device__ __forceinline__ void partialSM(f32x16& p0, f32x16& p1, float& m_reg, float& mn, float& alpha, bool msk) {
    constexpr float C = SCALE * 1.4426950408889634f;
    if (msk) {
#pragma unroll
        for (int r = 0; r < 16; ++r) { p0[r] = -1e30f; p1[r] = -1e30f; }
    }
    float pmax = p0[0];
#pragma unroll
    for (int r = 1; r < 16; ++r) pmax = fmaxf(pmax, p0[r]);
#pragma unroll
    for (int r = 0; r < 16; ++r) pmax = fmaxf(pmax, p1[r]);
    { auto rr = __builtin_amdgcn_permlane32_swap(__float_as_uint(pmax), __float_as_uint(pmax), false, false);
      pmax = fmaxf(__uint_as_float(rr[0]), __uint_as_float(rr[1])); }
    if (__builtin_expect(__all(pmax - m_reg <= THR / SCALE), 1)) { mn = m_reg; alpha = 1.f; }
    else { mn = fmaxf(m_reg, pmax); alpha = __builtin_amdgcn_exp2f((m_reg - mn) * C); m_reg = mn; }
    float mnC = -mn * C;
#pragma unroll
    for (int r = 0; r < 16; ++r) p0[r] = fmaf(p0[r], C, mnC);
#pragma unroll
    for (int r = 0; r < 16; ++r) p1[r] = fmaf(p1[r], C, mnC);
#pragma unroll
    for (int r = 0; r < 16; ++r) p0[r] = __builtin_amdgcn_exp2f(p0[r]);
}
__device__ __forceinline__ void finishSM(f32x16& p0, f32x16& p1, float alpha, float& l_reg, bf16x8& pa0, bf16x8& pa1, bf16x8& pa2, bf16x8& pa3) {
#pragma unroll
    for (int r = 0; r < 16; ++r) p1[r] = __builtin_amdgcn_exp2f(p1[r]);
    float ps = 0;
#pragma unroll
    for (int r = 0; r < 16; ++r) ps += p0[r];
#pragma unroll
    for (int r = 0; r < 16; ++r) ps += p1[r];
    { auto rr = __builtin_amdgcn_permlane32_swap(__float_as_uint(ps), __float_as_uint(ps), false, false);
      ps = __uint_as_float(rr[0]) + __uint_as_float(rr[1]); }
    l_reg = l_reg * alpha + ps;
#define PK4(P, BASE, OUT) do { unsigned a0 = cvt_pk_bf16(P[BASE + 0], P[BASE + 1]), a1 = cvt_pk_bf16(P[BASE + 2], P[BASE + 3]);   \
    unsigned b0 = cvt_pk_bf16(P[BASE + 4], P[BASE + 5]), b1 = cvt_pk_bf16(P[BASE + 6], P[BASE + 7]);                              \
    auto r0 = __builtin_amdgcn_permlane32_swap(a0, b0, false, false); auto r1 = __builtin_amdgcn_permlane32_swap(a1, b1, false, false); \
    u32x4 w = {r0[0], r1[0], r0[1], r1[1]}; OUT = *reinterpret_cast<bf16x8*>(&w); } while (0)
    PK4(p0, 0, pa0); PK4(p0, 8, pa1); PK4(p1, 0, pa2); PK4(p1, 8, pa3);
#undef PK4
}
__device__ __forceinline__ void qkt(f32x16& p0, f32x16& p1, const char* Ks, const bf16x8* qr, int r32, int hi) {
    p0 = f32x16{}; p1 = f32x16{};
#pragma unroll
    for (int d0 = 0; d0 < 8; ++d0) { int cb = (d0 * 16 + hi * 8) * 2;
        bf16x8 b0 = *reinterpret_cast<const bf16x8*>(Ks + KSWZ(r32, cb));
        bf16x8 b1 = *reinterpret_cast<const bf16x8*>(Ks + KSWZ(32 + r32, cb));
        p0 = __builtin_amdgcn_mfma_f32_32x32x16_bf16(b0, qr[d0], p0, 0, 0, 0);
        p1 = __builtin_amdgcn_mfma_f32_32x32x16_bf16(b1, qr[d0], p1, 0, 0, 0); }
}
__device__ __forceinline__ int v_st(int k, int c) { const int kk = (k & ~0xC) | ((k & 4) << 1) | ((k & 8) >> 1); return ((kk >> 3) * 4 + (c >> 5)) * 512 + ((kk & 7) * 32 + (c & 31)) * 2; }
__device__ __forceinline__ int v_rd_base(int lane) { return ((lane & 3) << 3) | (((lane >> 2) & 3) << 6) | (((lane >> 4) & 1) << 5) | (((lane >> 5) & 1) << 8); }
constexpr int v_rd_off(int d0, int ks, int half) { return d0 * 512 + ks * 4096 + half * 2048; }
template <int OFF> __device__ __forceinline__ s16x4 tr_read(int vb) {
    s16x4 r; asm volatile("ds_read_b64_tr_b16 %0, %1 offset:%2" : "=&v"(r) : "v"(vb), "i"(OFF) : "memory"); return r;
}
template <int D0> __device__ __forceinline__ void pv_one(f32x16& od, int vb, bf16x8 pa0, bf16x8 pa1, bf16x8 pa2, bf16x8 pa3) {
    const s16x4 l0 = tr_read<v_rd_off(D0, 0, 0)>(vb), h0 = tr_read<v_rd_off(D0, 0, 1)>(vb), l1 = tr_read<v_rd_off(D0, 1, 0)>(vb), h1 = tr_read<v_rd_off(D0, 1, 1)>(vb);
    const s16x4 l2 = tr_read<v_rd_off(D0, 2, 0)>(vb), h2 = tr_read<v_rd_off(D0, 2, 1)>(vb), l3 = tr_read<v_rd_off(D0, 3, 0)>(vb), h3 = tr_read<v_rd_off(D0, 3, 1)>(vb);
    asm volatile("s_waitcnt lgkmcnt(0)" ::: "memory"); SBAR();
#define PK(L, H) (bf16x8){L[0], L[1], L[2], L[3], H[0], H[1], H[2], H[3]}
    od = __builtin_amdgcn_mfma_f32_32x32x16_bf16(pa0, PK(l0, h0), od, 0, 0, 0);
    od = __builtin_amdgcn_mfma_f32_32x32x16_bf16(pa1, PK(l1, h1), od, 0, 0, 0);
    od = __builtin_amdgcn_mfma_f32_32x32x16_bf16(pa2, PK(l2, h2), od, 0, 0, 0);
    od = __builtin_amdgcn_mfma_f32_32x32x16_bf16(pa3, PK(l3, h3), od, 0, 0, 0);
#undef PK
}
__device__ __forceinline__ void pv_d0(f32x16* o, int vb, bf16x8 pa0, bf16x8 pa1, bf16x8 pa2, bf16x8 pa3) {
    pv_one<0>(o[0], vb, pa0, pa1, pa2, pa3); pv_one<1>(o[1], vb, pa0, pa1, pa2, pa3); pv_one<2>(o[2], vb, pa0, pa1, pa2, pa3); pv_one<3>(o[3], vb, pa0, pa1, pa2, pa3);
}
__device__ __forceinline__ void attn_body(const bf16_t* __restrict__ Qb, const bf16_t* __restrict__ Kh, const bf16_t* __restrict__ Vh, int NT, int ntw, char* lds, f32x16 (&o)[4]) {
    const int tid = otid(), wid = __builtin_amdgcn_readfirstlane(tid >> 6), lane = tid & 63, r32 = lane & 31, hi = lane >> 5;
    char* V_lds = lds; char* K_lds = lds + 2 * SHM_V;
    float* wsf = (float*)(lds + 2 * SHM_V + 2 * SHM_K) + wid * 64; float* li_l = wsf; float* al_l = wsf + 32;
    float m_reg = -1e30f, l_reg = 0; bf16x8 qr[8];
#pragma unroll
    for (int d = 0; d < 4; ++d) o[d] = f32x16{};
    const bf16_t* Qw = Qb + (long)(wid * 32 + r32) * LDK + hi * 8;
#pragma unroll
    for (int d0 = 0; d0 < 8; ++d0) qr[d0] = *reinterpret_cast<const bf16x8*>(Qw + d0 * 16);
    const int sr = tid >> 4, sc = (tid & 15) * 8, vst0 = v_st(sr, sc), vst1 = v_st(32 + sr, sc);
    const int vb0 = (int)(uintptr_t)V_lds + v_rd_base(lane);
    struct { bf16x8 vs0, vs1, ks0, ks1; } sr_[2];
#define SLOAD(i, k0) do { sr_[i].vs0 = *reinterpret_cast<const bf16x8*>(&Vh[(long)((k0) + sr) * LDK + sc]); sr_[i].vs1 = *reinterpret_cast<const bf16x8*>(&Vh[(long)((k0) + 32 + sr) * LDK + sc]); \
    sr_[i].ks0 = *reinterpret_cast<const bf16x8*>(&Kh[(long)((k0) + sr) * LDK + sc]); sr_[i].ks1 = *reinterpret_cast<const bf16x8*>(&Kh[(long)((k0) + 32 + sr) * LDK + sc]); } while (0)
#define SWRITE(b, i) do { *(bf16x8*)(V_lds + (b) * SHM_V + vst0) = sr_[i].vs0;          \
    *(bf16x8*)(V_lds + (b) * SHM_V + vst1) = sr_[i].vs1; int kc = sc * 2;               \
    *(bf16x8*)(K_lds + (b) * SHM_K + KSWZ(sr, kc)) = sr_[i].ks0;                       \
    *(bf16x8*)(K_lds + (b) * SHM_K + KSWZ(32 + sr, kc)) = sr_[i].ks1; } while (0)
#define SWAIT() asm volatile("s_waitcnt vmcnt(4)" ::: "memory")
#define RESC(a) do { if (__any((a) < 1.f)) { if (hi == 0) al_l[r32] = (a); asm volatile("s_waitcnt lgkmcnt(0)" ::: "memory"); \
    _Pragma("unroll") for (int d = 0; d < 4; ++d) _Pragma("unroll") for (int r = 0; r < 16; ++r) o[d][r] *= al_l[crow(r, hi)]; } } while (0)
    f32x16 pA0, pA1, pB0, pB1; float mnA, mnB, alA, alB; bf16x8 pa0, pa1, pa2, pa3;
    constexpr int SE = 0, SO = 1;
    __syncthreads();
    SLOAD(SE, 0); asm volatile("s_waitcnt vmcnt(0)" ::: "memory"); SWRITE(0, SE); __syncthreads();
    qkt(pA0, pA1, K_lds, qr, r32, hi); partialSM(pA0, pA1, m_reg, mnA, alA, false);
    SLOAD(SO, KVBLK); if (2 < NT) SLOAD(SE, 2 * KVBLK);
    SWAIT(); SWRITE(1, SO); __syncthreads();
    for (int j = 1; j + 1 < NT; j += 2) {
        SBAR(); qkt(pB0, pB1, K_lds + SHM_K, qr, r32, hi);
        finishSM(pA0, pA1, alA, l_reg, pa0, pa1, pa2, pa3); SBAR();
        SLOAD(SO, (j + 2) * KVBLK); SBAR();
        pv_d0(o, vb0, pa0, pa1, pa2, pa3); partialSM(pB0, pB1, m_reg, mnB, alB, j >= ntw);
        __syncthreads(); SWAIT(); SWRITE(0, SE);
        RESC(alB); __syncthreads();
        SBAR(); qkt(pA0, pA1, K_lds, qr, r32, hi);
        finishSM(pB0, pB1, alB, l_reg, pa0, pa1, pa2, pa3); SBAR();
        if (j + 3 < NT) SLOAD(SE, (j + 3) * KVBLK); SBAR();
        pv_d0(o, vb0 + (int)SHM_V, pa0, pa1, pa2, pa3); partialSM(pA0, pA1, m_reg, mnA, alA, (j + 1) >= ntw);
        __syncthreads(); SWAIT(); SWRITE(1, SO);
        RESC(alA); __syncthreads();
    }
    SBAR(); qkt(pB0, pB1, K_lds + SHM_K, qr, r32, hi);
    finishSM(pA0, pA1, alA, l_reg, pa0, pa1, pa2, pa3); SBAR();
    pv_d0(o, vb0, pa0, pa1, pa2, pa3); partialSM(pB0, pB1, m_reg, mnB, alB, (NT - 1) >= ntw);
    __syncthreads(); RESC(alB);
    finishSM(pB0, pB1, alB, l_reg, pa0, pa1, pa2, pa3); SBAR();
    pv_d0(o, vb0 + (int)SHM_V, pa0, pa1, pa2, pa3);
    if (hi == 0) li_l[r32] = l_reg; asm volatile("s_waitcnt lgkmcnt(0)" ::: "memory");
#pragma unroll
    for (int r = 0; r < 16; ++r) { const float rl = __builtin_amdgcn_rcpf(li_l[crow(r, hi)]);
#pragma unroll
        for (int d = 0; d < 4; ++d) o[d][r] *= rl; }
#undef SLOAD
#undef SWRITE
#undef SWAIT
#undef RESC
}
}

__device__ __forceinline__ void sincos_red(double ang, float& s, float& c) {
    const double k = rint(ang * 0.15915494309189535);
    const float r = (float)(ang - k * 6.283185307179586);
    s = __sinf(r); c = __cosf(r);
}
__device__ __forceinline__ float gelu_tanh(float y) {
    const float z = 0.7978845608028654f * (y + 0.044715f * y * y * y);
    const float th = 1.0f - 2.0f / (1.0f + __expf(2.0f * z));
    return 0.5f * y * (1.0f + th);
}

struct ConvJob { const float* W; bf16_t* Wt; const float* gain; int K, N, glu, tile; };
struct ConvRegs { f32x4 va[4], vb[4]; float ga[4], gb[4]; };
__device__ __forceinline__ ConvJob conv_decode(const Params& p, unsigned char* ws, int t) {
    ConvJob j; j.glu = 0; j.gain = nullptr;
    if (t < 1536) { const int q = t / 768; j.tile = t - q * 768; j.W = p.a_w_in + (size_t)q * 2048 * 6144; j.Wt = (bf16_t*)(ws + OFF_WT_A_IN + q * SZ_A_IN); j.K = 2048; j.N = 6144; j.gain = p.norm_mix + (size_t)(3 * q) * D_; }
    else if (t < 2048) { const int u = t - 1536; const int q = u / 256; j.tile = u - q * 256; j.W = p.a_w_out + (size_t)q * 2048 * 2048; j.Wt = (bf16_t*)(ws + OFF_WT_A_OUT + q * SZ_A_OUT); j.K = 2048; j.N = 2048; }
    else if (t < 2560) { j.tile = t - 2048; j.W = p.b_w_glu; j.Wt = (bf16_t*)(ws + OFF_WT_GLU); j.K = 2048; j.N = 4096; j.glu = 1; }
    else if (t < 4096) { j.tile = t - 2560; j.W = p.c_w_in; j.Wt = (bf16_t*)(ws + OFF_WT_C_IN); j.K = 2048; j.N = 12288; j.gain = p.norm_mix + 2 * D_; }
    else if (t < 4608) { j.tile = t - 4096; j.W = p.c_w_out; j.Wt = (bf16_t*)(ws + OFF_WT_C_OUT); j.K = 4096; j.N = 2048; }
    else if (t < 8704) { const int u = t - 4608; const int i = u / 1024; j.tile = u - i * 1024; j.W = p.mlp_w1 + (size_t)i * 2048 * 8192; j.Wt = (bf16_t*)(ws + OFF_WT_W1 + i * SZ_W1); j.K = 2048; j.N = 8192; j.gain = p.norm_mlp + (size_t)i * D_; }
    else { const int u = t - 8704; const int i = u / 1024; j.tile = u - i * 1024; j.W = p.mlp_w2 + (size_t)i * 8192 * 2048; j.Wt = (bf16_t*)(ws + OFF_WT_W2 + i * SZ_W1); j.K = 8192; j.N = 2048; }
    return j;
}
__device__ __forceinline__ void conv_load(const ConvJob& j, ConvRegs& r, int tid) {
    const int ntn = j.N >> 7; const int tk = j.tile / ntn, tn = j.tile - tk * ntn; const int k0 = tk << 7, n0 = tn << 7;
    const int kp = tid >> 5, nl = (tid & 31) << 2;
#pragma unroll
    for (int i = 0; i < 4; ++i) { const int k = 2 * (kp + 16 * i);
        r.va[i] = *(const f32x4*)(j.W + (size_t)(k0 + k) * j.N + n0 + nl); r.vb[i] = *(const f32x4*)(j.W + (size_t)(k0 + k + 1) * j.N + n0 + nl);
        r.ga[i] = j.gain ? j.gain[k0 + k] : 1.f; r.gb[i] = j.gain ? j.gain[k0 + k + 1] : 1.f; }
}
__device__ __forceinline__ void conv_store(const ConvJob& j, const ConvRegs& r, int tid, unsigned* ldsw) {
    const int ntn = j.N >> 7; const int tk = j.tile / ntn, tn = j.tile - tk * ntn; const int k0 = tk << 7, n0 = tn << 7;
    const int kp = tid >> 5, nl = (tid & 31) << 2;
    __syncthreads();
#pragma unroll
    for (int i = 0; i < 4; ++i) { const int kpair = kp + 16 * i;
#pragma unroll
        for (int jj = 0; jj < 4; ++jj) ldsw[(nl + jj) * 65 + kpair] = cvt_pk_bf16(r.va[i][jj] * r.ga[i], r.vb[i][jj] * r.gb[i]); }
    __syncthreads();
    int nbase = n0;
    if (j.glu) { const int bj = n0 >> 11, pn = (n0 & 2047) >> 7; nbase = 256 * pn + 128 * bj; }
#pragma unroll
    for (int i = 0; i < 4; ++i) { const int n = (tid >> 4) + 32 * i, k8 = tid & 15;
        u32x4 w; w.x = ldsw[n * 65 + k8 * 4 + 0]; w.y = ldsw[n * 65 + k8 * 4 + 1]; w.z = ldsw[n * 65 + k8 * 4 + 2]; w.w = ldsw[n * 65 + k8 * 4 + 3];
        const int c5 = n & 31, np = (n & ~31) | (16 * ((c5 >> 2) & 1) + 4 * (c5 >> 3) + (c5 & 3));
        *(u32x4*)(j.Wt + (size_t)(nbase + np) * j.K + k0 + k8 * 8) = w; }
}

__device__ __forceinline__ void prep_phase(const Params& p, unsigned char* shm) {
    const int tid = otid(), bid = obid(), G = gridDim.x;
    unsigned char* ws = p.ws;
    {
        ConvJob jc = conv_decode(p, ws, bid); ConvRegs rc; conv_load(jc, rc, tid);
#pragma unroll 1
        for (int t = bid; t < 12800; t += G) {
            ConvJob jn = jc; ConvRegs rn = rc;
            if (t + G < 12800) { jn = conv_decode(p, ws, t + G); conv_load(jn, rn, tid); }
            conv_store(jc, rc, tid, (unsigned*)shm);
            jc = jn; rc = rn;
        }
    }
    {
        float* ss = (float*)(ws + OFF_SSP); bf16_t* xb = (bf16_t*)(ws + OFF_XB);
        const int wid = tid >> 6, lane = tid & 63;
        for (int row = bid * 8 + wid; row < T_; row += G * 8) {
            const float* xr = p.x + (size_t)row * D_; float sq = 0.f;
#pragma unroll
            for (int i = 0; i < 8; ++i) { const f32x4 v = *(const f32x4*)(xr + (i * 64 + lane) * 4);
                sq += v[0] * v[0] + v[1] * v[1] + v[2] * v[2] + v[3] * v[3];
                *(f32x4*)(p.out + (size_t)row * D_ + (i * 64 + lane) * 4) = v;
                u32x2 w; w.x = cvt_pk_bf16(v[0], v[1]); w.y = cvt_pk_bf16(v[2], v[3]);
                *(u32x2*)(xb + (size_t)row * D_ + (i * 64 + lane) * 4) = w; }
#pragma unroll
            for (int o = 32; o > 0; o >>= 1) sq += __shfl_xor(sq, o);
            if (lane < 32) ss[(size_t)lane * T_ + row] = (lane == 0) ? sq : 0.f;
        }
        for (int i = bid * 512 + tid; i < 32 * T_; i += G * 512) ss[(size_t)3 * 32 * T_ + i] = 0.f;
        float* rssq = (float*)(ws + OFF_RSQP);
        for (int i = bid * 512 + tid; i < 64 * T_; i += G * 512) rssq[i] = 0.f;
    }
    {
        float* par = (float*)(ws + OFF_PAR);
        for (int i = bid * 512 + tid; i < PAR_N; i += G * 512) {
            float v;
            if (i < PAR_NFINAL) v = p.norm_mix[D_ + i];
            else if (i < PAR_LAM) v = p.norm_final[i - PAR_NFINAL];
            else if (i < PAR_SUBLN) v = p.a_lambda[i - PAR_LAM];
            else if (i < PAR_BD) v = p.a_subln[i - PAR_SUBLN];
            else v = p.b_d[i - PAR_BD];
            par[i] = v;
        }
    }
    {
        f32x2* rot = (f32x2*)(ws + OFF_ROT);
        for (int i = bid * 512 + tid; i < 4096 * 128; i += G * 512) {
            const int pos = i >> 7, j = i & 127;
            const double inv = exp(-9.210340371976184 * ((double)j / 127.0));
            float s, c; sincos_red((double)pos * inv, s, c);
            f32x2 v; v.x = c; v.y = s; rot[i] = v;
        }
    }
    {
        bf16_t* Bm = (bf16_t*)(ws + OFF_S5B); bf16_t* Cm = (bf16_t*)(ws + OFF_S5C); f32x2* AB = (f32x2*)(ws + OFF_S5AB);
        const float* gmix = p.norm_mix + 1 * D_;
        for (int i = bid * 512 + tid; i < 128 * 64; i += G * 512) {
            const int g = i >> 6, pp = i & 63;
            const float lre = p.b_a_re[i], lim = p.b_a_im[i];
            const float dt = __expf(p.b_log_dt[g]);
            const float mag = __expf(lre * dt);
            float sn, cs; sincos_red((double)lim * (double)dt, sn, cs);
            const float abr = mag * cs, abi = mag * sn;
            const float den = lre * lre + lim * lim;
            const float nr = abr - 1.0f, ni = abi;
            const float cr_ = (nr * lre + ni * lim) / den, ci_ = (ni * lre - nr * lim) / den;
            f32x2 ab; ab.x = abr; ab.y = abi; AB[i] = ab;
#pragma unroll
            for (int c = 0; c < 16; ++c) {
                const float br = p.b_b_re[(size_t)i * 16 + c], bi = p.b_b_im[(size_t)i * 16 + c];
                const float gm = gmix[g * 16 + c];
                Bm[((size_t)g * 128 + pp) * 16 + c] = f2bf((cr_ * br - ci_ * bi) * gm);
                Bm[((size_t)g * 128 + 64 + pp) * 16 + c] = f2bf((cr_ * bi + ci_ * br) * gm);
                Cm[((size_t)g * 16 + c) * 128 + pp] = f2bf(p.b_c_re[((size_t)g * 16 + c) * 64 + pp]);
                Cm[((size_t)g * 16 + c) * 128 + 64 + pp] = f2bf(-p.b_c_im[((size_t)g * 16 + c) * 64 + pp]);
            }
        }
    }
}

__device__ __forceinline__ void attn_phase(const Params& p, int j, float lambda_init, unsigned char* shm) {
    const int tid = otid(), wid = __builtin_amdgcn_readfirstlane(tid >> 6), lane = tid & 63, r32 = lane & 31, hi = lane >> 5;
    const bf16_t* qkv = (const bf16_t*)(p.ws + OFF_BIG);
    bf16_t* oa = (bf16_t*)(p.ws + OFF_OA);
    float* scr = (float*)(p.ws + OFF_ATT_SCR) + (size_t)obid() * 2 * 32768;
    float lam;
    { const float* lp = (const float*)(p.ws + OFF_PAR) + PAR_LAM + (size_t)j * 512;
      float a = lp[lane] * lp[128 + lane] + lp[64 + lane] * lp[192 + lane];
      float b = lp[256 + lane] * lp[384 + lane] + lp[320 + lane] * lp[448 + lane];
#pragma unroll
      for (int o = 32; o > 0; o >>= 1) { a += __shfl_xor(a, o); b += __shfl_xor(b, o); }
      lam = __expf(a) - __expf(b) + lambda_init; lam = __uint_as_float(__builtin_amdgcn_readfirstlane(__float_as_uint(lam))); }
    const float* sub = (const float*)(p.ws + OFF_PAR) + PAR_SUBLN + (size_t)j * 256;
    const int c = obid(); const int xcd = c & 7, jj = c >> 3;
    const int bh = xcd * 4 + (jj >> 3), pi = jj & 7;
    const int b = bh >> 3, h = bh & 7;
#pragma unroll 1
    for (int it = 0; it < 2; ++it) {
        const int qb = it == 0 ? (15 - pi) : pi;
        const int NT = 4 * qb + 4, ntw = 4 * qb + (wid >> 1) + 1;
        const size_t tok0 = (size_t)b * S_ + (size_t)qb * 256;
        f32x16 o[4];
#pragma unroll 1
        for (int ps = 0; ps < 4; ++ps) {
            const int e = ps >> 1, t = ps & 1;
            float* sc = scr + e * 32768;
            att::attn_body(qkv + tok0 * 6144 + h * 256 + t * 128, qkv + (size_t)b * S_ * 6144 + 2048 + h * 256 + t * 128,
                           qkv + (size_t)b * S_ * 6144 + 4096 + h * 256 + e * 128, NT, ntw, (char*)shm, o);
            if (t == 0) {
#pragma unroll
                for (int d = 0; d < 4; ++d)
#pragma unroll
                    for (int r = 0; r < 16; ++r) sc[tid * 64 + d * 16 + r] = o[d][r];
            } else {
#pragma unroll
                for (int d = 0; d < 4; ++d)
#pragma unroll
                    for (int r = 0; r < 16; ++r) { const float cv = sc[tid * 64 + d * 16 + r] - lam * o[d][r]; o[d][r] = cv; if (e == 0) sc[tid * 64 + d * 16 + r] = cv; }
            }
        }
        float ssq[16];
#pragma unroll
        for (int r = 0; r < 16; ++r) { float s = 0.f;
#pragma unroll
            for (int d = 0; d < 4; ++d) { const float c0 = scr[tid * 64 + d * 16 + r]; s += c0 * c0 + o[d][r] * o[d][r]; }
#pragma unroll
            for (int of = 16; of > 0; of >>= 1) s += __shfl_xor(s, of);
            ssq[r] = rsqrtf(s * (1.0f / 256.0f) + EPS_) * (1.0f - lambda_init); }
#pragma unroll
        for (int r = 0; r < 16; ++r) {
            const size_t row = tok0 + wid * 32 + att::crow(r, hi);
            bf16_t* op = oa + row * D_ + h * 256;
#pragma unroll
            for (int d = 0; d < 4; ++d) {
                const int col = d * 32 + r32;
                op[col] = f2bf(scr[tid * 64 + d * 16 + r] * ssq[r] * sub[col]);
                op[128 + col] = f2bf(o[d][r] * ssq[r] * sub[128 + col]);
            }
        }
    }
}

template <bool FINAL>
__device__ __forceinline__ void s5_phase(const Params& p, unsigned char* shm) {
    const int tid = otid(), wid = tid >> 6, lane = tid & 63, r32 = lane & 31, hi = lane >> 5, fr = lane & 15, fq = lane >> 4;
    const bf16_t* xb = (const bf16_t*)(p.ws + OFF_XB);
    const float* ss = (const float*)(p.ws + OFF_SSP) + (size_t)2 * 32 * T_;
    float* rsfin = (float*)(p.ws + OFF_RSFIN);
    const bf16_t* Bm = (const bf16_t*)(p.ws + OFF_S5B); const bf16_t* Cm = (const bf16_t*)(p.ws + OFF_S5C); const f32x2* AB = (const f32x2*)(p.ws + OFF_S5AB);
    f32x2* E = (f32x2*)(p.ws + OFF_BIG);
    bf16_t* gl = (bf16_t*)(p.ws + OFF_OA);
    bf16_t* Xs = (bf16_t*)shm + wid * (32 * 136);
    const float* gmix = (const float*)(p.ws + OFF_PAR) + PAR_GMIX; const float* dsk = (const float*)(p.ws + OFF_PAR) + PAR_BD;
    float* partL = (float*)(shm + 8 * 8704); float* rsL = partL + 512;
#pragma unroll 1
    for (int bc = obid(); bc < 256; bc += gridDim.x) {
      const int chunk = bc & 63, b = bc >> 6;
      const size_t t0 = (size_t)b * S_ + chunk * 64;
      __syncthreads();
      if (FINAL) { if (tid < 64) rsL[tid] = rsfin[t0 + tid]; }
      else {
          { const int row = tid & 63, part = tid >> 6; float a = 0.f;
#pragma unroll
            for (int k = 0; k < 4; ++k) a += ss[(size_t)(part * 4 + k) * T_ + t0 + row];
            partL[part * 64 + row] = a; }
          __syncthreads();
          if (tid < 64) { float tot = 0.f;
#pragma unroll
              for (int k = 0; k < 8; ++k) tot += partL[k * 64 + tid];
              const float r = rsqrtf(tot * (1.0f / D_) + EPS_); rsL[tid] = r; rsfin[t0 + tid] = r; }
      }
      __syncthreads();
#pragma unroll 1
      for (int goct = 0; goct < 16; ++goct) {
        const int g = goct * 8 + wid; const int pp = r32 + 32 * hi;
        const f32x2 ab = AB[g * 64 + pp];
        bf16x8 bfr[4];
#pragma unroll
        for (int nb = 0; nb < 4; ++nb) bfr[nb] = *(const bf16x8*)(Bm + ((size_t)g * 128 + nb * 32 + r32) * 16 + hi * 8);
        float xr = 0.f, xi = 0.f;
        bf16x8 cfr[4]; float gm4[4], ds4[4];
        if (FINAL) {
            { const f32x2 cin = E[((size_t)(b * 128 + g) * 64 + chunk) * 64 + pp]; xr = cin.x; xi = cin.y; }
#pragma unroll
            for (int ks = 0; ks < 4; ++ks) cfr[ks] = *(const bf16x8*)(Cm + ((size_t)g * 16 + fr) * 128 + ks * 32 + fq * 8);
#pragma unroll
            for (int jx = 0; jx < 4; ++jx) { gm4[jx] = gmix[g * 16 + 4 * fq + jx]; ds4[jx] = dsk[g * 16 + 4 * fq + jx]; }
        }
#pragma unroll
        for (int half = 0; half < 2; ++half) {
            const size_t trow = t0 + half * 32 + r32;
            const float rs = rsL[half * 32 + r32];
            const u32x4 raw = *(const u32x4*)(xb + trow * D_ + g * 16 + hi * 8);
            u32x4 sc4;
            sc4.x = cvt_pk_bf16(bflo(raw.x) * rs, bfhi(raw.x) * rs); sc4.y = cvt_pk_bf16(bflo(raw.y) * rs, bfhi(raw.y) * rs);
            sc4.z = cvt_pk_bf16(bflo(raw.z) * rs, bfhi(raw.z) * rs); sc4.w = cvt_pk_bf16(bflo(raw.w) * rs, bfhi(raw.w) * rs);
            const bf16x8 afr = *reinterpret_cast<const bf16x8*>(&sc4);
            f32x16 c0 = __builtin_amdgcn_mfma_f32_32x32x16_bf16(afr, bfr[0], f32x16{}, 0, 0, 0);
            f32x16 c1 = __builtin_amdgcn_mfma_f32_32x32x16_bf16(afr, bfr[1], f32x16{}, 0, 0, 0);
            f32x16 c2 = __builtin_amdgcn_mfma_f32_32x32x16_bf16(afr, bfr[2], f32x16{}, 0, 0, 0);
            f32x16 c3 = __builtin_amdgcn_mfma_f32_32x32x16_bf16(afr, bfr[3], f32x16{}, 0, 0, 0);
#pragma unroll
            for (int i = 0; i < 16; ++i) {
                auto r0 = __builtin_amdgcn_permlane32_swap(__float_as_uint(c0[i]), __float_as_uint(c1[i]), false, false);
                c0[i] = __uint_as_float(r0[0]); c1[i] = __uint_as_float(r0[1]);
                auto r1 = __builtin_amdgcn_permlane32_swap(__float_as_uint(c2[i]), __float_as_uint(c3[i]), false, false);
                c2[i] = __uint_as_float(r1[0]); c3[i] = __uint_as_float(r1[1]);
            }
#pragma unroll
            for (int t = 0; t < 32; ++t) {
                const int q = t >> 3, s = t & 7, idx = 4 * q + (s & 3);
                const float bur = (s < 4) ? c0[idx] : c1[idx], bui = (s < 4) ? c2[idx] : c3[idx];
                const float nr = ab.x * xr - ab.y * xi + bur, ni = ab.x * xi + ab.y * xr + bui;
                xr = nr; xi = ni;
                if (FINAL) { Xs[t * 136 + pp] = f2bf(xr); Xs[t * 136 + 64 + pp] = f2bf(xi); }
            }
            if (FINAL) {
                asm volatile("s_waitcnt lgkmcnt(0)" ::: "memory");
#pragma unroll
                for (int m = 0; m < 2; ++m) {
                    f32x4 acc = {0.f, 0.f, 0.f, 0.f};
#pragma unroll
                    for (int ks = 0; ks < 4; ++ks) {
                        const bf16x8 xf = *(const bf16x8*)(Xs + (m * 16 + fr) * 136 + ks * 32 + fq * 8);
                        acc = __builtin_amdgcn_mfma_f32_16x16x32_bf16(cfr[ks], xf, acc, 0, 0, 0);
                    }
                    const size_t tr2 = t0 + half * 32 + m * 16 + fr;
                    const float rs2 = rsL[half * 32 + m * 16 + fr];
                    const u32x2 hx = *(const u32x2*)(xb + tr2 * D_ + g * 16 + 4 * fq);
                    const float h0 = bflo(hx.x) * rs2 * gm4[0], h1 = bfhi(hx.x) * rs2 * gm4[1], h2 = bflo(hx.y) * rs2 * gm4[2], h3 = bfhi(hx.y) * rs2 * gm4[3];
                    const float y0 = gelu_tanh(acc[0] + ds4[0] * h0), y1 = gelu_tanh(acc[1] + ds4[1] * h1), y2 = gelu_tanh(acc[2] + ds4[2] * h2), y3 = gelu_tanh(acc[3] + ds4[3] * h3);
                    u32x2 w; w.x = cvt_pk_bf16(y0, y1); w.y = cvt_pk_bf16(y2, y3);
                    *(u32x2*)(gl + tr2 * D_ + g * 16 + 4 * fq) = w;
                }
                asm volatile("s_waitcnt lgkmcnt(0)" ::: "memory");
            }
        }
        if (!FINAL) { f32x2 e; e.x = xr; e.y = xi; E[((size_t)(b * 128 + g) * 64 + chunk) * 64 + pp] = e; }
      }
    }
}

__device__ __forceinline__ void s5_scan_phase(const Params& p) {
    const int tid = otid(), bid = obid();
    if (tid >= 128) return;
    f32x2* E = (f32x2*)(p.ws + OFF_BIG); const f32x2* AB = (const f32x2*)(p.ws + OFF_S5AB);
    for (int seq = bid * 128 + tid; seq < 4 * 128 * 64; seq += gridDim.x * 128) {
        const int pp = seq & 63, bg = seq >> 6, g = bg & 127;
        const f32x2 ab = AB[g * 64 + pp];
        float pr = ab.x, pi_ = ab.y;
#pragma unroll
        for (int k = 0; k < 6; ++k) { const float nr = pr * pr - pi_ * pi_, ni = 2.f * pr * pi_; pr = nr; pi_ = ni; }
        f32x2* Ep = E + (size_t)bg * 64 * 64 + pp;
        float xr = 0.f, xi = 0.f;
#pragma unroll 1
        for (int c0 = 0; c0 < 64; c0 += 16) {
            f32x2 e[16];
#pragma unroll
            for (int k = 0; k < 16; ++k) e[k] = Ep[(size_t)(c0 + k) * 64];
#pragma unroll
            for (int k = 0; k < 16; ++k) { f32x2 x; x.x = xr; x.y = xi; Ep[(size_t)(c0 + k) * 64] = x;
                const float nr = pr * xr - pi_ * xi + e[k].x, ni = pr * xi + pi_ * xr + e[k].y; xr = nr; xi = ni; }
        }
    }
}

__device__ __forceinline__ void ret_phase(const Params& p, unsigned char* shm, float* rssq) {
    const int tid = otid(), wid = tid >> 6, lane = tid & 63, fr = lane & 15, fq = lane >> 4;
    const bf16_t* ret = (const bf16_t*)(p.ws + OFF_BIG);
    bf16_t* ao = (bf16_t*)(p.ws + OFF_OA);
    constexpr int QS = 264, TS = 72;
    bf16_t* Qs = (bf16_t*)shm; bf16_t* Ks = Qs + 64 * QS; bf16_t* KTs = Ks + 64 * QS; bf16_t* VTs = KTs + 256 * TS; bf16_t* Ss = VTs + 64 * TS; bf16_t* RTs = Ss + 64 * TS;
    const int c = obid(); const int xcd = c & 7, jj = c >> 3;
    const int bh = xcd * 4 + (jj >> 3), sl = jj & 7;
    const int b = bh >> 3, h = bh & 7;
    const float lg = logf(1.0f - exp2f(-5.0f - (float)h));
    const float cdec = __expf(lg * 64.0f);
    const int mi = wid >> 1, ni0 = 2 * (wid & 1);
    const float qdec = __expf(lg * (float)(16 * mi + fr + 1));
    float idec[2][4];
#pragma unroll
    for (int t = 0; t < 2; ++t)
#pragma unroll
        for (int j = 0; j < 4; ++j) { const int n = 16 * mi + fr, m = 16 * (ni0 + t) + 4 * fq + j; idec[t][j] = __expf(lg * (fabsf((float)(n - m)) - (float)(63 - m))); }
    f32x4 R[4][2];
#pragma unroll
    for (int a = 0; a < 4; ++a)
#pragma unroll
        for (int d = 0; d < 2; ++d) R[a][d] = (f32x4){0.f, 0.f, 0.f, 0.f};
    const size_t tokb = (size_t)b * S_;
    const bf16_t* qsrc = ret + (tokb + lane) * 12288 + h * 256 + wid * 32;
    const bf16_t* ksrc = qsrc + 2048;
    const bf16_t* vsrc = ret + (tokb + lane) * 12288 + 4096 + h * 512 + sl * 64 + wid * 8;
    u32x4 pq[4], pk[4], pv; u32x2 pg[2], cg2[2];
    const bf16_t* gsrc = ret + (tokb + 16 * mi + fr) * 12288 + 8192 + h * 512 + sl * 64 + 16 * ni0 + 4 * fq;
#pragma unroll
    for (int j = 0; j < 4; ++j) { pq[j] = *(const u32x4*)(qsrc + j * 8); pk[j] = *(const u32x4*)(ksrc + j * 8); }
    pv = *(const u32x4*)vsrc;
    pg[0] = *(const u32x2*)gsrc; pg[1] = *(const u32x2*)(gsrc + 16);
    for (int ch = 0; ch < 64; ++ch) {
        __syncthreads();
        cg2[0] = pg[0]; cg2[1] = pg[1];
#pragma unroll
        for (int j = 0; j < 4; ++j) {
            *(u32x4*)(Qs + lane * QS + wid * 32 + j * 8) = pq[j];
            *(u32x4*)(Ks + lane * QS + wid * 32 + j * 8) = pk[j];
            const unsigned kw[4] = {pk[j].x, pk[j].y, pk[j].z, pk[j].w};
#pragma unroll
            for (int i = 0; i < 4; ++i) {
                KTs[(wid * 32 + j * 8 + 2 * i) * TS + lane] = (bf16_t)(kw[i] & 0xffffu);
                KTs[(wid * 32 + j * 8 + 2 * i + 1) * TS + lane] = (bf16_t)(kw[i] >> 16);
            }
        }
        { const unsigned vw[4] = {pv.x, pv.y, pv.z, pv.w};
#pragma unroll
          for (int i = 0; i < 4; ++i) { VTs[(wid * 8 + 2 * i) * TS + lane] = (bf16_t)(vw[i] & 0xffffu); VTs[(wid * 8 + 2 * i + 1) * TS + lane] = (bf16_t)(vw[i] >> 16); } }
#pragma unroll
        for (int ei = 0; ei < 4; ++ei)
#pragma unroll
            for (int di = 0; di < 2; ++di) { u32x2 w; w.x = cvt_pk_bf16(R[ei][di][0], R[ei][di][1]); w.y = cvt_pk_bf16(R[ei][di][2], R[ei][di][3]);
                *(u32x2*)(RTs + (16 * ei + fr) * QS + wid * 32 + 16 * di + 4 * fq) = w; }
        if (ch + 1 < 64) {
            const size_t adv = (size_t)(ch + 1) * 64 * 12288;
#pragma unroll
            for (int j = 0; j < 4; ++j) { pq[j] = *(const u32x4*)(qsrc + adv + j * 8); pk[j] = *(const u32x4*)(ksrc + adv + j * 8); }
            pv = *(const u32x4*)(vsrc + adv);
            pg[0] = *(const u32x2*)(gsrc + adv); pg[1] = *(const u32x2*)(gsrc + adv + 16);
        }
        __syncthreads();
        bf16x8 qa[8];
        {
            f32x4 sacc[2] = {{0.f, 0.f, 0.f, 0.f}, {0.f, 0.f, 0.f, 0.f}};
#pragma unroll
            for (int ks = 0; ks < 8; ++ks) qa[ks] = *(const bf16x8*)(Qs + (16 * mi + fr) * QS + ks * 32 + fq * 8);
#pragma unroll
            for (int ks = 0; ks < 8; ++ks) {
#pragma unroll
                for (int t = 0; t < 2; ++t) { const bf16x8 bf = *(const bf16x8*)(Ks + (16 * (ni0 + t) + fr) * QS + ks * 32 + fq * 8);
                    sacc[t] = __builtin_amdgcn_mfma_f32_16x16x32_bf16(bf, qa[ks], sacc[t], 0, 0, 0); }
            }
#pragma unroll
            for (int t = 0; t < 2; ++t) { u32x2 w; w.x = cvt_pk_bf16(sacc[t][0] * idec[t][0], sacc[t][1] * idec[t][1]); w.y = cvt_pk_bf16(sacc[t][2] * idec[t][2], sacc[t][3] * idec[t][3]);
                *(u32x2*)(Ss + (16 * mi + fr) * TS + 16 * (ni0 + t) + 4 * fq) = w; }
        }
        __syncthreads();
        {
            f32x4 oi[2] = {{0.f, 0.f, 0.f, 0.f}, {0.f, 0.f, 0.f, 0.f}}, oc[2] = {{0.f, 0.f, 0.f, 0.f}, {0.f, 0.f, 0.f, 0.f}};
#pragma unroll
            for (int ks = 0; ks < 2; ++ks) {
                const bf16x8 af = *(const bf16x8*)(Ss + (16 * mi + fr) * TS + ks * 32 + fq * 8);
#pragma unroll
                for (int t = 0; t < 2; ++t) { const bf16x8 bf = *(const bf16x8*)(VTs + (16 * (ni0 + t) + fr) * TS + ks * 32 + fq * 8);
                    oi[t] = __builtin_amdgcn_mfma_f32_16x16x32_bf16(bf, af, oi[t], 0, 0, 0); }
            }
#pragma unroll
            for (int ks = 0; ks < 8; ++ks) {
#pragma unroll
                for (int t = 0; t < 2; ++t) { const bf16x8 bf = *(const bf16x8*)(RTs + (16 * (ni0 + t) + fr) * QS + ks * 32 + fq * 8);
                    oc[t] = __builtin_amdgcn_mfma_f32_16x16x32_bf16(bf, qa[ks], oc[t], 0, 0, 0); }
            }
            const size_t tok = tokb + (size_t)ch * 64 + 16 * mi + fr;
            float sq = 0.f;
#pragma unroll
            for (int t = 0; t < 2; ++t) {
                const int e = sl * 64 + 16 * (ni0 + t) + 4 * fq;
                const u32x2 gw = cg2[t];
                f32x4 ov = oi[t] + oc[t] * qdec;
                sq += ov[0] * ov[0] + ov[1] * ov[1] + ov[2] * ov[2] + ov[3] * ov[3];
                u32x2 w; w.x = cvt_pk_bf16(ov[0] * bflo(gw.x), ov[1] * bfhi(gw.x)); w.y = cvt_pk_bf16(ov[2] * bflo(gw.y), ov[3] * bfhi(gw.y));
                *(u32x2*)(ao + tok * 4096 + h * 512 + e) = w;
            }
            sq += __shfl_xor(sq, 16); sq += __shfl_xor(sq, 32);
            if (fq == 0) atomicAdd(rssq + (size_t)(sl * 4 + mi) * 0 + (size_t)sl * (T_ * 8) + tok * 8 + h, sq);
        }
#pragma unroll
        for (int ei = 0; ei < 4; ++ei)
#pragma unroll
            for (int di = 0; di < 2; ++di) R[ei][di] *= cdec;
#pragma unroll
        for (int ks = 0; ks < 2; ++ks) {
            bf16x8 bfk[2];
#pragma unroll
            for (int di = 0; di < 2; ++di) bfk[di] = *(const bf16x8*)(KTs + (wid * 32 + 16 * di + fr) * TS + ks * 32 + fq * 8);
#pragma unroll
            for (int ei = 0; ei < 4; ++ei) { const bf16x8 af = *(const bf16x8*)(VTs + (16 * ei + fr) * TS + ks * 32 + fq * 8);
#pragma unroll
                for (int di = 0; di < 2; ++di) R[ei][di] = __builtin_amdgcn_mfma_f32_16x16x32_bf16(bfk[di], af, R[ei][di], 0, 0, 0); }
        }
    }
}

__device__ __forceinline__ void ret2_phase(const Params& p) {
    bf16_t* ao = (bf16_t*)(p.ws + OFF_OA); const float* rssq = (const float*)(p.ws + OFF_RSQP);
    const size_t nvec = (size_t)T_ * 4096 / 8, stride = (size_t)gridDim.x * 512;
    for (size_t i0 = (size_t)obid() * 512 + otid(); i0 < nvec; i0 += 4 * stride) {
        u32x4 w[4]; float rsum[4];
#pragma unroll
        for (int u = 0; u < 4; ++u) { const size_t i = i0 + u * stride; w[u] = *(u32x4*)(ao + i * 8);
            const size_t t = i >> 9; const int hh = (int)((i & 511) >> 6); float a = 0.f;
#pragma unroll
            for (int sl = 0; sl < 8; ++sl) a += rssq[(size_t)sl * (T_ * 8) + t * 8 + hh];
            rsum[u] = a; }
#pragma unroll
        for (int u = 0; u < 4; ++u) { const size_t i = i0 + u * stride; const float rs = rsqrtf(rsum[u] * (1.0f / 512.0f) + EPS_);
            u32x4 x = w[u];
            x.x = cvt_pk_bf16(bflo(x.x) * rs, bfhi(x.x) * rs); x.y = cvt_pk_bf16(bflo(x.y) * rs, bfhi(x.y) * rs);
            x.z = cvt_pk_bf16(bflo(x.z) * rs, bfhi(x.z) * rs); x.w = cvt_pk_bf16(bflo(x.w) * rs, bfhi(x.w) * rs);
            *(u32x4*)(ao + i * 8) = x; }
    }
}

__device__ __forceinline__ void final_phase(const Params& p) {
    const float* ss = (const float*)(p.ws + OFF_SSP) + (size_t)8 * 32 * T_;
    const int tid = otid();
    const f32x4 g = *(const f32x4*)((const float*)(p.ws + OFF_PAR) + PAR_NFINAL + tid * 4);
    const int G = gridDim.x;
    for (int row0 = obid(); row0 < T_; row0 += 4 * G) {
        f32x4 v[4]; float sm[4];
#pragma unroll
        for (int u = 0; u < 4; ++u) { const int row = row0 + u * G; sm[u] = ss[(size_t)(tid & 31) * T_ + row]; v[u] = *(f32x4*)(p.out + (size_t)row * D_ + tid * 4); }
#pragma unroll
        for (int u = 0; u < 4; ++u) { const int row = row0 + u * G; float ssum = sm[u];
#pragma unroll
            for (int o = 16; o > 0; o >>= 1) ssum += __shfl_xor(ssum, o);
            const float rs = rsqrtf(ssum * (1.0f / D_) + EPS_);
            *(f32x4*)(p.out + (size_t)row * D_ + tid * 4) = v[u] * rs * g; }
    }
}

enum { OP_PREP = 0, OP_A_IN, OP_ATTN, OP_A_OUT, OP_S5A, OP_S5C, OP_GLU, OP_C_IN, OP_RET, OP_RET2, OP_C_OUT, OP_W1, OP_W2, OP_FINAL, OP_S5B };
#ifndef PHMASK
#define PHMASK 0xffff
#endif
#define PHON(b) ((PHMASK >> (b)) & 1)
constexpr int NPH = 24;
__device__ const unsigned char PROG_OP[NPH] = { OP_PREP,
    OP_A_IN, OP_ATTN, OP_A_OUT, OP_W1, OP_W2,
    OP_S5A, OP_S5B, OP_S5C, OP_GLU, OP_W1, OP_W2,
    OP_C_IN, OP_RET, OP_RET2, OP_C_OUT, OP_W1, OP_W2,
    OP_A_IN, OP_ATTN, OP_A_OUT, OP_W1, OP_W2,
    OP_FINAL };
__device__ const unsigned char PROG_LAYER[NPH] = { 0, 0, 0, 0, 0, 0, 1, 1, 1, 1, 1, 1, 2, 2, 2, 2, 2, 2, 3, 3, 3, 3, 3, 3 };

struct GemmDesc { unsigned long long a_off, b_off; int N, K, ss_idx, mode; };
#define GD_NONE {0, 0, 0, 0, 0, 0}
#define GD_A_IN(L)  {OFF_XB, OFF_WT_A_IN + (L / 3) * SZ_A_IN, 6144, 2048, 2 * L, 0}
#define GD_A_OUT(L) {OFF_OA, OFF_WT_A_OUT + (L / 3) * SZ_A_OUT, 2048, 2048, 2 * L + 1, 0}
#define GD_W1(L)    {OFF_XB, OFF_WT_W1 + L * SZ_W1, 8192, 2048, 2 * L + 1, 1}
#define GD_W2(L)    {OFF_BIG, OFF_WT_W2 + L * SZ_W1, 2048, 8192, 2 * L + 2, 0}
#define GD_GLU(L)   {OFF_OA, OFF_WT_GLU, 4096, 2048, 2 * L + 1, 1}
#define GD_C_IN(L)  {OFF_XB, OFF_WT_C_IN, 12288, 2048, 2 * L, 2}
#define GD_C_OUT(L) {OFF_OA, OFF_WT_C_OUT, 2048, 4096, 2 * L + 1, 0}
__device__ const GemmDesc GD[NPH] = { GD_NONE,
    GD_A_IN(0ull), GD_NONE, GD_A_OUT(0ull), GD_W1(0ull), GD_W2(0ull),
    GD_NONE, GD_NONE, GD_NONE, GD_GLU(1ull), GD_W1(1ull), GD_W2(1ull),
    GD_C_IN(2ull), GD_NONE, GD_NONE, GD_C_OUT(2ull), GD_W1(2ull), GD_W2(2ull),
    GD_A_IN(3ull), GD_NONE, GD_A_OUT(3ull), GD_W1(3ull), GD_W2(3ull),
    GD_NONE };

#define XB_TMO      128
#define XB_XCNT(j)  (256  + 64 * (j))
#define XB_XSUB(j)  (1280 + 64 * (j))
#define XB_XGEN(j)  (2304 + 64 * (j))
#define XB_TOP      3328
#define XB_TOPGEN   3392
#define XCD_BAR_WORDS 3456
#define XB_SPIN_CAP (1u << 22)
__device__ __forceinline__ unsigned xb_ld(unsigned* p)              { return __hip_atomic_load(p, __ATOMIC_RELAXED, __HIP_MEMORY_SCOPE_AGENT); }
__device__ __forceinline__ unsigned xb_add(unsigned* p, unsigned v) { return __hip_atomic_fetch_add(p, v, __ATOMIC_RELAXED, __HIP_MEMORY_SCOPE_AGENT); }
__device__ __forceinline__ unsigned xb_xcc_id() { return (unsigned)__builtin_amdgcn_s_getreg((3 << 11) | 20) & 0xFu; }
#define XB_SPIN(cond, bar) do { unsigned _sp = 0; while (cond) { __builtin_amdgcn_s_sleep(1); \
    if ((++_sp & 255u) == 0u) { if (xb_ld(&(bar)[XB_TMO])) break; if (_sp > XB_SPIN_CAP) { atomicAdd(&(bar)[XB_TMO], 1u); break; } } } } while (0)
struct XcdBarrier { unsigned* bar; unsigned x; volatile LAS unsigned* st; };
__device__ __forceinline__ XcdBarrier xcd_barrier_post(unsigned* bar, volatile LAS unsigned* st) {
    XcdBarrier b; b.bar = bar; b.x = xb_xcc_id(); b.st = st;
    if (threadIdx.x == 0) (void)xb_add(&bar[XB_XCNT(b.x)], 1u);
    return b;
}
__device__ __forceinline__ void xcd_barrier_complete(unsigned* bar, unsigned x, unsigned& nloc, unsigned& nx) {
    const unsigned G = gridDim.x * gridDim.y * gridDim.z;
    unsigned sum, cnt, mine, sp = 0u;
    for (;;) {
        sum = 0u; cnt = 0u; mine = 0u;
#pragma unroll
        for (unsigned j = 0; j < 16; ++j) { const unsigned c = xb_ld(&bar[XB_XCNT(j)]); sum += c; cnt += (c > 0u) ? 1u : 0u; mine = (j == x) ? c : mine; }
        if (sum == G) break;
        __builtin_amdgcn_s_sleep(1);
        if ((++sp & 255u) == 0u) { if (xb_ld(&bar[XB_TMO])) break; if (sp > XB_SPIN_CAP) { atomicAdd(&bar[XB_TMO], 1u); break; } }
    }
    nloc = mine > 0u ? mine : 1u; nx = cnt > 0u ? cnt : 1u;
}
__device__ __forceinline__ void xcd_barrier(unsigned char* ws, unsigned char* shm) {
    XcdBarrier b; b.bar = (unsigned*)(ws + OFF_BAR); b.x = xb_xcc_id(); b.st = (volatile LAS unsigned*)((LAS unsigned char*)shm + LDS_PHASE_BYTES);
    asm volatile("s_waitcnt vmcnt(0) lgkmcnt(0)" ::: "memory");
    __syncthreads();
    if (threadIdx.x == 0) {
        unsigned* bar = b.bar;
        __builtin_amdgcn_s_waitcnt(0);
        unsigned nloc = b.st[0], nx = b.st[1];
        if (nloc == 0u) { xcd_barrier_complete(bar, b.x, nloc, nx); b.st[0] = nloc; b.st[1] = nx; }
        const unsigned old = xb_add(&bar[XB_XSUB(b.x)], 1u);
        const unsigned gen = old / nloc;
        if (old + 1u == (gen + 1u) * nloc) {
            __builtin_amdgcn_fence(__ATOMIC_RELEASE, "agent");
            asm volatile("s_waitcnt vmcnt(0)" ::: "memory");
            const unsigned og = xb_add(&bar[XB_TOP], 1u);
            const unsigned tg = og / nx;
            if (og + 1u == (tg + 1u) * nx) xb_add(&bar[XB_TOPGEN], 1u);
            else XB_SPIN(xb_ld(&bar[XB_TOPGEN]) == tg, bar);
            __builtin_amdgcn_fence(__ATOMIC_ACQUIRE, "agent");
            xb_add(&bar[XB_XGEN(b.x)], 1u);
            asm volatile("s_waitcnt vmcnt(0)" ::: "memory");
        } else {
            XB_SPIN(xb_ld(&bar[XB_XGEN(b.x)]) == gen, bar);
            __builtin_amdgcn_fence(__ATOMIC_ACQUIRE, "agent");
            asm volatile("s_waitcnt vmcnt(0)" ::: "memory");
        }
    }
    __syncthreads();
}
__device__ __forceinline__ void gsync_cg(cg::grid_group& grid) {
    asm volatile("s_waitcnt vmcnt(0) lgkmcnt(0)" ::: "memory");
    grid.sync();
    __builtin_amdgcn_fence(__ATOMIC_ACQUIRE, "agent");
    asm volatile("s_waitcnt vmcnt(0) lgkmcnt(0)" ::: "memory");
}

__global__ void __launch_bounds__(512, 2) fwd_megakernel(Params p, int ph_lo, int ph_hi) {
    extern __shared__ __attribute__((aligned(16))) unsigned char shm[];
    cg::grid_group grid = cg::this_grid();
    volatile LAS unsigned* xst = (volatile LAS unsigned*)((LAS unsigned char*)shm + LDS_PHASE_BYTES);
    if (threadIdx.x == 0) { xst[0] = 0u; xst[1] = 0u; }
    __syncthreads();
    (void)xcd_barrier_post((unsigned*)(p.ws + OFF_BAR), xst);
#ifndef DUPMASK
#define DUPMASK 0
#endif
    if (PHON(0) && ph_lo == 0) {
#pragma unroll 1
        for (int rp_ = 0; rp_ < ((DUPMASK & 1) ? 2 : 1); ++rp_) { prep_phase(p, shm); if (ph_hi > 1) gsync_cg(grid); } }
    for (int ph = (ph_lo < 1 ? 1 : ph_lo); ph < ph_hi; ++ph) {
        const int op = PROG_OP[ph], L = PROG_LAYER[ph];
        const int nrep_ = ((DUPMASK >> op) & 1) ? 2 : 1;
#pragma unroll 1
        for (int rp_ = 0; rp_ < nrep_; ++rp_) {
        unsigned char* ws = p.ws; asm volatile("" : "+s"(ws));
        float* ssb = (float*)(ws + OFF_SSP);
        if (PHON(1) && (op == OP_A_IN || op == OP_C_IN || op == OP_W1)) {
            const GemmDesc gd = GD[ph];
            pg8::Gemm g; g.A = (const bf16_t*)(ws + gd.a_off); g.Bt = (const bf16_t*)(ws + gd.b_off); g.M = T_; g.N = gd.N; g.K = gd.K;
            pg8::EpiBf E; E.rot = (const f32x2*)(ws + OFF_ROT); E.O = (bf16_t*)(ws + OFF_BIG); E.ldc = gd.N; E.mode = gd.mode; E.ss = ssb + (size_t)gd.ss_idx * 32 * T_;
            pg8::StaticOrder S; S.init(g.M, g.N, (int)gridDim.x, obid());
            {
                float* lrs = (float*)(shm + pg8::STAGE_BYTES); const int tid2 = otid();
                int nun = 0; { pg8::Unit uu; while (nun < 24 && S.next(nun, uu)) ++nun; }
                for (int j = tid2; j < nun * 256; j += 512) { pg8::Unit uu; S.next(j >> 8, uu);
                    const float* sp = E.ss + (size_t)uu.pm * 256 + (j & 255); float sv[32];
#pragma unroll
                    for (int sl = 0; sl < 32; ++sl) sv[sl] = sp[(size_t)sl * T_];
                    float a = 0.f;
#pragma unroll
                    for (int sl = 0; sl < 32; ++sl) a += sv[sl];
                    lrs[j] = rsqrtf(a * (1.0f / D_) + EPS_); }
                __syncthreads();
            }
            pg8::gemm_phase<pg8::EpiBf, pg8::StaticOrder>((LAS unsigned char*)shm, g, S, E);
        } else if (PHON(2) && (op == OP_A_OUT || op == OP_GLU || op == OP_C_OUT || op == OP_W2)) {
            const GemmDesc gd = GD[ph];
            pg8::Gemm g; g.A = (const bf16_t*)(ws + gd.a_off); g.Bt = (const bf16_t*)(ws + gd.b_off); g.M = T_; g.N = gd.N; g.K = gd.K;
            pg8::EpiRes E; E.xout = p.out; E.xb = (bf16_t*)(ws + OFF_XB); E.glu = gd.mode; E.xin = p.out; E.ssn = ssb + (size_t)gd.ss_idx * 32 * T_;
            pg8::StaticOrder S; S.init(g.M, g.N, (int)gridDim.x, obid());
            pg8::gemm_phase<pg8::EpiRes, pg8::StaticOrder>((LAS unsigned char*)shm, g, S, E);
        } else if (PHON(3) && op == OP_ATTN) {
            const float li = 0.8f - 0.6f * expf(-0.3f * (float)L);
            attn_phase(p, L / 3, li, shm);
        } else if (PHON(4) && op == OP_S5A) {
            s5_phase<false>(p, shm);
        } else if (PHON(4) && op == OP_S5B) {
            s5_scan_phase(p);
        } else if (PHON(5) && op == OP_S5C) {
            s5_phase<true>(p, shm);
        } else if (PHON(6) && op == OP_RET) {
            ret_phase(p, shm, (float*)(ws + (rp_ == 0 ? OFF_RSQP : OFF_XB)));
        } else if (PHON(7) && op == OP_RET2) {
            ret2_phase(p);
        } else if (PHON(8) && op == OP_FINAL) {
            final_phase(p);
        }
        if (ph + 1 < ph_hi || rp_ + 1 < nrep_) xcd_barrier(ws, shm);
        }
    }
}

extern "C" void kernel_launch(void* const* d_in, const int* in_sizes, int n_in, void* d_out, int out_size, void* d_ws, size_t ws_size, hipStream_t stream) {
    static int grid_blocks = 0;
    if (grid_blocks == 0) {
        if (n_in != 21 || out_size != T_ * D_ || ws_size < WS_NEED) { fprintf(stderr, "kernel_launch: unexpected shapes n_in %d out %d ws %zu (need %zu)\n", n_in, out_size, ws_size, (size_t)WS_NEED); grid_blocks = -1; return; }
        int dev = 0, cus = 0, per_cu = 0;
        hipGetDevice(&dev);
        hipDeviceGetAttribute(&cus, hipDeviceAttributeMultiprocessorCount, dev);
        if (hipFuncSetAttribute((const void*)fwd_megakernel, hipFuncAttributeMaxDynamicSharedMemorySize, LDS_BYTES) != hipSuccess) { fprintf(stderr, "kernel_launch: hipFuncSetAttribute failed\n"); grid_blocks = -1; return; }
        hipOccupancyMaxActiveBlocksPerMultiprocessor(&per_cu, (const void*)fwd_megakernel, 512, LDS_BYTES);
        (void)hipGetLastError();
        if (per_cu < 1) per_cu = 1;
        grid_blocks = cus * 1;
        if (grid_blocks != 256) fprintf(stderr, "kernel_launch: note: %d CUs (kernel tuned for 256)\n", cus);
    }
    if (grid_blocks < 0) return;
    (void)hipMemsetAsync((unsigned char*)d_ws + OFF_BAR, 0, XCD_BAR_WORDS * 4, stream);
    Params p{};
    const float** pp = (const float**)&p;
    for (int i = 0; i < 21; ++i) pp[i] = (const float*)d_in[i];
    p.out = (float*)d_out; p.ws = (unsigned char*)d_ws;
#ifndef DBG_LO
#define DBG_LO 0
#endif
#ifndef DBG_HI
#define DBG_HI NPH
#endif
    int lo = DBG_LO, hi = DBG_HI;
    void* args[] = {&p, &lo, &hi};
    hipError_t e = hipLaunchCooperativeKernel((const void*)fwd_megakernel, dim3(grid_blocks), dim3(512), args, LDS_BYTES, stream);
    if (e != hipSuccess) fprintf(stderr, "cooperative launch failed: %s (grid %d)\n", hipGetErrorString(e), grid_blocks);
}
```

```cpp
#include <hip/hip_runtime.h>
#include <hip/hip_cooperative_groups.h>
#include <cstdio>
#include <cstdint>
namespace cg = cooperative_groups;

#define LAS __attribute__((address_space(3)))
typedef unsigned short bf16_t;
typedef short bf16x8 __attribute__((ext_vector_type(8)));
typedef short s16x4 __attribute__((ext_vector_type(4)));
typedef float f32x4 __attribute__((ext_vector_type(4)));
typedef float f32x2 __attribute__((ext_vector_type(2)));
typedef float f32x16 __attribute__((ext_vector_type(16)));
typedef unsigned u32x4 __attribute__((ext_vector_type(4)));
typedef unsigned u32x2 __attribute__((ext_vector_type(2)));

constexpr int T_ = 16384, D_ = 2048, S_ = 4096;
constexpr float EPS_ = 1e-6f;
constexpr int LDS_PHASE_BYTES = 156672;
constexpr int LDS_BYTES = LDS_PHASE_BYTES + 16;

constexpr size_t SZ_A_IN = 6144ull * 2048 * 2, SZ_A_OUT = 2048ull * 2048 * 2, SZ_W1 = 8192ull * 2048 * 2;
constexpr size_t OFF_WT_A_IN = 0;
constexpr size_t OFF_WT_A_OUT = OFF_WT_A_IN + 2 * SZ_A_IN;
constexpr size_t OFF_WT_GLU = OFF_WT_A_OUT + 2 * SZ_A_OUT;
constexpr size_t OFF_WT_C_IN = OFF_WT_GLU + 4096ull * 2048 * 2;
constexpr size_t OFF_WT_C_OUT = OFF_WT_C_IN + 12288ull * 2048 * 2;
constexpr size_t OFF_WT_W1 = OFF_WT_C_OUT + 2048ull * 4096 * 2;
constexpr size_t OFF_WT_W2 = OFF_WT_W1 + 4 * SZ_W1;
constexpr size_t OFF_XB = OFF_WT_W2 + 4 * SZ_W1;
constexpr size_t OFF_BIG = OFF_XB + (size_t)T_ * D_ * 2;
constexpr size_t OFF_OA = OFF_BIG + (size_t)T_ * 12288 * 2;
constexpr size_t OFF_SS = OFF_OA + (size_t)T_ * 4096 * 2;
constexpr size_t OFF_RSSQ = OFF_SS + 9ull * T_ * 4;
constexpr size_t OFF_ROT = OFF_RSSQ + (size_t)T_ * 8 * 4;
constexpr size_t OFF_S5B = OFF_ROT + 4096ull * 128 * 8;
constexpr size_t OFF_S5C = OFF_S5B + 128ull * 128 * 16 * 2;
constexpr size_t OFF_S5AB = OFF_S5C + 128ull * 16 * 128 * 2;
constexpr size_t WS_END = OFF_S5AB + 128ull * 64 * 8;
constexpr size_t OFF_SSP = WS_END;
constexpr size_t OFF_RSQP = OFF_SSP + 9ull * 32 * T_ * 4;
constexpr size_t OFF_RSFIN = OFF_RSQP + 8ull * T_ * 8 * 4;
constexpr size_t OFF_BAR = OFF_RSFIN + (size_t)T_ * 4;
constexpr size_t OFF_PAR = OFF_BAR + 16384;
constexpr int PAR_GMIX = 0, PAR_NFINAL = 2048, PAR_LAM = 4096, PAR_SUBLN = 5120, PAR_BD = 5632, PAR_N = 7680;
constexpr size_t WS_NEED = OFF_PAR + PAR_N * 4;
constexpr size_t OFF_ATT_SCR = OFF_BIG + (size_t)T_ * 6144 * 2;

struct Params {
    const float* x; const float* norm_mix; const float* norm_mlp; const float* norm_final;
    const float* a_w_in; const float* a_lambda; const float* a_subln; const float* a_w_out;
    const float* b_a_re; const float* b_a_im; const float* b_log_dt; const float* b_b_re; const float* b_b_im;
    const float* b_c_re; const float* b_c_im; const float* b_d; const float* b_w_glu;
    const float* c_w_in; const float* c_w_out; const float* mlp_w1; const float* mlp_w2;
    float* out; unsigned char* ws;
};

__device__ __forceinline__ unsigned cvt_pk_bf16(float lo, float hi) { unsigned r; asm volatile("v_cvt_pk_bf16_f32 %0, %1, %2" : "=v"(r) : "v"(lo), "v"(hi)); return r; }
__device__ __forceinline__ float bf2f(unsigned short b) { return __uint_as_float(((unsigned)b) << 16); }
__device__ __forceinline__ float bflo(unsigned w) { return __uint_as_float(w << 16); }
__device__ __forceinline__ float bfhi(unsigned w) { return __uint_as_float(w & 0xffff0000u); }
__device__ __forceinline__ unsigned short f2bf(float f) { return (unsigned short)(cvt_pk_bf16(f, 0.f) & 0xffffu); }

__device__ __forceinline__ int otid() { int t = threadIdx.x; asm volatile("" : "+v"(t)); return t; }
__device__ __forceinline__ int obid() { int t = blockIdx.x; asm volatile("" : "+s"(t)); return t; }

namespace pg8 {
constexpr int BM = 256, BK = 64, HALF = 128, HTB = HALF * BK * 2, STAGE_BYTES = 8 * HTB, NXCD = 8, WGM = 8;
__device__ __forceinline__ int lds_byte(int r, int c) { const int st = (r >> 4) * 2 + (c >> 5), rr = r & 15, cc = c & 31, ob = rr * 64 + cc * 2; return st * 1024 + (ob ^ (((ob >> 9) & 1) << 5)); }
__device__ __forceinline__ void stage_rc(int b, int& R, int& C) { const int st = b / 1024, sb = b % 1024, swz = sb ^ (((sb >> 9) & 1) << 5); R = (st >> 1) * 16 + swz / 64; C = (st & 1) * 32 + (swz % 64) / 2; }
struct Unit { int pm, pn; };
struct Gemm { const bf16_t* A; const bf16_t* Bt; int M, N, K; };
struct StaticOrder {
    int nM, nN, nwg, G, c;
    __device__ void init(int M, int N, int G_, int c_) { nM = M / BM; nN = N / BM; nwg = nM * nN; G = G_; c = c_; }
    __device__ bool next(int i, Unit& u) const {
        const long L = (long)i * G + c; if (L >= nwg) return false;
        int wgid = (int)L; { const int q = nwg / NXCD, r = nwg % NXCD, xcd = wgid % NXCD, off = wgid / NXCD; wgid = (xcd < r ? xcd * (q + 1) : r * (q + 1) + (xcd - r) * q) + off; }
        const int nig = WGM * nN, gid = wgid / nig, fm = gid * WGM, gsz = (nM - fm) < WGM ? (nM - fm) : WGM;
        u.pm = fm + ((wgid % nig) % gsz); u.pn = (wgid % nig) / gsz; return true;
    }
};

#define GAS __attribute__((address_space(1)))
struct EpiBf {
    bf16_t* O; int ldc; const float* ss; int mode; const f32x2* rot;
    __device__ __forceinline__ void operator()(const f32x4 (&acc)[2][2][4][2], const Unit& u, int wr, int wc, int fr, int fq, LAS unsigned char* lds, int ui) const {
        const int row0 = u.pm * BM + wr * 64 + fr, colt = u.pn * BM + wc * 32 + 8 * fq;
        int sub = 0;
        if (mode == 1) sub = 1;
        else if (mode == 2) { sub = u.pn < 8 ? 2 : (u.pn < 16 ? 3 : (u.pn < 32 ? 0 : 4)); }
        const LAS float* lrs = (const LAS float*)(lds + STAGE_BYTES) + ui * 256 + wr * 64 + fr;
        float rs8[8];
#pragma unroll
        for (int r = 0; r < 8; ++r) rs8[r] = lrs[(r >> 2) * HALF + (r & 3) * 16];
        GAS bf16_t* Og = (GAS bf16_t*)O;
        if (sub == 2 || sub == 3) {
            const GAS f32x2* rotg = (const GAS f32x2*)rot + wc * 32 + 8 * fq;
#pragma unroll
            for (int ai = 0; ai < 2; ++ai) {
                f32x2 cs[4][2][4];
#pragma unroll
                for (int m = 0; m < 4; ++m) { const int row = row0 + ai * HALF + m * 16; const GAS f32x2* rp = rotg + (size_t)(row & (S_ - 1)) * 128;
#pragma unroll
                    for (int n = 0; n < 2; ++n)
#pragma unroll
                        for (int j = 0; j < 4; ++j) cs[m][n][j] = rp[n * 4 + j]; }
#pragma unroll
                for (int m = 0; m < 4; ++m) { const int row = row0 + ai * HALF + m * 16;
                    float ksc = rs8[ai * 4 + m];
                    if (sub == 3) { const float lgam = logf(1.0f - exp2f(-5.0f - (float)(u.pn - 8))); ksc *= 0.0625f * __expf(lgam * (float)(63 - (row & 63))); }
                    GAS bf16_t* rowp = Og + (size_t)row * ldc + colt;
                    u32x4 w1, w2;
#pragma unroll
                    for (int n = 0; n < 2; ++n) {
                        const f32x4 t1 = acc[ai][0][m][n] * ksc, t2 = acc[ai][1][m][n] * ksc;
                        f32x4 o1, o2;
#pragma unroll
                        for (int j = 0; j < 4; ++j) { const f32x2 c2 = cs[m][n][j]; o1[j] = t1[j] * c2.x - t2[j] * c2.y; o2[j] = t1[j] * c2.y + t2[j] * c2.x; }
                        w1[2 * n] = cvt_pk_bf16(o1[0], o1[1]); w1[2 * n + 1] = cvt_pk_bf16(o1[2], o1[3]); w2[2 * n] = cvt_pk_bf16(o2[0], o2[1]); w2[2 * n + 1] = cvt_pk_bf16(o2[2], o2[3]);
                    }
                    *(GAS u32x4*)(rowp) = w1; *(GAS u32x4*)(rowp + HALF) = w2;
                }
            }
        } else {
#pragma unroll
            for (int ai = 0; ai < 2; ++ai)
#pragma unroll
                for (int m = 0; m < 4; ++m) {
                    const int row = row0 + ai * HALF + m * 16;
                    const float rs = rs8[ai * 4 + m];
                    GAS bf16_t* rowp = Og + (size_t)row * ldc + colt;
#pragma unroll
                    for (int bj = 0; bj < 2; ++bj) {
                        u32x4 w;
#pragma unroll
                        for (int n = 0; n < 2; ++n) {
                            f32x4 v = acc[ai][bj][m][n] * rs;
                            if (sub == 1) {
#pragma unroll
                                for (int j = 0; j < 4; ++j) { const float r = fmaxf(v[j], 0.f); v[j] = r * r; }
                            } else if (sub == 4) {
#pragma unroll
                                for (int j = 0; j < 4; ++j) v[j] = v[j] / (1.0f + __expf(-v[j]));
                            }
                            w[2 * n] = cvt_pk_bf16(v[0], v[1]); w[2 * n + 1] = cvt_pk_bf16(v[2], v[3]);
                        }
                        *(GAS u32x4*)(rowp + bj * HALF) = w;
                    }
                }
        }
    }
};
struct EpiRes {
    const float* xin; float* xout; bf16_t* xb; float* ssn; int glu;
    __device__ __forceinline__ void operator()(const f32x4 (&acc)[2][2][4][2], const Unit& u, int wr, int wc, int fr, int fq, LAS unsigned char*, int) const {
        const int row0 = u.pm * BM + wr * 64 + fr;
        const GAS float* xi = (const GAS float*)xin; GAS float* xo = (GAS float*)xout; GAS bf16_t* xbg = (GAS bf16_t*)xb; GAS float* ssg = (GAS float*)ssn;
        if (glu) {
            const size_t cb = (size_t)u.pn * HALF + wc * 32 + 8 * fq;
#pragma unroll
            for (int ai = 0; ai < 2; ++ai) {
                f32x4 xv[4][2];
#pragma unroll
                for (int m = 0; m < 4; ++m)
#pragma unroll
                    for (int n = 0; n < 2; ++n) xv[m][n] = *(const GAS f32x4*)(xi + (size_t)(row0 + ai * HALF + m * 16) * D_ + cb + n * 4);
#pragma unroll
                for (int m = 0; m < 4; ++m) {
                    const int row = row0 + ai * HALF + m * 16; const size_t off = (size_t)row * D_ + cb;
                    float sq = 0.f; u32x4 w;
#pragma unroll
                    for (int n = 0; n < 2; ++n) {
                        const f32x4 va = acc[ai][0][m][n], ga = acc[ai][1][m][n];
                        f32x4 x4 = xv[m][n];
#pragma unroll
                        for (int j = 0; j < 4; ++j) { x4[j] += va[j] / (1.0f + __expf(-ga[j])); sq += x4[j] * x4[j]; }
                        *(GAS f32x4*)(xo + off + n * 4) = x4;
                        w[2 * n] = cvt_pk_bf16(x4[0], x4[1]); w[2 * n + 1] = cvt_pk_bf16(x4[2], x4[3]);
                    }
                    *(GAS u32x4*)(xbg + off) = w;
                    sq += __shfl_xor(sq, 16); sq += __shfl_xor(sq, 32);
                    if (fq == 0) atomicAdd((float*)ssn + (size_t)((u.pn >> 1) * 4 + wc) * T_ + row, sq);
                }
            }
        } else {
            const size_t cb = (size_t)u.pn * BM + wc * 32 + 8 * fq;
#pragma unroll
            for (int ai = 0; ai < 2; ++ai) {
                f32x4 xv[4][2][2];
#pragma unroll
                for (int m = 0; m < 4; ++m)
#pragma unroll
                    for (int bj = 0; bj < 2; ++bj)
#pragma unroll
                        for (int n = 0; n < 2; ++n) xv[m][bj][n] = *(const GAS f32x4*)(xi + (size_t)(row0 + ai * HALF + m * 16) * D_ + cb + bj * HALF + n * 4);
#pragma unroll
                for (int m = 0; m < 4; ++m) {
                    const int row = row0 + ai * HALF + m * 16; const size_t off = (size_t)row * D_ + cb;
                    float sq = 0.f;
#pragma unroll
                    for (int bj = 0; bj < 2; ++bj) {
                        u32x4 w;
#pragma unroll
                        for (int n = 0; n < 2; ++n) {
                            f32x4 x4 = xv[m][bj][n] + acc[ai][bj][m][n];
#pragma unroll
                            for (int j = 0; j < 4; ++j) sq += x4[j] * x4[j];
                            *(GAS f32x4*)(xo + off + bj * HALF + n * 4) = x4;
                            w[2 * n] = cvt_pk_bf16(x4[0], x4[1]); w[2 * n + 1] = cvt_pk_bf16(x4[2], x4[3]);
                        }
                        *(GAS u32x4*)(xbg + off + bj * HALF) = w;
                    }
                    sq += __shfl_xor(sq, 16); sq += __shfl_xor(sq, 32);
                    if (fq == 0) ssg[(size_t)(u.pn * 4 + wc) * T_ + row] = sq;
                }
            }
        }
    }
};

template <class Epi, class Sched>
__device__ __forceinline__ void gemm_phase(LAS unsigned char* lds, const Gemm g, const Sched& S, const Epi& E) {
    const int tid = otid(), wid = __builtin_amdgcn_readfirstlane(tid >> 6), lane = tid & 63, wr = wid >> 2, wc = wid & 3, fr = lane & 15, fq = lane >> 4;
    const int K = g.K, nt = K / BK;
    unsigned voffA[2], voffB[2];
#pragma unroll
    for (int i = 0; i < 2; ++i) { int R, C; stage_rc(tid * 16 + i * 8192, R, C); voffA[i] = (unsigned)(R * K + C) * 2u; voffB[i] = voffA[i]; }
    const size_t kstep = (size_t)(BK * 2);
    const size_t hstep = (size_t)HALF * K * 2;
    const size_t tstep = 2 * hstep;
    const unsigned ldsw = (unsigned)wid * 1024u;
    const int aoff = lds_byte(wr * 64 + fr, fq * 8), boff = lds_byte(wc * 32 + fr, fq * 8);
#define PG8_SA(b, h) (((b) * 2 + (h)) * HTB)
#define PG8_SB(b, h) ((4 + (b) * 2 + (h)) * HTB)
#define PG8_STAGE(bufoff, gbase, voff) do { _Pragma("unroll") for (int _i = 0; _i < 2; ++_i) \
        __builtin_amdgcn_global_load_lds((const unsigned*)((const char*)(gbase) + (voff)[_i]), (LAS unsigned*)(lds + (bufoff) + ldsw + _i * 8192), 16, 0, 0); } while (0)
#define PG8_LDA(dst, b, h) do { _Pragma("unroll") for (int m = 0; m < 4; ++m) _Pragma("unroll") for (int k = 0; k < 2; ++k) dst[m][k] = *(const LAS bf16x8*)(lds + PG8_SA(b, h) + aoff + m * 2048 + k * 1024); } while (0)
#define PG8_LDB(dst, b, h) do { _Pragma("unroll") for (int n = 0; n < 2; ++n) _Pragma("unroll") for (int k = 0; k < 2; ++k) dst[n][k] = *(const LAS bf16x8*)(lds + PG8_SB(b, h) + boff + n * 2048 + k * 1024); } while (0)
#define PG8_MMA(ai, bj, At, Bt) do { __builtin_amdgcn_s_setprio(1); _Pragma("unroll") for (int m = 0; m < 4; ++m) _Pragma("unroll") for (int n = 0; n < 2; ++n) _Pragma("unroll") for (int k = 0; k < 2; ++k) \
        acc[ai][bj][m][n] = __builtin_amdgcn_mfma_f32_16x16x32_bf16(Bt[n][k], At[m][k], acc[ai][bj][m][n], 0, 0, 0); __builtin_amdgcn_s_setprio(0); } while (0)
#define PG8_WAIT_V(n) asm volatile("s_waitcnt vmcnt(" #n ")" ::: "memory")
#define PG8_WAIT_L(n) asm volatile("s_waitcnt lgkmcnt(" #n ")" ::: "memory")
#define PG8_BAR __builtin_amdgcn_s_barrier()
#define PG8_SCHED __builtin_amdgcn_sched_barrier(0)
    Unit cur, nxt; int ui = 0;
    if (!S.next(0, cur)) return;
    f32x4 acc[2][2][4][2];
#pragma unroll
    for (int a = 0; a < 2; ++a)
#pragma unroll
        for (int b = 0; b < 2; ++b)
#pragma unroll
            for (int m = 0; m < 4; ++m)
#pragma unroll
                for (int n = 0; n < 2; ++n) acc[a][b][m][n] = (f32x4){0.f, 0.f, 0.f, 0.f};
    bf16x8 At[4][2], B0[2][2], B1[2][2];
    const char* cA = (const char*)g.A + (size_t)cur.pm * tstep; const char* cB = (const char*)g.Bt + (size_t)cur.pn * tstep;
    PG8_STAGE(PG8_SB(0, 0), cB, voffB); PG8_STAGE(PG8_SA(0, 0), cA, voffA); PG8_STAGE(PG8_SB(0, 1), cB + hstep, voffB); PG8_STAGE(PG8_SA(0, 1), cA + hstep, voffA);
    if (wr == 1) PG8_BAR;
    PG8_WAIT_V(4); PG8_BAR;
    PG8_STAGE(PG8_SB(1, 0), cB + kstep, voffB); PG8_STAGE(PG8_SA(1, 0), cA + kstep, voffA); PG8_STAGE(PG8_SB(1, 1), cB + hstep + kstep, voffB);
    PG8_WAIT_V(6); PG8_BAR;
    for (;;) {
        const bool has_next = S.next(ui + 1, nxt);
        const char* nA = has_next ? (const char*)g.A + (size_t)nxt.pm * tstep : cA; const char* nB = has_next ? (const char*)g.Bt + (size_t)nxt.pn * tstep : cB;
        for (int t = 0; t < nt; t += 2) {
            const bool last = (t == nt - 2);
            const char* a1 = cA + (size_t)(t + 1) * kstep;
            const char* a2 = last ? nA : cA + (size_t)(t + 2) * kstep; const char* b2 = last ? nB : cB + (size_t)(t + 2) * kstep;
            const char* a3 = a2 + kstep; const char* b3 = b2 + kstep;
            PG8_LDB(B0, 0, 0); PG8_SCHED; PG8_LDA(At, 0, 0); PG8_STAGE(PG8_SA(1, 1), a1 + hstep, voffA);
            PG8_WAIT_L(8); PG8_BAR; PG8_WAIT_L(0); PG8_MMA(0, 0, At, B0); PG8_BAR; PG8_SCHED;
            PG8_LDB(B1, 0, 1); PG8_STAGE(PG8_SB(0, 0), b2, voffB);
            PG8_BAR; PG8_WAIT_L(0); PG8_MMA(0, 1, At, B1); PG8_BAR;
            PG8_LDA(At, 0, 1); PG8_STAGE(PG8_SA(0, 0), a2, voffA);
            PG8_BAR; PG8_WAIT_L(0); PG8_MMA(1, 0, At, B0); PG8_BAR; PG8_SCHED;
            PG8_STAGE(PG8_SB(0, 1), b2 + hstep, voffB);
            PG8_WAIT_V(6); PG8_BAR; PG8_MMA(1, 1, At, B1); PG8_BAR;
            PG8_LDB(B0, 1, 0); PG8_SCHED; PG8_LDA(At, 1, 0); PG8_STAGE(PG8_SA(0, 1), a2 + hstep, voffA);
            PG8_WAIT_L(8); PG8_BAR; PG8_WAIT_L(0); PG8_MMA(0, 0, At, B0); PG8_BAR; PG8_SCHED;
            PG8_LDB(B1, 1, 1); PG8_STAGE(PG8_SB(1, 0), b3, voffB);
            PG8_BAR; PG8_WAIT_L(0); PG8_MMA(0, 1, At, B1); PG8_BAR;
            PG8_LDA(At, 1, 1); PG8_STAGE(PG8_SA(1, 0), a3, voffA);
            PG8_BAR; PG8_WAIT_L(0); PG8_MMA(1, 0, At, B0); PG8_BAR; PG8_SCHED;
            PG8_STAGE(PG8_SB(1, 1), b3 + hstep, voffB);
            PG8_WAIT_V(6); PG8_BAR; PG8_MMA(1, 1, At, B1); PG8_BAR;
        }
        E(acc, cur, wr, wc, fr, fq, lds, ui);
        if (!has_next) break;
#pragma unroll
        for (int a = 0; a < 2; ++a)
#pragma unroll
            for (int b = 0; b < 2; ++b)
#pragma unroll
                for (int m = 0; m < 4; ++m)
#pragma unroll
                    for (int n = 0; n < 2; ++n) acc[a][b][m][n] = (f32x4){0.f, 0.f, 0.f, 0.f};
        cur = nxt; cA = nA; cB = nB; ++ui;
    }
    PG8_WAIT_V(0);
    if (wr == 0) PG8_BAR;
    PG8_BAR;
#undef PG8_SA
#undef PG8_SB
#undef PG8_STAGE
#undef PG8_LDA
#undef PG8_LDB
#undef PG8_MMA
#undef PG8_WAIT_V
#undef PG8_WAIT_L
#undef PG8_BAR
#undef PG8_SCHED
}
}

namespace att {
constexpr int D = 128, KVBLK = 64, LDK = 6144;
constexpr float SCALE = 0.088388347648318440f;
constexpr float THR = 8.f;
constexpr size_t SHM_V = KVBLK * D * 2, SHM_K = KVBLK * D * 2;
#define KSWZ(row, colB) ((row) * 256 + ((colB) ^ (((row) & 7) << 4)))
#define SBAR() __builtin_amdgcn_sched_barrier(0)
__device__ __forceinline__ int crow(int r, int hi) { return (r & 3) + 8 * (r >> 2) + 4 * hi; }
__device__ __forceinline__ void partialSM(f32x16& p0, f32x16& p1, float& m_reg, float& mn, float& alpha, bool msk) {
    constexpr float C = SCALE * 1.4426950408889634f;
    if (msk) {
#pragma unroll
        for (int r = 0; r < 16; ++r) { p0[r] = -1e30f; p1[r] = -1e30f; }
    }
    float pmax = p0[0];
#pragma unroll
    for (int r = 1; r < 16; ++r) pmax = fmaxf(pmax, p0[r]);
#pragma unroll
    for (int r = 0; r < 16; ++r) pmax = fmaxf(pmax, p1[r]);
    { auto rr = __builtin_amdgcn_permlane32_swap(__float_as_uint(pmax), __float_as_uint(pmax), false, false);
      pmax = fmaxf(__uint_as_float(rr[0]), __uint_as_float(rr[1])); }
    if (__builtin_expect(__all(pmax - m_reg <= THR / SCALE), 1)) { mn = m_reg; alpha = 1.f; }
    else { mn = fmaxf(m_reg, pmax); alpha = __builtin_amdgcn_exp2f((m_reg - mn) * C); m_reg = mn; }
    float mnC = -mn * C;
#pragma unroll
    for (int r = 0; r < 16; ++r) p0[r] = fmaf(p0[r], C, mnC);
#pragma unroll
    for (int r = 0; r < 16; ++r) p1[r] = fmaf(p1[r], C, mnC);
#pragma unroll
    for (int r = 0; r < 16; ++r) p0[r] = __builtin_amdgcn_exp2f(p0[r]);
}
__device__ __forceinline__ void finishSM(f32x16& p0, f32x16& p1, float alpha, float& l_reg, bf16x8& pa0, bf16x8& pa1, bf16x8& pa2, bf16x8& pa3) {
#pragma unroll
    for (int r = 0; r < 16; ++r) p1[r] = __builtin_amdgcn_exp2f(p1[r]);
    float ps = 0;
#pragma unroll
    for (int r = 0; r < 16; ++r) ps += p0[r];
#pragma unroll
    for (int r = 0; r < 16; ++r) ps += p1[r];
    { auto rr = __builtin_amdgcn_permlane32_swap(__float_as_uint(ps), __float_as_uint(ps), false, false);
      ps = __uint_as_float(rr[0]) + __uint_as_float(rr[1]); }
    l_reg = l_reg * alpha + ps;
#define PK4(P, BASE, OUT) do { unsigned a0 = cvt_pk_bf16(P[BASE + 0], P[BASE + 1]), a1 = cvt_pk_bf16(P[BASE + 2], P[BASE + 3]);   \
    unsigned b0 = cvt_pk_bf16(P[BASE + 4], P[BASE + 5]), b1 = cvt_pk_bf16(P[BASE + 6], P[BASE + 7]);                              \
    auto r0 = __builtin_amdgcn_permlane32_swap(a0, b0, false, false); auto r1 = __builtin_amdgcn_permlane32_swap(a1, b1, false, false); \
    u32x4 w = {r0[0], r1[0], r0[1], r1[1]}; OUT = *reinterpret_cast<bf16x8*>(&w); } while (0)
    PK4(p0, 0, pa0); PK4(p0, 8, pa1); PK4(p1, 0, pa2); PK4(p1, 8, pa3);
#undef PK4
}
__device__ __forceinline__ void qkt(f32x16& p0, f32x16& p1, const char* Ks, const bf16x8* qr, int r32, int hi) {
    p0 = f32x16{}; p1 = f32x16{};
#pragma unroll
    for (int d0 = 0; d0 < 8; ++d0) { int cb = (d0 * 16 + hi * 8) * 2;
        bf16x8 b0 = *reinterpret_cast<const bf16x8*>(Ks + KSWZ(r32, cb));
        bf16x8 b1 = *reinterpret_cast<const bf16x8*>(Ks + KSWZ(32 + r32, cb));
        p0 = __builtin_amdgcn_mfma_f32_32x32x16_bf16(b0, qr[d0], p0, 0, 0, 0);
        p1 = __builtin_amdgcn_mfma_f32_32x32x16_bf16(b1, qr[d0], p1, 0, 0, 0); }
}
__device__ __forceinline__ int v_st(int k, int c) { const int kk = (k & ~0xC) | ((k & 4) << 1) | ((k & 8) >> 1); return ((kk >> 3) * 4 + (c >> 5)) * 512 + ((kk & 7) * 32 + (c & 31)) * 2; }
__device__ __forceinline__ int v_rd_base(int lane) { return ((lane & 3) << 3) | (((lane >> 2) & 3) << 6) | (((lane >> 4) & 1) << 5) | (((lane >> 5) & 1) << 8); }
constexpr int v_rd_off(int d0, int ks, int half) { return d0 * 512 + ks * 4096 + half * 2048; }
template <int OFF> __device__ __forceinline__ s16x4 tr_read(int vb) {
    s16x4 r; asm volatile("ds_read_b64_tr_b16 %0, %1 offset:%2" : "=&v"(r) : "v"(vb), "i"(OFF) : "memory"); return r;
}
template <int D0> __device__ __forceinline__ void pv_one(f32x16& od, int vb, bf16x8 pa0, bf16x8 pa1, bf16x8 pa2, bf16x8 pa3) {
    const s16x4 l0 = tr_read<v_rd_off(D0, 0, 0)>(vb), h0 = tr_read<v_rd_off(D0, 0, 1)>(vb), l1 = tr_read<v_rd_off(D0, 1, 0)>(vb), h1 = tr_read<v_rd_off(D0, 1, 1)>(vb);
    const s16x4 l2 = tr_read<v_rd_off(D0, 2, 0)>(vb), h2 = tr_read<v_rd_off(D0, 2, 1)>(vb), l3 = tr_read<v_rd_off(D0, 3, 0)>(vb), h3 = tr_read<v_rd_off(D0, 3, 1)>(vb);
    asm volatile("s_waitcnt lgkmcnt(0)" ::: "memory"); SBAR();
#define PK(L, H) (bf16x8){L[0], L[1], L[2], L[3], H[0], H[1], H[2], H[3]}
    od = __builtin_amdgcn_mfma_f32_32x32x16_bf16(pa0, PK(l0, h0), od, 0, 0, 0);
    od = __builtin_amdgcn_mfma_f32_32x32x16_bf16(pa1, PK(l1, h1), od, 0, 0, 0);
    od = __builtin_amdgcn_mfma_f32_32x32x16_bf16(pa2, PK(l2, h2), od, 0, 0, 0);
    od = __builtin_amdgcn_mfma_f32_32x32x16_bf16(pa3, PK(l3, h3), od, 0, 0, 0);
#undef PK
}
__device__ __forceinline__ void pv_d0(f32x16* o, int vb, bf16x8 pa0, bf16x8 pa1, bf16x8 pa2, bf16x8 pa3) {
    pv_one<0>(o[0], vb, pa0, pa1, pa2, pa3); pv_one<1>(o[1], vb, pa0, pa1, pa2, pa3); pv_one<2>(o[2], vb, pa0, pa1, pa2, pa3); pv_one<3>(o[3], vb, pa0, pa1, pa2, pa3);
}
__device__ __forceinline__ void attn_body(const bf16_t* __restrict__ Qb, const bf16_t* __restrict__ Kh, const bf16_t* __restrict__ Vh, int NT, int ntw, char* lds, f32x16 (&o)[4]) {
    const int tid = otid(), wid = __builtin_amdgcn_readfirstlane(tid >> 6), lane = tid & 63, r32 = lane & 31, hi = lane >> 5;
    char* V_lds = lds; char* K_lds = lds + 2 * SHM_V;
    float* wsf = (float*)(lds + 2 * SHM_V + 2 * SHM_K) + wid * 64; float* li_l = wsf; float* al_l = wsf + 32;
    float m_reg = -1e30f, l_reg = 0; bf16x8 qr[8];
#pragma unroll
    for (int d = 0; d < 4; ++d) o[d] = f32x16{};
    const bf16_t* Qw = Qb + (long)(wid * 32 + r32) * LDK + hi * 8;
#pragma unroll
    for (int d0 = 0; d0 < 8; ++d0) qr[d0] = *reinterpret_cast<const bf16x8*>(Qw + d0 * 16);
    const int sr = tid >> 4, sc = (tid & 15) * 8, vst0 = v_st(sr, sc), vst1 = v_st(32 + sr, sc);
    const int vb0 = (int)(uintptr_t)V_lds + v_rd_base(lane);
    struct { bf16x8 vs0, vs1, ks0, ks1; } sr_[2];
#define SLOAD(i, k0) do { sr_[i].vs0 = *reinterpret_cast<const bf16x8*>(&Vh[(long)((k0) + sr) * LDK + sc]); sr_[i].vs1 = *reinterpret_cast<const bf16x8*>(&Vh[(long)((k0) + 32 + sr) * LDK + sc]); \
    sr_[i].ks0 = *reinterpret_cast<const bf16x8*>(&Kh[(long)((k0) + sr) * LDK + sc]); sr_[i].ks1 = *reinterpret_cast<const bf16x8*>(&Kh[(long)((k0) + 32 + sr) * LDK + sc]); } while (0)
#define SWRITE(b, i) do { *(bf16x8*)(V_lds + (b) * SHM_V + vst0) = sr_[i].vs0;          \
    *(bf16x8*)(V_lds + (b) * SHM_V + vst1) = sr_[i].vs1; int kc = sc * 2;               \
    *(bf16x8*)(K_lds + (b) * SHM_K + KSWZ(sr, kc)) = sr_[i].ks0;                       \
    *(bf16x8*)(K_lds + (b) * SHM_K + KSWZ(32 + sr, kc)) = sr_[i].ks1; } while (0)
#define SWAIT() asm volatile("s_waitcnt vmcnt(4)" ::: "memory")
#define RESC(a) do { if (__any((a) < 1.f)) { if (hi == 0) al_l[r32] = (a); asm volatile("s_waitcnt lgkmcnt(0)" ::: "memory"); \
    _Pragma("unroll") for (int d = 0; d < 4; ++d) _Pragma("unroll") for (int r = 0; r < 16; ++r) o[d][r] *= al_l[crow(r, hi)]; } } while (0)
    f32x16 pA0, pA1, pB0, pB1; float mnA, mnB, alA, alB; bf16x8 pa0, pa1, pa2, pa3;
    constexpr int SE = 0, SO = 1;
    __syncthreads();
    SLOAD(SE, 0); asm volatile("s_waitcnt vmcnt(0)" ::: "memory"); SWRITE(0, SE); __syncthreads();
    qkt(pA0, pA1, K_lds, qr, r32, hi); partialSM(pA0, pA1, m_reg, mnA, alA, false);
    SLOAD(SO, KVBLK); if (2 < NT) SLOAD(SE, 2 * KVBLK);
    SWAIT(); SWRITE(1, SO); __syncthreads();
    for (int j = 1; j + 1 < NT; j += 2) {
        SBAR(); qkt(pB0, pB1, K_lds + SHM_K, qr, r32, hi);
        finishSM(pA0, pA1, alA, l_reg, pa0, pa1, pa2, pa3); SBAR();
        SLOAD(SO, (j + 2) * KVBLK); SBAR();
        pv_d0(o, vb0, pa0, pa1, pa2, pa3); partialSM(pB0, pB1, m_reg, mnB, alB, j >= ntw);
        __syncthreads(); SWAIT(); SWRITE(0, SE);
        RESC(alB); __syncthreads();
        SBAR(); qkt(pA0, pA1, K_lds, qr, r32, hi);
        finishSM(pB0, pB1, alB, l_reg, pa0, pa1, pa2, pa3); SBAR();
        if (j + 3 < NT) SLOAD(SE, (j + 3) * KVBLK); SBAR();
        pv_d0(o, vb0 + (int)SHM_V, pa0, pa1, pa2, pa3); partialSM(pA0, pA1, m_reg, mnA, alA, (j + 1) >= ntw);
        __syncthreads(); SWAIT(); SWRITE(1, SO);
        RESC(alA); __syncthreads();
    }
    SBAR(); qkt(pB0, pB1, K_lds + SHM_K, qr, r32, hi);
    finishSM(pA0, pA1, alA, l_reg, pa0, pa1, pa2, pa3); SBAR();
    pv_d0(o, vb0, pa0, pa1, pa2, pa3); partialSM(pB0, pB1, m_reg, mnB, alB, (NT - 1) >= ntw);
    __syncthreads(); RESC(alB);
    finishSM(pB0, pB1, alB, l_reg, pa0, pa1, pa2, pa3); SBAR();
    pv_d0(o, vb0 + (int)SHM_V, pa0, pa1, pa2, pa3);
    if (hi == 0) li_l[r32] = l_reg; asm volatile("s_waitcnt lgkmcnt(0)" ::: "memory");
#pragma unroll
    for (int r = 0; r < 16; ++r) { const float rl = __builtin_amdgcn_rcpf(li_l[crow(r, hi)]);
#pragma unroll
        for (int d = 0; d < 4; ++d) o[d][r] *= rl; }
#undef SLOAD
#undef SWRITE
#undef SWAIT
#undef RESC
}
}

__device__ __forceinline__ void sincos_red(double ang, float& s, float& c) {
    const double k = rint(ang * 0.15915494309189535);
    const float r = (float)(ang - k * 6.283185307179586);
    s = __sinf(r); c = __cosf(r);
}
__device__ __forceinline__ float gelu_tanh(float y) {
    const float z = 0.7978845608028654f * (y + 0.044715f * y * y * y);
    const float th = 1.0f - 2.0f / (1.0f + __expf(2.0f * z));
    return 0.5f * y * (1.0f + th);
}

struct ConvJob { const float* W; bf16_t* Wt; const float* gain; int K, N, glu, tile; };
struct ConvRegs { f32x4 va[4], vb[4]; float ga[4], gb[4]; };
__device__ __forceinline__ ConvJob conv_decode(const Params& p, unsigned char* ws, int t) {
    ConvJob j; j.glu = 0; j.gain = nullptr;
    if (t < 1536) { const int q = t / 768; j.tile = t - q * 768; j.W = p.a_w_in + (size_t)q * 2048 * 6144; j.Wt = (bf16_t*)(ws + OFF_WT_A_IN + q * SZ_A_IN); j.K = 2048; j.N = 6144; j.gain = p.norm_mix + (size_t)(3 * q) * D_; }
    else if (t < 2048) { const int u = t - 1536; const int q = u / 256; j.tile = u - q * 256; j.W = p.a_w_out + (size_t)q * 2048 * 2048; j.Wt = (bf16_t*)(ws + OFF_WT_A_OUT + q * SZ_A_OUT); j.K = 2048; j.N = 2048; }
    else if (t < 2560) { j.tile = t - 2048; j.W = p.b_w_glu; j.Wt = (bf16_t*)(ws + OFF_WT_GLU); j.K = 2048; j.N = 4096; j.glu = 1; }
    else if (t < 4096) { j.tile = t - 2560; j.W = p.c_w_in; j.Wt = (bf16_t*)(ws + OFF_WT_C_IN); j.K = 2048; j.N = 12288; j.gain = p.norm_mix + 2 * D_; }
    else if (t < 4608) { j.tile = t - 4096; j.W = p.c_w_out; j.Wt = (bf16_t*)(ws + OFF_WT_C_OUT); j.K = 4096; j.N = 2048; }
    else if (t < 8704) { const int u = t - 4608; const int i = u / 1024; j.tile = u - i * 1024; j.W = p.mlp_w1 + (size_t)i * 2048 * 8192; j.Wt = (bf16_t*)(ws + OFF_WT_W1 + i * SZ_W1); j.K = 2048; j.N = 8192; j.gain = p.norm_mlp + (size_t)i * D_; }
    else { const int u = t - 8704; const int i = u / 1024; j.tile = u - i * 1024; j.W = p.mlp_w2 + (size_t)i * 8192 * 2048; j.Wt = (bf16_t*)(ws + OFF_WT_W2 + i * SZ_W1); j.K = 8192; j.N = 2048; }
    return j;
}
__device__ __forceinline__ void conv_load(const ConvJob& j, ConvRegs& r, int tid) {
    const int ntn = j.N >> 7; const int tk = j.tile / ntn, tn = j.tile - tk * ntn; const int k0 = tk << 7, n0 = tn << 7;
    const int kp = tid >> 5, nl = (tid & 31) << 2;
#pragma unroll
    for (int i = 0; i < 4; ++i) { const int k = 2 * (kp + 16 * i);
        r.va[i] = *(const f32x4*)(j.W + (size_t)(k0 + k) * j.N + n0 + nl); r.vb[i] = *(const f32x4*)(j.W + (size_t)(k0 + k + 1) * j.N + n0 + nl);
        r.ga[i] = j.gain ? j.gain[k0 + k] : 1.f; r.gb[i] = j.gain ? j.gain[k0 + k + 1] : 1.f; }
}
__device__ __forceinline__ void conv_store(const ConvJob& j, const ConvRegs& r, int tid, unsigned* ldsw) {
    const int ntn = j.N >> 7; const int tk = j.tile / ntn, tn = j.tile - tk * ntn; const int k0 = tk << 7, n0 = tn << 7;
    const int kp = tid >> 5, nl = (tid & 31) << 2;
    __syncthreads();
#pragma unroll
    for (int i = 0; i < 4; ++i) { const int kpair = kp + 16 * i;
#pragma unroll
        for (int jj = 0; jj < 4; ++jj) ldsw[(nl + jj) * 65 + kpair] = cvt_pk_bf16(r.va[i][jj] * r.ga[i], r.vb[i][jj] * r.gb[i]); }
    __syncthreads();
    int nbase = n0;
    if (j.glu) { const int bj = n0 >> 11, pn = (n0 & 2047) >> 7; nbase = 256 * pn + 128 * bj; }
#pragma unroll
    for (int i = 0; i < 4; ++i) { const int n = (tid >> 4) + 32 * i, k8 = tid & 15;
        u32x4 w; w.x = ldsw[n * 65 + k8 * 4 + 0]; w.y = ldsw[n * 65 + k8 * 4 + 1]; w.z = ldsw[n * 65 + k8 * 4 + 2]; w.w = ldsw[n * 65 + k8 * 4 + 3];
        const int c5 = n & 31, np = (n & ~31) | (16 * ((c5 >> 2) & 1) + 4 * (c5 >> 3) + (c5 & 3));
        *(u32x4*)(j.Wt + (size_t)(nbase + np) * j.K + k0 + k8 * 8) = w; }
}

__device__ __forceinline__ void prep_phase(const Params& p, unsigned char* shm) {
    const int tid = otid(), bid = obid(), G = gridDim.x;
    unsigned char* ws = p.ws;
    {
        ConvJob jc = conv_decode(p, ws, bid); ConvRegs rc; conv_load(jc, rc, tid);
#pragma unroll 1
        for (int t = bid; t < 12800; t += G) {
            ConvJob jn = jc; ConvRegs rn = rc;
            if (t + G < 12800) { jn = conv_decode(p, ws, t + G); conv_load(jn, rn, tid); }
            conv_store(jc, rc, tid, (unsigned*)shm);
            jc = jn; rc = rn;
        }
    }
    {
        float* ss = (float*)(ws + OFF_SSP); bf16_t* xb = (bf16_t*)(ws + OFF_XB);
        const int wid = tid >> 6, lane = tid & 63;
        for (int row = bid * 8 + wid; row < T_; row += G * 8) {
            const float* xr = p.x + (size_t)row * D_; float sq = 0.f;
#pragma unroll
            for (int i = 0; i < 8; ++i) { const f32x4 v = *(const f32x4*)(xr + (i * 64 + lane) * 4);
                sq += v[0] * v[0] + v[1] * v[1] + v[2] * v[2] + v[3] * v[3];
                *(f32x4*)(p.out + (size_t)row * D_ + (i * 64 + lane) * 4) = v;
                u32x2 w; w.x = cvt_pk_bf16(v[0], v[1]); w.y = cvt_pk_bf16(v[2], v[3]);
                *(u32x2*)(xb + (size_t)row * D_ + (i * 64 + lane) * 4) = w; }
#pragma unroll
            for (int o = 32; o > 0; o >>= 1) sq += __shfl_xor(sq, o);
            if (lane < 32) ss[(size_t)lane * T_ + row] = (lane == 0) ? sq : 0.f;
        }
        for (int i = bid * 512 + tid; i < 32 * T_; i += G * 512) ss[(size_t)3 * 32 * T_ + i] = 0.f;
        float* rssq = (float*)(ws + OFF_RSQP);
        for (int i = bid * 512 + tid; i < 64 * T_; i += G * 512) rssq[i] = 0.f;
    }
    {
        float* par = (float*)(ws + OFF_PAR);
        for (int i = bid * 512 + tid; i < PAR_N; i += G * 512) {
            float v;
            if (i < PAR_NFINAL) v = p.norm_mix[D_ + i];
            else if (i < PAR_LAM) v = p.norm_final[i - PAR_NFINAL];
            else if (i < PAR_SUBLN) v = p.a_lambda[i - PAR_LAM];
            else if (i < PAR_BD) v = p.a_subln[i - PAR_SUBLN];
            else v = p.b_d[i - PAR_BD];
            par[i] = v;
        }
    }
    {
        f32x2* rot = (f32x2*)(ws + OFF_ROT);
        for (int i = bid * 512 + tid; i < 4096 * 128; i += G * 512) {
            const int pos = i >> 7, j = i & 127;
            const double inv = exp(-9.210340371976184 * ((double)j / 127.0));
            float s, c; sincos_red((double)pos * inv, s, c);
            f32x2 v; v.x = c; v.y = s; rot[i] = v;
        }
    }
    {
        bf16_t* Bm = (bf16_t*)(ws + OFF_S5B); bf16_t* Cm = (bf16_t*)(ws + OFF_S5C); f32x2* AB = (f32x2*)(ws + OFF_S5AB);
        const float* gmix = p.norm_mix + 1 * D_;
        for (int i = bid * 512 + tid; i < 128 * 64; i += G * 512) {
            const int g = i >> 6, pp = i & 63;
            const float lre = p.b_a_re[i], lim = p.b_a_im[i];
            const float dt = __expf(p.b_log_dt[g]);
            const float mag = __expf(lre * dt);
            float sn, cs; sincos_red((double)lim * (double)dt, sn, cs);
            const float abr = mag * cs, abi = mag * sn;
            const float den = lre * lre + lim * lim;
            const float nr = abr - 1.0f, ni = abi;
            const float cr_ = (nr * lre + ni * lim) / den, ci_ = (ni * lre - nr * lim) / den;
            f32x2 ab; ab.x = abr; ab.y = abi; AB[i] = ab;
#pragma unroll
            for (int c = 0; c < 16; ++c) {
                const float br = p.b_b_re[(size_t)i * 16 + c], bi = p.b_b_im[(size_t)i * 16 + c];
                const float gm = gmix[g * 16 + c];
                Bm[((size_t)g * 128 + pp) * 16 + c] = f2bf((cr_ * br - ci_ * bi) * gm);
                Bm[((size_t)g * 128 + 64 + pp) * 16 + c] = f2bf((cr_ * bi + ci_ * br) * gm);
                Cm[((size_t)g * 16 + c) * 128 + pp] = f2bf(p.b_c_re[((size_t)g * 16 + c) * 64 + pp]);
                Cm[((size_t)g * 16 + c) * 128 + 64 + pp] = f2bf(-p.b_c_im[((size_t)g * 16 + c) * 64 + pp]);
            }
        }
    }
}

__device__ __forceinline__ void attn_phase(const Params& p, int j, float lambda_init, unsigned char* shm) {
    const int tid = otid(), wid = __builtin_amdgcn_readfirstlane(tid >> 6), lane = tid & 63, r32 = lane & 31, hi = lane >> 5;
    const bf16_t* qkv = (const bf16_t*)(p.ws + OFF_BIG);
    bf16_t* oa = (bf16_t*)(p.ws + OFF_OA);
    float* scr = (float*)(p.ws + OFF_ATT_SCR) + (size_t)obid() * 2 * 32768;
    float lam;
    { const float* lp = (const float*)(p.ws + OFF_PAR) + PAR_LAM + (size_t)j * 512;
      float a = lp[lane] * lp[128 + lane] + lp[64 + lane] * lp[192 + lane];
      float b = lp[256 + lane] * lp[384 + lane] + lp[320 + lane] * lp[448 + lane];
#pragma unroll
      for (int o = 32; o > 0; o >>= 1) { a += __shfl_xor(a, o); b += __shfl_xor(b, o); }
      lam = __expf(a) - __expf(b) + lambda_init; lam = __uint_as_float(__builtin_amdgcn_readfirstlane(__float_as_uint(lam))); }
    const float* sub = (const float*)(p.ws + OFF_PAR) + PAR_SUBLN + (size_t)j * 256;
    const int c = obid(); const int xcd = c & 7, jj = c >> 3;
    const int bh = xcd * 4 + (jj >> 3), pi = jj & 7;
    const int b = bh >> 3, h = bh & 7;
#pragma unroll 1
    for (int it = 0; it < 2; ++it) {
        const int qb = it == 0 ? (15 - pi) : pi;
        const int NT = 4 * qb + 4, ntw = 4 * qb + (wid >> 1) + 1;
        const size_t tok0 = (size_t)b * S_ + (size_t)qb * 256;
        f32x16 o[4];
#pragma unroll 1
        for (int ps = 0; ps < 4; ++ps) {
            const int e = ps >> 1, t = ps & 1;
            float* sc = scr + e * 32768;
            att::attn_body(qkv + tok0 * 6144 + h * 256 + t * 128, qkv + (size_t)b * S_ * 6144 + 2048 + h * 256 + t * 128,
                           qkv + (size_t)b * S_ * 6144 + 4096 + h * 256 + e * 128, NT, ntw, (char*)shm, o);
            if (t == 0) {
#pragma unroll
                for (int d = 0; d < 4; ++d)
#pragma unroll
                    for (int r = 0; r < 16; ++r) sc[tid * 64 + d * 16 + r] = o[d][r];
            } else {
#pragma unroll
                for (int d = 0; d < 4; ++d)
#pragma unroll
                    for (int r = 0; r < 16; ++r) { const float cv = sc[tid * 64 + d * 16 + r] - lam * o[d][r]; o[d][r] = cv; if (e == 0) sc[tid * 64 + d * 16 + r] = cv; }
            }
        }
        float ssq[16];
#pragma unroll
        for (int r = 0; r < 16; ++r) { float s = 0.f;
#pragma unroll
            for (int d = 0; d < 4; ++d) { const float c0 = scr[tid * 64 + d * 16 + r]; s += c0 * c0 + o[d][r] * o[d][r]; }
#pragma unroll
            for (int of = 16; of > 0; of >>= 1) s += __shfl_xor(s, of);
            ssq[r] = rsqrtf(s * (1.0f / 256.0f) + EPS_) * (1.0f - lambda_init); }
#pragma unroll
        for (int r = 0; r < 16; ++r) {
            const size_t row = tok0 + wid * 32 + att::crow(r, hi);
            bf16_t* op = oa + row * D_ + h * 256;
#pragma unroll
            for (int d = 0; d < 4; ++d) {
                const int col = d * 32 + r32;
                op[col] = f2bf(scr[tid * 64 + d * 16 + r] * ssq[r] * sub[col]);
                op[128 + col] = f2bf(o[d][r] * ssq[r] * sub[128 + col]);
            }
        }
    }
}

template <bool FINAL>
__device__ __forceinline__ void s5_phase(const Params& p, unsigned char* shm) {
    const int tid = otid(), wid = tid >> 6, lane = tid & 63, r32 = lane & 31, hi = lane >> 5, fr = lane & 15, fq = lane >> 4;
    const bf16_t* xb = (const bf16_t*)(p.ws + OFF_XB);
    const float* ss = (const float*)(p.ws + OFF_SSP) + (size_t)2 * 32 * T_;
    float* rsfin = (float*)(p.ws + OFF_RSFIN);
    const bf16_t* Bm = (const bf16_t*)(p.ws + OFF_S5B); const bf16_t* Cm = (const bf16_t*)(p.ws + OFF_S5C); const f32x2* AB = (const f32x2*)(p.ws + OFF_S5AB);
    f32x2* E = (f32x2*)(p.ws + OFF_BIG);
    bf16_t* gl = (bf16_t*)(p.ws + OFF_OA);
    bf16_t* Xs = (bf16_t*)shm + wid * (32 * 136);
    const float* gmix = (const float*)(p.ws + OFF_PAR) + PAR_GMIX; const float* dsk = (const float*)(p.ws + OFF_PAR) + PAR_BD;
    float* partL = (float*)(shm + 8 * 8704); float* rsL = partL + 512;
#pragma unroll 1
    for (int bc = obid(); bc < 256; bc += gridDim.x) {
      const int chunk = bc & 63, b = bc >> 6;
      const size_t t0 = (size_t)b * S_ + chunk * 64;
      __syncthreads();
      if (FINAL) { if (tid < 64) rsL[tid] = rsfin[t0 + tid]; }
      else {
          { const int row = tid & 63, part = tid >> 6; float a = 0.f;
#pragma unroll
            for (int k = 0; k < 4; ++k) a += ss[(size_t)(part * 4 + k) * T_ + t0 + row];
            partL[part * 64 + row] = a; }
          __syncthreads();
          if (tid < 64) { float tot = 0.f;
#pragma unroll
              for (int k = 0; k < 8; ++k) tot += partL[k * 64 + tid];
              const float r = rsqrtf(tot * (1.0f / D_) + EPS_); rsL[tid] = r; rsfin[t0 + tid] = r; }
      }
      __syncthreads();
#pragma unroll 1
      for (int goct = 0; goct < 16; ++goct) {
        const int g = goct * 8 + wid; const int pp = r32 + 32 * hi;
        const f32x2 ab = AB[g * 64 + pp];
        bf16x8 bfr[4];
#pragma unroll
        for (int nb = 0; nb < 4; ++nb) bfr[nb] = *(const bf16x8*)(Bm + ((size_t)g * 128 + nb * 32 + r32) * 16 + hi * 8);
        float xr = 0.f, xi = 0.f;
        bf16x8 cfr[4]; float gm4[4], ds4[4];
        if (FINAL) {
            { const f32x2 cin = E[((size_t)(b * 128 + g) * 64 + chunk) * 64 + pp]; xr = cin.x; xi = cin.y; }
#pragma unroll
            for (int ks = 0; ks < 4; ++ks) cfr[ks] = *(const bf16x8*)(Cm + ((size_t)g * 16 + fr) * 128 + ks * 32 + fq * 8);
#pragma unroll
            for (int jx = 0; jx < 4; ++jx) { gm4[jx] = gmix[g * 16 + 4 * fq + jx]; ds4[jx] = dsk[g * 16 + 4 * fq + jx]; }
        }
#pragma unroll
        for (int half = 0; half < 2; ++half) {
            const size_t trow = t0 + half * 32 + r32;
            const float rs = rsL[half * 32 + r32];
            const u32x4 raw = *(const u32x4*)(xb + trow * D_ + g * 16 + hi * 8);
            u32x4 sc4;
            sc4.x = cvt_pk_bf16(bflo(raw.x) * rs, bfhi(raw.x) * rs); sc4.y = cvt_pk_bf16(bflo(raw.y) * rs, bfhi(raw.y) * rs);
            sc4.z = cvt_pk_bf16(bflo(raw.z) * rs, bfhi(raw.z) * rs); sc4.w = cvt_pk_bf16(bflo(raw.w) * rs, bfhi(raw.w) * rs);
            const bf16x8 afr = *reinterpret_cast<const bf16x8*>(&sc4);
            f32x16 c0 = __builtin_amdgcn_mfma_f32_32x32x16_bf16(afr, bfr[0], f32x16{}, 0, 0, 0);
            f32x16 c1 = __builtin_amdgcn_mfma_f32_32x32x16_bf16(afr, bfr[1], f32x16{}, 0, 0, 0);
            f32x16 c2 = __builtin_amdgcn_mfma_f32_32x32x16_bf16(afr, bfr[2], f32x16{}, 0, 0, 0);
            f32x16 c3 = __builtin_amdgcn_mfma_f32_32x32x16_bf16(afr, bfr[3], f32x16{}, 0, 0, 0);
#pragma unroll
            for (int i = 0; i < 16; ++i) {
                auto r0 = __builtin_amdgcn_permlane32_swap(__float_as_uint(c0[i]), __float_as_uint(c1[i]), false, false);
                c0[i] = __uint_as_float(r0[0]); c1[i] = __uint_as_float(r0[1]);
                auto r1 = __builtin_amdgcn_permlane32_swap(__float_as_uint(c2[i]), __float_as_uint(c3[i]), false, false);
                c2[i] = __uint_as_float(r1[0]); c3[i] = __uint_as_float(r1[1]);
            }
#pragma unroll
            for (int t = 0; t < 32; ++t) {
                const int q = t >> 3, s = t & 7, idx = 4 * q + (s & 3);
                const float bur = (s < 4) ? c0[idx] : c1[idx], bui = (s < 4) ? c2[idx] : c3[idx];
                const float nr = ab.x * xr - ab.y * xi + bur, ni = ab.x * xi + ab.y * xr + bui;
                xr = nr; xi = ni;
                if (FINAL) { Xs[t * 136 + pp] = f2bf(xr); Xs[t * 136 + 64 + pp] = f2bf(xi); }
            }
            if (FINAL) {
                asm volatile("s_waitcnt lgkmcnt(0)" ::: "memory");
#pragma unroll
                for (int m = 0; m < 2; ++m) {
                    f32x4 acc = {0.f, 0.f, 0.f, 0.f};
#pragma unroll
                    for (int ks = 0; ks < 4; ++ks) {
                        const bf16x8 xf = *(const bf16x8*)(Xs + (m * 16 + fr) * 136 + ks * 32 + fq * 8);
                        acc = __builtin_amdgcn_mfma_f32_16x16x32_bf16(cfr[ks], xf, acc, 0, 0, 0);
                    }
                    const size_t tr2 = t0 + half * 32 + m * 16 + fr;
                    const float rs2 = rsL[half * 32 + m * 16 + fr];
                    const u32x2 hx = *(const u32x2*)(xb + tr2 * D_ + g * 16 + 4 * fq);
                    const float h0 = bflo(hx.x) * rs2 * gm4[0], h1 = bfhi(hx.x) * rs2 * gm4[1], h2 = bflo(hx.y) * rs2 * gm4[2], h3 = bfhi(hx.y) * rs2 * gm4[3];
                    const float y0 = gelu_tanh(acc[0] + ds4[0] * h0), y1 = gelu_tanh(acc[1] + ds4[1] * h1), y2 = gelu_tanh(acc[2] + ds4[2] * h2), y3 = gelu_tanh(acc[3] + ds4[3] * h3);
                    u32x2 w; w.x = cvt_pk_bf16(y0, y1); w.y = cvt_pk_bf16(y2, y3);
                    *(u32x2*)(gl + tr2 * D_ + g * 16 + 4 * fq) = w;
                }
                asm volatile("s_waitcnt lgkmcnt(0)" ::: "memory");
            }
        }
        if (!FINAL) { f32x2 e; e.x = xr; e.y = xi; E[((size_t)(b * 128 + g) * 64 + chunk) * 64 + pp] = e; }
      }
    }
}

__device__ __forceinline__ void s5_scan_phase(const Params& p) {
    const int tid = otid(), bid = obid();
    if (tid >= 128) return;
    f32x2* E = (f32x2*)(p.ws + OFF_BIG); const f32x2* AB = (const f32x2*)(p.ws + OFF_S5AB);
    for (int seq = bid * 128 + tid; seq < 4 * 128 * 64; seq += gridDim.x * 128) {
        const int pp = seq & 63, bg = seq >> 6, g = bg & 127;
        const f32x2 ab = AB[g * 64 + pp];
        float pr = ab.x, pi_ = ab.y;
#pragma unroll
        for (int k = 0; k < 6; ++k) { const float nr = pr * pr - pi_ * pi_, ni = 2.f * pr * pi_; pr = nr; pi_ = ni; }
        f32x2* Ep = E + (size_t)bg * 64 * 64 + pp;
        float xr = 0.f, xi = 0.f;
#pragma unroll 1
        for (int c0 = 0; c0 < 64; c0 += 16) {
            f32x2 e[16];
#pragma unroll
            for (int k = 0; k < 16; ++k) e[k] = Ep[(size_t)(c0 + k) * 64];
#pragma unroll
            for (int k = 0; k < 16; ++k) { f32x2 x; x.x = xr; x.y = xi; Ep[(size_t)(c0 + k) * 64] = x;
                const float nr = pr * xr - pi_ * xi + e[k].x, ni = pr * xi + pi_ * xr + e[k].y; xr = nr; xi = ni; }
        }
    }
}

__device__ __forceinline__ void ret_phase(const Params& p, unsigned char* shm, float* rssq) {
    const int tid = otid(), wid = tid >> 6, lane = tid & 63, fr = lane & 15, fq = lane >> 4;
    const bf16_t* ret = (const bf16_t*)(p.ws + OFF_BIG);
    bf16_t* ao = (bf16_t*)(p.ws + OFF_OA);
    constexpr int QS = 264, TS = 72;
    bf16_t* Qs = (bf16_t*)shm; bf16_t* Ks = Qs + 64 * QS; bf16_t* KTs = Ks + 64 * QS; bf16_t* VTs = KTs + 256 * TS; bf16_t* Ss = VTs + 64 * TS; bf16_t* RTs = Ss + 64 * TS;
    const int c = obid(); const int xcd = c & 7, jj = c >> 3;
    const int bh = xcd * 4 + (jj >> 3), sl = jj & 7;
    const int b = bh >> 3, h = bh & 7;
    const float lg = logf(1.0f - exp2f(-5.0f - (float)h));
    const float cdec = __expf(lg * 64.0f);
    const int mi = wid >> 1, ni0 = 2 * (wid & 1);
    const float qdec = __expf(lg * (float)(16 * mi + fr + 1));
    float idec[2][4];
#pragma unroll
    for (int t = 0; t < 2; ++t)
#pragma unroll
        for (int j = 0; j < 4; ++j) { const int n = 16 * mi + fr, m = 16 * (ni0 + t) + 4 * fq + j; idec[t][j] = __expf(lg * (fabsf((float)(n - m)) - (float)(63 - m))); }
    f32x4 R[4][2];
#pragma unroll
    for (int a = 0; a < 4; ++a)
#pragma unroll
        for (int d = 0; d < 2; ++d) R[a][d] = (f32x4){0.f, 0.f, 0.f, 0.f};
    const size_t tokb = (size_t)b * S_;
    const bf16_t* qsrc = ret + (tokb + (tid >> 5)) * 12288 + h * 256 + (tid & 31) * 8;
    const bf16_t* ksrc = ret + (tokb + lane) * 12288 + 2048 + h * 256 + wid * 32;
    const bf16_t* vsrc = ret + (tokb + lane) * 12288 + 4096 + h * 512 + sl * 64 + wid * 8;
    u32x4 pq[4], pk[4], pv; u32x2 pg[2], cg2[2];
    const bf16_t* gsrc = ret + (tokb + 16 * mi + fr) * 12288 + 8192 + h * 512 + sl * 64 + 16 * ni0 + 4 * fq;
#pragma unroll
    for (int j = 0; j < 4; ++j) { pq[j] = *(const u32x4*)(qsrc + (size_t)j * 16 * 12288); pk[j] = *(const u32x4*)(ksrc + j * 8); }
    pv = *(const u32x4*)vsrc;
    pg[0] = *(const u32x2*)gsrc; pg[1] = *(const u32x2*)(gsrc + 16);
    for (int ch = 0; ch < 64; ++ch) {
        __syncthreads();
        cg2[0] = pg[0]; cg2[1] = pg[1];
#pragma unroll
        for (int j = 0; j < 4; ++j) {
            *(u32x4*)(Qs + (j * 16 + (tid >> 5)) * QS + (tid & 31) * 8) = pq[j];
            *(u32x4*)(Ks + lane * QS + wid * 32 + j * 8) = pk[j];
            const unsigned kw[4] = {pk[j].x, pk[j].y, pk[j].z, pk[j].w};
#pragma unroll
            for (int i = 0; i < 4; ++i) {
                KTs[(wid * 32 + j * 8 + 2 * i) * TS + lane] = (bf16_t)(kw[i] & 0xffffu);
                KTs[(wid * 32 + j * 8 + 2 * i + 1) * TS + lane] = (bf16_t)(kw[i] >> 16);
            }
        }
        { const unsigned vw[4] = {pv.x, pv.y, pv.z, pv.w};
#pragma unroll
          for (int i = 0; i < 4; ++i) { VTs[(wid * 8 + 2 * i) * TS + lane] = (bf16_t)(vw[i] & 0xffffu); VTs[(wid * 8 + 2 * i + 1) * TS + lane] = (bf16_t)(vw[i] >> 16); } }
#pragma unroll
        for (int ei = 0; ei < 4; ++ei)
#pragma unroll
            for (int di = 0; di < 2; ++di) { u32x2 w; w.x = cvt_pk_bf16(R[ei][di][0], R[ei][di][1]); w.y = cvt_pk_bf16(R[ei][di][2], R[ei][di][3]);
                *(u32x2*)(RTs + (16 * ei + fr) * QS + wid * 32 + 16 * di + 4 * fq) = w; }
        if (ch + 1 < 64) {
            const size_t adv = (size_t)(ch + 1) * 64 * 12288;
#pragma unroll
            for (int j = 0; j < 4; ++j) { pq[j] = *(const u32x4*)(qsrc + adv + (size_t)j * 16 * 12288); pk[j] = *(const u32x4*)(ksrc + adv + j * 8); }
            pv = *(const u32x4*)(vsrc + adv);
            pg[0] = *(const u32x2*)(gsrc + adv); pg[1] = *(const u32x2*)(gsrc + adv + 16);
        }
        __syncthreads();
        bf16x8 qa[8];
        {
            f32x4 sacc[2] = {{0.f, 0.f, 0.f, 0.f}, {0.f, 0.f, 0.f, 0.f}};
#pragma unroll
            for (int ks = 0; ks < 8; ++ks) qa[ks] = *(const bf16x8*)(Qs + (16 * mi + fr) * QS + ks * 32 + fq * 8);
#pragma unroll
            for (int ks = 0; ks < 8; ++ks) {
#pragma unroll
                for (int t = 0; t < 2; ++t) { const bf16x8 bf = *(const bf16x8*)(Ks + (16 * (ni0 + t) + fr) * QS + ks * 32 + fq * 8);
                    sacc[t] = __builtin_amdgcn_mfma_f32_16x16x32_bf16(bf, qa[ks], sacc[t], 0, 0, 0); }
            }
#pragma unroll
            for (int t = 0; t < 2; ++t) { u32x2 w; w.x = cvt_pk_bf16(sacc[t][0] * idec[t][0], sacc[t][1] * idec[t][1]); w.y = cvt_pk_bf16(sacc[t][2] * idec[t][2], sacc[t][3] * idec[t][3]);
                *(u32x2*)(Ss + (16 * mi + fr) * TS + 16 * (ni0 + t) + 4 * fq) = w; }
        }
        __syncthreads();
        {
            f32x4 oi[2] = {{0.f, 0.f, 0.f, 0.f}, {0.f, 0.f, 0.f, 0.f}}, oc[2] = {{0.f, 0.f, 0.f, 0.f}, {0.f, 0.f, 0.f, 0.f}};
#pragma unroll
            for (int ks = 0; ks < 2; ++ks) {
                const bf16x8 af = *(const bf16x8*)(Ss + (16 * mi + fr) * TS + ks * 32 + fq * 8);
#pragma unroll
                for (int t = 0; t < 2; ++t) { const bf16x8 bf = *(const bf16x8*)(VTs + (16 * (ni0 + t) + fr) * TS + ks * 32 + fq * 8);
                    oi[t] = __builtin_amdgcn_mfma_f32_16x16x32_bf16(bf, af, oi[t], 0, 0, 0); }
            }
#pragma unroll
            for (int ks = 0; ks < 8; ++ks) {
#pragma unroll
                for (int t = 0; t < 2; ++t) { const bf16x8 bf = *(const bf16x8*)(RTs + (16 * (ni0 + t) + fr) * QS + ks * 32 + fq * 8);
                    oc[t] = __builtin_amdgcn_mfma_f32_16x16x32_bf16(bf, qa[ks], oc[t], 0, 0, 0); }
            }
            const size_t tok = tokb + (size_t)ch * 64 + 16 * mi + fr;
            float sq = 0.f;
#pragma unroll
            for (int t = 0; t < 2; ++t) {
                const int e = sl * 64 + 16 * (ni0 + t) + 4 * fq;
                const u32x2 gw = cg2[t];
                f32x4 ov = oi[t] + oc[t] * qdec;
                sq += ov[0] * ov[0] + ov[1] * ov[1] + ov[2] * ov[2] + ov[3] * ov[3];
                u32x2 w; w.x = cvt_pk_bf16(ov[0] * bflo(gw.x), ov[1] * bfhi(gw.x)); w.y = cvt_pk_bf16(ov[2] * bflo(gw.y), ov[3] * bfhi(gw.y));
                *(u32x2*)(ao + tok * 4096 + h * 512 + e) = w;
            }
            sq += __shfl_xor(sq, 16); sq += __shfl_xor(sq, 32);
            if (fq == 0) atomicAdd(rssq + (size_t)(sl * 4 + mi) * 0 + (size_t)sl * (T_ * 8) + tok * 8 + h, sq);
        }
#pragma unroll
        for (int ei = 0; ei < 4; ++ei)
#pragma unroll
            for (int di = 0; di < 2; ++di) R[ei][di] *= cdec;
#pragma unroll
        for (int ks = 0; ks < 2; ++ks) {
            bf16x8 bfk[2];
#pragma unroll
            for (int di = 0; di < 2; ++di) bfk[di] = *(const bf16x8*)(KTs + (wid * 32 + 16 * di + fr) * TS + ks * 32 + fq * 8);
#pragma unroll
            for (int ei = 0; ei < 4; ++ei) { const bf16x8 af = *(const bf16x8*)(VTs + (16 * ei + fr) * TS + ks * 32 + fq * 8);
#pragma unroll
                for (int di = 0; di < 2; ++di) R[ei][di] = __builtin_amdgcn_mfma_f32_16x16x32_bf16(bfk[di], af, R[ei][di], 0, 0, 0); }
        }
    }
}

__device__ __forceinline__ void ret2_phase(const Params& p) {
    bf16_t* ao = (bf16_t*)(p.ws + OFF_OA); const float* rssq = (const float*)(p.ws + OFF_RSQP);
    const size_t nvec = (size_t)T_ * 4096 / 8, stride = (size_t)gridDim.x * 512;
    for (size_t i0 = (size_t)obid() * 512 + otid(); i0 < nvec; i0 += 4 * stride) {
        u32x4 w[4]; float rsum[4];
#pragma unroll
        for (int u = 0; u < 4; ++u) { const size_t i = i0 + u * stride; w[u] = *(u32x4*)(ao + i * 8);
            const size_t t = i >> 9; const int hh = (int)((i & 511) >> 6); float a = 0.f;
#pragma unroll
            for (int sl = 0; sl < 8; ++sl) a += rssq[(size_t)sl * (T_ * 8) + t * 8 + hh];
            rsum[u] = a; }
#pragma unroll
        for (int u = 0; u < 4; ++u) { const size_t i = i0 + u * stride; const float rs = rsqrtf(rsum[u] * (1.0f / 512.0f) + EPS_);
            u32x4 x = w[u];
            x.x = cvt_pk_bf16(bflo(x.x) * rs, bfhi(x.x) * rs); x.y = cvt_pk_bf16(bflo(x.y) * rs, bfhi(x.y) * rs);
            x.z = cvt_pk_bf16(bflo(x.z) * rs, bfhi(x.z) * rs); x.w = cvt_pk_bf16(bflo(x.w) * rs, bfhi(x.w) * rs);
            *(u32x4*)(ao + i * 8) = x; }
    }
}

__device__ __forceinline__ void final_phase(const Params& p) {
    const float* ss = (const float*)(p.ws + OFF_SSP) + (size_t)8 * 32 * T_;
    const int tid = otid();
    const f32x4 g = *(const f32x4*)((const float*)(p.ws + OFF_PAR) + PAR_NFINAL + tid * 4);
    const int G = gridDim.x;
    for (int row0 = obid(); row0 < T_; row0 += 4 * G) {
        f32x4 v[4]; float sm[4];
#pragma unroll
        for (int u = 0; u < 4; ++u) { const int row = row0 + u * G; sm[u] = ss[(size_t)(tid & 31) * T_ + row]; v[u] = *(f32x4*)(p.out + (size_t)row * D_ + tid * 4); }
#pragma unroll
        for (int u = 0; u < 4; ++u) { const int row = row0 + u * G; float ssum = sm[u];
#pragma unroll
            for (int o = 16; o > 0; o >>= 1) ssum += __shfl_xor(ssum, o);
            const float rs = rsqrtf(ssum * (1.0f / D_) + EPS_);
            *(f32x4*)(p.out + (size_t)row * D_ + tid * 4) = v[u] * rs * g; }
    }
}

enum { OP_PREP = 0, OP_A_IN, OP_ATTN, OP_A_OUT, OP_S5A, OP_S5C, OP_GLU, OP_C_IN, OP_RET, OP_RET2, OP_C_OUT, OP_W1, OP_W2, OP_FINAL, OP_S5B };
#ifndef PHMASK
#define PHMASK 0xffff
#endif
#define PHON(b) ((PHMASK >> (b)) & 1)
constexpr int NPH = 24;
__device__ const unsigned char PROG_OP[NPH] = { OP_PREP,
    OP_A_IN, OP_ATTN, OP_A_OUT, OP_W1, OP_W2,
    OP_S5A, OP_S5B, OP_S5C, OP_GLU, OP_W1, OP_W2,
    OP_C_IN, OP_RET, OP_RET2, OP_C_OUT, OP_W1, OP_W2,
    OP_A_IN, OP_ATTN, OP_A_OUT, OP_W1, OP_W2,
    OP_FINAL };
__device__ const unsigned char PROG_LAYER[NPH] = { 0, 0, 0, 0, 0, 0, 1, 1, 1, 1, 1, 1, 2, 2, 2, 2, 2, 2, 3, 3, 3, 3, 3, 3 };

struct GemmDesc { unsigned long long a_off, b_off; int N, K, ss_idx, mode; };
#define GD_NONE {0, 0, 0, 0, 0, 0}
#define GD_A_IN(L)  {OFF_XB, OFF_WT_A_IN + (L / 3) * SZ_A_IN, 6144, 2048, 2 * L, 0}
#define GD_A_OUT(L) {OFF_OA, OFF_WT_A_OUT + (L / 3) * SZ_A_OUT, 2048, 2048, 2 * L + 1, 0}
#define GD_W1(L)    {OFF_XB, OFF_WT_W1 + L * SZ_W1, 8192, 2048, 2 * L + 1, 1}
#define GD_W2(L)    {OFF_BIG, OFF_WT_W2 + L * SZ_W1, 2048, 8192, 2 * L + 2, 0}
#define GD_GLU(L)   {OFF_OA, OFF_WT_GLU, 4096, 2048, 2 * L + 1, 1}
#define GD_C_IN(L)  {OFF_XB, OFF_WT_C_IN, 12288, 2048, 2 * L, 2}
#define GD_C_OUT(L) {OFF_OA, OFF_WT_C_OUT, 2048, 4096, 2 * L + 1, 0}
__device__ const GemmDesc GD[NPH] = { GD_NONE,
    GD_A_IN(0ull), GD_NONE, GD_A_OUT(0ull), GD_W1(0ull), GD_W2(0ull),
    GD_NONE, GD_NONE, GD_NONE, GD_GLU(1ull), GD_W1(1ull), GD_W2(1ull),
    GD_C_IN(2ull), GD_NONE, GD_NONE, GD_C_OUT(2ull), GD_W1(2ull), GD_W2(2ull),
    GD_A_IN(3ull), GD_NONE, GD_A_OUT(3ull), GD_W1(3ull), GD_W2(3ull),
    GD_NONE };

#define XB_TMO      128
#define XB_XCNT(j)  (256  + 64 * (j))
#define XB_XSUB(j)  (1280 + 64 * (j))
#define XB_XGEN(j)  (2304 + 64 * (j))
#define XB_TOP      3328
#define XB_TOPGEN   3392
#define XCD_BAR_WORDS 3456
#define XB_SPIN_CAP (1u << 22)
__device__ __forceinline__ unsigned xb_ld(unsigned* p)              { return __hip_atomic_load(p, __ATOMIC_RELAXED, __HIP_MEMORY_SCOPE_AGENT); }
__device__ __forceinline__ unsigned xb_add(unsigned* p, unsigned v) { return __hip_atomic_fetch_add(p, v, __ATOMIC_RELAXED, __HIP_MEMORY_SCOPE_AGENT); }
__device__ __forceinline__ unsigned xb_xcc_id() { return (unsigned)__builtin_amdgcn_s_getreg((3 << 11) | 20) & 0xFu; }
#define XB_SPIN(cond, bar) do { unsigned _sp = 0; while (cond) { __builtin_amdgcn_s_sleep(1); \
    if ((++_sp & 255u) == 0u) { if (xb_ld(&(bar)[XB_TMO])) break; if (_sp > XB_SPIN_CAP) { atomicAdd(&(bar)[XB_TMO], 1u); break; } } } } while (0)
struct XcdBarrier { unsigned* bar; unsigned x; volatile LAS unsigned* st; };
__device__ __forceinline__ XcdBarrier xcd_barrier_post(unsigned* bar, volatile LAS unsigned* st) {
    XcdBarrier b; b.bar = bar; b.x = xb_xcc_id(); b.st = st;
    if (threadIdx.x == 0) (void)xb_add(&bar[XB_XCNT(b.x)], 1u);
    return b;
}
__device__ __forceinline__ void xcd_barrier_complete(unsigned* bar, unsigned x, unsigned& nloc, unsigned& nx) {
    const unsigned G = gridDim.x * gridDim.y * gridDim.z;
    unsigned sum, cnt, mine, sp = 0u;
    for (;;) {
        sum = 0u; cnt = 0u; mine = 0u;
#pragma unroll
        for (unsigned j = 0; j < 16; ++j) { const unsigned c = xb_ld(&bar[XB_XCNT(j)]); sum += c; cnt += (c > 0u) ? 1u : 0u; mine = (j == x) ? c : mine; }
        if (sum == G) break;
        __builtin_amdgcn_s_sleep(1);
        if ((++sp & 255u) == 0u) { if (xb_ld(&bar[XB_TMO])) break; if (sp > XB_SPIN_CAP) { atomicAdd(&bar[XB_TMO], 1u); break; } }
    }
    nloc = mine > 0u ? mine : 1u; nx = cnt > 0u ? cnt : 1u;
}
__device__ __forceinline__ void xcd_barrier(unsigned char* ws, unsigned char* shm) {
    XcdBarrier b; b.bar = (unsigned*)(ws + OFF_BAR); b.x = xb_xcc_id(); b.st = (volatile LAS unsigned*)((LAS unsigned char*)shm + LDS_PHASE_BYTES);
    asm volatile("s_waitcnt vmcnt(0) lgkmcnt(0)" ::: "memory");
    __syncthreads();
    if (threadIdx.x == 0) {
        unsigned* bar = b.bar;
        __builtin_amdgcn_s_waitcnt(0);
        unsigned nloc = b.st[0], nx = b.st[1];
        if (nloc == 0u) { xcd_barrier_complete(bar, b.x, nloc, nx); b.st[0] = nloc; b.st[1] = nx; }
        const unsigned old = xb_add(&bar[XB_XSUB(b.x)], 1u);
        const unsigned gen = old / nloc;
        if (old + 1u == (gen + 1u) * nloc) {
            __builtin_amdgcn_fence(__ATOMIC_RELEASE, "agent");
            asm volatile("s_waitcnt vmcnt(0)" ::: "memory");
            const unsigned og = xb_add(&bar[XB_TOP], 1u);
            const unsigned tg = og / nx;
            if (og + 1u == (tg + 1u) * nx) xb_add(&bar[XB_TOPGEN], 1u);
            else XB_SPIN(xb_ld(&bar[XB_TOPGEN]) == tg, bar);
            __builtin_amdgcn_fence(__ATOMIC_ACQUIRE, "agent");
            xb_add(&bar[XB_XGEN(b.x)], 1u);
            asm volatile("s_waitcnt vmcnt(0)" ::: "memory");
        } else {
            XB_SPIN(xb_ld(&bar[XB_XGEN(b.x)]) == gen, bar);
            __builtin_amdgcn_fence(__ATOMIC_ACQUIRE, "agent");
            asm volatile("s_waitcnt vmcnt(0)" ::: "memory");
        }
    }
    __syncthreads();
}
__device__ __forceinline__ void gsync_cg(cg::grid_group& grid) {
    asm volatile("s_waitcnt vmcnt(0) lgkmcnt(0)" ::: "memory");
    grid.sync();
    __builtin_amdgcn_fence(__ATOMIC_ACQUIRE, "agent");
    asm volatile("s_waitcnt vmcnt(0) lgkmcnt(0)" ::: "memory");
}

__global__ void __launch_bounds__(512, 2) fwd_megakernel(Params p, int ph_lo, int ph_hi) {
    extern __shared__ __attribute__((aligned(16))) unsigned char shm[];
    cg::grid_group grid = cg::this_grid();
    volatile LAS unsigned* xst = (volatile LAS unsigned*)((LAS unsigned char*)shm + LDS_PHASE_BYTES);
    if (threadIdx.x == 0) { xst[0] = 0u; xst[1] = 0u; }
    __syncthreads();
    (void)xcd_barrier_post((unsigned*)(p.ws + OFF_BAR), xst);
#ifndef DUPMASK
#define DUPMASK 0
#endif
    if (PHON(0) && ph_lo == 0) {
#pragma unroll 1
        for (int rp_ = 0; rp_ < ((DUPMASK & 1) ? 2 : 1); ++rp_) { prep_phase(p, shm); if (ph_hi > 1) gsync_cg(grid); } }
    for (int ph = (ph_lo < 1 ? 1 : ph_lo); ph < ph_hi; ++ph) {
        const int op = PROG_OP[ph], L = PROG_LAYER[ph];
        const int nrep_ = ((DUPMASK >> op) & 1) ? 2 : 1;
#pragma unroll 1
        for (int rp_ = 0; rp_ < nrep_; ++rp_) {
        unsigned char* ws = p.ws; asm volatile("" : "+s"(ws));
        float* ssb = (float*)(ws + OFF_SSP);
        if (PHON(1) && (op == OP_A_IN || op == OP_C_IN || op == OP_W1)) {
            const GemmDesc gd = GD[ph];
            pg8::Gemm g; g.A = (const bf16_t*)(ws + gd.a_off); g.Bt = (const bf16_t*)(ws + gd.b_off); g.M = T_; g.N = gd.N; g.K = gd.K;
            pg8::EpiBf E; E.rot = (const f32x2*)(ws + OFF_ROT); E.O = (bf16_t*)(ws + OFF_BIG); E.ldc = gd.N; E.mode = gd.mode; E.ss = ssb + (size_t)gd.ss_idx * 32 * T_;
            pg8::StaticOrder S; S.init(g.M, g.N, (int)gridDim.x, obid());
            {
                float* lrs = (float*)(shm + pg8::STAGE_BYTES); const int tid2 = otid();
                int nun = 0; { pg8::Unit uu; while (nun < 24 && S.next(nun, uu)) ++nun; }
                for (int j = tid2; j < nun * 256; j += 512) { pg8::Unit uu; S.next(j >> 8, uu);
                    const float* sp = E.ss + (size_t)uu.pm * 256 + (j & 255); float sv[32];
#pragma unroll
                    for (int sl = 0; sl < 32; ++sl) sv[sl] = sp[(size_t)sl * T_];
                    float a = 0.f;
#pragma unroll
                    for (int sl = 0; sl < 32; ++sl) a += sv[sl];
                    lrs[j] = rsqrtf(a * (1.0f / D_) + EPS_); }
                __syncthreads();
            }
            pg8::gemm_phase<pg8::EpiBf, pg8::StaticOrder>((LAS unsigned char*)shm, g, S, E);
        } else if (PHON(2) && (op == OP_A_OUT || op == OP_GLU || op == OP_C_OUT || op == OP_W2)) {
            const GemmDesc gd = GD[ph];
            pg8::Gemm g; g.A = (const bf16_t*)(ws + gd.a_off); g.Bt = (const bf16_t*)(ws + gd.b_off); g.M = T_; g.N = gd.N; g.K = gd.K;
            pg8::EpiRes E; E.xout = p.out; E.xb = (bf16_t*)(ws + OFF_XB); E.glu = gd.mode; E.xin = p.out; E.ssn = ssb + (size_t)gd.ss_idx * 32 * T_;
            pg8::StaticOrder S; S.init(g.M, g.N, (int)gridDim.x, obid());
            pg8::gemm_phase<pg8::EpiRes, pg8::StaticOrder>((LAS unsigned char*)shm, g, S, E);
        } else if (PHON(3) && op == OP_ATTN) {
            const float li = 0.8f - 0.6f * expf(-0.3f * (float)L);
            attn_phase(p, L / 3, li, shm);
        } else if (PHON(4) && op == OP_S5A) {
            s5_phase<false>(p, shm);
        } else if (PHON(4) && op == OP_S5B) {
            s5_scan_phase(p);
        } else if (PHON(5) && op == OP_S5C) {
            s5_phase<true>(p, shm);
        } else if (PHON(6) && op == OP_RET) {
            ret_phase(p, shm, (float*)(ws + (rp_ == 0 ? OFF_RSQP : OFF_XB)));
        } else if (PHON(7) && op == OP_RET2) {
            ret2_phase(p);
        } else if (PHON(8) && op == OP_FINAL) {
            final_phase(p);
        }
        if (ph + 1 < ph_hi || rp_ + 1 < nrep_) xcd_barrier(ws, shm);
        }
    }
}

extern "C" void kernel_launch(void* const* d_in, const int* in_sizes, int n_in, void* d_out, int out_size, void* d_ws, size_t ws_size, hipStream_t stream) {
    static int grid_blocks = 0;
    if (grid_blocks == 0) {
        if (n_in != 21 || out_size != T_ * D_ || ws_size < WS_NEED) { fprintf(stderr, "kernel_launch: unexpected shapes n_in %d out %d ws %zu (need %zu)\n", n_in, out_size, ws_size, (size_t)WS_NEED); grid_blocks = -1; return; }
        int dev = 0, cus = 0, per_cu = 0;
        hipGetDevice(&dev);
        hipDeviceGetAttribute(&cus, hipDeviceAttributeMultiprocessorCount, dev);
        if (hipFuncSetAttribute((const void*)fwd_megakernel, hipFuncAttributeMaxDynamicSharedMemorySize, LDS_BYTES) != hipSuccess) { fprintf(stderr, "kernel_launch: hipFuncSetAttribute failed\n"); grid_blocks = -1; return; }
        hipOccupancyMaxActiveBlocksPerMultiprocessor(&per_cu, (const void*)fwd_megakernel, 512, LDS_BYTES);
        (void)hipGetLastError();
        if (per_cu < 1) per_cu = 1;
        grid_blocks = cus * 1;
        if (grid_blocks != 256) fprintf(stderr, "kernel_launch: note: %d CUs (kernel tuned for 256)\n", cus);
    }
    if (grid_blocks < 0) return;
    (void)hipMemsetAsync((unsigned char*)d_ws + OFF_BAR, 0, XCD_BAR_WORDS * 4, stream);
    Params p{};
    const float** pp = (const float**)&p;
    for (int i = 0; i < 21; ++i) pp[i] = (const float*)d_in[i];
    p.out = (float*)d_out; p.ws = (unsigned char*)d_ws;
#ifndef DBG_LO
#define DBG_LO 0
#endif
#ifndef DBG_HI
#define DBG_HI NPH
#endif
    int lo = DBG_LO, hi = DBG_HI;
    void* args[] = {&p, &lo, &hi};
    hipError_t e = hipLaunchCooperativeKernel((const void*)fwd_megakernel, dim3(grid_blocks), dim3(512), args, LDS_BYTES, stream);
    if (e != hipSuccess) fprintf(stderr, "cooperative launch failed: %s (grid %d)\n", hipGetErrorString(e), grid_blocks);
}
```

```cpp
#include <hip/hip_runtime.h>
#include <hip/hip_cooperative_groups.h>
#include <cstdio>
#include <cstdint>
namespace cg = cooperative_groups;

#define LAS __attribute__((address_space(3)))
typedef unsigned short bf16_t;
typedef short bf16x8 __attribute__((ext_vector_type(8)));
typedef short s16x4 __attribute__((ext_vector_type(4)));
typedef float f32x4 __attribute__((ext_vector_type(4)));
typedef float f32x2 __attribute__((ext_vector_type(2)));
typedef float f32x16 __attribute__((ext_vector_type(16)));
typedef unsigned u32x4 __attribute__((ext_vector_type(4)));
typedef unsigned u32x2 __attribute__((ext_vector_type(2)));

constexpr int T_ = 16384, D_ = 2048, S_ = 4096;
constexpr float EPS_ = 1e-6f;
constexpr int LDS_PHASE_BYTES = 156672;
constexpr int LDS_BYTES = LDS_PHASE_BYTES + 16;

constexpr size_t SZ_A_IN = 6144ull * 2048 * 2, SZ_A_OUT = 2048ull * 2048 * 2, SZ_W1 = 8192ull * 2048 * 2;
constexpr size_t OFF_WT_A_IN = 0;
constexpr size_t OFF_WT_A_OUT = OFF_WT_A_IN + 2 * SZ_A_IN;
constexpr size_t OFF_WT_GLU = OFF_WT_A_OUT + 2 * SZ_A_OUT;
constexpr size_t OFF_WT_C_IN = OFF_WT_GLU + 4096ull * 2048 * 2;
constexpr size_t OFF_WT_C_OUT = OFF_WT_C_IN + 12288ull * 2048 * 2;
constexpr size_t OFF_WT_W1 = OFF_WT_C_OUT + 2048ull * 4096 * 2;
constexpr size_t OFF_WT_W2 = OFF_WT_W1 + 4 * SZ_W1;
constexpr size_t OFF_XB = OFF_WT_W2 + 4 * SZ_W1;
constexpr size_t OFF_BIG = OFF_XB + (size_t)T_ * D_ * 2;
constexpr size_t OFF_OA = OFF_BIG + (size_t)T_ * 12288 * 2;
constexpr size_t OFF_SS = OFF_OA + (size_t)T_ * 4096 * 2;
constexpr size_t OFF_RSSQ = OFF_SS + 9ull * T_ * 4;
constexpr size_t OFF_ROT = OFF_RSSQ + (size_t)T_ * 8 * 4;
constexpr size_t OFF_S5B = OFF_ROT + 4096ull * 128 * 8;
constexpr size_t OFF_S5C = OFF_S5B + 128ull * 128 * 16 * 2;
constexpr size_t OFF_S5AB = OFF_S5C + 128ull * 16 * 128 * 2;
constexpr size_t WS_END = OFF_S5AB + 128ull * 64 * 8;
constexpr size_t OFF_SSP = WS_END;
constexpr size_t OFF_RSQP = OFF_SSP + 9ull * 32 * T_ * 4;
constexpr size_t OFF_RSFIN = OFF_RSQP + 8ull * T_ * 8 * 4;
constexpr size_t OFF_BAR = OFF_RSFIN + (size_t)T_ * 4;
constexpr size_t OFF_PAR = OFF_BAR + 16384;
constexpr int PAR_GMIX = 0, PAR_NFINAL = 2048, PAR_LAM = 4096, PAR_SUBLN = 5120, PAR_BD = 5632, PAR_N = 7680;
constexpr size_t WS_NEED = OFF_PAR + PAR_N * 4;
constexpr size_t OFF_ATT_SCR = OFF_BIG + (size_t)T_ * 6144 * 2;

struct Params {
    const float* x; const float* norm_mix; const float* norm_mlp; const float* norm_final;
    const float* a_w_in; const float* a_lambda; const float* a_subln; const float* a_w_out;
    const float* b_a_re; const float* b_a_im; const float* b_log_dt; const float* b_b_re; const float* b_b_im;
    const float* b_c_re; const float* b_c_im; const float* b_d; const float* b_w_glu;
    const float* c_w_in; const float* c_w_out; const float* mlp_w1; const float* mlp_w2;
    float* out; unsigned char* ws;
};

__device__ __forceinline__ unsigned cvt_pk_bf16(float lo, float hi) { unsigned r; asm volatile("v_cvt_pk_bf16_f32 %0, %1, %2" : "=v"(r) : "v"(lo), "v"(hi)); return r; }
__device__ __forceinline__ float bf2f(unsigned short b) { return __uint_as_float(((unsigned)b) << 16); }
__device__ __forceinline__ float bflo(unsigned w) { return __uint_as_float(w << 16); }
__device__ __forceinline__ float bfhi(unsigned w) { return __uint_as_float(w & 0xffff0000u); }
__device__ __forceinline__ unsigned short f2bf(float f) { return (unsigned short)(cvt_pk_bf16(f, 0.f) & 0xffffu); }

__device__ __forceinline__ int otid() { int t = threadIdx.x; asm volatile("" : "+v"(t)); return t; }
__device__ __forceinline__ int obid() { int t = blockIdx.x; asm volatile("" : "+s"(t)); return t; }

namespace pg8 {
constexpr int BM = 256, BK = 64, HALF = 128, HTB = HALF * BK * 2, STAGE_BYTES = 8 * HTB, NXCD = 8, WGM = 8;
__device__ __forceinline__ int lds_byte(int r, int c) { const int st = (r >> 4) * 2 + (c >> 5), rr = r & 15, cc = c & 31, ob = rr * 64 + cc * 2; return st * 1024 + (ob ^ (((ob >> 9) & 1) << 5)); }
__device__ __forceinline__ void stage_rc(int b, int& R, int& C) { const int st = b / 1024, sb = b % 1024, swz = sb ^ (((sb >> 9) & 1) << 5); R = (st >> 1) * 16 + swz / 64; C = (st & 1) * 32 + (swz % 64) / 2; }
struct Unit { int pm, pn; };
struct Gemm { const bf16_t* A; const bf16_t* Bt; int M, N, K; };
struct StaticOrder {
    int nM, nN, nwg, G, c;
    __device__ void init(int M, int N, int G_, int c_) { nM = M / BM; nN = N / BM; nwg = nM * nN; G = G_; c = c_; }
    __device__ bool next(int i, Unit& u) const {
        const long L = (long)i * G + c; if (L >= nwg) return false;
        int wgid = (int)L; { const int q = nwg / NXCD, r = nwg % NXCD, xcd = wgid % NXCD, off = wgid / NXCD; wgid = (xcd < r ? xcd * (q + 1) : r * (q + 1) + (xcd - r) * q) + off; }
        const int nig = WGM * nN, gid = wgid / nig, fm = gid * WGM, gsz = (nM - fm) < WGM ? (nM - fm) : WGM;
        u.pm = fm + ((wgid % nig) % gsz); u.pn = (wgid % nig) / gsz; return true;
    }
};

#define GAS __attribute__((address_space(1)))
struct EpiBf {
    bf16_t* O; int ldc; const float* ss; int mode; const f32x2* rot;
    __device__ __forceinline__ void operator()(const f32x4 (&acc)[2][2][4][2], const Unit& u, int wr, int wc, int fr, int fq, LAS unsigned char* lds, int ui) const {
        const int row0 = u.pm * BM + wr * 64 + fr, colt = u.pn * BM + wc * 32 + 8 * fq;
        int sub = 0;
        if (mode == 1) sub = 1;
        else if (mode == 2) { sub = u.pn < 8 ? 2 : (u.pn < 16 ? 3 : (u.pn < 32 ? 0 : 4)); }
        const LAS float* lrs = (const LAS float*)(lds + STAGE_BYTES) + ui * 256 + wr * 64 + fr;
        float rs8[8];
#pragma unroll
        for (int r = 0; r < 8; ++r) rs8[r] = lrs[(r >> 2) * HALF + (r & 3) * 16];
        GAS bf16_t* Og = (GAS bf16_t*)O;
        if (sub == 2 || sub == 3) {
            const GAS f32x2* rotg = (const GAS f32x2*)rot + wc * 32 + 8 * fq;
#pragma unroll
            for (int ai = 0; ai < 2; ++ai) {
                f32x2 cs[4][2][4];
#pragma unroll
                for (int m = 0; m < 4; ++m) { const int row = row0 + ai * HALF + m * 16; const GAS f32x2* rp = rotg + (size_t)(row & (S_ - 1)) * 128;
#pragma unroll
                    for (int n = 0; n < 2; ++n)
#pragma unroll
                        for (int j = 0; j < 4; ++j) cs[m][n][j] = rp[n * 4 + j]; }
#pragma unroll
                for (int m = 0; m < 4; ++m) { const int row = row0 + ai * HALF + m * 16;
                    float ksc = rs8[ai * 4 + m];
                    if (sub == 3) { const float lgam = logf(1.0f - exp2f(-5.0f - (float)(u.pn - 8))); ksc *= 0.0625f * __expf(lgam * (float)(63 - (row & 63))); }
                    GAS bf16_t* rowp = Og + (size_t)row * ldc + colt;
                    u32x4 w1, w2;
#pragma unroll
                    for (int n = 0; n < 2; ++n) {
                        const f32x4 t1 = acc[ai][0][m][n] * ksc, t2 = acc[ai][1][m][n] * ksc;
                        f32x4 o1, o2;
#pragma unroll
                        for (int j = 0; j < 4; ++j) { const f32x2 c2 = cs[m][n][j]; o1[j] = t1[j] * c2.x - t2[j] * c2.y; o2[j] = t1[j] * c2.y + t2[j] * c2.x; }
                        w1[2 * n] = cvt_pk_bf16(o1[0], o1[1]); w1[2 * n + 1] = cvt_pk_bf16(o1[2], o1[3]); w2[2 * n] = cvt_pk_bf16(o2[0], o2[1]); w2[2 * n + 1] = cvt_pk_bf16(o2[2], o2[3]);
                    }
                    *(GAS u32x4*)(rowp) = w1; *(GAS u32x4*)(rowp + HALF) = w2;
                }
            }
        } else {
#pragma unroll
            for (int ai = 0; ai < 2; ++ai)
#pragma unroll
                for (int m = 0; m < 4; ++m) {
                    const int row = row0 + ai * HALF + m * 16;
                    const float rs = rs8[ai * 4 + m];
                    GAS bf16_t* rowp = Og + (size_t)row * ldc + colt;
#pragma unroll
                    for (int bj = 0; bj < 2; ++bj) {
                        u32x4 w;
#pragma unroll
                        for (int n = 0; n < 2; ++n) {
                            f32x4 v = acc[ai][bj][m][n] * rs;
                            if (sub == 1) {
#pragma unroll
                                for (int j = 0; j < 4; ++j) { const float r = fmaxf(v[j], 0.f); v[j] = r * r; }
                            } else if (sub == 4) {
#pragma unroll
                                for (int j = 0; j < 4; ++j) v[j] = v[j] / (1.0f + __expf(-v[j]));
                            }
                            w[2 * n] = cvt_pk_bf16(v[0], v[1]); w[2 * n + 1] = cvt_pk_bf16(v[2], v[3]);
                        }
                        *(GAS u32x4*)(rowp + bj * HALF) = w;
                    }
                }
        }
    }
};
struct EpiRes {
    const float* xin; float* xout; bf16_t* xb; float* ssn; int glu;
    __device__ __forceinline__ void operator()(const f32x4 (&acc)[2][2][4][2], const Unit& u, int wr, int wc, int fr, int fq, LAS unsigned char*, int) const {
        const int row0 = u.pm * BM + wr * 64 + fr;
        const GAS float* xi = (const GAS float*)xin; GAS float* xo = (GAS float*)xout; GAS bf16_t* xbg = (GAS bf16_t*)xb; GAS float* ssg = (GAS float*)ssn;
        if (glu) {
            const size_t cb = (size_t)u.pn * HALF + wc * 32 + 8 * fq;
#pragma unroll
            for (int ai = 0; ai < 2; ++ai) {
                f32x4 xv[4][2];
#pragma unroll
                for (int m = 0; m < 4; ++m)
#pragma unroll
                    for (int n = 0; n < 2; ++n) xv[m][n] = *(const GAS f32x4*)(xi + (size_t)(row0 + ai * HALF + m * 16) * D_ + cb + n * 4);
#pragma unroll
                for (int m = 0; m < 4; ++m) {
                    const int row = row0 + ai * HALF + m * 16; const size_t off = (size_t)row * D_ + cb;
                    float sq = 0.f; u32x4 w;
#pragma unroll
                    for (int n = 0; n < 2; ++n) {
                        const f32x4 va = acc[ai][0][m][n], ga = acc[ai][1][m][n];
                        f32x4 x4 = xv[m][n];
#pragma unroll
                        for (int j = 0; j < 4; ++j) { x4[j] += va[j] / (1.0f + __expf(-ga[j])); sq += x4[j] * x4[j]; }
                        *(GAS f32x4*)(xo + off + n * 4) = x4;
                        w[2 * n] = cvt_pk_bf16(x4[0], x4[1]); w[2 * n + 1] = cvt_pk_bf16(x4[2], x4[3]);
                    }
                    *(GAS u32x4*)(xbg + off) = w;
                    sq += __shfl_xor(sq, 16); sq += __shfl_xor(sq, 32);
                    if (fq == 0) atomicAdd((float*)ssn + (size_t)((u.pn >> 1) * 4 + wc) * T_ + row, sq);
                }
            }
        } else {
            const size_t cb = (size_t)u.pn * BM + wc * 32 + 8 * fq;
#pragma unroll
            for (int ai = 0; ai < 2; ++ai) {
                f32x4 xv[4][2][2];
#pragma unroll
                for (int m = 0; m < 4; ++m)
#pragma unroll
                    for (int bj = 0; bj < 2; ++bj)
#pragma unroll
                        for (int n = 0; n < 2; ++n) xv[m][bj][n] = *(const GAS f32x4*)(xi + (size_t)(row0 + ai * HALF + m * 16) * D_ + cb + bj * HALF + n * 4);
#pragma unroll
                for (int m = 0; m < 4; ++m) {
                    const int row = row0 + ai * HALF + m * 16; const size_t off = (size_t)row * D_ + cb;
                    float sq = 0.f;
#pragma unroll
                    for (int bj = 0; bj < 2; ++bj) {
                        u32x4 w;
#pragma unroll
                        for (int n = 0; n < 2; ++n) {
                            f32x4 x4 = xv[m][bj][n] + acc[ai][bj][m][n];
#pragma unroll
                            for (int j = 0; j < 4; ++j) sq += x4[j] * x4[j];
                            *(GAS f32x4*)(xo + off + bj * HALF + n * 4) = x4;
                            w[2 * n] = cvt_pk_bf16(x4[0], x4[1]); w[2 * n + 1] = cvt_pk_bf16(x4[2], x4[3]);
                        }
                        *(GAS u32x4*)(xbg + off + bj * HALF) = w;
                    }
                    sq += __shfl_xor(sq, 16); sq += __shfl_xor(sq, 32);
                    if (fq == 0) ssg[(size_t)(u.pn * 4 + wc) * T_ + row] = sq;
                }
            }
        }
    }
};

template <class Epi, class Sched>
__device__ __forceinline__ void gemm_phase(LAS unsigned char* lds, const Gemm g, const Sched& S, const Epi& E) {
    const int tid = otid(), wid = __builtin_amdgcn_readfirstlane(tid >> 6), lane = tid & 63, wr = wid >> 2, wc = wid & 3, fr = lane & 15, fq = lane >> 4;
    const int K = g.K, nt = K / BK;
    unsigned voffA[2], voffB[2];
#pragma unroll
    for (int i = 0; i < 2; ++i) { int R, C; stage_rc(tid * 16 + i * 8192, R, C); voffA[i] = (unsigned)(R * K + C) * 2u; voffB[i] = voffA[i]; }
    const size_t kstep = (size_t)(BK * 2);
    const size_t hstep = (size_t)HALF * K * 2;
    const size_t tstep = 2 * hstep;
    const unsigned ldsw = (unsigned)wid * 1024u;
    const int aoff = lds_byte(wr * 64 + fr, fq * 8), boff = lds_byte(wc * 32 + fr, fq * 8);
#define PG8_SA(b, h) (((b) * 2 + (h)) * HTB)
#define PG8_SB(b, h) ((4 + (b) * 2 + (h)) * HTB)
#define PG8_STAGE(bufoff, gbase, voff) do { _Pragma("unroll") for (int _i = 0; _i < 2; ++_i) \
        __builtin_amdgcn_global_load_lds((const unsigned*)((const char*)(gbase) + (voff)[_i]), (LAS unsigned*)(lds + (bufoff) + ldsw + _i * 8192), 16, 0, 0); } while (0)
#define PG8_LDA(dst, b, h) do { _Pragma("unroll") for (int m = 0; m < 4; ++m) _Pragma("unroll") for (int k = 0; k < 2; ++k) dst[m][k] = *(const LAS bf16x8*)(lds + PG8_SA(b, h) + aoff + m * 2048 + k * 1024); } while (0)
#define PG8_LDB(dst, b, h) do { _Pragma("unroll") for (int n = 0; n < 2; ++n) _Pragma("unroll") for (int k = 0; k < 2; ++k) dst[n][k] = *(const LAS bf16x8*)(lds + PG8_SB(b, h) + boff + n * 2048 + k * 1024); } while (0)
#define PG8_MMA(ai, bj, At, Bt) do { __builtin_amdgcn_s_setprio(1); _Pragma("unroll") for (int m = 0; m < 4; ++m) _Pragma("unroll") for (int n = 0; n < 2; ++n) _Pragma("unroll") for (int k = 0; k < 2; ++k) \
        acc[ai][bj][m][n] = __builtin_amdgcn_mfma_f32_16x16x32_bf16(Bt[n][k], At[m][k], acc[ai][bj][m][n], 0, 0, 0); __builtin_amdgcn_s_setprio(0); } while (0)
#define PG8_WAIT_V(n) asm volatile("s_waitcnt vmcnt(" #n ")" ::: "memory")
#define PG8_WAIT_L(n) asm volatile("s_waitcnt lgkmcnt(" #n ")" ::: "memory")
#define PG8_BAR __builtin_amdgcn_s_barrier()
#define PG8_SCHED __builtin_amdgcn_sched_barrier(0)
    Unit cur, nxt; int ui = 0;
    if (!S.next(0, cur)) return;
    f32x4 acc[2][2][4][2];
#pragma unroll
    for (int a = 0; a < 2; ++a)
#pragma unroll
        for (int b = 0; b < 2; ++b)
#pragma unroll
            for (int m = 0; m < 4; ++m)
#pragma unroll
                for (int n = 0; n < 2; ++n) acc[a][b][m][n] = (f32x4){0.f, 0.f, 0.f, 0.f};
    bf16x8 At[4][2], B0[2][2], B1[2][2];
    const char* cA = (const char*)g.A + (size_t)cur.pm * tstep; const char* cB = (const char*)g.Bt + (size_t)cur.pn * tstep;
    PG8_STAGE(PG8_SB(0, 0), cB, voffB); PG8_STAGE(PG8_SA(0, 0), cA, voffA); PG8_STAGE(PG8_SB(0, 1), cB + hstep, voffB); PG8_STAGE(PG8_SA(0, 1), cA + hstep, voffA);
    if (wr == 1) PG8_BAR;
    PG8_WAIT_V(4); PG8_BAR;
    PG8_STAGE(PG8_SB(1, 0), cB + kstep, voffB); PG8_STAGE(PG8_SA(1, 0), cA + kstep, voffA); PG8_STAGE(PG8_SB(1, 1), cB + hstep + kstep, voffB);
    PG8_WAIT_V(6); PG8_BAR;
    for (;;) {
        const bool has_next = S.next(ui + 1, nxt);
        const char* nA = has_next ? (const char*)g.A + (size_t)nxt.pm * tstep : cA; const char* nB = has_next ? (const char*)g.Bt + (size_t)nxt.pn * tstep : cB;
        for (int t = 0; t < nt; t += 2) {
            const bool last = (t == nt - 2);
            const char* a1 = cA + (size_t)(t + 1) * kstep;
            const char* a2 = last ? nA : cA + (size_t)(t + 2) * kstep; const char* b2 = last ? nB : cB + (size_t)(t + 2) * kstep;
            const char* a3 = a2 + kstep; const char* b3 = b2 + kstep;
            PG8_LDB(B0, 0, 0); PG8_SCHED; PG8_LDA(At, 0, 0); PG8_STAGE(PG8_SA(1, 1), a1 + hstep, voffA);
            PG8_WAIT_L(8); PG8_BAR; PG8_WAIT_L(0); PG8_MMA(0, 0, At, B0); PG8_BAR; PG8_SCHED;
            PG8_LDB(B1, 0, 1); PG8_STAGE(PG8_SB(0, 0), b2, voffB);
            PG8_BAR; PG8_WAIT_L(0); PG8_MMA(0, 1, At, B1); PG8_BAR;
            PG8_LDA(At, 0, 1); PG8_STAGE(PG8_SA(0, 0), a2, voffA);
            PG8_BAR; PG8_WAIT_L(0); PG8_MMA(1, 0, At, B0); PG8_BAR; PG8_SCHED;
            PG8_STAGE(PG8_SB(0, 1), b2 + hstep, voffB);
            PG8_WAIT_V(6); PG8_BAR; PG8_MMA(1, 1, At, B1); PG8_BAR;
            PG8_LDB(B0, 1, 0); PG8_SCHED; PG8_LDA(At, 1, 0); PG8_STAGE(PG8_SA(0, 1), a2 + hstep, voffA);
            PG8_WAIT_L(8); PG8_BAR; PG8_WAIT_L(0); PG8_MMA(0, 0, At, B0); PG8_BAR; PG8_SCHED;
            PG8_LDB(B1, 1, 1); PG8_STAGE(PG8_SB(1, 0), b3, voffB);
            PG8_BAR; PG8_WAIT_L(0); PG8_MMA(0, 1, At, B1); PG8_BAR;
            PG8_LDA(At, 1, 1); PG8_STAGE(PG8_SA(1, 0), a3, voffA);
            PG8_BAR; PG8_WAIT_L(0); PG8_MMA(1, 0, At, B0); PG8_BAR; PG8_SCHED;
            PG8_STAGE(PG8_SB(1, 1), b3 + hstep, voffB);
            PG8_WAIT_V(6); PG8_BAR; PG8_MMA(1, 1, At, B1); PG8_BAR;
        }
        E(acc, cur, wr, wc, fr, fq, lds, ui);
        if (!has_next) break;
#pragma unroll
        for (int a = 0; a < 2; ++a)
#pragma unroll
            for (int b = 0; b < 2; ++b)
#pragma unroll
                for (int m = 0; m < 4; ++m)
#pragma unroll
                    for (int n = 0; n < 2; ++n) acc[a][b][m][n] = (f32x4){0.f, 0.f, 0.f, 0.f};
        cur = nxt; cA = nA; cB = nB; ++ui;
    }
    PG8_WAIT_V(0);
    if (wr == 0) PG8_BAR;
    PG8_BAR;
#undef PG8_SA
#undef PG8_SB
#undef PG8_STAGE
#undef PG8_LDA
#undef PG8_LDB
#undef PG8_MMA
#undef PG8_WAIT_V
#undef PG8_WAIT_L
#undef PG8_BAR
#undef PG8_SCHED
}
}

namespace att {
constexpr int D = 128, KVBLK = 64, LDK = 6144;
constexpr float SCALE = 0.088388347648318440f;
constexpr float THR = 8.f;
constexpr size_t SHM_V = KVBLK * D * 2, SHM_K = KVBLK * D * 2;
#define KSWZ(row, colB) ((row) * 256 + ((colB) ^ (((row) & 7) << 4)))
#define SBAR() __builtin_amdgcn_sched_barrier(0)
__device__ __forceinline__ int crow(int r, int hi) { return (r & 3) + 8 * (r >> 2) + 4 * hi; }
__device__ __forceinline__ void partialSM(f32x16& p0, f32x16& p1, float& m_reg, float& mn, float& alpha, bool msk) {
    constexpr float C = SCALE * 1.4426950408889634f;
    if (msk) {
#pragma unroll
        for (int r = 0; r < 16; ++r) { p0[r] = -1e30f; p1[r] = -1e30f; }
    }
    float pmax = p0[0];
#pragma unroll
    for (int r = 1; r < 16; ++r) pmax = fmaxf(pmax, p0[r]);
#pragma unroll
    for (int r = 0; r < 16; ++r) pmax = fmaxf(pmax, p1[r]);
    { auto rr = __builtin_amdgcn_permlane32_swap(__float_as_uint(pmax), __float_as_uint(pmax), false, false);
      pmax = fmaxf(__uint_as_float(rr[0]), __uint_as_float(rr[1])); }
    if (__builtin_expect(__all(pmax - m_reg <= THR / SCALE), 1)) { mn = m_reg; alpha = 1.f; }
    else { mn = fmaxf(m_reg, pmax); alpha = __builtin_amdgcn_exp2f((m_reg - mn) * C); m_reg = mn; }
    float mnC = -mn * C;
#pragma unroll
    for (int r = 0; r < 16; ++r) p0[r] = fmaf(p0[r], C, mnC);
#pragma unroll
    for (int r = 0; r < 16; ++r) p1[r] = fmaf(p1[r], C, mnC);
#pragma unroll
    for (int r = 0; r < 16; ++r) p0[r] = __builtin_amdgcn_exp2f(p0[r]);
}
__device__ __forceinline__ void finishSM(f32x16& p0, f32x16& p1, float alpha, float& l_reg, bf16x8& pa0, bf16x8& pa1, bf16x8& pa2, bf16x8& pa3) {
#pragma unroll
    for (int r = 0; r < 16; ++r) p1[r] = __builtin_amdgcn_exp2f(p1[r]);
    float ps = 0;
#pragma unroll
    for (int r = 0; r < 16; ++r) ps += p0[r];
#pragma unroll
    for (int r = 0; r < 16; ++r) ps += p1[r];
    { auto rr = __builtin_amdgcn_permlane32_swap(__float_as_uint(ps), __float_as_uint(ps), false, false);
      ps = __uint_as_float(rr[0]) + __uint_as_float(rr[1]); }
    l_reg = l_reg * alpha + ps;
#define PK4(P, BASE, OUT) do { unsigned a0 = cvt_pk_bf16(P[BASE + 0], P[BASE + 1]), a1 = cvt_pk_bf16(P[BASE + 2], P[BASE + 3]);   \
    unsigned b0 = cvt_pk_bf16(P[BASE + 4], P[BASE + 5]), b1 = cvt_pk_bf16(P[BASE + 6], P[BASE + 7]);                              \
    auto r0 = __builtin_amdgcn_permlane32_swap(a0, b0, false, false); auto r1 = __builtin_amdgcn_permlane32_swap(a1, b1, false, false); \
    u32x4 w = {r0[0], r1[0], r0[1], r1[1]}; OUT = *reinterpret_cast<bf16x8*>(&w); } while (0)
    PK4(p0, 0, pa0); PK4(p0, 8, pa1); PK4(p1, 0, pa2); PK4(p1, 8, pa3);
#undef PK4
}
__device__ __forceinline__ void qkt(f32x16& p0, f32x16& p1, const char* Ks, const bf16x8* qr, int r32, int hi) {
    p0 = f32x16{}; p1 = f32x16{};
#pragma unroll
    for (int d0 = 0; d0 < 8; ++d0) { int cb = (d0 * 16 + hi * 8) * 2;
        bf16x8 b0 = *reinterpret_cast<const bf16x8*>(Ks + KSWZ(r32, cb));
        bf16x8 b1 = *reinterpret_cast<const bf16x8*>(Ks + KSWZ(32 + r32, cb));
        p0 = __builtin_amdgcn_mfma_f32_32x32x16_bf16(b0, qr[d0], p0, 0, 0, 0);
        p1 = __builtin_amdgcn_mfma_f32_32x32x16_bf16(b1, qr[d0], p1, 0, 0, 0); }
}
__device__ __forceinline__ int v_st(int k, int c) { const int kk = (k & ~0xC) | ((k & 4) << 1) | ((k & 8) >> 1); return ((kk >> 3) * 4 + (c >> 5)) * 512 + ((kk & 7) * 32 + (c & 31)) * 2; }
__device__ __forceinline__ int v_rd_base(int lane) { return ((lane & 3) << 3) | (((lane >> 2) & 3) << 6) | (((lane >> 4) & 1) << 5) | (((lane >> 5) & 1) << 8); }
constexpr int v_rd_off(int d0, int ks, int half) { return d0 * 512 + ks * 4096 + half * 2048; }
template <int OFF> __device__ __forceinline__ s16x4 tr_read(int vb) {
    s16x4 r; asm volatile("ds_read_b64_tr_b16 %0, %1 offset:%2" : "=&v"(r) : "v"(vb), "i"(OFF) : "memory"); return r;
}
template <int D0> __device__ __forceinline__ void pv_one(f32x16& od, int vb, bf16x8 pa0, bf16x8 pa1, bf16x8 pa2, bf16x8 pa3) {
    const s16x4 l0 = tr_read<v_rd_off(D0, 0, 0)>(vb), h0 = tr_read<v_rd_off(D0, 0, 1)>(vb), l1 = tr_read<v_rd_off(D0, 1, 0)>(vb), h1 = tr_read<v_rd_off(D0, 1, 1)>(vb);
    const s16x4 l2 = tr_read<v_rd_off(D0, 2, 0)>(vb), h2 = tr_read<v_rd_off(D0, 2, 1)>(vb), l3 = tr_read<v_rd_off(D0, 3, 0)>(vb), h3 = tr_read<v_rd_off(D0, 3, 1)>(vb);
    asm volatile("s_waitcnt lgkmcnt(0)" ::: "memory"); SBAR();
#define PK(L, H) (bf16x8){L[0], L[1], L[2], L[3], H[0], H[1], H[2], H[3]}
    od = __builtin_amdgcn_mfma_f32_32x32x16_bf16(pa0, PK(l0, h0), od, 0, 0, 0);
    od = __builtin_amdgcn_mfma_f32_32x32x16_bf16(pa1, PK(l1, h1), od, 0, 0, 0);
    od = __builtin_amdgcn_mfma_f32_32x32x16_bf16(pa2, PK(l2, h2), od, 0, 0, 0);
    od = __builtin_amdgcn_mfma_f32_32x32x16_bf16(pa3, PK(l3, h3), od, 0, 0, 0);
#undef PK
}
__device__ __forceinline__ void pv_d0(f32x16* o, int vb, bf16x8 pa0, bf16x8 pa1, bf16x8 pa2, bf16x8 pa3) {
    pv_one<0>(o[0], vb, pa0, pa1, pa2, pa3); pv_one<1>(o[1], vb, pa0, pa1, pa2, pa3); pv_one<2>(o[2], vb, pa0, pa1, pa2, pa3); pv_one<3>(o[3], vb, pa0, pa1, pa2, pa3);
}
__device__ __forceinline__ void attn_body(const bf16_t* __restrict__ Qb, const bf16_t* __restrict__ Kh, const bf16_t* __restrict__ Vh, int NT, int ntw, char* lds, f32x16 (&o)[4]) {
    const int tid = otid(), wid = __builtin_amdgcn_readfirstlane(tid >> 6), lane = tid & 63, r32 = lane & 31, hi = lane >> 5;
    char* V_lds = lds; char* K_lds = lds + 2 * SHM_V;
    float* wsf = (float*)(lds + 2 * SHM_V + 2 * SHM_K) + wid * 64; float* li_l = wsf; float* al_l = wsf + 32;
    float m_reg = -1e30f, l_reg = 0; bf16x8 qr[8];
#pragma unroll
    for (int d = 0; d < 4; ++d) o[d] = f32x16{};
    const bf16_t* Qw = Qb + (long)(wid * 32 + r32) * LDK + hi * 8;
#pragma unroll
    for (int d0 = 0; d0 < 8; ++d0) qr[d0] = *reinterpret_cast<const bf16x8*>(Qw + d0 * 16);
    const int sr = tid >> 4, sc = (tid & 15) * 8, vst0 = v_st(sr, sc), vst1 = v_st(32 + sr, sc);
    const int vb0 = (int)(uintptr_t)V_lds + v_rd_base(lane);
    struct { bf16x8 vs0, vs1, ks0, ks1; } sr_[2];
#define SLOAD(i, k0) do { sr_[i].vs0 = *reinterpret_cast<const bf16x8*>(&Vh[(long)((k0) + sr) * LDK + sc]); sr_[i].vs1 = *reinterpret_cast<const bf16x8*>(&Vh[(long)((k0) + 32 + sr) * LDK + sc]); \
    sr_[i].ks0 = *reinterpret_cast<const bf16x8*>(&Kh[(long)((k0) + sr) * LDK + sc]); sr_[i].ks1 = *reinterpret_cast<const bf16x8*>(&Kh[(long)((k0) + 32 + sr) * LDK + sc]); } while (0)
#define SWRITE(b, i) do { *(bf16x8*)(V_lds + (b) * SHM_V + vst0) = sr_[i].vs0;          \
    *(bf16x8*)(V_lds + (b) * SHM_V + vst1) = sr_[i].vs1; int kc = sc * 2;               \
    *(bf16x8*)(K_lds + (b) * SHM_K + KSWZ(sr, kc)) = sr_[i].ks0;                       \
    *(bf16x8*)(K_lds + (b) * SHM_K + KSWZ(32 + sr, kc)) = sr_[i].ks1; } while (0)
#define SWAIT() asm volatile("s_waitcnt vmcnt(4)" ::: "memory")
#define RESC(a) do { if (__any((a) < 1.f)) { if (hi == 0) al_l[r32] = (a); asm volatile("s_waitcnt lgkmcnt(0)" ::: "memory"); \
    _Pragma("unroll") for (int d = 0; d < 4; ++d) _Pragma("unroll") for (int r = 0; r < 16; ++r) o[d][r] *= al_l[crow(r, hi)]; } } while (0)
    f32x16 pA0, pA1, pB0, pB1; float mnA, mnB, alA, alB; bf16x8 pa0, pa1, pa2, pa3;
    constexpr int SE = 0, SO = 1;
    __syncthreads();
    SLOAD(SE, 0); asm volatile("s_waitcnt vmcnt(0)" ::: "memory"); SWRITE(0, SE); __syncthreads();
    qkt(pA0, pA1, K_lds, qr, r32, hi); partialSM(pA0, pA1, m_reg, mnA, alA, false);
    SLOAD(SO, KVBLK); if (2 < NT) SLOAD(SE, 2 * KVBLK);
    SWAIT(); SWRITE(1, SO); __syncthreads();
    for (int j = 1; j + 1 < NT; j += 2) {
        SBAR(); qkt(pB0, pB1, K_lds + SHM_K, qr, r32, hi);
        finishSM(pA0, pA1, alA, l_reg, pa0, pa1, pa2, pa3); SBAR();
        SLOAD(SO, (j + 2) * KVBLK); SBAR();
        pv_d0(o, vb0, pa0, pa1, pa2, pa3); partialSM(pB0, pB1, m_reg, mnB, alB, j >= ntw);
        __syncthreads(); SWAIT(); SWRITE(0, SE);
        RESC(alB); __syncthreads();
        SBAR(); qkt(pA0, pA1, K_lds, qr, r32, hi);
        finishSM(pB0, pB1, alB, l_reg, pa0, pa1, pa2, pa3); SBAR();
        if (j + 3 < NT) SLOAD(SE, (j + 3) * KVBLK); SBAR();
        pv_d0(o, vb0 + (int)SHM_V, pa0, pa1, pa2, pa3); partialSM(pA0, pA1, m_reg, mnA, alA, (j + 1) >= ntw);
        __syncthreads(); SWAIT(); SWRITE(1, SO);
        RESC(alA); __syncthreads();
    }
    SBAR(); qkt(pB0, pB1, K_lds + SHM_K, qr, r32, hi);
    finishSM(pA0, pA1, alA, l_reg, pa0, pa1, pa2, pa3); SBAR();
    pv_d0(o, vb0, pa0, pa1, pa2, pa3); partialSM(pB0, pB1, m_reg, mnB, alB, (NT - 1) >= ntw);
    __syncthreads(); RESC(alB);
    finishSM(pB0, pB1, alB, l_reg, pa0, pa1, pa2, pa3); SBAR();
    pv_d0(o, vb0 + (int)SHM_V, pa0, pa1, pa2, pa3);
    if (hi == 0) li_l[r32] = l_reg; asm volatile("s_waitcnt lgkmcnt(0)" ::: "memory");
#pragma unroll
    for (int r = 0; r < 16; ++r) { const float rl = __builtin_amdgcn_rcpf(li_l[crow(r, hi)]);
#pragma unroll
        for (int d = 0; d < 4; ++d) o[d][r] *= rl; }
#undef SLOAD
#undef SWRITE
#undef SWAIT
#undef RESC
}
}

__device__ __forceinline__ void sincos_red(double ang, float& s, float& c) {
    const double k = rint(ang * 0.15915494309189535);
    const float r = (float)(ang - k * 6.283185307179586);
    s = __sinf(r); c = __cosf(r);
}
__device__ __forceinline__ float gelu_tanh(float y) {
    const float z = 0.7978845608028654f * (y + 0.044715f * y * y * y);
    const float th = 1.0f - 2.0f / (1.0f + __expf(2.0f * z));
    return 0.5f * y * (1.0f + th);
}

struct ConvJob { const float* W; bf16_t* Wt; const float* gain; int K, N, glu, tile; };
struct ConvRegs { f32x4 va[4], vb[4]; float ga[4], gb[4]; };
__device__ __forceinline__ ConvJob conv_decode(const Params& p, unsigned char* ws, int t) {
    ConvJob j; j.glu = 0; j.gain = nullptr;
    if (t < 1536) { const int q = t / 768; j.tile = t - q * 768; j.W = p.a_w_in + (size_t)q * 2048 * 6144; j.Wt = (bf16_t*)(ws + OFF_WT_A_IN + q * SZ_A_IN); j.K = 2048; j.N = 6144; j.gain = p.norm_mix + (size_t)(3 * q) * D_; }
    else if (t < 2048) { const int u = t - 1536; const int q = u / 256; j.tile = u - q * 256; j.W = p.a_w_out + (size_t)q * 2048 * 2048; j.Wt = (bf16_t*)(ws + OFF_WT_A_OUT + q * SZ_A_OUT); j.K = 2048; j.N = 2048; }
    else if (t < 2560) { j.tile = t - 2048; j.W = p.b_w_glu; j.Wt = (bf16_t*)(ws + OFF_WT_GLU); j.K = 2048; j.N = 4096; j.glu = 1; }
    else if (t < 4096) { j.tile = t - 2560; j.W = p.c_w_in; j.Wt = (bf16_t*)(ws + OFF_WT_C_IN); j.K = 2048; j.N = 12288; j.gain = p.norm_mix + 2 * D_; }
    else if (t < 4608) { j.tile = t - 4096; j.W = p.c_w_out; j.Wt = (bf16_t*)(ws + OFF_WT_C_OUT); j.K = 4096; j.N = 2048; }
    else if (t < 8704) { const int u = t - 4608; const int i = u / 1024; j.tile = u - i * 1024; j.W = p.mlp_w1 + (size_t)i * 2048 * 8192; j.Wt = (bf16_t*)(ws + OFF_WT_W1 + i * SZ_W1); j.K = 2048; j.N = 8192; j.gain = p.norm_mlp + (size_t)i * D_; }
    else { const int u = t - 8704; const int i = u / 1024; j.tile = u - i * 1024; j.W = p.mlp_w2 + (size_t)i * 8192 * 2048; j.Wt = (bf16_t*)(ws + OFF_WT_W2 + i * SZ_W1); j.K = 8192; j.N = 2048; }
    return j;
}
__device__ __forceinline__ void conv_load(const ConvJob& j, ConvRegs& r, int tid) {
    const int ntn = j.N >> 7; const int tk = j.tile / ntn, tn = j.tile - tk * ntn; const int k0 = tk << 7, n0 = tn << 7;
    const int kp = tid >> 5, nl = (tid & 31) << 2;
#pragma unroll
    for (int i = 0; i < 4; ++i) { const int k = 2 * (kp + 16 * i);
        r.va[i] = *(const f32x4*)(j.W + (size_t)(k0 + k) * j.N + n0 + nl); r.vb[i] = *(const f32x4*)(j.W + (size_t)(k0 + k + 1) * j.N + n0 + nl);
        r.ga[i] = j.gain ? j.gain[k0 + k] : 1.f; r.gb[i] = j.gain ? j.gain[k0 + k + 1] : 1.f; }
}
__device__ __forceinline__ void conv_store(const ConvJob& j, const ConvRegs& r, int tid, unsigned* ldsw) {
    const int ntn = j.N >> 7; const int tk = j.tile / ntn, tn = j.tile - tk * ntn; const int k0 = tk << 7, n0 = tn << 7;
    const int kp = tid >> 5, nl = (tid & 31) << 2;
    __syncthreads();
#pragma unroll
    for (int i = 0; i < 4; ++i) { const int kpair = kp + 16 * i;
#pragma unroll
        for (int jj = 0; jj < 4; ++jj) ldsw[(nl + jj) * 65 + kpair] = cvt_pk_bf16(r.va[i][jj] * r.ga[i], r.vb[i][jj] * r.gb[i]); }
    __syncthreads();
    int nbase = n0;
    if (j.glu) { const int bj = n0 >> 11, pn = (n0 & 2047) >> 7; nbase = 256 * pn + 128 * bj; }
#pragma unroll
    for (int i = 0; i < 4; ++i) { const int n = (tid >> 4) + 32 * i, k8 = tid & 15;
        u32x4 w; w.x = ldsw[n * 65 + k8 * 4 + 0]; w.y = ldsw[n * 65 + k8 * 4 + 1]; w.z = ldsw[n * 65 + k8 * 4 + 2]; w.w = ldsw[n * 65 + k8 * 4 + 3];
        const int c5 = n & 31, np = (n & ~31) | (16 * ((c5 >> 2) & 1) + 4 * (c5 >> 3) + (c5 & 3));
        *(u32x4*)(j.Wt + (size_t)(nbase + np) * j.K + k0 + k8 * 8) = w; }
}

__device__ __forceinline__ void prep_phase(const Params& p, unsigned char* shm) {
    const int tid = otid(), bid = obid(), G = gridDim.x;
    unsigned char* ws = p.ws;
    {
        ConvJob jc = conv_decode(p, ws, bid); ConvRegs rc; conv_load(jc, rc, tid);
#pragma unroll 1
        for (int t = bid; t < 12800; t += G) {
            ConvJob jn = jc; ConvRegs rn = rc;
            if (t + G < 12800) { jn = conv_decode(p, ws, t + G); conv_load(jn, rn, tid); }
            conv_store(jc, rc, tid, (unsigned*)shm);
            jc = jn; rc = rn;
        }
    }
    {
        float* ss = (float*)(ws + OFF_SSP); bf16_t* xb = (bf16_t*)(ws + OFF_XB);
        const int wid = tid >> 6, lane = tid & 63;
        for (int row = bid * 8 + wid; row < T_; row += G * 8) {
            const float* xr = p.x + (size_t)row * D_; float sq = 0.f;
#pragma unroll
            for (int i = 0; i < 8; ++i) { const f32x4 v = *(const f32x4*)(xr + (i * 64 + lane) * 4);
                sq += v[0] * v[0] + v[1] * v[1] + v[2] * v[2] + v[3] * v[3];
                *(f32x4*)(p.out + (size_t)row * D_ + (i * 64 + lane) * 4) = v;
                u32x2 w; w.x = cvt_pk_bf16(v[0], v[1]); w.y = cvt_pk_bf16(v[2], v[3]);
                *(u32x2*)(xb + (size_t)row * D_ + (i * 64 + lane) * 4) = w; }
#pragma unroll
            for (int o = 32; o > 0; o >>= 1) sq += __shfl_xor(sq, o);
            if (lane < 32) ss[(size_t)lane * T_ + row] = (lane == 0) ? sq : 0.f;
        }
        for (int i = bid * 512 + tid; i < 32 * T_; i += G * 512) ss[(size_t)3 * 32 * T_ + i] = 0.f;
        float* rssq = (float*)(ws + OFF_RSQP);
        for (int i = bid * 512 + tid; i < 64 * T_; i += G * 512) rssq[i] = 0.f;
    }
    {
        float* par = (float*)(ws + OFF_PAR);
        for (int i = bid * 512 + tid; i < PAR_N; i += G * 512) {
            float v;
            if (i < PAR_NFINAL) v = p.norm_mix[D_ + i];
            else if (i < PAR_LAM) v = p.norm_final[i - PAR_NFINAL];
            else if (i < PAR_SUBLN) v = p.a_lambda[i - PAR_LAM];
            else if (i < PAR_BD) v = p.a_subln[i - PAR_SUBLN];
            else v = p.b_d[i - PAR_BD];
            par[i] = v;
        }
    }
    {
        f32x2* rot = (f32x2*)(ws + OFF_ROT);
        for (int i = bid * 512 + tid; i < 4096 * 128; i += G * 512) {
            const int pos = i >> 7, j = i & 127;
            const double inv = exp(-9.210340371976184 * ((double)j / 127.0));
            float s, c; sincos_red((double)pos * inv, s, c);
            f32x2 v; v.x = c; v.y = s; rot[i] = v;
        }
    }
    {
        bf16_t* Bm = (bf16_t*)(ws + OFF_S5B); bf16_t* Cm = (bf16_t*)(ws + OFF_S5C); f32x2* AB = (f32x2*)(ws + OFF_S5AB);
        const float* gmix = p.norm_mix + 1 * D_;
        for (int i = bid * 512 + tid; i < 128 * 64; i += G * 512) {
            const int g = i >> 6, pp = i & 63;
            const float lre = p.b_a_re[i], lim = p.b_a_im[i];
            const float dt = __expf(p.b_log_dt[g]);
            const float mag = __expf(lre * dt);
            float sn, cs; sincos_red((double)lim * (double)dt, sn, cs);
            const float abr = mag * cs, abi = mag * sn;
            const float den = lre * lre + lim * lim;
            const float nr = abr - 1.0f, ni = abi;
            const float cr_ = (nr * lre + ni * lim) / den, ci_ = (ni * lre - nr * lim) / den;
            f32x2 ab; ab.x = abr; ab.y = abi; AB[i] = ab;
#pragma unroll
            for (int c = 0; c < 16; ++c) {
                const float br = p.b_b_re[(size_t)i * 16 + c], bi = p.b_b_im[(size_t)i * 16 + c];
                const float gm = gmix[g * 16 + c];
                Bm[((size_t)g * 128 + pp) * 16 + c] = f2bf((cr_ * br - ci_ * bi) * gm);
                Bm[((size_t)g * 128 + 64 + pp) * 16 + c] = f2bf((cr_ * bi + ci_ * br) * gm);
                Cm[((size_t)g * 16 + c) * 128 + pp] = f2bf(p.b_c_re[((size_t)g * 16 + c) * 64 + pp]);
                Cm[((size_t)g * 16 + c) * 128 + 64 + pp] = f2bf(-p.b_c_im[((size_t)g * 16 + c) * 64 + pp]);
            }
        }
    }
}

__device__ __forceinline__ void attn_phase(const Params& p, int j, float lambda_init, unsigned char* shm) {
    const int tid = otid(), wid = __builtin_amdgcn_readfirstlane(tid >> 6), lane = tid & 63, r32 = lane & 31, hi = lane >> 5;
    const bf16_t* qkv = (const bf16_t*)(p.ws + OFF_BIG);
    bf16_t* oa = (bf16_t*)(p.ws + OFF_OA);
    float* scr = (float*)(p.ws + OFF_ATT_SCR) + (size_t)obid() * 2 * 32768;
    float lam;
    { const float* lp = (const float*)(p.ws + OFF_PAR) + PAR_LAM + (size_t)j * 512;
      float a = lp[lane] * lp[128 + lane] + lp[64 + lane] * lp[192 + lane];
      float b = lp[256 + lane] * lp[384 + lane] + lp[320 + lane] * lp[448 + lane];
#pragma unroll
      for (int o = 32; o > 0; o >>= 1) { a += __shfl_xor(a, o); b += __shfl_xor(b, o); }
      lam = __expf(a) - __expf(b) + lambda_init; lam = __uint_as_float(__builtin_amdgcn_readfirstlane(__float_as_uint(lam))); }
    const float* sub = (const float*)(p.ws + OFF_PAR) + PAR_SUBLN + (size_t)j * 256;
    const int c = obid(); const int xcd = c & 7, jj = c >> 3;
    const int bh = xcd * 4 + (jj >> 3), pi = jj & 7;
    const int b = bh >> 3, h = bh & 7;
#pragma unroll 1
    for (int it = 0; it < 2; ++it) {
        const int qb = it == 0 ? (15 - pi) : pi;
        const int NT = 4 * qb + 4, ntw = 4 * qb + (wid >> 1) + 1;
        const size_t tok0 = (size_t)b * S_ + (size_t)qb * 256;
        f32x16 o[4];
#pragma unroll 1
        for (int ps = 0; ps < 4; ++ps) {
            const int e = ps >> 1, t = ps & 1;
            float* sc = scr + e * 32768;
            att::attn_body(qkv + tok0 * 6144 + h * 256 + t * 128, qkv + (size_t)b * S_ * 6144 + 2048 + h * 256 + t * 128,
                           qkv + (size_t)b * S_ * 6144 + 4096 + h * 256 + e * 128, NT, ntw, (char*)shm, o);
            float* scb = sc + tid * 4; asm volatile("" : "+v"(scb));
            if (t == 0) {
#pragma unroll
                for (int d = 0; d < 4; ++d)
#pragma unroll
                    for (int q = 0; q < 4; ++q) { const f32x4 v = {o[d][4 * q], o[d][4 * q + 1], o[d][4 * q + 2], o[d][4 * q + 3]}; *(f32x4*)(scb + (d * 4 + q) * 2048) = v; }
            } else {
#pragma unroll
                for (int d = 0; d < 4; ++d)
#pragma unroll
                    for (int q = 0; q < 4; ++q) { f32x4 c = *(const f32x4*)(scb + (d * 4 + q) * 2048);
#pragma unroll
                        for (int k = 0; k < 4; ++k) { const float cv = c[k] - lam * o[d][4 * q + k]; o[d][4 * q + k] = cv; c[k] = cv; }
                        if (e == 0) *(f32x4*)(scb + (d * 4 + q) * 2048) = c; }
            }
        }
        float ssq[16]; f32x16 c0v[4];
        const float* scb0 = scr + tid * 4; asm volatile("" : "+v"(scb0));
#pragma unroll
        for (int d = 0; d < 4; ++d)
#pragma unroll
            for (int q = 0; q < 4; ++q) { const f32x4 c = *(const f32x4*)(scb0 + (d * 4 + q) * 2048);
#pragma unroll
                for (int k = 0; k < 4; ++k) c0v[d][4 * q + k] = c[k]; }
#pragma unroll
        for (int r = 0; r < 16; ++r) { float s = 0.f;
#pragma unroll
            for (int d = 0; d < 4; ++d) { const float c0 = c0v[d][r]; s += c0 * c0 + o[d][r] * o[d][r]; }
#pragma unroll
            for (int of = 16; of > 0; of >>= 1) s += __shfl_xor(s, of);
            ssq[r] = rsqrtf(s * (1.0f / 256.0f) + EPS_) * (1.0f - lambda_init); }
#pragma unroll
        for (int r = 0; r < 16; ++r) {
            const size_t row = tok0 + wid * 32 + att::crow(r, hi);
            bf16_t* op = oa + row * D_ + h * 256;
#pragma unroll
            for (int d = 0; d < 4; ++d) {
                const int col = d * 32 + r32;
                op[col] = f2bf(c0v[d][r] * ssq[r] * sub[col]);
                op[128 + col] = f2bf(o[d][r] * ssq[r] * sub[128 + col]);
            }
        }
    }
}

template <bool FINAL>
__device__ __forceinline__ void s5_phase(const Params& p, unsigned char* shm) {
    const int tid = otid(), wid = tid >> 6, lane = tid & 63, r32 = lane & 31, hi = lane >> 5, fr = lane & 15, fq = lane >> 4;
    const bf16_t* xb = (const bf16_t*)(p.ws + OFF_XB);
    const float* ss = (const float*)(p.ws + OFF_SSP) + (size_t)2 * 32 * T_;
    float* rsfin = (float*)(p.ws + OFF_RSFIN);
    const bf16_t* Bm = (const bf16_t*)(p.ws + OFF_S5B); const bf16_t* Cm = (const bf16_t*)(p.ws + OFF_S5C); const f32x2* AB = (const f32x2*)(p.ws + OFF_S5AB);
    f32x2* E = (f32x2*)(p.ws + OFF_BIG);
    bf16_t* gl = (bf16_t*)(p.ws + OFF_OA);
    bf16_t* Xs = (bf16_t*)shm + wid * (32 * 136);
    const float* gmix = (const float*)(p.ws + OFF_PAR) + PAR_GMIX; const float* dsk = (const float*)(p.ws + OFF_PAR) + PAR_BD;
    float* partL = (float*)(shm + 8 * 8704); float* rsL = partL + 512;
#pragma unroll 1
    for (int bc = obid(); bc < 256; bc += gridDim.x) {
      const int chunk = bc & 63, b = bc >> 6;
      const size_t t0 = (size_t)b * S_ + chunk * 64;
      __syncthreads();
      if (FINAL) { if (tid < 64) rsL[tid] = rsfin[t0 + tid]; }
      else {
          { const int row = tid & 63, part = tid >> 6; float a = 0.f;
#pragma unroll
            for (int k = 0; k < 4; ++k) a += ss[(size_t)(part * 4 + k) * T_ + t0 + row];
            partL[part * 64 + row] = a; }
          __syncthreads();
          if (tid < 64) { float tot = 0.f;
#pragma unroll
              for (int k = 0; k < 8; ++k) tot += partL[k * 64 + tid];
              const float r = rsqrtf(tot * (1.0f / D_) + EPS_); rsL[tid] = r; rsfin[t0 + tid] = r; }
      }
      __syncthreads();
#pragma unroll 1
      for (int goct = 0; goct < 16; ++goct) {
        const int g = goct * 8 + wid; const int pp = r32 + 32 * hi;
        const f32x2 ab = AB[g * 64 + pp];
        bf16x8 bfr[4];
#pragma unroll
        for (int nb = 0; nb < 4; ++nb) bfr[nb] = *(const bf16x8*)(Bm + ((size_t)g * 128 + nb * 32 + r32) * 16 + hi * 8);
        float xr = 0.f, xi = 0.f;
        bf16x8 cfr[4]; float gm4[4], ds4[4];
        if (FINAL) {
            { const f32x2 cin = E[((size_t)(b * 128 + g) * 64 + chunk) * 64 + pp]; xr = cin.x; xi = cin.y; }
#pragma unroll
            for (int ks = 0; ks < 4; ++ks) cfr[ks] = *(const bf16x8*)(Cm + ((size_t)g * 16 + fr) * 128 + ks * 32 + fq * 8);
#pragma unroll
            for (int jx = 0; jx < 4; ++jx) { gm4[jx] = gmix[g * 16 + 4 * fq + jx]; ds4[jx] = dsk[g * 16 + 4 * fq + jx]; }
        }
#pragma unroll
        for (int half = 0; half < 2; ++half) {
            const size_t trow = t0 + half * 32 + r32;
            const float rs = rsL[half * 32 + r32];
            const u32x4 raw = *(const u32x4*)(xb + trow * D_ + g * 16 + hi * 8);
            u32x4 sc4;
            sc4.x = cvt_pk_bf16(bflo(raw.x) * rs, bfhi(raw.x) * rs); sc4.y = cvt_pk_bf16(bflo(raw.y) * rs, bfhi(raw.y) * rs);
            sc4.z = cvt_pk_bf16(bflo(raw.z) * rs, bfhi(raw.z) * rs); sc4.w = cvt_pk_bf16(bflo(raw.w) * rs, bfhi(raw.w) * rs);
            const bf16x8 afr = *reinterpret_cast<const bf16x8*>(&sc4);
            f32x16 c0 = __builtin_amdgcn_mfma_f32_32x32x16_bf16(afr, bfr[0], f32x16{}, 0, 0, 0);
            f32x16 c1 = __builtin_amdgcn_mfma_f32_32x32x16_bf16(afr, bfr[1], f32x16{}, 0, 0, 0);
            f32x16 c2 = __builtin_amdgcn_mfma_f32_32x32x16_bf16(afr, bfr[2], f32x16{}, 0, 0, 0);
            f32x16 c3 = __builtin_amdgcn_mfma_f32_32x32x16_bf16(afr, bfr[3], f32x16{}, 0, 0, 0);
#pragma unroll
            for (int i = 0; i < 16; ++i) {
                auto r0 = __builtin_amdgcn_permlane32_swap(__float_as_uint(c0[i]), __float_as_uint(c1[i]), false, false);
                c0[i] = __uint_as_float(r0[0]); c1[i] = __uint_as_float(r0[1]);
                auto r1 = __builtin_amdgcn_permlane32_swap(__float_as_uint(c2[i]), __float_as_uint(c3[i]), false, false);
                c2[i] = __uint_as_float(r1[0]); c3[i] = __uint_as_float(r1[1]);
            }
#pragma unroll
            for (int t = 0; t < 32; ++t) {
                const int q = t >> 3, s = t & 7, idx = 4 * q + (s & 3);
                const float bur = (s < 4) ? c0[idx] : c1[idx], bui = (s < 4) ? c2[idx] : c3[idx];
                const float nr = ab.x * xr - ab.y * xi + bur, ni = ab.x * xi + ab.y * xr + bui;
                xr = nr; xi = ni;
                if (FINAL) { Xs[t * 136 + pp] = f2bf(xr); Xs[t * 136 + 64 + pp] = f2bf(xi); }
            }
            if (FINAL) {
                asm volatile("s_waitcnt lgkmcnt(0)" ::: "memory");
#pragma unroll
                for (int m = 0; m < 2; ++m) {
                    f32x4 acc = {0.f, 0.f, 0.f, 0.f};
#pragma unroll
                    for (int ks = 0; ks < 4; ++ks) {
                        const bf16x8 xf = *(const bf16x8*)(Xs + (m * 16 + fr) * 136 + ks * 32 + fq * 8);
                        acc = __builtin_amdgcn_mfma_f32_16x16x32_bf16(cfr[ks], xf, acc, 0, 0, 0);
                    }
                    const size_t tr2 = t0 + half * 32 + m * 16 + fr;
                    const float rs2 = rsL[half * 32 + m * 16 + fr];
                    const u32x2 hx = *(const u32x2*)(xb + tr2 * D_ + g * 16 + 4 * fq);
                    const float h0 = bflo(hx.x) * rs2 * gm4[0], h1 = bfhi(hx.x) * rs2 * gm4[1], h2 = bflo(hx.y) * rs2 * gm4[2], h3 = bfhi(hx.y) * rs2 * gm4[3];
                    const float y0 = gelu_tanh(acc[0] + ds4[0] * h0), y1 = gelu_tanh(acc[1] + ds4[1] * h1), y2 = gelu_tanh(acc[2] + ds4[2] * h2), y3 = gelu_tanh(acc[3] + ds4[3] * h3);
                    u32x2 w; w.x = cvt_pk_bf16(y0, y1); w.y = cvt_pk_bf16(y2, y3);
                    *(u32x2*)(gl + tr2 * D_ + g * 16 + 4 * fq) = w;
                }
                asm volatile("s_waitcnt lgkmcnt(0)" ::: "memory");
            }
        }
        if (!FINAL) { f32x2 e; e.x = xr; e.y = xi; E[((size_t)(b * 128 + g) * 64 + chunk) * 64 + pp] = e; }
      }
    }
}

__device__ __forceinline__ void s5_scan_phase(const Params& p) {
    const int tid = otid(), bid = obid();
    if (tid >= 128) return;
    f32x2* E = (f32x2*)(p.ws + OFF_BIG); const f32x2* AB = (const f32x2*)(p.ws + OFF_S5AB);
    for (int seq = bid * 128 + tid; seq < 4 * 128 * 64; seq += gridDim.x * 128) {
        const int pp = seq & 63, bg = seq >> 6, g = bg & 127;
        const f32x2 ab = AB[g * 64 + pp];
        float pr = ab.x, pi_ = ab.y;
#pragma unroll
        for (int k = 0; k < 6; ++k) { const float nr = pr * pr - pi_ * pi_, ni = 2.f * pr * pi_; pr = nr; pi_ = ni; }
        f32x2* Ep = E + (size_t)bg * 64 * 64 + pp;
        float xr = 0.f, xi = 0.f;
#pragma unroll 1
        for (int c0 = 0; c0 < 64; c0 += 16) {
            f32x2 e[16];
#pragma unroll
            for (int k = 0; k < 16; ++k) e[k] = Ep[(size_t)(c0 + k) * 64];
#pragma unroll
            for (int k = 0; k < 16; ++k) { f32x2 x; x.x = xr; x.y = xi; Ep[(size_t)(c0 + k) * 64] = x;
                const float nr = pr * xr - pi_ * xi + e[k].x, ni = pr * xi + pi_ * xr + e[k].y; xr = nr; xi = ni; }
        }
    }
}

__device__ __forceinline__ void ret_phase(const Params& p, unsigned char* shm, float* rssq) {
    const int tid = otid(), wid = tid >> 6, lane = tid & 63, fr = lane & 15, fq = lane >> 4;
    const bf16_t* ret = (const bf16_t*)(p.ws + OFF_BIG);
    bf16_t* ao = (bf16_t*)(p.ws + OFF_OA);
    constexpr int QS = 264, TS = 72;
    bf16_t* Qs = (bf16_t*)shm; bf16_t* Ks = Qs + 64 * QS; bf16_t* KTs = Ks + 64 * QS; bf16_t* VTs = KTs + 256 * TS; bf16_t* Ss = VTs + 64 * TS; bf16_t* RTs = Ss + 64 * TS;
    const int c = obid(); const int xcd = c & 7, jj = c >> 3;
    const int bh = xcd * 4 + (jj >> 3), sl = jj & 7;
    const int b = bh >> 3, h = bh & 7;
    const float lg = logf(1.0f - exp2f(-5.0f - (float)h));
    const float cdec = __expf(lg * 64.0f);
    const int mi = wid >> 1, ni0 = 2 * (wid & 1);
    const float qdec = __expf(lg * (float)(16 * mi + fr + 1));
    float idec[2][4];
#pragma unroll
    for (int t = 0; t < 2; ++t)
#pragma unroll
        for (int j = 0; j < 4; ++j) { const int n = 16 * mi + fr, m = 16 * (ni0 + t) + 4 * fq + j; idec[t][j] = __expf(lg * (fabsf((float)(n - m)) - (float)(63 - m))); }
    f32x4 R[4][2];
#pragma unroll
    for (int a = 0; a < 4; ++a)
#pragma unroll
        for (int d = 0; d < 2; ++d) R[a][d] = (f32x4){0.f, 0.f, 0.f, 0.f};
    const size_t tokb = (size_t)b * S_;
    const bf16_t* qsrc = ret + (tokb + (tid >> 5)) * 12288 + h * 256 + (tid & 31) * 8;
    const bf16_t* ksrc = ret + (tokb + lane) * 12288 + 2048 + h * 256 + wid * 32;
    const bf16_t* vsrc = ret + (tokb + lane) * 12288 + 4096 + h * 512 + sl * 64 + wid * 8;
    u32x4 pq[4], pk[4], pv; u32x2 pg[2], cg2[2];
    const bf16_t* gsrc = ret + (tokb + 16 * mi + fr) * 12288 + 8192 + h * 512 + sl * 64 + 16 * ni0 + 4 * fq;
#pragma unroll
    for (int j = 0; j < 4; ++j) { pq[j] = *(const u32x4*)(qsrc + (size_t)j * 16 * 12288); pk[j] = *(const u32x4*)(ksrc + j * 8); }
    pv = *(const u32x4*)vsrc;
    pg[0] = *(const u32x2*)gsrc; pg[1] = *(const u32x2*)(gsrc + 16);
    for (int ch = 0; ch < 64; ++ch) {
        __syncthreads();
        cg2[0] = pg[0]; cg2[1] = pg[1];
#pragma unroll
        for (int j = 0; j < 4; ++j) {
            *(u32x4*)(Qs + (j * 16 + (tid >> 5)) * QS + (tid & 31) * 8) = pq[j];
            *(u32x4*)(Ks + lane * QS + wid * 32 + j * 8) = pk[j];
            const unsigned kw[4] = {pk[j].x, pk[j].y, pk[j].z, pk[j].w};
#pragma unroll
            for (int i = 0; i < 4; ++i) {
                KTs[(wid * 32 + j * 8 + 2 * i) * TS + lane] = (bf16_t)(kw[i] & 0xffffu);
                KTs[(wid * 32 + j * 8 + 2 * i + 1) * TS + lane] = (bf16_t)(kw[i] >> 16);
            }
        }
        { const unsigned vw[4] = {pv.x, pv.y, pv.z, pv.w};
#pragma unroll
          for (int i = 0; i < 4; ++i) { VTs[(wid * 8 + 2 * i) * TS + lane] = (bf16_t)(vw[i] & 0xffffu); VTs[(wid * 8 + 2 * i + 1) * TS + lane] = (bf16_t)(vw[i] >> 16); } }
#pragma unroll
        for (int ei = 0; ei < 4; ++ei)
#pragma unroll
            for (int di = 0; di < 2; ++di) { u32x2 w; w.x = cvt_pk_bf16(R[ei][di][0], R[ei][di][1]); w.y = cvt_pk_bf16(R[ei][di][2], R[ei][di][3]);
                *(u32x2*)(RTs + (16 * ei + fr) * QS + wid * 32 + 16 * di + 4 * fq) = w; }
        if (ch + 1 < 64) {
            const size_t adv = (size_t)(ch + 1) * 64 * 12288;
#pragma unroll
            for (int j = 0; j < 4; ++j) { pq[j] = *(const u32x4*)(qsrc + adv + (size_t)j * 16 * 12288); pk[j] = *(const u32x4*)(ksrc + adv + j * 8); }
            pv = *(const u32x4*)(vsrc + adv);
            pg[0] = *(const u32x2*)(gsrc + adv); pg[1] = *(const u32x2*)(gsrc + adv + 16);
        }
        __syncthreads();
        bf16x8 qa[8];
        {
            f32x4 sacc[2] = {{0.f, 0.f, 0.f, 0.f}, {0.f, 0.f, 0.f, 0.f}};
#pragma unroll
            for (int ks = 0; ks < 8; ++ks) qa[ks] = *(const bf16x8*)(Qs + (16 * mi + fr) * QS + ks * 32 + fq * 8);
#pragma unroll
            for (int ks = 0; ks < 8; ++ks) {
#pragma unroll
                for (int t = 0; t < 2; ++t) { const bf16x8 bf = *(const bf16x8*)(Ks + (16 * (ni0 + t) + fr) * QS + ks * 32 + fq * 8);
                    sacc[t] = __builtin_amdgcn_mfma_f32_16x16x32_bf16(bf, qa[ks], sacc[t], 0, 0, 0); }
            }
#pragma unroll
            for (int t = 0; t < 2; ++t) { u32x2 w; w.x = cvt_pk_bf16(sacc[t][0] * idec[t][0], sacc[t][1] * idec[t][1]); w.y = cvt_pk_bf16(sacc[t][2] * idec[t][2], sacc[t][3] * idec[t][3]);
                *(u32x2*)(Ss + (16 * mi + fr) * TS + 16 * (ni0 + t) + 4 * fq) = w; }
        }
        __syncthreads();
        {
            f32x4 oi[2] = {{0.f, 0.f, 0.f, 0.f}, {0.f, 0.f, 0.f, 0.f}}, oc[2] = {{0.f, 0.f, 0.f, 0.f}, {0.f, 0.f, 0.f, 0.f}};
#pragma unroll
            for (int ks = 0; ks < 2; ++ks) {
                const bf16x8 af = *(const bf16x8*)(Ss + (16 * mi + fr) * TS + ks * 32 + fq * 8);
#pragma unroll
                for (int t = 0; t < 2; ++t) { const bf16x8 bf = *(const bf16x8*)(VTs + (16 * (ni0 + t) + fr) * TS + ks * 32 + fq * 8);
                    oi[t] = __builtin_amdgcn_mfma_f32_16x16x32_bf16(bf, af, oi[t], 0, 0, 0); }
            }
#pragma unroll
            for (int ks = 0; ks < 8; ++ks) {
#pragma unroll
                for (int t = 0; t < 2; ++t) { const bf16x8 bf = *(const bf16x8*)(RTs + (16 * (ni0 + t) + fr) * QS + ks * 32 + fq * 8);
                    oc[t] = __builtin_amdgcn_mfma_f32_16x16x32_bf16(bf, qa[ks], oc[t], 0, 0, 0); }
            }
            const size_t tok = tokb + (size_t)ch * 64 + 16 * mi + fr;
            float sq = 0.f;
#pragma unroll
            for (int t = 0; t < 2; ++t) {
                const int e = sl * 64 + 16 * (ni0 + t) + 4 * fq;
                const u32x2 gw = cg2[t];
                f32x4 ov = oi[t] + oc[t] * qdec;
                sq += ov[0] * ov[0] + ov[1] * ov[1] + ov[2] * ov[2] + ov[3] * ov[3];
                u32x2 w; w.x = cvt_pk_bf16(ov[0] * bflo(gw.x), ov[1] * bfhi(gw.x)); w.y = cvt_pk_bf16(ov[2] * bflo(gw.y), ov[3] * bfhi(gw.y));
                *(u32x2*)(ao + tok * 4096 + h * 512 + e) = w;
            }
            sq += __shfl_xor(sq, 16); sq += __shfl_xor(sq, 32);
            if (fq == 0) atomicAdd(rssq + (size_t)(sl * 4 + mi) * 0 + (size_t)sl * (T_ * 8) + tok * 8 + h, sq);
        }
#pragma unroll
        for (int ei = 0; ei < 4; ++ei)
#pragma unroll
            for (int di = 0; di < 2; ++di) R[ei][di] *= cdec;
#pragma unroll
        for (int ks = 0; ks < 2; ++ks) {
            bf16x8 bfk[2];
#pragma unroll
            for (int di = 0; di < 2; ++di) bfk[di] = *(const bf16x8*)(KTs + (wid * 32 + 16 * di + fr) * TS + ks * 32 + fq * 8);
#pragma unroll
            for (int ei = 0; ei < 4; ++ei) { const bf16x8 af = *(const bf16x8*)(VTs + (16 * ei + fr) * TS + ks * 32 + fq * 8);
#pragma unroll
                for (int di = 0; di < 2; ++di) R[ei][di] = __builtin_amdgcn_mfma_f32_16x16x32_bf16(bfk[di], af, R[ei][di], 0, 0, 0); }
        }
    }
}

__device__ __forceinline__ void ret2_phase(const Params& p) {
    bf16_t* ao = (bf16_t*)(p.ws + OFF_OA); const float* rssq = (const float*)(p.ws + OFF_RSQP);
    const size_t nvec = (size_t)T_ * 4096 / 8, stride = (size_t)gridDim.x * 512;
    for (size_t i0 = (size_t)obid() * 512 + otid(); i0 < nvec; i0 += 4 * stride) {
        u32x4 w[4]; float rsum[4];
#pragma unroll
        for (int u = 0; u < 4; ++u) { const size_t i = i0 + u * stride; w[u] = *(u32x4*)(ao + i * 8);
            const size_t t = i >> 9; const int hh = (int)((i & 511) >> 6); float a = 0.f;
#pragma unroll
            for (int sl = 0; sl < 8; ++sl) a += rssq[(size_t)sl * (T_ * 8) + t * 8 + hh];
            rsum[u] = a; }
#pragma unroll
        for (int u = 0; u < 4; ++u) { const size_t i = i0 + u * stride; const float rs = rsqrtf(rsum[u] * (1.0f / 512.0f) + EPS_);
            u32x4 x = w[u];
            x.x = cvt_pk_bf16(bflo(x.x) * rs, bfhi(x.x) * rs); x.y = cvt_pk_bf16(bflo(x.y) * rs, bfhi(x.y) * rs);
            x.z = cvt_pk_bf16(bflo(x.z) * rs, bfhi(x.z) * rs); x.w = cvt_pk_bf16(bflo(x.w) * rs, bfhi(x.w) * rs);
            *(u32x4*)(ao + i * 8) = x; }
    }
}

__device__ __forceinline__ void final_phase(const Params& p) {
    const float* ss = (const float*)(p.ws + OFF_SSP) + (size_t)8 * 32 * T_;
    const int tid = otid();
    const f32x4 g = *(const f32x4*)((const float*)(p.ws + OFF_PAR) + PAR_NFINAL + tid * 4);
    const int G = gridDim.x;
    for (int row0 = obid(); row0 < T_; row0 += 4 * G) {
        f32x4 v[4]; float sm[4];
#pragma unroll
        for (int u = 0; u < 4; ++u) { const int row = row0 + u * G; sm[u] = ss[(size_t)(tid & 31) * T_ + row]; v[u] = *(f32x4*)(p.out + (size_t)row * D_ + tid * 4); }
#pragma unroll
        for (int u = 0; u < 4; ++u) { const int row = row0 + u * G; float ssum = sm[u];
#pragma unroll
            for (int o = 16; o > 0; o >>= 1) ssum += __shfl_xor(ssum, o);
            const float rs = rsqrtf(ssum * (1.0f / D_) + EPS_);
            *(f32x4*)(p.out + (size_t)row * D_ + tid * 4) = v[u] * rs * g; }
    }
}

enum { OP_PREP = 0, OP_A_IN, OP_ATTN, OP_A_OUT, OP_S5A, OP_S5C, OP_GLU, OP_C_IN, OP_RET, OP_RET2, OP_C_OUT, OP_W1, OP_W2, OP_FINAL, OP_S5B };
#ifndef PHMASK
#define PHMASK 0xffff
#endif
#define PHON(b) ((PHMASK >> (b)) & 1)
constexpr int NPH = 24;
__device__ const unsigned char PROG_OP[NPH] = { OP_PREP,
    OP_A_IN, OP_ATTN, OP_A_OUT, OP_W1, OP_W2,
    OP_S5A, OP_S5B, OP_S5C, OP_GLU, OP_W1, OP_W2,
    OP_C_IN, OP_RET, OP_RET2, OP_C_OUT, OP_W1, OP_W2,
    OP_A_IN, OP_ATTN, OP_A_OUT, OP_W1, OP_W2,
    OP_FINAL };
__device__ const unsigned char PROG_LAYER[NPH] = { 0, 0, 0, 0, 0, 0, 1, 1, 1, 1, 1, 1, 2, 2, 2, 2, 2, 2, 3, 3, 3, 3, 3, 3 };

struct GemmDesc { unsigned long long a_off, b_off; int N, K, ss_idx, mode; };
#define GD_NONE {0, 0, 0, 0, 0, 0}
#define GD_A_IN(L)  {OFF_XB, OFF_WT_A_IN + (L / 3) * SZ_A_IN, 6144, 2048, 2 * L, 0}
#define GD_A_OUT(L) {OFF_OA, OFF_WT_A_OUT + (L / 3) * SZ_A_OUT, 2048, 2048, 2 * L + 1, 0}
#define GD_W1(L)    {OFF_XB, OFF_WT_W1 + L * SZ_W1, 8192, 2048, 2 * L + 1, 1}
#define GD_W2(L)    {OFF_BIG, OFF_WT_W2 + L * SZ_W1, 2048, 8192, 2 * L + 2, 0}
#define GD_GLU(L)   {OFF_OA, OFF_WT_GLU, 4096, 2048, 2 * L + 1, 1}
#define GD_C_IN(L)  {OFF_XB, OFF_WT_C_IN, 12288, 2048, 2 * L, 2}
#define GD_C_OUT(L) {OFF_OA, OFF_WT_C_OUT, 2048, 4096, 2 * L + 1, 0}
__device__ const GemmDesc GD[NPH] = { GD_NONE,
    GD_A_IN(0ull), GD_NONE, GD_A_OUT(0ull), GD_W1(0ull), GD_W2(0ull),
    GD_NONE, GD_NONE, GD_NONE, GD_GLU(1ull), GD_W1(1ull), GD_W2(1ull),
    GD_C_IN(2ull), GD_NONE, GD_NONE, GD_C_OUT(2ull), GD_W1(2ull), GD_W2(2ull),
    GD_A_IN(3ull), GD_NONE, GD_A_OUT(3ull), GD_W1(3ull), GD_W2(3ull),
    GD_NONE };

#define XB_TMO      128
#define XB_XCNT(j)  (256  + 64 * (j))
#define XB_XSUB(j)  (1280 + 64 * (j))
#define XB_XGEN(j)  (2304 + 64 * (j))
#define XB_TOP      3328
#define XB_TOPGEN   3392
#define XCD_BAR_WORDS 3456
#define XB_SPIN_CAP (1u << 22)
__device__ __forceinline__ unsigned xb_ld(unsigned* p)              { return __hip_atomic_load(p, __ATOMIC_RELAXED, __HIP_MEMORY_SCOPE_AGENT); }
__device__ __forceinline__ unsigned xb_add(unsigned* p, unsigned v) { return __hip_atomic_fetch_add(p, v, __ATOMIC_RELAXED, __HIP_MEMORY_SCOPE_AGENT); }
__device__ __forceinline__ unsigned xb_xcc_id() { return (unsigned)__builtin_amdgcn_s_getreg((3 << 11) | 20) & 0xFu; }
#define XB_SPIN(cond, bar) do { unsigned _sp = 0; while (cond) { __builtin_amdgcn_s_sleep(1); \
    if ((++_sp & 255u) == 0u) { if (xb_ld(&(bar)[XB_TMO])) break; if (_sp > XB_SPIN_CAP) { atomicAdd(&(bar)[XB_TMO], 1u); break; } } } } while (0)
struct XcdBarrier { unsigned* bar; unsigned x; volatile LAS unsigned* st; };
__device__ __forceinline__ XcdBarrier xcd_barrier_post(unsigned* bar, volatile LAS unsigned* st) {
    XcdBarrier b; b.bar = bar; b.x = xb_xcc_id(); b.st = st;
    if (threadIdx.x == 0) (void)xb_add(&bar[XB_XCNT(b.x)], 1u);
    return b;
}
__device__ __forceinline__ void xcd_barrier_complete(unsigned* bar, unsigned x, unsigned& nloc, unsigned& nx) {
    const unsigned G = gridDim.x * gridDim.y * gridDim.z;
    unsigned sum, cnt, mine, sp = 0u;
    for (;;) {
        sum = 0u; cnt = 0u; mine = 0u;
#pragma unroll
        for (unsigned j = 0; j < 16; ++j) { const unsigned c = xb_ld(&bar[XB_XCNT(j)]); sum += c; cnt += (c > 0u) ? 1u : 0u; mine = (j == x) ? c : mine; }
        if (sum == G) break;
        __builtin_amdgcn_s_sleep(1);
        if ((++sp & 255u) == 0u) { if (xb_ld(&bar[XB_TMO])) break; if (sp > XB_SPIN_CAP) { atomicAdd(&bar[XB_TMO], 1u); break; } }
    }
    nloc = mine > 0u ? mine : 1u; nx = cnt > 0u ? cnt : 1u;
}
__device__ __forceinline__ void xcd_barrier(unsigned char* ws, unsigned char* shm) {
    XcdBarrier b; b.bar = (unsigned*)(ws + OFF_BAR); b.x = xb_xcc_id(); b.st = (volatile LAS unsigned*)((LAS unsigned char*)shm + LDS_PHASE_BYTES);
    asm volatile("s_waitcnt vmcnt(0) lgkmcnt(0)" ::: "memory");
    __syncthreads();
    if (threadIdx.x == 0) {
        unsigned* bar = b.bar;
        __builtin_amdgcn_s_waitcnt(0);
        unsigned nloc = b.st[0], nx = b.st[1];
        if (nloc == 0u) { xcd_barrier_complete(bar, b.x, nloc, nx); b.st[0] = nloc; b.st[1] = nx; }
        const unsigned old = xb_add(&bar[XB_XSUB(b.x)], 1u);
        const unsigned gen = old / nloc;
        if (old + 1u == (gen + 1u) * nloc) {
            __builtin_amdgcn_fence(__ATOMIC_RELEASE, "agent");
            asm volatile("s_waitcnt vmcnt(0)" ::: "memory");
            const unsigned og = xb_add(&bar[XB_TOP], 1u);
            const unsigned tg = og / nx;
            if (og + 1u == (tg + 1u) * nx) xb_add(&bar[XB_TOPGEN], 1u);
            else XB_SPIN(xb_ld(&bar[XB_TOPGEN]) == tg, bar);
            __builtin_amdgcn_fence(__ATOMIC_ACQUIRE, "agent");
            xb_add(&bar[XB_XGEN(b.x)], 1u);
            asm volatile("s_waitcnt vmcnt(0)" ::: "memory");
        } else {
            XB_SPIN(xb_ld(&bar[XB_XGEN(b.x)]) == gen, bar);
            __builtin_amdgcn_fence(__ATOMIC_ACQUIRE, "agent");
            asm volatile("s_waitcnt vmcnt(0)" ::: "memory");
        }
    }
    __syncthreads();
}
__device__ __forceinline__ void gsync_cg(cg::grid_group& grid) {
    asm volatile("s_waitcnt vmcnt(0) lgkmcnt(0)" ::: "memory");
    grid.sync();
    __builtin_amdgcn_fence(__ATOMIC_ACQUIRE, "agent");
    asm volatile("s_waitcnt vmcnt(0) lgkmcnt(0)" ::: "memory");
}

__global__ void __launch_bounds__(512, 2) fwd_megakernel(Params p, int ph_lo, int ph_hi) {
    extern __shared__ __attribute__((aligned(16))) unsigned char shm[];
    cg::grid_group grid = cg::this_grid();
    volatile LAS unsigned* xst = (volatile LAS unsigned*)((LAS unsigned char*)shm + LDS_PHASE_BYTES);
    if (threadIdx.x == 0) { xst[0] = 0u; xst[1] = 0u; }
    __syncthreads();
    (void)xcd_barrier_post((unsigned*)(p.ws + OFF_BAR), xst);
#ifndef DUPMASK
#define DUPMASK 0
#endif
    if (PHON(0) && ph_lo == 0) {
#pragma unroll 1
        for (int rp_ = 0; rp_ < ((DUPMASK & 1) ? 2 : 1); ++rp_) { prep_phase(p, shm); if (ph_hi > 1) gsync_cg(grid); } }
    for (int ph = (ph_lo < 1 ? 1 : ph_lo); ph < ph_hi; ++ph) {
        const int op = PROG_OP[ph], L = PROG_LAYER[ph];
        const int nrep_ = ((DUPMASK >> op) & 1) ? 2 : 1;
#pragma unroll 1
        for (int rp_ = 0; rp_ < nrep_; ++rp_) {
        unsigned char* ws = p.ws; asm volatile("" : "+s"(ws));
        float* ssb = (float*)(ws + OFF_SSP);
        if (PHON(1) && (op == OP_A_IN || op == OP_C_IN || op == OP_W1)) {
            const GemmDesc gd = GD[ph];
            pg8::Gemm g; g.A = (const bf16_t*)(ws + gd.a_off); g.Bt = (const bf16_t*)(ws + gd.b_off); g.M = T_; g.N = gd.N; g.K = gd.K;
            pg8::EpiBf E; E.rot = (const f32x2*)(ws + OFF_ROT); E.O = (bf16_t*)(ws + OFF_BIG); E.ldc = gd.N; E.mode = gd.mode; E.ss = ssb + (size_t)gd.ss_idx * 32 * T_;
            pg8::StaticOrder S; S.init(g.M, g.N, (int)gridDim.x, obid());
            {
                float* lrs = (float*)(shm + pg8::STAGE_BYTES); const int tid2 = otid();
                int nun = 0; { pg8::Unit uu; while (nun < 24 && S.next(nun, uu)) ++nun; }
                for (int j = tid2; j < nun * 256; j += 512) { pg8::Unit uu; S.next(j >> 8, uu);
                    const float* sp = E.ss + (size_t)uu.pm * 256 + (j & 255); float sv[32];
#pragma unroll
                    for (int sl = 0; sl < 32; ++sl) sv[sl] = sp[(size_t)sl * T_];
                    float a = 0.f;
#pragma unroll
                    for (int sl = 0; sl < 32; ++sl) a += sv[sl];
                    lrs[j] = rsqrtf(a * (1.0f / D_) + EPS_); }
                __syncthreads();
            }
            pg8::gemm_phase<pg8::EpiBf, pg8::StaticOrder>((LAS unsigned char*)shm, g, S, E);
        } else if (PHON(2) && (op == OP_A_OUT || op == OP_GLU || op == OP_C_OUT || op == OP_W2)) {
            const GemmDesc gd = GD[ph];
            pg8::Gemm g; g.A = (const bf16_t*)(ws + gd.a_off); g.Bt = (const bf16_t*)(ws + gd.b_off); g.M = T_; g.N = gd.N; g.K = gd.K;
            pg8::EpiRes E; E.xout = p.out; E.xb = (bf16_t*)(ws + OFF_XB); E.glu = gd.mode; E.xin = p.out; E.ssn = ssb + (size_t)gd.ss_idx * 32 * T_;
            pg8::StaticOrder S; S.init(g.M, g.N, (int)gridDim.x, obid());
            pg8::gemm_phase<pg8::EpiRes, pg8::StaticOrder>((LAS unsigned char*)shm, g, S, E);
        } else if (PHON(3) && op == OP_ATTN) {
            const float li = 0.8f - 0.6f * expf(-0.3f * (float)L);
            attn_phase(p, L / 3, li, shm);
        } else if (PHON(4) && op == OP_S5A) {
            s5_phase<false>(p, shm);
        } else if (PHON(4) && op == OP_S5B) {
            s5_scan_phase(p);
        } else if (PHON(5) && op == OP_S5C) {
            s5_phase<true>(p, shm);
        } else if (PHON(6) && op == OP_RET) {
            ret_phase(p, shm, (float*)(ws + (rp_ == 0 ? OFF_RSQP : OFF_XB)));
        } else if (PHON(7) && op == OP_RET2) {
            ret2_phase(p);
        } else if (PHON(8) && op == OP_FINAL) {
            final_phase(p);
        }
        if (ph + 1 < ph_hi || rp_ + 1 < nrep_) xcd_barrier(ws, shm);
        }
    }
}

extern "C" void kernel_launch(void* const* d_in, const int* in_sizes, int n_in, void* d_out, int out_size, void* d_ws, size_t ws_size, hipStream_t stream) {
    static int grid_blocks = 0;
    if (grid_blocks == 0) {
        if (n_in != 21 || out_size != T_ * D_ || ws_size < WS_NEED) { fprintf(stderr, "kernel_launch: unexpected shapes n_in %d out %d ws %zu (need %zu)\n", n_in, out_size, ws_size, (size_t)WS_NEED); grid_blocks = -1; return; }
        int dev = 0, cus = 0, per_cu = 0;
        hipGetDevice(&dev);
        hipDeviceGetAttribute(&cus, hipDeviceAttributeMultiprocessorCount, dev);
        if (hipFuncSetAttribute((const void*)fwd_megakernel, hipFuncAttributeMaxDynamicSharedMemorySize, LDS_BYTES) != hipSuccess) { fprintf(stderr, "kernel_launch: hipFuncSetAttribute failed\n"); grid_blocks = -1; return; }
        hipOccupancyMaxActiveBlocksPerMultiprocessor(&per_cu, (const void*)fwd_megakernel, 512, LDS_BYTES);
        (void)hipGetLastError();
        if (per_cu < 1) per_cu = 1;
        grid_blocks = cus * 1;
        if (grid_blocks != 256) fprintf(stderr, "kernel_launch: note: %d CUs (kernel tuned for 256)\n", cus);
    }
    if (grid_blocks < 0) return;
    (void)hipMemsetAsync((unsigned char*)d_ws + OFF_BAR, 0, XCD_BAR_WORDS * 4, stream);
    Params p{};
    const float** pp = (const float**)&p;
    for (int i = 0; i < 21; ++i) pp[i] = (const float*)d_in[i];
    p.out = (float*)d_out; p.ws = (unsigned char*)d_ws;
#ifndef DBG_LO
#define DBG_LO 0
#endif
#ifndef DBG_HI
#define DBG_HI NPH
#endif
    int lo = DBG_LO, hi = DBG_HI;
    void* args[] = {&p, &lo, &hi};
    hipError_t e = hipLaunchCooperativeKernel((const void*)fwd_megakernel, dim3(grid_blocks), dim3(512), args, LDS_BYTES, stream);
    if (e != hipSuccess) fprintf(stderr, "cooperative launch failed: %s (grid %d)\n", hipGetErrorString(e), grid_blocks);
}
```

```cpp
#include <hip/hip_runtime.h>
#include <hip/hip_cooperative_groups.h>
#include <cstdio>
#include <cstdint>
namespace cg = cooperative_groups;

#define LAS __attribute__((address_space(3)))
typedef unsigned short bf16_t;
typedef short bf16x8 __attribute__((ext_vector_type(8)));
typedef short s16x4 __attribute__((ext_vector_type(4)));
typedef float f32x4 __attribute__((ext_vector_type(4)));
typedef float f32x2 __attribute__((ext_vector_type(2)));
typedef float f32x16 __attribute__((ext_vector_type(16)));
typedef unsigned u32x4 __attribute__((ext_vector_type(4)));
typedef unsigned u32x2 __attribute__((ext_vector_type(2)));

constexpr int T_ = 16384, D_ = 2048, S_ = 4096;
constexpr float EPS_ = 1e-6f;
constexpr int LDS_PHASE_BYTES = 156672;
constexpr int LDS_BYTES = LDS_PHASE_BYTES + 16;

constexpr size_t SZ_A_IN = 6144ull * 2048 * 2, SZ_A_OUT = 2048ull * 2048 * 2, SZ_W1 = 8192ull * 2048 * 2;
constexpr size_t OFF_WT_A_IN = 0;
constexpr size_t OFF_WT_A_OUT = OFF_WT_A_IN + 2 * SZ_A_IN;
constexpr size_t OFF_WT_GLU = OFF_WT_A_OUT + 2 * SZ_A_OUT;
constexpr size_t OFF_WT_C_IN = OFF_WT_GLU + 4096ull * 2048 * 2;
constexpr size_t OFF_WT_C_OUT = OFF_WT_C_IN + 12288ull * 2048 * 2;
constexpr size_t OFF_WT_W1 = OFF_WT_C_OUT + 2048ull * 4096 * 2;
constexpr size_t OFF_WT_W2 = OFF_WT_W1 + 4 * SZ_W1;
constexpr size_t OFF_XB = OFF_WT_W2 + 4 * SZ_W1;
constexpr size_t OFF_BIG = OFF_XB + (size_t)T_ * D_ * 2;
constexpr size_t OFF_OA = OFF_BIG + (size_t)T_ * 12288 * 2;
constexpr size_t OFF_SS = OFF_OA + (size_t)T_ * 4096 * 2;
constexpr size_t OFF_RSSQ = OFF_SS + 9ull * T_ * 4;
constexpr size_t OFF_ROT = OFF_RSSQ + (size_t)T_ * 8 * 4;
constexpr size_t OFF_S5B = OFF_ROT + 4096ull * 128 * 8;
constexpr size_t OFF_S5C = OFF_S5B + 128ull * 128 * 16 * 2;
constexpr size_t OFF_S5AB = OFF_S5C + 128ull * 16 * 128 * 2;
constexpr size_t WS_END = OFF_S5AB + 128ull * 64 * 8;
constexpr size_t OFF_SSP = WS_END;
constexpr size_t OFF_RSQP = OFF_SSP + 9ull * 32 * T_ * 4;
constexpr size_t OFF_RSFIN = OFF_RSQP + 8ull * T_ * 8 * 4;
constexpr size_t OFF_BAR = OFF_RSFIN + (size_t)T_ * 4;
constexpr size_t OFF_PAR = OFF_BAR + 16384;
constexpr int PAR_GMIX = 0, PAR_NFINAL = 2048, PAR_LAM = 4096, PAR_SUBLN = 5120, PAR_BD = 5632, PAR_N = 7680;
constexpr size_t WS_NEED = OFF_PAR + PAR_N * 4;
constexpr size_t OFF_ATT_SCR = OFF_BIG + (size_t)T_ * 6144 * 2;

struct Params {
    const float* x; const float* norm_mix; const float* norm_mlp; const float* norm_final;
    const float* a_w_in; const float* a_lambda; const float* a_subln; const float* a_w_out;
    const float* b_a_re; const float* b_a_im; const float* b_log_dt; const float* b_b_re; const float* b_b_im;
    const float* b_c_re; const float* b_c_im; const float* b_d; const float* b_w_glu;
    const float* c_w_in; const float* c_w_out; const float* mlp_w1; const float* mlp_w2;
    float* out; unsigned char* ws;
};

__device__ __forceinline__ unsigned cvt_pk_bf16(float lo, float hi) { unsigned r; asm volatile("v_cvt_pk_bf16_f32 %0, %1, %2" : "=v"(r) : "v"(lo), "v"(hi)); return r; }
__device__ __forceinline__ float bf2f(unsigned short b) { return __uint_as_float(((unsigned)b) << 16); }
__device__ __forceinline__ float bflo(unsigned w) { return __uint_as_float(w << 16); }
__device__ __forceinline__ float bfhi(unsigned w) { return __uint_as_float(w & 0xffff0000u); }
__device__ __forceinline__ unsigned short f2bf(float f) { return (unsigned short)(cvt_pk_bf16(f, 0.f) & 0xffffu); }

__device__ __forceinline__ int otid() { int t = threadIdx.x; asm volatile("" : "+v"(t)); return t; }
__device__ __forceinline__ int obid() { int t = blockIdx.x; asm volatile("" : "+s"(t)); return t; }

namespace pg8 {
constexpr int BM = 256, BK = 64, HALF = 128, HTB = HALF * BK * 2, STAGE_BYTES = 8 * HTB, NXCD = 8, WGM = 8;
__device__ __forceinline__ int lds_byte(int r, int c) { const int st = (r >> 4) * 2 + (c >> 5), rr = r & 15, cc = c & 31, ob = rr * 64 + cc * 2; return st * 1024 + (ob ^ (((ob >> 9) & 1) << 5)); }
__device__ __forceinline__ void stage_rc(int b, int& R, int& C) { const int st = b / 1024, sb = b % 1024, swz = sb ^ (((sb >> 9) & 1) << 5); R = (st >> 1) * 16 + swz / 64; C = (st & 1) * 32 + (swz % 64) / 2; }
struct Unit { int pm, pn; };
struct Gemm { const bf16_t* A; const bf16_t* Bt; int M, N, K; };
struct StaticOrder {
    int nM, nN, nwg, G, c;
    __device__ void init(int M, int N, int G_, int c_) { nM = M / BM; nN = N / BM; nwg = nM * nN; G = G_; c = c_; }
    __device__ bool next(int i, Unit& u) const {
        const long L = (long)i * G + c; if (L >= nwg) return false;
        int wgid = (int)L; { const int q = nwg / NXCD, r = nwg % NXCD, xcd = wgid % NXCD, off = wgid / NXCD; wgid = (xcd < r ? xcd * (q + 1) : r * (q + 1) + (xcd - r) * q) + off; }
        const int nig = WGM * nN, gid = wgid / nig, fm = gid * WGM, gsz = (nM - fm) < WGM ? (nM - fm) : WGM;
        u.pm = fm + ((wgid % nig) % gsz); u.pn = (wgid % nig) / gsz; return true;
    }
};

#define GAS __attribute__((address_space(1)))
struct EpiBf {
    bf16_t* O; int ldc; const float* ss; int mode; const f32x2* rot;
    __device__ __forceinline__ void operator()(const f32x4 (&acc)[2][2][4][2], const Unit& u, int wr, int wc, int fr, int fq, LAS unsigned char* lds, int ui) const {
        const int row0 = u.pm * BM + wr * 64 + fr, colt = u.pn * BM + wc * 32 + 8 * fq;
        int sub = 0;
        if (mode == 1) sub = 1;
        else if (mode == 2) { sub = u.pn < 8 ? 2 : (u.pn < 16 ? 3 : (u.pn < 32 ? 0 : 4)); }
        const LAS float* lrs = (const LAS float*)(lds + STAGE_BYTES) + ui * 256 + wr * 64 + fr;
        float rs8[8];
#pragma unroll
        for (int r = 0; r < 8; ++r) rs8[r] = lrs[(r >> 2) * HALF + (r & 3) * 16];
        GAS bf16_t* Og = (GAS bf16_t*)O;
        if (sub == 2 || sub == 3) {
            const GAS f32x2* rotg = (const GAS f32x2*)rot + wc * 32 + 8 * fq;
#pragma unroll
            for (int ai = 0; ai < 2; ++ai) {
                f32x2 cs[4][2][4];
#pragma unroll
                for (int m = 0; m < 4; ++m) { const int row = row0 + ai * HALF + m * 16; const GAS f32x2* rp = rotg + (size_t)(row & (S_ - 1)) * 128;
#pragma unroll
                    for (int n = 0; n < 2; ++n)
#pragma unroll
                        for (int j = 0; j < 4; ++j) cs[m][n][j] = rp[n * 4 + j]; }
#pragma unroll
                for (int m = 0; m < 4; ++m) { const int row = row0 + ai * HALF + m * 16;
                    float ksc = rs8[ai * 4 + m];
                    if (sub == 3) { const float lgam = logf(1.0f - exp2f(-5.0f - (float)(u.pn - 8))); ksc *= 0.0625f * __expf(lgam * (float)(63 - (row & 63))); }
                    GAS bf16_t* rowp = Og + (size_t)row * ldc + colt;
                    u32x4 w1, w2;
#pragma unroll
                    for (int n = 0; n < 2; ++n) {
                        const f32x4 t1 = acc[ai][0][m][n] * ksc, t2 = acc[ai][1][m][n] * ksc;
                        f32x4 o1, o2;
#pragma unroll
                        for (int j = 0; j < 4; ++j) { const f32x2 c2 = cs[m][n][j]; o1[j] = t1[j] * c2.x - t2[j] * c2.y; o2[j] = t1[j] * c2.y + t2[j] * c2.x; }
                        w1[2 * n] = cvt_pk_bf16(o1[0], o1[1]); w1[2 * n + 1] = cvt_pk_bf16(o1[2], o1[3]); w2[2 * n] = cvt_pk_bf16(o2[0], o2[1]); w2[2 * n + 1] = cvt_pk_bf16(o2[2], o2[3]);
                    }
                    *(GAS u32x4*)(rowp) = w1; *(GAS u32x4*)(rowp + HALF) = w2;
                }
            }
        } else {
#pragma unroll
            for (int ai = 0; ai < 2; ++ai)
#pragma unroll
                for (int m = 0; m < 4; ++m) {
                    const int row = row0 + ai * HALF + m * 16;
                    const float rs = rs8[ai * 4 + m];
                    GAS bf16_t* rowp = Og + (size_t)row * ldc + colt;
#pragma unroll
                    for (int bj = 0; bj < 2; ++bj) {
                        u32x4 w;
#pragma unroll
                        for (int n = 0; n < 2; ++n) {
                            f32x4 v = acc[ai][bj][m][n] * rs;
                            if (sub == 1) {
#pragma unroll
                                for (int j = 0; j < 4; ++j) { const float r = fmaxf(v[j], 0.f); v[j] = r * r; }
                            } else if (sub == 4) {
#pragma unroll
                                for (int j = 0; j < 4; ++j) v[j] = v[j] / (1.0f + __expf(-v[j]));
                            }
                            w[2 * n] = cvt_pk_bf16(v[0], v[1]); w[2 * n + 1] = cvt_pk_bf16(v[2], v[3]);
                        }
                        *(GAS u32x4*)(rowp + bj * HALF) = w;
                    }
                }
        }
    }
};
struct EpiRes {
    const float* xin; float* xout; bf16_t* xb; float* ssn; int glu;
    __device__ __forceinline__ void operator()(const f32x4 (&acc)[2][2][4][2], const Unit& u, int wr, int wc, int fr, int fq, LAS unsigned char*, int) const {
        const int row0 = u.pm * BM + wr * 64 + fr;
        const GAS float* xi = (const GAS float*)xin; GAS float* xo = (GAS float*)xout; GAS bf16_t* xbg = (GAS bf16_t*)xb; GAS float* ssg = (GAS float*)ssn;
        if (glu) {
            const size_t cb = (size_t)u.pn * HALF + wc * 32 + 8 * fq;
#pragma unroll
            for (int ai = 0; ai < 2; ++ai) {
                f32x4 xv[4][2];
#pragma unroll
                for (int m = 0; m < 4; ++m)
#pragma unroll
                    for (int n = 0; n < 2; ++n) xv[m][n] = *(const GAS f32x4*)(xi + (size_t)(row0 + ai * HALF + m * 16) * D_ + cb + n * 4);
#pragma unroll
                for (int m = 0; m < 4; ++m) {
                    const int row = row0 + ai * HALF + m * 16; const size_t off = (size_t)row * D_ + cb;
                    float sq = 0.f; u32x4 w;
#pragma unroll
                    for (int n = 0; n < 2; ++n) {
                        const f32x4 va = acc[ai][0][m][n], ga = acc[ai][1][m][n];
                        f32x4 x4 = xv[m][n];
#pragma unroll
                        for (int j = 0; j < 4; ++j) { x4[j] += va[j] / (1.0f + __expf(-ga[j])); sq += x4[j] * x4[j]; }
                        *(GAS f32x4*)(xo + off + n * 4) = x4;
                        w[2 * n] = cvt_pk_bf16(x4[0], x4[1]); w[2 * n + 1] = cvt_pk_bf16(x4[2], x4[3]);
                    }
                    *(GAS u32x4*)(xbg + off) = w;
                    sq += __shfl_xor(sq, 16); sq += __shfl_xor(sq, 32);
                    if (fq == 0) atomicAdd((float*)ssn + (size_t)((u.pn >> 1) * 4 + wc) * T_ + row, sq);
                }
            }
        } else {
            const size_t cb = (size_t)u.pn * BM + wc * 32 + 8 * fq;
#pragma unroll
            for (int ai = 0; ai < 2; ++ai) {
                f32x4 xv[4][2][2];
#pragma unroll
                for (int m = 0; m < 4; ++m)
#pragma unroll
                    for (int bj = 0; bj < 2; ++bj)
#pragma unroll
                        for (int n = 0; n < 2; ++n) xv[m][bj][n] = *(const GAS f32x4*)(xi + (size_t)(row0 + ai * HALF + m * 16) * D_ + cb + bj * HALF + n * 4);
#pragma unroll
                for (int m = 0; m < 4; ++m) {
                    const int row = row0 + ai * HALF + m * 16; const size_t off = (size_t)row * D_ + cb;
                    float sq = 0.f;
#pragma unroll
                    for (int bj = 0; bj < 2; ++bj) {
                        u32x4 w;
#pragma unroll
                        for (int n = 0; n < 2; ++n) {
                            f32x4 x4 = xv[m][bj][n] + acc[ai][bj][m][n];
#pragma unroll
                            for (int j = 0; j < 4; ++j) sq += x4[j] * x4[j];
                            *(GAS f32x4*)(xo + off + bj * HALF + n * 4) = x4;
                            w[2 * n] = cvt_pk_bf16(x4[0], x4[1]); w[2 * n + 1] = cvt_pk_bf16(x4[2], x4[3]);
                        }
                        *(GAS u32x4*)(xbg + off + bj * HALF) = w;
                    }
                    sq += __shfl_xor(sq, 16); sq += __shfl_xor(sq, 32);
                    if (fq == 0) ssg[(size_t)(u.pn * 4 + wc) * T_ + row] = sq;
                }
            }
        }
    }
};

template <class Epi, class Sched>
__device__ __forceinline__ void gemm_phase(LAS unsigned char* lds, const Gemm g, const Sched& S, const Epi& E) {
    const int tid = otid(), wid = __builtin_amdgcn_readfirstlane(tid >> 6), lane = tid & 63, wr = wid >> 2, wc = wid & 3, fr = lane & 15, fq = lane >> 4;
    const int K = g.K, nt = K / BK;
    unsigned voffA[2], voffB[2];
#pragma unroll
    for (int i = 0; i < 2; ++i) { int R, C; stage_rc(tid * 16 + i * 8192, R, C); voffA[i] = (unsigned)(R * K + C) * 2u; voffB[i] = voffA[i]; }
    const size_t kstep = (size_t)(BK * 2);
    const size_t hstep = (size_t)HALF * K * 2;
    const size_t tstep = 2 * hstep;
    const unsigned ldsw = (unsigned)wid * 1024u;
    const int aoff = lds_byte(wr * 64 + fr, fq * 8), boff = lds_byte(wc * 32 + fr, fq * 8);
#define PG8_SA(b, h) (((b) * 2 + (h)) * HTB)
#define PG8_SB(b, h) ((4 + (b) * 2 + (h)) * HTB)
#define PG8_STAGE(bufoff, gbase, voff) do { _Pragma("unroll") for (int _i = 0; _i < 2; ++_i) \
        __builtin_amdgcn_global_load_lds((const unsigned*)((const char*)(gbase) + (voff)[_i]), (LAS unsigned*)(lds + (bufoff) + ldsw + _i * 8192), 16, 0, 0); } while (0)
#define PG8_LDA(dst, b, h) do { _Pragma("unroll") for (int m = 0; m < 4; ++m) _Pragma("unroll") for (int k = 0; k < 2; ++k) dst[m][k] = *(const LAS bf16x8*)(lds + PG8_SA(b, h) + aoff + m * 2048 + k * 1024); } while (0)
#define PG8_LDB(dst, b, h) do { _Pragma("unroll") for (int n = 0; n < 2; ++n) _Pragma("unroll") for (int k = 0; k < 2; ++k) dst[n][k] = *(const LAS bf16x8*)(lds + PG8_SB(b, h) + boff + n * 2048 + k * 1024); } while (0)
#define PG8_MMA(ai, bj, At, Bt) do { __builtin_amdgcn_s_setprio(1); _Pragma("unroll") for (int m = 0; m < 4; ++m) _Pragma("unroll") for (int n = 0; n < 2; ++n) _Pragma("unroll") for (int k = 0; k < 2; ++k) \
        acc[ai][bj][m][n] = __builtin_amdgcn_mfma_f32_16x16x32_bf16(Bt[n][k], At[m][k], acc[ai][bj][m][n], 0, 0, 0); __builtin_amdgcn_s_setprio(0); } while (0)
#define PG8_WAIT_V(n) asm volatile("s_waitcnt vmcnt(" #n ")" ::: "memory")
#define PG8_WAIT_L(n) asm volatile("s_waitcnt lgkmcnt(" #n ")" ::: "memory")
#define PG8_BAR __builtin_amdgcn_s_barrier()
#define PG8_SCHED __builtin_amdgcn_sched_barrier(0)
    Unit cur, nxt; int ui = 0;
    if (!S.next(0, cur)) return;
    f32x4 acc[2][2][4][2];
#pragma unroll
    for (int a = 0; a < 2; ++a)
#pragma unroll
        for (int b = 0; b < 2; ++b)
#pragma unroll
            for (int m = 0; m < 4; ++m)
#pragma unroll
                for (int n = 0; n < 2; ++n) acc[a][b][m][n] = (f32x4){0.f, 0.f, 0.f, 0.f};
    bf16x8 At[4][2], B0[2][2], B1[2][2];
    const char* cA = (const char*)g.A + (size_t)cur.pm * tstep; const char* cB = (const char*)g.Bt + (size_t)cur.pn * tstep;
    PG8_STAGE(PG8_SB(0, 0), cB, voffB); PG8_STAGE(PG8_SA(0, 0), cA, voffA); PG8_STAGE(PG8_SB(0, 1), cB + hstep, voffB); PG8_STAGE(PG8_SA(0, 1), cA + hstep, voffA);
    if (wr == 1) PG8_BAR;
    PG8_WAIT_V(4); PG8_BAR;
    PG8_STAGE(PG8_SB(1, 0), cB + kstep, voffB); PG8_STAGE(PG8_SA(1, 0), cA + kstep, voffA); PG8_STAGE(PG8_SB(1, 1), cB + hstep + kstep, voffB);
    PG8_WAIT_V(6); PG8_BAR;
    for (;;) {
        const bool has_next = S.next(ui + 1, nxt);
        const char* nA = has_next ? (const char*)g.A + (size_t)nxt.pm * tstep : cA; const char* nB = has_next ? (const char*)g.Bt + (size_t)nxt.pn * tstep : cB;
        for (int t = 0; t < nt; t += 2) {
            const bool last = (t == nt - 2);
            const char* a1 = cA + (size_t)(t + 1) * kstep;
            const char* a2 = last ? nA : cA + (size_t)(t + 2) * kstep; const char* b2 = last ? nB : cB + (size_t)(t + 2) * kstep;
            const char* a3 = a2 + kstep; const char* b3 = b2 + kstep;
            PG8_LDB(B0, 0, 0); PG8_SCHED; PG8_LDA(At, 0, 0); PG8_STAGE(PG8_SA(1, 1), a1 + hstep, voffA);
            PG8_WAIT_L(8); PG8_BAR; PG8_WAIT_L(0); PG8_MMA(0, 0, At, B0); PG8_BAR; PG8_SCHED;
            PG8_LDB(B1, 0, 1); PG8_STAGE(PG8_SB(0, 0), b2, voffB);
            PG8_BAR; PG8_WAIT_L(0); PG8_MMA(0, 1, At, B1); PG8_BAR;
            PG8_LDA(At, 0, 1); PG8_STAGE(PG8_SA(0, 0), a2, voffA);
            PG8_BAR; PG8_WAIT_L(0); PG8_MMA(1, 0, At, B0); PG8_BAR; PG8_SCHED;
            PG8_STAGE(PG8_SB(0, 1), b2 + hstep, voffB);
            PG8_WAIT_V(6); PG8_BAR; PG8_MMA(1, 1, At, B1); PG8_BAR;
            PG8_LDB(B0, 1, 0); PG8_SCHED; PG8_LDA(At, 1, 0); PG8_STAGE(PG8_SA(0, 1), a2 + hstep, voffA);
            PG8_WAIT_L(8); PG8_BAR; PG8_WAIT_L(0); PG8_MMA(0, 0, At, B0); PG8_BAR; PG8_SCHED;
            PG8_LDB(B1, 1, 1); PG8_STAGE(PG8_SB(1, 0), b3, voffB);
            PG8_BAR; PG8_WAIT_L(0); PG8_MMA(0, 1, At, B1); PG8_BAR;
            PG8_LDA(At, 1, 1); PG8_STAGE(PG8_SA(1, 0), a3, voffA);
            PG8_BAR; PG8_WAIT_L(0); PG8_MMA(1, 0, At, B0); PG8_BAR; PG8_SCHED;
            PG8_STAGE(PG8_SB(1, 1), b3 + hstep, voffB);
            PG8_WAIT_V(6); PG8_BAR; PG8_MMA(1, 1, At, B1); PG8_BAR;
        }
        E(acc, cur, wr, wc, fr, fq, lds, ui);
        if (!has_next) break;
#pragma unroll
        for (int a = 0; a < 2; ++a)
#pragma unroll
            for (int b = 0; b < 2; ++b)
#pragma unroll
                for (int m = 0; m < 4; ++m)
#pragma unroll
                    for (int n = 0; n < 2; ++n) acc[a][b][m][n] = (f32x4){0.f, 0.f, 0.f, 0.f};
        cur = nxt; cA = nA; cB = nB; ++ui;
    }
    PG8_WAIT_V(0);
    if (wr == 0) PG8_BAR;
    PG8_BAR;
#undef PG8_SA
#undef PG8_SB
#undef PG8_STAGE
#undef PG8_LDA
#undef PG8_LDB
#undef PG8_MMA
#undef PG8_WAIT_V
#undef PG8_WAIT_L
#undef PG8_BAR
#undef PG8_SCHED
}
}

namespace att {
constexpr int D = 128, KVBLK = 64, LDK = 6144;
constexpr float SCALE = 0.088388347648318440f;
constexpr float THR = 8.f;
constexpr size_t SHM_V = KVBLK * D * 2, SHM_K = KVBLK * D * 2;
#define KSWZ(row, colB) ((row) * 256 + ((colB) ^ (((row) & 7) << 4)))
#define SBAR() __builtin_amdgcn_sched_barrier(0)
__device__ __forceinline__ int crow(int r, int hi) { return (r & 3) + 8 * (r >> 2) + 4 * hi; }
__device__ __forceinline__ void partialSM(f32x16& p0, f32x16& p1, float& m_reg, float& mn, float& alpha, bool msk) {
    constexpr float C = SCALE * 1.4426950408889634f;
    if (msk) {
#pragma unroll
        for (int r = 0; r < 16; ++r) { p0[r] = -1e30f; p1[r] = -1e30f; }
    }
    float pmax = p0[0];
#pragma unroll
    for (int r = 1; r < 16; ++r) pmax = fmaxf(pmax, p0[r]);
#pragma unroll
    for (int r = 0; r < 16; ++r) pmax = fmaxf(pmax, p1[r]);
    { auto rr = __builtin_amdgcn_permlane32_swap(__float_as_uint(pmax), __float_as_uint(pmax), false, false);
      pmax = fmaxf(__uint_as_float(rr[0]), __uint_as_float(rr[1])); }
    if (__builtin_expect(__all(pmax - m_reg <= THR / SCALE), 1)) { mn = m_reg; alpha = 1.f; }
    else { mn = fmaxf(m_reg, pmax); alpha = __builtin_amdgcn_exp2f((m_reg - mn) * C); m_reg = mn; }
    float mnC = -mn * C;
#pragma unroll
    for (int r = 0; r < 16; ++r) p0[r] = fmaf(p0[r], C, mnC);
#pragma unroll
    for (int r = 0; r < 16; ++r) p1[r] = fmaf(p1[r], C, mnC);
#pragma unroll
    for (int r = 0; r < 16; ++r) p0[r] = __builtin_amdgcn_exp2f(p0[r]);
}
__device__ __forceinline__ void finishSM(f32x16& p0, f32x16& p1, float alpha, float& l_reg, bf16x8& pa0, bf16x8& pa1, bf16x8& pa2, bf16x8& pa3) {
#pragma unroll
    for (int r = 0; r < 16; ++r) p1[r] = __builtin_amdgcn_exp2f(p1[r]);
    float ps = 0;
#pragma unroll
    for (int r = 0; r < 16; ++r) ps += p0[r];
#pragma unroll
    for (int r = 0; r < 16; ++r) ps += p1[r];
    { auto rr = __builtin_amdgcn_permlane32_swap(__float_as_uint(ps), __float_as_uint(ps), false, false);
      ps = __uint_as_float(rr[0]) + __uint_as_float(rr[1]); }
    l_reg = l_reg * alpha + ps;
#define PK4(P, BASE, OUT) do { unsigned a0 = cvt_pk_bf16(P[BASE + 0], P[BASE + 1]), a1 = cvt_pk_bf16(P[BASE + 2], P[BASE + 3]);   \
    unsigned b0 = cvt_pk_bf16(P[BASE + 4], P[BASE + 5]), b1 = cvt_pk_bf16(P[BASE + 6], P[BASE + 7]);                              \
    auto r0 = __builtin_amdgcn_permlane32_swap(a0, b0, false, false); auto r1 = __builtin_amdgcn_permlane32_swap(a1, b1, false, false); \
    u32x4 w = {r0[0], r1[0], r0[1], r1[1]}; OUT = *reinterpret_cast<bf16x8*>(&w); } while (0)
    PK4(p0, 0, pa0); PK4(p0, 8, pa1); PK4(p1, 0, pa2); PK4(p1, 8, pa3);
#undef PK4
}
__device__ __forceinline__ void qkt(f32x16& p0, f32x16& p1, const char* Ks, const bf16x8* qr, int r32, int hi) {
    p0 = f32x16{}; p1 = f32x16{};
#pragma unroll
    for (int d0 = 0; d0 < 8; ++d0) { int cb = (d0 * 16 + hi * 8) * 2;
        bf16x8 b0 = *reinterpret_cast<const bf16x8*>(Ks + KSWZ(r32, cb));
        bf16x8 b1 = *reinterpret_cast<const bf16x8*>(Ks + KSWZ(32 + r32, cb));
        p0 = __builtin_amdgcn_mfma_f32_32x32x16_bf16(b0, qr[d0], p0, 0, 0, 0);
        p1 = __builtin_amdgcn_mfma_f32_32x32x16_bf16(b1, qr[d0], p1, 0, 0, 0); }
}
__device__ __forceinline__ int v_st(int k, int c) { const int kk = (k & ~0xC) | ((k & 4) << 1) | ((k & 8) >> 1); return ((kk >> 3) * 4 + (c >> 5)) * 512 + ((kk & 7) * 32 + (c & 31)) * 2; }
__device__ __forceinline__ int v_rd_base(int lane) { return ((lane & 3) << 3) | (((lane >> 2) & 3) << 6) | (((lane >> 4) & 1) << 5) | (((lane >> 5) & 1) << 8); }
constexpr int v_rd_off(int d0, int ks, int half) { return d0 * 512 + ks * 4096 + half * 2048; }
template <int OFF> __device__ __forceinline__ s16x4 tr_read(int vb) {
    s16x4 r; asm volatile("ds_read_b64_tr_b16 %0, %1 offset:%2" : "=&v"(r) : "v"(vb), "i"(OFF) : "memory"); return r;
}
template <int D0> __device__ __forceinline__ void pv_one(f32x16& od, int vb, bf16x8 pa0, bf16x8 pa1, bf16x8 pa2, bf16x8 pa3) {
    const s16x4 l0 = tr_read<v_rd_off(D0, 0, 0)>(vb), h0 = tr_read<v_rd_off(D0, 0, 1)>(vb), l1 = tr_read<v_rd_off(D0, 1, 0)>(vb), h1 = tr_read<v_rd_off(D0, 1, 1)>(vb);
    const s16x4 l2 = tr_read<v_rd_off(D0, 2, 0)>(vb), h2 = tr_read<v_rd_off(D0, 2, 1)>(vb), l3 = tr_read<v_rd_off(D0, 3, 0)>(vb), h3 = tr_read<v_rd_off(D0, 3, 1)>(vb);
    asm volatile("s_waitcnt lgkmcnt(0)" ::: "memory"); SBAR();
#define PK(L, H) (bf16x8){L[0], L[1], L[2], L[3], H[0], H[1], H[2], H[3]}
    od = __builtin_amdgcn_mfma_f32_32x32x16_bf16(pa0, PK(l0, h0), od, 0, 0, 0);
    od = __builtin_amdgcn_mfma_f32_32x32x16_bf16(pa1, PK(l1, h1), od, 0, 0, 0);
    od = __builtin_amdgcn_mfma_f32_32x32x16_bf16(pa2, PK(l2, h2), od, 0, 0, 0);
    od = __builtin_amdgcn_mfma_f32_32x32x16_bf16(pa3, PK(l3, h3), od, 0, 0, 0);
#undef PK
}
__device__ __forceinline__ void pv_d0(f32x16* o, int vb, bf16x8 pa0, bf16x8 pa1, bf16x8 pa2, bf16x8 pa3) {
    pv_one<0>(o[0], vb, pa0, pa1, pa2, pa3); pv_one<1>(o[1], vb, pa0, pa1, pa2, pa3); pv_one<2>(o[2], vb, pa0, pa1, pa2, pa3); pv_one<3>(o[3], vb, pa0, pa1, pa2, pa3);
}
__device__ __forceinline__ void attn_body(const bf16_t* __restrict__ Qb, const bf16_t* __restrict__ Kh, const bf16_t* __restrict__ Vh, int NT, int ntw, char* lds, f32x16 (&o)[4]) {
    const int tid = otid(), wid = __builtin_amdgcn_readfirstlane(tid >> 6), lane = tid & 63, r32 = lane & 31, hi = lane >> 5;
    char* V_lds = lds; char* K_lds = lds + 2 * SHM_V;
    float* wsf = (float*)(lds + 2 * SHM_V + 2 * SHM_K) + wid * 64; float* li_l = wsf; float* al_l = wsf + 32;
    float m_reg = -1e30f, l_reg = 0; bf16x8 qr[8];
#pragma unroll
    for (int d = 0; d < 4; ++d) o[d] = f32x16{};
    const bf16_t* Qw = Qb + (long)(wid * 32 + r32) * LDK + hi * 8;
#pragma unroll
    for (int d0 = 0; d0 < 8; ++d0) qr[d0] = *reinterpret_cast<const bf16x8*>(Qw + d0 * 16);
    const int sr = tid >> 4, sc = (tid & 15) * 8, vst0 = v_st(sr, sc), vst1 = v_st(32 + sr, sc);
    const int vb0 = (int)(uintptr_t)V_lds + v_rd_base(lane);
    struct { bf16x8 vs0, vs1, ks0, ks1; } sr_[2];
#define SLOAD(i, k0) do { sr_[i].vs0 = *reinterpret_cast<const bf16x8*>(&Vh[(long)((k0) + sr) * LDK + sc]); sr_[i].vs1 = *reinterpret_cast<const bf16x8*>(&Vh[(long)((k0) + 32 + sr) * LDK + sc]); \
    sr_[i].ks0 = *reinterpret_cast<const bf16x8*>(&Kh[(long)((k0) + sr) * LDK + sc]); sr_[i].ks1 = *reinterpret_cast<const bf16x8*>(&Kh[(long)((k0) + 32 + sr) * LDK + sc]); } while (0)
#define SWRITE(b, i) do { *(bf16x8*)(V_lds + (b) * SHM_V + vst0) = sr_[i].vs0;          \
    *(bf16x8*)(V_lds + (b) * SHM_V + vst1) = sr_[i].vs1; int kc = sc * 2;               \
    *(bf16x8*)(K_lds + (b) * SHM_K + KSWZ(sr, kc)) = sr_[i].ks0;                       \
    *(bf16x8*)(K_lds + (b) * SHM_K + KSWZ(32 + sr, kc)) = sr_[i].ks1; } while (0)
#define SWAIT() asm volatile("s_waitcnt vmcnt(4)" ::: "memory")
#define RESC(a) do { if (__any((a) < 1.f)) { if (hi == 0) al_l[r32] = (a); asm volatile("s_waitcnt lgkmcnt(0)" ::: "memory"); \
    _Pragma("unroll") for (int d = 0; d < 4; ++d) _Pragma("unroll") for (int r = 0; r < 16; ++r) o[d][r] *= al_l[crow(r, hi)]; } } while (0)
    f32x16 pA0, pA1, pB0, pB1; float mnA, mnB, alA, alB; bf16x8 pa0, pa1, pa2, pa3;
    constexpr int SE = 0, SO = 1;
    __syncthreads();
    SLOAD(SE, 0); SLOAD(SO, KVBLK); SWAIT(); SWRITE(0, SE); __syncthreads();
    qkt(pA0, pA1, K_lds, qr, r32, hi); partialSM(pA0, pA1, m_reg, mnA, alA, false);
    if (2 < NT) SLOAD(SE, 2 * KVBLK);
    SWAIT(); SWRITE(1, SO); __syncthreads();
    for (int j = 1; j + 1 < NT; j += 2) {
        SBAR(); qkt(pB0, pB1, K_lds + SHM_K, qr, r32, hi);
        finishSM(pA0, pA1, alA, l_reg, pa0, pa1, pa2, pa3); SBAR();
        SLOAD(SO, (j + 2) * KVBLK); SBAR();
        pv_d0(o, vb0, pa0, pa1, pa2, pa3); partialSM(pB0, pB1, m_reg, mnB, alB, j >= ntw);
        __syncthreads(); SWAIT(); SWRITE(0, SE);
        RESC(alB); __syncthreads();
        SBAR(); qkt(pA0, pA1, K_lds, qr, r32, hi);
        finishSM(pB0, pB1, alB, l_reg, pa0, pa1, pa2, pa3); SBAR();
        if (j + 3 < NT) SLOAD(SE, (j + 3) * KVBLK); SBAR();
        pv_d0(o, vb0 + (int)SHM_V, pa0, pa1, pa2, pa3); partialSM(pA0, pA1, m_reg, mnA, alA, (j + 1) >= ntw);
        __syncthreads(); SWAIT(); SWRITE(1, SO);
        RESC(alA); __syncthreads();
    }
    SBAR(); qkt(pB0, pB1, K_lds + SHM_K, qr, r32, hi);
    finishSM(pA0, pA1, alA, l_reg, pa0, pa1, pa2, pa3); SBAR();
    pv_d0(o, vb0, pa0, pa1, pa2, pa3); partialSM(pB0, pB1, m_reg, mnB, alB, (NT - 1) >= ntw);
    __syncthreads(); RESC(alB);
    finishSM(pB0, pB1, alB, l_reg, pa0, pa1, pa2, pa3); SBAR();
    pv_d0(o, vb0 + (int)SHM_V, pa0, pa1, pa2, pa3);
    if (hi == 0) li_l[r32] = l_reg; asm volatile("s_waitcnt lgkmcnt(0)" ::: "memory");
#pragma unroll
    for (int r = 0; r < 16; ++r) { const float rl = __builtin_amdgcn_rcpf(li_l[crow(r, hi)]);
#pragma unroll
        for (int d = 0; d < 4; ++d) o[d][r] *= rl; }
#undef SLOAD
#undef SWRITE
#undef SWAIT
#undef RESC
}
}

__device__ __forceinline__ void sincos_red(double ang, float& s, float& c) {
    const double k = rint(ang * 0.15915494309189535);
    const float r = (float)(ang - k * 6.283185307179586);
    s = __sinf(r); c = __cosf(r);
}
__device__ __forceinline__ float gelu_tanh(float y) {
    const float z = 0.7978845608028654f * (y + 0.044715f * y * y * y);
    const float th = 1.0f - 2.0f / (1.0f + __expf(2.0f * z));
    return 0.5f * y * (1.0f + th);
}

struct ConvJob { const float* W; bf16_t* Wt; const float* gain; int K, N, glu, tile; };
struct ConvRegs { f32x4 va[4], vb[4]; float ga[4], gb[4]; };
__device__ __forceinline__ ConvJob conv_decode(const Params& p, unsigned char* ws, int t) {
    ConvJob j; j.glu = 0; j.gain = nullptr;
    if (t < 1536) { const int q = t / 768; j.tile = t - q * 768; j.W = p.a_w_in + (size_t)q * 2048 * 6144; j.Wt = (bf16_t*)(ws + OFF_WT_A_IN + q * SZ_A_IN); j.K = 2048; j.N = 6144; j.gain = p.norm_mix + (size_t)(3 * q) * D_; }
    else if (t < 2048) { const int u = t - 1536; const int q = u / 256; j.tile = u - q * 256; j.W = p.a_w_out + (size_t)q * 2048 * 2048; j.Wt = (bf16_t*)(ws + OFF_WT_A_OUT + q * SZ_A_OUT); j.K = 2048; j.N = 2048; }
    else if (t < 2560) { j.tile = t - 2048; j.W = p.b_w_glu; j.Wt = (bf16_t*)(ws + OFF_WT_GLU); j.K = 2048; j.N = 4096; j.glu = 1; }
    else if (t < 4096) { j.tile = t - 2560; j.W = p.c_w_in; j.Wt = (bf16_t*)(ws + OFF_WT_C_IN); j.K = 2048; j.N = 12288; j.gain = p.norm_mix + 2 * D_; }
    else if (t < 4608) { j.tile = t - 4096; j.W = p.c_w_out; j.Wt = (bf16_t*)(ws + OFF_WT_C_OUT); j.K = 4096; j.N = 2048; }
    else if (t < 8704) { const int u = t - 4608; const int i = u / 1024; j.tile = u - i * 1024; j.W = p.mlp_w1 + (size_t)i * 2048 * 8192; j.Wt = (bf16_t*)(ws + OFF_WT_W1 + i * SZ_W1); j.K = 2048; j.N = 8192; j.gain = p.norm_mlp + (size_t)i * D_; }
    else { const int u = t - 8704; const int i = u / 1024; j.tile = u - i * 1024; j.W = p.mlp_w2 + (size_t)i * 8192 * 2048; j.Wt = (bf16_t*)(ws + OFF_WT_W2 + i * SZ_W1); j.K = 8192; j.N = 2048; }
    return j;
}
__device__ __forceinline__ void conv_load(const ConvJob& j, ConvRegs& r, int tid) {
    const int ntn = j.N >> 7; const int tk = j.tile / ntn, tn = j.tile - tk * ntn; const int k0 = tk << 7, n0 = tn << 7;
    const int kp = tid >> 5, nl = (tid & 31) << 2;
#pragma unroll
    for (int i = 0; i < 4; ++i) { const int k = 2 * (kp + 16 * i);
        r.va[i] = *(const f32x4*)(j.W + (size_t)(k0 + k) * j.N + n0 + nl); r.vb[i] = *(const f32x4*)(j.W + (size_t)(k0 + k + 1) * j.N + n0 + nl);
        r.ga[i] = j.gain ? j.gain[k0 + k] : 1.f; r.gb[i] = j.gain ? j.gain[k0 + k + 1] : 1.f; }
}
__device__ __forceinline__ void conv_store(const ConvJob& j, const ConvRegs& r, int tid, unsigned* ldsw) {
    const int ntn = j.N >> 7; const int tk = j.tile / ntn, tn = j.tile - tk * ntn; const int k0 = tk << 7, n0 = tn << 7;
    const int kp = tid >> 5, nl = (tid & 31) << 2;
    __syncthreads();
#pragma unroll
    for (int i = 0; i < 4; ++i) { const int kpair = kp + 16 * i;
#pragma unroll
        for (int jj = 0; jj < 4; ++jj) ldsw[(nl + jj) * 65 + kpair] = cvt_pk_bf16(r.va[i][jj] * r.ga[i], r.vb[i][jj] * r.gb[i]); }
    __syncthreads();
    int nbase = n0;
    if (j.glu) { const int bj = n0 >> 11, pn = (n0 & 2047) >> 7; nbase = 256 * pn + 128 * bj; }
#pragma unroll
    for (int i = 0; i < 4; ++i) { const int n = (tid >> 4) + 32 * i, k8 = tid & 15;
        u32x4 w; w.x = ldsw[n * 65 + k8 * 4 + 0]; w.y = ldsw[n * 65 + k8 * 4 + 1]; w.z = ldsw[n * 65 + k8 * 4 + 2]; w.w = ldsw[n * 65 + k8 * 4 + 3];
        const int c5 = n & 31, np = (n & ~31) | (16 * ((c5 >> 2) & 1) + 4 * (c5 >> 3) + (c5 & 3));
        *(u32x4*)(j.Wt + (size_t)(nbase + np) * j.K + k0 + k8 * 8) = w; }
}

__device__ __forceinline__ void prep_phase(const Params& p, unsigned char* shm) {
    const int tid = otid(), bid = obid(), G = gridDim.x;
    unsigned char* ws = p.ws;
    {
        ConvJob jc = conv_decode(p, ws, bid); ConvRegs rc; conv_load(jc, rc, tid);
#pragma unroll 1
        for (int t = bid; t < 12800; t += G) {
            ConvJob jn = jc; ConvRegs rn = rc;
            if (t + G < 12800) { jn = conv_decode(p, ws, t + G); conv_load(jn, rn, tid); }
            conv_store(jc, rc, tid, (unsigned*)shm);
            jc = jn; rc = rn;
        }
    }
    {
        float* ss = (float*)(ws + OFF_SSP); bf16_t* xb = (bf16_t*)(ws + OFF_XB);
        const int wid = tid >> 6, lane = tid & 63;
        for (int row = bid * 8 + wid; row < T_; row += G * 8) {
            const float* xr = p.x + (size_t)row * D_; float sq = 0.f;
#pragma unroll
            for (int i = 0; i < 8; ++i) { const f32x4 v = *(const f32x4*)(xr + (i * 64 + lane) * 4);
                sq += v[0] * v[0] + v[1] * v[1] + v[2] * v[2] + v[3] * v[3];
                *(f32x4*)(p.out + (size_t)row * D_ + (i * 64 + lane) * 4) = v;
                u32x2 w; w.x = cvt_pk_bf16(v[0], v[1]); w.y = cvt_pk_bf16(v[2], v[3]);
                *(u32x2*)(xb + (size_t)row * D_ + (i * 64 + lane) * 4) = w; }
#pragma unroll
            for (int o = 32; o > 0; o >>= 1) sq += __shfl_xor(sq, o);
            if (lane < 32) ss[(size_t)lane * T_ + row] = (lane == 0) ? sq : 0.f;
        }
        for (int i = bid * 512 + tid; i < 32 * T_; i += G * 512) ss[(size_t)3 * 32 * T_ + i] = 0.f;
        float* rssq = (float*)(ws + OFF_RSQP);
        for (int i = bid * 512 + tid; i < 64 * T_; i += G * 512) rssq[i] = 0.f;
    }
    {
        float* par = (float*)(ws + OFF_PAR);
        for (int i = bid * 512 + tid; i < PAR_N; i += G * 512) {
            float v;
            if (i < PAR_NFINAL) v = p.norm_mix[D_ + i];
            else if (i < PAR_LAM) v = p.norm_final[i - PAR_NFINAL];
            else if (i < PAR_SUBLN) v = p.a_lambda[i - PAR_LAM];
            else if (i < PAR_BD) v = p.a_subln[i - PAR_SUBLN];
            else v = p.b_d[i - PAR_BD];
            par[i] = v;
        }
    }
    {
        f32x2* rot = (f32x2*)(ws + OFF_ROT);
        for (int i = bid * 512 + tid; i < 4096 * 128; i += G * 512) {
            const int pos = i >> 7, j = i & 127;
            const double inv = exp(-9.210340371976184 * ((double)j / 127.0));
            float s, c; sincos_red((double)pos * inv, s, c);
            f32x2 v; v.x = c; v.y = s; rot[i] = v;
        }
    }
    {
        bf16_t* Bm = (bf16_t*)(ws + OFF_S5B); bf16_t* Cm = (bf16_t*)(ws + OFF_S5C); f32x2* AB = (f32x2*)(ws + OFF_S5AB);
        const float* gmix = p.norm_mix + 1 * D_;
        for (int i = bid * 512 + tid; i < 128 * 64; i += G * 512) {
            const int g = i >> 6, pp = i & 63;
            const float lre = p.b_a_re[i], lim = p.b_a_im[i];
            const float dt = __expf(p.b_log_dt[g]);
            const float mag = __expf(lre * dt);
            float sn, cs; sincos_red((double)lim * (double)dt, sn, cs);
            const float abr = mag * cs, abi = mag * sn;
            const float den = lre * lre + lim * lim;
            const float nr = abr - 1.0f, ni = abi;
            const float cr_ = (nr * lre + ni * lim) / den, ci_ = (ni * lre - nr * lim) / den;
            f32x2 ab; ab.x = abr; ab.y = abi; AB[i] = ab;
#pragma unroll
            for (int c = 0; c < 16; ++c) {
                const float br = p.b_b_re[(size_t)i * 16 + c], bi = p.b_b_im[(size_t)i * 16 + c];
                const float gm = gmix[g * 16 + c];
                Bm[((size_t)g * 128 + pp) * 16 + c] = f2bf((cr_ * br - ci_ * bi) * gm);
                Bm[((size_t)g * 128 + 64 + pp) * 16 + c] = f2bf((cr_ * bi + ci_ * br) * gm);
                Cm[((size_t)g * 16 + c) * 128 + 2 * pp] = f2bf(p.b_c_re[((size_t)g * 16 + c) * 64 + pp]);
                Cm[((size_t)g * 16 + c) * 128 + 2 * pp + 1] = f2bf(-p.b_c_im[((size_t)g * 16 + c) * 64 + pp]);
            }
        }
    }
}

__device__ __forceinline__ void attn_phase(const Params& p, int j, float lambda_init, unsigned char* shm) {
    const int tid = otid(), wid = __builtin_amdgcn_readfirstlane(tid >> 6), lane = tid & 63, r32 = lane & 31, hi = lane >> 5;
    const bf16_t* qkv = (const bf16_t*)(p.ws + OFF_BIG);
    bf16_t* oa = (bf16_t*)(p.ws + OFF_OA);
    float* scr = (float*)(p.ws + OFF_ATT_SCR) + (size_t)obid() * 2 * 32768;
    float lam;
    { const float* lp = (const float*)(p.ws + OFF_PAR) + PAR_LAM + (size_t)j * 512;
      float a = lp[lane] * lp[128 + lane] + lp[64 + lane] * lp[192 + lane];
      float b = lp[256 + lane] * lp[384 + lane] + lp[320 + lane] * lp[448 + lane];
#pragma unroll
      for (int o = 32; o > 0; o >>= 1) { a += __shfl_xor(a, o); b += __shfl_xor(b, o); }
      lam = __expf(a) - __expf(b) + lambda_init; lam = __uint_as_float(__builtin_amdgcn_readfirstlane(__float_as_uint(lam))); }
    const float* sub = (const float*)(p.ws + OFF_PAR) + PAR_SUBLN + (size_t)j * 256;
    const int c = obid(); const int xcd = c & 7, jj = c >> 3;
    const int bh = xcd * 4 + (jj >> 3), pi = jj & 7;
    const int b = bh >> 3, h = bh & 7;
#pragma unroll 1
    for (int it = 0; it < 2; ++it) {
        const int qb = it == 0 ? (15 - pi) : pi;
        const int NT = 4 * qb + 4, ntw = 4 * qb + (wid >> 1) + 1;
        const size_t tok0 = (size_t)b * S_ + (size_t)qb * 256;
        f32x16 o[4];
#pragma unroll 1
        for (int ps = 0; ps < 4; ++ps) {
            const int e = ps >> 1, t = ps & 1;
            float* sc = scr + e * 32768;
            att::attn_body(qkv + tok0 * 6144 + h * 256 + t * 128, qkv + (size_t)b * S_ * 6144 + 2048 + h * 256 + t * 128,
                           qkv + (size_t)b * S_ * 6144 + 4096 + h * 256 + e * 128, NT, ntw, (char*)shm, o);
            float* scb = sc + tid * 4; asm volatile("" : "+v"(scb));
            if (t == 0) {
#pragma unroll
                for (int d = 0; d < 4; ++d)
#pragma unroll
                    for (int q = 0; q < 4; ++q) { const f32x4 v = {o[d][4 * q], o[d][4 * q + 1], o[d][4 * q + 2], o[d][4 * q + 3]}; *(f32x4*)(scb + (d * 4 + q) * 2048) = v; }
            } else {
#pragma unroll
                for (int d = 0; d < 4; ++d)
#pragma unroll
                    for (int q = 0; q < 4; ++q) { f32x4 c = *(const f32x4*)(scb + (d * 4 + q) * 2048);
#pragma unroll
                        for (int k = 0; k < 4; ++k) { const float cv = c[k] - lam * o[d][4 * q + k]; o[d][4 * q + k] = cv; c[k] = cv; }
                        if (e == 0) *(f32x4*)(scb + (d * 4 + q) * 2048) = c; }
            }
        }
        float ssq[16]; f32x16 c0v[4];
        const float* scb0 = scr + tid * 4; asm volatile("" : "+v"(scb0));
#pragma unroll
        for (int d = 0; d < 4; ++d)
#pragma unroll
            for (int q = 0; q < 4; ++q) { const f32x4 c = *(const f32x4*)(scb0 + (d * 4 + q) * 2048);
#pragma unroll
                for (int k = 0; k < 4; ++k) c0v[d][4 * q + k] = c[k]; }
#pragma unroll
        for (int r = 0; r < 16; ++r) { float s = 0.f;
#pragma unroll
            for (int d = 0; d < 4; ++d) { const float c0 = c0v[d][r]; s += c0 * c0 + o[d][r] * o[d][r]; }
#pragma unroll
            for (int of = 16; of > 0; of >>= 1) s += __shfl_xor(s, of);
            ssq[r] = rsqrtf(s * (1.0f / 256.0f) + EPS_) * (1.0f - lambda_init); }
#pragma unroll
        for (int r = 0; r < 16; ++r) {
            const size_t row = tok0 + wid * 32 + att::crow(r, hi);
            bf16_t* op = oa + row * D_ + h * 256;
#pragma unroll
            for (int d = 0; d < 4; ++d) {
                const int col = d * 32 + r32;
                op[col] = f2bf(c0v[d][r] * ssq[r] * sub[col]);
                op[128 + col] = f2bf(o[d][r] * ssq[r] * sub[128 + col]);
            }
        }
    }
}

template <bool FINAL>
__device__ __forceinline__ void s5_phase(const Params& p, unsigned char* shm) {
    const int tid = otid(), wid = tid >> 6, lane = tid & 63, r32 = lane & 31, hi = lane >> 5, fr = lane & 15, fq = lane >> 4;
    const bf16_t* xb = (const bf16_t*)(p.ws + OFF_XB);
    const float* ss = (const float*)(p.ws + OFF_SSP) + (size_t)2 * 32 * T_;
    float* rsfin = (float*)(p.ws + OFF_RSFIN);
    const bf16_t* Bm = (const bf16_t*)(p.ws + OFF_S5B); const bf16_t* Cm = (const bf16_t*)(p.ws + OFF_S5C); const f32x2* AB = (const f32x2*)(p.ws + OFF_S5AB);
    f32x2* E = (f32x2*)(p.ws + OFF_BIG);
    bf16_t* gl = (bf16_t*)(p.ws + OFF_OA);
    bf16_t* Xs = (bf16_t*)shm + wid * (32 * 136);
    const float* gmix = (const float*)(p.ws + OFF_PAR) + PAR_GMIX; const float* dsk = (const float*)(p.ws + OFF_PAR) + PAR_BD;
    float* partL = (float*)(shm + 8 * 8704); float* rsL = partL + 512;
#pragma unroll 1
    for (int bc = obid(); bc < 256; bc += gridDim.x) {
      const int chunk = bc & 63, b = bc >> 6;
      const size_t t0 = (size_t)b * S_ + chunk * 64;
      __syncthreads();
      if (FINAL) { if (tid < 64) rsL[tid] = rsfin[t0 + tid]; }
      else {
          { const int row = tid & 63, part = tid >> 6; float a = 0.f;
#pragma unroll
            for (int k = 0; k < 4; ++k) a += ss[(size_t)(part * 4 + k) * T_ + t0 + row];
            partL[part * 64 + row] = a; }
          __syncthreads();
          if (tid < 64) { float tot = 0.f;
#pragma unroll
              for (int k = 0; k < 8; ++k) tot += partL[k * 64 + tid];
              const float r = rsqrtf(tot * (1.0f / D_) + EPS_); rsL[tid] = r; rsfin[t0 + tid] = r; }
      }
      __syncthreads();
#pragma unroll 1
      for (int goct = 0; goct < 16; ++goct) {
        const int g = goct * 8 + wid; const int pp = r32 + 32 * hi;
        const f32x2 ab = AB[g * 64 + pp];
        bf16x8 bfr[4];
#pragma unroll
        for (int nb = 0; nb < 4; ++nb) bfr[nb] = *(const bf16x8*)(Bm + ((size_t)g * 128 + nb * 32 + r32) * 16 + hi * 8);
        float xr = 0.f, xi = 0.f;
        bf16x8 cfr[4]; float gm4[4], ds4[4];
        if (FINAL) {
            { const f32x2 cin = E[((size_t)(b * 128 + g) * 64 + chunk) * 64 + pp]; xr = cin.x; xi = cin.y; }
#pragma unroll
            for (int ks = 0; ks < 4; ++ks) cfr[ks] = *(const bf16x8*)(Cm + ((size_t)g * 16 + fr) * 128 + ks * 32 + fq * 8);
#pragma unroll
            for (int jx = 0; jx < 4; ++jx) { gm4[jx] = gmix[g * 16 + 4 * fq + jx]; ds4[jx] = dsk[g * 16 + 4 * fq + jx]; }
        }
#pragma unroll
        for (int half = 0; half < 2; ++half) {
            const size_t trow = t0 + half * 32 + r32;
            const float rs = rsL[half * 32 + r32];
            const u32x4 raw = *(const u32x4*)(xb + trow * D_ + g * 16 + hi * 8);
            u32x4 sc4;
            sc4.x = cvt_pk_bf16(bflo(raw.x) * rs, bfhi(raw.x) * rs); sc4.y = cvt_pk_bf16(bflo(raw.y) * rs, bfhi(raw.y) * rs);
            sc4.z = cvt_pk_bf16(bflo(raw.z) * rs, bfhi(raw.z) * rs); sc4.w = cvt_pk_bf16(bflo(raw.w) * rs, bfhi(raw.w) * rs);
            const bf16x8 afr = *reinterpret_cast<const bf16x8*>(&sc4);
            f32x16 c0 = __builtin_amdgcn_mfma_f32_32x32x16_bf16(afr, bfr[0], f32x16{}, 0, 0, 0);
            f32x16 c1 = __builtin_amdgcn_mfma_f32_32x32x16_bf16(afr, bfr[1], f32x16{}, 0, 0, 0);
            f32x16 c2 = __builtin_amdgcn_mfma_f32_32x32x16_bf16(afr, bfr[2], f32x16{}, 0, 0, 0);
            f32x16 c3 = __builtin_amdgcn_mfma_f32_32x32x16_bf16(afr, bfr[3], f32x16{}, 0, 0, 0);
#pragma unroll
            for (int i = 0; i < 16; ++i) {
                auto r0 = __builtin_amdgcn_permlane32_swap(__float_as_uint(c0[i]), __float_as_uint(c1[i]), false, false);
                c0[i] = __uint_as_float(r0[0]); c1[i] = __uint_as_float(r0[1]);
                auto r1 = __builtin_amdgcn_permlane32_swap(__float_as_uint(c2[i]), __float_as_uint(c3[i]), false, false);
                c2[i] = __uint_as_float(r1[0]); c3[i] = __uint_as_float(r1[1]);
            }
#pragma unroll
            for (int t = 0; t < 32; ++t) {
                const int q = t >> 3, s = t & 7, idx = 4 * q + (s & 3);
                const float bur = (s < 4) ? c0[idx] : c1[idx], bui = (s < 4) ? c2[idx] : c3[idx];
                const float nr = ab.x * xr - ab.y * xi + bur, ni = ab.x * xi + ab.y * xr + bui;
                xr = nr; xi = ni;
                if (FINAL) *(unsigned*)(Xs + t * 136 + 2 * pp) = cvt_pk_bf16(xr, xi);
            }
            if (FINAL) {
                asm volatile("s_waitcnt lgkmcnt(0)" ::: "memory");
#pragma unroll
                for (int m = 0; m < 2; ++m) {
                    f32x4 acc = {0.f, 0.f, 0.f, 0.f};
#pragma unroll
                    for (int ks = 0; ks < 4; ++ks) {
                        const bf16x8 xf = *(const bf16x8*)(Xs + (m * 16 + fr) * 136 + ks * 32 + fq * 8);
                        acc = __builtin_amdgcn_mfma_f32_16x16x32_bf16(cfr[ks], xf, acc, 0, 0, 0);
                    }
                    const size_t tr2 = t0 + half * 32 + m * 16 + fr;
                    const float rs2 = rsL[half * 32 + m * 16 + fr];
                    const u32x2 hx = *(const u32x2*)(xb + tr2 * D_ + g * 16 + 4 * fq);
                    const float h0 = bflo(hx.x) * rs2 * gm4[0], h1 = bfhi(hx.x) * rs2 * gm4[1], h2 = bflo(hx.y) * rs2 * gm4[2], h3 = bfhi(hx.y) * rs2 * gm4[3];
                    const float y0 = gelu_tanh(acc[0] + ds4[0] * h0), y1 = gelu_tanh(acc[1] + ds4[1] * h1), y2 = gelu_tanh(acc[2] + ds4[2] * h2), y3 = gelu_tanh(acc[3] + ds4[3] * h3);
                    u32x2 w; w.x = cvt_pk_bf16(y0, y1); w.y = cvt_pk_bf16(y2, y3);
                    *(u32x2*)(gl + tr2 * D_ + g * 16 + 4 * fq) = w;
                }
                asm volatile("s_waitcnt lgkmcnt(0)" ::: "memory");
            }
        }
        if (!FINAL) { f32x2 e; e.x = xr; e.y = xi; E[((size_t)(b * 128 + g) * 64 + chunk) * 64 + pp] = e; }
      }
    }
}

__device__ __forceinline__ void s5_scan_phase(const Params& p) {
    const int tid = otid(), bid = obid();
    if (tid >= 128) return;
    f32x2* E = (f32x2*)(p.ws + OFF_BIG); const f32x2* AB = (const f32x2*)(p.ws + OFF_S5AB);
    for (int seq = bid * 128 + tid; seq < 4 * 128 * 64; seq += gridDim.x * 128) {
        const int pp = seq & 63, bg = seq >> 6, g = bg & 127;
        const f32x2 ab = AB[g * 64 + pp];
        float pr = ab.x, pi_ = ab.y;
#pragma unroll
        for (int k = 0; k < 6; ++k) { const float nr = pr * pr - pi_ * pi_, ni = 2.f * pr * pi_; pr = nr; pi_ = ni; }
        f32x2* Ep = E + (size_t)bg * 64 * 64 + pp;
        float xr = 0.f, xi = 0.f;
#pragma unroll 1
        for (int c0 = 0; c0 < 64; c0 += 16) {
            f32x2 e[16];
#pragma unroll
            for (int k = 0; k < 16; ++k) e[k] = Ep[(size_t)(c0 + k) * 64];
#pragma unroll
            for (int k = 0; k < 16; ++k) { f32x2 x; x.x = xr; x.y = xi; Ep[(size_t)(c0 + k) * 64] = x;
                const float nr = pr * xr - pi_ * xi + e[k].x, ni = pr * xi + pi_ * xr + e[k].y; xr = nr; xi = ni; }
        }
    }
}

__device__ __forceinline__ void ret_phase(const Params& p, unsigned char* shm, float* rssq) {
    const int tid = otid(), wid = tid >> 6, lane = tid & 63, fr = lane & 15, fq = lane >> 4;
    const bf16_t* ret = (const bf16_t*)(p.ws + OFF_BIG);
    bf16_t* ao = (bf16_t*)(p.ws + OFF_OA);
    constexpr int QS = 264, TS = 72;
    bf16_t* Qs = (bf16_t*)shm; bf16_t* Ks = Qs + 64 * QS; bf16_t* KTs = Ks + 64 * QS; bf16_t* VTs = KTs + 256 * TS; bf16_t* Ss = VTs + 64 * TS; bf16_t* RTs = Ss + 64 * TS;
    const int c = obid(); const int xcd = c & 7, jj = c >> 3;
    const int bh = xcd * 4 + (jj >> 3), sl = jj & 7;
    const int b = bh >> 3, h = bh & 7;
    const float lg = logf(1.0f - exp2f(-5.0f - (float)h));
    const float cdec = __expf(lg * 64.0f);
    const int mi = wid >> 1, ni0 = 2 * (wid & 1);
    const float qdec = __expf(lg * (float)(16 * mi + fr + 1));
    float idec[2][4];
#pragma unroll
    for (int t = 0; t < 2; ++t)
#pragma unroll
        for (int j = 0; j < 4; ++j) { const int n = 16 * mi + fr, m = 16 * (ni0 + t) + 4 * fq + j; idec[t][j] = __expf(lg * (fabsf((float)(n - m)) - (float)(63 - m))); }
    f32x4 R[4][2];
#pragma unroll
    for (int a = 0; a < 4; ++a)
#pragma unroll
        for (int d = 0; d < 2; ++d) R[a][d] = (f32x4){0.f, 0.f, 0.f, 0.f};
    const size_t tokb = (size_t)b * S_;
    const bf16_t* qsrc = ret + (tokb + (tid >> 5)) * 12288 + h * 256 + (tid & 31) * 8;
    const bf16_t* ksrc = ret + (tokb + lane) * 12288 + 2048 + h * 256 + wid * 32;
    const bf16_t* vsrc = ret + (tokb + lane) * 12288 + 4096 + h * 512 + sl * 64 + wid * 8;
    u32x4 pq[4], pk[4], pv; u32x2 pg[2], cg2[2];
    const bf16_t* gsrc = ret + (tokb + 16 * mi + fr) * 12288 + 8192 + h * 512 + sl * 64 + 16 * ni0 + 4 * fq;
#pragma unroll
    for (int j = 0; j < 4; ++j) { pq[j] = *(const u32x4*)(qsrc + (size_t)j * 16 * 12288); pk[j] = *(const u32x4*)(ksrc + j * 8); }
    pv = *(const u32x4*)vsrc;
    pg[0] = *(const u32x2*)gsrc; pg[1] = *(const u32x2*)(gsrc + 16);
    for (int ch = 0; ch < 64; ++ch) {
        __syncthreads();
        cg2[0] = pg[0]; cg2[1] = pg[1];
#pragma unroll
        for (int j = 0; j < 4; ++j) {
            *(u32x4*)(Qs + (j * 16 + (tid >> 5)) * QS + (tid & 31) * 8) = pq[j];
            *(u32x4*)(Ks + lane * QS + wid * 32 + j * 8) = pk[j];
            const unsigned kw[4] = {pk[j].x, pk[j].y, pk[j].z, pk[j].w};
#pragma unroll
            for (int i = 0; i < 4; ++i) {
                KTs[(wid * 32 + j * 8 + 2 * i) * TS + lane] = (bf16_t)(kw[i] & 0xffffu);
                KTs[(wid * 32 + j * 8 + 2 * i + 1) * TS + lane] = (bf16_t)(kw[i] >> 16);
            }
        }
        { const unsigned vw[4] = {pv.x, pv.y, pv.z, pv.w};
#pragma unroll
          for (int i = 0; i < 4; ++i) { VTs[(wid * 8 + 2 * i) * TS + lane] = (bf16_t)(vw[i] & 0xffffu); VTs[(wid * 8 + 2 * i + 1) * TS + lane] = (bf16_t)(vw[i] >> 16); } }
#pragma unroll
        for (int ei = 0; ei < 4; ++ei)
#pragma unroll
            for (int di = 0; di < 2; ++di) { u32x2 w; w.x = cvt_pk_bf16(R[ei][di][0], R[ei][di][1]); w.y = cvt_pk_bf16(R[ei][di][2], R[ei][di][3]);
                *(u32x2*)(RTs + (16 * ei + fr) * QS + wid * 32 + 16 * di + 4 * fq) = w; }
        if (ch + 1 < 64) {
            const size_t adv = (size_t)(ch + 1) * 64 * 12288;
#pragma unroll
            for (int j = 0; j < 4; ++j) { pq[j] = *(const u32x4*)(qsrc + adv + (size_t)j * 16 * 12288); pk[j] = *(const u32x4*)(ksrc + adv + j * 8); }
            pv = *(const u32x4*)(vsrc + adv);
            pg[0] = *(const u32x2*)(gsrc + adv); pg[1] = *(const u32x2*)(gsrc + adv + 16);
        }
        __syncthreads();
        bf16x8 qa[8];
        {
            f32x4 sacc[2] = {{0.f, 0.f, 0.f, 0.f}, {0.f, 0.f, 0.f, 0.f}};
#pragma unroll
            for (int ks = 0; ks < 8; ++ks) qa[ks] = *(const bf16x8*)(Qs + (16 * mi + fr) * QS + ks * 32 + fq * 8);
#pragma unroll
            for (int ks = 0; ks < 8; ++ks) {
#pragma unroll
                for (int t = 0; t < 2; ++t) { const bf16x8 bf = *(const bf16x8*)(Ks + (16 * (ni0 + t) + fr) * QS + ks * 32 + fq * 8);
                    sacc[t] = __builtin_amdgcn_mfma_f32_16x16x32_bf16(bf, qa[ks], sacc[t], 0, 0, 0); }
            }
#pragma unroll
            for (int t = 0; t < 2; ++t) { u32x2 w; w.x = cvt_pk_bf16(sacc[t][0] * idec[t][0], sacc[t][1] * idec[t][1]); w.y = cvt_pk_bf16(sacc[t][2] * idec[t][2], sacc[t][3] * idec[t][3]);
                *(u32x2*)(Ss + (16 * mi + fr) * TS + 16 * (ni0 + t) + 4 * fq) = w; }
        }
        __syncthreads();
        {
            f32x4 oi[2] = {{0.f, 0.f, 0.f, 0.f}, {0.f, 0.f, 0.f, 0.f}}, oc[2] = {{0.f, 0.f, 0.f, 0.f}, {0.f, 0.f, 0.f, 0.f}};
#pragma unroll
            for (int ks = 0; ks < 2; ++ks) {
                const bf16x8 af = *(const bf16x8*)(Ss + (16 * mi + fr) * TS + ks * 32 + fq * 8);
#pragma unroll
                for (int t = 0; t < 2; ++t) { const bf16x8 bf = *(const bf16x8*)(VTs + (16 * (ni0 + t) + fr) * TS + ks * 32 + fq * 8);
                    oi[t] = __builtin_amdgcn_mfma_f32_16x16x32_bf16(bf, af, oi[t], 0, 0, 0); }
            }
#pragma unroll
            for (int ks = 0; ks < 8; ++ks) {
#pragma unroll
                for (int t = 0; t < 2; ++t) { const bf16x8 bf = *(const bf16x8*)(RTs + (16 * (ni0 + t) + fr) * QS + ks * 32 + fq * 8);
                    oc[t] = __builtin_amdgcn_mfma_f32_16x16x32_bf16(bf, qa[ks], oc[t], 0, 0, 0); }
            }
            const size_t tok = tokb + (size_t)ch * 64 + 16 * mi + fr;
            float sq = 0.f;
#pragma unroll
            for (int t = 0; t < 2; ++t) {
                const int e = sl * 64 + 16 * (ni0 + t) + 4 * fq;
                const u32x2 gw = cg2[t];
                f32x4 ov = oi[t] + oc[t] * qdec;
                sq += ov[0] * ov[0] + ov[1] * ov[1] + ov[2] * ov[2] + ov[3] * ov[3];
                u32x2 w; w.x = cvt_pk_bf16(ov[0] * bflo(gw.x), ov[1] * bfhi(gw.x)); w.y = cvt_pk_bf16(ov[2] * bflo(gw.y), ov[3] * bfhi(gw.y));
                *(u32x2*)(ao + tok * 4096 + h * 512 + e) = w;
            }
            sq += __shfl_xor(sq, 16); sq += __shfl_xor(sq, 32);
            if (fq == 0) atomicAdd(rssq + (size_t)(sl * 4 + mi) * 0 + (size_t)sl * (T_ * 8) + tok * 8 + h, sq);
        }
#pragma unroll
        for (int ei = 0; ei < 4; ++ei)
#pragma unroll
            for (int di = 0; di < 2; ++di) R[ei][di] *= cdec;
#pragma unroll
        for (int ks = 0; ks < 2; ++ks) {
            bf16x8 bfk[2];
#pragma unroll
            for (int di = 0; di < 2; ++di) bfk[di] = *(const bf16x8*)(KTs + (wid * 32 + 16 * di + fr) * TS + ks * 32 + fq * 8);
#pragma unroll
            for (int ei = 0; ei < 4; ++ei) { const bf16x8 af = *(const bf16x8*)(VTs + (16 * ei + fr) * TS + ks * 32 + fq * 8);
#pragma unroll
                for (int di = 0; di < 2; ++di) R[ei][di] = __builtin_amdgcn_mfma_f32_16x16x32_bf16(bfk[di], af, R[ei][di], 0, 0, 0); }
        }
    }
}

__device__ __forceinline__ void ret2_phase(const Params& p) {
    bf16_t* ao = (bf16_t*)(p.ws + OFF_OA); const float* rssq = (const float*)(p.ws + OFF_RSQP);
    const size_t nvec = (size_t)T_ * 4096 / 8, stride = (size_t)gridDim.x * 512;
    for (size_t i0 = (size_t)obid() * 512 + otid(); i0 < nvec; i0 += 4 * stride) {
        u32x4 w[4]; float rsum[4];
#pragma unroll
        for (int u = 0; u < 4; ++u) { const size_t i = i0 + u * stride; w[u] = *(u32x4*)(ao + i * 8);
            const size_t t = i >> 9; const int hh = (int)((i & 511) >> 6); float a = 0.f;
#pragma unroll
            for (int sl = 0; sl < 8; ++sl) a += rssq[(size_t)sl * (T_ * 8) + t * 8 + hh];
            rsum[u] = a; }
#pragma unroll
        for (int u = 0; u < 4; ++u) { const size_t i = i0 + u * stride; const float rs = rsqrtf(rsum[u] * (1.0f / 512.0f) + EPS_);
            u32x4 x = w[u];
            x.x = cvt_pk_bf16(bflo(x.x) * rs, bfhi(x.x) * rs); x.y = cvt_pk_bf16(bflo(x.y) * rs, bfhi(x.y) * rs);
            x.z = cvt_pk_bf16(bflo(x.z) * rs, bfhi(x.z) * rs); x.w = cvt_pk_bf16(bflo(x.w) * rs, bfhi(x.w) * rs);
            *(u32x4*)(ao + i * 8) = x; }
    }
}

__device__ __forceinline__ void final_phase(const Params& p) {
    const float* ss = (const float*)(p.ws + OFF_SSP) + (size_t)8 * 32 * T_;
    const int tid = otid();
    const f32x4 g = *(const f32x4*)((const float*)(p.ws + OFF_PAR) + PAR_NFINAL + tid * 4);
    const int G = gridDim.x;
    for (int row0 = obid(); row0 < T_; row0 += 4 * G) {
        f32x4 v[4]; float sm[4];
#pragma unroll
        for (int u = 0; u < 4; ++u) { const int row = row0 + u * G; sm[u] = ss[(size_t)(tid & 31) * T_ + row]; v[u] = *(f32x4*)(p.out + (size_t)row * D_ + tid * 4); }
#pragma unroll
        for (int u = 0; u < 4; ++u) { const int row = row0 + u * G; float ssum = sm[u];
#pragma unroll
            for (int o = 16; o > 0; o >>= 1) ssum += __shfl_xor(ssum, o);
            const float rs = rsqrtf(ssum * (1.0f / D_) + EPS_);
            *(f32x4*)(p.out + (size_t)row * D_ + tid * 4) = v[u] * rs * g; }
    }
}

enum { OP_PREP = 0, OP_A_IN, OP_ATTN, OP_A_OUT, OP_S5A, OP_S5C, OP_GLU, OP_C_IN, OP_RET, OP_RET2, OP_C_OUT, OP_W1, OP_W2, OP_FINAL, OP_S5B };
#ifndef PHMASK
#define PHMASK 0xffff
#endif
#define PHON(b) ((PHMASK >> (b)) & 1)
constexpr int NPH = 24;
__device__ const unsigned char PROG_OP[NPH] = { OP_PREP,
    OP_A_IN, OP_ATTN, OP_A_OUT, OP_W1, OP_W2,
    OP_S5A, OP_S5B, OP_S5C, OP_GLU, OP_W1, OP_W2,
    OP_C_IN, OP_RET, OP_RET2, OP_C_OUT, OP_W1, OP_W2,
    OP_A_IN, OP_ATTN, OP_A_OUT, OP_W1, OP_W2,
    OP_FINAL };
__device__ const unsigned char PROG_LAYER[NPH] = { 0, 0, 0, 0, 0, 0, 1, 1, 1, 1, 1, 1, 2, 2, 2, 2, 2, 2, 3, 3, 3, 3, 3, 3 };

struct GemmDesc { unsigned long long a_off, b_off; int N, K, ss_idx, mode; };
#define GD_NONE {0, 0, 0, 0, 0, 0}
#define GD_A_IN(L)  {OFF_XB, OFF_WT_A_IN + (L / 3) * SZ_A_IN, 6144, 2048, 2 * L, 0}
#define GD_A_OUT(L) {OFF_OA, OFF_WT_A_OUT + (L / 3) * SZ_A_OUT, 2048, 2048, 2 * L + 1, 0}
#define GD_W1(L)    {OFF_XB, OFF_WT_W1 + L * SZ_W1, 8192, 2048, 2 * L + 1, 1}
#define GD_W2(L)    {OFF_BIG, OFF_WT_W2 + L * SZ_W1, 2048, 8192, 2 * L + 2, 0}
#define GD_GLU(L)   {OFF_OA, OFF_WT_GLU, 4096, 2048, 2 * L + 1, 1}
#define GD_C_IN(L)  {OFF_XB, OFF_WT_C_IN, 12288, 2048, 2 * L, 2}
#define GD_C_OUT(L) {OFF_OA, OFF_WT_C_OUT, 2048, 4096, 2 * L + 1, 0}
__device__ const GemmDesc GD[NPH] = { GD_NONE,
    GD_A_IN(0ull), GD_NONE, GD_A_OUT(0ull), GD_W1(0ull), GD_W2(0ull),
    GD_NONE, GD_NONE, GD_NONE, GD_GLU(1ull), GD_W1(1ull), GD_W2(1ull),
    GD_C_IN(2ull), GD_NONE, GD_NONE, GD_C_OUT(2ull), GD_W1(2ull), GD_W2(2ull),
    GD_A_IN(3ull), GD_NONE, GD_A_OUT(3ull), GD_W1(3ull), GD_W2(3ull),
    GD_NONE };

#define XB_TMO      128
#define XB_XCNT(j)  (256  + 64 * (j))
#define XB_XSUB(j)  (1280 + 64 * (j))
#define XB_XGEN(j)  (2304 + 64 * (j))
#define XB_TOP      3328
#define XB_TOPGEN   3392
#define XCD_BAR_WORDS 3456
#define XB_SPIN_CAP (1u << 22)
__device__ __forceinline__ unsigned xb_ld(unsigned* p)              { return __hip_atomic_load(p, __ATOMIC_RELAXED, __HIP_MEMORY_SCOPE_AGENT); }
__device__ __forceinline__ unsigned xb_add(unsigned* p, unsigned v) { return __hip_atomic_fetch_add(p, v, __ATOMIC_RELAXED, __HIP_MEMORY_SCOPE_AGENT); }
__device__ __forceinline__ unsigned xb_xcc_id() { return (unsigned)__builtin_amdgcn_s_getreg((3 << 11) | 20) & 0xFu; }
#define XB_SPIN(cond, bar) do { unsigned _sp = 0; while (cond) { __builtin_amdgcn_s_sleep(1); \
    if ((++_sp & 255u) == 0u) { if (xb_ld(&(bar)[XB_TMO])) break; if (_sp > XB_SPIN_CAP) { atomicAdd(&(bar)[XB_TMO], 1u); break; } } } } while (0)
struct XcdBarrier { unsigned* bar; unsigned x; volatile LAS unsigned* st; };
__device__ __forceinline__ XcdBarrier xcd_barrier_post(unsigned* bar, volatile LAS unsigned* st) {
    XcdBarrier b; b.bar = bar; b.x = xb_xcc_id(); b.st = st;
    if (threadIdx.x == 0) (void)xb_add(&bar[XB_XCNT(b.x)], 1u);
    return b;
}
__device__ __forceinline__ void xcd_barrier_complete(unsigned* bar, unsigned x, unsigned& nloc, unsigned& nx) {
    const unsigned G = gridDim.x * gridDim.y * gridDim.z;
    unsigned sum, cnt, mine, sp = 0u;
    for (;;) {
        sum = 0u; cnt = 0u; mine = 0u;
#pragma unroll
        for (unsigned j = 0; j < 16; ++j) { const unsigned c = xb_ld(&bar[XB_XCNT(j)]); sum += c; cnt += (c > 0u) ? 1u : 0u; mine = (j == x) ? c : mine; }
        if (sum == G) break;
        __builtin_amdgcn_s_sleep(1);
        if ((++sp & 255u) == 0u) { if (xb_ld(&bar[XB_TMO])) break; if (sp > XB_SPIN_CAP) { atomicAdd(&bar[XB_TMO], 1u); break; } }
    }
    nloc = mine > 0u ? mine : 1u; nx = cnt > 0u ? cnt : 1u;
}
__device__ __forceinline__ void xcd_barrier(unsigned char* ws, unsigned char* shm) {
    XcdBarrier b; b.bar = (unsigned*)(ws + OFF_BAR); b.x = xb_xcc_id(); b.st = (volatile LAS unsigned*)((LAS unsigned char*)shm + LDS_PHASE_BYTES);
    asm volatile("s_waitcnt vmcnt(0) lgkmcnt(0)" ::: "memory");
    __syncthreads();
    if (threadIdx.x == 0) {
        unsigned* bar = b.bar;
        __builtin_amdgcn_s_waitcnt(0);
        unsigned nloc = b.st[0], nx = b.st[1];
        if (nloc == 0u) { xcd_barrier_complete(bar, b.x, nloc, nx); b.st[0] = nloc; b.st[1] = nx; }
        const unsigned old = xb_add(&bar[XB_XSUB(b.x)], 1u);
        const unsigned gen = old / nloc;
        if (old + 1u == (gen + 1u) * nloc) {
            __builtin_amdgcn_fence(__ATOMIC_RELEASE, "agent");
            asm volatile("s_waitcnt vmcnt(0)" ::: "memory");
            const unsigned og = xb_add(&bar[XB_TOP], 1u);
            const unsigned tg = og / nx;
            if (og + 1u == (tg + 1u) * nx) xb_add(&bar[XB_TOPGEN], 1u);
            else XB_SPIN(xb_ld(&bar[XB_TOPGEN]) == tg, bar);
            __builtin_amdgcn_fence(__ATOMIC_ACQUIRE, "agent");
            xb_add(&bar[XB_XGEN(b.x)], 1u);
            asm volatile("s_waitcnt vmcnt(0)" ::: "memory");
        } else {
            XB_SPIN(xb_ld(&bar[XB_XGEN(b.x)]) == gen, bar);
            __builtin_amdgcn_fence(__ATOMIC_ACQUIRE, "agent");
            asm volatile("s_waitcnt vmcnt(0)" ::: "memory");
        }
    }
    __syncthreads();
}
__device__ __forceinline__ void gsync_cg(cg::grid_group& grid) {
    asm volatile("s_waitcnt vmcnt(0) lgkmcnt(0)" ::: "memory");
    grid.sync();
    __builtin_amdgcn_fence(__ATOMIC_ACQUIRE, "agent");
    asm volatile("s_waitcnt vmcnt(0) lgkmcnt(0)" ::: "memory");
}

__global__ void __launch_bounds__(512, 2) fwd_megakernel(Params p, int ph_lo, int ph_hi) {
    extern __shared__ __attribute__((aligned(16))) unsigned char shm[];
    cg::grid_group grid = cg::this_grid();
    volatile LAS unsigned* xst = (volatile LAS unsigned*)((LAS unsigned char*)shm + LDS_PHASE_BYTES);
    if (threadIdx.x == 0) { xst[0] = 0u; xst[1] = 0u; }
    __syncthreads();
    (void)xcd_barrier_post((unsigned*)(p.ws + OFF_BAR), xst);
#ifndef DUPMASK
#define DUPMASK 0
#endif
    if (PHON(0) && ph_lo == 0) {
#pragma unroll 1
        for (int rp_ = 0; rp_ < ((DUPMASK & 1) ? 2 : 1); ++rp_) { prep_phase(p, shm); if (ph_hi > 1) gsync_cg(grid); } }
    for (int ph = (ph_lo < 1 ? 1 : ph_lo); ph < ph_hi; ++ph) {
        const int op = PROG_OP[ph], L = PROG_LAYER[ph];
        const int nrep_ = ((DUPMASK >> op) & 1) ? 2 : 1;
#pragma unroll 1
        for (int rp_ = 0; rp_ < nrep_; ++rp_) {
        unsigned char* ws = p.ws; asm volatile("" : "+s"(ws));
        float* ssb = (float*)(ws + OFF_SSP);
        if (PHON(1) && (op == OP_A_IN || op == OP_C_IN || op == OP_W1)) {
            const GemmDesc gd = GD[ph];
            pg8::Gemm g; g.A = (const bf16_t*)(ws + gd.a_off); g.Bt = (const bf16_t*)(ws + gd.b_off); g.M = T_; g.N = gd.N; g.K = gd.K;
            pg8::EpiBf E; E.rot = (const f32x2*)(ws + OFF_ROT); E.O = (bf16_t*)(ws + OFF_BIG); E.ldc = gd.N; E.mode = gd.mode; E.ss = ssb + (size_t)gd.ss_idx * 32 * T_;
            pg8::StaticOrder S; S.init(g.M, g.N, (int)gridDim.x, obid());
            {
                float* lrs = (float*)(shm + pg8::STAGE_BYTES); const int tid2 = otid();
                int nun = 0; { pg8::Unit uu; while (nun < 24 && S.next(nun, uu)) ++nun; }
                for (int j = tid2; j < nun * 256; j += 512) { pg8::Unit uu; S.next(j >> 8, uu);
                    const float* sp = E.ss + (size_t)uu.pm * 256 + (j & 255); float sv[32];
#pragma unroll
                    for (int sl = 0; sl < 32; ++sl) sv[sl] = sp[(size_t)sl * T_];
                    float a = 0.f;
#pragma unroll
                    for (int sl = 0; sl < 32; ++sl) a += sv[sl];
                    lrs[j] = rsqrtf(a * (1.0f / D_) + EPS_); }
                __syncthreads();
            }
            pg8::gemm_phase<pg8::EpiBf, pg8::StaticOrder>((LAS unsigned char*)shm, g, S, E);
        } else if (PHON(2) && (op == OP_A_OUT || op == OP_GLU || op == OP_C_OUT || op == OP_W2)) {
            const GemmDesc gd = GD[ph];
            pg8::Gemm g; g.A = (const bf16_t*)(ws + gd.a_off); g.Bt = (const bf16_t*)(ws + gd.b_off); g.M = T_; g.N = gd.N; g.K = gd.K;
            pg8::EpiRes E; E.xout = p.out; E.xb = (bf16_t*)(ws + OFF_XB); E.glu = gd.mode; E.xin = p.out; E.ssn = ssb + (size_t)gd.ss_idx * 32 * T_;
            pg8::StaticOrder S; S.init(g.M, g.N, (int)gridDim.x, obid());
            pg8::gemm_phase<pg8::EpiRes, pg8::StaticOrder>((LAS unsigned char*)shm, g, S, E);
        } else if (PHON(3) && op == OP_ATTN) {
            const float li = 0.8f - 0.6f * expf(-0.3f * (float)L);
            attn_phase(p, L / 3, li, shm);
        } else if (PHON(4) && op == OP_S5A) {
            s5_phase<false>(p, shm);
        } else if (PHON(4) && op == OP_S5B) {
            s5_scan_phase(p);
        } else if (PHON(5) && op == OP_S5C) {
            s5_phase<true>(p, shm);
        } else if (PHON(6) && op == OP_RET) {
            ret_phase(p, shm, (float*)(ws + (rp_ == 0 ? OFF_RSQP : OFF_XB)));
        } else if (PHON(7) && op == OP_RET2) {
            ret2_phase(p);
        } else if (PHON(8) && op == OP_FINAL) {
            final_phase(p);
        }
        if (ph + 1 < ph_hi || rp_ + 1 < nrep_) xcd_barrier(ws, shm);
        }
    }
}

extern "C" void kernel_launch(void* const* d_in, const int* in_sizes, int n_in, void* d_out, int out_size, void* d_ws, size_t ws_size, hipStream_t stream) {
    static int grid_blocks = 0;
    if (grid_blocks == 0) {
        if (n_in != 21 || out_size != T_ * D_ || ws_size < WS_NEED) { fprintf(stderr, "kernel_launch: unexpected shapes n_in %d out %d ws %zu (need %zu)\n", n_in, out_size, ws_size, (size_t)WS_NEED); grid_blocks = -1; return; }
        int dev = 0, cus = 0, per_cu = 0;
        hipGetDevice(&dev);
        hipDeviceGetAttribute(&cus, hipDeviceAttributeMultiprocessorCount, dev);
        if (hipFuncSetAttribute((const void*)fwd_megakernel, hipFuncAttributeMaxDynamicSharedMemorySize, LDS_BYTES) != hipSuccess) { fprintf(stderr, "kernel_launch: hipFuncSetAttribute failed\n"); grid_blocks = -1; return; }
        hipOccupancyMaxActiveBlocksPerMultiprocessor(&per_cu, (const void*)fwd_megakernel, 512, LDS_BYTES);
        (void)hipGetLastError();
        if (per_cu < 1) per_cu = 1;
        grid_blocks = cus * 1;
        if (grid_blocks != 256) fprintf(stderr, "kernel_launch: note: %d CUs (kernel tuned for 256)\n", cus);
    }
    if (grid_blocks < 0) return;
    (void)hipMemsetAsync((unsigned char*)d_ws + OFF_BAR, 0, XCD_BAR_WORDS * 4, stream);
    Params p{};
    const float** pp = (const float**)&p;
    for (int i = 0; i < 21; ++i) pp[i] = (const float*)d_in[i];
    p.out = (float*)d_out; p.ws = (unsigned char*)d_ws;
#ifndef DBG_LO
#define DBG_LO 0
#endif
#ifndef DBG_HI
#define DBG_HI NPH
#endif
    int lo = DBG_LO, hi = DBG_HI;
    void* args[] = {&p, &lo, &hi};
    hipError_t e = hipLaunchCooperativeKernel((const void*)fwd_megakernel, dim3(grid_blocks), dim3(512), args, LDS_BYTES, stream);
    if (e != hipSuccess) fprintf(stderr, "cooperative launch failed: %s (grid %d)\n", hipGetErrorString(e), grid_blocks);
}
```

```cpp
#include <hip/hip_runtime.h>
#include <hip/hip_cooperative_groups.h>
#include <cstdio>
#include <cstdint>
namespace cg = cooperative_groups;

#define LAS __attribute__((address_space(3)))
typedef unsigned short bf16_t;
typedef short bf16x8 __attribute__((ext_vector_type(8)));
typedef short s16x4 __attribute__((ext_vector_type(4)));
typedef float f32x4 __attribute__((ext_vector_type(4)));
typedef float f32x2 __attribute__((ext_vector_type(2)));
typedef float f32x16 __attribute__((ext_vector_type(16)));
typedef unsigned u32x4 __attribute__((ext_vector_type(4)));
typedef unsigned u32x2 __attribute__((ext_vector_type(2)));

constexpr int T_ = 16384, D_ = 2048, S_ = 4096;
constexpr float EPS_ = 1e-6f;
constexpr int LDS_PHASE_BYTES = 156672;
constexpr int LDS_BYTES = LDS_PHASE_BYTES + 16;

constexpr size_t SZ_A_IN = 6144ull * 2048 * 2, SZ_A_OUT = 2048ull * 2048 * 2, SZ_W1 = 8192ull * 2048 * 2;
constexpr size_t OFF_WT_A_IN = 0;
constexpr size_t OFF_WT_A_OUT = OFF_WT_A_IN + 2 * SZ_A_IN;
constexpr size_t OFF_WT_GLU = OFF_WT_A_OUT + 2 * SZ_A_OUT;
constexpr size_t OFF_WT_C_IN = OFF_WT_GLU + 4096ull * 2048 * 2;
constexpr size_t OFF_WT_C_OUT = OFF_WT_C_IN + 12288ull * 2048 * 2;
constexpr size_t OFF_WT_W1 = OFF_WT_C_OUT + 2048ull * 4096 * 2;
constexpr size_t OFF_WT_W2 = OFF_WT_W1 + 4 * SZ_W1;
constexpr size_t OFF_XB = OFF_WT_W2 + 4 * SZ_W1;
constexpr size_t OFF_BIG = OFF_XB + (size_t)T_ * D_ * 2;
constexpr size_t OFF_OA = OFF_BIG + (size_t)T_ * 12288 * 2;
constexpr size_t OFF_SS = OFF_OA + (size_t)T_ * 4096 * 2;
constexpr size_t OFF_RSSQ = OFF_SS + 9ull * T_ * 4;
constexpr size_t OFF_ROT = OFF_RSSQ + (size_t)T_ * 8 * 4;
constexpr size_t OFF_S5B = OFF_ROT + 4096ull * 128 * 8;
constexpr size_t OFF_S5C = OFF_S5B + 128ull * 128 * 16 * 2;
constexpr size_t OFF_S5AB = OFF_S5C + 128ull * 16 * 128 * 2;
constexpr size_t WS_END = OFF_S5AB + 128ull * 64 * 8;
constexpr size_t OFF_SSP = WS_END;
constexpr size_t OFF_RSQP = OFF_SSP + 9ull * 32 * T_ * 4;
constexpr size_t OFF_RSFIN = OFF_RSQP + 8ull * T_ * 8 * 4;
constexpr size_t OFF_BAR = OFF_RSFIN + (size_t)T_ * 4;
constexpr size_t OFF_PAR = OFF_BAR + 16384;
constexpr int PAR_GMIX = 0, PAR_NFINAL = 2048, PAR_LAM = 4096, PAR_SUBLN = 5120, PAR_BD = 5632, PAR_N = 7680;
constexpr size_t WS_NEED = OFF_PAR + PAR_N * 4;
constexpr size_t OFF_ATT_SCR = OFF_BIG + (size_t)T_ * 6144 * 2;

struct Params {
    const float* x; const float* norm_mix; const float* norm_mlp; const float* norm_final;
    const float* a_w_in; const float* a_lambda; const float* a_subln; const float* a_w_out;
    const float* b_a_re; const float* b_a_im; const float* b_log_dt; const float* b_b_re; const float* b_b_im;
    const float* b_c_re; const float* b_c_im; const float* b_d; const float* b_w_glu;
    const float* c_w_in; const float* c_w_out; const float* mlp_w1; const float* mlp_w2;
    float* out; unsigned char* ws;
};

__device__ __forceinline__ unsigned cvt_pk_bf16(float lo, float hi) { unsigned r; asm volatile("v_cvt_pk_bf16_f32 %0, %1, %2" : "=v"(r) : "v"(lo), "v"(hi)); return r; }
__device__ __forceinline__ float bf2f(unsigned short b) { return __uint_as_float(((unsigned)b) << 16); }
__device__ __forceinline__ float bflo(unsigned w) { return __uint_as_float(w << 16); }
__device__ __forceinline__ float bfhi(unsigned w) { return __uint_as_float(w & 0xffff0000u); }
__device__ __forceinline__ unsigned short f2bf(float f) { return (unsigned short)(cvt_pk_bf16(f, 0.f) & 0xffffu); }

__device__ __forceinline__ int otid() { int t = threadIdx.x; asm volatile("" : "+v"(t)); return t; }
__device__ __forceinline__ int obid() { int t = blockIdx.x; asm volatile("" : "+s"(t)); return t; }

namespace pg8 {
constexpr int BM = 256, BK = 64, HALF = 128, HTB = HALF * BK * 2, STAGE_BYTES = 8 * HTB, NXCD = 8, WGM = 8;
__device__ __forceinline__ int lds_byte(int r, int c) { const int st = (r >> 4) * 2 + (c >> 5), rr = r & 15, cc = c & 31, ob = rr * 64 + cc * 2; return st * 1024 + (ob ^ (((ob >> 9) & 1) << 5)); }
__device__ __forceinline__ void stage_rc(int b, int& R, int& C) { const int st = b / 1024, sb = b % 1024, swz = sb ^ (((sb >> 9) & 1) << 5); R = (st >> 1) * 16 + swz / 64; C = (st & 1) * 32 + (swz % 64) / 2; }
struct Unit { int pm, pn; };
struct Gemm { const bf16_t* A; const bf16_t* Bt; int M, N, K; };
struct StaticOrder {
    int nM, nN, nwg, G, c;
    __device__ void init(int M, int N, int G_, int c_) { nM = M / BM; nN = N / BM; nwg = nM * nN; G = G_; c = c_; }
    __device__ bool next(int i, Unit& u) const {
        const long L = (long)i * G + c; if (L >= nwg) return false;
        int wgid = (int)L; { const int q = nwg / NXCD, r = nwg % NXCD, xcd = wgid % NXCD, off = wgid / NXCD; wgid = (xcd < r ? xcd * (q + 1) : r * (q + 1) + (xcd - r) * q) + off; }
        const int nig = WGM * nN, gid = wgid / nig, fm = gid * WGM, gsz = (nM - fm) < WGM ? (nM - fm) : WGM;
        u.pm = fm + ((wgid % nig) % gsz); u.pn = (wgid % nig) / gsz; return true;
    }
};

#define GAS __attribute__((address_space(1)))
struct EpiBf {
    bf16_t* O; int ldc; const float* ss; int mode; const f32x2* rot;
    __device__ __forceinline__ void operator()(const f32x4 (&acc)[2][2][4][2], const Unit& u, int wr, int wc, int fr, int fq, LAS unsigned char* lds, int ui) const {
        const int row0 = u.pm * BM + wr * 64 + fr, colt = u.pn * BM + wc * 32 + 8 * fq;
        int sub = 0;
        if (mode == 1) sub = 1;
        else if (mode == 2) { sub = u.pn < 8 ? 2 : (u.pn < 16 ? 3 : (u.pn < 32 ? 0 : 4)); }
        const LAS float* lrs = (const LAS float*)(lds + STAGE_BYTES) + ui * 256 + wr * 64 + fr;
        float rs8[8];
#pragma unroll
        for (int r = 0; r < 8; ++r) rs8[r] = lrs[(r >> 2) * HALF + (r & 3) * 16];
        GAS bf16_t* Og = (GAS bf16_t*)O;
        if (sub == 2 || sub == 3) {
            const GAS f32x2* rotg = (const GAS f32x2*)rot + wc * 32 + 8 * fq;
#pragma unroll
            for (int ai = 0; ai < 2; ++ai) {
                f32x2 cs[4][2][4];
#pragma unroll
                for (int m = 0; m < 4; ++m) { const int row = row0 + ai * HALF + m * 16; const GAS f32x2* rp = rotg + (size_t)(row & (S_ - 1)) * 128;
#pragma unroll
                    for (int n = 0; n < 2; ++n)
#pragma unroll
                        for (int j = 0; j < 4; ++j) cs[m][n][j] = rp[n * 4 + j]; }
#pragma unroll
                for (int m = 0; m < 4; ++m) { const int row = row0 + ai * HALF + m * 16;
                    float ksc = rs8[ai * 4 + m];
                    if (sub == 3) { const float lgam = logf(1.0f - exp2f(-5.0f - (float)(u.pn - 8))); ksc *= 0.0625f * __expf(lgam * (float)(63 - (row & 63))); }
                    GAS bf16_t* rowp = Og + (size_t)row * ldc + colt;
                    u32x4 w1, w2;
#pragma unroll
                    for (int n = 0; n < 2; ++n) {
                        const f32x4 t1 = acc[ai][0][m][n] * ksc, t2 = acc[ai][1][m][n] * ksc;
                        f32x4 o1, o2;
#pragma unroll
                        for (int j = 0; j < 4; ++j) { const f32x2 c2 = cs[m][n][j]; o1[j] = t1[j] * c2.x - t2[j] * c2.y; o2[j] = t1[j] * c2.y + t2[j] * c2.x; }
                        w1[2 * n] = cvt_pk_bf16(o1[0], o1[1]); w1[2 * n + 1] = cvt_pk_bf16(o1[2], o1[3]); w2[2 * n] = cvt_pk_bf16(o2[0], o2[1]); w2[2 * n + 1] = cvt_pk_bf16(o2[2], o2[3]);
                    }
                    *(GAS u32x4*)(rowp) = w1; *(GAS u32x4*)(rowp + HALF) = w2;
                }
            }
        } else {
#pragma unroll
            for (int ai = 0; ai < 2; ++ai)
#pragma unroll
                for (int m = 0; m < 4; ++m) {
                    const int row = row0 + ai * HALF + m * 16;
                    const float rs = rs8[ai * 4 + m];
                    GAS bf16_t* rowp = Og + (size_t)row * ldc + colt;
#pragma unroll
                    for (int bj = 0; bj < 2; ++bj) {
                        u32x4 w;
#pragma unroll
                        for (int n = 0; n < 2; ++n) {
                            f32x4 v = acc[ai][bj][m][n] * rs;
                            if (sub == 1) {
#pragma unroll
                                for (int j = 0; j < 4; ++j) { const float r = fmaxf(v[j], 0.f); v[j] = r * r; }
                            } else if (sub == 4) {
#pragma unroll
                                for (int j = 0; j < 4; ++j) v[j] = v[j] / (1.0f + __expf(-v[j]));
                            }
                            w[2 * n] = cvt_pk_bf16(v[0], v[1]); w[2 * n + 1] = cvt_pk_bf16(v[2], v[3]);
                        }
                        *(GAS u32x4*)(rowp + bj * HALF) = w;
                    }
                }
        }
    }
};
struct EpiRes {
    const float* xin; float* xout; bf16_t* xb; float* ssn; int glu;
    __device__ __forceinline__ void operator()(const f32x4 (&acc)[2][2][4][2], const Unit& u, int wr, int wc, int fr, int fq, LAS unsigned char*, int) const {
        const int row0 = u.pm * BM + wr * 64 + fr;
        const GAS float* xi = (const GAS float*)xin; GAS float* xo = (GAS float*)xout; GAS bf16_t* xbg = (GAS bf16_t*)xb; GAS float* ssg = (GAS float*)ssn;
        if (glu) {
            const size_t cb = (size_t)u.pn * HALF + wc * 32 + 8 * fq;
#pragma unroll
            for (int ai = 0; ai < 2; ++ai) {
                f32x4 xv[4][2];
#pragma unroll
                for (int m = 0; m < 4; ++m)
#pragma unroll
                    for (int n = 0; n < 2; ++n) xv[m][n] = *(const GAS f32x4*)(xi + (size_t)(row0 + ai * HALF + m * 16) * D_ + cb + n * 4);
#pragma unroll
                for (int m = 0; m < 4; ++m) {
                    const int row = row0 + ai * HALF + m * 16; const size_t off = (size_t)row * D_ + cb;
                    float sq = 0.f; u32x4 w;
#pragma unroll
                    for (int n = 0; n < 2; ++n) {
                        const f32x4 va = acc[ai][0][m][n], ga = acc[ai][1][m][n];
                        f32x4 x4 = xv[m][n];
#pragma unroll
                        for (int j = 0; j < 4; ++j) { x4[j] += va[j] / (1.0f + __expf(-ga[j])); sq += x4[j] * x4[j]; }
                        *(GAS f32x4*)(xo + off + n * 4) = x4;
                        w[2 * n] = cvt_pk_bf16(x4[0], x4[1]); w[2 * n + 1] = cvt_pk_bf16(x4[2], x4[3]);
                    }
                    *(GAS u32x4*)(xbg + off) = w;
                    sq += __shfl_xor(sq, 16); sq += __shfl_xor(sq, 32);
                    if (fq == 0) atomicAdd((float*)ssn + (size_t)((u.pn >> 1) * 4 + wc) * T_ + row, sq);
                }
            }
        } else {
            const size_t cb = (size_t)u.pn * BM + wc * 32 + 8 * fq;
#pragma unroll
            for (int ai = 0; ai < 2; ++ai) {
                f32x4 xv[4][2][2];
#pragma unroll
                for (int m = 0; m < 4; ++m)
#pragma unroll
                    for (int bj = 0; bj < 2; ++bj)
#pragma unroll
                        for (int n = 0; n < 2; ++n) xv[m][bj][n] = *(const GAS f32x4*)(xi + (size_t)(row0 + ai * HALF + m * 16) * D_ + cb + bj * HALF + n * 4);
#pragma unroll
                for (int m = 0; m < 4; ++m) {
                    const int row = row0 + ai * HALF + m * 16; const size_t off = (size_t)row * D_ + cb;
                    float sq = 0.f;
#pragma unroll
                    for (int bj = 0; bj < 2; ++bj) {
                        u32x4 w;
#pragma unroll
                        for (int n = 0; n < 2; ++n) {
                            f32x4 x4 = xv[m][bj][n] + acc[ai][bj][m][n];
#pragma unroll
                            for (int j = 0; j < 4; ++j) sq += x4[j] * x4[j];
                            *(GAS f32x4*)(xo + off + bj * HALF + n * 4) = x4;
                            w[2 * n] = cvt_pk_bf16(x4[0], x4[1]); w[2 * n + 1] = cvt_pk_bf16(x4[2], x4[3]);
                        }
                        *(GAS u32x4*)(xbg + off + bj * HALF) = w;
                    }
                    sq += __shfl_xor(sq, 16); sq += __shfl_xor(sq, 32);
                    if (fq == 0) ssg[(size_t)(u.pn * 4 + wc) * T_ + row] = sq;
                }
            }
        }
    }
};

template <class Epi, class Sched>
__device__ __forceinline__ void gemm_phase(LAS unsigned char* lds, const Gemm g, const Sched& S, const Epi& E) {
    const int tid = otid(), wid = __builtin_amdgcn_readfirstlane(tid >> 6), lane = tid & 63, wr = wid >> 2, wc = wid & 3, fr = lane & 15, fq = lane >> 4;
    const int K = g.K, nt = K / BK;
    unsigned voffA[2], voffB[2];
#pragma unroll
    for (int i = 0; i < 2; ++i) { int R, C; stage_rc(tid * 16 + i * 8192, R, C); voffA[i] = (unsigned)(R * K + C) * 2u; voffB[i] = voffA[i]; }
    const size_t kstep = (size_t)(BK * 2);
    const size_t hstep = (size_t)HALF * K * 2;
    const size_t tstep = 2 * hstep;
    const unsigned ldsw = (unsigned)wid * 1024u;
    const int aoff = lds_byte(wr * 64 + fr, fq * 8), boff = lds_byte(wc * 32 + fr, fq * 8);
#define PG8_SA(b, h) (((b) * 2 + (h)) * HTB)
#define PG8_SB(b, h) ((4 + (b) * 2 + (h)) * HTB)
#define PG8_STAGE(bufoff, gbase, voff) do { _Pragma("unroll") for (int _i = 0; _i < 2; ++_i) \
        __builtin_amdgcn_global_load_lds((const unsigned*)((const char*)(gbase) + (voff)[_i]), (LAS unsigned*)(lds + (bufoff) + ldsw + _i * 8192), 16, 0, 0); } while (0)
#define PG8_LDA(dst, b, h) do { _Pragma("unroll") for (int m = 0; m < 4; ++m) _Pragma("unroll") for (int k = 0; k < 2; ++k) dst[m][k] = *(const LAS bf16x8*)(lds + PG8_SA(b, h) + aoff + m * 2048 + k * 1024); } while (0)
#define PG8_LDB(dst, b, h) do { _Pragma("unroll") for (int n = 0; n < 2; ++n) _Pragma("unroll") for (int k = 0; k < 2; ++k) dst[n][k] = *(const LAS bf16x8*)(lds + PG8_SB(b, h) + boff + n * 2048 + k * 1024); } while (0)
#define PG8_MMA(ai, bj, At, Bt) do { __builtin_amdgcn_s_setprio(1); _Pragma("unroll") for (int m = 0; m < 4; ++m) _Pragma("unroll") for (int n = 0; n < 2; ++n) _Pragma("unroll") for (int k = 0; k < 2; ++k) \
        acc[ai][bj][m][n] = __builtin_amdgcn_mfma_f32_16x16x32_bf16(Bt[n][k], At[m][k], acc[ai][bj][m][n], 0, 0, 0); __builtin_amdgcn_s_setprio(0); } while (0)
#define PG8_WAIT_V(n) asm volatile("s_waitcnt vmcnt(" #n ")" ::: "memory")
#define PG8_WAIT_L(n) asm volatile("s_waitcnt lgkmcnt(" #n ")" ::: "memory")
#define PG8_BAR __builtin_amdgcn_s_barrier()
#define PG8_SCHED __builtin_amdgcn_sched_barrier(0)
    Unit cur, nxt; int ui = 0;
    if (!S.next(0, cur)) return;
    f32x4 acc[2][2][4][2];
#pragma unroll
    for (int a = 0; a < 2; ++a)
#pragma unroll
        for (int b = 0; b < 2; ++b)
#pragma unroll
            for (int m = 0; m < 4; ++m)
#pragma unroll
                for (int n = 0; n < 2; ++n) acc[a][b][m][n] = (f32x4){0.f, 0.f, 0.f, 0.f};
    bf16x8 At[4][2], B0[2][2], B1[2][2];
    const char* cA = (const char*)g.A + (size_t)cur.pm * tstep; const char* cB = (const char*)g.Bt + (size_t)cur.pn * tstep;
    PG8_STAGE(PG8_SB(0, 0), cB, voffB); PG8_STAGE(PG8_SA(0, 0), cA, voffA); PG8_STAGE(PG8_SB(0, 1), cB + hstep, voffB); PG8_STAGE(PG8_SA(0, 1), cA + hstep, voffA);
    if (wr == 1) PG8_BAR;
    PG8_WAIT_V(4); PG8_BAR;
    PG8_STAGE(PG8_SB(1, 0), cB + kstep, voffB); PG8_STAGE(PG8_SA(1, 0), cA + kstep, voffA); PG8_STAGE(PG8_SB(1, 1), cB + hstep + kstep, voffB);
    PG8_WAIT_V(6); PG8_BAR;
    for (;;) {
        const bool has_next = S.next(ui + 1, nxt);
        const char* nA = has_next ? (const char*)g.A + (size_t)nxt.pm * tstep : cA; const char* nB = has_next ? (const char*)g.Bt + (size_t)nxt.pn * tstep : cB;
        for (int t = 0; t < nt; t += 2) {
            const bool last = (t == nt - 2);
            const char* a1 = cA + (size_t)(t + 1) * kstep;
            const char* a2 = last ? nA : cA + (size_t)(t + 2) * kstep; const char* b2 = last ? nB : cB + (size_t)(t + 2) * kstep;
            const char* a3 = a2 + kstep; const char* b3 = b2 + kstep;
            PG8_LDB(B0, 0, 0); PG8_SCHED; PG8_LDA(At, 0, 0); PG8_STAGE(PG8_SA(1, 1), a1 + hstep, voffA);
            PG8_WAIT_L(8); PG8_BAR; PG8_WAIT_L(0); PG8_MMA(0, 0, At, B0); PG8_BAR; PG8_SCHED;
            PG8_LDB(B1, 0, 1); PG8_STAGE(PG8_SB(0, 0), b2, voffB);
            PG8_BAR; PG8_WAIT_L(0); PG8_MMA(0, 1, At, B1); PG8_BAR;
            PG8_LDA(At, 0, 1); PG8_STAGE(PG8_SA(0, 0), a2, voffA);
            PG8_BAR; PG8_WAIT_L(0); PG8_MMA(1, 0, At, B0); PG8_BAR; PG8_SCHED;
            PG8_STAGE(PG8_SB(0, 1), b2 + hstep, voffB);
            PG8_WAIT_V(6); PG8_BAR; PG8_MMA(1, 1, At, B1); PG8_BAR;
            PG8_LDB(B0, 1, 0); PG8_SCHED; PG8_LDA(At, 1, 0); PG8_STAGE(PG8_SA(0, 1), a2 + hstep, voffA);
            PG8_WAIT_L(8); PG8_BAR; PG8_WAIT_L(0); PG8_MMA(0, 0, At, B0); PG8_BAR; PG8_SCHED;
            PG8_LDB(B1, 1, 1); PG8_STAGE(PG8_SB(1, 0), b3, voffB);
            PG8_BAR; PG8_WAIT_L(0); PG8_MMA(0, 1, At, B1); PG8_BAR;
            PG8_LDA(At, 1, 1); PG8_STAGE(PG8_SA(1, 0), a3, voffA);
            PG8_BAR; PG8_WAIT_L(0); PG8_MMA(1, 0, At, B0); PG8_BAR; PG8_SCHED;
            PG8_STAGE(PG8_SB(1, 1), b3 + hstep, voffB);
            PG8_WAIT_V(6); PG8_BAR; PG8_MMA(1, 1, At, B1); PG8_BAR;
        }
        E(acc, cur, wr, wc, fr, fq, lds, ui);
        if (!has_next) break;
#pragma unroll
        for (int a = 0; a < 2; ++a)
#pragma unroll
            for (int b = 0; b < 2; ++b)
#pragma unroll
                for (int m = 0; m < 4; ++m)
#pragma unroll
                    for (int n = 0; n < 2; ++n) acc[a][b][m][n] = (f32x4){0.f, 0.f, 0.f, 0.f};
        cur = nxt; cA = nA; cB = nB; ++ui;
    }
    PG8_WAIT_V(0);
    if (wr == 0) PG8_BAR;
    PG8_BAR;
#undef PG8_SA
#undef PG8_SB
#undef PG8_STAGE
#undef PG8_LDA
#undef PG8_LDB
#undef PG8_MMA
#undef PG8_WAIT_V
#undef PG8_WAIT_L
#undef PG8_BAR
#undef PG8_SCHED
}
}

namespace att {
constexpr int D = 128, KVBLK = 64, LDK = 6144;
constexpr float SCALE = 0.088388347648318440f;
constexpr float THR = 8.f;
constexpr size_t SHM_V = KVBLK * D * 2, SHM_K = KVBLK * D * 2;
#define KSWZ(row, colB) ((row) * 256 + ((colB) ^ (((row) & 7) << 4)))
#define SBAR() __builtin_amdgcn_sched_barrier(0)
__device__ __forceinline__ int crow(int r, int hi) { return (r & 3) + 8 * (r >> 2) + 4 * hi; }
__device__ __forceinline__ void partialSM(f32x16& p0, f32x16& p1, float& m_reg, float& mn, float& alpha, bool msk) {
    constexpr float C = SCALE * 1.4426950408889634f;
    if (msk) {
#pragma unroll
        for (int r = 0; r < 16; ++r) { p0[r] = -1e30f; p1[r] = -1e30f; }
    }
    float pmax = p0[0];
#pragma unroll
    for (int r = 1; r < 16; ++r) pmax = fmaxf(pmax, p0[r]);
#pragma unroll
    for (int r = 0; r < 16; ++r) pmax = fmaxf(pmax, p1[r]);
    { auto rr = __builtin_amdgcn_permlane32_swap(__float_as_uint(pmax), __float_as_uint(pmax), false, false);
      pmax = fmaxf(__uint_as_float(rr[0]), __uint_as_float(rr[1])); }
    if (__builtin_expect(__all(pmax - m_reg <= THR / SCALE), 1)) { mn = m_reg; alpha = 1.f; }
    else { mn = fmaxf(m_reg, pmax); alpha = __builtin_amdgcn_exp2f((m_reg - mn) * C); m_reg = mn; }
    float mnC = -mn * C;
#pragma unroll
    for (int r = 0; r < 16; ++r) p0[r] = fmaf(p0[r], C, mnC);
#pragma unroll
    for (int r = 0; r < 16; ++r) p1[r] = fmaf(p1[r], C, mnC);
#pragma unroll
    for (int r = 0; r < 16; ++r) p0[r] = __builtin_amdgcn_exp2f(p0[r]);
}
__device__ __forceinline__ void finishSM(f32x16& p0, f32x16& p1, float alpha, float& l_reg, bf16x8& pa0, bf16x8& pa1, bf16x8& pa2, bf16x8& pa3) {
#pragma unroll
    for (int r = 0; r < 16; ++r) p1[r] = __builtin_amdgcn_exp2f(p1[r]);
    float ps = 0;
#pragma unroll
    for (int r = 0; r < 16; ++r) ps += p0[r];
#pragma unroll
    for (int r = 0; r < 16; ++r) ps += p1[r];
    { auto rr = __builtin_amdgcn_permlane32_swap(__float_as_uint(ps), __float_as_uint(ps), false, false);
      ps = __uint_as_float(rr[0]) + __uint_as_float(rr[1]); }
    l_reg = l_reg * alpha + ps;
#define PK4(P, BASE, OUT) do { unsigned a0 = cvt_pk_bf16(P[BASE + 0], P[BASE + 1]), a1 = cvt_pk_bf16(P[BASE + 2], P[BASE + 3]);   \
    unsigned b0 = cvt_pk_bf16(P[BASE + 4], P[BASE + 5]), b1 = cvt_pk_bf16(P[BASE + 6], P[BASE + 7]);                              \
    auto r0 = __builtin_amdgcn_permlane32_swap(a0, b0, false, false); auto r1 = __builtin_amdgcn_permlane32_swap(a1, b1, false, false); \
    u32x4 w = {r0[0], r1[0], r0[1], r1[1]}; OUT = *reinterpret_cast<bf16x8*>(&w); } while (0)
    PK4(p0, 0, pa0); PK4(p0, 8, pa1); PK4(p1, 0, pa2); PK4(p1, 8, pa3);
#undef PK4
}
__device__ __forceinline__ void qkt(f32x16& p0, f32x16& p1, const char* Ks, const bf16x8* qr, int r32, int hi) {
    p0 = f32x16{}; p1 = f32x16{};
#pragma unroll
    for (int d0 = 0; d0 < 8; ++d0) { int cb = (d0 * 16 + hi * 8) * 2;
        bf16x8 b0 = *reinterpret_cast<const bf16x8*>(Ks + KSWZ(r32, cb));
        bf16x8 b1 = *reinterpret_cast<const bf16x8*>(Ks + KSWZ(32 + r32, cb));
        p0 = __builtin_amdgcn_mfma_f32_32x32x16_bf16(b0, qr[d0], p0, 0, 0, 0);
        p1 = __builtin_amdgcn_mfma_f32_32x32x16_bf16(b1, qr[d0], p1, 0, 0, 0); }
}
__device__ __forceinline__ int v_st(int k, int c) { const int kk = (k & ~0xC) | ((k & 4) << 1) | ((k & 8) >> 1); return ((kk >> 3) * 4 + (c >> 5)) * 512 + ((kk & 7) * 32 + (c & 31)) * 2; }
__device__ __forceinline__ int v_rd_base(int lane) { return ((lane & 3) << 3) | (((lane >> 2) & 3) << 6) | (((lane >> 4) & 1) << 5) | (((lane >> 5) & 1) << 8); }
constexpr int v_rd_off(int d0, int ks, int half) { return d0 * 512 + ks * 4096 + half * 2048; }
template <int OFF> __device__ __forceinline__ s16x4 tr_read(int vb) {
    s16x4 r; asm volatile("ds_read_b64_tr_b16 %0, %1 offset:%2" : "=&v"(r) : "v"(vb), "i"(OFF) : "memory"); return r;
}
template <int D0> __device__ __forceinline__ void pv_one(f32x16& od, int vb, bf16x8 pa0, bf16x8 pa1, bf16x8 pa2, bf16x8 pa3) {
    const s16x4 l0 = tr_read<v_rd_off(D0, 0, 0)>(vb), h0 = tr_read<v_rd_off(D0, 0, 1)>(vb), l1 = tr_read<v_rd_off(D0, 1, 0)>(vb), h1 = tr_read<v_rd_off(D0, 1, 1)>(vb);
    const s16x4 l2 = tr_read<v_rd_off(D0, 2, 0)>(vb), h2 = tr_read<v_rd_off(D0, 2, 1)>(vb), l3 = tr_read<v_rd_off(D0, 3, 0)>(vb), h3 = tr_read<v_rd_off(D0, 3, 1)>(vb);
    asm volatile("s_waitcnt lgkmcnt(0)" ::: "memory"); SBAR();
#define PK(L, H) (bf16x8){L[0], L[1], L[2], L[3], H[0], H[1], H[2], H[3]}
    od = __builtin_amdgcn_mfma_f32_32x32x16_bf16(pa0, PK(l0, h0), od, 0, 0, 0);
    od = __builtin_amdgcn_mfma_f32_32x32x16_bf16(pa1, PK(l1, h1), od, 0, 0, 0);
    od = __builtin_amdgcn_mfma_f32_32x32x16_bf16(pa2, PK(l2, h2), od, 0, 0, 0);
    od = __builtin_amdgcn_mfma_f32_32x32x16_bf16(pa3, PK(l3, h3), od, 0, 0, 0);
#undef PK
}
__device__ __forceinline__ void pv_d0(f32x16* o, int vb, bf16x8 pa0, bf16x8 pa1, bf16x8 pa2, bf16x8 pa3) {
    pv_one<0>(o[0], vb, pa0, pa1, pa2, pa3); pv_one<1>(o[1], vb, pa0, pa1, pa2, pa3); pv_one<2>(o[2], vb, pa0, pa1, pa2, pa3); pv_one<3>(o[3], vb, pa0, pa1, pa2, pa3);
}
__device__ __forceinline__ void attn_body(const bf16_t* __restrict__ Qb, const bf16_t* __restrict__ Kh, const bf16_t* __restrict__ Vh, int NT, int ntw, char* lds, f32x16 (&o)[4]) {
    const int tid = otid(), wid = __builtin_amdgcn_readfirstlane(tid >> 6), lane = tid & 63, r32 = lane & 31, hi = lane >> 5;
    char* V_lds = lds; char* K_lds = lds + 2 * SHM_V;
    float* wsf = (float*)(lds + 2 * SHM_V + 2 * SHM_K) + wid * 64; float* li_l = wsf; float* al_l = wsf + 32;
    float m_reg = -1e30f, l_reg = 0; bf16x8 qr[8];
#pragma unroll
    for (int d = 0; d < 4; ++d) o[d] = f32x16{};
    const bf16_t* Qw = Qb + (long)(wid * 32 + r32) * LDK + hi * 8;
#pragma unroll
    for (int d0 = 0; d0 < 8; ++d0) qr[d0] = *reinterpret_cast<const bf16x8*>(Qw + d0 * 16);
    const int sr = tid >> 4, sc = (tid & 15) * 8, vst0 = v_st(sr, sc), vst1 = v_st(32 + sr, sc);
    const int vb0 = (int)(uintptr_t)V_lds + v_rd_base(lane);
    struct { bf16x8 vs0, vs1, ks0, ks1; } sr_[2];
#define SLOAD(i, k0) do { sr_[i].vs0 = *reinterpret_cast<const bf16x8*>(&Vh[(long)((k0) + sr) * LDK + sc]); sr_[i].vs1 = *reinterpret_cast<const bf16x8*>(&Vh[(long)((k0) + 32 + sr) * LDK + sc]); \
    sr_[i].ks0 = *reinterpret_cast<const bf16x8*>(&Kh[(long)((k0) + sr) * LDK + sc]); sr_[i].ks1 = *reinterpret_cast<const bf16x8*>(&Kh[(long)((k0) + 32 + sr) * LDK + sc]); } while (0)
#define SWRITE(b, i) do { *(bf16x8*)(V_lds + (b) * SHM_V + vst0) = sr_[i].vs0;          \
    *(bf16x8*)(V_lds + (b) * SHM_V + vst1) = sr_[i].vs1; int kc = sc * 2;               \
    *(bf16x8*)(K_lds + (b) * SHM_K + KSWZ(sr, kc)) = sr_[i].ks0;                       \
    *(bf16x8*)(K_lds + (b) * SHM_K + KSWZ(32 + sr, kc)) = sr_[i].ks1; } while (0)
#define SWAIT() asm volatile("s_waitcnt vmcnt(4)" ::: "memory")
#define RESC(a) do { if (__any((a) < 1.f)) { if (hi == 0) al_l[r32] = (a); asm volatile("s_waitcnt lgkmcnt(0)" ::: "memory"); \
    _Pragma("unroll") for (int d = 0; d < 4; ++d) _Pragma("unroll") for (int r = 0; r < 16; ++r) o[d][r] *= al_l[crow(r, hi)]; } } while (0)
    f32x16 pA0, pA1, pB0, pB1; float mnA, mnB, alA, alB; bf16x8 pa0, pa1, pa2, pa3;
    constexpr int SE = 0, SO = 1;
    __syncthreads();
    SLOAD(SE, 0); SLOAD(SO, KVBLK); SWAIT(); SWRITE(0, SE); __syncthreads();
    qkt(pA0, pA1, K_lds, qr, r32, hi); partialSM(pA0, pA1, m_reg, mnA, alA, false);
    if (2 < NT) SLOAD(SE, 2 * KVBLK);
    SWAIT(); SWRITE(1, SO); __syncthreads();
    for (int j = 1; j + 1 < NT; j += 2) {
        SBAR(); qkt(pB0, pB1, K_lds + SHM_K, qr, r32, hi);
        finishSM(pA0, pA1, alA, l_reg, pa0, pa1, pa2, pa3); SBAR();
        SLOAD(SO, (j + 2) * KVBLK); SBAR();
        pv_d0(o, vb0, pa0, pa1, pa2, pa3); partialSM(pB0, pB1, m_reg, mnB, alB, j >= ntw);
        __syncthreads(); SWAIT(); SWRITE(0, SE);
        RESC(alB); __syncthreads();
        SBAR(); qkt(pA0, pA1, K_lds, qr, r32, hi);
        finishSM(pB0, pB1, alB, l_reg, pa0, pa1, pa2, pa3); SBAR();
        if (j + 3 < NT) SLOAD(SE, (j + 3) * KVBLK); SBAR();
        pv_d0(o, vb0 + (int)SHM_V, pa0, pa1, pa2, pa3); partialSM(pA0, pA1, m_reg, mnA, alA, (j + 1) >= ntw);
        __syncthreads(); SWAIT(); SWRITE(1, SO);
        RESC(alA); __syncthreads();
    }
    SBAR(); qkt(pB0, pB1, K_lds + SHM_K, qr, r32, hi);
    finishSM(pA0, pA1, alA, l_reg, pa0, pa1, pa2, pa3); SBAR();
    pv_d0(o, vb0, pa0, pa1, pa2, pa3); partialSM(pB0, pB1, m_reg, mnB, alB, (NT - 1) >= ntw);
    __syncthreads(); RESC(alB);
    finishSM(pB0, pB1, alB, l_reg, pa0, pa1, pa2, pa3); SBAR();
    pv_d0(o, vb0 + (int)SHM_V, pa0, pa1, pa2, pa3);
    if (hi == 0) li_l[r32] = l_reg; asm volatile("s_waitcnt lgkmcnt(0)" ::: "memory");
#pragma unroll
    for (int r = 0; r < 16; ++r) { const float rl = __builtin_amdgcn_rcpf(li_l[crow(r, hi)]);
#pragma unroll
        for (int d = 0; d < 4; ++d) o[d][r] *= rl; }
#undef SLOAD
#undef SWRITE
#undef SWAIT
#undef RESC
}
}

__device__ __forceinline__ void sincos_red(double ang, float& s, float& c) {
    const double k = rint(ang * 0.15915494309189535);
    const float r = (float)(ang - k * 6.283185307179586);
    s = __sinf(r); c = __cosf(r);
}
__device__ __forceinline__ float gelu_tanh(float y) {
    const float z = 0.7978845608028654f * (y + 0.044715f * y * y * y);
    const float th = 1.0f - 2.0f / (1.0f + __expf(2.0f * z));
    return 0.5f * y * (1.0f + th);
}

struct ConvJob { const float* W; bf16_t* Wt; const float* gain; int K, N, glu, tile; };
struct ConvRegs { f32x4 va[4], vb[4]; float ga[4], gb[4]; };
__device__ __forceinline__ ConvJob conv_decode(const Params& p, unsigned char* ws, int t) {
    ConvJob j; j.glu = 0; j.gain = nullptr;
    if (t < 1536) { const int q = t / 768; j.tile = t - q * 768; j.W = p.a_w_in + (size_t)q * 2048 * 6144; j.Wt = (bf16_t*)(ws + OFF_WT_A_IN + q * SZ_A_IN); j.K = 2048; j.N = 6144; j.gain = p.norm_mix + (size_t)(3 * q) * D_; }
    else if (t < 2048) { const int u = t - 1536; const int q = u / 256; j.tile = u - q * 256; j.W = p.a_w_out + (size_t)q * 2048 * 2048; j.Wt = (bf16_t*)(ws + OFF_WT_A_OUT + q * SZ_A_OUT); j.K = 2048; j.N = 2048; }
    else if (t < 2560) { j.tile = t - 2048; j.W = p.b_w_glu; j.Wt = (bf16_t*)(ws + OFF_WT_GLU); j.K = 2048; j.N = 4096; j.glu = 1; }
    else if (t < 4096) { j.tile = t - 2560; j.W = p.c_w_in; j.Wt = (bf16_t*)(ws + OFF_WT_C_IN); j.K = 2048; j.N = 12288; j.gain = p.norm_mix + 2 * D_; }
    else if (t < 4608) { j.tile = t - 4096; j.W = p.c_w_out; j.Wt = (bf16_t*)(ws + OFF_WT_C_OUT); j.K = 4096; j.N = 2048; }
    else if (t < 8704) { const int u = t - 4608; const int i = u / 1024; j.tile = u - i * 1024; j.W = p.mlp_w1 + (size_t)i * 2048 * 8192; j.Wt = (bf16_t*)(ws + OFF_WT_W1 + i * SZ_W1); j.K = 2048; j.N = 8192; j.gain = p.norm_mlp + (size_t)i * D_; }
    else { const int u = t - 8704; const int i = u / 1024; j.tile = u - i * 1024; j.W = p.mlp_w2 + (size_t)i * 8192 * 2048; j.Wt = (bf16_t*)(ws + OFF_WT_W2 + i * SZ_W1); j.K = 8192; j.N = 2048; }
    return j;
}
__device__ __forceinline__ void conv_load(const ConvJob& j, ConvRegs& r, int tid) {
    const int ntn = j.N >> 7; const int tk = j.tile / ntn, tn = j.tile - tk * ntn; const int k0 = tk << 7, n0 = tn << 7;
    const int kp = tid >> 5, nl = (tid & 31) << 2;
#pragma unroll
    for (int i = 0; i < 4; ++i) { const int k = 2 * (kp + 16 * i);
        r.va[i] = *(const f32x4*)(j.W + (size_t)(k0 + k) * j.N + n0 + nl); r.vb[i] = *(const f32x4*)(j.W + (size_t)(k0 + k + 1) * j.N + n0 + nl);
        r.ga[i] = j.gain ? j.gain[k0 + k] : 1.f; r.gb[i] = j.gain ? j.gain[k0 + k + 1] : 1.f; }
}
__device__ __forceinline__ void conv_store(const ConvJob& j, const ConvRegs& r, int tid, unsigned* ldsw) {
    const int ntn = j.N >> 7; const int tk = j.tile / ntn, tn = j.tile - tk * ntn; const int k0 = tk << 7, n0 = tn << 7;
    const int kp = tid >> 5, nl = (tid & 31) << 2;
    __syncthreads();
#pragma unroll
    for (int i = 0; i < 4; ++i) { const int kpair = kp + 16 * i;
#pragma unroll
        for (int jj = 0; jj < 4; ++jj) ldsw[(nl + jj) * 65 + kpair] = cvt_pk_bf16(r.va[i][jj] * r.ga[i], r.vb[i][jj] * r.gb[i]); }
    __syncthreads();
    int nbase = n0;
    if (j.glu) { const int bj = n0 >> 11, pn = (n0 & 2047) >> 7; nbase = 256 * pn + 128 * bj; }
#pragma unroll
    for (int i = 0; i < 4; ++i) { const int n = (tid >> 4) + 32 * i, k8 = tid & 15;
        u32x4 w; w.x = ldsw[n * 65 + k8 * 4 + 0]; w.y = ldsw[n * 65 + k8 * 4 + 1]; w.z = ldsw[n * 65 + k8 * 4 + 2]; w.w = ldsw[n * 65 + k8 * 4 + 3];
        const int c5 = n & 31, np = (n & ~31) | (16 * ((c5 >> 2) & 1) + 4 * (c5 >> 3) + (c5 & 3));
        *(u32x4*)(j.Wt + (size_t)(nbase + np) * j.K + k0 + k8 * 8) = w; }
}

__device__ __forceinline__ void prep_phase(const Params& p, unsigned char* shm) {
    const int tid = otid(), bid = obid(), G = gridDim.x;
    unsigned char* ws = p.ws;
    {
        ConvJob jc = conv_decode(p, ws, bid); ConvRegs rc; conv_load(jc, rc, tid);
#pragma unroll 1
        for (int t = bid; t < 12800; t += G) {
            ConvJob jn = jc; ConvRegs rn = rc;
            if (t + G < 12800) { jn = conv_decode(p, ws, t + G); conv_load(jn, rn, tid); }
            conv_store(jc, rc, tid, (unsigned*)shm);
            jc = jn; rc = rn;
        }
    }
    {
        float* ss = (float*)(ws + OFF_SSP); bf16_t* xb = (bf16_t*)(ws + OFF_XB);
        const int wid = tid >> 6, lane = tid & 63;
        for (int row = bid * 8 + wid; row < T_; row += G * 8) {
            const float* xr = p.x + (size_t)row * D_; float sq = 0.f;
#pragma unroll
            for (int i = 0; i < 8; ++i) { const f32x4 v = *(const f32x4*)(xr + (i * 64 + lane) * 4);
                sq += v[0] * v[0] + v[1] * v[1] + v[2] * v[2] + v[3] * v[3];
                *(f32x4*)(p.out + (size_t)row * D_ + (i * 64 + lane) * 4) = v;
                u32x2 w; w.x = cvt_pk_bf16(v[0], v[1]); w.y = cvt_pk_bf16(v[2], v[3]);
                *(u32x2*)(xb + (size_t)row * D_ + (i * 64 + lane) * 4) = w; }
#pragma unroll
            for (int o = 32; o > 0; o >>= 1) sq += __shfl_xor(sq, o);
            if (lane < 32) ss[(size_t)lane * T_ + row] = (lane == 0) ? sq : 0.f;
        }
        for (int i = bid * 512 + tid; i < 32 * T_; i += G * 512) ss[(size_t)3 * 32 * T_ + i] = 0.f;
        float* rssq = (float*)(ws + OFF_RSQP);
        for (int i = bid * 512 + tid; i < 64 * T_; i += G * 512) rssq[i] = 0.f;
    }
    {
        float* par = (float*)(ws + OFF_PAR);
        for (int i = bid * 512 + tid; i < PAR_N; i += G * 512) {
            float v;
            if (i < PAR_NFINAL) v = p.norm_mix[D_ + i];
            else if (i < PAR_LAM) v = p.norm_final[i - PAR_NFINAL];
            else if (i < PAR_SUBLN) v = p.a_lambda[i - PAR_LAM];
            else if (i < PAR_BD) v = p.a_subln[i - PAR_SUBLN];
            else v = p.b_d[i - PAR_BD];
            par[i] = v;
        }
    }
    {
        f32x2* rot = (f32x2*)(ws + OFF_ROT);
        for (int i = bid * 512 + tid; i < 4096 * 128; i += G * 512) {
            const int pos = i >> 7, j = i & 127;
            const double inv = exp(-9.210340371976184 * ((double)j / 127.0));
            float s, c; sincos_red((double)pos * inv, s, c);
            f32x2 v; v.x = c; v.y = s; rot[i] = v;
        }
    }
    {
        bf16_t* Bm = (bf16_t*)(ws + OFF_S5B); bf16_t* Cm = (bf16_t*)(ws + OFF_S5C); f32x2* AB = (f32x2*)(ws + OFF_S5AB);
        const float* gmix = p.norm_mix + 1 * D_;
        for (int i = bid * 512 + tid; i < 128 * 64; i += G * 512) {
            const int g = i >> 6, pp = i & 63;
            const float lre = p.b_a_re[i], lim = p.b_a_im[i];
            const float dt = __expf(p.b_log_dt[g]);
            const float mag = __expf(lre * dt);
            float sn, cs; sincos_red((double)lim * (double)dt, sn, cs);
            const float abr = mag * cs, abi = mag * sn;
            const float den = lre * lre + lim * lim;
            const float nr = abr - 1.0f, ni = abi;
            const float cr_ = (nr * lre + ni * lim) / den, ci_ = (ni * lre - nr * lim) / den;
            f32x2 ab; ab.x = abr; ab.y = abi; AB[i] = ab;
#pragma unroll
            for (int c = 0; c < 16; ++c) {
                const float br = p.b_b_re[(size_t)i * 16 + c], bi = p.b_b_im[(size_t)i * 16 + c];
                const float gm = gmix[g * 16 + c];
                Bm[((size_t)g * 128 + pp) * 16 + c] = f2bf((cr_ * br - ci_ * bi) * gm);
                Bm[((size_t)g * 128 + 64 + pp) * 16 + c] = f2bf((cr_ * bi + ci_ * br) * gm);
                Cm[((size_t)g * 16 + c) * 128 + 2 * pp] = f2bf(p.b_c_re[((size_t)g * 16 + c) * 64 + pp]);
                Cm[((size_t)g * 16 + c) * 128 + 2 * pp + 1] = f2bf(-p.b_c_im[((size_t)g * 16 + c) * 64 + pp]);
            }
        }
    }
}

__device__ __forceinline__ void attn_phase(const Params& p, int j, float lambda_init, unsigned char* shm) {
    const int tid = otid(), wid = __builtin_amdgcn_readfirstlane(tid >> 6), lane = tid & 63, r32 = lane & 31, hi = lane >> 5;
    const bf16_t* qkv = (const bf16_t*)(p.ws + OFF_BIG);
    bf16_t* oa = (bf16_t*)(p.ws + OFF_OA);
    float* scr = (float*)(p.ws + OFF_ATT_SCR) + (size_t)obid() * 2 * 32768;
    float lam;
    { const float* lp = (const float*)(p.ws + OFF_PAR) + PAR_LAM + (size_t)j * 512;
      float a = lp[lane] * lp[128 + lane] + lp[64 + lane] * lp[192 + lane];
      float b = lp[256 + lane] * lp[384 + lane] + lp[320 + lane] * lp[448 + lane];
#pragma unroll
      for (int o = 32; o > 0; o >>= 1) { a += __shfl_xor(a, o); b += __shfl_xor(b, o); }
      lam = __expf(a) - __expf(b) + lambda_init; lam = __uint_as_float(__builtin_amdgcn_readfirstlane(__float_as_uint(lam))); }
    const float* sub = (const float*)(p.ws + OFF_PAR) + PAR_SUBLN + (size_t)j * 256;
    const int c = obid(); const int xcd = c & 7, jj = c >> 3;
    const int bh = xcd * 4 + (jj >> 3), pi = jj & 7;
    const int b = bh >> 3, h = bh & 7;
#pragma unroll 1
    for (int it = 0; it < 2; ++it) {
        const int qb = it == 0 ? (15 - pi) : pi;
        const int NT = 4 * qb + 4, ntw = 4 * qb + (wid >> 1) + 1;
        const size_t tok0 = (size_t)b * S_ + (size_t)qb * 256;
        f32x16 o[4];
#pragma unroll 1
        for (int ps = 0; ps < 4; ++ps) {
            const int e = ps >> 1, t = ps & 1;
            float* sc = scr + e * 32768;
            att::attn_body(qkv + tok0 * 6144 + h * 256 + t * 128, qkv + (size_t)b * S_ * 6144 + 2048 + h * 256 + t * 128,
                           qkv + (size_t)b * S_ * 6144 + 4096 + h * 256 + e * 128, NT, ntw, (char*)shm, o);
            float* scb = sc + tid * 4; asm volatile("" : "+v"(scb));
            if (t == 0) {
#pragma unroll
                for (int d = 0; d < 4; ++d)
#pragma unroll
                    for (int q = 0; q < 4; ++q) { const f32x4 v = {o[d][4 * q], o[d][4 * q + 1], o[d][4 * q + 2], o[d][4 * q + 3]}; *(f32x4*)(scb + (d * 4 + q) * 2048) = v; }
            } else {
#pragma unroll
                for (int d = 0; d < 4; ++d)
#pragma unroll
                    for (int q = 0; q < 4; ++q) { f32x4 c = *(const f32x4*)(scb + (d * 4 + q) * 2048);
#pragma unroll
                        for (int k = 0; k < 4; ++k) { const float cv = c[k] - lam * o[d][4 * q + k]; o[d][4 * q + k] = cv; c[k] = cv; }
                        if (e == 0) *(f32x4*)(scb + (d * 4 + q) * 2048) = c; }
            }
        }
        float ssq[16]; f32x16 c0v[4];
        const float* scb0 = scr + tid * 4; asm volatile("" : "+v"(scb0));
#pragma unroll
        for (int d = 0; d < 4; ++d)
#pragma unroll
            for (int q = 0; q < 4; ++q) { const f32x4 c = *(const f32x4*)(scb0 + (d * 4 + q) * 2048);
#pragma unroll
                for (int k = 0; k < 4; ++k) c0v[d][4 * q + k] = c[k]; }
#pragma unroll
        for (int r = 0; r < 16; ++r) { float s = 0.f;
#pragma unroll
            for (int d = 0; d < 4; ++d) { const float c0 = c0v[d][r]; s += c0 * c0 + o[d][r] * o[d][r]; }
#pragma unroll
            for (int of = 16; of > 0; of >>= 1) s += __shfl_xor(s, of);
            ssq[r] = rsqrtf(s * (1.0f / 256.0f) + EPS_) * (1.0f - lambda_init); }
        {
            bf16_t* Lw = (bf16_t*)(shm + 67584) + wid * (32 * 136);
#pragma unroll
            for (int eh = 0; eh < 2; ++eh) {
#pragma unroll
                for (int r = 0; r < 16; ++r)
#pragma unroll
                    for (int d = 0; d < 4; ++d) { const int col = d * 32 + r32;
                        const float v = (eh == 0 ? c0v[d][r] : o[d][r]) * ssq[r] * sub[eh * 128 + col];
                        Lw[att::crow(r, hi) * 136 + col] = f2bf(v); }
                asm volatile("s_waitcnt lgkmcnt(0)" ::: "memory");
#pragma unroll
                for (int k = 0; k < 8; ++k) { const int rw = 4 * k + (lane >> 4), pc = lane & 15;
                    const u32x4 w = *(const u32x4*)(Lw + rw * 136 + pc * 8);
                    *(u32x4*)(oa + (tok0 + wid * 32 + rw) * D_ + h * 256 + eh * 128 + pc * 8) = w; }
                asm volatile("s_waitcnt lgkmcnt(0)" ::: "memory");
            }
        }
    }
}

template <bool FINAL>
__device__ __forceinline__ void s5_phase(const Params& p, unsigned char* shm) {
    const int tid = otid(), wid = tid >> 6, lane = tid & 63, r32 = lane & 31, hi = lane >> 5, fr = lane & 15, fq = lane >> 4;
    const bf16_t* xb = (const bf16_t*)(p.ws + OFF_XB);
    const float* ss = (const float*)(p.ws + OFF_SSP) + (size_t)2 * 32 * T_;
    float* rsfin = (float*)(p.ws + OFF_RSFIN);
    const bf16_t* Bm = (const bf16_t*)(p.ws + OFF_S5B); const bf16_t* Cm = (const bf16_t*)(p.ws + OFF_S5C); const f32x2* AB = (const f32x2*)(p.ws + OFF_S5AB);
    f32x2* E = (f32x2*)(p.ws + OFF_BIG);
    bf16_t* gl = (bf16_t*)(p.ws + OFF_OA);
    bf16_t* Xs = (bf16_t*)shm + wid * (32 * 136);
    const float* gmix = (const float*)(p.ws + OFF_PAR) + PAR_GMIX; const float* dsk = (const float*)(p.ws + OFF_PAR) + PAR_BD;
    float* partL = (float*)(shm + 8 * 8704); float* rsL = partL + 512;
#pragma unroll 1
    for (int bc = obid(); bc < 256; bc += gridDim.x) {
      const int chunk = bc & 63, b = bc >> 6;
      const size_t t0 = (size_t)b * S_ + chunk * 64;
      __syncthreads();
      if (FINAL) { if (tid < 64) rsL[tid] = rsfin[t0 + tid]; }
      else {
          { const int row = tid & 63, part = tid >> 6; float a = 0.f;
#pragma unroll
            for (int k = 0; k < 4; ++k) a += ss[(size_t)(part * 4 + k) * T_ + t0 + row];
            partL[part * 64 + row] = a; }
          __syncthreads();
          if (tid < 64) { float tot = 0.f;
#pragma unroll
              for (int k = 0; k < 8; ++k) tot += partL[k * 64 + tid];
              const float r = rsqrtf(tot * (1.0f / D_) + EPS_); rsL[tid] = r; rsfin[t0 + tid] = r; }
      }
      __syncthreads();
#pragma unroll 1
      for (int goct = 0; goct < 16; ++goct) {
        const int g = goct * 8 + wid; const int pp = r32 + 32 * hi;
        const f32x2 ab = AB[g * 64 + pp];
        bf16x8 bfr[4];
#pragma unroll
        for (int nb = 0; nb < 4; ++nb) bfr[nb] = *(const bf16x8*)(Bm + ((size_t)g * 128 + nb * 32 + r32) * 16 + hi * 8);
        float xr = 0.f, xi = 0.f;
        bf16x8 cfr[4]; float gm4[4], ds4[4];
        if (FINAL) {
            { const f32x2 cin = E[((size_t)(b * 128 + g) * 64 + chunk) * 64 + pp]; xr = cin.x; xi = cin.y; }
#pragma unroll
            for (int ks = 0; ks < 4; ++ks) cfr[ks] = *(const bf16x8*)(Cm + ((size_t)g * 16 + fr) * 128 + ks * 32 + fq * 8);
#pragma unroll
            for (int jx = 0; jx < 4; ++jx) { gm4[jx] = gmix[g * 16 + 4 * fq + jx]; ds4[jx] = dsk[g * 16 + 4 * fq + jx]; }
        }
#pragma unroll
        for (int half = 0; half < 2; ++half) {
            const size_t trow = t0 + half * 32 + r32;
            const float rs = rsL[half * 32 + r32];
            const u32x4 raw = *(const u32x4*)(xb + trow * D_ + g * 16 + hi * 8);
            u32x4 sc4;
            sc4.x = cvt_pk_bf16(bflo(raw.x) * rs, bfhi(raw.x) * rs); sc4.y = cvt_pk_bf16(bflo(raw.y) * rs, bfhi(raw.y) * rs);
            sc4.z = cvt_pk_bf16(bflo(raw.z) * rs, bfhi(raw.z) * rs); sc4.w = cvt_pk_bf16(bflo(raw.w) * rs, bfhi(raw.w) * rs);
            const bf16x8 afr = *reinterpret_cast<const bf16x8*>(&sc4);
            f32x16 c0 = __builtin_amdgcn_mfma_f32_32x32x16_bf16(afr, bfr[0], f32x16{}, 0, 0, 0);
            f32x16 c1 = __builtin_amdgcn_mfma_f32_32x32x16_bf16(afr, bfr[1], f32x16{}, 0, 0, 0);
            f32x16 c2 = __builtin_amdgcn_mfma_f32_32x32x16_bf16(afr, bfr[2], f32x16{}, 0, 0, 0);
            f32x16 c3 = __builtin_amdgcn_mfma_f32_32x32x16_bf16(afr, bfr[3], f32x16{}, 0, 0, 0);
#pragma unroll
            for (int i = 0; i < 16; ++i) {
                auto r0 = __builtin_amdgcn_permlane32_swap(__float_as_uint(c0[i]), __float_as_uint(c1[i]), false, false);
                c0[i] = __uint_as_float(r0[0]); c1[i] = __uint_as_float(r0[1]);
                auto r1 = __builtin_amdgcn_permlane32_swap(__float_as_uint(c2[i]), __float_as_uint(c3[i]), false, false);
                c2[i] = __uint_as_float(r1[0]); c3[i] = __uint_as_float(r1[1]);
            }
#pragma unroll
            for (int t = 0; t < 32; ++t) {
                const int q = t >> 3, s = t & 7, idx = 4 * q + (s & 3);
                const float bur = (s < 4) ? c0[idx] : c1[idx], bui = (s < 4) ? c2[idx] : c3[idx];
                const float nr = ab.x * xr - ab.y * xi + bur, ni = ab.x * xi + ab.y * xr + bui;
                xr = nr; xi = ni;
                if (FINAL) *(unsigned*)(Xs + t * 136 + 2 * pp) = cvt_pk_bf16(xr, xi);
            }
            if (FINAL) {
                asm volatile("s_waitcnt lgkmcnt(0)" ::: "memory");
#pragma unroll
                for (int m = 0; m < 2; ++m) {
                    f32x4 acc = {0.f, 0.f, 0.f, 0.f};
#pragma unroll
                    for (int ks = 0; ks < 4; ++ks) {
                        const bf16x8 xf = *(const bf16x8*)(Xs + (m * 16 + fr) * 136 + ks * 32 + fq * 8);
                        acc = __builtin_amdgcn_mfma_f32_16x16x32_bf16(cfr[ks], xf, acc, 0, 0, 0);
                    }
                    const size_t tr2 = t0 + half * 32 + m * 16 + fr;
                    const float rs2 = rsL[half * 32 + m * 16 + fr];
                    const u32x2 hx = *(const u32x2*)(xb + tr2 * D_ + g * 16 + 4 * fq);
                    const float h0 = bflo(hx.x) * rs2 * gm4[0], h1 = bfhi(hx.x) * rs2 * gm4[1], h2 = bflo(hx.y) * rs2 * gm4[2], h3 = bfhi(hx.y) * rs2 * gm4[3];
                    const float y0 = gelu_tanh(acc[0] + ds4[0] * h0), y1 = gelu_tanh(acc[1] + ds4[1] * h1), y2 = gelu_tanh(acc[2] + ds4[2] * h2), y3 = gelu_tanh(acc[3] + ds4[3] * h3);
                    u32x2 w; w.x = cvt_pk_bf16(y0, y1); w.y = cvt_pk_bf16(y2, y3);
                    *(u32x2*)(gl + tr2 * D_ + g * 16 + 4 * fq) = w;
                }
                asm volatile("s_waitcnt lgkmcnt(0)" ::: "memory");
            }
        }
        if (!FINAL) { f32x2 e; e.x = xr; e.y = xi; E[((size_t)(b * 128 + g) * 64 + chunk) * 64 + pp] = e; }
      }
    }
}

__device__ __forceinline__ void s5_scan_phase(const Params& p) {
    const int tid = otid(), bid = obid();
    if (tid >= 128) return;
    f32x2* E = (f32x2*)(p.ws + OFF_BIG); const f32x2* AB = (const f32x2*)(p.ws + OFF_S5AB);
    for (int seq = bid * 128 + tid; seq < 4 * 128 * 64; seq += gridDim.x * 128) {
        const int pp = seq & 63, bg = seq >> 6, g = bg & 127;
        const f32x2 ab = AB[g * 64 + pp];
        float pr = ab.x, pi_ = ab.y;
#pragma unroll
        for (int k = 0; k < 6; ++k) { const float nr = pr * pr - pi_ * pi_, ni = 2.f * pr * pi_; pr = nr; pi_ = ni; }
        f32x2* Ep = E + (size_t)bg * 64 * 64 + pp;
        float xr = 0.f, xi = 0.f;
#pragma unroll 1
        for (int c0 = 0; c0 < 64; c0 += 16) {
            f32x2 e[16];
#pragma unroll
            for (int k = 0; k < 16; ++k) e[k] = Ep[(size_t)(c0 + k) * 64];
#pragma unroll
            for (int k = 0; k < 16; ++k) { f32x2 x; x.x = xr; x.y = xi; Ep[(size_t)(c0 + k) * 64] = x;
                const float nr = pr * xr - pi_ * xi + e[k].x, ni = pr * xi + pi_ * xr + e[k].y; xr = nr; xi = ni; }
        }
    }
}

__device__ __forceinline__ void ret_phase(const Params& p, unsigned char* shm, float* rssq) {
    const int tid = otid(), wid = tid >> 6, lane = tid & 63, fr = lane & 15, fq = lane >> 4;
    const bf16_t* ret = (const bf16_t*)(p.ws + OFF_BIG);
    bf16_t* ao = (bf16_t*)(p.ws + OFF_OA);
    constexpr int QS = 264, TS = 72;
    bf16_t* Qs = (bf16_t*)shm; bf16_t* Ks = Qs + 64 * QS; bf16_t* KTs = Ks + 64 * QS; bf16_t* VTs = KTs + 256 * TS; bf16_t* Ss = VTs + 64 * TS; bf16_t* RTs = Ss + 64 * TS;
    const int c = obid(); const int xcd = c & 7, jj = c >> 3;
    const int bh = xcd * 4 + (jj >> 3), sl = jj & 7;
    const int b = bh >> 3, h = bh & 7;
    const float lg = logf(1.0f - exp2f(-5.0f - (float)h));
    const float cdec = __expf(lg * 64.0f);
    const int mi = wid >> 1, ni0 = 2 * (wid & 1);
    const float qdec = __expf(lg * (float)(16 * mi + fr + 1));
    float idec[2][4];
#pragma unroll
    for (int t = 0; t < 2; ++t)
#pragma unroll
        for (int j = 0; j < 4; ++j) { const int n = 16 * mi + fr, m = 16 * (ni0 + t) + 4 * fq + j; idec[t][j] = __expf(lg * (fabsf((float)(n - m)) - (float)(63 - m))); }
    f32x4 R[4][2];
#pragma unroll
    for (int a = 0; a < 4; ++a)
#pragma unroll
        for (int d = 0; d < 2; ++d) R[a][d] = (f32x4){0.f, 0.f, 0.f, 0.f};
    const size_t tokb = (size_t)b * S_;
    const bf16_t* qsrc = ret + (tokb + (tid >> 5)) * 12288 + h * 256 + (tid & 31) * 8;
    const bf16_t* ksrc = ret + (tokb + lane) * 12288 + 2048 + h * 256 + wid * 32;
    const bf16_t* vsrc = ret + (tokb + lane) * 12288 + 4096 + h * 512 + sl * 64 + wid * 8;
    u32x4 pq[4], pk[4], pv; u32x2 pg[2], cg2[2];
    const bf16_t* gsrc = ret + (tokb + 16 * mi + fr) * 12288 + 8192 + h * 512 + sl * 64 + 16 * ni0 + 4 * fq;
#pragma unroll
    for (int j = 0; j < 4; ++j) { pq[j] = *(const u32x4*)(qsrc + (size_t)j * 16 * 12288); pk[j] = *(const u32x4*)(ksrc + j * 8); }
    pv = *(const u32x4*)vsrc;
    pg[0] = *(const u32x2*)gsrc; pg[1] = *(const u32x2*)(gsrc + 16);
    for (int ch = 0; ch < 64; ++ch) {
        __syncthreads();
        cg2[0] = pg[0]; cg2[1] = pg[1];
#pragma unroll
        for (int j = 0; j < 4; ++j) {
            *(u32x4*)(Qs + (j * 16 + (tid >> 5)) * QS + (tid & 31) * 8) = pq[j];
            *(u32x4*)(Ks + lane * QS + wid * 32 + j * 8) = pk[j];
            const unsigned kw[4] = {pk[j].x, pk[j].y, pk[j].z, pk[j].w};
#pragma unroll
            for (int i = 0; i < 4; ++i) {
                KTs[(wid * 32 + j * 8 + 2 * i) * TS + lane] = (bf16_t)(kw[i] & 0xffffu);
                KTs[(wid * 32 + j * 8 + 2 * i + 1) * TS + lane] = (bf16_t)(kw[i] >> 16);
            }
        }
        { const unsigned vw[4] = {pv.x, pv.y, pv.z, pv.w};
#pragma unroll
          for (int i = 0; i < 4; ++i) { VTs[(wid * 8 + 2 * i) * TS + lane] = (bf16_t)(vw[i] & 0xffffu); VTs[(wid * 8 + 2 * i + 1) * TS + lane] = (bf16_t)(vw[i] >> 16); } }
#pragma unroll
        for (int ei = 0; ei < 4; ++ei)
#pragma unroll
            for (int di = 0; di < 2; ++di) { u32x2 w; w.x = cvt_pk_bf16(R[ei][di][0], R[ei][di][1]); w.y = cvt_pk_bf16(R[ei][di][2], R[ei][di][3]);
                *(u32x2*)(RTs + (16 * ei + fr) * QS + wid * 32 + 16 * di + 4 * fq) = w; }
        if (ch + 1 < 64) {
            const size_t adv = (size_t)(ch + 1) * 64 * 12288;
#pragma unroll
            for (int j = 0; j < 4; ++j) { pq[j] = *(const u32x4*)(qsrc + adv + (size_t)j * 16 * 12288); pk[j] = *(const u32x4*)(ksrc + adv + j * 8); }
            pv = *(const u32x4*)(vsrc + adv);
            pg[0] = *(const u32x2*)(gsrc + adv); pg[1] = *(const u32x2*)(gsrc + adv + 16);
        }
        __syncthreads();
        bf16x8 qa[8];
        {
            f32x4 sacc[2] = {{0.f, 0.f, 0.f, 0.f}, {0.f, 0.f, 0.f, 0.f}};
#pragma unroll
            for (int ks = 0; ks < 8; ++ks) qa[ks] = *(const bf16x8*)(Qs + (16 * mi + fr) * QS + ks * 32 + fq * 8);
#pragma unroll
            for (int ks = 0; ks < 8; ++ks) {
#pragma unroll
                for (int t = 0; t < 2; ++t) { const bf16x8 bf = *(const bf16x8*)(Ks + (16 * (ni0 + t) + fr) * QS + ks * 32 + fq * 8);
                    sacc[t] = __builtin_amdgcn_mfma_f32_16x16x32_bf16(bf, qa[ks], sacc[t], 0, 0, 0); }
            }
#pragma unroll
            for (int t = 0; t < 2; ++t) { u32x2 w; w.x = cvt_pk_bf16(sacc[t][0] * idec[t][0], sacc[t][1] * idec[t][1]); w.y = cvt_pk_bf16(sacc[t][2] * idec[t][2], sacc[t][3] * idec[t][3]);
                *(u32x2*)(Ss + (16 * mi + fr) * TS + 16 * (ni0 + t) + 4 * fq) = w; }
        }
        __syncthreads();
        {
            f32x4 oi[2] = {{0.f, 0.f, 0.f, 0.f}, {0.f, 0.f, 0.f, 0.f}}, oc[2] = {{0.f, 0.f, 0.f, 0.f}, {0.f, 0.f, 0.f, 0.f}};
#pragma unroll
            for (int ks = 0; ks < 2; ++ks) {
                const bf16x8 af = *(const bf16x8*)(Ss + (16 * mi + fr) * TS + ks * 32 + fq * 8);
#pragma unroll
                for (int t = 0; t < 2; ++t) { const bf16x8 bf = *(const bf16x8*)(VTs + (16 * (ni0 + t) + fr) * TS + ks * 32 + fq * 8);
                    oi[t] = __builtin_amdgcn_mfma_f32_16x16x32_bf16(bf, af, oi[t], 0, 0, 0); }
            }
#pragma unroll
            for (int ks = 0; ks < 8; ++ks) {
#pragma unroll
                for (int t = 0; t < 2; ++t) { const bf16x8 bf = *(const bf16x8*)(RTs + (16 * (ni0 + t) + fr) * QS + ks * 32 + fq * 8);
                    oc[t] = __builtin_amdgcn_mfma_f32_16x16x32_bf16(bf, qa[ks], oc[t], 0, 0, 0); }
            }
            const size_t tok = tokb + (size_t)ch * 64 + 16 * mi + fr;
            float sq = 0.f;
#pragma unroll
            for (int t = 0; t < 2; ++t) {
                const int e = sl * 64 + 16 * (ni0 + t) + 4 * fq;
                const u32x2 gw = cg2[t];
                f32x4 ov = oi[t] + oc[t] * qdec;
                sq += ov[0] * ov[0] + ov[1] * ov[1] + ov[2] * ov[2] + ov[3] * ov[3];
                u32x2 w; w.x = cvt_pk_bf16(ov[0] * bflo(gw.x), ov[1] * bfhi(gw.x)); w.y = cvt_pk_bf16(ov[2] * bflo(gw.y), ov[3] * bfhi(gw.y));
                *(u32x2*)(ao + tok * 4096 + h * 512 + e) = w;
            }
            sq += __shfl_xor(sq, 16); sq += __shfl_xor(sq, 32);
            if (fq == 0) atomicAdd(rssq + (size_t)(sl * 4 + mi) * 0 + (size_t)sl * (T_ * 8) + tok * 8 + h, sq);
        }
#pragma unroll
        for (int ei = 0; ei < 4; ++ei)
#pragma unroll
            for (int di = 0; di < 2; ++di) R[ei][di] *= cdec;
#pragma unroll
        for (int ks = 0; ks < 2; ++ks) {
            bf16x8 bfk[2];
#pragma unroll
            for (int di = 0; di < 2; ++di) bfk[di] = *(const bf16x8*)(KTs + (wid * 32 + 16 * di + fr) * TS + ks * 32 + fq * 8);
#pragma unroll
            for (int ei = 0; ei < 4; ++ei) { const bf16x8 af = *(const bf16x8*)(VTs + (16 * ei + fr) * TS + ks * 32 + fq * 8);
#pragma unroll
                for (int di = 0; di < 2; ++di) R[ei][di] = __builtin_amdgcn_mfma_f32_16x16x32_bf16(bfk[di], af, R[ei][di], 0, 0, 0); }
        }
    }
}

__device__ __forceinline__ void ret2_phase(const Params& p) {
    bf16_t* ao = (bf16_t*)(p.ws + OFF_OA); const float* rssq = (const float*)(p.ws + OFF_RSQP);
    const size_t nvec = (size_t)T_ * 4096 / 8, stride = (size_t)gridDim.x * 512;
    for (size_t i0 = (size_t)obid() * 512 + otid(); i0 < nvec; i0 += 4 * stride) {
        u32x4 w[4]; float rsum[4];
#pragma unroll
        for (int u = 0; u < 4; ++u) { const size_t i = i0 + u * stride; w[u] = *(u32x4*)(ao + i * 8);
            const size_t t = i >> 9; const int hh = (int)((i & 511) >> 6); float a = 0.f;
#pragma unroll
            for (int sl = 0; sl < 8; ++sl) a += rssq[(size_t)sl * (T_ * 8) + t * 8 + hh];
            rsum[u] = a; }
#pragma unroll
        for (int u = 0; u < 4; ++u) { const size_t i = i0 + u * stride; const float rs = rsqrtf(rsum[u] * (1.0f / 512.0f) + EPS_);
            u32x4 x = w[u];
            x.x = cvt_pk_bf16(bflo(x.x) * rs, bfhi(x.x) * rs); x.y = cvt_pk_bf16(bflo(x.y) * rs, bfhi(x.y) * rs);
            x.z = cvt_pk_bf16(bflo(x.z) * rs, bfhi(x.z) * rs); x.w = cvt_pk_bf16(bflo(x.w) * rs, bfhi(x.w) * rs);
            *(u32x4*)(ao + i * 8) = x; }
    }
}

__device__ __forceinline__ void final_phase(const Params& p) {
    const float* ss = (const float*)(p.ws + OFF_SSP) + (size_t)8 * 32 * T_;
    const int tid = otid();
    const f32x4 g = *(const f32x4*)((const float*)(p.ws + OFF_PAR) + PAR_NFINAL + tid * 4);
    const int G = gridDim.x;
    for (int row0 = obid(); row0 < T_; row0 += 4 * G) {
        f32x4 v[4]; float sm[4];
#pragma unroll
        for (int u = 0; u < 4; ++u) { const int row = row0 + u * G; sm[u] = ss[(size_t)(tid & 31) * T_ + row]; v[u] = *(f32x4*)(p.out + (size_t)row * D_ + tid * 4); }
#pragma unroll
        for (int u = 0; u < 4; ++u) { const int row = row0 + u * G; float ssum = sm[u];
#pragma unroll
            for (int o = 16; o > 0; o >>= 1) ssum += __shfl_xor(ssum, o);
            const float rs = rsqrtf(ssum * (1.0f / D_) + EPS_);
            *(f32x4*)(p.out + (size_t)row * D_ + tid * 4) = v[u] * rs * g; }
    }
}

enum { OP_PREP = 0, OP_A_IN, OP_ATTN, OP_A_OUT, OP_S5A, OP_S5C, OP_GLU, OP_C_IN, OP_RET, OP_RET2, OP_C_OUT, OP_W1, OP_W2, OP_FINAL, OP_S5B };
#ifndef PHMASK
#define PHMASK 0xffff
#endif
#define PHON(b) ((PHMASK >> (b)) & 1)
constexpr int NPH = 24;
__device__ const unsigned char PROG_OP[NPH] = { OP_PREP,
    OP_A_IN, OP_ATTN, OP_A_OUT, OP_W1, OP_W2,
    OP_S5A, OP_S5B, OP_S5C, OP_GLU, OP_W1, OP_W2,
    OP_C_IN, OP_RET, OP_RET2, OP_C_OUT, OP_W1, OP_W2,
    OP_A_IN, OP_ATTN, OP_A_OUT, OP_W1, OP_W2,
    OP_FINAL };
__device__ const unsigned char PROG_LAYER[NPH] = { 0, 0, 0, 0, 0, 0, 1, 1, 1, 1, 1, 1, 2, 2, 2, 2, 2, 2, 3, 3, 3, 3, 3, 3 };

struct GemmDesc { unsigned long long a_off, b_off; int N, K, ss_idx, mode; };
#define GD_NONE {0, 0, 0, 0, 0, 0}
#define GD_A_IN(L)  {OFF_XB, OFF_WT_A_IN + (L / 3) * SZ_A_IN, 6144, 2048, 2 * L, 0}
#define GD_A_OUT(L) {OFF_OA, OFF_WT_A_OUT + (L / 3) * SZ_A_OUT, 2048, 2048, 2 * L + 1, 0}
#define GD_W1(L)    {OFF_XB, OFF_WT_W1 + L * SZ_W1, 8192, 2048, 2 * L + 1, 1}
#define GD_W2(L)    {OFF_BIG, OFF_WT_W2 + L * SZ_W1, 2048, 8192, 2 * L + 2, 0}
#define GD_GLU(L)   {OFF_OA, OFF_WT_GLU, 4096, 2048, 2 * L + 1, 1}
#define GD_C_IN(L)  {OFF_XB, OFF_WT_C_IN, 12288, 2048, 2 * L, 2}
#define GD_C_OUT(L) {OFF_OA, OFF_WT_C_OUT, 2048, 4096, 2 * L + 1, 0}
__device__ const GemmDesc GD[NPH] = { GD_NONE,
    GD_A_IN(0ull), GD_NONE, GD_A_OUT(0ull), GD_W1(0ull), GD_W2(0ull),
    GD_NONE, GD_NONE, GD_NONE, GD_GLU(1ull), GD_W1(1ull), GD_W2(1ull),
    GD_C_IN(2ull), GD_NONE, GD_NONE, GD_C_OUT(2ull), GD_W1(2ull), GD_W2(2ull),
    GD_A_IN(3ull), GD_NONE, GD_A_OUT(3ull), GD_W1(3ull), GD_W2(3ull),
    GD_NONE };

#define XB_TMO      128
#define XB_XCNT(j)  (256  + 64 * (j))
#define XB_XSUB(j)  (1280 + 64 * (j))
#define XB_XGEN(j)  (2304 + 64 * (j))
#define XB_TOP      3328
#define XB_TOPGEN   3392
#define XCD_BAR_WORDS 3456
#define XB_SPIN_CAP (1u << 22)
__device__ __forceinline__ unsigned xb_ld(unsigned* p)              { return __hip_atomic_load(p, __ATOMIC_RELAXED, __HIP_MEMORY_SCOPE_AGENT); }
__device__ __forceinline__ unsigned xb_add(unsigned* p, unsigned v) { return __hip_atomic_fetch_add(p, v, __ATOMIC_RELAXED, __HIP_MEMORY_SCOPE_AGENT); }
__device__ __forceinline__ unsigned xb_xcc_id() { return (unsigned)__builtin_amdgcn_s_getreg((3 << 11) | 20) & 0xFu; }
#define XB_SPIN(cond, bar) do { unsigned _sp = 0; while (cond) { __builtin_amdgcn_s_sleep(1); \
    if ((++_sp & 255u) == 0u) { if (xb_ld(&(bar)[XB_TMO])) break; if (_sp > XB_SPIN_CAP) { atomicAdd(&(bar)[XB_TMO], 1u); break; } } } } while (0)
struct XcdBarrier { unsigned* bar; unsigned x; volatile LAS unsigned* st; };
__device__ __forceinline__ XcdBarrier xcd_barrier_post(unsigned* bar, volatile LAS unsigned* st) {
    XcdBarrier b; b.bar = bar; b.x = xb_xcc_id(); b.st = st;
    if (threadIdx.x == 0) (void)xb_add(&bar[XB_XCNT(b.x)], 1u);
    return b;
}
__device__ __forceinline__ void xcd_barrier_complete(unsigned* bar, unsigned x, unsigned& nloc, unsigned& nx) {
    const unsigned G = gridDim.x * gridDim.y * gridDim.z;
    unsigned sum, cnt, mine, sp = 0u;
    for (;;) {
        sum = 0u; cnt = 0u; mine = 0u;
#pragma unroll
        for (unsigned j = 0; j < 16; ++j) { const unsigned c = xb_ld(&bar[XB_XCNT(j)]); sum += c; cnt += (c > 0u) ? 1u : 0u; mine = (j == x) ? c : mine; }
        if (sum == G) break;
        __builtin_amdgcn_s_sleep(1);
        if ((++sp & 255u) == 0u) { if (xb_ld(&bar[XB_TMO])) break; if (sp > XB_SPIN_CAP) { atomicAdd(&bar[XB_TMO], 1u); break; } }
    }
    nloc = mine > 0u ? mine : 1u; nx = cnt > 0u ? cnt : 1u;
}
__device__ __forceinline__ void xcd_barrier(unsigned char* ws, unsigned char* shm) {
    XcdBarrier b; b.bar = (unsigned*)(ws + OFF_BAR); b.x = xb_xcc_id(); b.st = (volatile LAS unsigned*)((LAS unsigned char*)shm + LDS_PHASE_BYTES);
    asm volatile("s_waitcnt vmcnt(0) lgkmcnt(0)" ::: "memory");
    __syncthreads();
    if (threadIdx.x == 0) {
        unsigned* bar = b.bar;
        __builtin_amdgcn_s_waitcnt(0);
        unsigned nloc = b.st[0], nx = b.st[1];
        if (nloc == 0u) { xcd_barrier_complete(bar, b.x, nloc, nx); b.st[0] = nloc; b.st[1] = nx; }
        const unsigned old = xb_add(&bar[XB_XSUB(b.x)], 1u);
        const unsigned gen = old / nloc;
        if (old + 1u == (gen + 1u) * nloc) {
            __builtin_amdgcn_fence(__ATOMIC_RELEASE, "agent");
            asm volatile("s_waitcnt vmcnt(0)" ::: "memory");
            const unsigned og = xb_add(&bar[XB_TOP], 1u);
            const unsigned tg = og / nx;
            if (og + 1u == (tg + 1u) * nx) xb_add(&bar[XB_TOPGEN], 1u);
            else XB_SPIN(xb_ld(&bar[XB_TOPGEN]) == tg, bar);
            __builtin_amdgcn_fence(__ATOMIC_ACQUIRE, "agent");
            xb_add(&bar[XB_XGEN(b.x)], 1u);
            asm volatile("s_waitcnt vmcnt(0)" ::: "memory");
        } else {
            XB_SPIN(xb_ld(&bar[XB_XGEN(b.x)]) == gen, bar);
            __builtin_amdgcn_fence(__ATOMIC_ACQUIRE, "agent");
            asm volatile("s_waitcnt vmcnt(0)" ::: "memory");
        }
    }
    __syncthreads();
}
__device__ __forceinline__ void gsync_cg(cg::grid_group& grid) {
    asm volatile("s_waitcnt vmcnt(0) lgkmcnt(0)" ::: "memory");
    grid.sync();
    __builtin_amdgcn_fence(__ATOMIC_ACQUIRE, "agent");
    asm volatile("s_waitcnt vmcnt(0) lgkmcnt(0)" ::: "memory");
}

__global__ void __launch_bounds__(512, 2) fwd_megakernel(Params p, int ph_lo, int ph_hi) {
    extern __shared__ __attribute__((aligned(16))) unsigned char shm[];
    cg::grid_group grid = cg::this_grid();
    volatile LAS unsigned* xst = (volatile LAS unsigned*)((LAS unsigned char*)shm + LDS_PHASE_BYTES);
    if (threadIdx.x == 0) { xst[0] = 0u; xst[1] = 0u; }
    __syncthreads();
    (void)xcd_barrier_post((unsigned*)(p.ws + OFF_BAR), xst);
#ifndef DUPMASK
#define DUPMASK 0
#endif
    if (PHON(0) && ph_lo == 0) {
#pragma unroll 1
        for (int rp_ = 0; rp_ < ((DUPMASK & 1) ? 2 : 1); ++rp_) { prep_phase(p, shm); if (ph_hi > 1) gsync_cg(grid); } }
    for (int ph = (ph_lo < 1 ? 1 : ph_lo); ph < ph_hi; ++ph) {
        const int op = PROG_OP[ph], L = PROG_LAYER[ph];
        const int nrep_ = ((DUPMASK >> op) & 1) ? 2 : 1;
#pragma unroll 1
        for (int rp_ = 0; rp_ < nrep_; ++rp_) {
        unsigned char* ws = p.ws; asm volatile("" : "+s"(ws));
        float* ssb = (float*)(ws + OFF_SSP);
        if (PHON(1) && (op == OP_A_IN || op == OP_C_IN || op == OP_W1)) {
            const GemmDesc gd = GD[ph];
            pg8::Gemm g; g.A = (const bf16_t*)(ws + gd.a_off); g.Bt = (const bf16_t*)(ws + gd.b_off); g.M = T_; g.N = gd.N; g.K = gd.K;
            pg8::EpiBf E; E.rot = (const f32x2*)(ws + OFF_ROT); E.O = (bf16_t*)(ws + OFF_BIG); E.ldc = gd.N; E.mode = gd.mode; E.ss = ssb + (size_t)gd.ss_idx * 32 * T_;
            pg8::StaticOrder S; S.init(g.M, g.N, (int)gridDim.x, obid());
            {
                float* lrs = (float*)(shm + pg8::STAGE_BYTES); const int tid2 = otid();
                int nun = 0; { pg8::Unit uu; while (nun < 24 && S.next(nun, uu)) ++nun; }
                for (int j = tid2; j < nun * 256; j += 512) { pg8::Unit uu; S.next(j >> 8, uu);
                    const float* sp = E.ss + (size_t)uu.pm * 256 + (j & 255); float sv[32];
#pragma unroll
                    for (int sl = 0; sl < 32; ++sl) sv[sl] = sp[(size_t)sl * T_];
                    float a = 0.f;
#pragma unroll
                    for (int sl = 0; sl < 32; ++sl) a += sv[sl];
                    lrs[j] = rsqrtf(a * (1.0f / D_) + EPS_); }
                __syncthreads();
            }
            pg8::gemm_phase<pg8::EpiBf, pg8::StaticOrder>((LAS unsigned char*)shm, g, S, E);
        } else if (PHON(2) && (op == OP_A_OUT || op == OP_GLU || op == OP_C_OUT || op == OP_W2)) {
            const GemmDesc gd = GD[ph];
            pg8::Gemm g; g.A = (const bf16_t*)(ws + gd.a_off); g.Bt = (const bf16_t*)(ws + gd.b_off); g.M = T_; g.N = gd.N; g.K = gd.K;
            pg8::EpiRes E; E.xout = p.out; E.xb = (bf16_t*)(ws + OFF_XB); E.glu = gd.mode; E.xin = p.out; E.ssn = ssb + (size_t)gd.ss_idx * 32 * T_;
            pg8::StaticOrder S; S.init(g.M, g.N, (int)gridDim.x, obid());
            pg8::gemm_phase<pg8::EpiRes, pg8::StaticOrder>((LAS unsigned char*)shm, g, S, E);
        } else if (PHON(3) && op == OP_ATTN) {
            const float li = 0.8f - 0.6f * expf(-0.3f * (float)L);
            attn_phase(p, L / 3, li, shm);
        } else if (PHON(4) && op == OP_S5A) {
            s5_phase<false>(p, shm);
        } else if (PHON(4) && op == OP_S5B) {
            s5_scan_phase(p);
        } else if (PHON(5) && op == OP_S5C) {
            s5_phase<true>(p, shm);
        } else if (PHON(6) && op == OP_RET) {
            ret_phase(p, shm, (float*)(ws + (rp_ == 0 ? OFF_RSQP : OFF_XB)));
        } else if (PHON(7) && op == OP_RET2) {
            ret2_phase(p);
        } else if (PHON(8) && op == OP_FINAL) {
            final_phase(p);
        }
        if (ph + 1 < ph_hi || rp_ + 1 < nrep_) xcd_barrier(ws, shm);
        }
    }
}

extern "C" void kernel_launch(void* const* d_in, const int* in_sizes, int n_in, void* d_out, int out_size, void* d_ws, size_t ws_size, hipStream_t stream) {
    static int grid_blocks = 0;
    if (grid_blocks == 0) {
        if (n_in != 21 || out_size != T_ * D_ || ws_size < WS_NEED) { fprintf(stderr, "kernel_launch: unexpected shapes n_in %d out %d ws %zu (need %zu)\n", n_in, out_size, ws_size, (size_t)WS_NEED); grid_blocks = -1; return; }
        int dev = 0, cus = 0, per_cu = 0;
        hipGetDevice(&dev);
        hipDeviceGetAttribute(&cus, hipDeviceAttributeMultiprocessorCount, dev);
        if (hipFuncSetAttribute((const void*)fwd_megakernel, hipFuncAttributeMaxDynamicSharedMemorySize, LDS_BYTES) != hipSuccess) { fprintf(stderr, "kernel_launch: hipFuncSetAttribute failed\n"); grid_blocks = -1; return; }
        hipOccupancyMaxActiveBlocksPerMultiprocessor(&per_cu, (const void*)fwd_megakernel, 512, LDS_BYTES);
        (void)hipGetLastError();
        if (per_cu < 1) per_cu = 1;
        grid_blocks = cus * 1;
        if (grid_blocks != 256) fprintf(stderr, "kernel_launch: note: %d CUs (kernel tuned for 256)\n", cus);
    }
    if (grid_blocks < 0) return;
    (void)hipMemsetAsync((unsigned char*)d_ws + OFF_BAR, 0, XCD_BAR_WORDS * 4, stream);
    Params p{};
    const float** pp = (const float**)&p;
    for (int i = 0; i < 21; ++i) pp[i] = (const float*)d_in[i];
    p.out = (float*)d_out; p.ws = (unsigned char*)d_ws;
#ifndef DBG_LO
#define DBG_LO 0
#endif
#ifndef DBG_HI
#define DBG_HI NPH
#endif
    int lo = DBG_LO, hi = DBG_HI;
    void* args[] = {&p, &lo, &hi};
    hipError_t e = hipLaunchCooperativeKernel((const void*)fwd_megakernel, dim3(grid_blocks), dim3(512), args, LDS_BYTES, stream);
    if (e != hipSuccess) fprintf(stderr, "cooperative launch failed: %s (grid %d)\n", hipGetErrorString(e), grid_blocks);
}
```
